# Optimizing an MI355X kernel written in HIP

```python
import jax, jax.numpy as jnp
from jax import lax
import numpy as np

D_MODEL = 1024
BATCH = 4
SEQ = 8192
DEPTH = 2

CHUNK = 64
N_BRANCH = 3
POOL_GROUPS = 4
POOL_GW = 128
POOL_W = POOL_GROUPS * POOL_GW
POOL_WINDOWS = (2, 4, 8, 16)
ML_HEADS = 4
ML_DH = 128
ML_W = ML_HEADS * ML_DH
CONV_W = 4
FOX_HEADS = 8
FOX_DH = 64
FOX_W = FOX_HEADS * FOX_DH
Q_BLOCK = 128
D_FF = 2816
N_EXPERTS = 8
TOP_K = 2
D_FF_EXPERT = 3584
MOE_BLOCK = 128
NORM_EPS = 1e-6
IN_SIZES = (POOL_W, ML_W, ML_W, ML_W, ML_W, ML_HEADS, ML_HEADS, FOX_W, FOX_W, FOX_W, FOX_HEADS, N_BRANCH * D_MODEL)
IN_W = sum(IN_SIZES)
N_DENSE = (DEPTH + 1) // 2
N_MOE = DEPTH // 2

kernel_name = 'hybrid_pool_mlstm_fox_moe_trunk'


def rmsnorm(x, g):
    xf = x.astype(jnp.float32)
    y = xf * lax.rsqrt(jnp.mean(xf * xf, axis=-1, keepdims=True) + NORM_EPS)
    return (y * g.astype(jnp.float32)).astype(x.dtype)


def causal_depthwise_conv(u, w):
    return lax.conv_general_dilated(u, w[:, None, :].astype(u.dtype), window_strides=(1,),
                                    padding=[(CONV_W - 1, 0)], dimension_numbers=('NWC', 'WIO', 'NWC'),
                                    feature_group_count=u.shape[-1])


def pool_mixer(u, w_grp, scale):
    bsz, s_len, _ = u.shape
    uf = u.astype(jnp.float32).reshape(bsz, s_len, POOL_GROUPS, POOL_GW)
    cs = jnp.concatenate([jnp.zeros_like(uf[:, :1]), jnp.cumsum(uf, axis=1)], axis=1)
    pos = jnp.arange(s_len)
    outs = []
    for g, w in enumerate(POOL_WINDOWS):
        csg = cs[:, :, g]
        lower = jnp.concatenate([jnp.zeros_like(csg[:, :w - 1]), csg[:, :s_len - w + 1]], axis=1)
        cnt = jnp.minimum(pos + 1, w).astype(jnp.float32)[None, :, None]
        outs.append((csg[:, 1:] - lower) / cnt - uf[:, :, g])
    d = jnp.stack(outs, axis=2)
    y = jnp.einsum('bsgc,gcd->bsgd', d, w_grp.astype(jnp.float32)).reshape(bsz, s_len, POOL_W)
    return (y * scale.astype(jnp.float32)).astype(u.dtype)


def mlstm_mixer(q, k, v, o_pre, i_pre, f_pre, g_norm):
    bsz, s_len, _ = q.shape
    nc = s_len // CHUNK

    def heads(t):
        return t.astype(jnp.float32).reshape(bsz, nc, CHUNK, ML_HEADS, ML_DH).transpose(1, 0, 3, 2, 4)

    def gates(t):
        return t.astype(jnp.float32).reshape(bsz, nc, CHUNK, ML_HEADS).transpose(1, 0, 3, 2)

    qc, kc, vc = heads(q), heads(k) * (ML_DH ** -0.5), heads(v)
    lic = gates(i_pre)
    lfc = gates(jax.nn.log_sigmoid(f_pre.astype(jnp.float32)))
    tri = jnp.tril(jnp.ones((CHUNK, CHUNK), dtype=bool))

    def step(carry, inp):
        c_mat, n_vec, m = carry
        qb, kb, vb, li, lf = inp
        b = jnp.cumsum(lf, axis=-1)
        dmat = jnp.where(tri, b[..., :, None] - b[..., None, :] + li[..., None, :], -jnp.inf)
        m_inter = b + m[..., None]
        m_t = jnp.maximum(m_inter, jnp.max(dmat, axis=-1))
        w_inter = jnp.exp(m_inter - m_t)
        p = jnp.exp(dmat - m_t[..., None]) * jnp.einsum('bhtd,bhsd->bhts', qb, kb)
        num = w_inter[..., None] * jnp.einsum('bhvk,bhtk->bhtv', c_mat, qb) + jnp.einsum('bhts,bhsv->bhtv', p, vb)
        den = w_inter * jnp.einsum('bhk,bhtk->bht', n_vec, qb) + jnp.sum(p, axis=-1)
        h = num / jnp.maximum(jnp.abs(den), jnp.exp(-m_t))[..., None]
        b_last = b[..., -1]
        g = b_last[..., None] - b + li
        m_new = jnp.maximum(b_last + m, jnp.max(g, axis=-1))
        decay = jnp.exp(b_last + m - m_new)
        wk = jnp.exp(g - m_new[..., None])
        c_mat = decay[..., None, None] * c_mat + jnp.einsum('bhs,bhsv,bhsk->bhvk', wk, vb, kb)
        n_vec = decay[..., None] * n_vec + jnp.einsum('bhs,bhsk->bhk', wk, kb)
        return (c_mat, n_vec, m_new), h

    init = (jnp.zeros((bsz, ML_HEADS, ML_DH, ML_DH), jnp.float32),
            jnp.zeros((bsz, ML_HEADS, ML_DH), jnp.float32),
            jnp.zeros((bsz, ML_HEADS), jnp.float32))
    _, h = lax.scan(step, init, (qc, kc, vc, lic, lfc))
    h = h.transpose(1, 0, 3, 2, 4)
    h = h * lax.rsqrt(jnp.mean(h * h, axis=-1, keepdims=True) + NORM_EPS) * g_norm.astype(jnp.float32).reshape(ML_HEADS, ML_DH)
    h = h.reshape(bsz, s_len, ML_W) * jax.nn.sigmoid(o_pre.astype(jnp.float32))
    return h.astype(q.dtype)


def fox_mixer(q, k, v, f_pre):
    bsz, s_len, _ = q.shape
    nb = s_len // Q_BLOCK
    qh = q.reshape(bsz, s_len, FOX_HEADS, FOX_DH).transpose(0, 2, 1, 3)
    kh = k.reshape(bsz, s_len, FOX_HEADS, FOX_DH).transpose(0, 2, 1, 3)
    vh = v.reshape(bsz, s_len, FOX_HEADS, FOX_DH).transpose(0, 2, 1, 3)
    f_cum = jnp.cumsum(jax.nn.log_sigmoid(f_pre.astype(jnp.float32)), axis=1).transpose(0, 2, 1)
    q_blocks = qh.reshape(bsz, FOX_HEADS, nb, Q_BLOCK, FOX_DH).transpose(2, 0, 1, 3, 4)
    f_blocks = f_cum.reshape(bsz, FOX_HEADS, nb, Q_BLOCK).transpose(2, 0, 1, 3)
    kpos = jnp.arange(s_len)
    scale = FOX_DH ** -0.5

    def block(args):
        qb, fq, i = args
        qpos = i * Q_BLOCK + jnp.arange(Q_BLOCK)
        s = jnp.einsum('bhtd,bhsd->bhts', qb, kh).astype(jnp.float32) * scale + fq[..., :, None] - f_cum[:, :, None, :]
        s = jnp.where(kpos[None, :] <= qpos[:, None], s, -jnp.inf)
        p = jax.nn.softmax(s, axis=-1)
        return jnp.einsum('bhts,bhsd->bhtd', p.astype(vh.dtype), vh)

    o = lax.map(block, (q_blocks, f_blocks, jnp.arange(nb)))
    return o.transpose(1, 0, 3, 2, 4).reshape(bsz, s_len, FOX_W)


def token_mixing(x, norm_g, w_in, pool_w_grp, pool_scale, ml_conv_w, ml_b_i, ml_b_f, ml_norm_g,
                 fox_b_f, w_br_pool, w_br_ml, w_br_fox, w_out):
    h = rmsnorm(x, norm_g)
    proj = h @ w_in
    splits = np.cumsum(IN_SIZES)[:-1].tolist()
    (u_pool, ml_q, ml_k, ml_v, ml_o, ml_i, ml_f, fx_q, fx_k, fx_v, fx_f, gate_pre) = jnp.split(proj, splits, axis=-1)
    qk = jax.nn.silu(causal_depthwise_conv(jnp.concatenate([ml_q, ml_k], axis=-1), ml_conv_w))
    ml_q, ml_k = qk[..., :ML_W], qk[..., ML_W:]
    y_pool = pool_mixer(u_pool, pool_w_grp, pool_scale) @ w_br_pool
    y_ml = mlstm_mixer(ml_q, ml_k, ml_v, ml_o, ml_i + ml_b_i, ml_f + ml_b_f, ml_norm_g) @ w_br_ml
    y_fox = fox_mixer(fx_q, fx_k, fx_v, fx_f + fox_b_f) @ w_br_fox
    gts = jax.nn.sigmoid(gate_pre).reshape(gate_pre.shape[:-1] + (N_BRANCH, D_MODEL))
    merged = gts[..., 0, :] * y_pool + gts[..., 1, :] * y_ml + gts[..., 2, :] * y_fox
    return merged @ w_out


def swiglu(h, w_gate, w_up, w_down):
    return (jax.nn.silu(h @ w_gate) * (h @ w_up)) @ w_down


def moe_swiglu(h, w_router, b_router, w_gate, w_up, w_down):
    bsz, s_len, d = h.shape
    n_tok = bsz * s_len
    t = h.reshape(n_tok, d)
    logits = (t @ w_router).astype(jnp.float32) + b_router.astype(jnp.float32)
    top_v, top_e = lax.top_k(logits, TOP_K)
    gate = jax.nn.softmax(top_v, axis=-1)
    n_asg = n_tok * TOP_K
    e_flat = top_e.reshape(n_asg)
    tok_flat = jnp.repeat(jnp.arange(n_tok, dtype=jnp.int32), TOP_K)
    g_flat = gate.reshape(n_asg)
    order = jnp.argsort(e_flat)
    e_s, tok_s, g_s = e_flat[order], tok_flat[order], g_flat[order]
    counts = jnp.bincount(e_flat, length=N_EXPERTS).astype(jnp.int32)
    start = jnp.cumsum(counts) - counts
    padded = ((counts + MOE_BLOCK - 1) // MOE_BLOCK) * MOE_BLOCK
    pend = jnp.cumsum(padded)
    pstart = pend - padded
    dest = pstart[e_s] + (jnp.arange(n_asg, dtype=jnp.int32) - start[e_s])
    n_blk = (n_asg + N_EXPERTS * (MOE_BLOCK - 1) + MOE_BLOCK - 1) // MOE_BLOCK
    n_rows = n_blk * MOE_BLOCK
    row_tok = jnp.full((n_rows,), n_tok, dtype=jnp.int32).at[dest].set(tok_s)
    row_g = jnp.zeros((n_rows,), jnp.float32).at[dest].set(g_s)
    blk_e = jnp.minimum(jnp.searchsorted(pend, jnp.arange(n_blk, dtype=jnp.int32) * MOE_BLOCK, side='right'), N_EXPERTS - 1)
    t_pad = jnp.concatenate([t, jnp.zeros((1, d), t.dtype)], axis=0)
    xr = t_pad[row_tok].reshape(n_blk, MOE_BLOCK, d)

    def one(args):
        xb, e = args
        return (jax.nn.silu(xb @ w_gate[e]) * (xb @ w_up[e])) @ w_down[e]

    out = lax.map(one, (xr, blk_e)).reshape(n_rows, d)
    y = jnp.zeros((n_tok + 1, d), out.dtype).at[row_tok].add(out * row_g[:, None].astype(out.dtype))[:n_tok]
    return y.reshape(bsz, s_len, d)


def setup_inputs(seed: int = 0) -> dict:
    key = jax.random.key(seed)
    ks = iter(jax.random.split(key, 32))

    def nrm(shape, scale):
        return jax.random.normal(next(ks), shape, jnp.float32) * scale

    return {
        'x': nrm((BATCH, SEQ, D_MODEL), 1.0),
        'mix_norm_g': 1.0 + nrm((DEPTH, D_MODEL), 0.05),
        'w_in': nrm((DEPTH, D_MODEL, IN_W), D_MODEL ** -0.5),
        'pool_w_grp': nrm((DEPTH, POOL_GROUPS, POOL_GW, POOL_GW), POOL_GW ** -0.5),
        'pool_scale': 1.0 + nrm((DEPTH, POOL_W), 0.05),
        'ml_conv_w': nrm((DEPTH, CONV_W, 2 * ML_W), CONV_W ** -0.5),
        'ml_b_i': nrm((DEPTH, ML_HEADS), 0.1),
        'ml_b_f': 3.0 + nrm((DEPTH, ML_HEADS), 0.5),
        'ml_norm_g': 1.0 + nrm((DEPTH, ML_W), 0.05),
        'fox_b_f': 3.0 + nrm((DEPTH, FOX_HEADS), 0.5),
        'w_br_pool': nrm((DEPTH, POOL_W, D_MODEL), POOL_W ** -0.5),
        'w_br_ml': nrm((DEPTH, ML_W, D_MODEL), ML_W ** -0.5),
        'w_br_fox': nrm((DEPTH, FOX_W, D_MODEL), FOX_W ** -0.5),
        'w_out': nrm((DEPTH, D_MODEL, D_MODEL), D_MODEL ** -0.5),
        'ffn_norm_g': 1.0 + nrm((DEPTH, D_MODEL), 0.05),
        'ff_w_gate': nrm((N_DENSE, D_MODEL, D_FF), D_MODEL ** -0.5),
        'ff_w_up': nrm((N_DENSE, D_MODEL, D_FF), D_MODEL ** -0.5),
        'ff_w_down': nrm((N_DENSE, D_FF, D_MODEL), D_FF ** -0.5),
        'moe_w_router': nrm((N_MOE, D_MODEL, N_EXPERTS), D_MODEL ** -0.5),
        'moe_b_router': nrm((N_MOE, N_EXPERTS), 0.01),
        'moe_w_gate': nrm((N_MOE, N_EXPERTS, D_MODEL, D_FF_EXPERT), D_MODEL ** -0.5),
        'moe_w_up': nrm((N_MOE, N_EXPERTS, D_MODEL, D_FF_EXPERT), D_MODEL ** -0.5),
        'moe_w_down': nrm((N_MOE, N_EXPERTS, D_FF_EXPERT, D_MODEL), D_FF_EXPERT ** -0.5),
        'final_norm_g': 1.0 + nrm((D_MODEL,), 0.05),
    }


def reference(x, mix_norm_g, w_in, pool_w_grp, pool_scale, ml_conv_w, ml_b_i, ml_b_f, ml_norm_g, fox_b_f,
              w_br_pool, w_br_ml, w_br_fox, w_out, ffn_norm_g, ff_w_gate, ff_w_up, ff_w_down,
              moe_w_router, moe_b_router, moe_w_gate, moe_w_up, moe_w_down, final_norm_g):
    for l in range(DEPTH):
        x = x + token_mixing(x, mix_norm_g[l], w_in[l], pool_w_grp[l], pool_scale[l], ml_conv_w[l],
                             ml_b_i[l], ml_b_f[l], ml_norm_g[l], fox_b_f[l], w_br_pool[l], w_br_ml[l],
                             w_br_fox[l], w_out[l])
        h = rmsnorm(x, ffn_norm_g[l])
        if l % 2 == 0:
            x = x + swiglu(h, ff_w_gate[l // 2], ff_w_up[l // 2], ff_w_down[l // 2])
        else:
            x = x + moe_swiglu(h, moe_w_router[l // 2], moe_b_router[l // 2], moe_w_gate[l // 2],
                               moe_w_up[l // 2], moe_w_down[l // 2])
    return rmsnorm(x, final_norm_g)
```

```cpp
#include <hip/hip_runtime.h>
#include <cstdio>
#include <cstdint>
namespace pg8 {
#define PG8_LAS __attribute__((address_space(3)))
typedef unsigned short bf16_t;
typedef short bf16x8 __attribute__((ext_vector_type(8)));
typedef float f32x4 __attribute__((ext_vector_type(4)));
typedef unsigned u32x4 __attribute__((ext_vector_type(4)));
constexpr int BM = 256, BK = 64, HALF = 128, HTB = HALF * BK * 2  , STAGE_BYTES = 8 * HTB, NXCD = 8, WGM = 8;

__host__ __device__ __forceinline__ int lds_byte(int r, int c) { const int st = (r >> 4) * 2 + (c >> 5), rr = r & 15, cc = c & 31, ob = rr * 64 + cc * 2; return st * 1024 + (ob ^ (((ob >> 9) & 1) << 5)); }
__host__ __device__ __forceinline__ void stage_rc(int b, int& R, int& C) { const int st = b / 1024, sb = b % 1024, swz = sb ^ (((sb >> 9) & 1) << 5); R = (st >> 1) * 16 + swz / 64; C = (st & 1) * 32 + (swz % 64) / 2; }
__host__ __device__ __forceinline__ int perm32(int rho) { const int n = rho >> 4, i = rho & 15; return 8 * (i >> 2) + 4 * n + (i & 3); }

struct Unit { int pm, pn, pb; };
struct Gemm { const bf16_t* A; const bf16_t* Bt; int M, N, K; };

struct StaticOrder {
    int nM, nN, nwg, G, c;
    __host__ __device__ void init(int M, int N, int G_, int c_) { nM = M / BM; nN = N / BM; nwg = nM * nN; G = G_; c = c_; }
    __host__ __device__ bool next(int i, Unit& u) const {
        const long L = (long)i * G + c; if (L >= nwg) return false;
        int wgid = (int)L; { const int q = nwg / NXCD, r = nwg % NXCD, xcd = wgid % NXCD, off = wgid / NXCD; wgid = (xcd < r ? xcd * (q + 1) : r * (q + 1) + (xcd - r) * q) + off; }
        const int nig = WGM * nN, gid = wgid / nig, fm = gid * WGM, gsz = (nM - fm) < WGM ? (nM - fm) : WGM;
        u.pm = fm + ((wgid % nig) % gsz); u.pn = (wgid % nig) / gsz; u.pb = u.pn; return true;
    }
    __device__ __forceinline__ void a_ready(const Unit&) const {}
    __device__ __forceinline__ void done(const Unit&) const {}
};

__device__ __forceinline__ unsigned cvt_pk_bf16(float lo, float hi) { unsigned r; asm volatile("v_cvt_pk_bf16_f32 %0, %1, %2" : "=v"(r) : "v"(lo), "v"(hi)); return r; }
__device__ __forceinline__ float sigm(float x) { return __builtin_amdgcn_rcpf(1.f + __builtin_amdgcn_exp2f(-1.4426950408889634f * x)); }
__device__ __forceinline__ float bf_lo(unsigned w) { return __uint_as_float(w << 16); }
__device__ __forceinline__ float bf_hi(unsigned w) { return __uint_as_float(w & 0xffff0000u); }

struct EpiSlab {
    static constexpr bool PERM = true, AFTER_DRAIN = false, HOOK = false;
    bf16_t* O; size_t slab_stride; int qslab; float qscale;
    __device__ __forceinline__ void operator()(const f32x4 (&acc)[2][2][4][2], const Unit& u, int wr, int wc, int fr, int fq) const {
        const int slab = u.pn >> 1; bf16_t* base = O + (size_t)slab * slab_stride; const float sc = (slab == qslab) ? qscale : 1.f;
        const int row0 = u.pm * BM + wr * 64 + fr, col0 = (u.pn & 1) * 256 + wc * 32 + 8 * fq;
#pragma unroll
        for (int ai = 0; ai < 2; ++ai)
#pragma unroll
            for (int m = 0; m < 4; ++m) { bf16_t* rowp = base + (size_t)(row0 + ai * HALF + m * 16) * 512 + col0;
#pragma unroll
                for (int bj = 0; bj < 2; ++bj) { const f32x4 v0 = acc[ai][bj][m][0] * sc, v1 = acc[ai][bj][m][1] * sc;
                    u32x4 w; w.x = cvt_pk_bf16(v0[0], v0[1]); w.y = cvt_pk_bf16(v0[2], v0[3]); w.z = cvt_pk_bf16(v1[0], v1[1]); w.w = cvt_pk_bf16(v1[2], v1[3]);
                    *(u32x4*)(rowp + bj * HALF) = w; } }
    }
};
struct EpiSig {
    static constexpr bool PERM = true, AFTER_DRAIN = false, HOOK = false;
    bf16_t* O; size_t br_stride;
    __device__ __forceinline__ void operator()(const f32x4 (&acc)[2][2][4][2], const Unit& u, int wr, int wc, int fr, int fq) const {
        bf16_t* base = O + (size_t)(u.pn >> 2) * br_stride;
        const int row0 = u.pm * BM + wr * 64 + fr, col0 = (u.pn & 3) * 256 + wc * 32 + 8 * fq;
#pragma unroll
        for (int ai = 0; ai < 2; ++ai)
#pragma unroll
            for (int m = 0; m < 4; ++m) { bf16_t* rowp = base + (size_t)(row0 + ai * HALF + m * 16) * 1024 + col0;
#pragma unroll
                for (int bj = 0; bj < 2; ++bj) { f32x4 v0 = acc[ai][bj][m][0], v1 = acc[ai][bj][m][1];
#pragma unroll
                    for (int j = 0; j < 4; ++j) { v0[j] = __builtin_fmaxf(sigm(v0[j]), 1e-30f); v1[j] = __builtin_fmaxf(sigm(v1[j]), 1e-30f); }
                    u32x4 w; w.x = cvt_pk_bf16(v0[0], v0[1]); w.y = cvt_pk_bf16(v0[2], v0[3]); w.z = cvt_pk_bf16(v1[0], v1[1]); w.w = cvt_pk_bf16(v1[2], v1[3]);
                    *(u32x4*)(rowp + bj * HALF) = w; } }
    }
};
struct EpiMerge {
    static constexpr bool PERM = true, AFTER_DRAIN = false, HOOK = true;
    const bf16_t* G; size_t gstride; bf16_t* O;
    __device__ __forceinline__ void hook(f32x4 (&acc)[2][2][4][2], const Unit& u, int t, int wr, int wc, int fr, int fq) const {
        const int i = (t >> 3) - 1; const bf16_t* Ga = G + (size_t)i * gstride; const bf16_t* Gb = Ga + gstride;
        int row0 = u.pm * BM + wr * 64 + fr; const int col0 = u.pn * BM + wc * 32 + 8 * fq;
        asm volatile("" : "+v"(row0));
#pragma unroll
        for (int ai = 0; ai < 2; ++ai)
#pragma unroll
            for (int m = 0; m < 4; ++m) { const size_t off = (size_t)(row0 + ai * HALF + m * 16) * 1024 + col0;
#pragma unroll
                for (int bj = 0; bj < 2; ++bj) { const u32x4 a = *(const u32x4*)(Ga + off + bj * HALF), b = *(const u32x4*)(Gb + off + bj * HALF);
                    f32x4 r0, r1;
                    r0[0] = bf_lo(a.x) * __builtin_amdgcn_rcpf(bf_lo(b.x)); r0[1] = bf_hi(a.x) * __builtin_amdgcn_rcpf(bf_hi(b.x));
                    r0[2] = bf_lo(a.y) * __builtin_amdgcn_rcpf(bf_lo(b.y)); r0[3] = bf_hi(a.y) * __builtin_amdgcn_rcpf(bf_hi(b.y));
                    r1[0] = bf_lo(a.z) * __builtin_amdgcn_rcpf(bf_lo(b.z)); r1[1] = bf_hi(a.z) * __builtin_amdgcn_rcpf(bf_hi(b.z));
                    r1[2] = bf_lo(a.w) * __builtin_amdgcn_rcpf(bf_lo(b.w)); r1[3] = bf_hi(a.w) * __builtin_amdgcn_rcpf(bf_hi(b.w));
                    acc[ai][bj][m][0] *= r0; acc[ai][bj][m][1] *= r1; }
                asm volatile("" : "+v"(acc[ai][0][m][0]), "+v"(acc[ai][0][m][1]), "+v"(acc[ai][1][m][0]), "+v"(acc[ai][1][m][1]) :: "memory"); }
    }
    __device__ __forceinline__ void operator()(const f32x4 (&acc)[2][2][4][2], const Unit& u, int wr, int wc, int fr, int fq) const {
        const bf16_t* Gc = G + 2 * gstride;
        const int row0 = u.pm * BM + wr * 64 + fr, col0 = u.pn * BM + wc * 32 + 8 * fq;
#pragma unroll
        for (int ai = 0; ai < 2; ++ai)
#pragma unroll
            for (int m = 0; m < 4; ++m) { const size_t off = (size_t)(row0 + ai * HALF + m * 16) * 1024 + col0;
#pragma unroll
                for (int bj = 0; bj < 2; ++bj) { const u32x4 g = *(const u32x4*)(Gc + off + bj * HALF); const f32x4 v0 = acc[ai][bj][m][0], v1 = acc[ai][bj][m][1];
                    u32x4 w; w.x = cvt_pk_bf16(v0[0] * bf_lo(g.x), v0[1] * bf_hi(g.x)); w.y = cvt_pk_bf16(v0[2] * bf_lo(g.y), v0[3] * bf_hi(g.y));
                    w.z = cvt_pk_bf16(v1[0] * bf_lo(g.z), v1[1] * bf_hi(g.z)); w.w = cvt_pk_bf16(v1[2] * bf_lo(g.w), v1[3] * bf_hi(g.w));
                    *(u32x4*)(O + off + bj * HALF) = w; }
                if (m & 1) asm volatile("" ::: "memory"); }
    }
};
struct EpiRes {
    static constexpr bool PERM = false, AFTER_DRAIN = false, HOOK = false;
    const float* base; float* out; int ldc;
    __device__ __forceinline__ void operator()(const f32x4 (&acc)[2][2][4][2], const Unit& u, int wr, int wc, int fr, int fq) const {
        const int row0 = u.pm * BM + wr * 64 + fr, col0 = u.pn * BM + wc * 32 + 4 * fq;
#pragma unroll
        for (int ai = 0; ai < 2; ++ai)
#pragma unroll
            for (int m = 0; m < 4; ++m) { const size_t off = (size_t)(row0 + ai * HALF + m * 16) * ldc + col0;
#pragma unroll
                for (int bj = 0; bj < 2; ++bj)
#pragma unroll
                    for (int n = 0; n < 2; ++n) { const f32x4 bs = *(const f32x4*)(base + off + bj * HALF + n * 16); *(f32x4*)(out + off + bj * HALF + n * 16) = bs + acc[ai][bj][m][n]; }
                if (m & 1) asm volatile("" ::: "memory"); }
    }
};
struct EpiSwiGLU {
    static constexpr bool PERM = true, AFTER_DRAIN = false, HOOK = false;
    bf16_t* O; int ldc;
    __device__ __forceinline__ void operator()(const f32x4 (&acc)[2][2][4][2], const Unit& u, int wr, int wc, int fr, int fq) const {
        const int row0 = u.pm * BM + wr * 64 + fr, col0 = u.pn * HALF + wc * 32 + 8 * fq;
#pragma unroll
        for (int ai = 0; ai < 2; ++ai)
#pragma unroll
            for (int m = 0; m < 4; ++m) { f32x4 v0, v1;
#pragma unroll
                for (int j = 0; j < 4; ++j) { const float g0 = acc[ai][0][m][0][j], g1 = acc[ai][0][m][1][j]; v0[j] = g0 * sigm(g0) * acc[ai][1][m][0][j]; v1[j] = g1 * sigm(g1) * acc[ai][1][m][1][j]; }
                u32x4 w; w.x = cvt_pk_bf16(v0[0], v0[1]); w.y = cvt_pk_bf16(v0[2], v0[3]); w.z = cvt_pk_bf16(v1[0], v1[1]); w.w = cvt_pk_bf16(v1[2], v1[3]);
                *(u32x4*)(O + (size_t)(row0 + ai * HALF + m * 16) * ldc + col0) = w; }
    }
};
struct EpiMoeDown {
    static constexpr bool PERM = false, AFTER_DRAIN = false, HOOK = false;
    float* X; const int* row_tok; const float* row_g;
    __device__ __forceinline__ void operator()(const f32x4 (&acc)[2][2][4][2], const Unit& u, int wr, int wc, int fr, int fq) const {
        const int row0 = u.pm * BM + wr * 64 + fr, col0 = u.pn * BM + wc * 32 + 4 * fq;
#pragma unroll
        for (int ai = 0; ai < 2; ++ai)
#pragma unroll
            for (int m = 0; m < 4; ++m) { const int r = row0 + ai * HALF + m * 16; const int tok = row_tok[r]; const float g = row_g[r];
                if (tok >= 0) { float* p = X + (size_t)tok * 1024 + col0;
#pragma unroll
                    for (int bj = 0; bj < 2; ++bj)
#pragma unroll
                        for (int n = 0; n < 2; ++n) { const f32x4 bs = *(const f32x4*)(p + bj * HALF + n * 16); *(f32x4*)(p + bj * HALF + n * 16) = bs + acc[ai][bj][m][n] * g; } }
                if (m & 1) asm volatile("" ::: "memory"); }
    }
};
struct MoeOrder {
    int nM, nN, nwg, G, c; const int* tile_e;
    __device__ void init(int nM_, int nN_, int G_, int c_, const int* te) { nM = nM_; nN = nN_; nwg = nM * nN; G = G_; c = c_; tile_e = te; }
    __device__ bool next(int i, Unit& u) const {
        const long L = (long)i * G + c; if (L >= nwg) return false;
        int wgid = (int)L; { const int q = nwg / NXCD, r = nwg % NXCD, xcd = wgid % NXCD, off = wgid / NXCD; wgid = (xcd < r ? xcd * (q + 1) : r * (q + 1) + (xcd - r) * q) + off; }
        const int nig = WGM * nN, gid = wgid / nig, fm = gid * WGM, gsz = (nM - fm) < WGM ? (nM - fm) : WGM;
        u.pm = fm + ((wgid % nig) % gsz); u.pn = (wgid % nig) / gsz;
        const int e = __builtin_amdgcn_readfirstlane(__hip_atomic_load(tile_e + u.pm, __ATOMIC_RELAXED, __HIP_MEMORY_SCOPE_AGENT)); u.pb = e * nN + u.pn; return true;
    }
    __device__ __forceinline__ void a_ready(const Unit&) const {}
    __device__ __forceinline__ void done(const Unit&) const {}
};
template <class Epi, class Sched, bool ALIGN_EPI = false, bool SP2 = false>
__device__ __forceinline__ void gemm_phase(PG8_LAS unsigned char* lds, const Gemm g, const Sched& S, const Epi& E) {
    int tid_ = threadIdx.x; asm volatile("" : "+v"(tid_));
    const int tid = tid_, wid = __builtin_amdgcn_readfirstlane(tid >> 6), lane = tid & 63, wr = wid >> 2, wc = wid & 3, fr = lane & 15, fq = lane >> 4;
    const int K = g.K, nt = K / BK;
    unsigned voffA[2], voffB[2];
#pragma unroll
    for (int i = 0; i < 2; ++i) { int R, C; stage_rc(tid * 16 + i * 8192, R, C); const int Rb = Epi::PERM ? ((R & ~31) + perm32(R & 31)) : R;
        voffA[i] = (unsigned)(R * K + C) * 2u; voffB[i] = (unsigned)(Rb * K + C) * 2u; }
    const size_t kstep = (size_t)(BK * 2);
    const size_t hstep = (size_t)HALF * K * 2;
    const size_t tstep = 2 * hstep;
    const unsigned ldsw = (unsigned)wid * 1024u;
    const int aoff = lds_byte(wr * 64 + fr, fq * 8), boff = lds_byte(wc * 32 + fr, fq * 8);
#define PG8_SA(b, h) (((b) * 2 + (h)) * HTB)
#define PG8_SB(b, h) ((4 + (b) * 2 + (h)) * HTB)
#define PG8_STAGE(bufoff, gbase, voff) do { _Pragma("unroll") for (int _i = 0; _i < 2; ++_i) \
        __builtin_amdgcn_global_load_lds((const unsigned*)((const char*)(gbase) + (voff)[_i]), (PG8_LAS unsigned*)(lds + (bufoff) + ldsw + _i * 8192), 16, 0, 0); } while (0)
#define PG8_LDA(dst, b, h) do { _Pragma("unroll") for (int m = 0; m < 4; ++m) _Pragma("unroll") for (int k = 0; k < 2; ++k) dst[m][k] = *(const PG8_LAS bf16x8*)(lds + PG8_SA(b, h) + aoff + m * 2048 + k * 1024); } while (0)
#define PG8_LDB(dst, b, h) do { _Pragma("unroll") for (int n = 0; n < 2; ++n) _Pragma("unroll") for (int k = 0; k < 2; ++k) dst[n][k] = *(const PG8_LAS bf16x8*)(lds + PG8_SB(b, h) + boff + n * 2048 + k * 1024); } while (0)
#define PG8_MMA(ai, bj, At, Bt) do { __builtin_amdgcn_s_setprio(1); _Pragma("unroll") for (int m = 0; m < 4; ++m) _Pragma("unroll") for (int n = 0; n < 2; ++n) _Pragma("unroll") for (int k = 0; k < 2; ++k) \
        acc[ai][bj][m][n] = __builtin_amdgcn_mfma_f32_16x16x32_bf16(Bt[n][k], At[m][k], acc[ai][bj][m][n], 0, 0, 0); __builtin_amdgcn_s_setprio(0); } while (0)
#define PG8_WAIT_V(n) asm volatile("s_waitcnt vmcnt(" #n ")" ::: "memory")
#define PG8_WAIT_L(n) asm volatile("s_waitcnt lgkmcnt(" #n ")" ::: "memory")
#define PG8_BAR __builtin_amdgcn_s_barrier()
#define PG8_SCHED __builtin_amdgcn_sched_barrier(0)
    Unit cur, nxt; int ui = 0;
    if (!S.next(0, cur)) return;
    f32x4 acc[2][2][4][2];
#pragma unroll
    for (int a = 0; a < 2; ++a)
#pragma unroll
        for (int b = 0; b < 2; ++b)
#pragma unroll
            for (int m = 0; m < 4; ++m)
#pragma unroll
                for (int n = 0; n < 2; ++n) acc[a][b][m][n] = (f32x4){0.f, 0.f, 0.f, 0.f};
    bf16x8 At[4][2], B0[2][2], B1[2][2];
    const char* cA = (const char*)g.A + (size_t)cur.pm * tstep; const char* cB = (const char*)g.Bt + (size_t)cur.pb * tstep;
    S.a_ready(cur);
    if constexpr (SP2) {
        PG8_STAGE(PG8_SB(0, 0), cB, voffB); PG8_STAGE(PG8_SB(0, 1), cB + hstep, voffB); PG8_STAGE(PG8_SA(0, 0), cA, voffA); PG8_STAGE(PG8_SA(0, 1), cA + hstep, voffA);
        if (wr == 1) PG8_BAR;
        PG8_WAIT_V(2); PG8_BAR;
        PG8_STAGE(PG8_SB(1, 0), cB + kstep, voffB); PG8_STAGE(PG8_SA(1, 0), cA + kstep, voffA); PG8_STAGE(PG8_SB(1, 1), cB + hstep + kstep, voffB);
        PG8_WAIT_V(6); PG8_BAR;
    } else {
        PG8_STAGE(PG8_SB(0, 0), cB, voffB); PG8_STAGE(PG8_SA(0, 0), cA, voffA); PG8_STAGE(PG8_SB(0, 1), cB + hstep, voffB); PG8_STAGE(PG8_SA(0, 1), cA + hstep, voffA);
        if (wr == 1) PG8_BAR;
        PG8_WAIT_V(4); PG8_BAR;
        PG8_STAGE(PG8_SB(1, 0), cB + kstep, voffB); PG8_STAGE(PG8_SA(1, 0), cA + kstep, voffA); PG8_STAGE(PG8_SB(1, 1), cB + hstep + kstep, voffB);
        PG8_WAIT_V(6); PG8_BAR;
    }
    for (;;) {
        const bool has_next = S.next(ui + 1, nxt);
        const char* nA = has_next ? (const char*)g.A + (size_t)nxt.pm * tstep : cA; const char* nB = has_next ? (const char*)g.Bt + (size_t)nxt.pb * tstep : cB;
        for (int t = 0; t < nt; t += 2) {
            if constexpr (Epi::HOOK) { if (t == 8 || t == 16) E.hook(acc, cur, t, wr, wc, fr, fq); }
            const bool last = (t == nt - 2);
            const char* a1 = cA + (size_t)(t + 1) * kstep;
            const char* a2 = last ? nA : cA + (size_t)(t + 2) * kstep; const char* b2 = last ? nB : cB + (size_t)(t + 2) * kstep;
            const char* a3 = a2 + kstep; const char* b3 = b2 + kstep;
            if (last && has_next) S.a_ready(nxt);
            if constexpr (SP2) {
            PG8_LDB(B0, 0, 0); PG8_LDB(B1, 0, 1); PG8_SCHED; PG8_LDA(At, 0, 0); PG8_STAGE(PG8_SA(1, 1), a1 + hstep, voffA);
            PG8_WAIT_V(8); PG8_WAIT_L(0); PG8_BAR; PG8_MMA(0, 0, At, B0); PG8_MMA(0, 1, At, B1); PG8_BAR; PG8_SCHED;
            PG8_LDA(At, 0, 1); PG8_STAGE(PG8_SB(0, 0), b2, voffB); PG8_STAGE(PG8_SB(0, 1), b2 + hstep, voffB); PG8_STAGE(PG8_SA(0, 0), a2, voffA);
            PG8_WAIT_V(8); PG8_WAIT_L(0); PG8_BAR; PG8_MMA(1, 0, At, B0); PG8_MMA(1, 1, At, B1); PG8_BAR; PG8_SCHED;
            PG8_LDB(B0, 1, 0); PG8_LDB(B1, 1, 1); PG8_SCHED; PG8_LDA(At, 1, 0); PG8_STAGE(PG8_SA(0, 1), a2 + hstep, voffA);
            PG8_WAIT_V(8); PG8_WAIT_L(0); PG8_BAR; PG8_MMA(0, 0, At, B0); PG8_MMA(0, 1, At, B1); PG8_BAR; PG8_SCHED;
            PG8_LDA(At, 1, 1); PG8_STAGE(PG8_SB(1, 0), b3, voffB); PG8_STAGE(PG8_SB(1, 1), b3 + hstep, voffB); PG8_STAGE(PG8_SA(1, 0), a3, voffA);
            PG8_WAIT_V(8); PG8_WAIT_L(0); PG8_BAR; PG8_MMA(1, 0, At, B0); PG8_MMA(1, 1, At, B1); PG8_BAR; PG8_SCHED;
            } else {
            PG8_LDB(B0, 0, 0); PG8_SCHED; PG8_LDA(At, 0, 0); PG8_STAGE(PG8_SA(1, 1), a1 + hstep, voffA);
            PG8_WAIT_L(8); PG8_BAR; PG8_WAIT_L(0); PG8_MMA(0, 0, At, B0); PG8_BAR; PG8_SCHED;
            PG8_LDB(B1, 0, 1); PG8_STAGE(PG8_SB(0, 0), b2, voffB);
            PG8_BAR; PG8_WAIT_L(0); PG8_MMA(0, 1, At, B1); PG8_BAR;
            PG8_LDA(At, 0, 1); PG8_STAGE(PG8_SA(0, 0), a2, voffA);
            PG8_BAR; PG8_WAIT_L(0); PG8_MMA(1, 0, At, B0); PG8_BAR; PG8_SCHED;
            PG8_STAGE(PG8_SB(0, 1), b2 + hstep, voffB);
            PG8_WAIT_V(6); PG8_BAR; PG8_MMA(1, 1, At, B1); PG8_BAR;
            PG8_LDB(B0, 1, 0); PG8_SCHED; PG8_LDA(At, 1, 0); PG8_STAGE(PG8_SA(0, 1), a2 + hstep, voffA);
            PG8_WAIT_L(8); PG8_BAR; PG8_WAIT_L(0); PG8_MMA(0, 0, At, B0); PG8_BAR; PG8_SCHED;
            PG8_LDB(B1, 1, 1); PG8_STAGE(PG8_SB(1, 0), b3, voffB);
            PG8_BAR; PG8_WAIT_L(0); PG8_MMA(0, 1, At, B1); PG8_BAR;
            PG8_LDA(At, 1, 1); PG8_STAGE(PG8_SA(1, 0), a3, voffA);
            PG8_BAR; PG8_WAIT_L(0); PG8_MMA(1, 0, At, B0); PG8_BAR; PG8_SCHED;
            PG8_STAGE(PG8_SB(1, 1), b3 + hstep, voffB);
            PG8_WAIT_V(6); PG8_BAR; PG8_MMA(1, 1, At, B1); PG8_BAR;
            }
        }
        if constexpr (ALIGN_EPI) { if (wr == 0) PG8_BAR; }
        if constexpr (!Epi::AFTER_DRAIN) { E(acc, cur, wr, wc, fr, fq); S.done(cur); }
        if (!has_next) break;
#pragma unroll
        for (int a = 0; a < 2; ++a)
#pragma unroll
            for (int b = 0; b < 2; ++b)
#pragma unroll
                for (int m = 0; m < 4; ++m)
#pragma unroll
                    for (int n = 0; n < 2; ++n) acc[a][b][m][n] = (f32x4){0.f, 0.f, 0.f, 0.f};
        cur = nxt; cA = nA; cB = nB; ++ui;
        if constexpr (ALIGN_EPI) { if (wr == 1) PG8_BAR; }
    }
    PG8_WAIT_V(0);
    if constexpr (!ALIGN_EPI) { if (wr == 0) PG8_BAR; }
    PG8_BAR;
    if constexpr (Epi::AFTER_DRAIN) { E.fused(acc, cur, wr, wc, fr, fq, lds, wid, lane); S.done(cur); }
#undef PG8_SA
#undef PG8_SB
#undef PG8_STAGE
#undef PG8_LDA
#undef PG8_LDB
#undef PG8_MMA
#undef PG8_WAIT_V
#undef PG8_WAIT_L
#undef PG8_BAR
#undef PG8_SCHED
}
}
#include <hip/hip_bf16.h>
#include <cmath>
namespace attn_body {
using bf16=__hip_bfloat16;
using bf16x8=__attribute__((ext_vector_type(8)))short;
using s16x4=__attribute__((ext_vector_type(4)))short;
using f32x16=__attribute__((ext_vector_type(16)))float;
using u32x4=__attribute__((ext_vector_type(4)))unsigned;
constexpr int BATCH=4,NHEAD=8,SEQ=8192,D=64,DM=NHEAD*D,DMO=1536,OCOL=1024;
constexpr int NW=8,QBLK=32,QB=QBLK*NW,KVBLK=64,NQB=SEQ/QB;
constexpr int ATTN_PITCH=DM, ATTN_UNIT_ROWS=QB;
__device__ __forceinline__ int crow(int r,int hi){return (r&3)+8*(r>>2)+4*hi;}
#define SBAR() __builtin_amdgcn_sched_barrier(0)
__device__ __forceinline__ void cmask(f32x16&p0,f32x16&p1,int jb,int qrel,int hi){
  const float NEG=-INFINITY; int kb=64*jb+4*hi;
  #pragma unroll
  for(int r=0;r<16;++r){int kv=kb+(r&3)+8*(r>>2); if(kv>qrel)p0[r]=NEG; if(kv+32>qrel)p1[r]=NEG;}
}

constexpr int NSLOT=3, SLOTB=8192;
constexpr int LDS_K=0, LDS_V=NSLOT*SLOTB, LDS_WS=2*NSLOT*SLOTB, LDS_OST=LDS_WS+NW*64*4, LDS_NB=LDS_OST+NW*4096, LDS_BYTES=LDS_NB+SEQ*4;
constexpr float C2=0.125f*1.4426950408889634f;
__device__ __forceinline__ void glds16(const void*gsrc,unsigned lds_dst){unsigned keep;
  asm volatile("s_mov_b32 %0, m0\n\ts_mov_b32 m0, %2\n\ts_nop 0\n\tglobal_load_lds_dwordx4 %1, off\n\ts_mov_b32 m0, %0":"=&s"(keep):"v"(gsrc),"s"(lds_dst):"memory");}
__device__ __forceinline__ float max3f(float a,float b,float c){float r;asm("v_max3_f32 %0, %1, %2, %3":"=v"(r):"v"(a),"v"(b),"v"(c));return r;}
__device__ __forceinline__ float max2f(float a,float b){float r;asm("v_max_f32_e32 %0, %1, %2":"=v"(r):"v"(a),"v"(b));return r;}
__device__ __forceinline__ float fadd_s(float a,float b){float r;asm("v_add_f32_e32 %0, %1, %2":"=v"(r):"v"(a),"v"(b));return r;}
__device__ __forceinline__ float fsub_s(float a,float b){float r;asm("v_sub_f32_e32 %0, %1, %2":"=v"(r):"v"(a),"v"(b));return r;}
typedef float f32x2_t __attribute__((ext_vector_type(2))); typedef __bf16 bf16x2_t __attribute__((ext_vector_type(2)));
__device__ __forceinline__ unsigned cvtpk_s(float lo,float hi){f32x2_t v={lo,hi};bf16x2_t b=__builtin_convertvector(v,bf16x2_t);return __builtin_bit_cast(unsigned,b);}
#define WAIT_BAR(N) asm volatile("s_waitcnt vmcnt(" #N ") lgkmcnt(0)\n\ts_barrier":::"memory")

__device__ __forceinline__ void qkt(f32x16&p0,f32x16&p1,const char*Kslot,const bf16x8*qr,int r32,int hi){
  const char*kb=Kslot+hi*1024+r32*16;
  #pragma unroll
  for(int d0=0;d0<4;++d0){
    const bf16x8 b0=*reinterpret_cast<const bf16x8*>(kb+d0*2048);
    const bf16x8 b1=*reinterpret_cast<const bf16x8*>(kb+d0*2048+512);
    p0=__builtin_amdgcn_mfma_f32_32x32x16_bf16(b0,qr[d0],p0,0,0,0);p1=__builtin_amdgcn_mfma_f32_32x32x16_bf16(b1,qr[d0],p1,0,0,0);}
}
typedef __attribute__((address_space(3))) const char* lds_cptr;
typedef short v4i16_t __attribute__((ext_vector_type(4)));
__device__ __forceinline__ void kload8(bf16x8*kf,lds_cptr kp){
  kf[0]=*(const __attribute__((address_space(3))) bf16x8*)(kp);      kf[1]=*(const __attribute__((address_space(3))) bf16x8*)(kp+512);
  kf[2]=*(const __attribute__((address_space(3))) bf16x8*)(kp+2048); kf[3]=*(const __attribute__((address_space(3))) bf16x8*)(kp+2560);
  kf[4]=*(const __attribute__((address_space(3))) bf16x8*)(kp+4096); kf[5]=*(const __attribute__((address_space(3))) bf16x8*)(kp+4608);
  kf[6]=*(const __attribute__((address_space(3))) bf16x8*)(kp+6144); kf[7]=*(const __attribute__((address_space(3))) bf16x8*)(kp+6656);
}
__device__ __forceinline__ void kload2(bf16x8*kf,lds_cptr kp,int j){ kf[2*j]=*(const __attribute__((address_space(3))) bf16x8*)(kp+j*2048); kf[2*j+1]=*(const __attribute__((address_space(3))) bf16x8*)(kp+j*2048+512); }
__device__ __forceinline__ s16x4 vtr(lds_cptr p){ return __builtin_bit_cast(s16x4,__builtin_amdgcn_ds_read_tr16_b64_v4i16((__attribute__((address_space(3))) v4i16_t*)p)); }
__device__ __forceinline__ float rowmax(const f32x16&p0,const f32x16&p1){
  float a=max3f(p0[0],p0[1],p1[0]),b=max3f(p0[2],p0[3],p1[1]);a=max3f(a,p1[2],p1[3]);
  #pragma unroll
  for(int r=4;r<16;r+=4){a=max3f(a,p0[r],p0[r+1]);b=max3f(b,p0[r+2],p0[r+3]);a=max3f(a,p1[r],p1[r+1]);b=max3f(b,p1[r+2],p1[r+3]);}
  const float m=max2f(a,b);
  auto rr=__builtin_amdgcn_permlane32_swap(__float_as_uint(m),__float_as_uint(m),false,false);
  return max2f(__uint_as_float(rr[0]),__uint_as_float(rr[1]));
}
__device__ __forceinline__ void pv(f32x16*o,int vb,bf16x8 pa0,bf16x8 pa1,bf16x8 pa2,bf16x8 pa3){
  #pragma unroll
  for(int d0=0;d0<2;++d0){s16x4 lo[4],hi[4];
    #pragma unroll
    for(int ks=0;ks<4;++ks){
      asm volatile("ds_read_b64_tr_b16 %0,%1 offset:%c2":"=&v"(lo[ks]):"v"(vb),"i"(d0*4096+ks*1024):"memory");
      asm volatile("ds_read_b64_tr_b16 %0,%1 offset:%c2":"=&v"(hi[ks]):"v"(vb),"i"(d0*4096+ks*1024+512):"memory");}
    asm volatile("s_waitcnt lgkmcnt(0)":::"memory");SBAR();
    #define PK(k) (bf16x8){lo[k][0],lo[k][1],lo[k][2],lo[k][3],hi[k][0],hi[k][1],hi[k][2],hi[k][3]}
    o[d0]=__builtin_amdgcn_mfma_f32_32x32x16_bf16(pa0,PK(0),o[d0],0,0,0);
    o[d0]=__builtin_amdgcn_mfma_f32_32x32x16_bf16(pa1,PK(1),o[d0],0,0,0);
    o[d0]=__builtin_amdgcn_mfma_f32_32x32x16_bf16(pa2,PK(2),o[d0],0,0,0);
    o[d0]=__builtin_amdgcn_mfma_f32_32x32x16_bf16(pa3,PK(3),o[d0],0,0,0);
    #undef PK
  }
}

#ifndef ATTN_STORE16
#define ATTN_STORE16(p,v) (*(u32x4*)(p)=(v))
#endif
typedef float f32x4v __attribute__((ext_vector_type(4)));
template<int THRL> __device__ __forceinline__ void attn_unit(int b,int h,int qb,const bf16*Q,const bf16*__restrict__ K,const bf16*__restrict__ V,bf16*O,const float*__restrict__ nbg,char*shm){
  int tid_=threadIdx.x; asm volatile("":"+v"(tid_));
  const int tid=tid_,lane=tid&63,r32=lane&31,hi=lane>>5; const int wid=__builtin_amdgcn_readfirstlane(tid>>6);
  const long rowbase=(long)b*SEQ; const int q0=qb*QB;
  const bf16*Qw=Q+(rowbase+q0+wid*QBLK)*DM+h*D;
  const bf16*Kh=K+rowbase*DM+h*D,*Vh=V+rowbase*DM+h*D;
  const unsigned lds0=(unsigned)(uintptr_t)shm;
  float*wsf=(float*)(shm+LDS_WS)+wid*64;
  const bf16*ksrc=Kh+(long)lane*DM+wid*8;
  const bf16*vsrc=Vh+(long)(16*(wid&3)+(lane>>2))*DM+(wid>>2)*32+(lane&3)*8;
  const unsigned kdst=lds0+LDS_K+wid*1024, vdst=lds0+LDS_V+wid*1024;
  #define DMA_K(t,slot) glds16(ksrc+(long)(t)*KVBLK*DM,(unsigned)__builtin_amdgcn_readfirstlane(kdst+(slot)))
  #define DMA_V(t,slot) glds16(vsrc+(long)(t)*KVBLK*DM,(unsigned)__builtin_amdgcn_readfirstlane(vdst+(slot)))
  const int vb0=(int)(lds0+LDS_V)+((lane>>4)&1)*32+(lane&3)*8+(4*hi+((lane&15)>>2))*64;
  const char*Kbase=shm+LDS_K; bf16x8 kf[8];
  const lds_cptr shm3=(lds_cptr)shm; const lds_cptr kp0=shm3+LDS_K+hi*1024+r32*16; const lds_cptr vp0=shm3+LDS_V+((lane>>4)&1)*32+(lane&3)*8+(4*hi+((lane&15)>>2))*64;
  const int NT=(q0+QB)/KVBLK;
  typedef __attribute__((address_space(3))) float* lds_fptr;
  const lds_fptr nbl3=(lds_fptr)(shm3+LDS_NB);
  { const float ref=nbg[q0+QB-1]; for(int j=tid;j<q0+QB;j+=NW*64) nbl3[j]=nbg[j]-ref; }
  DMA_K(0,0);DMA_V(0,0);DMA_K(1,SLOTB);
  bf16x8 qr[4];
  #pragma unroll
  for(int d0=0;d0<4;++d0)qr[d0]=*reinterpret_cast<const bf16x8*>(&Qw[(long)r32*DM+d0*16+hi*8]);
  float mhat=0.f,l_reg=0.f;f32x16 o[2];o[0]=f32x16{};o[1]=f32x16{};
  const int qrel=wid*QBLK+r32;
  #define CMASK(P0,P1,t) do{int jb_=(t)-(NT-4); if(jb_>=0)cmask(P0,P1,jb_,qrel,hi);}while(0)
  bool resc=false;
  #define START(P0,P1) do{ const float rm=rowmax(P0,P1); resc=false; \
    if(__any(rm>(float)THRL)){ const float dl=__builtin_fmaxf(rm,0.f); mhat=fadd_s(mhat,dl); \
      _Pragma("unroll") for(int r=0;r<16;++r){P0[r]=fsub_s(P0[r],dl);P1[r]=fsub_s(P1[r],dl);} } \
    _Pragma("unroll") for(int r=0;r<16;++r)P0[r]=__builtin_amdgcn_exp2f(P0[r]); }while(0)
  #define BIAS(P0,P1,t) do{ const lds_fptr nbp_=nbl3+64*(t)+4*hi; \
    _Pragma("unroll") for(int q_=0;q_<4;++q_){ const f32x4v b0_=*(const __attribute__((address_space(3))) f32x4v*)(nbp_+8*q_), b1_=*(const __attribute__((address_space(3))) f32x4v*)(nbp_+32+8*q_); \
      _Pragma("unroll") for(int i_=0;i_<4;++i_){ P0[4*q_+i_]=b0_[i_]-mhat; P1[4*q_+i_]=b1_[i_]-mhat; } } }while(0)
  #define RESC() do{ if(resc){ asm volatile("s_waitcnt lgkmcnt(0)":::"memory"); \
      _Pragma("unroll") for(int d_=0;d_<2;++d_) _Pragma("unroll") for(int r=0;r<16;++r)o[d_][r]*=wsf[crow(r,hi)]; } }while(0)
  f32x16 pA0,pA1,pB0,pB1;
  int sl_prev=0,sl_cur=0,sl_next=SLOTB;
  #define ROT() do{sl_prev=sl_cur;sl_cur=sl_next;sl_next=(sl_next==(NSLOT-1)*SLOTB)?0:sl_next+SLOTB;}while(0)
  DMA_K(2,2*SLOTB);
  WAIT_BAR(3);
  mhat=nbl3[q0+qrel];
  BIAS(pA0,pA1,0);qkt(pA0,pA1,Kbase,qr,r32,hi);asm volatile("s_nop 15\n\ts_nop 7":"+v"(pA0),"+v"(pA1));CMASK(pA0,pA1,0);
  START(pA0,pA1);
  _Pragma("unroll") for(int r=0;r<16;++r)pA1[r]=__builtin_amdgcn_exp2f(pA1[r]);
  WAIT_BAR(0);
  DMA_K(3,0);DMA_V(1,SLOTB);
  ROT();
  kload8(kf,kp0+sl_cur);
  WAIT_BAR(2);
  s16x4 vlo[8],vhi[8]; u32x4 pw0,pw1,pw2,pw3;
  #define PKW(P,B) cvtpk_s(P[B],P[B+1])
  #define PAF(k) __builtin_bit_cast(bf16x8,pw##k)
  #define VFR(i) (bf16x8){vlo[i][0],vlo[i][1],vlo[i][2],vlo[i][3],vhi[i][0],vhi[i][1],vhi[i][2],vhi[i][3]}
  #define PIN(x) asm volatile("":"+v"(x))
  #define MX3(a,b,c) __builtin_fmaxf(__builtin_fmaxf((a),(b)),(c))
  #define GAPA(MF,A0,A1,A2,A3,W0,W1,PW) do{ MF; sacc+=A0; sacc+=A1; sacc+=A2; sacc+=A3; PIN(sacc); W0; W1; PIN(PW); SBAR(); }while(0)
  #define EX(v) __builtin_amdgcn_exp2f(v)
  #define GAPB(MF,X,B) do{ MF; X[B]=EX(X[B]); X[B+1]=EX(X[B+1]); X[B+2]=EX(X[B+2]); X[B+3]=EX(X[B+3]); PIN(X); SBAR(); }while(0)
  #define VRD(i) do{ vlo[i]=vtr(vp_+(((i)>>2)*4096+((i)&3)*1024)); vhi[i]=vtr(vp_+(((i)>>2)*4096+((i)&3)*1024+512)); }while(0)
  #define KRD(G,j) do{ if(G){ kload2(kf,kp0+sl_next,j); SBAR(); } }while(0)
  #define STEP(C0,C1,P0,P1,t,GK,GV,GL) do{ SBAR(); \
    const lds_cptr vp_=vp0+sl_prev; \
    BIAS(C0,C1,t); SBAR(); \
    VRD(0); SBAR(); float sacc=(P0[0]+P0[1]); \
    GAPA(C0=__builtin_amdgcn_mfma_f32_32x32x16_bf16(kf[0],qr[0],C0,0,0,0), P0[2],P0[3],P0[4],P0[5],     pw0[0]=PKW(P0,0), pw0[1]=PKW(P0,2), pw0); \
    VRD(4); SBAR(); GAPA(C1=__builtin_amdgcn_mfma_f32_32x32x16_bf16(kf[1],qr[0],C1,0,0,0), P0[6],P0[7],P0[8],P0[9],     pw0[2]=PKW(P0,4), pw0[3]=PKW(P0,6), pw0); \
    VRD(1); SBAR(); GAPA(C0=__builtin_amdgcn_mfma_f32_32x32x16_bf16(kf[2],qr[1],C0,0,0,0),   P0[10],P0[11],P0[12],P0[13], pw1[0]=PKW(P0,8), pw1[1]=PKW(P0,10), pw1); \
    VRD(5); SBAR(); GAPA(C1=__builtin_amdgcn_mfma_f32_32x32x16_bf16(kf[3],qr[1],C1,0,0,0),   P0[14],P0[15],P1[0],P1[1],   pw1[2]=PKW(P0,12),pw1[3]=PKW(P0,14), pw1); \
    VRD(2); SBAR(); GAPA(C0=__builtin_amdgcn_mfma_f32_32x32x16_bf16(kf[4],qr[2],C0,0,0,0),   P1[2],P1[3],P1[4],P1[5],     pw2[0]=PKW(P1,0), pw2[1]=PKW(P1,2), pw2); \
    VRD(6); SBAR(); GAPA(C1=__builtin_amdgcn_mfma_f32_32x32x16_bf16(kf[5],qr[2],C1,0,0,0),   P1[6],P1[7],P1[8],P1[9],     pw2[2]=PKW(P1,4), pw2[3]=PKW(P1,6), pw2); \
    VRD(3); SBAR(); GAPA(C0=__builtin_amdgcn_mfma_f32_32x32x16_bf16(kf[6],qr[3],C0,0,0,0),   P1[10],P1[11],P1[12],P1[13], pw3[0]=PKW(P1,8), pw3[1]=PKW(P1,10), pw3); \
    VRD(7); SBAR(); GAPA(C1=__builtin_amdgcn_mfma_f32_32x32x16_bf16(kf[7],qr[3],C1,0,0,0),   P1[14],P1[15],0.f,0.f,       pw3[2]=PKW(P1,12),pw3[3]=PKW(P1,14), pw3); \
    l_reg+=sacc; \
    if(GK){DMA_K((t)+3,sl_cur);} if(GV){DMA_V((t)+1,sl_next);} \
    CMASK(C0,C1,t); \
    { float a=MX3(C0[0],C0[1],C1[0]),b=MX3(C0[2],C0[3],C1[1]); a=MX3(a,C1[2],C1[3]); \
      _Pragma("unroll") for(int r=4;r<16;r+=4){a=MX3(a,C0[r],C0[r+1]);b=MX3(b,C0[r+2],C0[r+3]);a=MX3(a,C1[r],C1[r+1]);b=MX3(b,C1[r+2],C1[r+3]);} \
      float rm=__builtin_fmaxf(a,b); { auto rr=__builtin_amdgcn_permlane32_swap(__float_as_uint(rm),__float_as_uint(rm),false,false); rm=__builtin_fmaxf(__uint_as_float(rr[0]),__uint_as_float(rr[1])); } \
      resc=false; \
      if(__builtin_expect(__any(rm>(float)THRL),0)){ const float dl=__builtin_fmaxf(rm,0.f); mhat+=dl; \
        _Pragma("unroll") for(int r=0;r<16;++r){C0[r]-=dl;C1[r]-=dl;} \
        const float f=__builtin_amdgcn_exp2f(-dl); l_reg*=f; if(hi==0)wsf[r32]=f; resc=true; } } \
    SBAR(); \
    GAPB(o[0]=__builtin_amdgcn_mfma_f32_32x32x16_bf16(PAF(0),VFR(0),o[0],0,0,0), C0,0); \
    GAPB(o[1]=__builtin_amdgcn_mfma_f32_32x32x16_bf16(PAF(0),VFR(4),o[1],0,0,0), C0,4); \
    KRD(GL,0); GAPB(o[0]=__builtin_amdgcn_mfma_f32_32x32x16_bf16(PAF(1),VFR(1),o[0],0,0,0), C0,8); \
    KRD(GL,1); GAPB(o[1]=__builtin_amdgcn_mfma_f32_32x32x16_bf16(PAF(1),VFR(5),o[1],0,0,0), C0,12); \
    KRD(GL,2); GAPB(o[0]=__builtin_amdgcn_mfma_f32_32x32x16_bf16(PAF(2),VFR(2),o[0],0,0,0), C1,0); \
    KRD(GL,3); GAPB(o[1]=__builtin_amdgcn_mfma_f32_32x32x16_bf16(PAF(2),VFR(6),o[1],0,0,0), C1,4); \
    GAPB(o[0]=__builtin_amdgcn_mfma_f32_32x32x16_bf16(PAF(3),VFR(3),o[0],0,0,0), C1,8); \
    GAPB(o[1]=__builtin_amdgcn_mfma_f32_32x32x16_bf16(PAF(3),VFR(7),o[1],0,0,0), C1,12); \
    }while(0)
  int t=1;
  #undef CMASK
  #define CMASK(P0,P1,t) do{}while(0)
  for(;t+5<NT;t+=2){
    STEP(pB0,pB1,pA0,pA1,t,true,true,true);     WAIT_BAR(2); RESC(); ROT();
    STEP(pA0,pA1,pB0,pB1,t+1,true,true,true);   WAIT_BAR(2); RESC(); ROT();
  }
  #undef CMASK
  #define CMASK(P0,P1,t) do{int jb_=(t)-(NT-4); if(jb_>=0)cmask(P0,P1,jb_,qrel,hi);}while(0)
  #define ENDW(tt) do{ if((tt)+3<NT){WAIT_BAR(2);} else if((tt)+2<NT){WAIT_BAR(1);} else {WAIT_BAR(0);} }while(0)
  for(;t+1<NT;t+=2){
    STEP(pB0,pB1,pA0,pA1,t,(t+3<NT),(t+1<NT),(t+1<NT));       ENDW(t);   RESC(); ROT();
    STEP(pA0,pA1,pB0,pB1,t+1,(t+4<NT),(t+2<NT),(t+2<NT));     ENDW(t+1); RESC(); ROT();
  }
  STEP(pB0,pB1,pA0,pA1,NT-1,false,false,false); RESC();
  { float sacc=pB0[0]+pB0[1]; _Pragma("unroll") for(int r=2;r<16;++r)sacc+=pB0[r]; _Pragma("unroll") for(int r=0;r<16;++r)sacc+=pB1[r]; l_reg+=sacc;
    pw0=(u32x4){PKW(pB0,0),PKW(pB0,2),PKW(pB0,4),PKW(pB0,6)};pw1=(u32x4){PKW(pB0,8),PKW(pB0,10),PKW(pB0,12),PKW(pB0,14)};pw2=(u32x4){PKW(pB1,0),PKW(pB1,2),PKW(pB1,4),PKW(pB1,6)};pw3=(u32x4){PKW(pB1,8),PKW(pB1,10),PKW(pB1,12),PKW(pB1,14)};
    SBAR(); pv(o,vb0+sl_cur,PAF(0),PAF(1),PAF(2),PAF(3)); }
  #undef PKW
  #undef PAF
  #undef VFR
  #undef PIN
  #undef MX3
  #undef GAPA
  #undef GAPB
  #undef EX
  #undef VRD
  #undef KRD
  #undef STEP
  #undef ENDW
  {auto rr=__builtin_amdgcn_permlane32_swap(__float_as_uint(l_reg),__float_as_uint(l_reg),false,false);l_reg=__uint_as_float(rr[0])+__uint_as_float(rr[1]);}
  if(hi==0)wsf[32+r32]=l_reg;asm volatile("s_waitcnt lgkmcnt(0)":::"memory");
  float rli[16];
  #pragma unroll
  for(int r=0;r<16;++r)rli[r]=__builtin_amdgcn_rcpf(wsf[32+crow(r,hi)]);
  bf16*Ow=O+(rowbase+q0+wid*QBLK)*DMO+OCOL+h*D;
  { bf16*stg=(bf16*)(shm+LDS_OST)+wid*2048;
    #pragma unroll
    for(int r=0;r<16;++r){const int orow=crow(r,hi);
      #pragma unroll
      for(int d0=0;d0<2;++d0)stg[orow*64+d0*32+r32]=__float2bfloat16(o[d0][r]*rli[r]);}
    asm volatile("s_waitcnt lgkmcnt(0)":::"memory");
    #pragma unroll
    for(int i=0;i<4;++i){const int row=i*8+(lane>>3),ch=lane&7; const u32x4 v=*(const u32x4*)(stg+row*64+ch*8); ATTN_STORE16(Ow+(long)row*DMO+ch*8,v);} }
  asm volatile("s_waitcnt lgkmcnt(0)\n\ts_barrier":::"memory");
  #undef DMA_K
  #undef DMA_V
  #undef CMASK
  #undef START
  #undef BIAS
  #undef RESC
  #undef ROT
}
constexpr int ATTN_LDS_BYTES=LDS_BYTES;
struct AttnTensors { const bf16* Q; const bf16* K; const bf16* V; bf16* O; const float* nb; };
struct AttnUnit { int bh; int qb; };
struct StaticOrder {
  int vcu,G;
  __device__ __forceinline__ explicit StaticOrder(int grid,int block):vcu((grid%8==0)?(block%8)*(grid/8)+block/8:block),G(grid){}
  __device__ __forceinline__ bool next(int i,AttnUnit&u)const{ const int w=vcu+(i>>2)*G; if(w>=BATCH*NHEAD*8)return false; const int s=w&7,j=i&3; u.bh=w>>3; u.qb=(j==0)?s:(j==1)?15-s:(j==2)?16+s:31-s; return true; }
  __device__ __forceinline__ void a_ready(const AttnUnit&)const{}
  __device__ __forceinline__ void done(const AttnUnit&)const{}
};
template<class Sched,int THRL=8> __device__ __forceinline__ void attn_phase(char*lds,const AttnTensors&T,const Sched&S){
  AttnUnit u;
  for(int i=0;S.next(i,u);++i){ S.a_ready(u); attn_unit<THRL>(u.bh/NHEAD,u.bh%NHEAD,u.qb,T.Q,T.K,T.V,T.O,T.nb+(long)u.bh*SEQ,lds); S.done(u); }
}
#undef SBAR
#undef WAIT_BAR
}
#define GAS __attribute__((address_space(1)))
#define LAS __attribute__((address_space(3)))
typedef unsigned short bf16;
typedef unsigned v4u __attribute__((ext_vector_type(4)));
typedef float f32x4 __attribute__((ext_vector_type(4)));
typedef short bf16x8 __attribute__((ext_vector_type(8)));
typedef GAS unsigned gu32;
typedef GAS unsigned long long gu64;
#define RLX_AGENT __ATOMIC_RELAXED, __HIP_MEMORY_SCOPE_AGENT
#define LDS_WAIT() asm volatile("s_waitcnt lgkmcnt(0)" ::: "memory")
#define VM_WAIT() asm volatile("s_waitcnt vmcnt(0)" ::: "memory")
__device__ __forceinline__ unsigned long long rt() { return __builtin_amdgcn_s_memrealtime(); }
__device__ __forceinline__ unsigned f2bf(float f) { unsigned u = __builtin_bit_cast(unsigned, f); return (u + 0x7fffu + ((u >> 16) & 1u)) >> 16; }
__device__ __forceinline__ unsigned pk2(float lo, float hi) { return f2bf(lo) | (f2bf(hi) << 16); }

#define XB_TMO      128
#define XB_XCNT(j)  (256  + 64 * (j))
#define XB_XSUB(j)  (1280 + 64 * (j))
#define XB_XGEN(j)  (2304 + 64 * (j))
#define XB_TOP      3328
#define XB_TOPGEN   3392
#define XCD_BAR_WORDS 3456
#define XB_SPIN_CAP (1u << 18)

__device__ __forceinline__ unsigned xb_ld(unsigned* p)              { return __hip_atomic_load(p, __ATOMIC_RELAXED, __HIP_MEMORY_SCOPE_AGENT); }
__device__ __forceinline__ unsigned xb_add(unsigned* p, unsigned v) { return __hip_atomic_fetch_add(p, v, __ATOMIC_RELAXED, __HIP_MEMORY_SCOPE_AGENT); }
__device__ __forceinline__ unsigned xb_xcc_id() { return (unsigned)__builtin_amdgcn_s_getreg((3 << 11) | 20) & 0xFu; }
#define XB_SPIN(cond, bar) do { unsigned _sp = 0; while (cond) { __builtin_amdgcn_s_sleep(1); \
    if ((++_sp & 255u) == 0u) { if (xb_ld(&(bar)[XB_TMO])) break; if (_sp > XB_SPIN_CAP) { atomicAdd(&(bar)[XB_TMO], 1u); break; } } } } while (0)

struct XcdBarrier {
    unsigned* bar; unsigned x;
    volatile LAS unsigned* st;
};

__device__ __forceinline__ XcdBarrier xcd_barrier_post(unsigned* bar, volatile LAS unsigned* st) {
    XcdBarrier b; b.bar = bar; b.x = xb_xcc_id(); b.st = st;
    if (threadIdx.x == 0) (void)xb_add(&bar[XB_XCNT(b.x)], 1u);
    return b;
}
__device__ __forceinline__ void xcd_barrier_complete(unsigned* bar, unsigned x, unsigned& nloc, unsigned& nx) {
    const unsigned G = gridDim.x * gridDim.y * gridDim.z;
    unsigned sum, cnt, mine, sp = 0u;
    for (;;) {
        sum = 0u; cnt = 0u; mine = 0u;
#pragma unroll
        for (unsigned j = 0; j < 16; ++j) { const unsigned c = xb_ld(&bar[XB_XCNT(j)]); sum += c; cnt += (c > 0u) ? 1u : 0u; mine = (j == x) ? c : mine; }
        if (sum == G) break;
        __builtin_amdgcn_s_sleep(1);
        if ((++sp & 255u) == 0u) { if (xb_ld(&bar[XB_TMO])) break; if (sp > XB_SPIN_CAP) { atomicAdd(&bar[XB_TMO], 1u); break; } }
    }
    nloc = mine > 0u ? mine : 1u; nx = cnt > 0u ? cnt : 1u;
}

__device__ __forceinline__ void xcd_barrier(const XcdBarrier& b) {
    asm volatile("s_waitcnt vmcnt(0)" ::: "memory");
    __syncthreads();
    if (threadIdx.x == 0) {
        unsigned* bar = b.bar;
        __builtin_amdgcn_s_waitcnt(0);
        unsigned nloc = b.st[0], nx = b.st[1];
        if (nloc == 0u) { xcd_barrier_complete(bar, b.x, nloc, nx); b.st[0] = nloc; b.st[1] = nx; }
        const unsigned old = xb_add(&bar[XB_XSUB(b.x)], 1u);
        const unsigned gen = old / nloc;
        if (old + 1u == (gen + 1u) * nloc) {
            __builtin_amdgcn_fence(__ATOMIC_RELEASE, "agent");
            asm volatile("s_waitcnt vmcnt(0)" ::: "memory");
            const unsigned og = xb_add(&bar[XB_TOP], 1u);
            const unsigned tg = og / nx;
            if (og + 1u == (tg + 1u) * nx) xb_add(&bar[XB_TOPGEN], 1u);
            else XB_SPIN(xb_ld(&bar[XB_TOPGEN]) == tg, bar);
            __builtin_amdgcn_fence(__ATOMIC_ACQUIRE, "agent");
            xb_add(&bar[XB_XGEN(b.x)], 1u);
            asm volatile("s_waitcnt vmcnt(0)" ::: "memory");
        } else {
            XB_SPIN(xb_ld(&bar[XB_XGEN(b.x)]) == gen, bar);
            __builtin_amdgcn_fence(__ATOMIC_ACQUIRE, "agent");
            asm volatile("s_waitcnt vmcnt(0)" ::: "memory");
        }
    }
    __syncthreads();
}

constexpr int NWAVES = 8;
constexpr int BATCH = 4, SEQ = 8192, D = 1024, M = BATCH * SEQ;
constexpr int IN_W = 7184, NGW = 4096, NGT = 3072, NSLAB = 8;
constexpr int SL_POOL = 0, SL_MQ = 1, SL_MK = 2, SL_MV = 3, SL_MO = 4, SL_FQ = 5, SL_FK = 6, SL_FV = 7;
constexpr int ML_H = 4, ML_DH = 128, CHUNK = 64, NCH = SEQ / CHUNK;
constexpr int FX_H = 8;
constexpr int DFF = 2816, NEXP = 8, DFE = 3584;
constexpr float NORM_EPS = 1e-6f;
constexpr int KCAT = 1536;
constexpr int MOE_KROWS = 34816;
constexpr int MOE_KTILES = MOE_KROWS / 256;
constexpr int TOKBLK = 128, NTOKBLK = M / TOKBLK;

constexpr size_t MiB = 1u << 20;
constexpr size_t WS_CTL = 0, CTL_ZERO_BYTES = 1 * MiB;
constexpr size_t WS_W = 1 * MiB;
constexpr size_t W_LAYER = 19 * MiB, W_NG = 0, W_GT = 8 * MiB, W_CAT = 14 * MiB, W_OUT = 17 * MiB;
constexpr size_t WS_WGU = WS_W + 2 * W_LAYER, WS_WDN = WS_WGU + 11 * MiB;
constexpr size_t WS_NG = 56 * MiB, SLAB_BYTES = (size_t)M * 512 * 2;
constexpr size_t WS_GATE = WS_NG;
constexpr size_t WS_ACT0 = WS_NG;
constexpr size_t WS_HB = 312 * MiB;
constexpr size_t WS_CAT = 376 * MiB;
constexpr size_t WS_MLC = 472 * MiB;
constexpr size_t WS_MOEGU = 1 * MiB;
constexpr size_t WS_MOEDN = 113 * MiB;
constexpr size_t WS_XS = 169 * MiB;
constexpr size_t WS_ACT1 = 305 * MiB;
constexpr size_t WS_SM = 544 * MiB;
constexpr size_t SM_GATE16 = 0;
constexpr size_t SM_MLB = 2 * MiB, SM_MLA = SM_MLB + 512 * 1024, SM_MLMX = SM_MLA + 512 * 1024;
constexpr size_t SM_FNB = SM_MLMX + 512 * 1024;
constexpr size_t SM_MLN = SM_FNB + 1 * MiB;
constexpr size_t SM_MLM = SM_MLN + 1 * MiB;
constexpr size_t SM_MLDEC = SM_MLM + 16 * 132 * 4;
constexpr size_t SM_MOE = 6 * MiB;
constexpr size_t MO_RSTD = 0, MO_TOKE = MO_RSTD + (size_t)M * 4, MO_TOKG = MO_TOKE + (size_t)M * 8, MO_HIST = MO_TOKG + (size_t)M * 8,
                 MO_ROWTOK = MO_HIST + (size_t)NTOKBLK * 16 * 4, MO_ROWG = MO_ROWTOK + (size_t)2 * MOE_KROWS * 4, MO_TILEE = MO_ROWG + (size_t)2 * MOE_KROWS * 4, MO_NT = MO_TILEE + 2 * MOE_KTILES * 4, MO_END = MO_NT + 64;
static_assert(SM_MOE + MO_END <= 8 * MiB, "small arrays");
constexpr size_t WS_END = 552 * MiB;
static_assert(WS_WDN + (size_t)DFF * D * 2 <= WS_NG && WS_NG + NSLAB * SLAB_BYTES <= WS_HB && WS_HB + (size_t)M * D * 2 <= WS_CAT && WS_CAT + (size_t)M * KCAT * 2 <= WS_MLC && WS_MLC + 64 * MiB <= WS_SM, "d_ws map");
static_assert(WS_MOEDN + (size_t)NEXP * D * DFE * 2 <= WS_XS && WS_XS + (size_t)2 * MOE_KROWS * D * 2 <= WS_ACT1 && WS_ACT1 + (size_t)MOE_KROWS * DFE * 2 <= WS_SM, "d_ws map (MoE)");
constexpr int CW_TMO = 0, CW_CODE = 1, CW_BAR = 4096;

constexpr int RING_OFF = 0, RING_BYTES = 131072;
constexpr int LDSCTL_OFF = RING_BYTES, MISC_OFF = LDSCTL_OFF + 320;
constexpr int LDS_BYTES = 147456;
static_assert(MISC_OFF + 128 <= LDS_BYTES, "LDS map");

struct Frame {
    LAS unsigned char* lds;
    volatile LAS unsigned* MISC;
    gu32* ctl;
    int tid, lane, wave;
    int vcu, G, blk;
    unsigned char* ws;
    const float* const* in; float* out; int zi;
};
#define INP(F, i) ((F).in[(i) + (F).zi])
enum { IN_X = 0, IN_MIXG, IN_WIN, IN_POOLW, IN_POOLS, IN_CONVW, IN_MLBI, IN_MLBF, IN_MLNG, IN_FXBF, IN_WBRP, IN_WBRM, IN_WBRF, IN_WOUT, IN_FFNG, IN_FFG, IN_FFU, IN_FFD, IN_RW, IN_RB, IN_MOEG, IN_MOEU, IN_MOED, IN_FING };

__device__ __forceinline__ float wave_sum(float v) {
#pragma unroll
    for (int o = 1; o < 64; o <<= 1) v += __shfl_xor(v, o);
    return v;
}
__device__ __forceinline__ float wave_max(float v) {
#pragma unroll
    for (int o = 1; o < 64; o <<= 1) v = fmaxf(v, __shfl_xor(v, o));
    return v;
}
__device__ __forceinline__ float sigmoid_f(float x) { return 1.f / (1.f + __expf(-x)); }
__device__ __forceinline__ float logsigmoid_f(float x) { return fminf(x, 0.f) - log1pf(expf(-fabsf(x))); }

__device__ __forceinline__ void tr_item(const float* W, int ldw, int srccol0, const float* gain, bf16* WT, int ldt, int drow0, int dcol0, int k0, LAS float* scr, int lane) {
#pragma unroll 8
    for (int i = 0; i < 32; ++i) { const int kk = 2 * i + (lane >> 5); float v = W[(size_t)(k0 + kk) * ldw + srccol0 + (lane & 31)]; if (gain) v *= gain[k0 + kk]; scr[kk * 33 + (lane & 31)] = v; }
    LDS_WAIT(); asm volatile("" ::: "memory");
    const int c = lane & 7;
#pragma unroll
    for (int j = 0; j < 4; ++j) { const int n = (lane >> 3) + 8 * j; const LAS float* s = scr + (8 * c) * 33 + n;
        v4u o; o.x = pk2(s[0 * 33], s[1 * 33]); o.y = pk2(s[2 * 33], s[3 * 33]); o.z = pk2(s[4 * 33], s[5 * 33]); o.w = pk2(s[6 * 33], s[7 * 33]);
        *(GAS v4u*)(WT + (size_t)(drow0 + n) * ldt + dcol0 + k0 + 8 * c) = o; }
    LDS_WAIT(); asm volatile("" ::: "memory");
}
constexpr int CI_NG = 2048, CI_GT = 1536, CI_BR = 256, CI_OUT = 512, CI_LAYER = CI_NG + CI_GT + 2 * CI_BR + CI_OUT, CI_GU = 2816, CI_DN = 1408, CI_MAIN = 2 * CI_LAYER + CI_GU + CI_DN;
__device__ __forceinline__ void conv_item_main(Frame& F, int it, LAS float* scr) {
    if (it < 2 * CI_LAYER) {
        const int l = it / CI_LAYER; int r = it % CI_LAYER; bf16* wl = (bf16*)(F.ws + WS_W + (size_t)l * W_LAYER);
        const float* g = INP(F, IN_MIXG) + l * D; const float* win = INP(F, IN_WIN) + (size_t)l * D * IN_W;
        if (r < CI_NG) { const int nb = r >> 4, kb = r & 15; tr_item(win, IN_W, nb * 32 + (nb * 32 >= 2560 ? 8 : 0), g, wl + W_NG / 2, D, nb * 32, 0, kb * 64, scr, F.lane); return; } r -= CI_NG;
        if (r < CI_GT) { const int nb = r >> 4, kb = r & 15; tr_item(win, IN_W, 4112 + nb * 32, g, wl + W_GT / 2, D, nb * 32, 0, kb * 64, scr, F.lane); return; } r -= CI_GT;
        if (r < CI_BR) { const int nb = r >> 3, kb = r & 7; tr_item(INP(F, IN_WBRM) + (size_t)l * 512 * D, D, nb * 32, nullptr, wl + W_CAT / 2, KCAT, nb * 32, 512, kb * 64, scr, F.lane); return; } r -= CI_BR;
        if (r < CI_BR) { const int nb = r >> 3, kb = r & 7; tr_item(INP(F, IN_WBRF) + (size_t)l * 512 * D, D, nb * 32, nullptr, wl + W_CAT / 2, KCAT, nb * 32, 1024, kb * 64, scr, F.lane); return; } r -= CI_BR;
        { const int nb = r >> 4, kb = r & 15; tr_item(INP(F, IN_WOUT) + (size_t)l * D * D, D, nb * 32, nullptr, wl + W_OUT / 2, D, nb * 32, 0, kb * 64, scr, F.lane); }
        return;
    }
    it -= 2 * CI_LAYER;
    if (it < CI_GU) { const int nb = it >> 4, kb = it & 15, p = nb >> 3, w = nb & 7;
        tr_item(w < 4 ? INP(F, IN_FFG) : INP(F, IN_FFU), DFF, 128 * p + (w & 3) * 32, INP(F, IN_FFNG), (bf16*)(F.ws + WS_WGU), D, nb * 32, 0, kb * 64, scr, F.lane); return; }
    it -= CI_GU;
    { const int kb = it >> 5, nb = it & 31; tr_item(INP(F, IN_FFD), D, nb * 32, nullptr, (bf16*)(F.ws + WS_WDN), DFF, nb * 32, 0, kb * 64, scr, F.lane); }
}
constexpr int CI_MGU = 3584, CI_MDN = 1792, CI_MEXP = CI_MGU + CI_MDN, CI_MOE = NEXP * CI_MEXP;
__device__ __forceinline__ void conv_item_moe(Frame& F, int it, LAS float* scr) {
    const int e = it / CI_MEXP; int r = it % CI_MEXP;
    if (r < CI_MGU) { const int nb = r >> 4, kb = r & 15, p = nb >> 3, w = nb & 7;
        tr_item((w < 4 ? INP(F, IN_MOEG) : INP(F, IN_MOEU)) + (size_t)e * D * DFE, DFE, 128 * p + (w & 3) * 32, INP(F, IN_FFNG) + D, (bf16*)(F.ws + WS_MOEGU) + (size_t)e * 2 * DFE * D, D, nb * 32, 0, kb * 64, scr, F.lane); return; }
    r -= CI_MGU;
    { const int kb = r >> 5, nb = r & 31; tr_item(INP(F, IN_MOED) + (size_t)e * DFE * D, D, nb * 32, nullptr, (bf16*)(F.ws + WS_MOEDN) + (size_t)e * D * DFE, DFE, nb * 32, 0, kb * 64, scr, F.lane); }
}
__device__ __forceinline__ void pool_fold(Frame& F) {
    const int gt = F.blk * (NWAVES * 64) + F.tid, NT = F.G * NWAVES * 64;
    for (int o = gt; o < 2 * 512 * D; o += NT) {
        const int l = o / (512 * D), r = o % (512 * D), kk = r / D, n = r % D, g = kk >> 7;
        const float* wg = INP(F, IN_POOLW) + (size_t)l * 4 * 128 * 128 + (size_t)kk * 128; const float* sc = INP(F, IN_POOLS) + l * 512 + g * 128; const float* wb = INP(F, IN_WBRP) + (size_t)l * 512 * D + (size_t)(g * 128) * D + n;
        float a = 0.f;
#pragma unroll 8
        for (int dd = 0; dd < 128; ++dd) a += wg[dd] * sc[dd] * wb[(size_t)dd * D];
        ((bf16*)(F.ws + WS_W + (size_t)l * W_LAYER + W_CAT))[(size_t)n * KCAT + kk] = (bf16)f2bf(a);
    }
}

__device__ __forceinline__ void phase_norm_mix(Frame& F, const float* x, int l) {
    LAS float* w16 = (LAS float*)(F.lds);
    const float* g = INP(F, IN_MIXG) + l * D; const float* win = INP(F, IN_WIN) + (size_t)l * D * IN_W;
    for (int idx = F.tid; idx < 16 * D; idx += NWAVES * 64) { const int k = idx >> 4, j = idx & 15, col = j < 8 ? 2560 + j : 4104 + (j - 8); w16[j * D + k] = g[k] * win[(size_t)k * IN_W + col]; }
    __syncthreads();
    bf16* HB = (bf16*)(F.ws + WS_HB); float* gate16 = (float*)(F.ws + WS_SM + SM_GATE16);
    const int gw = F.vcu * NWAVES + F.wave, NGWV = F.G * NWAVES;
    for (int m = gw; m < M; m += NGWV) {
        const GAS f32x4* xr = (const GAS f32x4*)(x + (size_t)m * D) + F.lane;
        f32x4 v[4]; float ss = 0.f;
#pragma unroll
        for (int j = 0; j < 4; ++j) { v[j] = xr[64 * j]; ss += (v[j].x * v[j].x + v[j].y * v[j].y) + (v[j].z * v[j].z + v[j].w * v[j].w); }
        const float rstd = 1.f / sqrtf(wave_sum(ss) * (1.f / D) + NORM_EPS);
        GAS unsigned long long* o8 = (GAS unsigned long long*)(HB + (size_t)m * D) + F.lane;
#pragma unroll
        for (int j = 0; j < 4; ++j) o8[64 * j] = (unsigned long long)pk2(v[j].x * rstd, v[j].y * rstd) | ((unsigned long long)pk2(v[j].z * rstd, v[j].w * rstd) << 32);
        float keep = 0.f;
#pragma unroll 4
        for (int jj = 0; jj < 16; ++jj) { float p = 0.f;
#pragma unroll
            for (int j = 0; j < 4; ++j) { const f32x4 wv = *(const LAS f32x4*)(w16 + jj * D + 256 * j + 4 * F.lane); p += (v[j].x * wv.x + v[j].y * wv.y) + (v[j].z * wv.z + v[j].w * wv.w); }
            p = wave_sum(p) * rstd; if (F.lane == jj) keep = p; }
        if (F.lane < 16) gate16[(size_t)m * 16 + F.lane] = keep;
    }
    __syncthreads();
}
__device__ __forceinline__ void phase_norm_ffn(Frame& F, const float* x) {
    bf16* HB = (bf16*)(F.ws + WS_HB);
    const int gw = F.vcu * NWAVES + F.wave, NGWV = F.G * NWAVES;
    for (int m = gw; m < M; m += NGWV) {
        const GAS f32x4* xr = (const GAS f32x4*)(x + (size_t)m * D) + F.lane;
        f32x4 v[4]; float ss = 0.f;
#pragma unroll
        for (int j = 0; j < 4; ++j) { v[j] = xr[64 * j]; ss += (v[j].x * v[j].x + v[j].y * v[j].y) + (v[j].z * v[j].z + v[j].w * v[j].w); }
        const float rstd = 1.f / sqrtf(wave_sum(ss) * (1.f / D) + NORM_EPS);
        GAS unsigned long long* o8 = (GAS unsigned long long*)(HB + (size_t)m * D) + F.lane;
#pragma unroll
        for (int j = 0; j < 4; ++j) o8[64 * j] = (unsigned long long)pk2(v[j].x * rstd, v[j].y * rstd) | ((unsigned long long)pk2(v[j].z * rstd, v[j].w * rstd) << 32);
    }
}
__device__ __forceinline__ void phase_norm_final(Frame& F, float* x) {
    const GAS f32x4* gp = (const GAS f32x4*)INP(F, IN_FING) + F.lane; f32x4 gv[4];
#pragma unroll
    for (int j = 0; j < 4; ++j) gv[j] = gp[64 * j];
    const int gw = F.vcu * NWAVES + F.wave, NGWV = F.G * NWAVES;
    for (int m = gw; m < M; m += NGWV) {
        GAS f32x4* xr = (GAS f32x4*)(x + (size_t)m * D) + F.lane;
        f32x4 v[4]; float ss = 0.f;
#pragma unroll
        for (int j = 0; j < 4; ++j) { v[j] = xr[64 * j]; ss += (v[j].x * v[j].x + v[j].y * v[j].y) + (v[j].z * v[j].z + v[j].w * v[j].w); }
        const float rstd = 1.f / sqrtf(wave_sum(ss) * (1.f / D) + NORM_EPS);
#pragma unroll
        for (int j = 0; j < 4; ++j) xr[64 * j] = v[j] * rstd * gv[j];
    }
}

__device__ __forceinline__ void phase_route1(Frame& F, const float* x) {
    LAS float* w8 = (LAS float*)(F.lds);
    LAS int* hist = (LAS int*)(F.lds + 32768);
    const float* g = INP(F, IN_FFNG) + D; const float* rw = INP(F, IN_RW);
    for (int idx = F.tid; idx < 8 * D; idx += NWAVES * 64) { const int k = idx >> 3, e = idx & 7; w8[e * D + k] = g[k] * rw[(size_t)k * 8 + e]; }
    unsigned char* sm = F.ws + WS_SM + SM_MOE;
    float* rstd_g = (float*)(sm + MO_RSTD); int* tok_e = (int*)(sm + MO_TOKE); float* tok_g = (float*)(sm + MO_TOKG); int* hist_g = (int*)(sm + MO_HIST);
    for (int blk = F.blk; blk < NTOKBLK; blk += F.G) {
        if (F.tid < 16) hist[F.tid] = 0;
        __syncthreads();
        for (int i = 0; i < TOKBLK / NWAVES; ++i) {
            const int m = blk * TOKBLK + F.wave * (TOKBLK / NWAVES) + i;
            const GAS f32x4* xr = (const GAS f32x4*)(x + (size_t)m * D) + F.lane;
            f32x4 v[4]; float ss = 0.f;
#pragma unroll
            for (int j = 0; j < 4; ++j) { v[j] = xr[64 * j]; ss += (v[j].x * v[j].x + v[j].y * v[j].y) + (v[j].z * v[j].z + v[j].w * v[j].w); }
            const float rstd = 1.f / sqrtf(wave_sum(ss) * (1.f / D) + NORM_EPS);
            float lg[8];
#pragma unroll
            for (int e = 0; e < 8; ++e) { float p = 0.f;
#pragma unroll
                for (int j = 0; j < 4; ++j) { const f32x4 wv = *(const LAS f32x4*)(w8 + e * D + 256 * j + 4 * F.lane); p += (v[j].x * wv.x + v[j].y * wv.y) + (v[j].z * wv.z + v[j].w * wv.w); }
                lg[e] = wave_sum(p) * rstd + INP(F, IN_RB)[e]; }
            if (F.lane == 0) {
                int e0 = 0; float v0 = lg[0];
#pragma unroll
                for (int e = 1; e < 8; ++e) if (lg[e] > v0) { v0 = lg[e]; e0 = e; }
                int e1 = -1; float v1 = -INFINITY;
#pragma unroll
                for (int e = 0; e < 8; ++e) if (e != e0 && lg[e] > v1) { v1 = lg[e]; e1 = e; }
                const float t = __expf(v1 - v0), g0 = 1.f / (1.f + t), g1 = t * g0;
                rstd_g[m] = rstd; tok_e[2 * m] = e0; tok_e[2 * m + 1] = e1; tok_g[2 * m] = g0; tok_g[2 * m + 1] = g1;
                atomicAdd((int*)&hist[e0], 1); atomicAdd((int*)&hist[8 + e1], 1);
            }
        }
        __syncthreads();
        if (F.tid < 16) hist_g[blk * 16 + F.tid] = hist[F.tid];
        __syncthreads();
    }
}
__device__ __forceinline__ void phase_route2(Frame& F, const float* x) {
    LAS int* H = (LAS int*)(F.lds);
    LAS int* tot = (LAS int*)(F.lds + 16384); LAS int* pre = tot + 16; LAS int* start = tot + 32; LAS int* dest = tot + 64;
    unsigned char* sm = F.ws + WS_SM + SM_MOE;
    const float* rstd_g = (const float*)(sm + MO_RSTD); const int* tok_e = (const int*)(sm + MO_TOKE); const float* tok_g = (const float*)(sm + MO_TOKG); const int* hist_g = (const int*)(sm + MO_HIST);
    int* row_tok = (int*)(sm + MO_ROWTOK); float* row_g = (float*)(sm + MO_ROWG); int* tile_e = (int*)(sm + MO_TILEE); int* ntl = (int*)(sm + MO_NT);
    bf16* XS = (bf16*)(F.ws + WS_XS);
    for (int blk = F.blk; blk < NTOKBLK; blk += F.G) {
        for (int i = F.tid; i < NTOKBLK * 16; i += NWAVES * 64) H[i] = hist_g[i];
        __syncthreads();
        if (F.tid < 16) { int t = 0, p = 0; for (int b = 0; b < NTOKBLK; ++b) { const int h = H[b * 16 + F.tid]; if (b < blk) p += h; t += h; } tot[F.tid] = t; pre[F.tid] = p; }
        __syncthreads();
        if (F.tid == 0) { for (int k = 0; k < 2; ++k) { int run = 0; for (int e = 0; e < 8; ++e) { start[k * 8 + e] = run; run += ((tot[k * 8 + e] + 255) >> 8) << 8; } if (blk == 0) ntl[k] = run >> 8; } }
        __syncthreads();
        if (F.tid < 16) { const int k = F.tid >> 3, e = F.tid & 7; int cnt = 0; const int base = k * MOE_KROWS + start[F.tid] + pre[F.tid];
            for (int i = 0; i < TOKBLK; ++i) if (tok_e[2 * (blk * TOKBLK + i) + k] == e) { dest[2 * i + k] = base + cnt; ++cnt; }
            if (blk == 0) { const int s0 = start[F.tid], t0 = tot[F.tid], pe = ((t0 + 255) >> 8) << 8;
                for (int tI = s0 >> 8; tI < (s0 + pe) >> 8; ++tI) tile_e[k * MOE_KTILES + tI] = e;
                for (int r = s0 + t0; r < s0 + pe; ++r) { row_tok[k * MOE_KROWS + r] = -1; row_g[k * MOE_KROWS + r] = 0.f; } } }
        __syncthreads();
        for (int i = 0; i < TOKBLK / NWAVES; ++i) {
            const int li = F.wave * (TOKBLK / NWAVES) + i, m = blk * TOKBLK + li; const int d0 = dest[2 * li], d1 = dest[2 * li + 1];
            const GAS f32x4* xr = (const GAS f32x4*)(x + (size_t)m * D) + F.lane; const float rstd = rstd_g[m];
            GAS unsigned long long* o0 = (GAS unsigned long long*)(XS + (size_t)d0 * D) + F.lane; GAS unsigned long long* o1 = (GAS unsigned long long*)(XS + (size_t)d1 * D) + F.lane;
#pragma unroll
            for (int j = 0; j < 4; ++j) { const f32x4 v = xr[64 * j]; const unsigned long long w = (unsigned long long)pk2(v.x * rstd, v.y * rstd) | ((unsigned long long)pk2(v.z * rstd, v.w * rstd) << 32); o0[64 * j] = w; o1[64 * j] = w; }
            if (F.lane == 0) { row_tok[d0] = m; row_g[d0] = tok_g[2 * m]; row_tok[d1] = m; row_g[d1] = tok_g[2 * m + 1]; }
        }
        __syncthreads();
    }
}

__device__ __forceinline__ float wave_scan_add(float v, int lane) {
#pragma unroll
    for (int d = 1; d < 64; d <<= 1) { const float t = __shfl_up(v, d); if (lane >= d) v += t; }
    return v;
}
__device__ __forceinline__ float wave_scan_max(float v, int lane) {
#pragma unroll
    for (int d = 1; d < 64; d <<= 1) { const float t = __shfl_up(v, d); if (lane >= d) v = fmaxf(v, t); }
    return v;
}
__device__ __forceinline__ void prep_mlstm(Frame& F, int l, int bh) {
    LAS float* Bc = (LAS float*)(F.lds); LAS float* Gc = Bc + NCH; LAS float* mc = Gc + NCH;
    const int b = bh >> 2, h = bh & 3;
    const float* gate16 = (const float*)(F.ws + WS_SM + SM_GATE16);
    float* mlb = (float*)(F.ws + WS_SM + SM_MLB) + (size_t)bh * SEQ; float* mla = (float*)(F.ws + WS_SM + SM_MLA) + (size_t)bh * SEQ; float* mlmx = (float*)(F.ws + WS_SM + SM_MLMX) + (size_t)bh * SEQ;
    float* mlm = (float*)(F.ws + WS_SM + SM_MLM) + bh * 132; float* mldec = (float*)(F.ws + WS_SM + SM_MLDEC) + bh * NCH;
    const float bi = INP(F, IN_MLBI)[l * ML_H + h], bf = INP(F, IN_MLBF)[l * ML_H + h];
    float areg[NCH / NWAVES];
#pragma unroll
    for (int ci = 0; ci < NCH / NWAVES; ++ci) {
        const int c = F.wave + NWAVES * ci, t = c * CHUNK + F.lane; const size_t m = (size_t)b * SEQ + t;
        const float lf = logsigmoid_f(gate16[m * 16 + 4 + h] + bf), li = gate16[m * 16 + h] + bi;
        const float bc = wave_scan_add(lf, F.lane), a = li - bc;
        const float amax = wave_max(a), btot = __shfl(bc, 63);
        mlb[t] = bc; mla[t] = a; areg[ci] = a;
        if (F.lane == 0) { Bc[c] = btot; Gc[c] = btot + amax; }
    }
    __syncthreads();
    if (F.tid == 0) { float mm = 0.f; for (int c = 0; c < NCH; ++c) { mc[c] = mm; const float mn = fmaxf(Bc[c] + mm, Gc[c]); mldec[c] = __expf(Bc[c] + mm - mn); mlm[c] = mm; mm = mn; } mc[NCH] = mm; mlm[NCH] = mm; }
    __syncthreads();
#pragma unroll
    for (int ci = 0; ci < NCH / NWAVES; ++ci) {
        const int c = F.wave + NWAVES * ci, t = c * CHUNK + F.lane;
        mlmx[t] = fmaxf(mc[c], wave_scan_max(areg[ci], F.lane));
    }
    __syncthreads();
}
__device__ __forceinline__ void prep_fox(Frame& F, int l, int bh) {
    LAS float* wtot = (LAS float*)(F.lds);
    const int b = bh >> 3, h = bh & 7;
    const float* gate16 = (const float*)(F.ws + WS_SM + SM_GATE16);
    float* nb = (float*)(F.ws + WS_SM + SM_FNB) + (size_t)bh * SEQ;
    const float bf = INP(F, IN_FXBF)[l * FX_H + h];
    float v[16]; float s = 0.f;
#pragma unroll
    for (int i = 0; i < 16; ++i) { const size_t m = (size_t)b * SEQ + F.tid * 16 + i; s += logsigmoid_f(gate16[m * 16 + 8 + h] + bf); v[i] = s; }
    const float incl = wave_scan_add(s, F.lane);
    if (F.lane == 63) wtot[F.wave] = incl;
    __syncthreads();
    float off = incl - s;
    for (int w = 0; w < F.wave; ++w) off += wtot[w];
#pragma unroll
    for (int i = 0; i < 16; ++i) nb[F.tid * 16 + i] = -1.4426950408889634f * (off + v[i]);
    __syncthreads();
}

__device__ __forceinline__ void pool_item(Frame& F, int item) {
    const bf16* U = (const bf16*)(F.ws + WS_NG + SL_POOL * SLAB_BYTES); bf16* CAT = (bf16*)(F.ws + WS_CAT);
    const int w = 2 << (F.lane >> 4);
    for (int rr = 0; rr < 32; ++rr) {
        const int m = item * 32 + rr, tt = m & (SEQ - 1);
        float acc[8]; float cur[8];
#pragma unroll
        for (int i = 0; i < 8; ++i) acc[i] = 0.f;
        const int cnt = (tt + 1 < w) ? tt + 1 : w;
        for (int j = 0; j < cnt; ++j) { const v4u q = *(const GAS v4u*)(U + (size_t)(m - j) * 512 + F.lane * 8);
            const float f[8] = { __uint_as_float(q.x << 16), __uint_as_float(q.x & 0xffff0000u), __uint_as_float(q.y << 16), __uint_as_float(q.y & 0xffff0000u), __uint_as_float(q.z << 16), __uint_as_float(q.z & 0xffff0000u), __uint_as_float(q.w << 16), __uint_as_float(q.w & 0xffff0000u) };
#pragma unroll
            for (int i = 0; i < 8; ++i) { acc[i] += f[i]; if (j == 0) cur[i] = f[i]; } }
        const float inv = 1.f / (float)cnt;
        v4u o; o.x = pk2(acc[0] * inv - cur[0], acc[1] * inv - cur[1]); o.y = pk2(acc[2] * inv - cur[2], acc[3] * inv - cur[3]); o.z = pk2(acc[4] * inv - cur[4], acc[5] * inv - cur[5]); o.w = pk2(acc[6] * inv - cur[6], acc[7] * inv - cur[7]);
        *(GAS v4u*)(CAT + (size_t)m * KCAT + F.lane * 8) = o;
    }
}

typedef float f32x16 __attribute__((ext_vector_type(16)));
typedef unsigned u32x2 __attribute__((ext_vector_type(2)));
__device__ __forceinline__ float silu_f(float x) { return x / (1.f + __expf(-x)); }
__device__ __forceinline__ void unpack8(const v4u q, float (&f)[8]) {
    f[0] = __uint_as_float(q.x << 16); f[1] = __uint_as_float(q.x & 0xffff0000u); f[2] = __uint_as_float(q.y << 16); f[3] = __uint_as_float(q.y & 0xffff0000u);
    f[4] = __uint_as_float(q.z << 16); f[5] = __uint_as_float(q.z & 0xffff0000u); f[6] = __uint_as_float(q.w << 16); f[7] = __uint_as_float(q.w & 0xffff0000u);
}
__device__ __forceinline__ void conv8(const bf16* slab, size_t m, int tt, int col, const float (&cw)[4][8], float (&o)[8]) {
#pragma unroll
    for (int i = 0; i < 8; ++i) o[i] = 0.f;
#pragma unroll
    for (int j = 0; j < 4; ++j) { if (tt - 3 + j >= 0) { float f[8]; unpack8(*(const GAS v4u*)(slab + (m - 3 + j) * 512 + col), f);
#pragma unroll
            for (int i = 0; i < 8; ++i) o[i] += cw[j][i] * f[i]; } }
#pragma unroll
    for (int i = 0; i < 8; ++i) o[i] = silu_f(o[i]);
}
constexpr int KT_P = 72, QS_P = 136;
__device__ __forceinline__ bf16x8 pack_acc8(const f32x16& x, int s) {
    v4u w; w.x = pk2(x[8 * s + 0], x[8 * s + 1]); w.y = pk2(x[8 * s + 2], x[8 * s + 3]); w.z = pk2(x[8 * s + 4], x[8 * s + 5]); w.w = pk2(x[8 * s + 6], x[8 * s + 7]);
    return __builtin_bit_cast(bf16x8, w);
}
__device__ __forceinline__ void mlstm_L_unit(Frame& F, int l, int u) {
    LAS bf16* Kt = (LAS bf16*)(F.lds); LAS bf16* Vt = Kt + 128 * KT_P; LAS float* wk = (LAS float*)(F.lds + 2 * 128 * KT_P * 2);
    const int bh = u >> 7, c = u & (NCH - 1), b = bh >> 2, h = bh & 3;
    const bf16* KS = (const bf16*)(F.ws + WS_NG + SL_MK * SLAB_BYTES); const bf16* VS = (const bf16*)(F.ws + WS_NG + SL_MV * SLAB_BYTES);
    const float* mlb = (const float*)(F.ws + WS_SM + SM_MLB) + (size_t)bh * SEQ; const float* mla = (const float*)(F.ws + WS_SM + SM_MLA) + (size_t)bh * SEQ;
    const float* mlm = (const float*)(F.ws + WS_SM + SM_MLM) + bh * 132;
    if (F.tid < CHUNK) wk[F.tid] = __expf(mlb[c * CHUNK + 63] + mla[c * CHUNK + F.tid] - mlm[c + 1]);
    __syncthreads();
    {   const int cg = F.tid & 15, col = h * ML_DH + cg * 8; float cw[4][8];
#pragma unroll
        for (int j = 0; j < 4; ++j)
#pragma unroll
            for (int i = 0; i < 8; ++i) cw[j][i] = INP(F, IN_CONVW)[(size_t)l * 4 * 1024 + j * 1024 + 512 + col + i];
#pragma unroll
        for (int half = 0; half < 2; ++half) { const int s = (F.tid >> 4) + 32 * half, tt = c * CHUNK + s; const size_t m = (size_t)b * SEQ + tt;
            float kk[8]; conv8(KS, m, tt, col, cw, kk);
            float vv[8]; unpack8(*(const GAS v4u*)(VS + m * 512 + col), vv); const float ws = wk[s];
#pragma unroll
            for (int i = 0; i < 8; ++i) { Kt[(cg * 8 + i) * KT_P + s] = (bf16)f2bf(kk[i] * 0.08838834764831845f); Vt[(cg * 8 + i) * KT_P + s] = (bf16)f2bf(vv[i] * ws); } }
    }
    __syncthreads();
    {   const int r = F.lane & 31, hi = F.lane >> 5, kb = F.wave >> 1;
        f32x16 acc[2]; acc[0] = f32x16{}; acc[1] = f32x16{};
#pragma unroll
        for (int sp = 0; sp < 4; ++sp) { const bf16x8 a = *(const LAS bf16x8*)(Kt + (kb * 32 + r) * KT_P + 16 * sp + 8 * hi);
#pragma unroll
            for (int j = 0; j < 2; ++j) { const int vb = 2 * (F.wave & 1) + j; const bf16x8 bb = *(const LAS bf16x8*)(Vt + (vb * 32 + r) * KT_P + 16 * sp + 8 * hi);
                acc[j] = __builtin_amdgcn_mfma_f32_32x32x16_bf16(a, bb, acc[j], 0, 0, 0); } }
        GAS bf16x8* img = (GAS bf16x8*)(F.ws + WS_MLC + (size_t)u * 32768);
#pragma unroll
        for (int j = 0; j < 2; ++j) { const int vb = 2 * (F.wave & 1) + j;
#pragma unroll
            for (int s = 0; s < 2; ++s) img[((vb * 4 + kb) * 2 + s) * 64 + F.lane] = pack_acc8(acc[j], s); }
    }
    if (F.tid < ML_DH) { float a = 0.f;
#pragma unroll 8
        for (int s = 0; s < CHUNK; ++s) a += wk[s] * __uint_as_float((unsigned)Kt[F.tid * KT_P + s] << 16);
        ((float*)(F.ws + WS_SM + SM_MLN))[(size_t)u * ML_DH + F.tid] = a; }
    __syncthreads();
}
__device__ __forceinline__ void mlstm_S(Frame& F) {
    const int gt = F.vcu * (NWAVES * 64) + F.tid, NT = F.G * NWAVES * 64;
    const float* mldec = (const float*)(F.ws + WS_SM + SM_MLDEC);
    for (int id = gt; id < 16 * 4096 + 16 * ML_DH; id += NT) {
        if (id < 16 * 4096) {
            const int bh = id >> 12, e4 = id & 4095; GAS u32x2* p = (GAS u32x2*)(F.ws + WS_MLC + (size_t)bh * NCH * 32768) + e4; const float* dec = mldec + bh * NCH;
            float r0 = 0.f, r1 = 0.f, r2 = 0.f, r3 = 0.f;
            for (int c0 = 0; c0 < NCH; c0 += 8) { u32x2 q[8];
#pragma unroll
                for (int i = 0; i < 8; ++i) q[i] = p[(size_t)(c0 + i) * 4096];
#pragma unroll
                for (int i = 0; i < 8; ++i) { const float d = dec[c0 + i]; u32x2 o; o.x = pk2(r0, r1); o.y = pk2(r2, r3); p[(size_t)(c0 + i) * 4096] = o;
                    r0 = d * r0 + __uint_as_float(q[i].x << 16); r1 = d * r1 + __uint_as_float(q[i].x & 0xffff0000u); r2 = d * r2 + __uint_as_float(q[i].y << 16); r3 = d * r3 + __uint_as_float(q[i].y & 0xffff0000u); } }
        } else {
            const int j = id - 16 * 4096, bh = j >> 7, k = j & (ML_DH - 1); float* p = (float*)(F.ws + WS_SM + SM_MLN) + (size_t)bh * NCH * ML_DH + k; const float* dec = mldec + bh * NCH;
            float r = 0.f;
            for (int c = 0; c < NCH; ++c) { const float loc = p[(size_t)c * ML_DH]; p[(size_t)c * ML_DH] = r; r = dec[c] * r + loc; }
        }
    }
}
__device__ __forceinline__ void mlstm_O_unit(Frame& F, int l, int u) {
    LAS bf16* Qs = (LAS bf16*)(F.lds); LAS bf16* Ks = Qs + 64 * QS_P; LAS bf16* Vt = Ks + 64 * QS_P;
    LAS float* fa = (LAS float*)(F.lds + (2 * 64 * QS_P + 128 * KT_P) * 2); LAS float* fmx = fa + 64; LAS float* fb = fa + 128; LAS float* nvec = fa + 192; LAS float* ssq = fa + 320;
    const int bh = u >> 7, c = u & (NCH - 1), b = bh >> 2, h = bh & 3;
    const bf16* QS_ = (const bf16*)(F.ws + WS_NG + SL_MQ * SLAB_BYTES); const bf16* KS = (const bf16*)(F.ws + WS_NG + SL_MK * SLAB_BYTES);
    const bf16* VS = (const bf16*)(F.ws + WS_NG + SL_MV * SLAB_BYTES); const bf16* OS = (const bf16*)(F.ws + WS_NG + SL_MO * SLAB_BYTES);
    const float* mlb = (const float*)(F.ws + WS_SM + SM_MLB) + (size_t)bh * SEQ; const float* mla = (const float*)(F.ws + WS_SM + SM_MLA) + (size_t)bh * SEQ;
    const float* mlmx = (const float*)(F.ws + WS_SM + SM_MLMX) + (size_t)bh * SEQ; const float m_c = ((const float*)(F.ws + WS_SM + SM_MLM))[bh * 132 + c];
    const int r = F.lane & 31, hi = F.lane >> 5, tb = F.wave & 1, vb = F.wave >> 1;
    bf16x8 cf[4][2];
    {   const GAS bf16x8* img = (const GAS bf16x8*)(F.ws + WS_MLC + (size_t)u * 32768);
#pragma unroll
        for (int kb = 0; kb < 4; ++kb)
#pragma unroll
            for (int s = 0; s < 2; ++s) cf[kb][s] = img[((vb * 4 + kb) * 2 + s) * 64 + F.lane]; }
    if (F.tid < CHUNK) { fa[F.tid] = mla[c * CHUNK + F.tid]; fmx[F.tid] = mlmx[c * CHUNK + F.tid]; fb[F.tid] = mlb[c * CHUNK + F.tid]; }
    else if (F.tid < CHUNK + ML_DH) nvec[F.tid - CHUNK] = ((const float*)(F.ws + WS_SM + SM_MLN))[(size_t)u * ML_DH + F.tid - CHUNK];
    {   const int cg = F.tid & 15, col = h * ML_DH + cg * 8; float cwq[4][8], cwk[4][8];
#pragma unroll
        for (int j = 0; j < 4; ++j)
#pragma unroll
            for (int i = 0; i < 8; ++i) { cwq[j][i] = INP(F, IN_CONVW)[(size_t)l * 4 * 1024 + j * 1024 + col + i]; cwk[j][i] = INP(F, IN_CONVW)[(size_t)l * 4 * 1024 + j * 1024 + 512 + col + i]; }
#pragma unroll
        for (int half = 0; half < 2; ++half) { const int s = (F.tid >> 4) + 32 * half, tt = c * CHUNK + s; const size_t m = (size_t)b * SEQ + tt;
            float qq[8], kk[8], vv[8]; conv8(QS_, m, tt, col, cwq, qq); conv8(KS, m, tt, col, cwk, kk); unpack8(*(const GAS v4u*)(VS + m * 512 + col), vv);
            v4u wq, wkk; wq.x = pk2(qq[0], qq[1]); wq.y = pk2(qq[2], qq[3]); wq.z = pk2(qq[4], qq[5]); wq.w = pk2(qq[6], qq[7]);
            const float sc = 0.08838834764831845f;
            wkk.x = pk2(kk[0] * sc, kk[1] * sc); wkk.y = pk2(kk[2] * sc, kk[3] * sc); wkk.z = pk2(kk[4] * sc, kk[5] * sc); wkk.w = pk2(kk[6] * sc, kk[7] * sc);
            *(LAS v4u*)(Qs + s * QS_P + cg * 8) = wq; *(LAS v4u*)(Ks + s * QS_P + cg * 8) = wkk;
#pragma unroll
            for (int i = 0; i < 8; ++i) Vt[(cg * 8 + i) * KT_P + s] = (bf16)f2bf(vv[i]); }
    }
    __syncthreads();
    const int t = tb * 32 + r;
    const float Mx_t = fmx[t], m_t = fb[t] + Mx_t, w_int = __expf(m_c - Mx_t);
    bf16x8 pf[2][2]; float psum = 0.f;
#pragma unroll
    for (int sb = 0; sb < 2; ++sb) {
        if (sb <= tb) {
            f32x16 x = f32x16{};
#pragma unroll
            for (int ks = 0; ks < 8; ++ks) { const bf16x8 a = *(const LAS bf16x8*)(Ks + (sb * 32 + r) * QS_P + 16 * ks + 8 * hi); const bf16x8 q = *(const LAS bf16x8*)(Qs + t * QS_P + 16 * ks + 8 * hi);
                x = __builtin_amdgcn_mfma_f32_32x32x16_bf16(a, q, x, 0, 0, 0); }
#pragma unroll
            for (int rr = 0; rr < 16; ++rr) { const int s = sb * 32 + (rr & 3) + 8 * (rr >> 2) + 4 * hi; const float p = (s <= t) ? __expf(fa[s] - Mx_t) * x[rr] : 0.f; x[rr] = p; psum += p; }
            pf[sb][0] = pack_acc8(x, 0); pf[sb][1] = pack_acc8(x, 1);
        }
    }
    psum += __shfl_xor(psum, 32);
    f32x16 acc = f32x16{};
#pragma unroll
    for (int kb = 0; kb < 4; ++kb)
#pragma unroll
        for (int s = 0; s < 2; ++s) { const u32x2 lo = *(const LAS u32x2*)(Qs + t * QS_P + kb * 32 + 16 * s + 4 * hi), hi2 = *(const LAS u32x2*)(Qs + t * QS_P + kb * 32 + 16 * s + 8 + 4 * hi);
            v4u w; w.x = lo.x; w.y = lo.y; w.z = hi2.x; w.w = hi2.y;
            acc = __builtin_amdgcn_mfma_f32_32x32x16_bf16(cf[kb][s], __builtin_bit_cast(bf16x8, w), acc, 0, 0, 0); }
#pragma unroll
    for (int rr = 0; rr < 16; ++rr) acc[rr] *= w_int;
#pragma unroll
    for (int sb = 0; sb < 2; ++sb) {
        if (sb <= tb) {
#pragma unroll
            for (int s = 0; s < 2; ++s) { const u32x2 lo = *(const LAS u32x2*)(Vt + (vb * 32 + r) * KT_P + sb * 32 + 16 * s + 4 * hi), hi2 = *(const LAS u32x2*)(Vt + (vb * 32 + r) * KT_P + sb * 32 + 16 * s + 8 + 4 * hi);
                v4u w; w.x = lo.x; w.y = lo.y; w.z = hi2.x; w.w = hi2.y;
                acc = __builtin_amdgcn_mfma_f32_32x32x16_bf16(__builtin_bit_cast(bf16x8, w), pf[sb][s], acc, 0, 0, 0); }
        }
    }
    float nq = 0.f;
#pragma unroll
    for (int i = 0; i < 8; ++i) { float f[8]; unpack8(*(const LAS v4u*)(Qs + t * QS_P + 64 * hi + 8 * i), f);
#pragma unroll
        for (int j = 0; j < 8; ++j) nq += f[j] * nvec[64 * hi + 8 * i + j]; }
    nq += __shfl_xor(nq, 32);
    const float den = w_int * nq + psum, inv = 1.f / fmaxf(fabsf(den), __expf(-m_t));
    float sq = 0.f;
#pragma unroll
    for (int rr = 0; rr < 16; ++rr) { acc[rr] *= inv; sq += acc[rr] * acc[rr]; }
    sq += __shfl_xor(sq, 32);
    if (hi == 0) ssq[vb * 64 + t] = sq;
    __syncthreads();
    const float rstd = 1.f / sqrtf((ssq[t] + ssq[64 + t] + ssq[128 + t] + ssq[192 + t]) * (1.f / ML_DH) + NORM_EPS);
    {   const size_t m = (size_t)b * SEQ + c * CHUNK + t; bf16* CAT = (bf16*)(F.ws + WS_CAT);
#pragma unroll
        for (int q = 0; q < 4; ++q) { const int v0 = vb * 32 + 8 * q + 4 * hi, col = h * ML_DH + v0;
            const u32x2 ow = *(const GAS u32x2*)(OS + m * 512 + col); const f32x4 gn = *(const GAS f32x4*)(INP(F, IN_MLNG) + (size_t)l * 512 + col);
            const float o0 = sigmoid_f(__uint_as_float(ow.x << 16)), o1 = sigmoid_f(__uint_as_float(ow.x & 0xffff0000u)), o2 = sigmoid_f(__uint_as_float(ow.y << 16)), o3 = sigmoid_f(__uint_as_float(ow.y & 0xffff0000u));
            u32x2 w; w.x = pk2(acc[4 * q] * rstd * gn.x * o0, acc[4 * q + 1] * rstd * gn.y * o1); w.y = pk2(acc[4 * q + 2] * rstd * gn.z * o2, acc[4 * q + 3] * rstd * gn.w * o3);
            *(GAS u32x2*)(CAT + m * KCAT + 512 + col) = w; }
    }
    __syncthreads();
}

#ifndef MK_MULTI
#define MK_MULTI 1
#endif
constexpr int NPH = 1 + (10 + 2) + (1 + 10 + 5) + 1;
#ifndef PH_MASK
#define PH_MASK 0xffffffffu
#endif
#define PH_BEGIN(id) if (ph >= lo && ph < hi) { if constexpr (((PH_MASK) >> (id)) & 1u) { Frame F = FK; { size_t z_ = 0; int zi_ = 0; asm volatile("" : "+v"(F.tid), "+s"(z_), "+s"(zi_)); \
        F.lane = F.tid & 63; F.ws = FK.ws + z_; F.out = (float*)((char*)FK.out + z_); F.zi = zi_; } const int gw = F.vcu * NWAVES + F.wave, NGWV = F.G * NWAVES; (void)gw; (void)NGWV;
#define PH_END } if (ph + 1 < hi) { XcdBarrier b2_ = bar; size_t zb_ = 0; asm volatile("" : "+s"(zb_)); b2_.bar = bar.bar + zb_; xcd_barrier(b2_); } } ++ph;
#define HB ((bf16*)(F.ws + WS_HB))
#define CAT ((bf16*)(F.ws + WS_CAT))
#define SLAB ((bf16*)(F.ws + WS_NG))
#define GATE ((bf16*)(F.ws + WS_GATE))
#define WL ((bf16*)(F.ws + WS_W + (size_t)l * W_LAYER))
#define XIN ((l == 0) ? INP(F, IN_X) : (const float*)F.out)

template <int l> __device__ __forceinline__ void layer_phases(Frame& FK, int& ph, const int lo, const int hi, const XcdBarrier& bar, unsigned char* lds) {
        if constexpr (l > 0) { PH_BEGIN(1) phase_norm_mix(F, XIN, l); PH_END }
        PH_BEGIN(17)
            for (int s = F.blk; s < 48; s += F.G) { if (s < 16) prep_mlstm(F, l, s); else prep_fox(F, l, s - 16); }
        PH_END
        PH_BEGIN(2)
            pg8::Gemm g{HB, WL + W_NG / 2, M, NGW, D}; pg8::StaticOrder S; S.init(M, NGW, F.G, F.blk);
            pg8::EpiSlab E{SLAB, (size_t)M * 512, SL_FQ, attn_body::C2};
            pg8::gemm_phase<pg8::EpiSlab, pg8::StaticOrder, true, true>(F.lds + RING_OFF, g, S, E);
        PH_END
        PH_BEGIN(3)
            for (int it = gw; it < M / 32; it += NGWV) pool_item(F, it);
            for (int u = F.vcu; u < BATCH * ML_H * NCH; u += F.G) mlstm_L_unit(F, l, u);
        PH_END
        PH_BEGIN(4) mlstm_S(F); PH_END
        PH_BEGIN(18)
            for (int u = F.vcu; u < BATCH * ML_H * NCH; u += F.G) mlstm_O_unit(F, l, u);
        PH_END
        PH_BEGIN(5)
            const attn_body::AttnTensors AT{(const attn_body::bf16*)(SLAB + (size_t)SL_FQ * M * 512), (const attn_body::bf16*)(SLAB + (size_t)SL_FK * M * 512), (const attn_body::bf16*)(SLAB + (size_t)SL_FV * M * 512),
                                            (attn_body::bf16*)CAT, (const float*)(F.ws + WS_SM + SM_FNB)};
            const attn_body::StaticOrder S((int)F.G, (int)F.blk);
            attn_body::attn_phase<attn_body::StaticOrder>((char*)lds + RING_OFF, AT, S);
        PH_END
        PH_BEGIN(6)
            pg8::Gemm g{HB, WL + W_GT / 2, M, NGT, D}; pg8::StaticOrder S; S.init(M, NGT, F.G, F.blk);
            pg8::EpiSig E{GATE, (size_t)M * D};
            pg8::gemm_phase<pg8::EpiSig, pg8::StaticOrder, true, true>(F.lds + RING_OFF, g, S, E);
        PH_END
        PH_BEGIN(7)
            pg8::Gemm g{CAT, WL + W_CAT / 2, M, D, KCAT}; pg8::StaticOrder S; S.init(M, D, F.G, F.blk);
            pg8::EpiMerge E{GATE, (size_t)M * D, HB};
            pg8::gemm_phase<pg8::EpiMerge, pg8::StaticOrder, true, true>(F.lds + RING_OFF, g, S, E);
        PH_END
        PH_BEGIN(8)
            pg8::Gemm g{HB, WL + W_OUT / 2, M, D, D}; pg8::StaticOrder S; S.init(M, D, F.G, F.blk);
            pg8::EpiRes E{XIN, F.out, D};
            pg8::gemm_phase<pg8::EpiRes, pg8::StaticOrder, true, true>(F.lds + RING_OFF, g, S, E);
        PH_END
        if constexpr (l == 0) {
            PH_BEGIN(9) phase_norm_ffn(F, F.out); PH_END
            PH_BEGIN(10)
                pg8::Gemm g{HB, (const bf16*)(F.ws + WS_WGU), M, 2 * DFF, D}; pg8::StaticOrder S; S.init(M, 2 * DFF, F.G, F.blk);
                pg8::EpiSwiGLU E{(bf16*)(F.ws + WS_ACT0), DFF};
                pg8::gemm_phase<pg8::EpiSwiGLU, pg8::StaticOrder, true, true>(F.lds + RING_OFF, g, S, E);
            PH_END
            PH_BEGIN(11)
                pg8::Gemm g{(const bf16*)(F.ws + WS_ACT0), (const bf16*)(F.ws + WS_WDN), M, D, DFF}; pg8::StaticOrder S; S.init(M, D, F.G, F.blk);
                pg8::EpiRes E{F.out, F.out, D};
                pg8::gemm_phase<pg8::EpiRes, pg8::StaticOrder, true, true>(F.lds + RING_OFF, g, S, E);
            PH_END
        } else {
            PH_BEGIN(12)
                phase_route1(F, F.out);
                __syncthreads();
                LAS float* scr = (LAS float*)(F.lds + F.wave * 16384);
                for (int it = gw; it < CI_MOE; it += NGWV) conv_item_moe(F, it, scr);
            PH_END
            PH_BEGIN(13) phase_route2(F, F.out); PH_END
            for (int k = 0; k < 2; ++k) {
                PH_BEGIN(14)
                    unsigned char* sm = F.ws + WS_SM + SM_MOE; const int* tile_e = (const int*)(sm + MO_TILEE) + k * MOE_KTILES;
                    const int nM = __builtin_amdgcn_readfirstlane(__hip_atomic_load((const int*)(sm + MO_NT) + k, RLX_AGENT));
                    pg8::Gemm g{(const bf16*)(F.ws + WS_XS) + (size_t)k * MOE_KROWS * D, (const bf16*)(F.ws + WS_MOEGU), MOE_KROWS, 2 * DFE, D}; pg8::MoeOrder S; S.init(nM, 2 * DFE / 256, F.G, F.blk, tile_e);
                    pg8::EpiSwiGLU E{(bf16*)(F.ws + WS_ACT1), DFE};
                    pg8::gemm_phase<pg8::EpiSwiGLU, pg8::MoeOrder, true, true>(F.lds + RING_OFF, g, S, E);
                PH_END
                PH_BEGIN(15)
                    unsigned char* sm = F.ws + WS_SM + SM_MOE; const int* tile_e = (const int*)(sm + MO_TILEE) + k * MOE_KTILES;
                    const int nM = __builtin_amdgcn_readfirstlane(__hip_atomic_load((const int*)(sm + MO_NT) + k, RLX_AGENT));
                    pg8::Gemm g{(const bf16*)(F.ws + WS_ACT1), (const bf16*)(F.ws + WS_MOEDN), MOE_KROWS, D, DFE}; pg8::MoeOrder S; S.init(nM, D / 256, F.G, F.blk, tile_e);
                    pg8::EpiMoeDown E{F.out, (const int*)(sm + MO_ROWTOK) + k * MOE_KROWS, (const float*)(sm + MO_ROWG) + k * MOE_KROWS};
                    pg8::gemm_phase<pg8::EpiMoeDown, pg8::MoeOrder, true, true>(F.lds + RING_OFF, g, S, E);
                PH_END
            }
        }
    }
struct Args { const float* in[24]; float* out; unsigned char* ws; int ph_lo, ph_hi; };
__global__ void __launch_bounds__(NWAVES * 64, 2) fwd(Args args) {
    extern __shared__ __attribute__((aligned(16))) unsigned char lds[];
    Frame FK;
    FK.lds = (LAS unsigned char*)lds;
    FK.MISC = (volatile LAS unsigned*)(FK.lds + MISC_OFF);
    FK.tid = threadIdx.x; FK.lane = FK.tid & 63; FK.wave = __builtin_amdgcn_readfirstlane(FK.tid >> 6);
    FK.G = gridDim.x; FK.blk = blockIdx.x; { const int bx = blockIdx.x; FK.vcu = (FK.G % 8 == 0) ? (bx % 8) * (FK.G / 8) + bx / 8 : bx; }
    FK.ws = args.ws; FK.ctl = (gu32*)(args.ws + WS_CTL); FK.out = args.out;
    FK.in = args.in; FK.zi = 0;
    for (int u = FK.tid; u < (LDS_BYTES - LDSCTL_OFF) / 4; u += NWAVES * 64) ((LAS unsigned*)(FK.lds + LDSCTL_OFF))[u] = 0u;
    __syncthreads();
    const int lo = args.ph_lo, hi = args.ph_hi;
    XcdBarrier bar; bar.bar = (unsigned*)(FK.ctl + CW_BAR); bar.x = 0; bar.st = nullptr;
    if (hi - lo > 1) bar = xcd_barrier_post((unsigned*)(FK.ctl + CW_BAR), FK.MISC + 8);
    int ph = 0;
    PH_BEGIN(0)
        LAS float* scr = (LAS float*)(F.lds + F.wave * 16384);
        for (int it = gw; it < CI_MAIN; it += NGWV) conv_item_main(F, it, scr);
        pool_fold(F);
        __syncthreads();
        phase_norm_mix(F, INP(F, IN_X), 0);
    PH_END

    layer_phases<0>(FK, ph, lo, hi, bar, lds);
    layer_phases<1>(FK, ph, lo, hi, bar, lds);
    PH_BEGIN(16) phase_norm_final(F, F.out); PH_END
#undef PH_BEGIN
#undef HB
#undef CAT
#undef SLAB
#undef GATE
#undef WL
#undef XIN
#undef PH_END
}

extern "C" void kernel_launch(void* const* d_in, const int* in_sizes, int n_in, void* d_out, int out_size, void* d_ws, size_t ws_size, hipStream_t stream) {
    static int grid = 0;
    if (grid == 0) {
        if (n_in != 24 || in_sizes[0] != M * D || out_size != M * D || ws_size < WS_END) { fprintf(stderr, "kernel_launch: built for 24 inputs, x/out of %d floats, >= %zu bytes of workspace; got n_in %d, in0 %d, out %d, ws %zu; nothing launched\n", M * D, (size_t)WS_END, n_in, n_in > 0 ? in_sizes[0] : -1, out_size, ws_size); grid = -1; return; }
        int dev = 0, cus = 0, per_cu = 0;
        if (hipGetDevice(&dev) != hipSuccess || hipDeviceGetAttribute(&cus, hipDeviceAttributeMultiprocessorCount, dev) != hipSuccess) { fprintf(stderr, "kernel_launch: hipGetDevice / hipDeviceGetAttribute failed\n"); grid = -1; return; }
        if (hipFuncSetAttribute((const void*)fwd, hipFuncAttributeMaxDynamicSharedMemorySize, LDS_BYTES) != hipSuccess) { fprintf(stderr, "kernel_launch: hipFuncSetAttribute failed\n"); grid = -1; return; }
        if (hipOccupancyMaxActiveBlocksPerMultiprocessor(&per_cu, (const void*)fwd, NWAVES * 64, LDS_BYTES) != hipSuccess || per_cu < 1)
            fprintf(stderr, "kernel_launch: note: the occupancy query reports %d workgroups per CU\n", per_cu);
        (void)hipGetLastError();
        grid = cus;
    }
    if (grid < 0) return;
    if (hipMemsetAsync((char*)d_ws + WS_CTL, 0, CTL_ZERO_BYTES, stream) != hipSuccess) { fprintf(stderr, "kernel_launch: hipMemsetAsync failed\n"); return; }
    Args a{};
    for (int i = 0; i < 24; ++i) a.in[i] = (const float*)d_in[i];
    a.out = (float*)d_out; a.ws = (unsigned char*)d_ws;
#if MK_MULTI
    for (int p = 0; p < NPH; ++p) { a.ph_lo = p; a.ph_hi = p + 1; hipLaunchKernelGGL(fwd, dim3(grid), dim3(NWAVES * 64), LDS_BYTES, stream, a); }
#else
    a.ph_lo = 0; a.ph_hi = NPH; hipLaunchKernelGGL(fwd, dim3(grid), dim3(NWAVES * 64), LDS_BYTES, stream, a);
#endif
    const hipError_t le = hipPeekAtLastError();
    if (le != hipSuccess) fprintf(stderr, "kernel_launch: launch failed: %s\n", hipGetErrorName(le));
}
```

```cpp
#include <hip/hip_runtime.h>
#include <cstdio>
#include <cstdint>
namespace pg8 {
#define PG8_LAS __attribute__((address_space(3)))
typedef unsigned short bf16_t;
typedef short bf16x8 __attribute__((ext_vector_type(8)));
typedef float f32x4 __attribute__((ext_vector_type(4)));
typedef unsigned u32x4 __attribute__((ext_vector_type(4)));
constexpr int BM = 256, BK = 64, HALF = 128, HTB = HALF * BK * 2  , STAGE_BYTES = 8 * HTB, NXCD = 8, WGM = 8;

__host__ __device__ __forceinline__ int lds_byte(int r, int c) { const int st = (r >> 4) * 2 + (c >> 5), rr = r & 15, cc = c & 31, ob = rr * 64 + cc * 2; return st * 1024 + (ob ^ (((ob >> 9) & 1) << 5)); }
__host__ __device__ __forceinline__ void stage_rc(int b, int& R, int& C) { const int st = b / 1024, sb = b % 1024, swz = sb ^ (((sb >> 9) & 1) << 5); R = (st >> 1) * 16 + swz / 64; C = (st & 1) * 32 + (swz % 64) / 2; }
__host__ __device__ __forceinline__ int perm32(int rho) { const int n = rho >> 4, i = rho & 15; return 8 * (i >> 2) + 4 * n + (i & 3); }

struct Unit { int pm, pn, pb; };
struct Gemm { const bf16_t* A; const bf16_t* Bt; int M, N, K; };

struct StaticOrder {
    int nM, nN, nwg, G, c;
    __host__ __device__ void init(int M, int N, int G_, int c_) { nM = M / BM; nN = N / BM; nwg = nM * nN; G = G_; c = c_; }
    __host__ __device__ bool next(int i, Unit& u) const {
        const long L = (long)i * G + c; if (L >= nwg) return false;
        int wgid = (int)L; { const int q = nwg / NXCD, r = nwg % NXCD, xcd = wgid % NXCD, off = wgid / NXCD; wgid = (xcd < r ? xcd * (q + 1) : r * (q + 1) + (xcd - r) * q) + off; }
        const int nig = WGM * nN, gid = wgid / nig, fm = gid * WGM, gsz = (nM - fm) < WGM ? (nM - fm) : WGM;
        u.pm = fm + ((wgid % nig) % gsz); u.pn = (wgid % nig) / gsz; u.pb = u.pn; return true;
    }
    __device__ __forceinline__ void a_ready(const Unit&) const {}
    __device__ __forceinline__ void done(const Unit&) const {}
};

__device__ __forceinline__ unsigned cvt_pk_bf16(float lo, float hi) { unsigned r; asm volatile("v_cvt_pk_bf16_f32 %0, %1, %2" : "=v"(r) : "v"(lo), "v"(hi)); return r; }
__device__ __forceinline__ float sigm(float x) { return __builtin_amdgcn_rcpf(1.f + __builtin_amdgcn_exp2f(-1.4426950408889634f * x)); }
typedef int v4i_t __attribute__((ext_vector_type(4)));
typedef int v8i_t __attribute__((ext_vector_type(8)));
__device__ __forceinline__ v8i_t cat8(bf16x8 a, bf16x8 b) { return __builtin_shufflevector(__builtin_bit_cast(v4i_t, a), __builtin_bit_cast(v4i_t, b), 0, 1, 2, 3, 4, 5, 6, 7); }
__device__ __forceinline__ float clamp8(float x) { return __builtin_amdgcn_fmed3f(x, -448.f, 448.f); }
__device__ __forceinline__ unsigned pack_fp8x4(float a, float b, float c, float d) { int w = 0; w = __builtin_amdgcn_cvt_pk_fp8_f32(clamp8(a), clamp8(b), w, false); w = __builtin_amdgcn_cvt_pk_fp8_f32(clamp8(c), clamp8(d), w, true); return (unsigned)w; }
__device__ __forceinline__ float bf_lo(unsigned w) { return __uint_as_float(w << 16); }
__device__ __forceinline__ float bf_hi(unsigned w) { return __uint_as_float(w & 0xffff0000u); }

struct EpiSlab {
    static constexpr bool PERM = true, AFTER_DRAIN = false, HOOK = false;
    bf16_t* O; size_t slab_stride; int qslab; float qscale;
    __device__ __forceinline__ void operator()(const f32x4 (&acc)[2][2][4][2], const Unit& u, int wr, int wc, int fr, int fq) const {
        const int slab = u.pn >> 1; bf16_t* base = O + (size_t)slab * slab_stride; const float sc = (slab == qslab) ? qscale : 1.f;
        const int row0 = u.pm * BM + wr * 64 + fr, col0 = (u.pn & 1) * 256 + wc * 32 + 8 * fq;
#pragma unroll
        for (int ai = 0; ai < 2; ++ai)
#pragma unroll
            for (int m = 0; m < 4; ++m) { bf16_t* rowp = base + (size_t)(row0 + ai * HALF + m * 16) * 512 + col0;
#pragma unroll
                for (int bj = 0; bj < 2; ++bj) { const f32x4 v0 = acc[ai][bj][m][0] * sc, v1 = acc[ai][bj][m][1] * sc;
                    u32x4 w; w.x = cvt_pk_bf16(v0[0], v0[1]); w.y = cvt_pk_bf16(v0[2], v0[3]); w.z = cvt_pk_bf16(v1[0], v1[1]); w.w = cvt_pk_bf16(v1[2], v1[3]);
                    *(u32x4*)(rowp + bj * HALF) = w; } }
    }
};
__device__ __forceinline__ size_t gate_img(int br, int pm, int pn, int piece, int wave, int lane) { return ((((size_t)(br * 512 + pm * 4 + pn) * 16 + piece) * 8 + wave) * 64 + lane) * 8; }
typedef unsigned u32x2g __attribute__((ext_vector_type(2)));
__device__ __forceinline__ float gate_val(float x, float c) { return __builtin_fmaxf(__builtin_fmaf(__builtin_amdgcn_rcpf(1.f + __builtin_amdgcn_exp2f(x * c)), 256.f, 0.5f), 1.f); }
__device__ __forceinline__ f32x4 ub4(unsigned w) { return (f32x4){(float)(w & 0xffu), (float)((w >> 8) & 0xffu), (float)((w >> 16) & 0xffu), (float)(w >> 24)}; }
struct EpiSig {
    static constexpr bool PERM = true, AFTER_DRAIN = false, HOOK = false;
    unsigned char* O; float in_scale;
    __device__ __forceinline__ void operator()(const f32x4 (&acc)[2][2][4][2], const Unit& u, int wr, int wc, int fr, int fq) const {
        const int br = u.pn >> 2, pn = u.pn & 3, wave = wr * 4 + wc, lane = fq * 16 + fr;
#pragma unroll
        for (int ai = 0; ai < 2; ++ai)
#pragma unroll
            for (int m = 0; m < 4; ++m)
#pragma unroll
                for (int bj = 0; bj < 2; ++bj) { const f32x4 v0 = acc[ai][bj][m][0], v1 = acc[ai][bj][m][1];
                    const float c = -1.4426950408889634f * in_scale; u32x2g w; w.x = 0u; w.y = 0u;
#pragma unroll
                    for (int j = 0; j < 4; ++j) { w.x = __builtin_amdgcn_cvt_pk_u8_f32(gate_val(v0[j], c), j, w.x); w.y = __builtin_amdgcn_cvt_pk_u8_f32(gate_val(v1[j], c), j, w.y); }
                    *(u32x2g*)(O + gate_img(br, u.pm, pn, ai * 8 + m * 2 + bj, wave, lane)) = w; }
    }
};
struct EpiMerge {
    static constexpr bool PERM = true, AFTER_DRAIN = false, HOOK = true;
    const unsigned char* G; bf16_t* O;
    __device__ __forceinline__ void hook(f32x4 (&acc)[2][2][4][2], const Unit& u, int t, int wr, int wc, int fr, int fq) const {
        const int i = (t >> 3) - 1; int lane = fq * 16 + fr; const int wave = wr * 4 + wc;
        asm volatile("" : "+v"(lane));
#pragma unroll
        for (int ai = 0; ai < 2; ++ai) {
            u32x2g ga[4][2], gb[4][2];
#pragma unroll
            for (int m = 0; m < 4; ++m)
#pragma unroll
                for (int bj = 0; bj < 2; ++bj) { ga[m][bj] = *(const u32x2g*)(G + gate_img(i, u.pm, u.pn, ai * 8 + m * 2 + bj, wave, lane)); gb[m][bj] = *(const u32x2g*)(G + gate_img(i + 1, u.pm, u.pn, ai * 8 + m * 2 + bj, wave, lane)); }
            __builtin_amdgcn_sched_barrier(0);
#pragma unroll
            for (int m = 0; m < 4; ++m)
#pragma unroll
                for (int bj = 0; bj < 2; ++bj) { const f32x4 a0 = ub4(ga[m][bj].x), a1 = ub4(ga[m][bj].y), b0 = ub4(gb[m][bj].x), b1 = ub4(gb[m][bj].y);
                    f32x4 r0, r1;
#pragma unroll
                    for (int j = 0; j < 4; ++j) { r0[j] = a0[j] * __builtin_amdgcn_rcpf(b0[j]); r1[j] = a1[j] * __builtin_amdgcn_rcpf(b1[j]); }
                    acc[ai][bj][m][0] *= r0; acc[ai][bj][m][1] *= r1; }
            __builtin_amdgcn_sched_barrier(0);
        }
    }
    __device__ __forceinline__ void operator()(const f32x4 (&acc)[2][2][4][2], const Unit& u, int wr, int wc, int fr, int fq) const {
        const int row0 = u.pm * BM + wr * 64 + fr, col0 = u.pn * BM + wc * 32 + 8 * fq, lane = fq * 16 + fr, wave = wr * 4 + wc;
        u32x2g g[2][4][2];
#pragma unroll
        for (int ai = 0; ai < 2; ++ai)
#pragma unroll
            for (int m = 0; m < 4; ++m)
#pragma unroll
                for (int bj = 0; bj < 2; ++bj) g[ai][m][bj] = *(const u32x2g*)(G + gate_img(2, u.pm, u.pn, ai * 8 + m * 2 + bj, wave, lane));
        __builtin_amdgcn_sched_barrier(0);
#pragma unroll
        for (int ai = 0; ai < 2; ++ai)
#pragma unroll
            for (int m = 0; m < 4; ++m) { const size_t off = (size_t)(row0 + ai * HALF + m * 16) * 1024 + col0;
#pragma unroll
                for (int bj = 0; bj < 2; ++bj) { const f32x4 g0 = ub4(g[ai][m][bj].x) * (1.f / 256.f), g1 = ub4(g[ai][m][bj].y) * (1.f / 256.f); const f32x4 v0 = acc[ai][bj][m][0] * g0, v1 = acc[ai][bj][m][1] * g1;
                    u32x4 w; w.x = cvt_pk_bf16(v0[0], v0[1]); w.y = cvt_pk_bf16(v0[2], v0[3]); w.z = cvt_pk_bf16(v1[0], v1[1]); w.w = cvt_pk_bf16(v1[2], v1[3]);
                    *(u32x4*)(O + off + bj * HALF) = w; } }
    }
};
struct EpiRes {
    static constexpr bool PERM = false, AFTER_DRAIN = false, HOOK = false;
    const float* base; float* out; int ldc; float in_scale = 1.f;
    __device__ __forceinline__ void operator()(const f32x4 (&acc)[2][2][4][2], const Unit& u, int wr, int wc, int fr, int fq) const {
        const int row0 = u.pm * BM + wr * 64 + fr, col0 = u.pn * BM + wc * 32 + 4 * fq;
#pragma unroll
        for (int ai = 0; ai < 2; ++ai) {
            f32x4 bs[4][2][2];
#pragma unroll
            for (int m = 0; m < 4; ++m)
#pragma unroll
                for (int bj = 0; bj < 2; ++bj)
#pragma unroll
                    for (int n = 0; n < 2; ++n) bs[m][bj][n] = *(const f32x4*)(base + (size_t)(row0 + ai * HALF + m * 16) * ldc + col0 + bj * HALF + n * 16);
            __builtin_amdgcn_sched_barrier(0);
#pragma unroll
            for (int m = 0; m < 4; ++m)
#pragma unroll
                for (int bj = 0; bj < 2; ++bj)
#pragma unroll
                    for (int n = 0; n < 2; ++n) *(f32x4*)(out + (size_t)(row0 + ai * HALF + m * 16) * ldc + col0 + bj * HALF + n * 16) = bs[m][bj][n] + acc[ai][bj][m][n] * in_scale;
            __builtin_amdgcn_sched_barrier(0);
        }
    }
};
template <bool BASE_F32> struct EpiResB {
    static constexpr bool PERM = true, AFTER_DRAIN = false, HOOK = false;
    const void* base; bf16_t* out;
    __device__ __forceinline__ void operator()(const f32x4 (&acc)[2][2][4][2], const Unit& u, int wr, int wc, int fr, int fq) const {
        const int row0 = u.pm * BM + wr * 64 + fr, col0 = u.pn * BM + wc * 32 + 8 * fq;
#pragma unroll
        for (int ai = 0; ai < 2; ++ai) {
            f32x4 b0[4][2], b1[4][2];
            if constexpr (BASE_F32) {
#pragma unroll
                for (int m = 0; m < 4; ++m)
#pragma unroll
                    for (int bj = 0; bj < 2; ++bj) { const float* p = (const float*)base + (size_t)(row0 + ai * HALF + m * 16) * 1024 + col0 + bj * HALF; b0[m][bj] = *(const f32x4*)p; b1[m][bj] = *(const f32x4*)(p + 4); }
            } else {
                u32x4 q[4][2];
#pragma unroll
                for (int m = 0; m < 4; ++m)
#pragma unroll
                    for (int bj = 0; bj < 2; ++bj) q[m][bj] = *(const u32x4*)((const bf16_t*)base + (size_t)(row0 + ai * HALF + m * 16) * 1024 + col0 + bj * HALF);
                __builtin_amdgcn_sched_barrier(0);
#pragma unroll
                for (int m = 0; m < 4; ++m)
#pragma unroll
                    for (int bj = 0; bj < 2; ++bj) { b0[m][bj] = (f32x4){bf_lo(q[m][bj].x), bf_hi(q[m][bj].x), bf_lo(q[m][bj].y), bf_hi(q[m][bj].y)}; b1[m][bj] = (f32x4){bf_lo(q[m][bj].z), bf_hi(q[m][bj].z), bf_lo(q[m][bj].w), bf_hi(q[m][bj].w)}; }
            }
            __builtin_amdgcn_sched_barrier(0);
#pragma unroll
            for (int m = 0; m < 4; ++m)
#pragma unroll
                for (int bj = 0; bj < 2; ++bj) { const f32x4 v0 = b0[m][bj] + acc[ai][bj][m][0], v1 = b1[m][bj] + acc[ai][bj][m][1];
                    u32x4 w; w.x = cvt_pk_bf16(v0[0], v0[1]); w.y = cvt_pk_bf16(v0[2], v0[3]); w.z = cvt_pk_bf16(v1[0], v1[1]); w.w = cvt_pk_bf16(v1[2], v1[3]);
                    *(u32x4*)(out + (size_t)(row0 + ai * HALF + m * 16) * 1024 + col0 + bj * HALF) = w; }
            __builtin_amdgcn_sched_barrier(0);
        }
    }
};
struct EpiSwiGLU {
    static constexpr bool PERM = true, AFTER_DRAIN = false, HOOK = false;
    bf16_t* O; int ldc;
    __device__ __forceinline__ void operator()(const f32x4 (&acc)[2][2][4][2], const Unit& u, int wr, int wc, int fr, int fq) const {
        const int row0 = u.pm * BM + wr * 64 + fr, col0 = u.pn * HALF + wc * 32 + 8 * fq;
#pragma unroll
        for (int ai = 0; ai < 2; ++ai)
#pragma unroll
            for (int m = 0; m < 4; ++m) { f32x4 v0, v1;
#pragma unroll
                for (int j = 0; j < 4; ++j) { const float g0 = acc[ai][0][m][0][j], g1 = acc[ai][0][m][1][j]; v0[j] = g0 * sigm(g0) * acc[ai][1][m][0][j]; v1[j] = g1 * sigm(g1) * acc[ai][1][m][1][j]; }
                u32x4 w; w.x = cvt_pk_bf16(v0[0], v0[1]); w.y = cvt_pk_bf16(v0[2], v0[3]); w.z = cvt_pk_bf16(v1[0], v1[1]); w.w = cvt_pk_bf16(v1[2], v1[3]);
                *(u32x4*)(O + (size_t)(row0 + ai * HALF + m * 16) * ldc + col0) = w; }
    }
};
struct EpiSwiGLU8 {
    static constexpr bool PERM = true, AFTER_DRAIN = false, HOOK = false;
    unsigned char* O; int ldc; float in_scale, out_scale;
    __device__ __forceinline__ void operator()(const f32x4 (&acc)[2][2][4][2], const Unit& u, int wr, int wc, int fr, int fq) const {
        const int row0 = u.pm * BM + wr * 64 + fr, col0 = u.pn * HALF + wc * 32 + 8 * fq; const float c1 = in_scale * in_scale * out_scale, c2 = -1.4426950408889634f * in_scale;
#pragma unroll
        for (int ai = 0; ai < 2; ++ai)
#pragma unroll
            for (int m = 0; m < 4; ++m) { f32x4 v0, v1;
#pragma unroll
                for (int j = 0; j < 4; ++j) { const float g0 = acc[ai][0][m][0][j], g1 = acc[ai][0][m][1][j];
                    v0[j] = (g0 * acc[ai][1][m][0][j]) * __builtin_amdgcn_rcpf(1.f + __builtin_amdgcn_exp2f(g0 * c2)) * c1; v1[j] = (g1 * acc[ai][1][m][1][j]) * __builtin_amdgcn_rcpf(1.f + __builtin_amdgcn_exp2f(g1 * c2)) * c1; }
                typedef unsigned u32x2_t __attribute__((ext_vector_type(2)));
                u32x2_t w; w.x = pack_fp8x4(v0[0], v0[1], v0[2], v0[3]); w.y = pack_fp8x4(v1[0], v1[1], v1[2], v1[3]);
                *(u32x2_t*)(O + (size_t)(row0 + ai * HALF + m * 16) * ldc + col0) = w; }
    }
};
struct EpiMoeDown {
    static constexpr bool PERM = true, AFTER_DRAIN = false, HOOK = false;
    bf16_t* Y; const int* row_tok; const float* row_g; float in_scale;
    __device__ __forceinline__ void operator()(const f32x4 (&acc)[2][2][4][2], const Unit& u, int wr, int wc, int fr, int fq) const {
        const int row0 = u.pm * BM + wr * 64 + fr, col0 = u.pn * BM + wc * 32 + 8 * fq;
#pragma unroll
        for (int ai = 0; ai < 2; ++ai)
#pragma unroll
            for (int m = 0; m < 4; ++m) { const int r = row0 + ai * HALF + m * 16; const int tok = row_tok[r]; const float g = row_g[r] * in_scale;
                if (tok >= 0) { bf16_t* p = Y + (size_t)tok * 1024 + col0;
#pragma unroll
                    for (int bj = 0; bj < 2; ++bj) { const f32x4 v0 = acc[ai][bj][m][0] * g, v1 = acc[ai][bj][m][1] * g;
                        u32x4 w; w.x = cvt_pk_bf16(v0[0], v0[1]); w.y = cvt_pk_bf16(v0[2], v0[3]); w.z = cvt_pk_bf16(v1[0], v1[1]); w.w = cvt_pk_bf16(v1[2], v1[3]);
                        *(u32x4*)(p + bj * HALF) = w; } } }
    }
};
struct MoeRange {
    int nM, nN, lo, hi; const PG8_LAS int* tile_e;
    __device__ void init(int nM_, int nN_, int lo_, int hi_, const PG8_LAS int* te) { nM = nM_; nN = nN_; lo = lo_; hi = hi_; tile_e = te; }
    __device__ bool next(int i, Unit& u) const {
        const int wgid = lo + i; if (wgid >= hi) return false;
        const int nig = WGM * nN, gid = wgid / nig, fm = gid * WGM, gsz = (nM - fm) < WGM ? (nM - fm) : WGM;
        u.pm = fm + ((wgid % nig) % gsz); u.pn = (wgid % nig) / gsz;
        const int e = __builtin_amdgcn_readfirstlane(tile_e[u.pm]); u.pb = e * nN + u.pn; return true;
    }
    __device__ __forceinline__ void a_ready(const Unit&) const {}
    __device__ __forceinline__ void done(const Unit&) const {}
};
struct MoeOrder {
    int nM, nN, nwg, G, c; const PG8_LAS int* tile_e;
    __device__ void init(int nM_, int nN_, int G_, int c_, const PG8_LAS int* te) { nM = nM_; nN = nN_; nwg = nM * nN; G = G_; c = c_; tile_e = te; }
    __device__ bool next(int i, Unit& u) const {
        const long L = (long)i * G + c; if (L >= nwg) return false;
        int wgid = (int)L; { const int q = nwg / NXCD, r = nwg % NXCD, xcd = wgid % NXCD, off = wgid / NXCD; wgid = (xcd < r ? xcd * (q + 1) : r * (q + 1) + (xcd - r) * q) + off; }
        const int nig = WGM * nN, gid = wgid / nig, fm = gid * WGM, gsz = (nM - fm) < WGM ? (nM - fm) : WGM;
        u.pm = fm + ((wgid % nig) % gsz); u.pn = (wgid % nig) / gsz;
        const int e = __builtin_amdgcn_readfirstlane(tile_e[u.pm]); u.pb = e * nN + u.pn; return true;
    }
    __device__ __forceinline__ void a_ready(const Unit&) const {}
    __device__ __forceinline__ void done(const Unit&) const {}
};
template <class Epi, class Sched, bool ALIGN_EPI = false, bool SP2 = false, bool FP8 = false>
__device__ __forceinline__ void gemm_phase(PG8_LAS unsigned char* lds, const Gemm g, const Sched& S, const Epi& E) {
    int tid_ = threadIdx.x; asm volatile("" : "+v"(tid_));
    const int tid = tid_, wid = __builtin_amdgcn_readfirstlane(tid >> 6), lane = tid & 63, wr = wid >> 2, wc = wid & 3, fr = lane & 15, fq = lane >> 4;
    const int K = g.K, nt = K / BK;
    unsigned voffA[2], voffB[2];
#pragma unroll
    for (int i = 0; i < 2; ++i) { int R, C; stage_rc(tid * 16 + i * 8192, R, C); const int Rb = Epi::PERM ? ((R & ~31) + perm32(R & 31)) : R;
        voffA[i] = (unsigned)(R * K + C) * 2u; voffB[i] = (unsigned)(Rb * K + C) * 2u; }
    const size_t kstep = (size_t)(BK * 2);
    const size_t hstep = (size_t)HALF * K * 2;
    const size_t tstep = 2 * hstep;
    const unsigned ldsw = (unsigned)wid * 1024u;
    const int aoff = lds_byte(wr * 64 + fr, fq * 8), boff = lds_byte(wc * 32 + fr, fq * 8);
#define PG8_SA(b, h) (((b) * 2 + (h)) * HTB)
#define PG8_SB(b, h) ((4 + (b) * 2 + (h)) * HTB)
#define PG8_STAGE(bufoff, gbase, voff) do { _Pragma("unroll") for (int _i = 0; _i < 2; ++_i) \
        __builtin_amdgcn_global_load_lds((const unsigned*)((const char*)(gbase) + (voff)[_i]), (PG8_LAS unsigned*)(lds + (bufoff) + ldsw + _i * 8192), 16, 0, 0); } while (0)
#define PG8_LDA(dst, b, h) do { _Pragma("unroll") for (int m = 0; m < 4; ++m) _Pragma("unroll") for (int k = 0; k < 2; ++k) dst[m][k] = *(const PG8_LAS bf16x8*)(lds + PG8_SA(b, h) + aoff + m * 2048 + k * 1024); } while (0)
#define PG8_LDB(dst, b, h) do { _Pragma("unroll") for (int n = 0; n < 2; ++n) _Pragma("unroll") for (int k = 0; k < 2; ++k) dst[n][k] = *(const PG8_LAS bf16x8*)(lds + PG8_SB(b, h) + boff + n * 2048 + k * 1024); } while (0)
#define PG8_MMA(ai, bj, At, Bt) do { __builtin_amdgcn_s_setprio(1); \
        if constexpr (FP8) { _Pragma("unroll") for (int m = 0; m < 4; ++m) _Pragma("unroll") for (int n = 0; n < 2; ++n) \
            asm volatile("v_mfma_f32_16x16x128_f8f6f4 %0, %1, %2, %0" : "+v"(acc[ai][bj][m][n]) : "v"(cat8(Bt[n][0], Bt[n][1])), "v"(cat8(At[m][0], At[m][1]))); } \
        else { _Pragma("unroll") for (int m = 0; m < 4; ++m) _Pragma("unroll") for (int n = 0; n < 2; ++n) _Pragma("unroll") for (int k = 0; k < 2; ++k) \
            acc[ai][bj][m][n] = __builtin_amdgcn_mfma_f32_16x16x32_bf16(Bt[n][k], At[m][k], acc[ai][bj][m][n], 0, 0, 0); } \
        __builtin_amdgcn_s_setprio(0); } while (0)
#define PG8_WAIT_V(n) asm volatile("s_waitcnt vmcnt(" #n ")" ::: "memory")
#define PG8_WAIT_L(n) asm volatile("s_waitcnt lgkmcnt(" #n ")" ::: "memory")
#define PG8_BAR __builtin_amdgcn_s_barrier()
#define PG8_SCHED __builtin_amdgcn_sched_barrier(0)
    Unit cur, nxt; int ui = 0;
    if (!S.next(0, cur)) return;
    f32x4 acc[2][2][4][2];
#pragma unroll
    for (int a = 0; a < 2; ++a)
#pragma unroll
        for (int b = 0; b < 2; ++b)
#pragma unroll
            for (int m = 0; m < 4; ++m)
#pragma unroll
                for (int n = 0; n < 2; ++n) acc[a][b][m][n] = (f32x4){0.f, 0.f, 0.f, 0.f};
    bf16x8 At[4][2], B0[2][2], B1[2][2];
    const char* cA = (const char*)g.A + (size_t)cur.pm * tstep; const char* cB = (const char*)g.Bt + (size_t)cur.pb * tstep;
    S.a_ready(cur);
    if constexpr (SP2) {
        PG8_STAGE(PG8_SB(0, 0), cB, voffB); PG8_STAGE(PG8_SB(0, 1), cB + hstep, voffB); PG8_STAGE(PG8_SA(0, 0), cA, voffA); PG8_STAGE(PG8_SA(0, 1), cA + hstep, voffA);
        if (wr == 1) PG8_BAR;
        PG8_WAIT_V(2); PG8_BAR;
        PG8_STAGE(PG8_SB(1, 0), cB + kstep, voffB); PG8_STAGE(PG8_SA(1, 0), cA + kstep, voffA); PG8_STAGE(PG8_SB(1, 1), cB + hstep + kstep, voffB);
        PG8_WAIT_V(6); PG8_BAR;
    } else {
        PG8_STAGE(PG8_SB(0, 0), cB, voffB); PG8_STAGE(PG8_SA(0, 0), cA, voffA); PG8_STAGE(PG8_SB(0, 1), cB + hstep, voffB); PG8_STAGE(PG8_SA(0, 1), cA + hstep, voffA);
        if (wr == 1) PG8_BAR;
        PG8_WAIT_V(4); PG8_BAR;
        PG8_STAGE(PG8_SB(1, 0), cB + kstep, voffB); PG8_STAGE(PG8_SA(1, 0), cA + kstep, voffA); PG8_STAGE(PG8_SB(1, 1), cB + hstep + kstep, voffB);
        PG8_WAIT_V(6); PG8_BAR;
    }
    for (;;) {
        const bool has_next = S.next(ui + 1, nxt);
        const char* nA = has_next ? (const char*)g.A + (size_t)nxt.pm * tstep : cA; const char* nB = has_next ? (const char*)g.Bt + (size_t)nxt.pb * tstep : cB;
        for (int t = 0; t < nt; t += 2) {
            if constexpr (Epi::HOOK) { if (t == 8 || t == 16) E.hook(acc, cur, t, wr, wc, fr, fq); }
            const bool last = (t == nt - 2);
            const char* a1 = cA + (size_t)(t + 1) * kstep;
            const char* a2 = last ? nA : cA + (size_t)(t + 2) * kstep; const char* b2 = last ? nB : cB + (size_t)(t + 2) * kstep;
            const char* a3 = a2 + kstep; const char* b3 = b2 + kstep;
            if (last && has_next) S.a_ready(nxt);
            if constexpr (SP2) {
            PG8_LDB(B0, 0, 0); PG8_LDB(B1, 0, 1); PG8_SCHED; PG8_LDA(At, 0, 0); PG8_STAGE(PG8_SA(1, 1), a1 + hstep, voffA);
            PG8_WAIT_V(8); PG8_WAIT_L(0); PG8_BAR; PG8_MMA(0, 0, At, B0); PG8_MMA(0, 1, At, B1); PG8_BAR; PG8_SCHED;
            PG8_LDA(At, 0, 1); PG8_STAGE(PG8_SB(0, 0), b2, voffB); PG8_STAGE(PG8_SB(0, 1), b2 + hstep, voffB); PG8_STAGE(PG8_SA(0, 0), a2, voffA);
            PG8_WAIT_V(8); PG8_WAIT_L(0); PG8_BAR; PG8_MMA(1, 0, At, B0); PG8_MMA(1, 1, At, B1); PG8_BAR; PG8_SCHED;
            PG8_LDB(B0, 1, 0); PG8_LDB(B1, 1, 1); PG8_SCHED; PG8_LDA(At, 1, 0); PG8_STAGE(PG8_SA(0, 1), a2 + hstep, voffA);
            PG8_WAIT_V(8); PG8_WAIT_L(0); PG8_BAR; PG8_MMA(0, 0, At, B0); PG8_MMA(0, 1, At, B1); PG8_BAR; PG8_SCHED;
            PG8_LDA(At, 1, 1); PG8_STAGE(PG8_SB(1, 0), b3, voffB); PG8_STAGE(PG8_SB(1, 1), b3 + hstep, voffB); PG8_STAGE(PG8_SA(1, 0), a3, voffA);
            PG8_WAIT_V(8); PG8_WAIT_L(0); PG8_BAR; PG8_MMA(1, 0, At, B0); PG8_MMA(1, 1, At, B1); PG8_BAR; PG8_SCHED;
            } else {
            PG8_LDB(B0, 0, 0); PG8_SCHED; PG8_LDA(At, 0, 0); PG8_STAGE(PG8_SA(1, 1), a1 + hstep, voffA);
            PG8_WAIT_L(8); PG8_BAR; PG8_WAIT_L(0); PG8_MMA(0, 0, At, B0); PG8_BAR; PG8_SCHED;
            PG8_LDB(B1, 0, 1); PG8_STAGE(PG8_SB(0, 0), b2, voffB);
            PG8_BAR; PG8_WAIT_L(0); PG8_MMA(0, 1, At, B1); PG8_BAR;
            PG8_LDA(At, 0, 1); PG8_STAGE(PG8_SA(0, 0), a2, voffA);
            PG8_BAR; PG8_WAIT_L(0); PG8_MMA(1, 0, At, B0); PG8_BAR; PG8_SCHED;
            PG8_STAGE(PG8_SB(0, 1), b2 + hstep, voffB);
            PG8_WAIT_V(6); PG8_BAR; PG8_MMA(1, 1, At, B1); PG8_BAR;
            PG8_LDB(B0, 1, 0); PG8_SCHED; PG8_LDA(At, 1, 0); PG8_STAGE(PG8_SA(0, 1), a2 + hstep, voffA);
            PG8_WAIT_L(8); PG8_BAR; PG8_WAIT_L(0); PG8_MMA(0, 0, At, B0); PG8_BAR; PG8_SCHED;
            PG8_LDB(B1, 1, 1); PG8_STAGE(PG8_SB(1, 0), b3, voffB);
            PG8_BAR; PG8_WAIT_L(0); PG8_MMA(0, 1, At, B1); PG8_BAR;
            PG8_LDA(At, 1, 1); PG8_STAGE(PG8_SA(1, 0), a3, voffA);
            PG8_BAR; PG8_WAIT_L(0); PG8_MMA(1, 0, At, B0); PG8_BAR; PG8_SCHED;
            PG8_STAGE(PG8_SB(1, 1), b3 + hstep, voffB);
            PG8_WAIT_V(6); PG8_BAR; PG8_MMA(1, 1, At, B1); PG8_BAR;
            }
        }
        if constexpr (ALIGN_EPI) { if (wr == 0) PG8_BAR; }
        if constexpr (FP8) {
            asm volatile("s_nop 15\n\ts_nop 15" : "+v"(acc[0][0][0][0]), "+v"(acc[0][0][0][1]), "+v"(acc[0][0][1][0]), "+v"(acc[0][0][1][1]), "+v"(acc[0][0][2][0]), "+v"(acc[0][0][2][1]), "+v"(acc[0][0][3][0]), "+v"(acc[0][0][3][1]));
            asm volatile("" : "+v"(acc[0][1][0][0]), "+v"(acc[0][1][0][1]), "+v"(acc[0][1][1][0]), "+v"(acc[0][1][1][1]), "+v"(acc[0][1][2][0]), "+v"(acc[0][1][2][1]), "+v"(acc[0][1][3][0]), "+v"(acc[0][1][3][1]));
            asm volatile("" : "+v"(acc[1][0][0][0]), "+v"(acc[1][0][0][1]), "+v"(acc[1][0][1][0]), "+v"(acc[1][0][1][1]), "+v"(acc[1][0][2][0]), "+v"(acc[1][0][2][1]), "+v"(acc[1][0][3][0]), "+v"(acc[1][0][3][1]));
            asm volatile("" : "+v"(acc[1][1][0][0]), "+v"(acc[1][1][0][1]), "+v"(acc[1][1][1][0]), "+v"(acc[1][1][1][1]), "+v"(acc[1][1][2][0]), "+v"(acc[1][1][2][1]), "+v"(acc[1][1][3][0]), "+v"(acc[1][1][3][1])); }
        if constexpr (!Epi::AFTER_DRAIN) { E(acc, cur, wr, wc, fr, fq); S.done(cur); }
        if (!has_next) break;
#pragma unroll
        for (int a = 0; a < 2; ++a)
#pragma unroll
            for (int b = 0; b < 2; ++b)
#pragma unroll
                for (int m = 0; m < 4; ++m)
#pragma unroll
                    for (int n = 0; n < 2; ++n) acc[a][b][m][n] = (f32x4){0.f, 0.f, 0.f, 0.f};
        cur = nxt; cA = nA; cB = nB; ++ui;
        if constexpr (ALIGN_EPI) { if (wr == 1) PG8_BAR; }
    }
    PG8_WAIT_V(0);
    if constexpr (!ALIGN_EPI) { if (wr == 0) PG8_BAR; }
    PG8_BAR;
    if constexpr (Epi::AFTER_DRAIN) { E.fused(acc, cur, wr, wc, fr, fq, lds, wid, lane); S.done(cur); }
#undef PG8_SA
#undef PG8_SB
#undef PG8_STAGE
#undef PG8_LDA
#undef PG8_LDB
#undef PG8_MMA
#undef PG8_WAIT_V
#undef PG8_WAIT_L
#undef PG8_BAR
#undef PG8_SCHED
}
}
#include <hip/hip_bf16.h>
#include <cmath>
namespace attn_body {
using bf16=__hip_bfloat16;
using bf16x8=__attribute__((ext_vector_type(8)))short;
using s16x4=__attribute__((ext_vector_type(4)))short;
using f32x16=__attribute__((ext_vector_type(16)))float;
using u32x4=__attribute__((ext_vector_type(4)))unsigned;
constexpr int BATCH=4,NHEAD=8,SEQ=8192,D=64,DM=NHEAD*D,DMO=1536,OCOL=1024;
constexpr int NW=8,QBLK=32,QB=QBLK*NW,KVBLK=64,NQB=SEQ/QB;
constexpr int ATTN_PITCH=DM, ATTN_UNIT_ROWS=QB;
__device__ __forceinline__ int crow(int r,int hi){return (r&3)+8*(r>>2)+4*hi;}
#define SBAR() __builtin_amdgcn_sched_barrier(0)
__device__ __forceinline__ void cmask(f32x16&p0,f32x16&p1,int jb,int qrel,int hi){
  const float NEG=-INFINITY; int kb=64*jb+4*hi;
  #pragma unroll
  for(int r=0;r<16;++r){int kv=kb+(r&3)+8*(r>>2); if(kv>qrel)p0[r]=NEG; if(kv+32>qrel)p1[r]=NEG;}
}

constexpr int NSLOT=3, SLOTB=8192;
constexpr int LDS_K=0, LDS_V=NSLOT*SLOTB, LDS_WS=2*NSLOT*SLOTB, LDS_OST=LDS_WS+NW*64*4, LDS_NB=LDS_OST+NW*4096, LDS_BYTES=LDS_NB+SEQ*4;
constexpr float C2=0.125f*1.4426950408889634f;
__device__ __forceinline__ void glds16(const void*gsrc,unsigned lds_dst){unsigned keep;
  asm volatile("s_mov_b32 %0, m0\n\ts_mov_b32 m0, %2\n\ts_nop 0\n\tglobal_load_lds_dwordx4 %1, off\n\ts_mov_b32 m0, %0":"=&s"(keep):"v"(gsrc),"s"(lds_dst):"memory");}
__device__ __forceinline__ float max3f(float a,float b,float c){float r;asm("v_max3_f32 %0, %1, %2, %3":"=v"(r):"v"(a),"v"(b),"v"(c));return r;}
__device__ __forceinline__ float max2f(float a,float b){float r;asm("v_max_f32_e32 %0, %1, %2":"=v"(r):"v"(a),"v"(b));return r;}
__device__ __forceinline__ float fadd_s(float a,float b){float r;asm("v_add_f32_e32 %0, %1, %2":"=v"(r):"v"(a),"v"(b));return r;}
__device__ __forceinline__ float fsub_s(float a,float b){float r;asm("v_sub_f32_e32 %0, %1, %2":"=v"(r):"v"(a),"v"(b));return r;}
typedef float f32x2_t __attribute__((ext_vector_type(2))); typedef __bf16 bf16x2_t __attribute__((ext_vector_type(2)));
__device__ __forceinline__ unsigned cvtpk_s(float lo,float hi){f32x2_t v={lo,hi};bf16x2_t b=__builtin_convertvector(v,bf16x2_t);return __builtin_bit_cast(unsigned,b);}
#define WAIT_BAR(N) asm volatile("s_waitcnt vmcnt(" #N ") lgkmcnt(0)\n\ts_barrier":::"memory")

__device__ __forceinline__ void qkt(f32x16&p0,f32x16&p1,const char*Kslot,const bf16x8*qr,int r32,int hi){
  const char*kb=Kslot+hi*1024+r32*16;
  #pragma unroll
  for(int d0=0;d0<4;++d0){
    const bf16x8 b0=*reinterpret_cast<const bf16x8*>(kb+d0*2048);
    const bf16x8 b1=*reinterpret_cast<const bf16x8*>(kb+d0*2048+512);
    p0=__builtin_amdgcn_mfma_f32_32x32x16_bf16(b0,qr[d0],p0,0,0,0);p1=__builtin_amdgcn_mfma_f32_32x32x16_bf16(b1,qr[d0],p1,0,0,0);}
}
typedef __attribute__((address_space(3))) const char* lds_cptr;
typedef short v4i16_t __attribute__((ext_vector_type(4)));
__device__ __forceinline__ void kload8(bf16x8*kf,lds_cptr kp){
  kf[0]=*(const __attribute__((address_space(3))) bf16x8*)(kp);      kf[1]=*(const __attribute__((address_space(3))) bf16x8*)(kp+512);
  kf[2]=*(const __attribute__((address_space(3))) bf16x8*)(kp+2048); kf[3]=*(const __attribute__((address_space(3))) bf16x8*)(kp+2560);
  kf[4]=*(const __attribute__((address_space(3))) bf16x8*)(kp+4096); kf[5]=*(const __attribute__((address_space(3))) bf16x8*)(kp+4608);
  kf[6]=*(const __attribute__((address_space(3))) bf16x8*)(kp+6144); kf[7]=*(const __attribute__((address_space(3))) bf16x8*)(kp+6656);
}
__device__ __forceinline__ void kload2(bf16x8*kf,lds_cptr kp,int j){ kf[2*j]=*(const __attribute__((address_space(3))) bf16x8*)(kp+j*2048); kf[2*j+1]=*(const __attribute__((address_space(3))) bf16x8*)(kp+j*2048+512); }
__device__ __forceinline__ s16x4 vtr(lds_cptr p){ return __builtin_bit_cast(s16x4,__builtin_amdgcn_ds_read_tr16_b64_v4i16((__attribute__((address_space(3))) v4i16_t*)p)); }
__device__ __forceinline__ float rowmax(const f32x16&p0,const f32x16&p1){
  float a=max3f(p0[0],p0[1],p1[0]),b=max3f(p0[2],p0[3],p1[1]);a=max3f(a,p1[2],p1[3]);
  #pragma unroll
  for(int r=4;r<16;r+=4){a=max3f(a,p0[r],p0[r+1]);b=max3f(b,p0[r+2],p0[r+3]);a=max3f(a,p1[r],p1[r+1]);b=max3f(b,p1[r+2],p1[r+3]);}
  const float m=max2f(a,b);
  auto rr=__builtin_amdgcn_permlane32_swap(__float_as_uint(m),__float_as_uint(m),false,false);
  return max2f(__uint_as_float(rr[0]),__uint_as_float(rr[1]));
}
__device__ __forceinline__ void pv(f32x16*o,int vb,bf16x8 pa0,bf16x8 pa1,bf16x8 pa2,bf16x8 pa3){
  #pragma unroll
  for(int d0=0;d0<2;++d0){s16x4 lo[4],hi[4];
    #pragma unroll
    for(int ks=0;ks<4;++ks){
      asm volatile("ds_read_b64_tr_b16 %0,%1 offset:%c2":"=&v"(lo[ks]):"v"(vb),"i"(d0*4096+ks*1024):"memory");
      asm volatile("ds_read_b64_tr_b16 %0,%1 offset:%c2":"=&v"(hi[ks]):"v"(vb),"i"(d0*4096+ks*1024+512):"memory");}
    asm volatile("s_waitcnt lgkmcnt(0)":::"memory");SBAR();
    #define PK(k) (bf16x8){lo[k][0],lo[k][1],lo[k][2],lo[k][3],hi[k][0],hi[k][1],hi[k][2],hi[k][3]}
    o[d0]=__builtin_amdgcn_mfma_f32_32x32x16_bf16(pa0,PK(0),o[d0],0,0,0);
    o[d0]=__builtin_amdgcn_mfma_f32_32x32x16_bf16(pa1,PK(1),o[d0],0,0,0);
    o[d0]=__builtin_amdgcn_mfma_f32_32x32x16_bf16(pa2,PK(2),o[d0],0,0,0);
    o[d0]=__builtin_amdgcn_mfma_f32_32x32x16_bf16(pa3,PK(3),o[d0],0,0,0);
    #undef PK
  }
}

#ifndef ATTN_STORE16
#define ATTN_STORE16(p,v) (*(u32x4*)(p)=(v))
#endif
typedef float f32x4v __attribute__((ext_vector_type(4)));
__device__ __forceinline__ int attn_t0(int qb,const float*__restrict__ nbg,const float*__restrict__ qnw,const float*__restrict__ knw,const float*__restrict__ xmw,int lane){
  const int q0=qb*QB; float qn=0.f,kn=0.f,xm=3.0e38f; if(lane<8){qn=qnw[qb*8+lane];xm=xmw[qb*8+lane];}
  _Pragma("unroll") for(int i=0;i<4;++i){const int idx=lane*4+i; if(idx<(qb+1)*8)kn=__builtin_fmaxf(kn,knw[idx]);}
  _Pragma("unroll") for(int o_=1;o_<64;o_<<=1){qn=__builtin_fmaxf(qn,__shfl_xor(qn,o_));kn=__builtin_fmaxf(kn,__shfl_xor(kn,o_));xm=__builtin_fminf(xm,__shfl_xor(xm,o_));}
  const float thr=56.f+sqrtf(qn*kn)-xm; const int NT0=(q0+QB)/KVBLK;
  bool c_=(lane>=1)&&(2*lane<=NT0-4); float d_=0.f; if(c_)d_=nbg[128*lane-1]-nbg[q0]; c_=c_&&(d_<=-thr);
  return __builtin_amdgcn_readfirstlane(2*(int)__popcll(__ballot(c_)));
}
template<int THRL> __device__ __forceinline__ void attn_unit(int b,int h,int qb,const bf16*Q,const bf16*__restrict__ K,const bf16*__restrict__ V,bf16*O,const float*__restrict__ nbg,const int t0,char*shm){
  int tid_=threadIdx.x; asm volatile("":"+v"(tid_));
  const int tid=tid_,lane=tid&63,r32=lane&31,hi=lane>>5; const int wid=__builtin_amdgcn_readfirstlane(tid>>6);
  const long rowbase=(long)b*SEQ; const int q0=qb*QB;
  const bf16*Qw=Q+(rowbase+q0+wid*QBLK)*DM+h*D;
  const bf16*Kh=K+(rowbase+(long)t0*KVBLK)*DM+h*D,*Vh=V+(rowbase+(long)t0*KVBLK)*DM+h*D;
  const unsigned lds0=(unsigned)(uintptr_t)shm;
  float*wsf=(float*)(shm+LDS_WS)+wid*64;
  const bf16*ksrc=Kh+(long)lane*DM+wid*8;
  const bf16*vsrc=Vh+(long)(16*(wid&3)+(lane>>2))*DM+(wid>>2)*32+(lane&3)*8;
  const unsigned kdst=lds0+LDS_K+wid*1024, vdst=lds0+LDS_V+wid*1024;
  #define DMA_K(t,slot) glds16(ksrc+(long)(t)*KVBLK*DM,(unsigned)__builtin_amdgcn_readfirstlane(kdst+(slot)))
  #define DMA_V(t,slot) glds16(vsrc+(long)(t)*KVBLK*DM,(unsigned)__builtin_amdgcn_readfirstlane(vdst+(slot)))
  const int vb0=(int)(lds0+LDS_V)+((lane>>4)&1)*32+(lane&3)*8+(4*hi+((lane&15)>>2))*64;
  const char*Kbase=shm+LDS_K; bf16x8 kf[8];
  const lds_cptr shm3=(lds_cptr)shm; const lds_cptr kp0=shm3+LDS_K+hi*1024+r32*16; const lds_cptr vp0=shm3+LDS_V+((lane>>4)&1)*32+(lane&3)*8+(4*hi+((lane&15)>>2))*64;
  const int NT=(q0+QB)/KVBLK-t0;
  typedef __attribute__((address_space(3))) float* lds_fptr;
  const lds_fptr nbl3=(lds_fptr)(shm3+LDS_NB);
  const lds_fptr nbl3o=nbl3+t0*KVBLK;
  DMA_K(0,0);DMA_V(0,0);DMA_K(1,SLOTB);
  { const float ref=nbg[q0+QB-1]; for(int j=t0*KVBLK+tid;j<q0+QB;j+=NW*64) nbl3[j]=nbg[j]-ref; }
  bf16x8 qr[4];
  #pragma unroll
  for(int d0=0;d0<4;++d0)qr[d0]=*reinterpret_cast<const bf16x8*>(&Qw[(long)r32*DM+d0*16+hi*8]);
  float mhat=0.f,l_reg=0.f;f32x16 o[2];o[0]=f32x16{};o[1]=f32x16{};
  const int qrel=wid*QBLK+r32;
  #define CMASK(P0,P1,t) do{int jb_=(t)-(NT-4); if(jb_>=0)cmask(P0,P1,jb_,qrel,hi);}while(0)
  bool resc=false;
  #define START(P0,P1) do{ const float rm=rowmax(P0,P1); resc=false; \
    if(__any(rm>(float)THRL)){ const float dl=__builtin_fmaxf(rm,0.f); mhat=fadd_s(mhat,dl); \
      _Pragma("unroll") for(int r=0;r<16;++r){P0[r]=fsub_s(P0[r],dl);P1[r]=fsub_s(P1[r],dl);} } \
    _Pragma("unroll") for(int r=0;r<16;++r)P0[r]=__builtin_amdgcn_exp2f(P0[r]); }while(0)
  #define BIAS(P0,P1,t) do{ const lds_fptr nbp_=nbl3o+64*(t)+4*hi; \
    _Pragma("unroll") for(int q_=0;q_<4;++q_){ const f32x4v b0_=*(const __attribute__((address_space(3))) f32x4v*)(nbp_+8*q_), b1_=*(const __attribute__((address_space(3))) f32x4v*)(nbp_+32+8*q_); \
      _Pragma("unroll") for(int i_=0;i_<4;++i_){ P0[4*q_+i_]=b0_[i_]-mhat; P1[4*q_+i_]=b1_[i_]-mhat; } } }while(0)
  #define RESC() do{ if(resc){ asm volatile("s_waitcnt lgkmcnt(0)":::"memory"); \
      _Pragma("unroll") for(int d_=0;d_<2;++d_) _Pragma("unroll") for(int r=0;r<16;++r)o[d_][r]*=wsf[crow(r,hi)]; } }while(0)
  f32x16 pA0,pA1,pB0,pB1;
  int sl_prev=0,sl_cur=0,sl_next=SLOTB;
  #define ROT() do{sl_prev=sl_cur;sl_cur=sl_next;sl_next=(sl_next==(NSLOT-1)*SLOTB)?0:sl_next+SLOTB;}while(0)
  DMA_K(2,2*SLOTB);
  WAIT_BAR(3);
  mhat=nbl3[q0+qrel];
  BIAS(pA0,pA1,0);qkt(pA0,pA1,Kbase,qr,r32,hi);asm volatile("s_nop 15\n\ts_nop 7":"+v"(pA0),"+v"(pA1));CMASK(pA0,pA1,0);
  START(pA0,pA1);
  _Pragma("unroll") for(int r=0;r<16;++r)pA1[r]=__builtin_amdgcn_exp2f(pA1[r]);
  WAIT_BAR(0);
  DMA_K(3,0);DMA_V(1,SLOTB);
  ROT();
  kload8(kf,kp0+sl_cur);
  WAIT_BAR(2);
  s16x4 vlo[8],vhi[8]; u32x4 pw0,pw1,pw2,pw3;
  #define PKW(P,B) cvtpk_s(P[B],P[B+1])
  #define PAF(k) __builtin_bit_cast(bf16x8,pw##k)
  #define VFR(i) (bf16x8){vlo[i][0],vlo[i][1],vlo[i][2],vlo[i][3],vhi[i][0],vhi[i][1],vhi[i][2],vhi[i][3]}
  #define PIN(x) asm volatile("":"+v"(x))
  #define MX3(a,b,c) __builtin_fmaxf(__builtin_fmaxf((a),(b)),(c))
  #define GAPA(MF,A0,A1,A2,A3,W0,W1,PW) do{ MF; sacc+=A0; sacc+=A1; sacc+=A2; sacc+=A3; PIN(sacc); W0; W1; PIN(PW); SBAR(); }while(0)
  #define EX(v) __builtin_amdgcn_exp2f(v)
  #define GAPB(MF,X,B) do{ MF; X[B]=EX(X[B]); X[B+1]=EX(X[B+1]); X[B+2]=EX(X[B+2]); X[B+3]=EX(X[B+3]); PIN(X); SBAR(); }while(0)
  #define VRD(i) do{ vlo[i]=vtr(vp_+(((i)>>2)*4096+((i)&3)*1024)); vhi[i]=vtr(vp_+(((i)>>2)*4096+((i)&3)*1024+512)); }while(0)
  #define KRD(G,j) do{ if(G){ kload2(kf,kp0+sl_next,j); SBAR(); } }while(0)
  #define STEP(C0,C1,P0,P1,t,GK,GV,GL) do{ SBAR(); \
    const lds_cptr vp_=vp0+sl_prev; \
    BIAS(C0,C1,t); SBAR(); \
    VRD(0); SBAR(); float sacc=(P0[0]+P0[1]); \
    GAPA(C0=__builtin_amdgcn_mfma_f32_32x32x16_bf16(kf[0],qr[0],C0,0,0,0), P0[2],P0[3],P0[4],P0[5],     pw0[0]=PKW(P0,0), pw0[1]=PKW(P0,2), pw0); \
    VRD(4); SBAR(); GAPA(C1=__builtin_amdgcn_mfma_f32_32x32x16_bf16(kf[1],qr[0],C1,0,0,0), P0[6],P0[7],P0[8],P0[9],     pw0[2]=PKW(P0,4), pw0[3]=PKW(P0,6), pw0); \
    VRD(1); SBAR(); GAPA(C0=__builtin_amdgcn_mfma_f32_32x32x16_bf16(kf[2],qr[1],C0,0,0,0),   P0[10],P0[11],P0[12],P0[13], pw1[0]=PKW(P0,8), pw1[1]=PKW(P0,10), pw1); \
    VRD(5); SBAR(); GAPA(C1=__builtin_amdgcn_mfma_f32_32x32x16_bf16(kf[3],qr[1],C1,0,0,0),   P0[14],P0[15],P1[0],P1[1],   pw1[2]=PKW(P0,12),pw1[3]=PKW(P0,14), pw1); \
    VRD(2); SBAR(); GAPA(C0=__builtin_amdgcn_mfma_f32_32x32x16_bf16(kf[4],qr[2],C0,0,0,0),   P1[2],P1[3],P1[4],P1[5],     pw2[0]=PKW(P1,0), pw2[1]=PKW(P1,2), pw2); \
    VRD(6); SBAR(); GAPA(C1=__builtin_amdgcn_mfma_f32_32x32x16_bf16(kf[5],qr[2],C1,0,0,0),   P1[6],P1[7],P1[8],P1[9],     pw2[2]=PKW(P1,4), pw2[3]=PKW(P1,6), pw2); \
    VRD(3); SBAR(); GAPA(C0=__builtin_amdgcn_mfma_f32_32x32x16_bf16(kf[6],qr[3],C0,0,0,0),   P1[10],P1[11],P1[12],P1[13], pw3[0]=PKW(P1,8), pw3[1]=PKW(P1,10), pw3); \
    VRD(7); SBAR(); GAPA(C1=__builtin_amdgcn_mfma_f32_32x32x16_bf16(kf[7],qr[3],C1,0,0,0),   P1[14],P1[15],0.f,0.f,       pw3[2]=PKW(P1,12),pw3[3]=PKW(P1,14), pw3); \
    l_reg+=sacc; \
    if(GK){DMA_K((t)+3,sl_cur);} if(GV){DMA_V((t)+1,sl_next);} \
    CMASK(C0,C1,t); \
    { float a=MX3(C0[0],C0[1],C1[0]),b=MX3(C0[2],C0[3],C1[1]); a=MX3(a,C1[2],C1[3]); \
      _Pragma("unroll") for(int r=4;r<16;r+=4){a=MX3(a,C0[r],C0[r+1]);b=MX3(b,C0[r+2],C0[r+3]);a=MX3(a,C1[r],C1[r+1]);b=MX3(b,C1[r+2],C1[r+3]);} \
      float rm=__builtin_fmaxf(a,b); { auto rr=__builtin_amdgcn_permlane32_swap(__float_as_uint(rm),__float_as_uint(rm),false,false); rm=__builtin_fmaxf(__uint_as_float(rr[0]),__uint_as_float(rr[1])); } \
      resc=false; \
      if(__builtin_expect(__any(rm>(float)THRL),0)){ const float dl=__builtin_fmaxf(rm,0.f); mhat+=dl; \
        _Pragma("unroll") for(int r=0;r<16;++r){C0[r]-=dl;C1[r]-=dl;} \
        const float f=__builtin_amdgcn_exp2f(-dl); l_reg*=f; if(hi==0)wsf[r32]=f; resc=true; } } \
    SBAR(); \
    GAPB(o[0]=__builtin_amdgcn_mfma_f32_32x32x16_bf16(PAF(0),VFR(0),o[0],0,0,0), C0,0); \
    GAPB(o[1]=__builtin_amdgcn_mfma_f32_32x32x16_bf16(PAF(0),VFR(4),o[1],0,0,0), C0,4); \
    KRD(GL,0); GAPB(o[0]=__builtin_amdgcn_mfma_f32_32x32x16_bf16(PAF(1),VFR(1),o[0],0,0,0), C0,8); \
    KRD(GL,1); GAPB(o[1]=__builtin_amdgcn_mfma_f32_32x32x16_bf16(PAF(1),VFR(5),o[1],0,0,0), C0,12); \
    KRD(GL,2); GAPB(o[0]=__builtin_amdgcn_mfma_f32_32x32x16_bf16(PAF(2),VFR(2),o[0],0,0,0), C1,0); \
    KRD(GL,3); GAPB(o[1]=__builtin_amdgcn_mfma_f32_32x32x16_bf16(PAF(2),VFR(6),o[1],0,0,0), C1,4); \
    GAPB(o[0]=__builtin_amdgcn_mfma_f32_32x32x16_bf16(PAF(3),VFR(3),o[0],0,0,0), C1,8); \
    GAPB(o[1]=__builtin_amdgcn_mfma_f32_32x32x16_bf16(PAF(3),VFR(7),o[1],0,0,0), C1,12); \
    }while(0)
  int t=1;
  #undef CMASK
  #define CMASK(P0,P1,t) do{}while(0)
  for(;t+5<NT;t+=2){
    STEP(pB0,pB1,pA0,pA1,t,true,true,true);     WAIT_BAR(2); RESC(); ROT();
    STEP(pA0,pA1,pB0,pB1,t+1,true,true,true);   WAIT_BAR(2); RESC(); ROT();
  }
  #undef CMASK
  #define CMASK(P0,P1,t) do{int jb_=(t)-(NT-4); if(jb_>=0)cmask(P0,P1,jb_,qrel,hi);}while(0)
  #define ENDW(tt) do{ if((tt)+3<NT){WAIT_BAR(2);} else if((tt)+2<NT){WAIT_BAR(1);} else {WAIT_BAR(0);} }while(0)
  for(;t+1<NT;t+=2){
    STEP(pB0,pB1,pA0,pA1,t,(t+3<NT),(t+1<NT),(t+1<NT));       ENDW(t);   RESC(); ROT();
    STEP(pA0,pA1,pB0,pB1,t+1,(t+4<NT),(t+2<NT),(t+2<NT));     ENDW(t+1); RESC(); ROT();
  }
  STEP(pB0,pB1,pA0,pA1,NT-1,false,false,false); RESC();
  { float sacc=pB0[0]+pB0[1]; _Pragma("unroll") for(int r=2;r<16;++r)sacc+=pB0[r]; _Pragma("unroll") for(int r=0;r<16;++r)sacc+=pB1[r]; l_reg+=sacc;
    pw0=(u32x4){PKW(pB0,0),PKW(pB0,2),PKW(pB0,4),PKW(pB0,6)};pw1=(u32x4){PKW(pB0,8),PKW(pB0,10),PKW(pB0,12),PKW(pB0,14)};pw2=(u32x4){PKW(pB1,0),PKW(pB1,2),PKW(pB1,4),PKW(pB1,6)};pw3=(u32x4){PKW(pB1,8),PKW(pB1,10),PKW(pB1,12),PKW(pB1,14)};
    SBAR(); pv(o,vb0+sl_cur,PAF(0),PAF(1),PAF(2),PAF(3)); }
  #undef PKW
  #undef PAF
  #undef VFR
  #undef PIN
  #undef MX3
  #undef GAPA
  #undef GAPB
  #undef EX
  #undef VRD
  #undef KRD
  #undef STEP
  #undef ENDW
  {auto rr=__builtin_amdgcn_permlane32_swap(__float_as_uint(l_reg),__float_as_uint(l_reg),false,false);l_reg=__uint_as_float(rr[0])+__uint_as_float(rr[1]);}
  if(hi==0)wsf[32+r32]=l_reg;asm volatile("s_waitcnt lgkmcnt(0)":::"memory");
  float rli[16];
  #pragma unroll
  for(int r=0;r<16;++r)rli[r]=__builtin_amdgcn_rcpf(wsf[32+crow(r,hi)]);
  bf16*Ow=O+(rowbase+q0+wid*QBLK)*DMO+OCOL+h*D;
  { bf16*stg=(bf16*)(shm+LDS_OST)+wid*2048;
    #pragma unroll
    for(int r=0;r<16;++r){const int orow=crow(r,hi);
      #pragma unroll
      for(int d0=0;d0<2;++d0)stg[orow*64+d0*32+r32]=__float2bfloat16(o[d0][r]*rli[r]);}
    asm volatile("s_waitcnt lgkmcnt(0)":::"memory");
    #pragma unroll
    for(int i=0;i<4;++i){const int row=i*8+(lane>>3),ch=lane&7; const u32x4 v=*(const u32x4*)(stg+row*64+ch*8); ATTN_STORE16(Ow+(long)row*DMO+ch*8,v);} }
  asm volatile("s_waitcnt lgkmcnt(0)\n\ts_barrier":::"memory");
  #undef DMA_K
  #undef DMA_V
  #undef CMASK
  #undef START
  #undef BIAS
  #undef RESC
  #undef ROT
}
constexpr int ATTN_LDS_BYTES=LDS_BYTES;
struct AttnTensors { const bf16* Q; const bf16* K; const bf16* V; bf16* O; const float* nb; const float* qn; const float* kn; const int* t0tab; };
struct AttnUnit { int bh; int qb; };
struct StaticOrder {
  int vcu,G;
  __device__ __forceinline__ explicit StaticOrder(int grid,int block):vcu((grid%8==0)?(block%8)*(grid/8)+block/8:block),G(grid){}
  __device__ __forceinline__ bool next(int i,AttnUnit&u)const{ const int w=vcu+(i>>2)*G; if(w>=BATCH*NHEAD*8)return false; const int s=w&7,j=i&3; u.bh=((w>>3)+9*j)&31; u.qb=(j==0)?s:(j==1)?15-s:(j==2)?16+s:31-s; return true; }
  __device__ __forceinline__ void a_ready(const AttnUnit&)const{}
  __device__ __forceinline__ void done(const AttnUnit&)const{}
};
template<int THRL=8> __device__ __forceinline__ void attn_phase_dyn(char*lds,const AttnTensors&T,unsigned*ctr,volatile __attribute__((address_space(3))) unsigned*slot){
  const int tid=threadIdx.x,lane=tid&63;
  int ord=0;
  { const float myv=(lane<32)?T.nb[(long)lane*SEQ+SEQ-1]:3.0e38f; int rank=0;
    _Pragma("unroll") for(int j=0;j<32;++j){const float vj=__shfl(myv,j); rank+=(vj<myv||(vj==myv&&j<lane))?1:0;}
    _Pragma("unroll") for(int j=0;j<32;++j){const int rj=__shfl(rank,j); if(rj==lane)ord=j;} }
  if(tid==0){ const unsigned id=__hip_atomic_fetch_add(ctr,1u,__ATOMIC_RELAXED,__HIP_MEMORY_SCOPE_AGENT); *slot=id; }
  asm volatile("s_waitcnt vmcnt(0) lgkmcnt(0)\n\ts_barrier":::"memory");
  for(;;){
    const unsigned uid=*slot;
    if(uid>=(unsigned)(BATCH*NHEAD*NQB))break;
    unsigned nxt=0u; if(tid==0)nxt=__hip_atomic_fetch_add(ctr,1u,__ATOMIC_RELAXED,__HIP_MEMORY_SCOPE_AGENT);
    const int bh=__builtin_amdgcn_readfirstlane(__shfl(ord,(int)(uid>>5))), qb=NQB-1-(int)(uid&31u);
    const int t0=__builtin_amdgcn_readfirstlane(T.t0tab[bh*NQB+qb]);
    attn_unit<THRL>(bh/NHEAD,bh%NHEAD,qb,T.Q,T.K,T.V,T.O,T.nb+(long)bh*SEQ,t0,lds);
    if(tid==0)*slot=nxt;
    asm volatile("s_waitcnt vmcnt(0) lgkmcnt(0)\n\ts_barrier":::"memory");
  }
}
#undef SBAR
#undef WAIT_BAR
}
#define GAS __attribute__((address_space(1)))
#define LAS __attribute__((address_space(3)))
typedef unsigned short bf16;
typedef unsigned v4u __attribute__((ext_vector_type(4)));
typedef float f32x4 __attribute__((ext_vector_type(4)));
typedef short bf16x8 __attribute__((ext_vector_type(8)));
typedef GAS unsigned gu32;
typedef GAS unsigned long long gu64;
#define RLX_AGENT __ATOMIC_RELAXED, __HIP_MEMORY_SCOPE_AGENT
#define LDS_WAIT() asm volatile("s_waitcnt lgkmcnt(0)" ::: "memory")
#define VM_WAIT() asm volatile("s_waitcnt vmcnt(0)" ::: "memory")
__device__ __forceinline__ unsigned long long rt() { return __builtin_amdgcn_s_memrealtime(); }
typedef float f32x2_pk __attribute__((ext_vector_type(2))); typedef __bf16 bf16x2_pk __attribute__((ext_vector_type(2)));
__device__ __forceinline__ unsigned pk2(float lo, float hi) { f32x2_pk v = {lo, hi}; bf16x2_pk r = __builtin_convertvector(v, bf16x2_pk); return __builtin_bit_cast(unsigned, r); }
__device__ __forceinline__ unsigned f2bf(float f) { return pk2(f, 0.f) & 0xffffu; }

#define XB_TMO      128
#define XB_XCNT(j)  (256  + 64 * (j))
#define XB_XSUB(j)  (1280 + 64 * (j))
#define XB_XGEN(j)  (2304 + 64 * (j))
#define XB_TOP      3328
#define XB_TOPGEN   3392
#define XCD_BAR_WORDS 3456
#define XB_SPIN_CAP (1u << 18)

__device__ __forceinline__ unsigned xb_ld(unsigned* p)              { return __hip_atomic_load(p, __ATOMIC_RELAXED, __HIP_MEMORY_SCOPE_AGENT); }
__device__ __forceinline__ unsigned xb_add(unsigned* p, unsigned v) { return __hip_atomic_fetch_add(p, v, __ATOMIC_RELAXED, __HIP_MEMORY_SCOPE_AGENT); }
__device__ __forceinline__ unsigned xb_xcc_id() { return (unsigned)__builtin_amdgcn_s_getreg((3 << 11) | 20) & 0xFu; }
#define XB_SPIN(cond, bar) do { unsigned _sp = 0; while (cond) { __builtin_amdgcn_s_sleep(1); \
    if ((++_sp & 255u) == 0u) { if (xb_ld(&(bar)[XB_TMO])) break; if (_sp > XB_SPIN_CAP) { atomicAdd(&(bar)[XB_TMO], 1u); break; } } } } while (0)

struct XcdBarrier {
    unsigned* bar; unsigned x;
    volatile LAS unsigned* st;
};

__device__ __forceinline__ XcdBarrier xcd_barrier_post(unsigned* bar, volatile LAS unsigned* st) {
    XcdBarrier b; b.bar = bar; b.x = xb_xcc_id(); b.st = st;
    if (threadIdx.x == 0) (void)xb_add(&bar[XB_XCNT(b.x)], 1u);
    return b;
}
__device__ __forceinline__ void xcd_barrier_complete(unsigned* bar, unsigned x, unsigned& nloc, unsigned& nx) {
    const unsigned G = gridDim.x * gridDim.y * gridDim.z;
    unsigned sum, cnt, mine, sp = 0u;
    for (;;) {
        sum = 0u; cnt = 0u; mine = 0u;
#pragma unroll
        for (unsigned j = 0; j < 16; ++j) { const unsigned c = xb_ld(&bar[XB_XCNT(j)]); sum += c; cnt += (c > 0u) ? 1u : 0u; mine = (j == x) ? c : mine; }
        if (sum == G) break;
        __builtin_amdgcn_s_sleep(1);
        if ((++sp & 255u) == 0u) { if (xb_ld(&bar[XB_TMO])) break; if (sp > XB_SPIN_CAP) { atomicAdd(&bar[XB_TMO], 1u); break; } }
    }
    nloc = mine > 0u ? mine : 1u; nx = cnt > 0u ? cnt : 1u;
}

__device__ __forceinline__ void xcd_barrier(const XcdBarrier& b) {
    asm volatile("s_waitcnt vmcnt(0)" ::: "memory");
    __syncthreads();
    if (threadIdx.x == 0) {
        unsigned* bar = b.bar;
        __builtin_amdgcn_s_waitcnt(0);
        unsigned nloc = b.st[0], nx = b.st[1];
        if (nloc == 0u) { xcd_barrier_complete(bar, b.x, nloc, nx); b.st[0] = nloc; b.st[1] = nx; }
        const unsigned old = xb_add(&bar[XB_XSUB(b.x)], 1u);
        const unsigned gen = old / nloc;
        if (old + 1u == (gen + 1u) * nloc) {
            __builtin_amdgcn_fence(__ATOMIC_RELEASE, "agent");
            asm volatile("s_waitcnt vmcnt(0)" ::: "memory");
            const unsigned og = xb_add(&bar[XB_TOP], 1u);
            const unsigned tg = og / nx;
            if (og + 1u == (tg + 1u) * nx) xb_add(&bar[XB_TOPGEN], 1u);
            else XB_SPIN(xb_ld(&bar[XB_TOPGEN]) == tg, bar);
            __builtin_amdgcn_fence(__ATOMIC_ACQUIRE, "agent");
            xb_add(&bar[XB_XGEN(b.x)], 1u);
            asm volatile("s_waitcnt vmcnt(0)" ::: "memory");
        } else {
            XB_SPIN(xb_ld(&bar[XB_XGEN(b.x)]) == gen, bar);
            __builtin_amdgcn_fence(__ATOMIC_ACQUIRE, "agent");
            asm volatile("s_waitcnt vmcnt(0)" ::: "memory");
        }
    }
    __syncthreads();
}

constexpr int NWAVES = 8;
constexpr int BATCH = 4, SEQ = 8192, D = 1024, M = BATCH * SEQ;
constexpr int IN_W = 7184, NGW = 4096, NGT = 3072, NSLAB = 8;
constexpr int SL_POOL = 0, SL_MQ = 1, SL_MK = 2, SL_MV = 3, SL_MO = 4, SL_FQ = 5, SL_FK = 6, SL_FV = 7;
constexpr int ML_H = 4, ML_DH = 128, CHUNK = 64, NCH = SEQ / CHUNK;
constexpr int FX_H = 8;
constexpr int DFF = 2816, NEXP = 8, DFE = 3584;
constexpr float NORM_EPS = 1e-6f;
constexpr int KCAT = 1536;
constexpr int MOE_KROWS = 34816;
constexpr int MOE_KTILES = MOE_KROWS / 256;
constexpr int TOKBLK = 128, NTOKBLK = M / TOKBLK;

constexpr size_t MiB = 1u << 20;
constexpr size_t WS_CTL = 0, CTL_ZERO_BYTES = 1 * MiB;
constexpr size_t WS_W = 1 * MiB;
constexpr size_t W_LAYER = 19 * MiB, W_NG = 0, W_GT = 8 * MiB, W_CAT = 14 * MiB, W_OUT = 17 * MiB;
constexpr size_t WS_WGU = WS_W + 2 * W_LAYER, WS_WDN = WS_WGU + 11 * MiB;
constexpr size_t WS_NG = 56 * MiB, SLAB_BYTES = (size_t)M * 512 * 2;
constexpr size_t WS_GATE = WS_NG + SLAB_BYTES;
constexpr size_t WS_ACT0 = WS_NG;
constexpr size_t WS_HB = 312 * MiB;
constexpr size_t WS_CAT = 376 * MiB;
constexpr size_t WS_MLC = 472 * MiB;
constexpr size_t WS_MOEGU = 1 * MiB;
constexpr size_t WS_MOEDN = 57 * MiB;
constexpr size_t WS_XS = 85 * MiB;
constexpr size_t WS_Y0 = 153 * MiB, WS_Y1 = 217 * MiB;
constexpr size_t WS_ACT1 = 305 * MiB;
constexpr size_t WS_SM = 544 * MiB;
constexpr size_t SM_GATE16 = 0;
constexpr size_t SM_MLB = 2 * MiB, SM_MLA = SM_MLB + 512 * 1024, SM_MLMX = SM_MLA + 512 * 1024;
constexpr size_t SM_FNB = SM_MLMX + 512 * 1024;
constexpr size_t SM_MLN = SM_FNB + 1 * MiB;
constexpr size_t SM_MLM = SM_MLN + 1 * MiB;
constexpr size_t SM_MLDEC = SM_MLM + 16 * 132 * 4;
constexpr size_t SM_FQN = SM_MLDEC + 16 * 128 * 4, SM_FKN = SM_FQN + 32768, SM_FT0 = SM_FKN + 32768, SM_MLBG = SM_FT0 + 4096, SM_FXM = SM_MLBG + 16384;
constexpr size_t SM_MOE = 6 * MiB;
constexpr size_t MO_RSTD = 0, MO_TOKE = MO_RSTD + (size_t)M * 4, MO_TOKG = MO_TOKE + (size_t)M * 8, MO_HIST = MO_TOKG + (size_t)M * 8,
                 MO_ROWTOK = MO_HIST + (size_t)NTOKBLK * 16 * 4, MO_ROWG = MO_ROWTOK + (size_t)2 * MOE_KROWS * 4, MO_TILEE = MO_ROWG + (size_t)2 * MOE_KROWS * 4, MO_NT = MO_TILEE + 2 * MOE_KTILES * 4, MO_END = MO_NT + 64;
static_assert(SM_MOE + MO_END <= 8 * MiB, "small arrays");
constexpr size_t WS_END = 552 * MiB;
static_assert(WS_WDN + (size_t)DFF * D * 2 <= WS_NG && WS_NG + NSLAB * SLAB_BYTES <= WS_HB && WS_HB + (size_t)M * D * 2 <= WS_CAT && WS_CAT + (size_t)M * KCAT * 2 <= WS_MLC && WS_MLC + 64 * MiB <= WS_SM, "d_ws map");
static_assert(WS_MOEGU + (size_t)NEXP * 2 * DFE * D <= WS_MOEDN && WS_MOEDN + (size_t)NEXP * D * DFE <= WS_XS && WS_XS + (size_t)2 * MOE_KROWS * D <= WS_Y0 && WS_Y0 + (size_t)M * D * 2 <= WS_Y1 && WS_Y1 + (size_t)M * D * 2 <= WS_ACT1 && WS_ACT1 + (size_t)2 * MOE_KROWS * DFE <= WS_SM, "d_ws map (MoE)");
constexpr int CW_TMO = 0, CW_CODE = 1, CW_BAR = 4096;

constexpr int RING_OFF = 0, RING_BYTES = 131072;
constexpr int LDSCTL_OFF = RING_BYTES, MISC_OFF = LDSCTL_OFF + 320;
constexpr int LDS_BYTES = 147456;
static_assert(MISC_OFF + 128 <= LDS_BYTES, "LDS map");

struct Frame {
    LAS unsigned char* lds;
    volatile LAS unsigned* MISC;
    gu32* ctl;
    int tid, lane, wave;
    int vcu, G, blk;
    unsigned char* ws;
    const float* const* in; float* out; int zi;
};
#define INP(F, i) ((F).in[(i) + (F).zi])
enum { IN_X = 0, IN_MIXG, IN_WIN, IN_POOLW, IN_POOLS, IN_CONVW, IN_MLBI, IN_MLBF, IN_MLNG, IN_FXBF, IN_WBRP, IN_WBRM, IN_WBRF, IN_WOUT, IN_FFNG, IN_FFG, IN_FFU, IN_FFD, IN_RW, IN_RB, IN_MOEG, IN_MOEU, IN_MOED, IN_FING };

__device__ __forceinline__ float wave_sum(float v) {
#pragma unroll
    for (int o = 1; o < 64; o <<= 1) v += __shfl_xor(v, o);
    return v;
}
__device__ __forceinline__ float wave_max(float v) {
#pragma unroll
    for (int o = 1; o < 64; o <<= 1) v = fmaxf(v, __shfl_xor(v, o));
    return v;
}
__device__ __forceinline__ float sigmoid_f(float x) { return __builtin_amdgcn_rcpf(1.f + __builtin_amdgcn_exp2f(-1.4426950408889634f * x)); }
__device__ __forceinline__ float logsigmoid_f(float x) { return fminf(x, 0.f) - log1pf(expf(-fabsf(x))); }

__device__ __forceinline__ void tr_item(const float* W, int ldw, int srccol0, const float* gain, bf16* WT, int ldt, int drow0, int dcol0, int k0, LAS float* scr, int lane) {
    (void)scr;
    const int ng = lane & 7, kg = lane >> 3;
    f32x4 v[8];
#pragma unroll
    for (int i = 0; i < 8; ++i) v[i] = *(const GAS f32x4*)(W + (size_t)(k0 + 8 * kg + i) * ldw + srccol0 + 4 * ng);
    if (gain) { const f32x4 g0 = *(const GAS f32x4*)(gain + k0 + 8 * kg), g1 = *(const GAS f32x4*)(gain + k0 + 8 * kg + 4);
#pragma unroll
        for (int i = 0; i < 4; ++i) { v[i] = v[i] * g0[i]; v[4 + i] = v[4 + i] * g1[i]; } }
#pragma unroll
    for (int j = 0; j < 4; ++j) { v4u o; o.x = pk2(v[0][j], v[1][j]); o.y = pk2(v[2][j], v[3][j]); o.z = pk2(v[4][j], v[5][j]); o.w = pk2(v[6][j], v[7][j]);
        *(GAS v4u*)(WT + (size_t)(drow0 + 4 * ng + j) * ldt + dcol0 + k0 + 8 * kg) = o; }
}
__device__ __forceinline__ void tr_item_fp8(const float* W, int ldw, int srccol0, const float* gain, float scale, unsigned char* WT8, int ldt, int drow0, int k0, int lane) {
    const int ng = lane & 7, kg = lane >> 3;
    f32x4 v[8];
#pragma unroll
    for (int i = 0; i < 8; ++i) v[i] = *(const GAS f32x4*)(W + (size_t)(k0 + 8 * kg + i) * ldw + srccol0 + 4 * ng);
    f32x4 g0 = (f32x4){scale, scale, scale, scale}, g1 = g0;
    if (gain) { g0 = *(const GAS f32x4*)(gain + k0 + 8 * kg) * scale; g1 = *(const GAS f32x4*)(gain + k0 + 8 * kg + 4) * scale; }
#pragma unroll
    for (int i = 0; i < 4; ++i) { v[i] = v[i] * g0[i]; v[4 + i] = v[4 + i] * g1[i]; }
    typedef unsigned u32x2_t __attribute__((ext_vector_type(2)));
#pragma unroll
    for (int j = 0; j < 4; ++j) { u32x2_t o; o.x = pg8::pack_fp8x4(v[0][j], v[1][j], v[2][j], v[3][j]); o.y = pg8::pack_fp8x4(v[4][j], v[5][j], v[6][j], v[7][j]);
        *(GAS u32x2_t*)(WT8 + (size_t)(drow0 + 4 * ng + j) * ldt + k0 + 8 * kg) = o; }
}
constexpr float FP8_ASCALE = 16.f, FP8_WSCALE = 256.f;
constexpr int CI_NG = 2048, CI_GT = 1536, CI_BR = 256, CI_OUT = 512, CI_LAYER = CI_NG + CI_GT + 2 * CI_BR + CI_OUT, CI_GU = 2816, CI_DN = 1408, CI_MAIN = 2 * CI_LAYER + CI_GU + CI_DN;
__device__ __forceinline__ void conv_item_main(Frame& F, int it, LAS float* scr) {
    if (it < 2 * CI_LAYER) {
        const int l = it / CI_LAYER; int r = it % CI_LAYER; bf16* wl = (bf16*)(F.ws + WS_W + (size_t)l * W_LAYER);
        const float* g = INP(F, IN_MIXG) + l * D; const float* win = INP(F, IN_WIN) + (size_t)l * D * IN_W;
        if (r < CI_NG) { const int nb = r >> 4, kb = r & 15; tr_item(win, IN_W, nb * 32 + (nb * 32 >= 2560 ? 8 : 0), g, wl + W_NG / 2, D, nb * 32, 0, kb * 64, scr, F.lane); return; } r -= CI_NG;
        if (r < CI_GT) { const int nb = r >> 4, kb = r & 15; tr_item_fp8(win, IN_W, 4112 + nb * 32, g, FP8_WSCALE, (unsigned char*)wl + W_GT, D, nb * 32, kb * 64, F.lane); return; } r -= CI_GT;
        if (r < CI_BR) { const int nb = r >> 3, kb = r & 7; tr_item(INP(F, IN_WBRM) + (size_t)l * 512 * D, D, nb * 32, nullptr, wl + W_CAT / 2, KCAT, nb * 32, 512, kb * 64, scr, F.lane); return; } r -= CI_BR;
        if (r < CI_BR) { const int nb = r >> 3, kb = r & 7; tr_item(INP(F, IN_WBRF) + (size_t)l * 512 * D, D, nb * 32, nullptr, wl + W_CAT / 2, KCAT, nb * 32, 1024, kb * 64, scr, F.lane); return; } r -= CI_BR;
        { const int nb = r >> 4, kb = r & 15; tr_item(INP(F, IN_WOUT) + (size_t)l * D * D, D, nb * 32, nullptr, wl + W_OUT / 2, D, nb * 32, 0, kb * 64, scr, F.lane); }
        return;
    }
    it -= 2 * CI_LAYER;
    if (it < CI_GU) { const int nb = it >> 4, kb = it & 15, p = nb >> 3, w = nb & 7;
        tr_item(w < 4 ? INP(F, IN_FFG) : INP(F, IN_FFU), DFF, 128 * p + (w & 3) * 32, INP(F, IN_FFNG), (bf16*)(F.ws + WS_WGU), D, nb * 32, 0, kb * 64, scr, F.lane); return; }
    it -= CI_GU;
    { const int kb = it >> 5, nb = it & 31; tr_item(INP(F, IN_FFD), D, nb * 32, nullptr, (bf16*)(F.ws + WS_WDN), DFF, nb * 32, 0, kb * 64, scr, F.lane); }
}
constexpr int CI_MGU = 3584, CI_MDN = 1792, CI_MEXP = CI_MGU + CI_MDN, CI_MOE = NEXP * CI_MEXP;
__device__ __forceinline__ void conv_item_moe(Frame& F, int it, LAS float* scr) {
    (void)scr;
    const int e = it / CI_MEXP; int r = it % CI_MEXP;
    if (r < CI_MGU) { const int nb = r % 224, kb = r / 224, p = nb >> 3, w = nb & 7;
        tr_item_fp8((w < 4 ? INP(F, IN_MOEG) : INP(F, IN_MOEU)) + (size_t)e * D * DFE, DFE, 128 * p + (w & 3) * 32, INP(F, IN_FFNG) + D, FP8_WSCALE, F.ws + WS_MOEGU + (size_t)e * 2 * DFE * D, D, nb * 32, kb * 64, F.lane); return; }
    r -= CI_MGU;
    { const int kb = r >> 5, nb = r & 31; tr_item_fp8(INP(F, IN_MOED) + (size_t)e * DFE * D, D, nb * 32, nullptr, FP8_WSCALE, F.ws + WS_MOEDN + (size_t)e * D * DFE, DFE, nb * 32, kb * 64, F.lane); }
}
__device__ __forceinline__ void pool_fold(Frame& F) {
    const int gt = F.blk * (NWAVES * 64) + F.tid, NT = F.G * NWAVES * 64;
    for (int o = gt; o < 2 * 4 * 16 * D; o += NT) {
        const int n = o & (D - 1), cb = __builtin_amdgcn_readfirstlane(o >> 10), l = cb >> 6, g = (cb >> 4) & 3, c0 = (cb & 15) * 8;
        const float* wg = INP(F, IN_POOLW) + (size_t)l * 4 * 128 * 128 + (size_t)(g * 128 + c0) * 128; const float* sc = INP(F, IN_POOLS) + l * 512 + g * 128; const float* wb = INP(F, IN_WBRP) + (size_t)l * 512 * D + (size_t)(g * 128) * D + n;
        float a[8];
#pragma unroll
        for (int i = 0; i < 8; ++i) a[i] = 0.f;
#pragma unroll 8
        for (int dd = 0; dd < 128; ++dd) { const float t = sc[dd] * wb[(size_t)dd * D];
#pragma unroll
            for (int i = 0; i < 8; ++i) a[i] += wg[i * 128 + dd] * t; }
        v4u w; w.x = pk2(a[0], a[1]); w.y = pk2(a[2], a[3]); w.z = pk2(a[4], a[5]); w.w = pk2(a[6], a[7]);
        *(GAS v4u*)((bf16*)(F.ws + WS_W + (size_t)l * W_LAYER + W_CAT) + (size_t)n * KCAT + g * 128 + c0) = w;
    }
}

template <bool XB> __device__ __forceinline__ void load_xrow(const void* x, size_t m, int lane, f32x4 (&v)[4]) {
    if constexpr (XB) { typedef unsigned u32x2_t __attribute__((ext_vector_type(2))); const GAS u32x2_t* xr = (const GAS u32x2_t*)((const bf16*)x + m * D) + lane;
#pragma unroll
        for (int j = 0; j < 4; ++j) { const u32x2_t q = xr[64 * j]; v[j] = (f32x4){__uint_as_float(q.x << 16), __uint_as_float(q.x & 0xffff0000u), __uint_as_float(q.y << 16), __uint_as_float(q.y & 0xffff0000u)}; } }
    else { const GAS f32x4* xr = (const GAS f32x4*)((const float*)x + m * D) + lane;
#pragma unroll
        for (int j = 0; j < 4; ++j) v[j] = xr[64 * j]; }
}
template <bool XB> __device__ __forceinline__ void phase_norm_mix(Frame& F, const void* x, int l) {
    LAS float* w16 = (LAS float*)(F.lds);
    const float* g = INP(F, IN_MIXG) + l * D; const float* win = INP(F, IN_WIN) + (size_t)l * D * IN_W;
    for (int idx = F.tid; idx < 16 * D; idx += NWAVES * 64) { const int k = idx >> 4, j = idx & 15, col = j < 8 ? 2560 + j : 4104 + (j - 8); w16[j * D + k] = g[k] * win[(size_t)k * IN_W + col]; }
    __syncthreads();
    bf16* HB = (bf16*)(F.ws + WS_HB); float* gate16 = (float*)(F.ws + WS_SM + SM_GATE16);
    const int gw = F.vcu * NWAVES + F.wave, NGWV = F.G * NWAVES;
    for (int m = gw; m < M; m += NGWV) {
        f32x4 v[4]; float ss = 0.f; load_xrow<XB>(x, (size_t)m, F.lane, v);
#pragma unroll
        for (int j = 0; j < 4; ++j) ss += (v[j].x * v[j].x + v[j].y * v[j].y) + (v[j].z * v[j].z + v[j].w * v[j].w);
        const float rstd = 1.f / sqrtf(wave_sum(ss) * (1.f / D) + NORM_EPS);
        GAS unsigned long long* o8 = (GAS unsigned long long*)(HB + (size_t)m * D) + F.lane;
#pragma unroll
        for (int j = 0; j < 4; ++j) o8[64 * j] = (unsigned long long)pk2(v[j].x * rstd, v[j].y * rstd) | ((unsigned long long)pk2(v[j].z * rstd, v[j].w * rstd) << 32);
        float pp[16];
#pragma unroll
        for (int jj = 0; jj < 16; ++jj) { float p = 0.f;
#pragma unroll
            for (int j = 0; j < 4; ++j) { const f32x4 wv = *(const LAS f32x4*)(w16 + jj * D + 256 * j + 4 * F.lane); p += (v[j].x * wv.x + v[j].y * wv.y) + (v[j].z * wv.z + v[j].w * wv.w); }
            pp[jj] = p; if ((jj & 3) == 3) asm volatile("" ::: "memory"); }
#define TB_STAGE(ST, N) { const bool up = (F.lane >> (ST)) & 1; _Pragma("unroll") for (int i = 0; i < (N); ++i) { const float mine = up ? pp[2 * i + 1] : pp[2 * i], give = up ? pp[2 * i] : pp[2 * i + 1]; pp[i] = mine + __shfl_xor(give, 1 << (ST)); } }
        TB_STAGE(0, 8) TB_STAGE(1, 4) TB_STAGE(2, 2) TB_STAGE(3, 1)
        float keep = pp[0]; keep += __shfl_xor(keep, 16); keep += __shfl_xor(keep, 32); keep *= rstd;
        if (F.lane < 16) gate16[(size_t)m * 16 + F.lane] = keep;
    }
    __syncthreads();
}
__device__ __forceinline__ void phase_norm_ffn(Frame& F, const bf16* x) {
    bf16* HB = (bf16*)(F.ws + WS_HB);
    const int gw = F.vcu * NWAVES + F.wave, NGWV = F.G * NWAVES;
    for (int m = gw; m < M; m += NGWV) {
        f32x4 v[4]; float ss = 0.f; load_xrow<true>(x, (size_t)m, F.lane, v);
#pragma unroll
        for (int j = 0; j < 4; ++j) ss += (v[j].x * v[j].x + v[j].y * v[j].y) + (v[j].z * v[j].z + v[j].w * v[j].w);
        const float rstd = 1.f / sqrtf(wave_sum(ss) * (1.f / D) + NORM_EPS);
        GAS unsigned long long* o8 = (GAS unsigned long long*)(HB + (size_t)m * D) + F.lane;
#pragma unroll
        for (int j = 0; j < 4; ++j) o8[64 * j] = (unsigned long long)pk2(v[j].x * rstd, v[j].y * rstd) | ((unsigned long long)pk2(v[j].z * rstd, v[j].w * rstd) << 32);
    }
}
__device__ __forceinline__ void quant_rows_fp8(Frame& F, const bf16* src, unsigned char* dst) {
    const int gw = F.vcu * NWAVES + F.wave, NGWV = F.G * NWAVES;
    for (int m = gw; m < M; m += NGWV) {
        const v4u a = *((const GAS v4u*)(src + (size_t)m * D) + F.lane), b = *((const GAS v4u*)(src + (size_t)m * D) + 64 + F.lane);
        typedef unsigned u32x2_t __attribute__((ext_vector_type(2)));
        u32x2_t o0, o1; const float s = FP8_ASCALE;
        o0.x = pg8::pack_fp8x4(__uint_as_float(a.x << 16) * s, __uint_as_float(a.x & 0xffff0000u) * s, __uint_as_float(a.y << 16) * s, __uint_as_float(a.y & 0xffff0000u) * s);
        o0.y = pg8::pack_fp8x4(__uint_as_float(a.z << 16) * s, __uint_as_float(a.z & 0xffff0000u) * s, __uint_as_float(a.w << 16) * s, __uint_as_float(a.w & 0xffff0000u) * s);
        o1.x = pg8::pack_fp8x4(__uint_as_float(b.x << 16) * s, __uint_as_float(b.x & 0xffff0000u) * s, __uint_as_float(b.y << 16) * s, __uint_as_float(b.y & 0xffff0000u) * s);
        o1.y = pg8::pack_fp8x4(__uint_as_float(b.z << 16) * s, __uint_as_float(b.z & 0xffff0000u) * s, __uint_as_float(b.w << 16) * s, __uint_as_float(b.w & 0xffff0000u) * s);
        *((GAS u32x2_t*)(dst + (size_t)m * D) + F.lane) = o0; *((GAS u32x2_t*)(dst + (size_t)m * D) + 64 + F.lane) = o1;
    }
}
__device__ __forceinline__ void phase_norm_final(Frame& F, const bf16* xb, float* out, float* tmp) {
    const GAS f32x4* gp = (const GAS f32x4*)INP(F, IN_FING) + F.lane; f32x4 gv[4];
#pragma unroll
    for (int j = 0; j < 4; ++j) gv[j] = gp[64 * j];
    const bf16* Y0 = (const bf16*)(F.ws + WS_Y0); const bf16* Y1 = (const bf16*)(F.ws + WS_Y1);
    const int gw = F.vcu * NWAVES + F.wave, NGWV = F.G * NWAVES;
    for (int m = gw; m < M; m += NGWV) {
        f32x4 v[4], a[4], b[4]; float ss = 0.f; load_xrow<true>(xb, (size_t)m, F.lane, v); load_xrow<true>(Y0, (size_t)m, F.lane, a); load_xrow<true>(Y1, (size_t)m, F.lane, b);
#pragma unroll
        for (int j = 0; j < 4; ++j) { v[j] = v[j] + (a[j] + b[j]); ss += (v[j].x * v[j].x + v[j].y * v[j].y) + (v[j].z * v[j].z + v[j].w * v[j].w); }
        const float rstd = 1.f / sqrtf(wave_sum(ss) * (1.f / D) + NORM_EPS);
        GAS f32x4* o = (GAS f32x4*)((m < M / 2 ? out + (size_t)m * D : tmp + (size_t)(m - M / 2) * D)) + F.lane;
#pragma unroll
        for (int j = 0; j < 4; ++j) o[64 * j] = v[j] * rstd * gv[j];
    }
}
__device__ __forceinline__ void phase_copy_upper(Frame& F, const float* tmp, float* out) {
    const size_t n4 = (size_t)(M / 2) * D / 4; const GAS f32x4* s = (const GAS f32x4*)tmp; GAS f32x4* d = (GAS f32x4*)(out + (size_t)(M / 2) * D);
    for (size_t i = (size_t)F.vcu * (NWAVES * 64) + F.tid; i < n4; i += (size_t)F.G * NWAVES * 64) d[i] = s[i];
}

__device__ __forceinline__ void phase_route1(Frame& F, const bf16* x) {
    LAS float* w8 = (LAS float*)(F.lds);
    LAS int* hist = (LAS int*)(F.lds + 32768);
    const float* g = INP(F, IN_FFNG) + D; const float* rw = INP(F, IN_RW);
    for (int idx = F.tid; idx < 8 * D; idx += NWAVES * 64) { const int k = idx >> 3, e = idx & 7; w8[e * D + k] = g[k] * rw[(size_t)k * 8 + e]; }
    unsigned char* sm = F.ws + WS_SM + SM_MOE;
    float* rstd_g = (float*)(sm + MO_RSTD); int* tok_e = (int*)(sm + MO_TOKE); float* tok_g = (float*)(sm + MO_TOKG); int* hist_g = (int*)(sm + MO_HIST);
    for (int blk = F.blk; blk < NTOKBLK; blk += F.G) {
        if (F.tid < 16) hist[F.tid] = 0;
        __syncthreads();
        for (int i = 0; i < TOKBLK / NWAVES; ++i) {
            const int m = blk * TOKBLK + F.wave * (TOKBLK / NWAVES) + i;
            f32x4 v[4]; float ss = 0.f; load_xrow<true>(x, (size_t)m, F.lane, v);
#pragma unroll
            for (int j = 0; j < 4; ++j) ss += (v[j].x * v[j].x + v[j].y * v[j].y) + (v[j].z * v[j].z + v[j].w * v[j].w);
            const float rstd = 1.f / sqrtf(wave_sum(ss) * (1.f / D) + NORM_EPS);
            float pp[8];
#pragma unroll
            for (int e = 0; e < 8; ++e) { float p = 0.f;
#pragma unroll
                for (int j = 0; j < 4; ++j) { const f32x4 wv = *(const LAS f32x4*)(w8 + e * D + 256 * j + 4 * F.lane); p += (v[j].x * wv.x + v[j].y * wv.y) + (v[j].z * wv.z + v[j].w * wv.w); }
                pp[e] = p; }
            TB_STAGE(0, 4) TB_STAGE(1, 2) TB_STAGE(2, 1)
            float tot = pp[0]; tot += __shfl_xor(tot, 8); tot += __shfl_xor(tot, 16); tot += __shfl_xor(tot, 32);
            float lg[8];
#pragma unroll
            for (int e = 0; e < 8; ++e) lg[e] = __shfl(tot, e) * rstd + INP(F, IN_RB)[e];
            if (F.lane == 0) {
                int e0 = 0; float v0 = lg[0];
#pragma unroll
                for (int e = 1; e < 8; ++e) if (lg[e] > v0) { v0 = lg[e]; e0 = e; }
                int e1 = -1; float v1 = -INFINITY;
#pragma unroll
                for (int e = 0; e < 8; ++e) if (e != e0 && lg[e] > v1) { v1 = lg[e]; e1 = e; }
                const float t = __expf(v1 - v0), g0 = 1.f / (1.f + t), g1 = t * g0;
                rstd_g[m] = rstd; tok_e[2 * m] = e0; tok_e[2 * m + 1] = e1; tok_g[2 * m] = g0; tok_g[2 * m + 1] = g1;
                atomicAdd((int*)&hist[e0], 1); atomicAdd((int*)&hist[8 + e1], 1);
            }
        }
        __syncthreads();
        if (F.tid < 16) hist_g[blk * 16 + F.tid] = hist[F.tid];
        __syncthreads();
    }
}
__device__ __forceinline__ void phase_route2(Frame& F, const bf16* x) {
    LAS int* H = (LAS int*)(F.lds);
    LAS int* tot = (LAS int*)(F.lds + 16384); LAS int* pre = tot + 16; LAS int* start = tot + 32; LAS int* dest = tot + 64; LAS int* te = tot + 320;
    unsigned char* sm = F.ws + WS_SM + SM_MOE;
    const float* rstd_g = (const float*)(sm + MO_RSTD); const int* tok_e = (const int*)(sm + MO_TOKE); const float* tok_g = (const float*)(sm + MO_TOKG); const int* hist_g = (const int*)(sm + MO_HIST);
    int* row_tok = (int*)(sm + MO_ROWTOK); float* row_g = (float*)(sm + MO_ROWG); int* tile_e = (int*)(sm + MO_TILEE); int* ntl = (int*)(sm + MO_NT);
    unsigned char* XS = F.ws + WS_XS;
    for (int blk = F.blk; blk < NTOKBLK; blk += F.G) {
        for (int i = F.tid; i < NTOKBLK * 16; i += NWAVES * 64) H[i] = hist_g[i];
        __syncthreads();
        if (F.tid < 16) { int t = 0, p = 0; for (int b = 0; b < NTOKBLK; ++b) { const int h = H[b * 16 + F.tid]; if (b < blk) p += h; t += h; } tot[F.tid] = t; pre[F.tid] = p; }
        __syncthreads();
        if (F.tid == 0) { for (int k = 0; k < 2; ++k) { int run = 0; for (int e = 0; e < 8; ++e) { start[k * 8 + e] = run; run += ((tot[k * 8 + e] + 255) >> 8) << 8; } if (blk == 0) ntl[k] = run >> 8; } }
        __syncthreads();
        if (F.tid < 2 * TOKBLK) te[F.tid] = tok_e[2 * blk * TOKBLK + F.tid];
        __syncthreads();
        if (F.tid < 16) { const int k = F.tid >> 3, e = F.tid & 7; int cnt = 0; const int base = k * MOE_KROWS + start[F.tid] + pre[F.tid];
            for (int i = 0; i < TOKBLK; ++i) if (te[2 * i + k] == e) { dest[2 * i + k] = base + cnt; ++cnt; }
            if (blk == 0) { const int s0 = start[F.tid], t0 = tot[F.tid], pe = ((t0 + 255) >> 8) << 8;
                for (int tI = s0 >> 8; tI < (s0 + pe) >> 8; ++tI) tile_e[k * MOE_KTILES + tI] = e;
                for (int r = s0 + t0; r < s0 + pe; ++r) { row_tok[k * MOE_KROWS + r] = -1; row_g[k * MOE_KROWS + r] = 0.f; } } }
        __syncthreads();
        for (int i = 0; i < TOKBLK / NWAVES; ++i) {
            const int li = F.wave * (TOKBLK / NWAVES) + i, m = blk * TOKBLK + li; const int d0 = dest[2 * li], d1 = dest[2 * li + 1];
            f32x4 xv[4]; load_xrow<true>(x, (size_t)m, F.lane, xv); const float rstd = rstd_g[m];
            GAS unsigned* o0 = (GAS unsigned*)(XS + (size_t)d0 * D) + F.lane; GAS unsigned* o1 = (GAS unsigned*)(XS + (size_t)d1 * D) + F.lane; const float sc = rstd * FP8_ASCALE;
#pragma unroll
            for (int j = 0; j < 4; ++j) { const f32x4 v = xv[j]; const unsigned w = pg8::pack_fp8x4(v.x * sc, v.y * sc, v.z * sc, v.w * sc); o0[64 * j] = w; o1[64 * j] = w; }
            if (F.lane == 0) { row_tok[d0] = m; row_g[d0] = tok_g[2 * m]; row_tok[d1] = m; row_g[d1] = tok_g[2 * m + 1]; }
        }
        __syncthreads();
    }
}

__device__ __forceinline__ float wave_scan_add(float v, int lane) {
#pragma unroll
    for (int d = 1; d < 64; d <<= 1) { const float t = __shfl_up(v, d); if (lane >= d) v += t; }
    return v;
}
__device__ __forceinline__ float wave_scan_max(float v, int lane) {
#pragma unroll
    for (int d = 1; d < 64; d <<= 1) { const float t = __shfl_up(v, d); if (lane >= d) v = fmaxf(v, t); }
    return v;
}
__device__ __forceinline__ void prep_mlstm(Frame& F, int l, int bh) {
    LAS float* Bc = (LAS float*)(F.lds); LAS float* Gc = Bc + NCH; LAS float* mc = Gc + NCH;
    const int b = bh >> 2, h = bh & 3;
    const float* gate16 = (const float*)(F.ws + WS_SM + SM_GATE16);
    float* mlb = (float*)(F.ws + WS_SM + SM_MLB) + (size_t)bh * SEQ; float* mla = (float*)(F.ws + WS_SM + SM_MLA) + (size_t)bh * SEQ; float* mlmx = (float*)(F.ws + WS_SM + SM_MLMX) + (size_t)bh * SEQ;
    float* mlm = (float*)(F.ws + WS_SM + SM_MLM) + bh * 132; float* mldec = (float*)(F.ws + WS_SM + SM_MLDEC) + bh * NCH;
    const float bi = INP(F, IN_MLBI)[l * ML_H + h], bf = INP(F, IN_MLBF)[l * ML_H + h];
    float areg[NCH / NWAVES];
#pragma unroll
    for (int ci = 0; ci < NCH / NWAVES; ++ci) {
        const int c = F.wave + NWAVES * ci, t = c * CHUNK + F.lane; const size_t m = (size_t)b * SEQ + t;
        const float lf = logsigmoid_f(gate16[m * 16 + 4 + h] + bf), li = gate16[m * 16 + h] + bi;
        const float bc = wave_scan_add(lf, F.lane), a = li - bc;
        const float amax = wave_max(a), btot = __shfl(bc, 63);
        mlb[t] = bc; mla[t] = a; areg[ci] = a;
        if (F.lane == 0) { Bc[c] = btot; Gc[c] = btot + amax; }
    }
    __syncthreads();
    if (F.tid == 0) { float mm = 0.f; for (int c = 0; c < NCH; ++c) { mc[c] = mm; const float mn = fmaxf(Bc[c] + mm, Gc[c]); mldec[c] = __expf(Bc[c] + mm - mn); mlm[c] = mm; mm = mn; } mc[NCH] = mm; mlm[NCH] = mm; }
    __syncthreads();
#pragma unroll
    for (int ci = 0; ci < NCH / NWAVES; ++ci) {
        const int c = F.wave + NWAVES * ci, t = c * CHUNK + F.lane;
        mlmx[t] = fmaxf(mc[c], wave_scan_max(areg[ci], F.lane));
    }
    __syncthreads();
}
__device__ __forceinline__ void prep_fox(Frame& F, int l, int bh) {
    LAS float* wtot = (LAS float*)(F.lds);
    const int b = bh >> 3, h = bh & 7;
    const float* gate16 = (const float*)(F.ws + WS_SM + SM_GATE16);
    float* nb = (float*)(F.ws + WS_SM + SM_FNB) + (size_t)bh * SEQ;
    const float bf = INP(F, IN_FXBF)[l * FX_H + h];
    float v[16]; float s = 0.f;
#pragma unroll
    for (int i = 0; i < 16; ++i) { const size_t m = (size_t)b * SEQ + F.tid * 16 + i; s += logsigmoid_f(gate16[m * 16 + 8 + h] + bf); v[i] = s; }
    const float incl = wave_scan_add(s, F.lane);
    if (F.lane == 63) wtot[F.wave] = incl;
    __syncthreads();
    float off = incl - s;
    for (int w = 0; w < F.wave; ++w) off += wtot[w];
#pragma unroll
    for (int i = 0; i < 16; ++i) nb[F.tid * 16 + i] = -1.4426950408889634f * (off + v[i]);
    __syncthreads();
}

__device__ __forceinline__ void unpack8(const v4u q, float (&f)[8]) {
    f[0] = __uint_as_float(q.x << 16); f[1] = __uint_as_float(q.x & 0xffff0000u); f[2] = __uint_as_float(q.y << 16); f[3] = __uint_as_float(q.y & 0xffff0000u);
    f[4] = __uint_as_float(q.z << 16); f[5] = __uint_as_float(q.z & 0xffff0000u); f[6] = __uint_as_float(q.w << 16); f[7] = __uint_as_float(q.w & 0xffff0000u);
}
__device__ __forceinline__ void pool_item(Frame& F, int item) {
    const bf16* U = (const bf16*)(F.ws + WS_NG + SL_POOL * SLAB_BYTES) + F.lane * 8; bf16* CAT = (bf16*)(F.ws + WS_CAT) + F.lane * 8;
    const int grp = F.lane >> 4, w = 2 << grp, m0 = item * 32, tt0 = m0 & (SEQ - 1);
    v4u ring[16];
#pragma unroll
    for (int j = 1; j < 16; ++j) { ring[(16 - j) & 15] = (v4u){0u, 0u, 0u, 0u}; if (tt0 - j >= 0) ring[(16 - j) & 15] = *(const GAS v4u*)(U + (size_t)(m0 - j) * 512); }
    float sum[8];
#pragma unroll
    for (int i = 0; i < 8; ++i) sum[i] = 0.f;
#pragma unroll
    for (int j = 1; j < 16; ++j) { float f[8]; unpack8(ring[(16 - j) & 15], f); const float on = (j < w) ? 1.f : 0.f;
#pragma unroll
        for (int i = 0; i < 8; ++i) sum[i] += on * f[i]; }
#pragma unroll
    for (int r0 = 0; r0 < 32; r0 += 8) {
        v4u cur[8];
#pragma unroll
        for (int j = 0; j < 8; ++j) cur[j] = *(const GAS v4u*)(U + (size_t)(m0 + r0 + j) * 512);
#pragma unroll
        for (int j = 0; j < 8; ++j) { const int r = r0 + j, tt = tt0 + r;
            float c[8]; unpack8(cur[j], c);
#pragma unroll
            for (int i = 0; i < 8; ++i) sum[i] += c[i];
            const int cnt = (tt + 1 < w) ? tt + 1 : w; const float inv = 1.f / (float)cnt;
            v4u o; o.x = pk2(sum[0] * inv - c[0], sum[1] * inv - c[1]); o.y = pk2(sum[2] * inv - c[2], sum[3] * inv - c[3]); o.z = pk2(sum[4] * inv - c[4], sum[5] * inv - c[5]); o.w = pk2(sum[6] * inv - c[6], sum[7] * inv - c[7]);
            *(GAS v4u*)(CAT + (size_t)(m0 + r) * KCAT) = o;
            const v4u a2 = (r - 1 >= 0 || true) ? ((r - 1) >= r0 ? cur[(j - 1) & 7] : ring[(r - 1) & 15]) : ring[0];
            const v4u a4 = ((r - 3) >= r0) ? cur[(j - 3) & 7] : ring[(r - 3) & 15];
            const v4u a8 = ((r - 7) >= r0) ? cur[(j - 7) & 7] : ring[(r - 7) & 15];
            const v4u a16 = ring[(r - 15) & 15];
            v4u old; old.x = grp == 0 ? a2.x : (grp == 1 ? a4.x : (grp == 2 ? a8.x : a16.x)); old.y = grp == 0 ? a2.y : (grp == 1 ? a4.y : (grp == 2 ? a8.y : a16.y));
            old.z = grp == 0 ? a2.z : (grp == 1 ? a4.z : (grp == 2 ? a8.z : a16.z)); old.w = grp == 0 ? a2.w : (grp == 1 ? a4.w : (grp == 2 ? a8.w : a16.w));
            float f[8]; unpack8(old, f);
#pragma unroll
            for (int i = 0; i < 8; ++i) sum[i] -= f[i];
        }
#pragma unroll
        for (int j = 0; j < 8; ++j) ring[(r0 + j) & 15] = cur[j];
    }
}

__device__ __forceinline__ void fox_norm_item(Frame& F, int it) {
    const int bhblk = it >> 3, wv = it & 7, bh = bhblk >> 5, blk = bhblk & 31, b = bh >> 3, h = bh & 7;
    const size_t m = (size_t)b * SEQ + blk * 256 + wv * 32 + (F.lane >> 1); const int col = h * 64 + (F.lane & 1) * 32;
    const bf16* QS = (const bf16*)(F.ws + WS_NG + SL_FQ * SLAB_BYTES) + m * 512 + col; const bf16* KS = (const bf16*)(F.ws + WS_NG + SL_FK * SLAB_BYTES) + m * 512 + col;
    float sq = 0.f, sk = 0.f, dq = 0.f;
#pragma unroll
    for (int i = 0; i < 4; ++i) { float f[8], g[8]; const v4u a = *(const GAS v4u*)(QS + 8 * i), c = *(const GAS v4u*)(KS + 8 * i);
        f[0] = __uint_as_float(a.x << 16); f[1] = __uint_as_float(a.x & 0xffff0000u); f[2] = __uint_as_float(a.y << 16); f[3] = __uint_as_float(a.y & 0xffff0000u); f[4] = __uint_as_float(a.z << 16); f[5] = __uint_as_float(a.z & 0xffff0000u); f[6] = __uint_as_float(a.w << 16); f[7] = __uint_as_float(a.w & 0xffff0000u);
        g[0] = __uint_as_float(c.x << 16); g[1] = __uint_as_float(c.x & 0xffff0000u); g[2] = __uint_as_float(c.y << 16); g[3] = __uint_as_float(c.y & 0xffff0000u); g[4] = __uint_as_float(c.z << 16); g[5] = __uint_as_float(c.z & 0xffff0000u); g[6] = __uint_as_float(c.w << 16); g[7] = __uint_as_float(c.w & 0xffff0000u);
#pragma unroll
        for (int j = 0; j < 8; ++j) { sq += f[j] * f[j]; sk += g[j] * g[j]; dq += f[j] * g[j]; } }
    sq += __shfl_xor(sq, 1); sk += __shfl_xor(sk, 1); dq += __shfl_xor(dq, 1);
    dq = -wave_max(-dq);
    sq = wave_max(sq) * 1.0001f; sk = wave_max(sk) * 1.0001f;
    if (F.lane == 0) { ((float*)(F.ws + WS_SM + SM_FQN))[it] = sq; ((float*)(F.ws + WS_SM + SM_FKN))[it] = sk; ((float*)(F.ws + WS_SM + SM_FXM))[it] = dq; }
}

typedef float f32x16 __attribute__((ext_vector_type(16)));
typedef unsigned u32x2 __attribute__((ext_vector_type(2)));
__device__ __forceinline__ float silu_f(float x) { return x * __builtin_amdgcn_rcpf(1.f + __builtin_amdgcn_exp2f(-1.4426950408889634f * x)); }
__device__ __forceinline__ void conv8(const bf16* slab, size_t m, int tt, int col, const float (&cw)[4][8], float (&o)[8]) {
    v4u q[4];
#pragma unroll
    for (int j = 0; j < 4; ++j) { const size_t mr = (tt - 3 + j >= 0) ? m - 3 + j : m; q[j] = *(const GAS v4u*)(slab + mr * 512 + col); }
#pragma unroll
    for (int i = 0; i < 8; ++i) o[i] = 0.f;
#pragma unroll
    for (int j = 0; j < 4; ++j) { float f[8]; unpack8(q[j], f); const float vld = (tt - 3 + j >= 0) ? 1.f : 0.f;
#pragma unroll
        for (int i = 0; i < 8; ++i) o[i] += (cw[j][i] * vld) * f[i]; }
#pragma unroll
    for (int i = 0; i < 8; ++i) o[i] = silu_f(o[i]);
}
constexpr int KT_P = 72, QS_P = 136;
__device__ __forceinline__ bf16x8 pack_acc8(const f32x16& x, int s) {
    v4u w; w.x = pk2(x[8 * s + 0], x[8 * s + 1]); w.y = pk2(x[8 * s + 2], x[8 * s + 3]); w.z = pk2(x[8 * s + 4], x[8 * s + 5]); w.w = pk2(x[8 * s + 6], x[8 * s + 7]);
    return __builtin_bit_cast(bf16x8, w);
}
__device__ __forceinline__ void conv8r(const v4u (&q)[4], int tt, const LAS float* cw, int col, float (&o)[8]) {
#pragma unroll
    for (int i = 0; i < 8; ++i) o[i] = 0.f;
#pragma unroll
    for (int j = 0; j < 4; ++j) { float f[8]; unpack8(q[j], f); const float vld = (tt - 3 + j >= 0) ? 1.f : 0.f;
        const f32x4 w0 = *(const LAS f32x4*)(cw + j * 512 + col) * vld, w1 = *(const LAS f32x4*)(cw + j * 512 + col + 4) * vld;
#pragma unroll
        for (int i = 0; i < 4; ++i) { o[i] += w0[i] * f[i]; o[4 + i] += w1[i] * f[4 + i]; } }
#pragma unroll
    for (int i = 0; i < 8; ++i) o[i] = silu_f(o[i]);
}
struct RawL { v4u k[2][4]; v4u v[2]; float fp, ip; };
__device__ __forceinline__ void mlstm_L_load(Frame& F, int u, RawL& R) {
    const int bh = u >> 7, c = u & (NCH - 1), b = bh >> 2, h = bh & 3;
    const bf16* KS = (const bf16*)(F.ws + WS_NG + SL_MK * SLAB_BYTES); const bf16* VS = (const bf16*)(F.ws + WS_NG + SL_MV * SLAB_BYTES);
    const int s = F.lane, tt = c * CHUNK + s; const size_t m = (size_t)b * SEQ + tt;
#pragma unroll
    for (int half = 0; half < 2; ++half) { const int col = h * ML_DH + (F.wave + 8 * half) * 8;
#pragma unroll
        for (int j = 0; j < 4; ++j) { const size_t mr = (tt - 3 + j >= 0) ? m - 3 + j : m; R.k[half][j] = *(const GAS v4u*)(KS + mr * 512 + col); }
        R.v[half] = *(const GAS v4u*)(VS + m * 512 + col); }
    const float* gate16 = (const float*)(F.ws + WS_SM + SM_GATE16) + m * 16;
    R.fp = gate16[4 + h]; R.ip = gate16[h];
}
__device__ __forceinline__ void mlstm_L_phase(Frame& F, int l) {
    LAS bf16* Kt = (LAS bf16*)(F.lds); LAS bf16* Vt = Kt + 128 * KT_P; LAS float* wk = (LAS float*)(F.lds + 2 * 128 * KT_P * 2); LAS float* cwk = (LAS float*)(F.lds + 40960);
    for (int i = F.tid; i < 4 * 512; i += NWAVES * 64) cwk[i] = INP(F, IN_CONVW)[(size_t)l * 4 * 1024 + (i >> 9) * 1024 + 512 + (i & 511)];
    const int NU = BATCH * ML_H * NCH;
    float b_f[ML_H], b_i[ML_H];
#pragma unroll
    for (int i = 0; i < ML_H; ++i) { b_f[i] = INP(F, IN_MLBF)[l * ML_H + i]; b_i[i] = INP(F, IN_MLBI)[l * ML_H + i]; }
    int u = F.vcu; if (u >= NU) { __syncthreads(); return; }
    RawL cur; mlstm_L_load(F, u, cur);
    __syncthreads();
    for (; u < NU; u += F.G) {
        const int bh = u >> 7, h = bh & 3;
        if (F.tid < CHUNK) {
            const float lf = logsigmoid_f(cur.fp + b_f[h]), li = cur.ip + b_i[h];
            const float bc = wave_scan_add(lf, F.lane), a = li - bc, amax = wave_max(a);
            wk[F.tid] = __expf(a - amax);
            const int c = u & (NCH - 1);
            ((float*)(F.ws + WS_SM + SM_MLB))[(size_t)bh * SEQ + c * CHUNK + F.tid] = bc; ((float*)(F.ws + WS_SM + SM_MLA))[(size_t)bh * SEQ + c * CHUNK + F.tid] = a;
            if (F.tid == 63) { float* bg = (float*)(F.ws + WS_SM + SM_MLBG) + 2 * u; bg[0] = bc; bg[1] = bc + amax; }
        }
        __syncthreads();
        {   const int s = F.lane, tt = (u & (NCH - 1)) * CHUNK + s;
#pragma unroll
            for (int half = 0; half < 2; ++half) { const int cg = F.wave + 8 * half, col = h * ML_DH + cg * 8;
                float kk[8]; conv8r(cur.k[half], tt, cwk, col, kk);
                float vv[8]; unpack8(cur.v[half], vv); const float ws = wk[s];
#pragma unroll
                for (int i = 0; i < 8; ++i) { Kt[(cg * 8 + i) * KT_P + s] = (bf16)f2bf(kk[i] * 0.08838834764831845f); Vt[(cg * 8 + i) * KT_P + s] = (bf16)f2bf(vv[i] * ws); } }
        }
        __syncthreads();
        if (u + F.G < NU) mlstm_L_load(F, u + F.G, cur);
        {   const int r = F.lane & 31, hi = F.lane >> 5, kb = F.wave >> 1;
            f32x16 acc[2]; acc[0] = f32x16{}; acc[1] = f32x16{};
#pragma unroll
            for (int sp = 0; sp < 4; ++sp) { const bf16x8 a = *(const LAS bf16x8*)(Kt + (kb * 32 + r) * KT_P + 16 * sp + 8 * hi);
#pragma unroll
                for (int j = 0; j < 2; ++j) { const int vb = 2 * (F.wave & 1) + j; const bf16x8 bb = *(const LAS bf16x8*)(Vt + (vb * 32 + r) * KT_P + 16 * sp + 8 * hi);
                    acc[j] = __builtin_amdgcn_mfma_f32_32x32x16_bf16(a, bb, acc[j], 0, 0, 0); } }
            GAS bf16x8* img = (GAS bf16x8*)(F.ws + WS_MLC + (size_t)u * 32768);
#pragma unroll
            for (int j = 0; j < 2; ++j) { const int vb = 2 * (F.wave & 1) + j;
#pragma unroll
                for (int s = 0; s < 2; ++s) img[((vb * 4 + kb) * 2 + s) * 64 + F.lane] = pack_acc8(acc[j], s); }
        }
        if (F.tid < ML_DH) { float a = 0.f;
#pragma unroll 8
            for (int s = 0; s < CHUNK; ++s) a += wk[s] * __uint_as_float((unsigned)Kt[F.tid * KT_P + s] << 16);
            ((float*)(F.ws + WS_SM + SM_MLN))[(size_t)u * ML_DH + F.tid] = a; }
        __syncthreads();
    }
}
__device__ __forceinline__ void mlstm_S(Frame& F) {
    LAS float* dec = (LAS float*)(F.lds); LAS float* cor = dec + NCH;
    for (int unit = F.vcu; unit < 16 * 16; unit += F.G) {
        const int bh = unit >> 4, part = unit & 15;
        if (F.tid == 0) { const float* bg = (const float*)(F.ws + WS_SM + SM_MLBG) + 2 * bh * NCH; float* mlm = (float*)(F.ws + WS_SM + SM_MLM) + bh * 132; float mm = 0.f;
            for (int c = 0; c < NCH; ++c) { const float B = bg[2 * c], G = bg[2 * c + 1], mn = fmaxf(B + mm, G); dec[c] = __expf(B + mm - mn); cor[c] = __expf(G - mn); mlm[c] = mm; mm = mn; }
            mlm[NCH] = mm; }
        __syncthreads();
        {   const int e2 = part * 512 + F.tid; GAS unsigned* p = (GAS unsigned*)(F.ws + WS_MLC + (size_t)bh * NCH * 32768) + e2;
            float r0 = 0.f, r1 = 0.f;
            for (int c0 = 0; c0 < NCH; c0 += 16) { unsigned q[16];
#pragma unroll
                for (int i = 0; i < 16; ++i) q[i] = p[(size_t)(c0 + i) * 8192];
#pragma unroll
                for (int i = 0; i < 16; ++i) { const float d = dec[c0 + i], k = cor[c0 + i]; p[(size_t)(c0 + i) * 8192] = pk2(r0, r1);
                    r0 = d * r0 + k * __uint_as_float(q[i] << 16); r1 = d * r1 + k * __uint_as_float(q[i] & 0xffff0000u); } } }
        if (part == 0 && F.tid < ML_DH) { float* p = (float*)(F.ws + WS_SM + SM_MLN) + (size_t)bh * NCH * ML_DH + F.tid;
            float r = 0.f;
            for (int c0 = 0; c0 < NCH; c0 += 16) { float q[16];
#pragma unroll
                for (int i = 0; i < 16; ++i) q[i] = p[(size_t)(c0 + i) * ML_DH];
#pragma unroll
                for (int i = 0; i < 16; ++i) { p[(size_t)(c0 + i) * ML_DH] = r; r = dec[c0 + i] * r + cor[c0 + i] * q[i]; } } }
        __syncthreads();
    }
}
#define O_BAR() do { asm volatile("s_waitcnt lgkmcnt(0)" ::: "memory"); __builtin_amdgcn_s_barrier(); asm volatile("" ::: "memory"); } while (0)
constexpr int O_RAWQ = 73728, O_RAWK = O_RAWQ + 68 * 256, O_RAWV = O_RAWK + 68 * 256, O_END = O_RAWV + 64 * 256;
static_assert(O_END + 3 * 2 * 1024 <= RING_BYTES, "mLSTM O-phase LDS map");
__device__ __forceinline__ void mlstm_O_dma(Frame& F, int u) {
    const int bh = u >> 7, c = u & (NCH - 1), b = bh >> 2, h = bh & 3;
    const size_t seq0 = (size_t)b * SEQ; const int t0 = c * CHUNK;
    for (int i = F.wave; i < 50; i += NWAVES) {
        const int ten = i < 17 ? 0 : (i < 34 ? 1 : 2), ii = i - 17 * ten, row = 4 * ii + (F.lane >> 4);
        int t = (ten == 2) ? t0 + row : t0 - 3 + row; t = t < 0 ? 0 : (t > t0 + CHUNK - 1 ? t0 + CHUNK - 1 : t);
        const bf16* src = (const bf16*)(F.ws + WS_NG + (size_t)(ten == 0 ? SL_MQ : (ten == 1 ? SL_MK : SL_MV)) * SLAB_BYTES) + (seq0 + t) * 512 + h * ML_DH + (((F.lane & 15) ^ (row & 15)) * 8);
        const int dst = (ten == 0 ? O_RAWQ : (ten == 1 ? O_RAWK : O_RAWV)) + ii * 1024;
        __builtin_amdgcn_global_load_lds((const GAS unsigned*)src, (LAS unsigned*)(F.lds + dst), 16, 0, 0);
    }
}
__device__ __forceinline__ void conv8l(const LAS bf16* raw, int s, int tt, const LAS float* cw, int cg, int col, float (&o)[8]) {
#pragma unroll
    for (int i = 0; i < 8; ++i) o[i] = 0.f;
#pragma unroll
    for (int j = 0; j < 4; ++j) { float f[8]; unpack8(*(const LAS v4u*)(raw + (s + j) * 128 + ((cg ^ ((s + j) & 15)) * 8)), f); const float vld = (tt - 3 + j >= 0) ? 1.f : 0.f;
        const f32x4 w0 = *(const LAS f32x4*)(cw + j * 512 + col) * vld, w1 = *(const LAS f32x4*)(cw + j * 512 + col + 4) * vld;
#pragma unroll
        for (int i = 0; i < 4; ++i) { o[i] += w0[i] * f[i]; o[4 + i] += w1[i] * f[4 + i]; } }
#pragma unroll
    for (int i = 0; i < 8; ++i) o[i] = silu_f(o[i]);
}
__device__ __forceinline__ void mlstm_O_phase(Frame& F, int l) {
    LAS bf16* Qs = (LAS bf16*)(F.lds); LAS bf16* Ks = Qs + 64 * QS_P; LAS bf16* Vt = Ks + 64 * QS_P;
    LAS float* fa = (LAS float*)(F.lds + (2 * 64 * QS_P + 128 * KT_P) * 2); LAS float* fmx = fa + 64; LAS float* fb = fa + 128; LAS float* nvec = fa + 192; LAS float* ssq = fa + 320;
    LAS float* cwq = (LAS float*)(F.lds + 57344); LAS float* cwk = cwq + 4 * 512;
    LAS float* psm = (LAS float*)(F.lds + 55552); LAS float* nqp = psm + 96; LAS bf16x8* pimg = (LAS bf16x8*)(F.lds + O_END);
    const LAS bf16* rawq = (const LAS bf16*)(F.lds + O_RAWQ); const LAS bf16* rawk = (const LAS bf16*)(F.lds + O_RAWK); const LAS bf16* rawv = (const LAS bf16*)(F.lds + O_RAWV);
    for (int i = F.tid; i < 4 * 512; i += NWAVES * 64) { cwq[i] = INP(F, IN_CONVW)[(size_t)l * 4 * 1024 + (i >> 9) * 1024 + (i & 511)]; cwk[i] = INP(F, IN_CONVW)[(size_t)l * 4 * 1024 + (i >> 9) * 1024 + 512 + (i & 511)]; }
    const int NU = BATCH * ML_H * NCH;
    int u = F.vcu; if (u >= NU) { __syncthreads(); return; }
    mlstm_O_dma(F, u);
    const bf16* OS = (const bf16*)(F.ws + WS_NG + SL_MO * SLAB_BYTES);
    const int r = F.lane & 31, hi = F.lane >> 5, tb = F.wave & 1, vb = F.wave >> 1;
    for (; u < NU; u += F.G) {
    const int bh = u >> 7, c = u & (NCH - 1), b = bh >> 2, h = bh & 3;
    asm volatile("s_waitcnt vmcnt(0)" ::: "memory"); O_BAR();
    const float m_c = ((const float*)(F.ws + WS_SM + SM_MLM))[bh * 132 + c];
    bf16x8 cf[4][2];
    {   const GAS bf16x8* img = (const GAS bf16x8*)(F.ws + WS_MLC + (size_t)u * 32768);
#pragma unroll
        for (int kb = 0; kb < 4; ++kb)
#pragma unroll
            for (int s = 0; s < 2; ++s) cf[kb][s] = img[((vb * 4 + kb) * 2 + s) * 64 + F.lane]; }
    u32x2 oww[4];
    {   const size_t m = (size_t)b * SEQ + c * CHUNK + tb * 32 + r;
#pragma unroll
        for (int q = 0; q < 4; ++q) oww[q] = *(const GAS u32x2*)(OS + m * 512 + h * ML_DH + vb * 32 + 8 * q + 4 * hi); }
    float g0 = 0.f, g1 = 0.f, g2 = 0.f;
    {   const float* mlb = (const float*)(F.ws + WS_SM + SM_MLB) + (size_t)bh * SEQ; const float* mla = (const float*)(F.ws + WS_SM + SM_MLA) + (size_t)bh * SEQ; const float* mlmx = (const float*)(F.ws + WS_SM + SM_MLMX) + (size_t)bh * SEQ;
        if (F.tid < CHUNK) { g0 = mla[c * CHUNK + F.tid]; g2 = mlb[c * CHUNK + F.tid]; g1 = fmaxf(m_c, wave_scan_max(g0, F.lane)); }
        else if (F.tid < CHUNK + ML_DH) g0 = ((const float*)(F.ws + WS_SM + SM_MLN))[(size_t)u * ML_DH + F.tid - CHUNK]; }
    {   const int s = F.lane, tt = c * CHUNK + s;
#pragma unroll
        for (int half = 0; half < 2; ++half) { const int cg = F.wave + 8 * half, col = h * ML_DH + cg * 8;
            float qq[8], kk[8], vv[8]; conv8l(rawq, s, tt, cwq, cg, col, qq); conv8l(rawk, s, tt, cwk, cg, col, kk); unpack8(*(const LAS v4u*)(rawv + s * 128 + ((cg ^ (s & 15)) * 8)), vv);
            v4u wq, wkk; wq.x = pk2(qq[0], qq[1]); wq.y = pk2(qq[2], qq[3]); wq.z = pk2(qq[4], qq[5]); wq.w = pk2(qq[6], qq[7]);
            const float sc = 0.08838834764831845f;
            wkk.x = pk2(kk[0] * sc, kk[1] * sc); wkk.y = pk2(kk[2] * sc, kk[3] * sc); wkk.z = pk2(kk[4] * sc, kk[5] * sc); wkk.w = pk2(kk[6] * sc, kk[7] * sc);
            *(LAS v4u*)(Qs + s * QS_P + cg * 8) = wq; *(LAS v4u*)(Ks + s * QS_P + cg * 8) = wkk;
#pragma unroll
            for (int i = 0; i < 8; ++i) Vt[(cg * 8 + i) * KT_P + s] = (bf16)f2bf(vv[i]); }
    }
    if (F.tid < CHUNK) { fa[F.tid] = g0; fmx[F.tid] = g1; fb[F.tid] = g2; }
    else if (F.tid < CHUNK + ML_DH) nvec[F.tid - CHUNK] = g0;
    O_BAR();
    if (u + F.G < NU) mlstm_O_dma(F, u + F.G);
    const int t = tb * 32 + r;
    const float Mx_t = fmx[t], m_t = fb[t] + Mx_t, w_int = __expf(m_c - Mx_t);
    if (F.wave < 3) {
        const int tbs = F.wave ? 1 : 0, sbs = F.wave == 2 ? 1 : 0, ts = tbs * 32 + r; const float Mxs = fmx[ts];
        f32x16 x = f32x16{};
#pragma unroll
        for (int ks = 0; ks < 8; ++ks) { const bf16x8 a = *(const LAS bf16x8*)(Ks + (sbs * 32 + r) * QS_P + 16 * ks + 8 * hi); const bf16x8 q = *(const LAS bf16x8*)(Qs + ts * QS_P + 16 * ks + 8 * hi);
            x = __builtin_amdgcn_mfma_f32_32x32x16_bf16(a, q, x, 0, 0, 0); }
        float ps = 0.f;
#pragma unroll
        for (int rr = 0; rr < 16; ++rr) { const int s = sbs * 32 + (rr & 3) + 8 * (rr >> 2) + 4 * hi; const float pv = (s <= ts) ? __expf(fa[s] - Mxs) * x[rr] : 0.f; x[rr] = pv; ps += pv; }
        ps += __shfl_xor(ps, 32);
        pimg[(F.wave * 2 + 0) * 64 + F.lane] = pack_acc8(x, 0); pimg[(F.wave * 2 + 1) * 64 + F.lane] = pack_acc8(x, 1);
        if (hi == 0) psm[F.wave * 32 + r] = ps;
    }
    {   float nq = 0.f;
#pragma unroll
        for (int i = 0; i < 2; ++i) { float f[8]; unpack8(*(const LAS v4u*)(Qs + t * QS_P + 32 * vb + 16 * hi + 8 * i), f);
#pragma unroll
            for (int j = 0; j < 8; ++j) nq += f[j] * nvec[32 * vb + 16 * hi + 8 * i + j]; }
        nq += __shfl_xor(nq, 32);
        if (hi == 0) nqp[vb * 64 + t] = nq; }
    f32x16 acc = f32x16{};
#pragma unroll
    for (int kb = 0; kb < 4; ++kb)
#pragma unroll
        for (int s = 0; s < 2; ++s) { const u32x2 lo = *(const LAS u32x2*)(Qs + t * QS_P + kb * 32 + 16 * s + 4 * hi), hi2 = *(const LAS u32x2*)(Qs + t * QS_P + kb * 32 + 16 * s + 8 + 4 * hi);
            v4u w; w.x = lo.x; w.y = lo.y; w.z = hi2.x; w.w = hi2.y;
            acc = __builtin_amdgcn_mfma_f32_32x32x16_bf16(cf[kb][s], __builtin_bit_cast(bf16x8, w), acc, 0, 0, 0); }
#pragma unroll
    for (int rr = 0; rr < 16; ++rr) acc[rr] *= w_int;
    O_BAR();
    float psum = 0.f;
#pragma unroll
    for (int sb = 0; sb < 2; ++sb) {
        if (sb <= tb) { const int blk = tb == 0 ? 0 : 1 + sb; psum += psm[blk * 32 + r];
#pragma unroll
            for (int s = 0; s < 2; ++s) { const u32x2 lo = *(const LAS u32x2*)(Vt + (vb * 32 + r) * KT_P + sb * 32 + 16 * s + 4 * hi), hi2 = *(const LAS u32x2*)(Vt + (vb * 32 + r) * KT_P + sb * 32 + 16 * s + 8 + 4 * hi);
                v4u w; w.x = lo.x; w.y = lo.y; w.z = hi2.x; w.w = hi2.y;
                acc = __builtin_amdgcn_mfma_f32_32x32x16_bf16(__builtin_bit_cast(bf16x8, w), pimg[(blk * 2 + s) * 64 + F.lane], acc, 0, 0, 0); }
        }
    }
    const float nq = (nqp[t] + nqp[64 + t]) + (nqp[128 + t] + nqp[192 + t]);
    const float den = w_int * nq + psum, inv = 1.f / fmaxf(fabsf(den), __expf(-m_t));
    float sq = 0.f;
#pragma unroll
    for (int rr = 0; rr < 16; ++rr) { acc[rr] *= inv; sq += acc[rr] * acc[rr]; }
    sq += __shfl_xor(sq, 32);
    if (hi == 0) ssq[vb * 64 + t] = sq;
    O_BAR();
    const float rstd = 1.f / sqrtf((ssq[t] + ssq[64 + t] + ssq[128 + t] + ssq[192 + t]) * (1.f / ML_DH) + NORM_EPS);
    {   const size_t m = (size_t)b * SEQ + c * CHUNK + t; bf16* CAT = (bf16*)(F.ws + WS_CAT);
#pragma unroll
        for (int q = 0; q < 4; ++q) { const int v0 = vb * 32 + 8 * q + 4 * hi, col = h * ML_DH + v0;
            const u32x2 ow = oww[q]; const f32x4 gn = *(const GAS f32x4*)(INP(F, IN_MLNG) + (size_t)l * 512 + col);
            const float o0 = sigmoid_f(__uint_as_float(ow.x << 16)), o1 = sigmoid_f(__uint_as_float(ow.x & 0xffff0000u)), o2 = sigmoid_f(__uint_as_float(ow.y << 16)), o3 = sigmoid_f(__uint_as_float(ow.y & 0xffff0000u));
            u32x2 w; w.x = pk2(acc[4 * q] * rstd * gn.x * o0, acc[4 * q + 1] * rstd * gn.y * o1); w.y = pk2(acc[4 * q + 2] * rstd * gn.z * o2, acc[4 * q + 3] * rstd * gn.w * o3);
            *(GAS u32x2*)(CAT + m * KCAT + 512 + col) = w; }
    }
    }
    asm volatile("s_waitcnt vmcnt(0)" ::: "memory"); O_BAR();
}
#undef O_BAR

#ifndef SUBP
#define SUBP 0
#endif
#ifndef MK_MULTI
#define MK_MULTI 0
#endif
constexpr int NPH = 1 + (8 + 2) + (1 + 8 + 4) + 2;
#ifndef PH_MASK
#define PH_MASK 0xffffffffu
#endif
#ifndef PROBE_MASK
#define PROBE_MASK 0u
#endif
#define PH_BEGIN(id) if (ph >= lo && ph < hi) { if constexpr (((PH_MASK) >> (id)) & 1u) { for (int rep_ = 0; rep_ < 1 + (int)(((PROBE_MASK) >> (id)) & 1u); ++rep_) { Frame F = FK; { size_t z_ = 0; int zi_ = 0; asm volatile("" : "+v"(F.tid), "+s"(z_), "+s"(zi_)); \
        F.lane = F.tid & 63; F.ws = FK.ws + z_; F.out = (float*)((char*)FK.out + z_); F.zi = zi_; } const int gw = F.vcu * NWAVES + F.wave, NGWV = F.G * NWAVES; (void)gw; (void)NGWV;
#define PH_END __syncthreads(); } } if (ph + 1 < hi) { XcdBarrier b2_ = bar; size_t zb_ = 0; asm volatile("" : "+s"(zb_)); b2_.bar = bar.bar + zb_; xcd_barrier(b2_); } } ++ph;
#define HB ((bf16*)(F.ws + WS_HB))
#define CAT ((bf16*)(F.ws + WS_CAT))
#define SLAB ((bf16*)(F.ws + WS_NG))
#define GATE ((bf16*)(F.ws + WS_GATE))
#define WL ((bf16*)(F.ws + WS_W + (size_t)l * W_LAYER))
#define XBP ((bf16*)((char*)F.out + (size_t)M * D * 2))

template <int l> __device__ __forceinline__ void layer_phases(Frame& FK, int& ph, const int lo, const int hi, const XcdBarrier& bar, unsigned char* lds) {
        if constexpr (l > 0) { PH_BEGIN(1) phase_norm_mix<true>(F, XBP, l); PH_END }
        PH_BEGIN(2)
            pg8::Gemm g{HB, WL + W_NG / 2, M, NGW, D}; pg8::StaticOrder S; S.init(M, NGW, F.G, F.blk);
            pg8::EpiSlab E{SLAB, (size_t)M * 512, SL_FQ, attn_body::C2};
            pg8::gemm_phase<pg8::EpiSlab, pg8::StaticOrder, true, true>(F.lds + RING_OFF, g, S, E);
        PH_END
        PH_BEGIN(3)
            for (int s = F.blk; s < BATCH * FX_H; s += F.G) prep_fox(F, l, s);
            for (int rp = 0; rp < (SUBP == 1 ? 2 : 1); ++rp) for (int it = gw; it < M / 32; it += NGWV) pool_item(F, it);
            for (int rp = 0; rp < (SUBP == 2 ? 2 : 1); ++rp) for (int it = gw; it < BATCH * FX_H * 32 * 8; it += NGWV) fox_norm_item(F, it);
            for (int rp = 0; rp < (SUBP == 3 ? 2 : 1); ++rp) mlstm_L_phase(F, l);
        PH_END
        PH_BEGIN(4)
            mlstm_S(F);
            for (int ui = gw; ui < BATCH * FX_H * 32; ui += NGWV) { const int bh = ui >> 5, qb = ui & 31;
                const int t0 = attn_body::attn_t0(qb, (const float*)(F.ws + WS_SM + SM_FNB) + (size_t)bh * SEQ, (const float*)(F.ws + WS_SM + SM_FQN) + bh * 256, (const float*)(F.ws + WS_SM + SM_FKN) + bh * 256, (const float*)(F.ws + WS_SM + SM_FXM) + bh * 256, F.lane);
                if (F.lane == 0) ((int*)(F.ws + WS_SM + SM_FT0))[ui] = t0; }
        PH_END
        PH_BEGIN(18)
            for (int rp = 0; rp < (SUBP == 4 ? 2 : 1); ++rp) mlstm_O_phase(F, l);
            const attn_body::AttnTensors AT{(const attn_body::bf16*)(SLAB + (size_t)SL_FQ * M * 512), (const attn_body::bf16*)(SLAB + (size_t)SL_FK * M * 512), (const attn_body::bf16*)(SLAB + (size_t)SL_FV * M * 512),
                                            (attn_body::bf16*)CAT, (const float*)(F.ws + WS_SM + SM_FNB), (const float*)(F.ws + WS_SM + SM_FQN), (const float*)(F.ws + WS_SM + SM_FKN), (const int*)(F.ws + WS_SM + SM_FT0)};
            attn_body::attn_phase_dyn<8>((char*)lds + RING_OFF, AT, (unsigned*)(F.ctl + 2048 + 64 * l), F.MISC + 0);
            quant_rows_fp8(F, HB, F.ws + WS_NG + (size_t)SL_POOL * SLAB_BYTES);
        PH_END
        PH_BEGIN(6)
            pg8::Gemm g{(const bf16*)(F.ws + WS_NG + (size_t)SL_POOL * SLAB_BYTES), WL + W_GT / 2, M, NGT, D / 2}; pg8::StaticOrder S; S.init(M, NGT, F.G, F.blk);
            pg8::EpiSig E{(unsigned char*)GATE, 1.f / (FP8_ASCALE * FP8_WSCALE)};
            pg8::gemm_phase<pg8::EpiSig, pg8::StaticOrder, true, true, true>(F.lds + RING_OFF, g, S, E);
        PH_END
        PH_BEGIN(7)
            pg8::Gemm g{CAT, WL + W_CAT / 2, M, D, KCAT}; pg8::StaticOrder S; S.init(M, D, F.G, F.blk);
            pg8::EpiMerge E{(const unsigned char*)GATE, HB};
            pg8::gemm_phase<pg8::EpiMerge, pg8::StaticOrder, true, true>(F.lds + RING_OFF, g, S, E);
        PH_END
        PH_BEGIN(8)
            pg8::Gemm g{HB, WL + W_OUT / 2, M, D, D}; pg8::StaticOrder S; S.init(M, D, F.G, F.blk);
            if constexpr (l == 0) { pg8::EpiResB<true> E{INP(F, IN_X), XBP}; pg8::gemm_phase<pg8::EpiResB<true>, pg8::StaticOrder, true, true>(F.lds + RING_OFF, g, S, E); }
            else { pg8::EpiResB<false> E{XBP, XBP}; pg8::gemm_phase<pg8::EpiResB<false>, pg8::StaticOrder, true, true>(F.lds + RING_OFF, g, S, E); }
        PH_END
        if constexpr (l == 0) {
            PH_BEGIN(9) phase_norm_ffn(F, XBP); PH_END
            PH_BEGIN(10)
                pg8::Gemm g{HB, (const bf16*)(F.ws + WS_WGU), M, 2 * DFF, D}; pg8::StaticOrder S; S.init(M, 2 * DFF, F.G, F.blk);
                pg8::EpiSwiGLU E{(bf16*)(F.ws + WS_ACT0), DFF};
                pg8::gemm_phase<pg8::EpiSwiGLU, pg8::StaticOrder, true, true>(F.lds + RING_OFF, g, S, E);
            PH_END
            PH_BEGIN(11)
                pg8::Gemm g{(const bf16*)(F.ws + WS_ACT0), (const bf16*)(F.ws + WS_WDN), M, D, DFF}; pg8::StaticOrder S; S.init(M, D, F.G, F.blk);
                pg8::EpiResB<false> E{XBP, XBP};
                pg8::gemm_phase<pg8::EpiResB<false>, pg8::StaticOrder, true, true>(F.lds + RING_OFF, g, S, E);
            PH_END
        } else {
            PH_BEGIN(12)
                phase_route1(F, XBP);
                __syncthreads();
                LAS float* scr = (LAS float*)(F.lds + F.wave * 16384);
                for (int it = gw; it < CI_MOE; it += NGWV) conv_item_moe(F, it, scr);
            PH_END
            PH_BEGIN(13) phase_route2(F, XBP); PH_END
#define MOE_UP(k_, S_) do { pg8::Gemm g{(const bf16*)(F.ws + WS_XS + (size_t)(k_) * MOE_KROWS * D), (const bf16*)(F.ws + WS_MOEGU), MOE_KROWS, 2 * DFE, D / 2}; \
                    pg8::EpiSwiGLU8 E{F.ws + WS_ACT1 + (size_t)(k_) * MOE_KROWS * DFE, DFE, 1.f / (FP8_ASCALE * FP8_WSCALE), FP8_ASCALE}; \
                    pg8::gemm_phase<pg8::EpiSwiGLU8, decltype(S_), true, true, true>(F.lds + RING_OFF, g, S_, E); } while (0)
#define MOE_DOWN(k_) do { pg8::Gemm g{(const bf16*)(F.ws + WS_ACT1 + (size_t)(k_) * MOE_KROWS * DFE), (const bf16*)(F.ws + WS_MOEDN), MOE_KROWS, D, DFE / 2}; pg8::MoeOrder S; S.init(nM[k_], D / 256, F.G, F.blk, tile_e + (k_) * MOE_KTILES); \
                    pg8::EpiMoeDown E{(bf16*)(F.ws + ((k_) == 0 ? WS_Y0 : WS_Y1)), (const int*)(sm + MO_ROWTOK) + (k_) * MOE_KROWS, (const float*)(sm + MO_ROWG) + (k_) * MOE_KROWS, 1.f / (FP8_ASCALE * FP8_WSCALE)}; \
                    pg8::gemm_phase<pg8::EpiMoeDown, pg8::MoeOrder, true, true, true>(F.lds + RING_OFF, g, S, E); } while (0)
#define MOE_TABLES unsigned char* sm = F.ws + WS_SM + SM_MOE; LAS int* tile_e = (LAS int*)(F.lds + LDSCTL_OFF + 1024); \
                    for (int i_ = F.tid; i_ < 2 * MOE_KTILES; i_ += NWAVES * 64) tile_e[i_] = __hip_atomic_load((const int*)(sm + MO_TILEE) + i_, RLX_AGENT); __syncthreads(); \
                    const int nM[2] = {__builtin_amdgcn_readfirstlane(__hip_atomic_load((const int*)(sm + MO_NT), RLX_AGENT)), __builtin_amdgcn_readfirstlane(__hip_atomic_load((const int*)(sm + MO_NT) + 1, RLX_AGENT))};
            PH_BEGIN(14)
                MOE_TABLES
                pg8::MoeOrder S; S.init(nM[0], 2 * DFE / 256, F.G, F.blk, tile_e);
                MOE_UP(0, S);
            PH_END
            PH_BEGIN(15)
                MOE_TABLES
                MOE_DOWN(0);
                const int Nd = nM[0] * (D / 256), Nu = nM[1] * (2 * DFE / 256), qd = Nd / F.G, rd = Nd % F.G;
                const float T = (3.5f * (float)Nd + (float)Nu) / (float)F.G;
                float cum = 0.f; int lo_u = 0, hi_u = 0;
                for (int v = 0; v <= F.vcu; ++v) { const int w = (F.G % 8 == 0) ? (v % (F.G / 8)) * 8 + v / (F.G / 8) : v; const float cap = fmaxf(T - 3.5f * (float)(qd + (w < rd ? 1 : 0)), 0.f);
                    lo_u = (int)(cum + 0.5f); cum += cap; hi_u = (int)(cum + 0.5f); }
                if (F.vcu == F.G - 1 || hi_u > Nu) hi_u = Nu; if (lo_u > Nu) lo_u = Nu;
                lo_u = __builtin_amdgcn_readfirstlane(lo_u); hi_u = __builtin_amdgcn_readfirstlane(hi_u);
                pg8::MoeRange R; R.init(nM[1], 2 * DFE / 256, lo_u, hi_u, tile_e + MOE_KTILES);
                MOE_UP(1, R);
            PH_END
            PH_BEGIN(19)
                MOE_TABLES
                MOE_DOWN(1);
            PH_END
#undef MOE_UP
#undef MOE_DOWN
#undef MOE_TABLES
        }
    }
struct Args { const float* in[24]; float* out; unsigned char* ws; int ph_lo, ph_hi; };
__global__ void __launch_bounds__(NWAVES * 64, 2) fwd(Args args) {
    extern __shared__ __attribute__((aligned(16))) unsigned char lds[];
    Frame FK;
    FK.lds = (LAS unsigned char*)lds;
    FK.MISC = (volatile LAS unsigned*)(FK.lds + MISC_OFF);
    FK.tid = threadIdx.x; FK.lane = FK.tid & 63; FK.wave = __builtin_amdgcn_readfirstlane(FK.tid >> 6);
    FK.G = gridDim.x; FK.blk = blockIdx.x; { const int bx = blockIdx.x; FK.vcu = (FK.G % 8 == 0) ? (bx % 8) * (FK.G / 8) + bx / 8 : bx; }
    FK.ws = args.ws; FK.ctl = (gu32*)(args.ws + WS_CTL); FK.out = args.out;
    FK.in = args.in; FK.zi = 0;
    for (int u = FK.tid; u < (LDS_BYTES - LDSCTL_OFF) / 4; u += NWAVES * 64) ((LAS unsigned*)(FK.lds + LDSCTL_OFF))[u] = 0u;
    __syncthreads();
    const int lo = args.ph_lo, hi = args.ph_hi;
    XcdBarrier bar; bar.bar = (unsigned*)(FK.ctl + CW_BAR); bar.x = 0; bar.st = nullptr;
    if (hi - lo > 1) bar = xcd_barrier_post((unsigned*)(FK.ctl + CW_BAR), FK.MISC + 8);
    int ph = 0;
    PH_BEGIN(0)
        LAS float* scr = (LAS float*)(F.lds + F.wave * 16384);
        for (int it = gw; it < CI_MAIN; it += NGWV) conv_item_main(F, it, scr);
        pool_fold(F);
        __syncthreads();
        phase_norm_mix<false>(F, INP(F, IN_X), 0);
    PH_END

    layer_phases<0>(FK, ph, lo, hi, bar, lds);
    layer_phases<1>(FK, ph, lo, hi, bar, lds);
    PH_BEGIN(16) phase_norm_final(F, XBP, F.out, (float*)(F.ws + WS_ACT1)); PH_END
    PH_BEGIN(20) phase_copy_upper(F, (const float*)(F.ws + WS_ACT1), F.out); PH_END
#undef PH_BEGIN
#undef HB
#undef CAT
#undef SLAB
#undef GATE
#undef WL
#undef XBP
#undef PH_END
}

extern "C" void kernel_launch(void* const* d_in, const int* in_sizes, int n_in, void* d_out, int out_size, void* d_ws, size_t ws_size, hipStream_t stream) {
    static int grid = 0;
    if (grid == 0) {
        if (n_in != 24 || in_sizes[0] != M * D || out_size != M * D || ws_size < WS_END) { fprintf(stderr, "kernel_launch: built for 24 inputs, x/out of %d floats, >= %zu bytes of workspace; got n_in %d, in0 %d, out %d, ws %zu; nothing launched\n", M * D, (size_t)WS_END, n_in, n_in > 0 ? in_sizes[0] : -1, out_size, ws_size); grid = -1; return; }
        int dev = 0, cus = 0, per_cu = 0;
        if (hipGetDevice(&dev) != hipSuccess || hipDeviceGetAttribute(&cus, hipDeviceAttributeMultiprocessorCount, dev) != hipSuccess) { fprintf(stderr, "kernel_launch: hipGetDevice / hipDeviceGetAttribute failed\n"); grid = -1; return; }
        if (hipFuncSetAttribute((const void*)fwd, hipFuncAttributeMaxDynamicSharedMemorySize, LDS_BYTES) != hipSuccess) { fprintf(stderr, "kernel_launch: hipFuncSetAttribute failed\n"); grid = -1; return; }
        if (hipOccupancyMaxActiveBlocksPerMultiprocessor(&per_cu, (const void*)fwd, NWAVES * 64, LDS_BYTES) != hipSuccess || per_cu < 1)
            fprintf(stderr, "kernel_launch: note: the occupancy query reports %d workgroups per CU\n", per_cu);
        (void)hipGetLastError();
        grid = cus;
    }
    if (grid < 0) return;
    if (hipMemsetAsync((char*)d_ws + WS_CTL, 0, CTL_ZERO_BYTES, stream) != hipSuccess) { fprintf(stderr, "kernel_launch: hipMemsetAsync failed\n"); return; }
    Args a{};
    for (int i = 0; i < 24; ++i) a.in[i] = (const float*)d_in[i];
    a.out = (float*)d_out; a.ws = (unsigned char*)d_ws;
#if MK_MULTI
    for (int p = 0; p < NPH; ++p) { a.ph_lo = p; a.ph_hi = p + 1; hipLaunchKernelGGL(fwd, dim3(grid), dim3(NWAVES * 64), LDS_BYTES, stream, a); }
#else
    a.ph_lo = 0; a.ph_hi = NPH; hipLaunchKernelGGL(fwd, dim3(grid), dim3(NWAVES * 64), LDS_BYTES, stream, a);
#endif
    const hipError_t le = hipPeekAtLastError();
    if (le != hipSuccess) fprintf(stderr, "kernel_launch: launch failed: %s\n", hipGetErrorName(le));
}
```

```cpp
#include <hip/hip_runtime.h>
#include <cstdio>
#include <cstdint>
namespace pg8 {
#define PG8_LAS __attribute__((address_space(3)))
typedef unsigned short bf16_t;
typedef short bf16x8 __attribute__((ext_vector_type(8)));
typedef float f32x4 __attribute__((ext_vector_type(4)));
typedef unsigned u32x4 __attribute__((ext_vector_type(4)));
constexpr int BM = 256, BK = 64, HALF = 128, HTB = HALF * BK * 2  , STAGE_BYTES = 8 * HTB, NXCD = 8, WGM = 8;

__host__ __device__ __forceinline__ int lds_byte(int r, int c) { const int st = (r >> 4) * 2 + (c >> 5), rr = r & 15, cc = c & 31, ob = rr * 64 + cc * 2; return st * 1024 + (ob ^ (((ob >> 9) & 1) << 5)); }
__host__ __device__ __forceinline__ void stage_rc(int b, int& R, int& C) { const int st = b / 1024, sb = b % 1024, swz = sb ^ (((sb >> 9) & 1) << 5); R = (st >> 1) * 16 + swz / 64; C = (st & 1) * 32 + (swz % 64) / 2; }
__host__ __device__ __forceinline__ int perm32(int rho) { const int n = rho >> 4, i = rho & 15; return 8 * (i >> 2) + 4 * n + (i & 3); }

struct Unit { int pm, pn, pb; };
struct Gemm { const bf16_t* A; const bf16_t* Bt; int M, N, K; };

struct StaticOrder {
    int nM, nN, nwg, G, c;
    __host__ __device__ void init(int M, int N, int G_, int c_) { nM = M / BM; nN = N / BM; nwg = nM * nN; G = G_; c = c_; }
    __host__ __device__ bool next(int i, Unit& u) const {
        const long L = (long)i * G + c; if (L >= nwg) return false;
        int wgid = (int)L; { const int q = nwg / NXCD, r = nwg % NXCD, xcd = wgid % NXCD, off = wgid / NXCD; wgid = (xcd < r ? xcd * (q + 1) : r * (q + 1) + (xcd - r) * q) + off; }
        const int nig = WGM * nN, gid = wgid / nig, fm = gid * WGM, gsz = (nM - fm) < WGM ? (nM - fm) : WGM;
        u.pm = fm + ((wgid % nig) % gsz); u.pn = (wgid % nig) / gsz; u.pb = u.pn; return true;
    }
    __device__ __forceinline__ void a_ready(const Unit&) const {}
    __device__ __forceinline__ void done(const Unit&) const {}
};

__device__ __forceinline__ unsigned cvt_pk_bf16(float lo, float hi) { unsigned r; asm volatile("v_cvt_pk_bf16_f32 %0, %1, %2" : "=v"(r) : "v"(lo), "v"(hi)); return r; }
__device__ __forceinline__ float sigm(float x) { return __builtin_amdgcn_rcpf(1.f + __builtin_amdgcn_exp2f(-1.4426950408889634f * x)); }
typedef int v4i_t __attribute__((ext_vector_type(4)));
typedef int v8i_t __attribute__((ext_vector_type(8)));
__device__ __forceinline__ v8i_t cat8(bf16x8 a, bf16x8 b) { return __builtin_shufflevector(__builtin_bit_cast(v4i_t, a), __builtin_bit_cast(v4i_t, b), 0, 1, 2, 3, 4, 5, 6, 7); }
__device__ __forceinline__ float clamp8(float x) { return __builtin_amdgcn_fmed3f(x, -448.f, 448.f); }
__device__ __forceinline__ unsigned pack_fp8x4(float a, float b, float c, float d) { int w = 0; w = __builtin_amdgcn_cvt_pk_fp8_f32(clamp8(a), clamp8(b), w, false); w = __builtin_amdgcn_cvt_pk_fp8_f32(clamp8(c), clamp8(d), w, true); return (unsigned)w; }
__device__ __forceinline__ float bf_lo(unsigned w) { return __uint_as_float(w << 16); }
__device__ __forceinline__ float bf_hi(unsigned w) { return __uint_as_float(w & 0xffff0000u); }

struct EpiSlab {
    static constexpr bool PERM = true, AFTER_DRAIN = false, HOOK = false;
    bf16_t* O; size_t slab_stride; int qslab; float qscale;
    __device__ __forceinline__ void operator()(const f32x4 (&acc)[2][2][4][2], const Unit& u, int wr, int wc, int fr, int fq) const {
        const int slab = u.pn >> 1; bf16_t* base = O + (size_t)slab * slab_stride; const float sc = (slab == qslab) ? qscale : 1.f;
        const int row0 = u.pm * BM + wr * 64 + fr, col0 = (u.pn & 1) * 256 + wc * 32 + 8 * fq;
#pragma unroll
        for (int ai = 0; ai < 2; ++ai)
#pragma unroll
            for (int m = 0; m < 4; ++m) { bf16_t* rowp = base + (size_t)(row0 + ai * HALF + m * 16) * 512 + col0;
#pragma unroll
                for (int bj = 0; bj < 2; ++bj) { const f32x4 v0 = acc[ai][bj][m][0] * sc, v1 = acc[ai][bj][m][1] * sc;
                    u32x4 w; w.x = cvt_pk_bf16(v0[0], v0[1]); w.y = cvt_pk_bf16(v0[2], v0[3]); w.z = cvt_pk_bf16(v1[0], v1[1]); w.w = cvt_pk_bf16(v1[2], v1[3]);
                    *(u32x4*)(rowp + bj * HALF) = w; } }
    }
};
__device__ __forceinline__ size_t gate_img(int br, int pm, int pn, int piece, int wave, int lane) { return ((((size_t)(br * 512 + pm * 4 + pn) * 16 + piece) * 8 + wave) * 64 + lane) * 8; }
typedef unsigned u32x2g __attribute__((ext_vector_type(2)));
__device__ __forceinline__ float gate_val(float x, float c) { return __builtin_fmaxf(__builtin_fmaf(__builtin_amdgcn_rcpf(1.f + __builtin_amdgcn_exp2f(x * c)), 256.f, 0.5f), 1.f); }
__device__ __forceinline__ f32x4 ub4(unsigned w) { return (f32x4){(float)(w & 0xffu), (float)((w >> 8) & 0xffu), (float)((w >> 16) & 0xffu), (float)(w >> 24)}; }
struct EpiSig {
    static constexpr bool PERM = true, AFTER_DRAIN = false, HOOK = false;
    unsigned char* O; float in_scale;
    __device__ __forceinline__ void operator()(const f32x4 (&acc)[2][2][4][2], const Unit& u, int wr, int wc, int fr, int fq) const {
        const int br = u.pn >> 2, pn = u.pn & 3, wave = wr * 4 + wc, lane = fq * 16 + fr;
#pragma unroll
        for (int ai = 0; ai < 2; ++ai)
#pragma unroll
            for (int m = 0; m < 4; ++m)
#pragma unroll
                for (int bj = 0; bj < 2; ++bj) { const f32x4 v0 = acc[ai][bj][m][0], v1 = acc[ai][bj][m][1];
                    const float c = -1.4426950408889634f * in_scale; u32x2g w; w.x = 0u; w.y = 0u;
#pragma unroll
                    for (int j = 0; j < 4; ++j) { w.x = __builtin_amdgcn_cvt_pk_u8_f32(gate_val(v0[j], c), j, w.x); w.y = __builtin_amdgcn_cvt_pk_u8_f32(gate_val(v1[j], c), j, w.y); }
                    *(u32x2g*)(O + gate_img(br, u.pm, pn, ai * 8 + m * 2 + bj, wave, lane)) = w; }
    }
};
struct EpiMerge {
    static constexpr bool PERM = true, AFTER_DRAIN = false, HOOK = true;
    const unsigned char* G; bf16_t* O;
    __device__ __forceinline__ void hook(f32x4 (&acc)[2][2][4][2], const Unit& u, int t, int wr, int wc, int fr, int fq) const {
        const int i = (t >> 3) - 1; int lane = fq * 16 + fr; const int wave = wr * 4 + wc;
        asm volatile("" : "+v"(lane));
#pragma unroll
        for (int ai = 0; ai < 2; ++ai) {
            u32x2g ga[4][2], gb[4][2];
#pragma unroll
            for (int m = 0; m < 4; ++m)
#pragma unroll
                for (int bj = 0; bj < 2; ++bj) { ga[m][bj] = *(const u32x2g*)(G + gate_img(i, u.pm, u.pn, ai * 8 + m * 2 + bj, wave, lane)); gb[m][bj] = *(const u32x2g*)(G + gate_img(i + 1, u.pm, u.pn, ai * 8 + m * 2 + bj, wave, lane)); }
            __builtin_amdgcn_sched_barrier(0);
#pragma unroll
            for (int m = 0; m < 4; ++m)
#pragma unroll
                for (int bj = 0; bj < 2; ++bj) { const f32x4 a0 = ub4(ga[m][bj].x), a1 = ub4(ga[m][bj].y), b0 = ub4(gb[m][bj].x), b1 = ub4(gb[m][bj].y);
                    f32x4 r0, r1;
#pragma unroll
                    for (int j = 0; j < 4; ++j) { r0[j] = a0[j] * __builtin_amdgcn_rcpf(b0[j]); r1[j] = a1[j] * __builtin_amdgcn_rcpf(b1[j]); }
                    acc[ai][bj][m][0] *= r0; acc[ai][bj][m][1] *= r1; }
            __builtin_amdgcn_sched_barrier(0);
        }
    }
    __device__ __forceinline__ void operator()(const f32x4 (&acc)[2][2][4][2], const Unit& u, int wr, int wc, int fr, int fq) const {
        const int row0 = u.pm * BM + wr * 64 + fr, col0 = u.pn * BM + wc * 32 + 8 * fq, lane = fq * 16 + fr, wave = wr * 4 + wc;
        u32x2g g[2][4][2];
#pragma unroll
        for (int ai = 0; ai < 2; ++ai)
#pragma unroll
            for (int m = 0; m < 4; ++m)
#pragma unroll
                for (int bj = 0; bj < 2; ++bj) g[ai][m][bj] = *(const u32x2g*)(G + gate_img(2, u.pm, u.pn, ai * 8 + m * 2 + bj, wave, lane));
        __builtin_amdgcn_sched_barrier(0);
#pragma unroll
        for (int ai = 0; ai < 2; ++ai)
#pragma unroll
            for (int m = 0; m < 4; ++m) { const size_t off = (size_t)(row0 + ai * HALF + m * 16) * 1024 + col0;
#pragma unroll
                for (int bj = 0; bj < 2; ++bj) { const f32x4 g0 = ub4(g[ai][m][bj].x) * (1.f / 256.f), g1 = ub4(g[ai][m][bj].y) * (1.f / 256.f); const f32x4 v0 = acc[ai][bj][m][0] * g0, v1 = acc[ai][bj][m][1] * g1;
                    u32x4 w; w.x = cvt_pk_bf16(v0[0], v0[1]); w.y = cvt_pk_bf16(v0[2], v0[3]); w.z = cvt_pk_bf16(v1[0], v1[1]); w.w = cvt_pk_bf16(v1[2], v1[3]);
                    *(u32x4*)(O + off + bj * HALF) = w; } }
    }
};
struct EpiRes {
    static constexpr bool PERM = false, AFTER_DRAIN = false, HOOK = false;
    const float* base; float* out; int ldc; float in_scale = 1.f;
    __device__ __forceinline__ void operator()(const f32x4 (&acc)[2][2][4][2], const Unit& u, int wr, int wc, int fr, int fq) const {
        const int row0 = u.pm * BM + wr * 64 + fr, col0 = u.pn * BM + wc * 32 + 4 * fq;
#pragma unroll
        for (int ai = 0; ai < 2; ++ai) {
            f32x4 bs[4][2][2];
#pragma unroll
            for (int m = 0; m < 4; ++m)
#pragma unroll
                for (int bj = 0; bj < 2; ++bj)
#pragma unroll
                    for (int n = 0; n < 2; ++n) bs[m][bj][n] = *(const f32x4*)(base + (size_t)(row0 + ai * HALF + m * 16) * ldc + col0 + bj * HALF + n * 16);
            __builtin_amdgcn_sched_barrier(0);
#pragma unroll
            for (int m = 0; m < 4; ++m)
#pragma unroll
                for (int bj = 0; bj < 2; ++bj)
#pragma unroll
                    for (int n = 0; n < 2; ++n) *(f32x4*)(out + (size_t)(row0 + ai * HALF + m * 16) * ldc + col0 + bj * HALF + n * 16) = bs[m][bj][n] + acc[ai][bj][m][n] * in_scale;
            __builtin_amdgcn_sched_barrier(0);
        }
    }
};
template <bool BASE_F32> struct EpiResB {
    static constexpr bool PERM = true, AFTER_DRAIN = false, HOOK = false;
    const void* base; bf16_t* out;
    __device__ __forceinline__ void operator()(const f32x4 (&acc)[2][2][4][2], const Unit& u, int wr, int wc, int fr, int fq) const {
        const int row0 = u.pm * BM + wr * 64 + fr, col0 = u.pn * BM + wc * 32 + 8 * fq;
#pragma unroll
        for (int ai = 0; ai < 2; ++ai) {
            f32x4 b0[4][2], b1[4][2];
            if constexpr (BASE_F32) {
#pragma unroll
                for (int m = 0; m < 4; ++m)
#pragma unroll
                    for (int bj = 0; bj < 2; ++bj) { const float* p = (const float*)base + (size_t)(row0 + ai * HALF + m * 16) * 1024 + col0 + bj * HALF; b0[m][bj] = *(const f32x4*)p; b1[m][bj] = *(const f32x4*)(p + 4); }
            } else {
                u32x4 q[4][2];
#pragma unroll
                for (int m = 0; m < 4; ++m)
#pragma unroll
                    for (int bj = 0; bj < 2; ++bj) q[m][bj] = *(const u32x4*)((const bf16_t*)base + (size_t)(row0 + ai * HALF + m * 16) * 1024 + col0 + bj * HALF);
                __builtin_amdgcn_sched_barrier(0);
#pragma unroll
                for (int m = 0; m < 4; ++m)
#pragma unroll
                    for (int bj = 0; bj < 2; ++bj) { b0[m][bj] = (f32x4){bf_lo(q[m][bj].x), bf_hi(q[m][bj].x), bf_lo(q[m][bj].y), bf_hi(q[m][bj].y)}; b1[m][bj] = (f32x4){bf_lo(q[m][bj].z), bf_hi(q[m][bj].z), bf_lo(q[m][bj].w), bf_hi(q[m][bj].w)}; }
            }
            __builtin_amdgcn_sched_barrier(0);
#pragma unroll
            for (int m = 0; m < 4; ++m)
#pragma unroll
                for (int bj = 0; bj < 2; ++bj) { const f32x4 v0 = b0[m][bj] + acc[ai][bj][m][0], v1 = b1[m][bj] + acc[ai][bj][m][1];
                    u32x4 w; w.x = cvt_pk_bf16(v0[0], v0[1]); w.y = cvt_pk_bf16(v0[2], v0[3]); w.z = cvt_pk_bf16(v1[0], v1[1]); w.w = cvt_pk_bf16(v1[2], v1[3]);
                    *(u32x4*)(out + (size_t)(row0 + ai * HALF + m * 16) * 1024 + col0 + bj * HALF) = w; }
            __builtin_amdgcn_sched_barrier(0);
        }
    }
};
struct EpiSwiGLU {
    static constexpr bool PERM = true, AFTER_DRAIN = false, HOOK = false;
    bf16_t* O; int ldc;
    __device__ __forceinline__ void operator()(const f32x4 (&acc)[2][2][4][2], const Unit& u, int wr, int wc, int fr, int fq) const {
        const int row0 = u.pm * BM + wr * 64 + fr, col0 = u.pn * HALF + wc * 32 + 8 * fq;
#pragma unroll
        for (int ai = 0; ai < 2; ++ai)
#pragma unroll
            for (int m = 0; m < 4; ++m) { f32x4 v0, v1;
#pragma unroll
                for (int j = 0; j < 4; ++j) { const float g0 = acc[ai][0][m][0][j], g1 = acc[ai][0][m][1][j]; v0[j] = g0 * sigm(g0) * acc[ai][1][m][0][j]; v1[j] = g1 * sigm(g1) * acc[ai][1][m][1][j]; }
                u32x4 w; w.x = cvt_pk_bf16(v0[0], v0[1]); w.y = cvt_pk_bf16(v0[2], v0[3]); w.z = cvt_pk_bf16(v1[0], v1[1]); w.w = cvt_pk_bf16(v1[2], v1[3]);
                *(u32x4*)(O + (size_t)(row0 + ai * HALF + m * 16) * ldc + col0) = w; }
    }
};
struct EpiSwiGLU8 {
    static constexpr bool PERM = true, AFTER_DRAIN = false, HOOK = false;
    unsigned char* O; int ldc; float in_scale, out_scale;
    __device__ __forceinline__ void operator()(const f32x4 (&acc)[2][2][4][2], const Unit& u, int wr, int wc, int fr, int fq) const {
        const int row0 = u.pm * BM + wr * 64 + fr, col0 = u.pn * HALF + wc * 32 + 8 * fq; const float c1 = in_scale * in_scale * out_scale, c2 = -1.4426950408889634f * in_scale;
#pragma unroll
        for (int ai = 0; ai < 2; ++ai)
#pragma unroll
            for (int m = 0; m < 4; ++m) { f32x4 v0, v1;
#pragma unroll
                for (int j = 0; j < 4; ++j) { const float g0 = acc[ai][0][m][0][j], g1 = acc[ai][0][m][1][j];
                    v0[j] = (g0 * acc[ai][1][m][0][j]) * __builtin_amdgcn_rcpf(1.f + __builtin_amdgcn_exp2f(g0 * c2)) * c1; v1[j] = (g1 * acc[ai][1][m][1][j]) * __builtin_amdgcn_rcpf(1.f + __builtin_amdgcn_exp2f(g1 * c2)) * c1; }
                typedef unsigned u32x2_t __attribute__((ext_vector_type(2)));
                u32x2_t w; w.x = pack_fp8x4(v0[0], v0[1], v0[2], v0[3]); w.y = pack_fp8x4(v1[0], v1[1], v1[2], v1[3]);
                *(u32x2_t*)(O + (size_t)(row0 + ai * HALF + m * 16) * ldc + col0) = w; }
    }
};
struct EpiMoeDown {
    static constexpr bool PERM = true, AFTER_DRAIN = false, HOOK = false;
    bf16_t* Y; const int* row_tok; const float* row_g; float in_scale;
    __device__ __forceinline__ void operator()(const f32x4 (&acc)[2][2][4][2], const Unit& u, int wr, int wc, int fr, int fq) const {
        const int row0 = u.pm * BM + wr * 64 + fr, col0 = u.pn * BM + wc * 32 + 8 * fq;
#pragma unroll
        for (int ai = 0; ai < 2; ++ai)
#pragma unroll
            for (int m = 0; m < 4; ++m) { const int r = row0 + ai * HALF + m * 16; const int tok = row_tok[r]; const float g = row_g[r] * in_scale;
                if (tok >= 0) { bf16_t* p = Y + (size_t)tok * 1024 + col0;
#pragma unroll
                    for (int bj = 0; bj < 2; ++bj) { const f32x4 v0 = acc[ai][bj][m][0] * g, v1 = acc[ai][bj][m][1] * g;
                        u32x4 w; w.x = cvt_pk_bf16(v0[0], v0[1]); w.y = cvt_pk_bf16(v0[2], v0[3]); w.z = cvt_pk_bf16(v1[0], v1[1]); w.w = cvt_pk_bf16(v1[2], v1[3]);
                        *(u32x4*)(p + bj * HALF) = w; } } }
    }
};
struct MoeRange {
    int nM, nN, lo, hi; const PG8_LAS int* tile_e;
    __device__ void init(int nM_, int nN_, int lo_, int hi_, const PG8_LAS int* te) { nM = nM_; nN = nN_; lo = lo_; hi = hi_; tile_e = te; }
    __device__ bool next(int i, Unit& u) const {
        const int wgid = lo + i; if (wgid >= hi) return false;
        const int nig = WGM * nN, gid = wgid / nig, fm = gid * WGM, gsz = (nM - fm) < WGM ? (nM - fm) : WGM;
        u.pm = fm + ((wgid % nig) % gsz); u.pn = (wgid % nig) / gsz;
        const int e = __builtin_amdgcn_readfirstlane(tile_e[u.pm]); u.pb = e * nN + u.pn; return true;
    }
    __device__ __forceinline__ void a_ready(const Unit&) const {}
    __device__ __forceinline__ void done(const Unit&) const {}
};
struct MoeOrder {
    int nM, nN, nwg, G, c; const PG8_LAS int* tile_e;
    __device__ void init(int nM_, int nN_, int G_, int c_, const PG8_LAS int* te) { nM = nM_; nN = nN_; nwg = nM * nN; G = G_; c = c_; tile_e = te; }
    __device__ bool next(int i, Unit& u) const {
        const long L = (long)i * G + c; if (L >= nwg) return false;
        int wgid = (int)L; { const int q = nwg / NXCD, r = nwg % NXCD, xcd = wgid % NXCD, off = wgid / NXCD; wgid = (xcd < r ? xcd * (q + 1) : r * (q + 1) + (xcd - r) * q) + off; }
        const int nig = WGM * nN, gid = wgid / nig, fm = gid * WGM, gsz = (nM - fm) < WGM ? (nM - fm) : WGM;
        u.pm = fm + ((wgid % nig) % gsz); u.pn = (wgid % nig) / gsz;
        const int e = __builtin_amdgcn_readfirstlane(tile_e[u.pm]); u.pb = e * nN + u.pn; return true;
    }
    __device__ __forceinline__ void a_ready(const Unit&) const {}
    __device__ __forceinline__ void done(const Unit&) const {}
};
template <class Epi, class Sched, bool ALIGN_EPI = false, bool SP2 = false, bool FP8 = false>
__device__ __forceinline__ void gemm_phase(PG8_LAS unsigned char* lds, const Gemm g, const Sched& S, const Epi& E) {
    int tid_ = threadIdx.x; asm volatile("" : "+v"(tid_));
    const int tid = tid_, wid = __builtin_amdgcn_readfirstlane(tid >> 6), lane = tid & 63, wr = wid >> 2, wc = wid & 3, fr = lane & 15, fq = lane >> 4;
    const int K = g.K, nt = K / BK;
    unsigned voffA[2], voffB[2];
#pragma unroll
    for (int i = 0; i < 2; ++i) { int R, C; stage_rc(tid * 16 + i * 8192, R, C); const int Rb = Epi::PERM ? ((R & ~31) + perm32(R & 31)) : R;
        voffA[i] = (unsigned)(R * K + C) * 2u; voffB[i] = (unsigned)(Rb * K + C) * 2u; }
    const size_t kstep = (size_t)(BK * 2);
    const size_t hstep = (size_t)HALF * K * 2;
    const size_t tstep = 2 * hstep;
    const unsigned ldsw = (unsigned)wid * 1024u;
    const int aoff = lds_byte(wr * 64 + fr, fq * 8), boff = lds_byte(wc * 32 + fr, fq * 8);
#define PG8_SA(b, h) (((b) * 2 + (h)) * HTB)
#define PG8_SB(b, h) ((4 + (b) * 2 + (h)) * HTB)
#define PG8_STAGE(bufoff, gbase, voff) do { _Pragma("unroll") for (int _i = 0; _i < 2; ++_i) \
        __builtin_amdgcn_global_load_lds((const unsigned*)((const char*)(gbase) + (voff)[_i]), (PG8_LAS unsigned*)(lds + (bufoff) + ldsw + _i * 8192), 16, 0, 0); } while (0)
#define PG8_LDA(dst, b, h) do { _Pragma("unroll") for (int m = 0; m < 4; ++m) _Pragma("unroll") for (int k = 0; k < 2; ++k) dst[m][k] = *(const PG8_LAS bf16x8*)(lds + PG8_SA(b, h) + aoff + m * 2048 + k * 1024); } while (0)
#define PG8_LDB(dst, b, h) do { _Pragma("unroll") for (int n = 0; n < 2; ++n) _Pragma("unroll") for (int k = 0; k < 2; ++k) dst[n][k] = *(const PG8_LAS bf16x8*)(lds + PG8_SB(b, h) + boff + n * 2048 + k * 1024); } while (0)
#define PG8_MMA(ai, bj, At, Bt) do { __builtin_amdgcn_s_setprio(1); \
        if constexpr (FP8) { _Pragma("unroll") for (int m = 0; m < 4; ++m) _Pragma("unroll") for (int n = 0; n < 2; ++n) \
            asm volatile("v_mfma_f32_16x16x128_f8f6f4 %0, %1, %2, %0" : "+v"(acc[ai][bj][m][n]) : "v"(cat8(Bt[n][0], Bt[n][1])), "v"(cat8(At[m][0], At[m][1]))); } \
        else { _Pragma("unroll") for (int m = 0; m < 4; ++m) _Pragma("unroll") for (int n = 0; n < 2; ++n) _Pragma("unroll") for (int k = 0; k < 2; ++k) \
            acc[ai][bj][m][n] = __builtin_amdgcn_mfma_f32_16x16x32_bf16(Bt[n][k], At[m][k], acc[ai][bj][m][n], 0, 0, 0); } \
        __builtin_amdgcn_s_setprio(0); } while (0)
#define PG8_WAIT_V(n) asm volatile("s_waitcnt vmcnt(" #n ")" ::: "memory")
#define PG8_WAIT_L(n) asm volatile("s_waitcnt lgkmcnt(" #n ")" ::: "memory")
#define PG8_BAR __builtin_amdgcn_s_barrier()
#define PG8_SCHED __builtin_amdgcn_sched_barrier(0)
    Unit cur, nxt; int ui = 0;
    if (!S.next(0, cur)) return;
    f32x4 acc[2][2][4][2];
#pragma unroll
    for (int a = 0; a < 2; ++a)
#pragma unroll
        for (int b = 0; b < 2; ++b)
#pragma unroll
            for (int m = 0; m < 4; ++m)
#pragma unroll
                for (int n = 0; n < 2; ++n) acc[a][b][m][n] = (f32x4){0.f, 0.f, 0.f, 0.f};
    bf16x8 At[4][2], B0[2][2], B1[2][2];
    const char* cA = (const char*)g.A + (size_t)cur.pm * tstep; const char* cB = (const char*)g.Bt + (size_t)cur.pb * tstep;
    S.a_ready(cur);
    if constexpr (SP2) {
        PG8_STAGE(PG8_SB(0, 0), cB, voffB); PG8_STAGE(PG8_SB(0, 1), cB + hstep, voffB); PG8_STAGE(PG8_SA(0, 0), cA, voffA); PG8_STAGE(PG8_SA(0, 1), cA + hstep, voffA);
        if (wr == 1) PG8_BAR;
        PG8_WAIT_V(2); PG8_BAR;
        PG8_STAGE(PG8_SB(1, 0), cB + kstep, voffB); PG8_STAGE(PG8_SA(1, 0), cA + kstep, voffA); PG8_STAGE(PG8_SB(1, 1), cB + hstep + kstep, voffB);
        PG8_WAIT_V(6); PG8_BAR;
    } else {
        PG8_STAGE(PG8_SB(0, 0), cB, voffB); PG8_STAGE(PG8_SA(0, 0), cA, voffA); PG8_STAGE(PG8_SB(0, 1), cB + hstep, voffB); PG8_STAGE(PG8_SA(0, 1), cA + hstep, voffA);
        if (wr == 1) PG8_BAR;
        PG8_WAIT_V(4); PG8_BAR;
        PG8_STAGE(PG8_SB(1, 0), cB + kstep, voffB); PG8_STAGE(PG8_SA(1, 0), cA + kstep, voffA); PG8_STAGE(PG8_SB(1, 1), cB + hstep + kstep, voffB);
        PG8_WAIT_V(6); PG8_BAR;
    }
    for (;;) {
        const bool has_next = S.next(ui + 1, nxt);
        const char* nA = has_next ? (const char*)g.A + (size_t)nxt.pm * tstep : cA; const char* nB = has_next ? (const char*)g.Bt + (size_t)nxt.pb * tstep : cB;
        for (int t = 0; t < nt; t += 2) {
            if constexpr (Epi::HOOK) { if (t == 8 || t == 16) E.hook(acc, cur, t, wr, wc, fr, fq); }
            const bool last = (t == nt - 2);
            const char* a1 = cA + (size_t)(t + 1) * kstep;
            const char* a2 = last ? nA : cA + (size_t)(t + 2) * kstep; const char* b2 = last ? nB : cB + (size_t)(t + 2) * kstep;
            const char* a3 = a2 + kstep; const char* b3 = b2 + kstep;
            if (last && has_next) S.a_ready(nxt);
            if constexpr (SP2) {
            PG8_LDB(B0, 0, 0); PG8_LDB(B1, 0, 1); PG8_SCHED; PG8_LDA(At, 0, 0); PG8_STAGE(PG8_SA(1, 1), a1 + hstep, voffA);
            PG8_WAIT_V(8); PG8_WAIT_L(0); PG8_BAR; PG8_MMA(0, 0, At, B0); PG8_MMA(0, 1, At, B1); PG8_BAR; PG8_SCHED;
            PG8_LDA(At, 0, 1); PG8_STAGE(PG8_SB(0, 0), b2, voffB); PG8_STAGE(PG8_SB(0, 1), b2 + hstep, voffB); PG8_STAGE(PG8_SA(0, 0), a2, voffA);
            PG8_WAIT_V(8); PG8_WAIT_L(0); PG8_BAR; PG8_MMA(1, 0, At, B0); PG8_MMA(1, 1, At, B1); PG8_BAR; PG8_SCHED;
            PG8_LDB(B0, 1, 0); PG8_LDB(B1, 1, 1); PG8_SCHED; PG8_LDA(At, 1, 0); PG8_STAGE(PG8_SA(0, 1), a2 + hstep, voffA);
            PG8_WAIT_V(8); PG8_WAIT_L(0); PG8_BAR; PG8_MMA(0, 0, At, B0); PG8_MMA(0, 1, At, B1); PG8_BAR; PG8_SCHED;
            PG8_LDA(At, 1, 1); PG8_STAGE(PG8_SB(1, 0), b3, voffB); PG8_STAGE(PG8_SB(1, 1), b3 + hstep, voffB); PG8_STAGE(PG8_SA(1, 0), a3, voffA);
            PG8_WAIT_V(8); PG8_WAIT_L(0); PG8_BAR; PG8_MMA(1, 0, At, B0); PG8_MMA(1, 1, At, B1); PG8_BAR; PG8_SCHED;
            } else {
            PG8_LDB(B0, 0, 0); PG8_SCHED; PG8_LDA(At, 0, 0); PG8_STAGE(PG8_SA(1, 1), a1 + hstep, voffA);
            PG8_WAIT_L(8); PG8_BAR; PG8_WAIT_L(0); PG8_MMA(0, 0, At, B0); PG8_BAR; PG8_SCHED;
            PG8_LDB(B1, 0, 1); PG8_STAGE(PG8_SB(0, 0), b2, voffB);
            PG8_BAR; PG8_WAIT_L(0); PG8_MMA(0, 1, At, B1); PG8_BAR;
            PG8_LDA(At, 0, 1); PG8_STAGE(PG8_SA(0, 0), a2, voffA);
            PG8_BAR; PG8_WAIT_L(0); PG8_MMA(1, 0, At, B0); PG8_BAR; PG8_SCHED;
            PG8_STAGE(PG8_SB(0, 1), b2 + hstep, voffB);
            PG8_WAIT_V(6); PG8_BAR; PG8_MMA(1, 1, At, B1); PG8_BAR;
            PG8_LDB(B0, 1, 0); PG8_SCHED; PG8_LDA(At, 1, 0); PG8_STAGE(PG8_SA(0, 1), a2 + hstep, voffA);
            PG8_WAIT_L(8); PG8_BAR; PG8_WAIT_L(0); PG8_MMA(0, 0, At, B0); PG8_BAR; PG8_SCHED;
            PG8_LDB(B1, 1, 1); PG8_STAGE(PG8_SB(1, 0), b3, voffB);
            PG8_BAR; PG8_WAIT_L(0); PG8_MMA(0, 1, At, B1); PG8_BAR;
            PG8_LDA(At, 1, 1); PG8_STAGE(PG8_SA(1, 0), a3, voffA);
            PG8_BAR; PG8_WAIT_L(0); PG8_MMA(1, 0, At, B0); PG8_BAR; PG8_SCHED;
            PG8_STAGE(PG8_SB(1, 1), b3 + hstep, voffB);
            PG8_WAIT_V(6); PG8_BAR; PG8_MMA(1, 1, At, B1); PG8_BAR;
            }
        }
        if constexpr (ALIGN_EPI) { if (wr == 0) PG8_BAR; }
        if constexpr (FP8) {
            asm volatile("s_nop 15\n\ts_nop 15" : "+v"(acc[0][0][0][0]), "+v"(acc[0][0][0][1]), "+v"(acc[0][0][1][0]), "+v"(acc[0][0][1][1]), "+v"(acc[0][0][2][0]), "+v"(acc[0][0][2][1]), "+v"(acc[0][0][3][0]), "+v"(acc[0][0][3][1]));
            asm volatile("" : "+v"(acc[0][1][0][0]), "+v"(acc[0][1][0][1]), "+v"(acc[0][1][1][0]), "+v"(acc[0][1][1][1]), "+v"(acc[0][1][2][0]), "+v"(acc[0][1][2][1]), "+v"(acc[0][1][3][0]), "+v"(acc[0][1][3][1]));
            asm volatile("" : "+v"(acc[1][0][0][0]), "+v"(acc[1][0][0][1]), "+v"(acc[1][0][1][0]), "+v"(acc[1][0][1][1]), "+v"(acc[1][0][2][0]), "+v"(acc[1][0][2][1]), "+v"(acc[1][0][3][0]), "+v"(acc[1][0][3][1]));
            asm volatile("" : "+v"(acc[1][1][0][0]), "+v"(acc[1][1][0][1]), "+v"(acc[1][1][1][0]), "+v"(acc[1][1][1][1]), "+v"(acc[1][1][2][0]), "+v"(acc[1][1][2][1]), "+v"(acc[1][1][3][0]), "+v"(acc[1][1][3][1])); }
        if constexpr (!Epi::AFTER_DRAIN) { E(acc, cur, wr, wc, fr, fq); S.done(cur); }
        if (!has_next) break;
#pragma unroll
        for (int a = 0; a < 2; ++a)
#pragma unroll
            for (int b = 0; b < 2; ++b)
#pragma unroll
                for (int m = 0; m < 4; ++m)
#pragma unroll
                    for (int n = 0; n < 2; ++n) acc[a][b][m][n] = (f32x4){0.f, 0.f, 0.f, 0.f};
        cur = nxt; cA = nA; cB = nB; ++ui;
        if constexpr (ALIGN_EPI) { if (wr == 1) PG8_BAR; }
    }
    PG8_WAIT_V(0);
    if constexpr (!ALIGN_EPI) { if (wr == 0) PG8_BAR; }
    PG8_BAR;
    if constexpr (Epi::AFTER_DRAIN) { E.fused(acc, cur, wr, wc, fr, fq, lds, wid, lane); S.done(cur); }
#undef PG8_SA
#undef PG8_SB
#undef PG8_STAGE
#undef PG8_LDA
#undef PG8_LDB
#undef PG8_MMA
#undef PG8_WAIT_V
#undef PG8_WAIT_L
#undef PG8_BAR
#undef PG8_SCHED
}
}
#include <hip/hip_bf16.h>
#include <cmath>
namespace attn_body {
using bf16=__hip_bfloat16;
using bf16x8=__attribute__((ext_vector_type(8)))short;
using s16x4=__attribute__((ext_vector_type(4)))short;
using f32x16=__attribute__((ext_vector_type(16)))float;
using u32x4=__attribute__((ext_vector_type(4)))unsigned;
constexpr int BATCH=4,NHEAD=8,SEQ=8192,D=64,DM=NHEAD*D,DMO=1536,OCOL=1024;
constexpr int NW=8,QBLK=32,QB=QBLK*NW,KVBLK=64,NQB=SEQ/QB;
constexpr int ATTN_PITCH=DM, ATTN_UNIT_ROWS=QB;
__device__ __forceinline__ int crow(int r,int hi){return (r&3)+8*(r>>2)+4*hi;}
#define SBAR() __builtin_amdgcn_sched_barrier(0)
__device__ __forceinline__ void cmask(f32x16&p0,f32x16&p1,int jb,int qrel,int hi){
  const float NEG=-INFINITY; int kb=64*jb+4*hi;
  #pragma unroll
  for(int r=0;r<16;++r){int kv=kb+(r&3)+8*(r>>2); if(kv>qrel)p0[r]=NEG; if(kv+32>qrel)p1[r]=NEG;}
}

constexpr int NSLOT=3, SLOTB=8192;
constexpr int LDS_K=0, LDS_V=NSLOT*SLOTB, LDS_WS=2*NSLOT*SLOTB, LDS_OST=LDS_WS+NW*64*4, LDS_NB=LDS_OST+NW*4096, LDS_BYTES=LDS_NB+SEQ*4;
constexpr float C2=0.125f*1.4426950408889634f;
__device__ __forceinline__ void glds16(const void*gsrc,unsigned lds_dst){unsigned keep;
  asm volatile("s_mov_b32 %0, m0\n\ts_mov_b32 m0, %2\n\ts_nop 0\n\tglobal_load_lds_dwordx4 %1, off\n\ts_mov_b32 m0, %0":"=&s"(keep):"v"(gsrc),"s"(lds_dst):"memory");}
__device__ __forceinline__ float max3f(float a,float b,float c){float r;asm("v_max3_f32 %0, %1, %2, %3":"=v"(r):"v"(a),"v"(b),"v"(c));return r;}
__device__ __forceinline__ float max2f(float a,float b){float r;asm("v_max_f32_e32 %0, %1, %2":"=v"(r):"v"(a),"v"(b));return r;}
__device__ __forceinline__ float fadd_s(float a,float b){float r;asm("v_add_f32_e32 %0, %1, %2":"=v"(r):"v"(a),"v"(b));return r;}
__device__ __forceinline__ float fsub_s(float a,float b){float r;asm("v_sub_f32_e32 %0, %1, %2":"=v"(r):"v"(a),"v"(b));return r;}
typedef float f32x2_t __attribute__((ext_vector_type(2))); typedef __bf16 bf16x2_t __attribute__((ext_vector_type(2)));
__device__ __forceinline__ unsigned cvtpk_s(float lo,float hi){f32x2_t v={lo,hi};bf16x2_t b=__builtin_convertvector(v,bf16x2_t);return __builtin_bit_cast(unsigned,b);}
#define WAIT_BAR(N) asm volatile("s_waitcnt vmcnt(" #N ") lgkmcnt(0)\n\ts_barrier":::"memory")

__device__ __forceinline__ void qkt(f32x16&p0,f32x16&p1,const char*Kslot,const bf16x8*qr,int r32,int hi){
  const char*kb=Kslot+hi*1024+r32*16;
  #pragma unroll
  for(int d0=0;d0<4;++d0){
    const bf16x8 b0=*reinterpret_cast<const bf16x8*>(kb+d0*2048);
    const bf16x8 b1=*reinterpret_cast<const bf16x8*>(kb+d0*2048+512);
    p0=__builtin_amdgcn_mfma_f32_32x32x16_bf16(b0,qr[d0],p0,0,0,0);p1=__builtin_amdgcn_mfma_f32_32x32x16_bf16(b1,qr[d0],p1,0,0,0);}
}
typedef __attribute__((address_space(3))) const char* lds_cptr;
typedef short v4i16_t __attribute__((ext_vector_type(4)));
__device__ __forceinline__ void kload8(bf16x8*kf,lds_cptr kp){
  kf[0]=*(const __attribute__((address_space(3))) bf16x8*)(kp);      kf[1]=*(const __attribute__((address_space(3))) bf16x8*)(kp+512);
  kf[2]=*(const __attribute__((address_space(3))) bf16x8*)(kp+2048); kf[3]=*(const __attribute__((address_space(3))) bf16x8*)(kp+2560);
  kf[4]=*(const __attribute__((address_space(3))) bf16x8*)(kp+4096); kf[5]=*(const __attribute__((address_space(3))) bf16x8*)(kp+4608);
  kf[6]=*(const __attribute__((address_space(3))) bf16x8*)(kp+6144); kf[7]=*(const __attribute__((address_space(3))) bf16x8*)(kp+6656);
}
__device__ __forceinline__ void kload2(bf16x8*kf,lds_cptr kp,int j){ kf[2*j]=*(const __attribute__((address_space(3))) bf16x8*)(kp+j*2048); kf[2*j+1]=*(const __attribute__((address_space(3))) bf16x8*)(kp+j*2048+512); }
__device__ __forceinline__ s16x4 vtr(lds_cptr p){ return __builtin_bit_cast(s16x4,__builtin_amdgcn_ds_read_tr16_b64_v4i16((__attribute__((address_space(3))) v4i16_t*)p)); }
__device__ __forceinline__ float rowmax(const f32x16&p0,const f32x16&p1){
  float a=max3f(p0[0],p0[1],p1[0]),b=max3f(p0[2],p0[3],p1[1]);a=max3f(a,p1[2],p1[3]);
  #pragma unroll
  for(int r=4;r<16;r+=4){a=max3f(a,p0[r],p0[r+1]);b=max3f(b,p0[r+2],p0[r+3]);a=max3f(a,p1[r],p1[r+1]);b=max3f(b,p1[r+2],p1[r+3]);}
  const float m=max2f(a,b);
  auto rr=__builtin_amdgcn_permlane32_swap(__float_as_uint(m),__float_as_uint(m),false,false);
  return max2f(__uint_as_float(rr[0]),__uint_as_float(rr[1]));
}
__device__ __forceinline__ void pv(f32x16*o,int vb,bf16x8 pa0,bf16x8 pa1,bf16x8 pa2,bf16x8 pa3){
  #pragma unroll
  for(int d0=0;d0<2;++d0){s16x4 lo[4],hi[4];
    #pragma unroll
    for(int ks=0;ks<4;++ks){
      asm volatile("ds_read_b64_tr_b16 %0,%1 offset:%c2":"=&v"(lo[ks]):"v"(vb),"i"(d0*4096+ks*1024):"memory");
      asm volatile("ds_read_b64_tr_b16 %0,%1 offset:%c2":"=&v"(hi[ks]):"v"(vb),"i"(d0*4096+ks*1024+512):"memory");}
    asm volatile("s_waitcnt lgkmcnt(0)":::"memory");SBAR();
    #define PK(k) (bf16x8){lo[k][0],lo[k][1],lo[k][2],lo[k][3],hi[k][0],hi[k][1],hi[k][2],hi[k][3]}
    o[d0]=__builtin_amdgcn_mfma_f32_32x32x16_bf16(pa0,PK(0),o[d0],0,0,0);
    o[d0]=__builtin_amdgcn_mfma_f32_32x32x16_bf16(pa1,PK(1),o[d0],0,0,0);
    o[d0]=__builtin_amdgcn_mfma_f32_32x32x16_bf16(pa2,PK(2),o[d0],0,0,0);
    o[d0]=__builtin_amdgcn_mfma_f32_32x32x16_bf16(pa3,PK(3),o[d0],0,0,0);
    #undef PK
  }
}

#ifndef ATTN_STORE16
#define ATTN_STORE16(p,v) (*(u32x4*)(p)=(v))
#endif
typedef float f32x4v __attribute__((ext_vector_type(4)));
__device__ __forceinline__ int attn_t0(int qb,const float*__restrict__ nbg,const float*__restrict__ qnw,const float*__restrict__ knw,const float*__restrict__ xmw,int lane){
  const int q0=qb*QB; float qn=0.f,kn=0.f,xm=3.0e38f; if(lane<8){qn=qnw[qb*8+lane];xm=xmw[qb*8+lane];}
  _Pragma("unroll") for(int i=0;i<4;++i){const int idx=lane*4+i; if(idx<(qb+1)*8)kn=__builtin_fmaxf(kn,knw[idx]);}
  _Pragma("unroll") for(int o_=1;o_<64;o_<<=1){qn=__builtin_fmaxf(qn,__shfl_xor(qn,o_));kn=__builtin_fmaxf(kn,__shfl_xor(kn,o_));xm=__builtin_fminf(xm,__shfl_xor(xm,o_));}
  const float thr=56.f+sqrtf(qn*kn)-xm; const int NT0=(q0+QB)/KVBLK;
  bool c_=(lane>=1)&&(2*lane<=NT0-4); float d_=0.f; if(c_)d_=nbg[128*lane-1]-nbg[q0]; c_=c_&&(d_<=-thr);
  return __builtin_amdgcn_readfirstlane(2*(int)__popcll(__ballot(c_)));
}
template<int THRL> __device__ __forceinline__ void attn_unit(int b,int h,int qb,const bf16*Q,const bf16*__restrict__ K,const bf16*__restrict__ V,bf16*O,const float*__restrict__ nbg,const int t0,char*shm){
  int tid_=threadIdx.x; asm volatile("":"+v"(tid_));
  const int tid=tid_,lane=tid&63,r32=lane&31,hi=lane>>5; const int wid=__builtin_amdgcn_readfirstlane(tid>>6);
  const long rowbase=(long)b*SEQ; const int q0=qb*QB;
  const bf16*Qw=Q+(rowbase+q0+wid*QBLK)*DM+h*D;
  const bf16*Kh=K+(rowbase+(long)t0*KVBLK)*DM+h*D,*Vh=V+(rowbase+(long)t0*KVBLK)*DM+h*D;
  const unsigned lds0=(unsigned)(uintptr_t)shm;
  float*wsf=(float*)(shm+LDS_WS)+wid*64;
  const bf16*ksrc=Kh+(long)lane*DM+wid*8;
  const bf16*vsrc=Vh+(long)(16*(wid&3)+(lane>>2))*DM+(wid>>2)*32+(lane&3)*8;
  const unsigned kdst=lds0+LDS_K+wid*1024, vdst=lds0+LDS_V+wid*1024;
  #define DMA_K(t,slot) glds16(ksrc+(long)(t)*KVBLK*DM,(unsigned)__builtin_amdgcn_readfirstlane(kdst+(slot)))
  #define DMA_V(t,slot) glds16(vsrc+(long)(t)*KVBLK*DM,(unsigned)__builtin_amdgcn_readfirstlane(vdst+(slot)))
  const int vb0=(int)(lds0+LDS_V)+((lane>>4)&1)*32+(lane&3)*8+(4*hi+((lane&15)>>2))*64;
  const char*Kbase=shm+LDS_K; bf16x8 kf[8];
  const lds_cptr shm3=(lds_cptr)shm; const lds_cptr kp0=shm3+LDS_K+hi*1024+r32*16; const lds_cptr vp0=shm3+LDS_V+((lane>>4)&1)*32+(lane&3)*8+(4*hi+((lane&15)>>2))*64;
  const int NT=(q0+QB)/KVBLK-t0;
  typedef __attribute__((address_space(3))) float* lds_fptr;
  const lds_fptr nbl3=(lds_fptr)(shm3+LDS_NB);
  const lds_fptr nbl3o=nbl3+t0*KVBLK;
  DMA_K(0,0);DMA_V(0,0);DMA_K(1,SLOTB);
  { const float ref=nbg[q0+QB-1]; for(int j=t0*KVBLK+tid;j<q0+QB;j+=NW*64) nbl3[j]=nbg[j]-ref; }
  bf16x8 qr[4];
  #pragma unroll
  for(int d0=0;d0<4;++d0)qr[d0]=*reinterpret_cast<const bf16x8*>(&Qw[(long)r32*DM+d0*16+hi*8]);
  float mhat=0.f,l_reg=0.f;f32x16 o[2];o[0]=f32x16{};o[1]=f32x16{};
  const int qrel=wid*QBLK+r32;
  #define CMASK(P0,P1,t) do{int jb_=(t)-(NT-4); if(jb_>=0)cmask(P0,P1,jb_,qrel,hi);}while(0)
  bool resc=false;
  #define START(P0,P1) do{ const float rm=rowmax(P0,P1); resc=false; \
    if(__any(rm>(float)THRL)){ const float dl=__builtin_fmaxf(rm,0.f); mhat=fadd_s(mhat,dl); \
      _Pragma("unroll") for(int r=0;r<16;++r){P0[r]=fsub_s(P0[r],dl);P1[r]=fsub_s(P1[r],dl);} } \
    _Pragma("unroll") for(int r=0;r<16;++r)P0[r]=__builtin_amdgcn_exp2f(P0[r]); }while(0)
  #define BIAS(P0,P1,t) do{ const lds_fptr nbp_=nbl3o+64*(t)+4*hi; \
    _Pragma("unroll") for(int q_=0;q_<4;++q_){ const f32x4v b0_=*(const __attribute__((address_space(3))) f32x4v*)(nbp_+8*q_), b1_=*(const __attribute__((address_space(3))) f32x4v*)(nbp_+32+8*q_); \
      _Pragma("unroll") for(int i_=0;i_<4;++i_){ P0[4*q_+i_]=b0_[i_]-mhat; P1[4*q_+i_]=b1_[i_]-mhat; } } }while(0)
  #define RESC() do{ if(resc){ asm volatile("s_waitcnt lgkmcnt(0)":::"memory"); \
      _Pragma("unroll") for(int d_=0;d_<2;++d_) _Pragma("unroll") for(int r=0;r<16;++r)o[d_][r]*=wsf[crow(r,hi)]; } }while(0)
  f32x16 pA0,pA1,pB0,pB1;
  int sl_prev=0,sl_cur=0,sl_next=SLOTB;
  #define ROT() do{sl_prev=sl_cur;sl_cur=sl_next;sl_next=(sl_next==(NSLOT-1)*SLOTB)?0:sl_next+SLOTB;}while(0)
  DMA_K(2,2*SLOTB);
  WAIT_BAR(3);
  mhat=nbl3[q0+qrel];
  BIAS(pA0,pA1,0);qkt(pA0,pA1,Kbase,qr,r32,hi);asm volatile("s_nop 15\n\ts_nop 7":"+v"(pA0),"+v"(pA1));CMASK(pA0,pA1,0);
  START(pA0,pA1);
  _Pragma("unroll") for(int r=0;r<16;++r)pA1[r]=__builtin_amdgcn_exp2f(pA1[r]);
  WAIT_BAR(0);
  DMA_K(3,0);DMA_V(1,SLOTB);
  ROT();
  kload8(kf,kp0+sl_cur);
  WAIT_BAR(2);
  s16x4 vlo[8],vhi[8]; u32x4 pw0,pw1,pw2,pw3;
  #define PKW(P,B) cvtpk_s(P[B],P[B+1])
  #define PAF(k) __builtin_bit_cast(bf16x8,pw##k)
  #define VFR(i) (bf16x8){vlo[i][0],vlo[i][1],vlo[i][2],vlo[i][3],vhi[i][0],vhi[i][1],vhi[i][2],vhi[i][3]}
  #define PIN(x) asm volatile("":"+v"(x))
  #define MX3(a,b,c) __builtin_fmaxf(__builtin_fmaxf((a),(b)),(c))
  #define GAPA(MF,A0,A1,A2,A3,W0,W1,PW) do{ MF; sacc+=A0; sacc+=A1; sacc+=A2; sacc+=A3; PIN(sacc); W0; W1; PIN(PW); SBAR(); }while(0)
  #define EX(v) __builtin_amdgcn_exp2f(v)
  #define GAPB(MF,X,B) do{ MF; X[B]=EX(X[B]); X[B+1]=EX(X[B+1]); X[B+2]=EX(X[B+2]); X[B+3]=EX(X[B+3]); PIN(X); SBAR(); }while(0)
  #define VRD(i) do{ vlo[i]=vtr(vp_+(((i)>>2)*4096+((i)&3)*1024)); vhi[i]=vtr(vp_+(((i)>>2)*4096+((i)&3)*1024+512)); }while(0)
  #define KRD(G,j) do{ if(G){ kload2(kf,kp0+sl_next,j); SBAR(); } }while(0)
  #define STEP(C0,C1,P0,P1,t,GK,GV,GL) do{ SBAR(); \
    const lds_cptr vp_=vp0+sl_prev; \
    BIAS(C0,C1,t); SBAR(); \
    VRD(0); SBAR(); float sacc=(P0[0]+P0[1]); \
    GAPA(C0=__builtin_amdgcn_mfma_f32_32x32x16_bf16(kf[0],qr[0],C0,0,0,0), P0[2],P0[3],P0[4],P0[5],     pw0[0]=PKW(P0,0), pw0[1]=PKW(P0,2), pw0); \
    VRD(4); SBAR(); GAPA(C1=__builtin_amdgcn_mfma_f32_32x32x16_bf16(kf[1],qr[0],C1,0,0,0), P0[6],P0[7],P0[8],P0[9],     pw0[2]=PKW(P0,4), pw0[3]=PKW(P0,6), pw0); \
    VRD(1); SBAR(); GAPA(C0=__builtin_amdgcn_mfma_f32_32x32x16_bf16(kf[2],qr[1],C0,0,0,0),   P0[10],P0[11],P0[12],P0[13], pw1[0]=PKW(P0,8), pw1[1]=PKW(P0,10), pw1); \
    VRD(5); SBAR(); GAPA(C1=__builtin_amdgcn_mfma_f32_32x32x16_bf16(kf[3],qr[1],C1,0,0,0),   P0[14],P0[15],P1[0],P1[1],   pw1[2]=PKW(P0,12),pw1[3]=PKW(P0,14), pw1); \
    VRD(2); SBAR(); GAPA(C0=__builtin_amdgcn_mfma_f32_32x32x16_bf16(kf[4],qr[2],C0,0,0,0),   P1[2],P1[3],P1[4],P1[5],     pw2[0]=PKW(P1,0), pw2[1]=PKW(P1,2), pw2); \
    VRD(6); SBAR(); GAPA(C1=__builtin_amdgcn_mfma_f32_32x32x16_bf16(kf[5],qr[2],C1,0,0,0),   P1[6],P1[7],P1[8],P1[9],     pw2[2]=PKW(P1,4), pw2[3]=PKW(P1,6), pw2); \
    VRD(3); SBAR(); GAPA(C0=__builtin_amdgcn_mfma_f32_32x32x16_bf16(kf[6],qr[3],C0,0,0,0),   P1[10],P1[11],P1[12],P1[13], pw3[0]=PKW(P1,8), pw3[1]=PKW(P1,10), pw3); \
    VRD(7); SBAR(); GAPA(C1=__builtin_amdgcn_mfma_f32_32x32x16_bf16(kf[7],qr[3],C1,0,0,0),   P1[14],P1[15],0.f,0.f,       pw3[2]=PKW(P1,12),pw3[3]=PKW(P1,14), pw3); \
    l_reg+=sacc; \
    if(GK){DMA_K((t)+3,sl_cur);} if(GV){DMA_V((t)+1,sl_next);} \
    CMASK(C0,C1,t); \
    { float a=MX3(C0[0],C0[1],C1[0]),b=MX3(C0[2],C0[3],C1[1]); a=MX3(a,C1[2],C1[3]); \
      _Pragma("unroll") for(int r=4;r<16;r+=4){a=MX3(a,C0[r],C0[r+1]);b=MX3(b,C0[r+2],C0[r+3]);a=MX3(a,C1[r],C1[r+1]);b=MX3(b,C1[r+2],C1[r+3]);} \
      float rm=__builtin_fmaxf(a,b); { auto rr=__builtin_amdgcn_permlane32_swap(__float_as_uint(rm),__float_as_uint(rm),false,false); rm=__builtin_fmaxf(__uint_as_float(rr[0]),__uint_as_float(rr[1])); } \
      resc=false; \
      if(__builtin_expect(__any(rm>(float)THRL),0)){ const float dl=__builtin_fmaxf(rm,0.f); mhat+=dl; \
        _Pragma("unroll") for(int r=0;r<16;++r){C0[r]-=dl;C1[r]-=dl;} \
        const float f=__builtin_amdgcn_exp2f(-dl); l_reg*=f; if(hi==0)wsf[r32]=f; resc=true; } } \
    SBAR(); \
    GAPB(o[0]=__builtin_amdgcn_mfma_f32_32x32x16_bf16(PAF(0),VFR(0),o[0],0,0,0), C0,0); \
    GAPB(o[1]=__builtin_amdgcn_mfma_f32_32x32x16_bf16(PAF(0),VFR(4),o[1],0,0,0), C0,4); \
    KRD(GL,0); GAPB(o[0]=__builtin_amdgcn_mfma_f32_32x32x16_bf16(PAF(1),VFR(1),o[0],0,0,0), C0,8); \
    KRD(GL,1); GAPB(o[1]=__builtin_amdgcn_mfma_f32_32x32x16_bf16(PAF(1),VFR(5),o[1],0,0,0), C0,12); \
    KRD(GL,2); GAPB(o[0]=__builtin_amdgcn_mfma_f32_32x32x16_bf16(PAF(2),VFR(2),o[0],0,0,0), C1,0); \
    KRD(GL,3); GAPB(o[1]=__builtin_amdgcn_mfma_f32_32x32x16_bf16(PAF(2),VFR(6),o[1],0,0,0), C1,4); \
    GAPB(o[0]=__builtin_amdgcn_mfma_f32_32x32x16_bf16(PAF(3),VFR(3),o[0],0,0,0), C1,8); \
    GAPB(o[1]=__builtin_amdgcn_mfma_f32_32x32x16_bf16(PAF(3),VFR(7),o[1],0,0,0), C1,12); \
    }while(0)
  int t=1;
  #undef CMASK
  #define CMASK(P0,P1,t) do{}while(0)
  for(;t+5<NT;t+=2){
    STEP(pB0,pB1,pA0,pA1,t,true,true,true);     WAIT_BAR(2); RESC(); ROT();
    STEP(pA0,pA1,pB0,pB1,t+1,true,true,true);   WAIT_BAR(2); RESC(); ROT();
  }
  #undef CMASK
  #define CMASK(P0,P1,t) do{int jb_=(t)-(NT-4); if(jb_>=0)cmask(P0,P1,jb_,qrel,hi);}while(0)
  #define ENDW(tt) do{ if((tt)+3<NT){WAIT_BAR(2);} else if((tt)+2<NT){WAIT_BAR(1);} else {WAIT_BAR(0);} }while(0)
  for(;t+1<NT;t+=2){
    STEP(pB0,pB1,pA0,pA1,t,(t+3<NT),(t+1<NT),(t+1<NT));       ENDW(t);   RESC(); ROT();
    STEP(pA0,pA1,pB0,pB1,t+1,(t+4<NT),(t+2<NT),(t+2<NT));     ENDW(t+1); RESC(); ROT();
  }
  STEP(pB0,pB1,pA0,pA1,NT-1,false,false,false); RESC();
  { float sacc=pB0[0]+pB0[1]; _Pragma("unroll") for(int r=2;r<16;++r)sacc+=pB0[r]; _Pragma("unroll") for(int r=0;r<16;++r)sacc+=pB1[r]; l_reg+=sacc;
    pw0=(u32x4){PKW(pB0,0),PKW(pB0,2),PKW(pB0,4),PKW(pB0,6)};pw1=(u32x4){PKW(pB0,8),PKW(pB0,10),PKW(pB0,12),PKW(pB0,14)};pw2=(u32x4){PKW(pB1,0),PKW(pB1,2),PKW(pB1,4),PKW(pB1,6)};pw3=(u32x4){PKW(pB1,8),PKW(pB1,10),PKW(pB1,12),PKW(pB1,14)};
    SBAR(); pv(o,vb0+sl_cur,PAF(0),PAF(1),PAF(2),PAF(3)); }
  #undef PKW
  #undef PAF
  #undef VFR
  #undef PIN
  #undef MX3
  #undef GAPA
  #undef GAPB
  #undef EX
  #undef VRD
  #undef KRD
  #undef STEP
  #undef ENDW
  {auto rr=__builtin_amdgcn_permlane32_swap(__float_as_uint(l_reg),__float_as_uint(l_reg),false,false);l_reg=__uint_as_float(rr[0])+__uint_as_float(rr[1]);}
  if(hi==0)wsf[32+r32]=l_reg;asm volatile("s_waitcnt lgkmcnt(0)":::"memory");
  float rli[16];
  #pragma unroll
  for(int r=0;r<16;++r)rli[r]=__builtin_amdgcn_rcpf(wsf[32+crow(r,hi)]);
  bf16*Ow=O+(rowbase+q0+wid*QBLK)*DMO+OCOL+h*D;
  { bf16*stg=(bf16*)(shm+LDS_OST)+wid*2048;
    #pragma unroll
    for(int r=0;r<16;++r){const int orow=crow(r,hi);
      #pragma unroll
      for(int d0=0;d0<2;++d0)stg[orow*64+d0*32+r32]=__float2bfloat16(o[d0][r]*rli[r]);}
    asm volatile("s_waitcnt lgkmcnt(0)":::"memory");
    #pragma unroll
    for(int i=0;i<4;++i){const int row=i*8+(lane>>3),ch=lane&7; const u32x4 v=*(const u32x4*)(stg+row*64+ch*8); ATTN_STORE16(Ow+(long)row*DMO+ch*8,v);} }
  asm volatile("s_waitcnt lgkmcnt(0)\n\ts_barrier":::"memory");
  #undef DMA_K
  #undef DMA_V
  #undef CMASK
  #undef START
  #undef BIAS
  #undef RESC
  #undef ROT
}
constexpr int ATTN_LDS_BYTES=LDS_BYTES;
struct AttnTensors { const bf16* Q; const bf16* K; const bf16* V; bf16* O; const float* nb; const float* qn; const float* kn; const int* t0tab; };
struct AttnUnit { int bh; int qb; };
struct StaticOrder {
  int vcu,G;
  __device__ __forceinline__ explicit StaticOrder(int grid,int block):vcu((grid%8==0)?(block%8)*(grid/8)+block/8:block),G(grid){}
  __device__ __forceinline__ bool next(int i,AttnUnit&u)const{ const int w=vcu+(i>>2)*G; if(w>=BATCH*NHEAD*8)return false; const int s=w&7,j=i&3; u.bh=((w>>3)+9*j)&31; u.qb=(j==0)?s:(j==1)?15-s:(j==2)?16+s:31-s; return true; }
  __device__ __forceinline__ void a_ready(const AttnUnit&)const{}
  __device__ __forceinline__ void done(const AttnUnit&)const{}
};
template<int THRL=8> __device__ __forceinline__ void attn_phase_dyn(char*lds,const AttnTensors&T,unsigned*ctr,volatile __attribute__((address_space(3))) unsigned*slot){
  const int tid=threadIdx.x,lane=tid&63;
  int ord=0;
  { const float myv=(lane<32)?T.nb[(long)lane*SEQ+SEQ-1]:3.0e38f; int rank=0;
    _Pragma("unroll") for(int j=0;j<32;++j){const float vj=__shfl(myv,j); rank+=(vj<myv||(vj==myv&&j<lane))?1:0;}
    _Pragma("unroll") for(int j=0;j<32;++j){const int rj=__shfl(rank,j); if(rj==lane)ord=j;} }
  if(tid==0){ const unsigned id=__hip_atomic_fetch_add(ctr,1u,__ATOMIC_RELAXED,__HIP_MEMORY_SCOPE_AGENT); *slot=id; }
  asm volatile("s_waitcnt vmcnt(0) lgkmcnt(0)\n\ts_barrier":::"memory");
  for(;;){
    const unsigned uid=*slot;
    if(uid>=(unsigned)(BATCH*NHEAD*NQB))break;
    unsigned nxt=0u; if(tid==0)nxt=__hip_atomic_fetch_add(ctr,1u,__ATOMIC_RELAXED,__HIP_MEMORY_SCOPE_AGENT);
    const int bh=__builtin_amdgcn_readfirstlane(__shfl(ord,(int)(uid>>5))), qb=NQB-1-(int)(uid&31u);
    const int t0=__builtin_amdgcn_readfirstlane(T.t0tab[bh*NQB+qb]);
    attn_unit<THRL>(bh/NHEAD,bh%NHEAD,qb,T.Q,T.K,T.V,T.O,T.nb+(long)bh*SEQ,t0,lds);
    if(tid==0)*slot=nxt;
    asm volatile("s_waitcnt vmcnt(0) lgkmcnt(0)\n\ts_barrier":::"memory");
  }
}
#undef SBAR
#undef WAIT_BAR
}
#define GAS __attribute__((address_space(1)))
#define LAS __attribute__((address_space(3)))
typedef unsigned short bf16;
typedef unsigned v4u __attribute__((ext_vector_type(4)));
typedef float f32x4 __attribute__((ext_vector_type(4)));
typedef short bf16x8 __attribute__((ext_vector_type(8)));
typedef GAS unsigned gu32;
typedef GAS unsigned long long gu64;
#define RLX_AGENT __ATOMIC_RELAXED, __HIP_MEMORY_SCOPE_AGENT
#define LDS_WAIT() asm volatile("s_waitcnt lgkmcnt(0)" ::: "memory")
#define VM_WAIT() asm volatile("s_waitcnt vmcnt(0)" ::: "memory")
__device__ __forceinline__ unsigned long long rt() { return __builtin_amdgcn_s_memrealtime(); }
typedef float f32x2_pk __attribute__((ext_vector_type(2))); typedef __bf16 bf16x2_pk __attribute__((ext_vector_type(2)));
__device__ __forceinline__ unsigned pk2(float lo, float hi) { f32x2_pk v = {lo, hi}; bf16x2_pk r = __builtin_convertvector(v, bf16x2_pk); return __builtin_bit_cast(unsigned, r); }
__device__ __forceinline__ unsigned f2bf(float f) { return pk2(f, 0.f) & 0xffffu; }

#define XB_TMO      128
#define XB_XCNT(j)  (256  + 64 * (j))
#define XB_XSUB(j)  (1280 + 64 * (j))
#define XB_XGEN(j)  (2304 + 64 * (j))
#define XB_TOP      3328
#define XB_TOPGEN   3392
#define XCD_BAR_WORDS 3456
#define XB_SPIN_CAP (1u << 18)

__device__ __forceinline__ unsigned xb_ld(unsigned* p)              { return __hip_atomic_load(p, __ATOMIC_RELAXED, __HIP_MEMORY_SCOPE_AGENT); }
__device__ __forceinline__ unsigned xb_add(unsigned* p, unsigned v) { return __hip_atomic_fetch_add(p, v, __ATOMIC_RELAXED, __HIP_MEMORY_SCOPE_AGENT); }
__device__ __forceinline__ unsigned xb_xcc_id() { return (unsigned)__builtin_amdgcn_s_getreg((3 << 11) | 20) & 0xFu; }
#define XB_SPIN(cond, bar) do { unsigned _sp = 0; while (cond) { __builtin_amdgcn_s_sleep(1); \
    if ((++_sp & 255u) == 0u) { if (xb_ld(&(bar)[XB_TMO])) break; if (_sp > XB_SPIN_CAP) { atomicAdd(&(bar)[XB_TMO], 1u); break; } } } } while (0)

struct XcdBarrier {
    unsigned* bar; unsigned x;
    volatile LAS unsigned* st;
};

__device__ __forceinline__ XcdBarrier xcd_barrier_post(unsigned* bar, volatile LAS unsigned* st) {
    XcdBarrier b; b.bar = bar; b.x = xb_xcc_id(); b.st = st;
    if (threadIdx.x == 0) (void)xb_add(&bar[XB_XCNT(b.x)], 1u);
    return b;
}
__device__ __forceinline__ void xcd_barrier_complete(unsigned* bar, unsigned x, unsigned& nloc, unsigned& nx) {
    const unsigned G = gridDim.x * gridDim.y * gridDim.z;
    unsigned sum, cnt, mine, sp = 0u;
    for (;;) {
        sum = 0u; cnt = 0u; mine = 0u;
#pragma unroll
        for (unsigned j = 0; j < 16; ++j) { const unsigned c = xb_ld(&bar[XB_XCNT(j)]); sum += c; cnt += (c > 0u) ? 1u : 0u; mine = (j == x) ? c : mine; }
        if (sum == G) break;
        __builtin_amdgcn_s_sleep(1);
        if ((++sp & 255u) == 0u) { if (xb_ld(&bar[XB_TMO])) break; if (sp > XB_SPIN_CAP) { atomicAdd(&bar[XB_TMO], 1u); break; } }
    }
    nloc = mine > 0u ? mine : 1u; nx = cnt > 0u ? cnt : 1u;
}

__device__ __forceinline__ void xcd_barrier(const XcdBarrier& b) {
    asm volatile("s_waitcnt vmcnt(0)" ::: "memory");
    __syncthreads();
    if (threadIdx.x == 0) {
        unsigned* bar = b.bar;
        __builtin_amdgcn_s_waitcnt(0);
        unsigned nloc = b.st[0], nx = b.st[1];
        if (nloc == 0u) { xcd_barrier_complete(bar, b.x, nloc, nx); b.st[0] = nloc; b.st[1] = nx; }
        const unsigned old = xb_add(&bar[XB_XSUB(b.x)], 1u);
        const unsigned gen = old / nloc;
        if (old + 1u == (gen + 1u) * nloc) {
            __builtin_amdgcn_fence(__ATOMIC_RELEASE, "agent");
            asm volatile("s_waitcnt vmcnt(0)" ::: "memory");
            const unsigned og = xb_add(&bar[XB_TOP], 1u);
            const unsigned tg = og / nx;
            if (og + 1u == (tg + 1u) * nx) xb_add(&bar[XB_TOPGEN], 1u);
            else XB_SPIN(xb_ld(&bar[XB_TOPGEN]) == tg, bar);
            __builtin_amdgcn_fence(__ATOMIC_ACQUIRE, "agent");
            xb_add(&bar[XB_XGEN(b.x)], 1u);
            asm volatile("s_waitcnt vmcnt(0)" ::: "memory");
        } else {
            XB_SPIN(xb_ld(&bar[XB_XGEN(b.x)]) == gen, bar);
            __builtin_amdgcn_fence(__ATOMIC_ACQUIRE, "agent");
            asm volatile("s_waitcnt vmcnt(0)" ::: "memory");
        }
    }
    __syncthreads();
}

constexpr int NWAVES = 8;
constexpr int BATCH = 4, SEQ = 8192, D = 1024, M = BATCH * SEQ;
constexpr int IN_W = 7184, NGW = 4096, NGT = 3072, NSLAB = 8;
constexpr int SL_POOL = 0, SL_MQ = 1, SL_MK = 2, SL_MV = 3, SL_MO = 4, SL_FQ = 5, SL_FK = 6, SL_FV = 7;
constexpr int ML_H = 4, ML_DH = 128, CHUNK = 64, NCH = SEQ / CHUNK;
constexpr int FX_H = 8;
constexpr int DFF = 2816, NEXP = 8, DFE = 3584;
constexpr float NORM_EPS = 1e-6f;
constexpr int KCAT = 1536;
constexpr int MOE_KROWS = 34816;
constexpr int MOE_KTILES = MOE_KROWS / 256;
constexpr int TOKBLK = 128, NTOKBLK = M / TOKBLK;

constexpr size_t MiB = 1u << 20;
constexpr size_t WS_CTL = 0, CTL_ZERO_BYTES = 1 * MiB;
constexpr size_t WS_W = 1 * MiB;
constexpr size_t W_LAYER = 19 * MiB, W_NG = 0, W_GT = 8 * MiB, W_CAT = 14 * MiB, W_OUT = 17 * MiB;
constexpr size_t WS_WGU = WS_W + 2 * W_LAYER, WS_WDN = WS_WGU + 11 * MiB;
constexpr size_t WS_NG = 56 * MiB, SLAB_BYTES = (size_t)M * 512 * 2;
constexpr size_t WS_GATE = WS_NG + SLAB_BYTES;
constexpr size_t WS_ACT0 = WS_NG;
constexpr size_t WS_HB = 312 * MiB;
constexpr size_t WS_CAT = 376 * MiB;
constexpr size_t WS_MLC = 472 * MiB;
constexpr size_t WS_MOEGU = 1 * MiB;
constexpr size_t WS_MOEDN = 57 * MiB;
constexpr size_t WS_XS = 85 * MiB;
constexpr size_t WS_Y0 = 153 * MiB, WS_Y1 = 217 * MiB;
constexpr size_t WS_ACT1 = 305 * MiB;
constexpr size_t WS_SM = 544 * MiB;
constexpr size_t SM_GATE16 = 0;
constexpr size_t SM_MLB = 2 * MiB, SM_MLA = SM_MLB + 512 * 1024, SM_MLMX = SM_MLA + 512 * 1024;
constexpr size_t SM_FNB = SM_MLMX + 512 * 1024;
constexpr size_t SM_MLN = SM_FNB + 1 * MiB;
constexpr size_t SM_MLM = SM_MLN + 1 * MiB;
constexpr size_t SM_MLDEC = SM_MLM + 16 * 132 * 4;
constexpr size_t SM_FQN = SM_MLDEC + 16 * 128 * 4, SM_FKN = SM_FQN + 32768, SM_FT0 = SM_FKN + 32768, SM_MLBG = SM_FT0 + 4096, SM_FXM = SM_MLBG + 16384;
constexpr size_t SM_MOE = 6 * MiB;
constexpr size_t MO_RSTD = 0, MO_TOKE = MO_RSTD + (size_t)M * 4, MO_TOKG = MO_TOKE + (size_t)M * 8, MO_HIST = MO_TOKG + (size_t)M * 8,
                 MO_ROWTOK = MO_HIST + (size_t)NTOKBLK * 16 * 4, MO_ROWG = MO_ROWTOK + (size_t)2 * MOE_KROWS * 4, MO_TILEE = MO_ROWG + (size_t)2 * MOE_KROWS * 4, MO_NT = MO_TILEE + 2 * MOE_KTILES * 4, MO_END = MO_NT + 64;
static_assert(SM_MOE + MO_END <= 8 * MiB, "small arrays");
constexpr size_t WS_END = 552 * MiB;
static_assert(WS_WDN + (size_t)DFF * D * 2 <= WS_NG && WS_NG + NSLAB * SLAB_BYTES <= WS_HB && WS_HB + (size_t)M * D * 2 <= WS_CAT && WS_CAT + (size_t)M * KCAT * 2 <= WS_MLC && WS_MLC + 64 * MiB <= WS_SM, "d_ws map");
static_assert(WS_MOEGU + (size_t)NEXP * 2 * DFE * D <= WS_MOEDN && WS_MOEDN + (size_t)NEXP * D * DFE <= WS_XS && WS_XS + (size_t)2 * MOE_KROWS * D <= WS_Y0 && WS_Y0 + (size_t)M * D * 2 <= WS_Y1 && WS_Y1 + (size_t)M * D * 2 <= WS_ACT1 && WS_ACT1 + (size_t)2 * MOE_KROWS * DFE <= WS_SM, "d_ws map (MoE)");
constexpr int CW_TMO = 0, CW_CODE = 1, CW_BAR = 4096;

constexpr int RING_OFF = 0, RING_BYTES = 131072;
constexpr int LDSCTL_OFF = RING_BYTES, MISC_OFF = LDSCTL_OFF + 320;
constexpr int LDS_BYTES = 147456;
static_assert(MISC_OFF + 128 <= LDS_BYTES, "LDS map");

struct Frame {
    LAS unsigned char* lds;
    volatile LAS unsigned* MISC;
    gu32* ctl;
    int tid, lane, wave;
    int vcu, G, blk;
    unsigned char* ws;
    const float* const* in; float* out; int zi;
};
#define INP(F, i) ((F).in[(i) + (F).zi])
enum { IN_X = 0, IN_MIXG, IN_WIN, IN_POOLW, IN_POOLS, IN_CONVW, IN_MLBI, IN_MLBF, IN_MLNG, IN_FXBF, IN_WBRP, IN_WBRM, IN_WBRF, IN_WOUT, IN_FFNG, IN_FFG, IN_FFU, IN_FFD, IN_RW, IN_RB, IN_MOEG, IN_MOEU, IN_MOED, IN_FING };

__device__ __forceinline__ float wave_sum(float v) {
#pragma unroll
    for (int o = 1; o < 64; o <<= 1) v += __shfl_xor(v, o);
    return v;
}
__device__ __forceinline__ float wave_max(float v) {
#pragma unroll
    for (int o = 1; o < 64; o <<= 1) v = fmaxf(v, __shfl_xor(v, o));
    return v;
}
__device__ __forceinline__ float sigmoid_f(float x) { return __builtin_amdgcn_rcpf(1.f + __builtin_amdgcn_exp2f(-1.4426950408889634f * x)); }
__device__ __forceinline__ float logsigmoid_f(float x) { return fminf(x, 0.f) - log1pf(expf(-fabsf(x))); }

__device__ __forceinline__ void tr_item(const float* W, int ldw, int srccol0, const float* gain, bf16* WT, int ldt, int drow0, int dcol0, int k0, LAS float* scr, int lane) {
    (void)scr;
    const int ng = lane & 7, kg = lane >> 3;
    f32x4 v[8];
#pragma unroll
    for (int i = 0; i < 8; ++i) v[i] = *(const GAS f32x4*)(W + (size_t)(k0 + 8 * kg + i) * ldw + srccol0 + 4 * ng);
    if (gain) { const f32x4 g0 = *(const GAS f32x4*)(gain + k0 + 8 * kg), g1 = *(const GAS f32x4*)(gain + k0 + 8 * kg + 4);
#pragma unroll
        for (int i = 0; i < 4; ++i) { v[i] = v[i] * g0[i]; v[4 + i] = v[4 + i] * g1[i]; } }
#pragma unroll
    for (int j = 0; j < 4; ++j) { v4u o; o.x = pk2(v[0][j], v[1][j]); o.y = pk2(v[2][j], v[3][j]); o.z = pk2(v[4][j], v[5][j]); o.w = pk2(v[6][j], v[7][j]);
        *(GAS v4u*)(WT + (size_t)(drow0 + 4 * ng + j) * ldt + dcol0 + k0 + 8 * kg) = o; }
}
__device__ __forceinline__ void tr_item_fp8(const float* W, int ldw, int srccol0, const float* gain, float scale, unsigned char* WT8, int ldt, int drow0, int k0, int lane) {
    const int ng = lane & 7, kg = lane >> 3;
    f32x4 v[8];
#pragma unroll
    for (int i = 0; i < 8; ++i) v[i] = *(const GAS f32x4*)(W + (size_t)(k0 + 8 * kg + i) * ldw + srccol0 + 4 * ng);
    f32x4 g0 = (f32x4){scale, scale, scale, scale}, g1 = g0;
    if (gain) { g0 = *(const GAS f32x4*)(gain + k0 + 8 * kg) * scale; g1 = *(const GAS f32x4*)(gain + k0 + 8 * kg + 4) * scale; }
#pragma unroll
    for (int i = 0; i < 4; ++i) { v[i] = v[i] * g0[i]; v[4 + i] = v[4 + i] * g1[i]; }
    typedef unsigned u32x2_t __attribute__((ext_vector_type(2)));
#pragma unroll
    for (int j = 0; j < 4; ++j) { u32x2_t o; o.x = pg8::pack_fp8x4(v[0][j], v[1][j], v[2][j], v[3][j]); o.y = pg8::pack_fp8x4(v[4][j], v[5][j], v[6][j], v[7][j]);
        *(GAS u32x2_t*)(WT8 + (size_t)(drow0 + 4 * ng + j) * ldt + k0 + 8 * kg) = o; }
}
constexpr float FP8_ASCALE = 16.f, FP8_WSCALE = 256.f;
constexpr int CI_NG = 2048, CI_GT = 1536, CI_BR = 256, CI_OUT = 512, CI_LAYER = CI_NG + CI_GT + 2 * CI_BR + CI_OUT, CI_GU = 2816, CI_DN = 1408, CI_MAIN = 2 * CI_LAYER + CI_GU + CI_DN;
__device__ __forceinline__ void conv_item_main(Frame& F, int it, LAS float* scr) {
    if (it < 2 * CI_LAYER) {
        const int l = it / CI_LAYER; int r = it % CI_LAYER; bf16* wl = (bf16*)(F.ws + WS_W + (size_t)l * W_LAYER);
        const float* g = INP(F, IN_MIXG) + l * D; const float* win = INP(F, IN_WIN) + (size_t)l * D * IN_W;
        if (r < CI_NG) { const int nb = r >> 4, kb = r & 15; tr_item(win, IN_W, nb * 32 + (nb * 32 >= 2560 ? 8 : 0), g, wl + W_NG / 2, D, nb * 32, 0, kb * 64, scr, F.lane); return; } r -= CI_NG;
        if (r < CI_GT) { const int nb = r >> 4, kb = r & 15; tr_item_fp8(win, IN_W, 4112 + nb * 32, g, FP8_WSCALE, (unsigned char*)wl + W_GT, D, nb * 32, kb * 64, F.lane); return; } r -= CI_GT;
        if (r < CI_BR) { const int nb = r >> 3, kb = r & 7; tr_item(INP(F, IN_WBRM) + (size_t)l * 512 * D, D, nb * 32, nullptr, wl + W_CAT / 2, KCAT, nb * 32, 512, kb * 64, scr, F.lane); return; } r -= CI_BR;
        if (r < CI_BR) { const int nb = r >> 3, kb = r & 7; tr_item(INP(F, IN_WBRF) + (size_t)l * 512 * D, D, nb * 32, nullptr, wl + W_CAT / 2, KCAT, nb * 32, 1024, kb * 64, scr, F.lane); return; } r -= CI_BR;
        { const int nb = r >> 4, kb = r & 15; tr_item(INP(F, IN_WOUT) + (size_t)l * D * D, D, nb * 32, nullptr, wl + W_OUT / 2, D, nb * 32, 0, kb * 64, scr, F.lane); }
        return;
    }
    it -= 2 * CI_LAYER;
    if (it < CI_GU) { const int nb = it >> 4, kb = it & 15, p = nb >> 3, w = nb & 7;
        tr_item(w < 4 ? INP(F, IN_FFG) : INP(F, IN_FFU), DFF, 128 * p + (w & 3) * 32, INP(F, IN_FFNG), (bf16*)(F.ws + WS_WGU), D, nb * 32, 0, kb * 64, scr, F.lane); return; }
    it -= CI_GU;
    { const int kb = it >> 5, nb = it & 31; tr_item(INP(F, IN_FFD), D, nb * 32, nullptr, (bf16*)(F.ws + WS_WDN), DFF, nb * 32, 0, kb * 64, scr, F.lane); }
}
constexpr int CI_MGU = 3584, CI_MDN = 1792, CI_MEXP = CI_MGU + CI_MDN, CI_MOE = NEXP * CI_MEXP;
__device__ __forceinline__ void conv_item_moe(Frame& F, int it, LAS float* scr) {
    (void)scr;
    const int e = it / CI_MEXP; int r = it % CI_MEXP;
    if (r < CI_MGU) { const int nb = r % 224, kb = r / 224, p = nb >> 3, w = nb & 7;
        tr_item_fp8((w < 4 ? INP(F, IN_MOEG) : INP(F, IN_MOEU)) + (size_t)e * D * DFE, DFE, 128 * p + (w & 3) * 32, INP(F, IN_FFNG) + D, FP8_WSCALE, F.ws + WS_MOEGU + (size_t)e * 2 * DFE * D, D, nb * 32, kb * 64, F.lane); return; }
    r -= CI_MGU;
    { const int kb = r >> 5, nb = r & 31; tr_item_fp8(INP(F, IN_MOED) + (size_t)e * DFE * D, D, nb * 32, nullptr, FP8_WSCALE, F.ws + WS_MOEDN + (size_t)e * D * DFE, DFE, nb * 32, kb * 64, F.lane); }
}
__device__ __forceinline__ void pool_fold(Frame& F) {
    const int gt = F.blk * (NWAVES * 64) + F.tid, NT = F.G * NWAVES * 64;
    for (int o = gt; o < 2 * 4 * 16 * D; o += NT) {
        const int n = o & (D - 1), cb = __builtin_amdgcn_readfirstlane(o >> 10), l = cb >> 6, g = (cb >> 4) & 3, c0 = (cb & 15) * 8;
        const float* wg = INP(F, IN_POOLW) + (size_t)l * 4 * 128 * 128 + (size_t)(g * 128 + c0) * 128; const float* sc = INP(F, IN_POOLS) + l * 512 + g * 128; const float* wb = INP(F, IN_WBRP) + (size_t)l * 512 * D + (size_t)(g * 128) * D + n;
        float a[8];
#pragma unroll
        for (int i = 0; i < 8; ++i) a[i] = 0.f;
#pragma unroll 8
        for (int dd = 0; dd < 128; ++dd) { const float t = sc[dd] * wb[(size_t)dd * D];
#pragma unroll
            for (int i = 0; i < 8; ++i) a[i] += wg[i * 128 + dd] * t; }
        v4u w; w.x = pk2(a[0], a[1]); w.y = pk2(a[2], a[3]); w.z = pk2(a[4], a[5]); w.w = pk2(a[6], a[7]);
        *(GAS v4u*)((bf16*)(F.ws + WS_W + (size_t)l * W_LAYER + W_CAT) + (size_t)n * KCAT + g * 128 + c0) = w;
    }
}

template <bool XB> __device__ __forceinline__ void load_xrow(const void* x, size_t m, int lane, f32x4 (&v)[4]) {
    if constexpr (XB) { typedef unsigned u32x2_t __attribute__((ext_vector_type(2))); const GAS u32x2_t* xr = (const GAS u32x2_t*)((const bf16*)x + m * D) + lane;
#pragma unroll
        for (int j = 0; j < 4; ++j) { const u32x2_t q = xr[64 * j]; v[j] = (f32x4){__uint_as_float(q.x << 16), __uint_as_float(q.x & 0xffff0000u), __uint_as_float(q.y << 16), __uint_as_float(q.y & 0xffff0000u)}; } }
    else { const GAS f32x4* xr = (const GAS f32x4*)((const float*)x + m * D) + lane;
#pragma unroll
        for (int j = 0; j < 4; ++j) v[j] = xr[64 * j]; }
}
template <bool XB> __device__ __forceinline__ void phase_norm_mix(Frame& F, const void* x, int l) {
    LAS float* w16 = (LAS float*)(F.lds);
    const float* g = INP(F, IN_MIXG) + l * D; const float* win = INP(F, IN_WIN) + (size_t)l * D * IN_W;
    for (int idx = F.tid; idx < 16 * D; idx += NWAVES * 64) { const int k = idx >> 4, j = idx & 15, col = j < 8 ? 2560 + j : 4104 + (j - 8); w16[j * D + k] = g[k] * win[(size_t)k * IN_W + col]; }
    __syncthreads();
    bf16* HB = (bf16*)(F.ws + WS_HB); float* gate16 = (float*)(F.ws + WS_SM + SM_GATE16);
    const int gw = F.vcu * NWAVES + F.wave, NGWV = F.G * NWAVES;
    f32x4 nv[4]; if (gw < M) load_xrow<XB>(x, (size_t)gw, F.lane, nv);
    for (int m = gw; m < M; m += NGWV) {
        f32x4 v[4]; float ss = 0.f;
#pragma unroll
        for (int j = 0; j < 4; ++j) v[j] = nv[j];
        if (m + NGWV < M) load_xrow<XB>(x, (size_t)(m + NGWV), F.lane, nv);
#pragma unroll
        for (int j = 0; j < 4; ++j) ss += (v[j].x * v[j].x + v[j].y * v[j].y) + (v[j].z * v[j].z + v[j].w * v[j].w);
        const float rstd = 1.f / sqrtf(wave_sum(ss) * (1.f / D) + NORM_EPS);
        GAS unsigned long long* o8 = (GAS unsigned long long*)(HB + (size_t)m * D) + F.lane;
#pragma unroll
        for (int j = 0; j < 4; ++j) o8[64 * j] = (unsigned long long)pk2(v[j].x * rstd, v[j].y * rstd) | ((unsigned long long)pk2(v[j].z * rstd, v[j].w * rstd) << 32);
        float pp[16];
#pragma unroll
        for (int jj = 0; jj < 16; ++jj) { float p = 0.f;
#pragma unroll
            for (int j = 0; j < 4; ++j) { const f32x4 wv = *(const LAS f32x4*)(w16 + jj * D + 256 * j + 4 * F.lane); p += (v[j].x * wv.x + v[j].y * wv.y) + (v[j].z * wv.z + v[j].w * wv.w); }
            pp[jj] = p; if ((jj & 3) == 3) asm volatile("" ::: "memory"); }
#define TB_STAGE(ST, N) { const bool up = (F.lane >> (ST)) & 1; _Pragma("unroll") for (int i = 0; i < (N); ++i) { const float mine = up ? pp[2 * i + 1] : pp[2 * i], give = up ? pp[2 * i] : pp[2 * i + 1]; pp[i] = mine + __shfl_xor(give, 1 << (ST)); } }
        TB_STAGE(0, 8) TB_STAGE(1, 4) TB_STAGE(2, 2) TB_STAGE(3, 1)
        float keep = pp[0]; keep += __shfl_xor(keep, 16); keep += __shfl_xor(keep, 32); keep *= rstd;
        if (F.lane < 16) gate16[(size_t)m * 16 + F.lane] = keep;
    }
    __syncthreads();
}
__device__ __forceinline__ void phase_norm_ffn(Frame& F, const bf16* x) {
    bf16* HB = (bf16*)(F.ws + WS_HB);
    const int gw = F.vcu * NWAVES + F.wave, NGWV = F.G * NWAVES;
    f32x4 nv[4]; if (gw < M) load_xrow<true>(x, (size_t)gw, F.lane, nv);
    for (int m = gw; m < M; m += NGWV) {
        f32x4 v[4]; float ss = 0.f;
#pragma unroll
        for (int j = 0; j < 4; ++j) v[j] = nv[j];
        if (m + NGWV < M) load_xrow<true>(x, (size_t)(m + NGWV), F.lane, nv);
#pragma unroll
        for (int j = 0; j < 4; ++j) ss += (v[j].x * v[j].x + v[j].y * v[j].y) + (v[j].z * v[j].z + v[j].w * v[j].w);
        const float rstd = 1.f / sqrtf(wave_sum(ss) * (1.f / D) + NORM_EPS);
        GAS unsigned long long* o8 = (GAS unsigned long long*)(HB + (size_t)m * D) + F.lane;
#pragma unroll
        for (int j = 0; j < 4; ++j) o8[64 * j] = (unsigned long long)pk2(v[j].x * rstd, v[j].y * rstd) | ((unsigned long long)pk2(v[j].z * rstd, v[j].w * rstd) << 32);
    }
}
__device__ __forceinline__ void quant_rows_fp8(Frame& F, const bf16* src, unsigned char* dst) {
    const int gw = F.vcu * NWAVES + F.wave, NGWV = F.G * NWAVES;
    for (int m = gw; m < M; m += NGWV) {
        const v4u a = *((const GAS v4u*)(src + (size_t)m * D) + F.lane), b = *((const GAS v4u*)(src + (size_t)m * D) + 64 + F.lane);
        typedef unsigned u32x2_t __attribute__((ext_vector_type(2)));
        u32x2_t o0, o1; const float s = FP8_ASCALE;
        o0.x = pg8::pack_fp8x4(__uint_as_float(a.x << 16) * s, __uint_as_float(a.x & 0xffff0000u) * s, __uint_as_float(a.y << 16) * s, __uint_as_float(a.y & 0xffff0000u) * s);
        o0.y = pg8::pack_fp8x4(__uint_as_float(a.z << 16) * s, __uint_as_float(a.z & 0xffff0000u) * s, __uint_as_float(a.w << 16) * s, __uint_as_float(a.w & 0xffff0000u) * s);
        o1.x = pg8::pack_fp8x4(__uint_as_float(b.x << 16) * s, __uint_as_float(b.x & 0xffff0000u) * s, __uint_as_float(b.y << 16) * s, __uint_as_float(b.y & 0xffff0000u) * s);
        o1.y = pg8::pack_fp8x4(__uint_as_float(b.z << 16) * s, __uint_as_float(b.z & 0xffff0000u) * s, __uint_as_float(b.w << 16) * s, __uint_as_float(b.w & 0xffff0000u) * s);
        *((GAS u32x2_t*)(dst + (size_t)m * D) + F.lane) = o0; *((GAS u32x2_t*)(dst + (size_t)m * D) + 64 + F.lane) = o1;
    }
}
__device__ __forceinline__ void phase_norm_final(Frame& F, const bf16* xb, float* out, float* tmp) {
    const GAS f32x4* gp = (const GAS f32x4*)INP(F, IN_FING) + F.lane; f32x4 gv[4];
#pragma unroll
    for (int j = 0; j < 4; ++j) gv[j] = gp[64 * j];
    const bf16* Y0 = (const bf16*)(F.ws + WS_Y0); const bf16* Y1 = (const bf16*)(F.ws + WS_Y1);
    const int gw = F.vcu * NWAVES + F.wave, NGWV = F.G * NWAVES;
    f32x4 nv[4], na[4], nb_[4]; if (gw < M) { load_xrow<true>(xb, (size_t)gw, F.lane, nv); load_xrow<true>(Y0, (size_t)gw, F.lane, na); load_xrow<true>(Y1, (size_t)gw, F.lane, nb_); }
    for (int m = gw; m < M; m += NGWV) {
        f32x4 v[4]; float ss = 0.f;
#pragma unroll
        for (int j = 0; j < 4; ++j) v[j] = nv[j] + (na[j] + nb_[j]);
        if (m + NGWV < M) { load_xrow<true>(xb, (size_t)(m + NGWV), F.lane, nv); load_xrow<true>(Y0, (size_t)(m + NGWV), F.lane, na); load_xrow<true>(Y1, (size_t)(m + NGWV), F.lane, nb_); }
#pragma unroll
        for (int j = 0; j < 4; ++j) ss += (v[j].x * v[j].x + v[j].y * v[j].y) + (v[j].z * v[j].z + v[j].w * v[j].w);
        const float rstd = 1.f / sqrtf(wave_sum(ss) * (1.f / D) + NORM_EPS);
        GAS f32x4* o = (GAS f32x4*)((m < M / 2 ? out + (size_t)m * D : tmp + (size_t)(m - M / 2) * D)) + F.lane;
#pragma unroll
        for (int j = 0; j < 4; ++j) o[64 * j] = v[j] * rstd * gv[j];
    }
}
__device__ __forceinline__ void phase_copy_upper(Frame& F, const float* tmp, float* out) {
    const size_t n4 = (size_t)(M / 2) * D / 4; const GAS f32x4* s = (const GAS f32x4*)tmp; GAS f32x4* d = (GAS f32x4*)(out + (size_t)(M / 2) * D);
    for (size_t i = (size_t)F.vcu * (NWAVES * 64) + F.tid; i < n4; i += (size_t)F.G * NWAVES * 64) d[i] = s[i];
}

__device__ __forceinline__ void phase_route1(Frame& F, const bf16* x) {
    LAS float* w8 = (LAS float*)(F.lds);
    LAS int* hist = (LAS int*)(F.lds + 32768);
    const float* g = INP(F, IN_FFNG) + D; const float* rw = INP(F, IN_RW);
    for (int idx = F.tid; idx < 8 * D; idx += NWAVES * 64) { const int k = idx >> 3, e = idx & 7; w8[e * D + k] = g[k] * rw[(size_t)k * 8 + e]; }
    unsigned char* sm = F.ws + WS_SM + SM_MOE;
    float* rstd_g = (float*)(sm + MO_RSTD); int* tok_e = (int*)(sm + MO_TOKE); float* tok_g = (float*)(sm + MO_TOKG); int* hist_g = (int*)(sm + MO_HIST);
    for (int blk = F.blk; blk < NTOKBLK; blk += F.G) {
        if (F.tid < 16) hist[F.tid] = 0;
        __syncthreads();
        f32x4 nv[4]; load_xrow<true>(x, (size_t)(blk * TOKBLK + F.wave * (TOKBLK / NWAVES)), F.lane, nv);
        for (int i = 0; i < TOKBLK / NWAVES; ++i) {
            const int m = blk * TOKBLK + F.wave * (TOKBLK / NWAVES) + i;
            f32x4 v[4]; float ss = 0.f;
#pragma unroll
            for (int j = 0; j < 4; ++j) v[j] = nv[j];
            if (i + 1 < TOKBLK / NWAVES) load_xrow<true>(x, (size_t)(m + 1), F.lane, nv);
#pragma unroll
            for (int j = 0; j < 4; ++j) ss += (v[j].x * v[j].x + v[j].y * v[j].y) + (v[j].z * v[j].z + v[j].w * v[j].w);
            const float rstd = 1.f / sqrtf(wave_sum(ss) * (1.f / D) + NORM_EPS);
            float pp[8];
#pragma unroll
            for (int e = 0; e < 8; ++e) { float p = 0.f;
#pragma unroll
                for (int j = 0; j < 4; ++j) { const f32x4 wv = *(const LAS f32x4*)(w8 + e * D + 256 * j + 4 * F.lane); p += (v[j].x * wv.x + v[j].y * wv.y) + (v[j].z * wv.z + v[j].w * wv.w); }
                pp[e] = p; }
            TB_STAGE(0, 4) TB_STAGE(1, 2) TB_STAGE(2, 1)
            float tot = pp[0]; tot += __shfl_xor(tot, 8); tot += __shfl_xor(tot, 16); tot += __shfl_xor(tot, 32);
            float lg[8];
#pragma unroll
            for (int e = 0; e < 8; ++e) lg[e] = __shfl(tot, e) * rstd + INP(F, IN_RB)[e];
            if (F.lane == 0) {
                int e0 = 0; float v0 = lg[0];
#pragma unroll
                for (int e = 1; e < 8; ++e) if (lg[e] > v0) { v0 = lg[e]; e0 = e; }
                int e1 = -1; float v1 = -INFINITY;
#pragma unroll
                for (int e = 0; e < 8; ++e) if (e != e0 && lg[e] > v1) { v1 = lg[e]; e1 = e; }
                const float t = __expf(v1 - v0), g0 = 1.f / (1.f + t), g1 = t * g0;
                rstd_g[m] = rstd; tok_e[2 * m] = e0; tok_e[2 * m + 1] = e1; tok_g[2 * m] = g0; tok_g[2 * m + 1] = g1;
                atomicAdd((int*)&hist[e0], 1); atomicAdd((int*)&hist[8 + e1], 1);
            }
        }
        __syncthreads();
        if (F.tid < 16) hist_g[blk * 16 + F.tid] = hist[F.tid];
        __syncthreads();
    }
}
__device__ __forceinline__ void phase_route2(Frame& F, const bf16* x) {
    LAS int* H = (LAS int*)(F.lds);
    LAS int* tot = (LAS int*)(F.lds + 16384); LAS int* pre = tot + 16; LAS int* start = tot + 32; LAS int* dest = tot + 64; LAS int* te = tot + 320;
    unsigned char* sm = F.ws + WS_SM + SM_MOE;
    const float* rstd_g = (const float*)(sm + MO_RSTD); const int* tok_e = (const int*)(sm + MO_TOKE); const float* tok_g = (const float*)(sm + MO_TOKG); const int* hist_g = (const int*)(sm + MO_HIST);
    int* row_tok = (int*)(sm + MO_ROWTOK); float* row_g = (float*)(sm + MO_ROWG); int* tile_e = (int*)(sm + MO_TILEE); int* ntl = (int*)(sm + MO_NT);
    unsigned char* XS = F.ws + WS_XS;
    for (int blk = F.blk; blk < NTOKBLK; blk += F.G) {
        for (int i = F.tid; i < NTOKBLK * 16; i += NWAVES * 64) H[i] = hist_g[i];
        __syncthreads();
        if (F.tid < 16) { int t = 0, p = 0; for (int b = 0; b < NTOKBLK; ++b) { const int h = H[b * 16 + F.tid]; if (b < blk) p += h; t += h; } tot[F.tid] = t; pre[F.tid] = p; }
        __syncthreads();
        if (F.tid == 0) { for (int k = 0; k < 2; ++k) { int run = 0; for (int e = 0; e < 8; ++e) { start[k * 8 + e] = run; run += ((tot[k * 8 + e] + 255) >> 8) << 8; } if (blk == 0) ntl[k] = run >> 8; } }
        __syncthreads();
        if (F.tid < 2 * TOKBLK) te[F.tid] = tok_e[2 * blk * TOKBLK + F.tid];
        __syncthreads();
        if (F.tid < 16) { const int k = F.tid >> 3, e = F.tid & 7; int cnt = 0; const int base = k * MOE_KROWS + start[F.tid] + pre[F.tid];
            for (int i = 0; i < TOKBLK; ++i) if (te[2 * i + k] == e) { dest[2 * i + k] = base + cnt; ++cnt; }
            if (blk == 0) { const int s0 = start[F.tid], t0 = tot[F.tid], pe = ((t0 + 255) >> 8) << 8;
                for (int tI = s0 >> 8; tI < (s0 + pe) >> 8; ++tI) tile_e[k * MOE_KTILES + tI] = e;
                for (int r = s0 + t0; r < s0 + pe; ++r) { row_tok[k * MOE_KROWS + r] = -1; row_g[k * MOE_KROWS + r] = 0.f; } } }
        __syncthreads();
        for (int i0 = 0; i0 < TOKBLK / NWAVES; i0 += 4) {
            f32x4 xv[4][4]; float rs[4]; float tg[4][2];
#pragma unroll
            for (int q = 0; q < 4; ++q) { const int m = blk * TOKBLK + F.wave * (TOKBLK / NWAVES) + i0 + q; load_xrow<true>(x, (size_t)m, F.lane, xv[q]); rs[q] = rstd_g[m]; tg[q][0] = tok_g[2 * m]; tg[q][1] = tok_g[2 * m + 1]; }
#pragma unroll
            for (int q = 0; q < 4; ++q) { const int li = F.wave * (TOKBLK / NWAVES) + i0 + q, m = blk * TOKBLK + li; const int d0 = dest[2 * li], d1 = dest[2 * li + 1];
                GAS unsigned* o0 = (GAS unsigned*)(XS + (size_t)d0 * D) + F.lane; GAS unsigned* o1 = (GAS unsigned*)(XS + (size_t)d1 * D) + F.lane; const float sc = rs[q] * FP8_ASCALE;
#pragma unroll
                for (int j = 0; j < 4; ++j) { const f32x4 v = xv[q][j]; const unsigned w = pg8::pack_fp8x4(v.x * sc, v.y * sc, v.z * sc, v.w * sc); o0[64 * j] = w; o1[64 * j] = w; }
                if (F.lane == 0) { row_tok[d0] = m; row_g[d0] = tg[q][0]; row_tok[d1] = m; row_g[d1] = tg[q][1]; } }
        }
        __syncthreads();
    }
}

__device__ __forceinline__ float wave_scan_add(float v, int lane) {
#pragma unroll
    for (int d = 1; d < 64; d <<= 1) { const float t = __shfl_up(v, d); if (lane >= d) v += t; }
    return v;
}
__device__ __forceinline__ float wave_scan_max(float v, int lane) {
#pragma unroll
    for (int d = 1; d < 64; d <<= 1) { const float t = __shfl_up(v, d); if (lane >= d) v = fmaxf(v, t); }
    return v;
}
__device__ __forceinline__ void prep_mlstm(Frame& F, int l, int bh) {
    LAS float* Bc = (LAS float*)(F.lds); LAS float* Gc = Bc + NCH; LAS float* mc = Gc + NCH;
    const int b = bh >> 2, h = bh & 3;
    const float* gate16 = (const float*)(F.ws + WS_SM + SM_GATE16);
    float* mlb = (float*)(F.ws + WS_SM + SM_MLB) + (size_t)bh * SEQ; float* mla = (float*)(F.ws + WS_SM + SM_MLA) + (size_t)bh * SEQ; float* mlmx = (float*)(F.ws + WS_SM + SM_MLMX) + (size_t)bh * SEQ;
    float* mlm = (float*)(F.ws + WS_SM + SM_MLM) + bh * 132; float* mldec = (float*)(F.ws + WS_SM + SM_MLDEC) + bh * NCH;
    const float bi = INP(F, IN_MLBI)[l * ML_H + h], bf = INP(F, IN_MLBF)[l * ML_H + h];
    float areg[NCH / NWAVES];
#pragma unroll
    for (int ci = 0; ci < NCH / NWAVES; ++ci) {
        const int c = F.wave + NWAVES * ci, t = c * CHUNK + F.lane; const size_t m = (size_t)b * SEQ + t;
        const float lf = logsigmoid_f(gate16[m * 16 + 4 + h] + bf), li = gate16[m * 16 + h] + bi;
        const float bc = wave_scan_add(lf, F.lane), a = li - bc;
        const float amax = wave_max(a), btot = __shfl(bc, 63);
        mlb[t] = bc; mla[t] = a; areg[ci] = a;
        if (F.lane == 0) { Bc[c] = btot; Gc[c] = btot + amax; }
    }
    __syncthreads();
    if (F.tid == 0) { float mm = 0.f; for (int c = 0; c < NCH; ++c) { mc[c] = mm; const float mn = fmaxf(Bc[c] + mm, Gc[c]); mldec[c] = __expf(Bc[c] + mm - mn); mlm[c] = mm; mm = mn; } mc[NCH] = mm; mlm[NCH] = mm; }
    __syncthreads();
#pragma unroll
    for (int ci = 0; ci < NCH / NWAVES; ++ci) {
        const int c = F.wave + NWAVES * ci, t = c * CHUNK + F.lane;
        mlmx[t] = fmaxf(mc[c], wave_scan_max(areg[ci], F.lane));
    }
    __syncthreads();
}
__device__ __forceinline__ void prep_fox(Frame& F, int l, int bh) {
    LAS float* wtot = (LAS float*)(F.lds);
    const int b = bh >> 3, h = bh & 7;
    const float* gate16 = (const float*)(F.ws + WS_SM + SM_GATE16);
    float* nb = (float*)(F.ws + WS_SM + SM_FNB) + (size_t)bh * SEQ;
    const float bf = INP(F, IN_FXBF)[l * FX_H + h];
    float v[16]; float s = 0.f;
#pragma unroll
    for (int i = 0; i < 16; ++i) { const size_t m = (size_t)b * SEQ + F.tid * 16 + i; s += logsigmoid_f(gate16[m * 16 + 8 + h] + bf); v[i] = s; }
    const float incl = wave_scan_add(s, F.lane);
    if (F.lane == 63) wtot[F.wave] = incl;
    __syncthreads();
    float off = incl - s;
    for (int w = 0; w < F.wave; ++w) off += wtot[w];
#pragma unroll
    for (int i = 0; i < 16; ++i) nb[F.tid * 16 + i] = -1.4426950408889634f * (off + v[i]);
    __syncthreads();
}

__device__ __forceinline__ void unpack8(const v4u q, float (&f)[8]) {
    f[0] = __uint_as_float(q.x << 16); f[1] = __uint_as_float(q.x & 0xffff0000u); f[2] = __uint_as_float(q.y << 16); f[3] = __uint_as_float(q.y & 0xffff0000u);
    f[4] = __uint_as_float(q.z << 16); f[5] = __uint_as_float(q.z & 0xffff0000u); f[6] = __uint_as_float(q.w << 16); f[7] = __uint_as_float(q.w & 0xffff0000u);
}
__device__ __forceinline__ void pool_item(Frame& F, int item) {
    const bf16* U = (const bf16*)(F.ws + WS_NG + SL_POOL * SLAB_BYTES) + F.lane * 8; bf16* CAT = (bf16*)(F.ws + WS_CAT) + F.lane * 8;
    const int grp = F.lane >> 4, w = 2 << grp, m0 = item * 32, tt0 = m0 & (SEQ - 1);
    v4u ring[16];
#pragma unroll
    for (int j = 1; j < 16; ++j) { ring[(16 - j) & 15] = (v4u){0u, 0u, 0u, 0u}; if (tt0 - j >= 0) ring[(16 - j) & 15] = *(const GAS v4u*)(U + (size_t)(m0 - j) * 512); }
    float sum[8];
#pragma unroll
    for (int i = 0; i < 8; ++i) sum[i] = 0.f;
#pragma unroll
    for (int j = 1; j < 16; ++j) { float f[8]; unpack8(ring[(16 - j) & 15], f); const float on = (j < w) ? 1.f : 0.f;
#pragma unroll
        for (int i = 0; i < 8; ++i) sum[i] += on * f[i]; }
#pragma unroll
    for (int r0 = 0; r0 < 32; r0 += 8) {
        v4u cur[8];
#pragma unroll
        for (int j = 0; j < 8; ++j) cur[j] = *(const GAS v4u*)(U + (size_t)(m0 + r0 + j) * 512);
#pragma unroll
        for (int j = 0; j < 8; ++j) { const int r = r0 + j, tt = tt0 + r;
            float c[8]; unpack8(cur[j], c);
#pragma unroll
            for (int i = 0; i < 8; ++i) sum[i] += c[i];
            const int cnt = (tt + 1 < w) ? tt + 1 : w; const float inv = 1.f / (float)cnt;
            v4u o; o.x = pk2(sum[0] * inv - c[0], sum[1] * inv - c[1]); o.y = pk2(sum[2] * inv - c[2], sum[3] * inv - c[3]); o.z = pk2(sum[4] * inv - c[4], sum[5] * inv - c[5]); o.w = pk2(sum[6] * inv - c[6], sum[7] * inv - c[7]);
            *(GAS v4u*)(CAT + (size_t)(m0 + r) * KCAT) = o;
            const v4u a2 = (r - 1 >= 0 || true) ? ((r - 1) >= r0 ? cur[(j - 1) & 7] : ring[(r - 1) & 15]) : ring[0];
            const v4u a4 = ((r - 3) >= r0) ? cur[(j - 3) & 7] : ring[(r - 3) & 15];
            const v4u a8 = ((r - 7) >= r0) ? cur[(j - 7) & 7] : ring[(r - 7) & 15];
            const v4u a16 = ring[(r - 15) & 15];
            v4u old; old.x = grp == 0 ? a2.x : (grp == 1 ? a4.x : (grp == 2 ? a8.x : a16.x)); old.y = grp == 0 ? a2.y : (grp == 1 ? a4.y : (grp == 2 ? a8.y : a16.y));
            old.z = grp == 0 ? a2.z : (grp == 1 ? a4.z : (grp == 2 ? a8.z : a16.z)); old.w = grp == 0 ? a2.w : (grp == 1 ? a4.w : (grp == 2 ? a8.w : a16.w));
            float f[8]; unpack8(old, f);
#pragma unroll
            for (int i = 0; i < 8; ++i) sum[i] -= f[i];
        }
#pragma unroll
        for (int j = 0; j < 8; ++j) ring[(r0 + j) & 15] = cur[j];
    }
}

__device__ __forceinline__ void fox_norm_item(Frame& F, int it) {
    const int bhblk = it >> 3, wv = it & 7, bh = bhblk >> 5, blk = bhblk & 31, b = bh >> 3, h = bh & 7;
    const size_t m = (size_t)b * SEQ + blk * 256 + wv * 32 + (F.lane >> 1); const int col = h * 64 + (F.lane & 1) * 32;
    const bf16* QS = (const bf16*)(F.ws + WS_NG + SL_FQ * SLAB_BYTES) + m * 512 + col; const bf16* KS = (const bf16*)(F.ws + WS_NG + SL_FK * SLAB_BYTES) + m * 512 + col;
    float sq = 0.f, sk = 0.f, dq = 0.f;
#pragma unroll
    for (int i = 0; i < 4; ++i) { float f[8], g[8]; const v4u a = *(const GAS v4u*)(QS + 8 * i), c = *(const GAS v4u*)(KS + 8 * i);
        f[0] = __uint_as_float(a.x << 16); f[1] = __uint_as_float(a.x & 0xffff0000u); f[2] = __uint_as_float(a.y << 16); f[3] = __uint_as_float(a.y & 0xffff0000u); f[4] = __uint_as_float(a.z << 16); f[5] = __uint_as_float(a.z & 0xffff0000u); f[6] = __uint_as_float(a.w << 16); f[7] = __uint_as_float(a.w & 0xffff0000u);
        g[0] = __uint_as_float(c.x << 16); g[1] = __uint_as_float(c.x & 0xffff0000u); g[2] = __uint_as_float(c.y << 16); g[3] = __uint_as_float(c.y & 0xffff0000u); g[4] = __uint_as_float(c.z << 16); g[5] = __uint_as_float(c.z & 0xffff0000u); g[6] = __uint_as_float(c.w << 16); g[7] = __uint_as_float(c.w & 0xffff0000u);
#pragma unroll
        for (int j = 0; j < 8; ++j) { sq += f[j] * f[j]; sk += g[j] * g[j]; dq += f[j] * g[j]; } }
    sq += __shfl_xor(sq, 1); sk += __shfl_xor(sk, 1); dq += __shfl_xor(dq, 1);
    dq = -wave_max(-dq);
    sq = wave_max(sq) * 1.0001f; sk = wave_max(sk) * 1.0001f;
    if (F.lane == 0) { ((float*)(F.ws + WS_SM + SM_FQN))[it] = sq; ((float*)(F.ws + WS_SM + SM_FKN))[it] = sk; ((float*)(F.ws + WS_SM + SM_FXM))[it] = dq; }
}

typedef float f32x16 __attribute__((ext_vector_type(16)));
typedef unsigned u32x2 __attribute__((ext_vector_type(2)));
__device__ __forceinline__ float silu_f(float x) { return x * __builtin_amdgcn_rcpf(1.f + __builtin_amdgcn_exp2f(-1.4426950408889634f * x)); }
__device__ __forceinline__ void conv8(const bf16* slab, size_t m, int tt, int col, const float (&cw)[4][8], float (&o)[8]) {
    v4u q[4];
#pragma unroll
    for (int j = 0; j < 4; ++j) { const size_t mr = (tt - 3 + j >= 0) ? m - 3 + j : m; q[j] = *(const GAS v4u*)(slab + mr * 512 + col); }
#pragma unroll
    for (int i = 0; i < 8; ++i) o[i] = 0.f;
#pragma unroll
    for (int j = 0; j < 4; ++j) { float f[8]; unpack8(q[j], f); const float vld = (tt - 3 + j >= 0) ? 1.f : 0.f;
#pragma unroll
        for (int i = 0; i < 8; ++i) o[i] += (cw[j][i] * vld) * f[i]; }
#pragma unroll
    for (int i = 0; i < 8; ++i) o[i] = silu_f(o[i]);
}
constexpr int KT_P = 72, QS_P = 136;
__device__ __forceinline__ bf16x8 pack_acc8(const f32x16& x, int s) {
    v4u w; w.x = pk2(x[8 * s + 0], x[8 * s + 1]); w.y = pk2(x[8 * s + 2], x[8 * s + 3]); w.z = pk2(x[8 * s + 4], x[8 * s + 5]); w.w = pk2(x[8 * s + 6], x[8 * s + 7]);
    return __builtin_bit_cast(bf16x8, w);
}
__device__ __forceinline__ void conv8r(const v4u (&q)[4], int tt, const LAS float* cw, int col, float (&o)[8]) {
#pragma unroll
    for (int i = 0; i < 8; ++i) o[i] = 0.f;
#pragma unroll
    for (int j = 0; j < 4; ++j) { float f[8]; unpack8(q[j], f); const float vld = (tt - 3 + j >= 0) ? 1.f : 0.f;
        const f32x4 w0 = *(const LAS f32x4*)(cw + j * 512 + col) * vld, w1 = *(const LAS f32x4*)(cw + j * 512 + col + 4) * vld;
#pragma unroll
        for (int i = 0; i < 4; ++i) { o[i] += w0[i] * f[i]; o[4 + i] += w1[i] * f[4 + i]; } }
#pragma unroll
    for (int i = 0; i < 8; ++i) o[i] = silu_f(o[i]);
}
struct RawL { v4u k[2][4]; v4u v[2]; float fp, ip; };
__device__ __forceinline__ void mlstm_L_load(Frame& F, int u, RawL& R) {
    const int bh = u >> 7, c = u & (NCH - 1), b = bh >> 2, h = bh & 3;
    const bf16* KS = (const bf16*)(F.ws + WS_NG + SL_MK * SLAB_BYTES); const bf16* VS = (const bf16*)(F.ws + WS_NG + SL_MV * SLAB_BYTES);
    const int s = F.lane, tt = c * CHUNK + s; const size_t m = (size_t)b * SEQ + tt;
#pragma unroll
    for (int half = 0; half < 2; ++half) { const int col = h * ML_DH + (F.wave + 8 * half) * 8;
#pragma unroll
        for (int j = 0; j < 4; ++j) { const size_t mr = (tt - 3 + j >= 0) ? m - 3 + j : m; R.k[half][j] = *(const GAS v4u*)(KS + mr * 512 + col); }
        R.v[half] = *(const GAS v4u*)(VS + m * 512 + col); }
    const float* gate16 = (const float*)(F.ws + WS_SM + SM_GATE16) + m * 16;
    R.fp = gate16[4 + h]; R.ip = gate16[h];
}
__device__ __forceinline__ void mlstm_L_phase(Frame& F, int l) {
    LAS bf16* Kt = (LAS bf16*)(F.lds); LAS bf16* Vt = Kt + 128 * KT_P; LAS float* wk = (LAS float*)(F.lds + 2 * 128 * KT_P * 2); LAS float* cwk = (LAS float*)(F.lds + 40960);
    for (int i = F.tid; i < 4 * 512; i += NWAVES * 64) cwk[i] = INP(F, IN_CONVW)[(size_t)l * 4 * 1024 + (i >> 9) * 1024 + 512 + (i & 511)];
    const int NU = BATCH * ML_H * NCH;
    float b_f[ML_H], b_i[ML_H];
#pragma unroll
    for (int i = 0; i < ML_H; ++i) { b_f[i] = INP(F, IN_MLBF)[l * ML_H + i]; b_i[i] = INP(F, IN_MLBI)[l * ML_H + i]; }
    int u = F.vcu; if (u >= NU) { __syncthreads(); return; }
    RawL cur; mlstm_L_load(F, u, cur);
    __syncthreads();
    for (; u < NU; u += F.G) {
        const int bh = u >> 7, h = bh & 3;
        if (F.tid < CHUNK) {
            const float lf = logsigmoid_f(cur.fp + b_f[h]), li = cur.ip + b_i[h];
            const float bc = wave_scan_add(lf, F.lane), a = li - bc, amax = wave_max(a);
            wk[F.tid] = __expf(a - amax);
            const int c = u & (NCH - 1);
            ((float*)(F.ws + WS_SM + SM_MLB))[(size_t)bh * SEQ + c * CHUNK + F.tid] = bc; ((float*)(F.ws + WS_SM + SM_MLA))[(size_t)bh * SEQ + c * CHUNK + F.tid] = a;
            if (F.tid == 63) { float* bg = (float*)(F.ws + WS_SM + SM_MLBG) + 2 * u; bg[0] = bc; bg[1] = bc + amax; }
        }
        __syncthreads();
        {   const int s = F.lane, tt = (u & (NCH - 1)) * CHUNK + s;
#pragma unroll
            for (int half = 0; half < 2; ++half) { const int cg = F.wave + 8 * half, col = h * ML_DH + cg * 8;
                float kk[8]; conv8r(cur.k[half], tt, cwk, col, kk);
                float vv[8]; unpack8(cur.v[half], vv); const float ws = wk[s];
#pragma unroll
                for (int i = 0; i < 8; ++i) { Kt[(cg * 8 + i) * KT_P + s] = (bf16)f2bf(kk[i] * 0.08838834764831845f); Vt[(cg * 8 + i) * KT_P + s] = (bf16)f2bf(vv[i] * ws); } }
        }
        __syncthreads();
        if (u + F.G < NU) mlstm_L_load(F, u + F.G, cur);
        {   const int r = F.lane & 31, hi = F.lane >> 5, kb = F.wave >> 1;
            f32x16 acc[2]; acc[0] = f32x16{}; acc[1] = f32x16{};
#pragma unroll
            for (int sp = 0; sp < 4; ++sp) { const bf16x8 a = *(const LAS bf16x8*)(Kt + (kb * 32 + r) * KT_P + 16 * sp + 8 * hi);
#pragma unroll
                for (int j = 0; j < 2; ++j) { const int vb = 2 * (F.wave & 1) + j; const bf16x8 bb = *(const LAS bf16x8*)(Vt + (vb * 32 + r) * KT_P + 16 * sp + 8 * hi);
                    acc[j] = __builtin_amdgcn_mfma_f32_32x32x16_bf16(a, bb, acc[j], 0, 0, 0); } }
            GAS bf16x8* img = (GAS bf16x8*)(F.ws + WS_MLC + (size_t)u * 32768);
#pragma unroll
            for (int j = 0; j < 2; ++j) { const int vb = 2 * (F.wave & 1) + j;
#pragma unroll
                for (int s = 0; s < 2; ++s) img[((vb * 4 + kb) * 2 + s) * 64 + F.lane] = pack_acc8(acc[j], s); }
        }
        if (F.tid < ML_DH) { float a = 0.f;
#pragma unroll 8
            for (int s = 0; s < CHUNK; ++s) a += wk[s] * __uint_as_float((unsigned)Kt[F.tid * KT_P + s] << 16);
            ((float*)(F.ws + WS_SM + SM_MLN))[(size_t)u * ML_DH + F.tid] = a; }
        __syncthreads();
    }
}
__device__ __forceinline__ void mlstm_S(Frame& F) {
    LAS float* dec = (LAS float*)(F.lds); LAS float* cor = dec + NCH;
    for (int unit = F.vcu; unit < 16 * 16; unit += F.G) {
        const int bh = unit >> 4, part = unit & 15;
        if (F.tid == 0) { const float* bg = (const float*)(F.ws + WS_SM + SM_MLBG) + 2 * bh * NCH; float* mlm = (float*)(F.ws + WS_SM + SM_MLM) + bh * 132; float mm = 0.f;
            for (int c = 0; c < NCH; ++c) { const float B = bg[2 * c], G = bg[2 * c + 1], mn = fmaxf(B + mm, G); dec[c] = __expf(B + mm - mn); cor[c] = __expf(G - mn); mlm[c] = mm; mm = mn; }
            mlm[NCH] = mm; }
        __syncthreads();
        {   const int e2 = part * 512 + F.tid; GAS unsigned* p = (GAS unsigned*)(F.ws + WS_MLC + (size_t)bh * NCH * 32768) + e2;
            float r0 = 0.f, r1 = 0.f;
            for (int c0 = 0; c0 < NCH; c0 += 16) { unsigned q[16];
#pragma unroll
                for (int i = 0; i < 16; ++i) q[i] = p[(size_t)(c0 + i) * 8192];
#pragma unroll
                for (int i = 0; i < 16; ++i) { const float d = dec[c0 + i], k = cor[c0 + i]; p[(size_t)(c0 + i) * 8192] = pk2(r0, r1);
                    r0 = d * r0 + k * __uint_as_float(q[i] << 16); r1 = d * r1 + k * __uint_as_float(q[i] & 0xffff0000u); } } }
        if (part == 0 && F.tid < ML_DH) { float* p = (float*)(F.ws + WS_SM + SM_MLN) + (size_t)bh * NCH * ML_DH + F.tid;
            float r = 0.f;
            for (int c0 = 0; c0 < NCH; c0 += 16) { float q[16];
#pragma unroll
                for (int i = 0; i < 16; ++i) q[i] = p[(size_t)(c0 + i) * ML_DH];
#pragma unroll
                for (int i = 0; i < 16; ++i) { p[(size_t)(c0 + i) * ML_DH] = r; r = dec[c0 + i] * r + cor[c0 + i] * q[i]; } } }
        __syncthreads();
    }
}
#define O_BAR() do { asm volatile("s_waitcnt lgkmcnt(0)" ::: "memory"); __builtin_amdgcn_s_barrier(); asm volatile("" ::: "memory"); } while (0)
constexpr int O_RAWQ = 73728, O_RAWK = O_RAWQ + 68 * 256, O_RAWV = O_RAWK + 68 * 256, O_END = O_RAWV + 64 * 256;
static_assert(O_END + 3 * 2 * 1024 <= RING_BYTES, "mLSTM O-phase LDS map");
__device__ __forceinline__ void mlstm_O_dma(Frame& F, int u) {
    const int bh = u >> 7, c = u & (NCH - 1), b = bh >> 2, h = bh & 3;
    const size_t seq0 = (size_t)b * SEQ; const int t0 = c * CHUNK;
    for (int i = F.wave; i < 50; i += NWAVES) {
        const int ten = i < 17 ? 0 : (i < 34 ? 1 : 2), ii = i - 17 * ten, row = 4 * ii + (F.lane >> 4);
        int t = (ten == 2) ? t0 + row : t0 - 3 + row; t = t < 0 ? 0 : (t > t0 + CHUNK - 1 ? t0 + CHUNK - 1 : t);
        const bf16* src = (const bf16*)(F.ws + WS_NG + (size_t)(ten == 0 ? SL_MQ : (ten == 1 ? SL_MK : SL_MV)) * SLAB_BYTES) + (seq0 + t) * 512 + h * ML_DH + (((F.lane & 15) ^ (row & 15)) * 8);
        const int dst = (ten == 0 ? O_RAWQ : (ten == 1 ? O_RAWK : O_RAWV)) + ii * 1024;
        __builtin_amdgcn_global_load_lds((const GAS unsigned*)src, (LAS unsigned*)(F.lds + dst), 16, 0, 0);
    }
}
__device__ __forceinline__ void conv8l(const LAS bf16* raw, int s, int tt, const LAS float* cw, int cg, int col, float (&o)[8]) {
#pragma unroll
    for (int i = 0; i < 8; ++i) o[i] = 0.f;
#pragma unroll
    for (int j = 0; j < 4; ++j) { float f[8]; unpack8(*(const LAS v4u*)(raw + (s + j) * 128 + ((cg ^ ((s + j) & 15)) * 8)), f); const float vld = (tt - 3 + j >= 0) ? 1.f : 0.f;
        const f32x4 w0 = *(const LAS f32x4*)(cw + j * 512 + col) * vld, w1 = *(const LAS f32x4*)(cw + j * 512 + col + 4) * vld;
#pragma unroll
        for (int i = 0; i < 4; ++i) { o[i] += w0[i] * f[i]; o[4 + i] += w1[i] * f[4 + i]; } }
#pragma unroll
    for (int i = 0; i < 8; ++i) o[i] = silu_f(o[i]);
}
__device__ __forceinline__ void mlstm_O_phase(Frame& F, int l) {
    LAS bf16* Qs = (LAS bf16*)(F.lds); LAS bf16* Ks = Qs + 64 * QS_P; LAS bf16* Vt = Ks + 64 * QS_P;
    LAS float* fa = (LAS float*)(F.lds + (2 * 64 * QS_P + 128 * KT_P) * 2); LAS float* fmx = fa + 64; LAS float* fb = fa + 128; LAS float* nvec = fa + 192; LAS float* ssq = fa + 320;
    LAS float* cwq = (LAS float*)(F.lds + 57344); LAS float* cwk = cwq + 4 * 512;
    LAS float* psm = (LAS float*)(F.lds + 55552); LAS float* nqp = psm + 96; LAS bf16x8* pimg = (LAS bf16x8*)(F.lds + O_END);
    const LAS bf16* rawq = (const LAS bf16*)(F.lds + O_RAWQ); const LAS bf16* rawk = (const LAS bf16*)(F.lds + O_RAWK); const LAS bf16* rawv = (const LAS bf16*)(F.lds + O_RAWV);
    for (int i = F.tid; i < 4 * 512; i += NWAVES * 64) { cwq[i] = INP(F, IN_CONVW)[(size_t)l * 4 * 1024 + (i >> 9) * 1024 + (i & 511)]; cwk[i] = INP(F, IN_CONVW)[(size_t)l * 4 * 1024 + (i >> 9) * 1024 + 512 + (i & 511)]; }
    const int NU = BATCH * ML_H * NCH;
    int u = F.vcu; if (u >= NU) { __syncthreads(); return; }
    mlstm_O_dma(F, u);
    const bf16* OS = (const bf16*)(F.ws + WS_NG + SL_MO * SLAB_BYTES);
    const int r = F.lane & 31, hi = F.lane >> 5, tb = F.wave & 1, vb = F.wave >> 1;
    for (; u < NU; u += F.G) {
    const int bh = u >> 7, c = u & (NCH - 1), b = bh >> 2, h = bh & 3;
    asm volatile("s_waitcnt vmcnt(0)" ::: "memory"); O_BAR();
    const float m_c = ((const float*)(F.ws + WS_SM + SM_MLM))[bh * 132 + c];
    bf16x8 cf[4][2];
    {   const GAS bf16x8* img = (const GAS bf16x8*)(F.ws + WS_MLC + (size_t)u * 32768);
#pragma unroll
        for (int kb = 0; kb < 4; ++kb)
#pragma unroll
            for (int s = 0; s < 2; ++s) cf[kb][s] = img[((vb * 4 + kb) * 2 + s) * 64 + F.lane]; }
    u32x2 oww[4];
    {   const size_t m = (size_t)b * SEQ + c * CHUNK + tb * 32 + r;
#pragma unroll
        for (int q = 0; q < 4; ++q) oww[q] = *(const GAS u32x2*)(OS + m * 512 + h * ML_DH + vb * 32 + 8 * q + 4 * hi); }
    float g0 = 0.f, g1 = 0.f, g2 = 0.f;
    {   const float* mlb = (const float*)(F.ws + WS_SM + SM_MLB) + (size_t)bh * SEQ; const float* mla = (const float*)(F.ws + WS_SM + SM_MLA) + (size_t)bh * SEQ; const float* mlmx = (const float*)(F.ws + WS_SM + SM_MLMX) + (size_t)bh * SEQ;
        if (F.tid < CHUNK) { g0 = mla[c * CHUNK + F.tid]; g2 = mlb[c * CHUNK + F.tid]; g1 = fmaxf(m_c, wave_scan_max(g0, F.lane)); }
        else if (F.tid < CHUNK + ML_DH) g0 = ((const float*)(F.ws + WS_SM + SM_MLN))[(size_t)u * ML_DH + F.tid - CHUNK]; }
    {   const int s = F.lane, tt = c * CHUNK + s;
#pragma unroll
        for (int half = 0; half < 2; ++half) { const int cg = F.wave + 8 * half, col = h * ML_DH + cg * 8;
            float qq[8], kk[8], vv[8]; conv8l(rawq, s, tt, cwq, cg, col, qq); conv8l(rawk, s, tt, cwk, cg, col, kk); unpack8(*(const LAS v4u*)(rawv + s * 128 + ((cg ^ (s & 15)) * 8)), vv);
            v4u wq, wkk; wq.x = pk2(qq[0], qq[1]); wq.y = pk2(qq[2], qq[3]); wq.z = pk2(qq[4], qq[5]); wq.w = pk2(qq[6], qq[7]);
            const float sc = 0.08838834764831845f;
            wkk.x = pk2(kk[0] * sc, kk[1] * sc); wkk.y = pk2(kk[2] * sc, kk[3] * sc); wkk.z = pk2(kk[4] * sc, kk[5] * sc); wkk.w = pk2(kk[6] * sc, kk[7] * sc);
            *(LAS v4u*)(Qs + s * QS_P + cg * 8) = wq; *(LAS v4u*)(Ks + s * QS_P + cg * 8) = wkk;
#pragma unroll
            for (int i = 0; i < 8; ++i) Vt[(cg * 8 + i) * KT_P + s] = (bf16)f2bf(vv[i]); }
    }
    if (F.tid < CHUNK) { fa[F.tid] = g0; fmx[F.tid] = g1; fb[F.tid] = g2; }
    else if (F.tid < CHUNK + ML_DH) nvec[F.tid - CHUNK] = g0;
    O_BAR();
    if (u + F.G < NU) mlstm_O_dma(F, u + F.G);
    const int t = tb * 32 + r;
    const float Mx_t = fmx[t], m_t = fb[t] + Mx_t, w_int = __expf(m_c - Mx_t);
    if (F.wave < 3) {
        const int tbs = F.wave ? 1 : 0, sbs = F.wave == 2 ? 1 : 0, ts = tbs * 32 + r; const float Mxs = fmx[ts];
        f32x16 x = f32x16{};
#pragma unroll
        for (int ks = 0; ks < 8; ++ks) { const bf16x8 a = *(const LAS bf16x8*)(Ks + (sbs * 32 + r) * QS_P + 16 * ks + 8 * hi); const bf16x8 q = *(const LAS bf16x8*)(Qs + ts * QS_P + 16 * ks + 8 * hi);
            x = __builtin_amdgcn_mfma_f32_32x32x16_bf16(a, q, x, 0, 0, 0); }
        float ps = 0.f;
#pragma unroll
        for (int rr = 0; rr < 16; ++rr) { const int s = sbs * 32 + (rr & 3) + 8 * (rr >> 2) + 4 * hi; const float pv = (s <= ts) ? __expf(fa[s] - Mxs) * x[rr] : 0.f; x[rr] = pv; ps += pv; }
        ps += __shfl_xor(ps, 32);
        pimg[(F.wave * 2 + 0) * 64 + F.lane] = pack_acc8(x, 0); pimg[(F.wave * 2 + 1) * 64 + F.lane] = pack_acc8(x, 1);
        if (hi == 0) psm[F.wave * 32 + r] = ps;
    }
    {   float nq = 0.f;
#pragma unroll
        for (int i = 0; i < 2; ++i) { float f[8]; unpack8(*(const LAS v4u*)(Qs + t * QS_P + 32 * vb + 16 * hi + 8 * i), f);
#pragma unroll
            for (int j = 0; j < 8; ++j) nq += f[j] * nvec[32 * vb + 16 * hi + 8 * i + j]; }
        nq += __shfl_xor(nq, 32);
        if (hi == 0) nqp[vb * 64 + t] = nq; }
    f32x16 acc = f32x16{};
#pragma unroll
    for (int kb = 0; kb < 4; ++kb)
#pragma unroll
        for (int s = 0; s < 2; ++s) { const u32x2 lo = *(const LAS u32x2*)(Qs + t * QS_P + kb * 32 + 16 * s + 4 * hi), hi2 = *(const LAS u32x2*)(Qs + t * QS_P + kb * 32 + 16 * s + 8 + 4 * hi);
            v4u w; w.x = lo.x; w.y = lo.y; w.z = hi2.x; w.w = hi2.y;
            acc = __builtin_amdgcn_mfma_f32_32x32x16_bf16(cf[kb][s], __builtin_bit_cast(bf16x8, w), acc, 0, 0, 0); }
#pragma unroll
    for (int rr = 0; rr < 16; ++rr) acc[rr] *= w_int;
    O_BAR();
    float psum = 0.f;
#pragma unroll
    for (int sb = 0; sb < 2; ++sb) {
        if (sb <= tb) { const int blk = tb == 0 ? 0 : 1 + sb; psum += psm[blk * 32 + r];
#pragma unroll
            for (int s = 0; s < 2; ++s) { const u32x2 lo = *(const LAS u32x2*)(Vt + (vb * 32 + r) * KT_P + sb * 32 + 16 * s + 4 * hi), hi2 = *(const LAS u32x2*)(Vt + (vb * 32 + r) * KT_P + sb * 32 + 16 * s + 8 + 4 * hi);
                v4u w; w.x = lo.x; w.y = lo.y; w.z = hi2.x; w.w = hi2.y;
                acc = __builtin_amdgcn_mfma_f32_32x32x16_bf16(__builtin_bit_cast(bf16x8, w), pimg[(blk * 2 + s) * 64 + F.lane], acc, 0, 0, 0); }
        }
    }
    const float nq = (nqp[t] + nqp[64 + t]) + (nqp[128 + t] + nqp[192 + t]);
    const float den = w_int * nq + psum, inv = 1.f / fmaxf(fabsf(den), __expf(-m_t));
    float sq = 0.f;
#pragma unroll
    for (int rr = 0; rr < 16; ++rr) { acc[rr] *= inv; sq += acc[rr] * acc[rr]; }
    sq += __shfl_xor(sq, 32);
    if (hi == 0) ssq[vb * 64 + t] = sq;
    O_BAR();
    const float rstd = 1.f / sqrtf((ssq[t] + ssq[64 + t] + ssq[128 + t] + ssq[192 + t]) * (1.f / ML_DH) + NORM_EPS);
    {   const size_t m = (size_t)b * SEQ + c * CHUNK + t; bf16* CAT = (bf16*)(F.ws + WS_CAT);
#pragma unroll
        for (int q = 0; q < 4; ++q) { const int v0 = vb * 32 + 8 * q + 4 * hi, col = h * ML_DH + v0;
            const u32x2 ow = oww[q]; const f32x4 gn = *(const GAS f32x4*)(INP(F, IN_MLNG) + (size_t)l * 512 + col);
            const float o0 = sigmoid_f(__uint_as_float(ow.x << 16)), o1 = sigmoid_f(__uint_as_float(ow.x & 0xffff0000u)), o2 = sigmoid_f(__uint_as_float(ow.y << 16)), o3 = sigmoid_f(__uint_as_float(ow.y & 0xffff0000u));
            u32x2 w; w.x = pk2(acc[4 * q] * rstd * gn.x * o0, acc[4 * q + 1] * rstd * gn.y * o1); w.y = pk2(acc[4 * q + 2] * rstd * gn.z * o2, acc[4 * q + 3] * rstd * gn.w * o3);
            *(GAS u32x2*)(CAT + m * KCAT + 512 + col) = w; }
    }
    }
    asm volatile("s_waitcnt vmcnt(0)" ::: "memory"); O_BAR();
}
#undef O_BAR

#ifndef SUBP
#define SUBP 0
#endif
#ifndef MK_MULTI
#define MK_MULTI 0
#endif
constexpr int NPH = 1 + (8 + 2) + (1 + 8 + 4) + 2;
#ifndef PH_MASK
#define PH_MASK 0xffffffffu
#endif
#ifndef PROBE_MASK
#define PROBE_MASK 0u
#endif
#define PH_BEGIN(id) if (ph >= lo && ph < hi) { if constexpr (((PH_MASK) >> (id)) & 1u) { for (int rep_ = 0; rep_ < 1 + (int)(((PROBE_MASK) >> (id)) & 1u); ++rep_) { Frame F = FK; { size_t z_ = 0; int zi_ = 0; asm volatile("" : "+v"(F.tid), "+s"(z_), "+s"(zi_)); \
        F.lane = F.tid & 63; F.ws = FK.ws + z_; F.out = (float*)((char*)FK.out + z_); F.zi = zi_; } const int gw = F.vcu * NWAVES + F.wave, NGWV = F.G * NWAVES; (void)gw; (void)NGWV;
#define PH_END __syncthreads(); } } if (ph + 1 < hi) { XcdBarrier b2_ = bar; size_t zb_ = 0; asm volatile("" : "+s"(zb_)); b2_.bar = bar.bar + zb_; xcd_barrier(b2_); } } ++ph;
#define HB ((bf16*)(F.ws + WS_HB))
#define CAT ((bf16*)(F.ws + WS_CAT))
#define SLAB ((bf16*)(F.ws + WS_NG))
#define GATE ((bf16*)(F.ws + WS_GATE))
#define WL ((bf16*)(F.ws + WS_W + (size_t)l * W_LAYER))
#define XBP ((bf16*)((char*)F.out + (size_t)M * D * 2))

template <int l> __device__ __forceinline__ void layer_phases(Frame& FK, int& ph, const int lo, const int hi, const XcdBarrier& bar, unsigned char* lds) {
        if constexpr (l > 0) { PH_BEGIN(1) phase_norm_mix<true>(F, XBP, l); PH_END }
        PH_BEGIN(2)
            pg8::Gemm g{HB, WL + W_NG / 2, M, NGW, D}; pg8::StaticOrder S; S.init(M, NGW, F.G, F.blk);
            pg8::EpiSlab E{SLAB, (size_t)M * 512, SL_FQ, attn_body::C2};
            pg8::gemm_phase<pg8::EpiSlab, pg8::StaticOrder, true, true>(F.lds + RING_OFF, g, S, E);
        PH_END
        PH_BEGIN(3)
            for (int s = F.blk; s < BATCH * FX_H; s += F.G) prep_fox(F, l, s);
            for (int rp = 0; rp < (SUBP == 1 ? 2 : 1); ++rp) for (int it = gw; it < M / 32; it += NGWV) pool_item(F, it);
            for (int rp = 0; rp < (SUBP == 2 ? 2 : 1); ++rp) for (int it = gw; it < BATCH * FX_H * 32 * 8; it += NGWV) fox_norm_item(F, it);
            for (int rp = 0; rp < (SUBP == 3 ? 2 : 1); ++rp) mlstm_L_phase(F, l);
        PH_END
        PH_BEGIN(4)
            mlstm_S(F);
            for (int ui = gw; ui < BATCH * FX_H * 32; ui += NGWV) { const int bh = ui >> 5, qb = ui & 31;
                const int t0 = attn_body::attn_t0(qb, (const float*)(F.ws + WS_SM + SM_FNB) + (size_t)bh * SEQ, (const float*)(F.ws + WS_SM + SM_FQN) + bh * 256, (const float*)(F.ws + WS_SM + SM_FKN) + bh * 256, (const float*)(F.ws + WS_SM + SM_FXM) + bh * 256, F.lane);
                if (F.lane == 0) ((int*)(F.ws + WS_SM + SM_FT0))[ui] = t0; }
        PH_END
        PH_BEGIN(18)
            for (int rp = 0; rp < (SUBP == 4 ? 2 : 1); ++rp) mlstm_O_phase(F, l);
            const attn_body::AttnTensors AT{(const attn_body::bf16*)(SLAB + (size_t)SL_FQ * M * 512), (const attn_body::bf16*)(SLAB + (size_t)SL_FK * M * 512), (const attn_body::bf16*)(SLAB + (size_t)SL_FV * M * 512),
                                            (attn_body::bf16*)CAT, (const float*)(F.ws + WS_SM + SM_FNB), (const float*)(F.ws + WS_SM + SM_FQN), (const float*)(F.ws + WS_SM + SM_FKN), (const int*)(F.ws + WS_SM + SM_FT0)};
            attn_body::attn_phase_dyn<8>((char*)lds + RING_OFF, AT, (unsigned*)(F.ctl + 2048 + 64 * l), F.MISC + 0);
            quant_rows_fp8(F, HB, F.ws + WS_NG + (size_t)SL_POOL * SLAB_BYTES);
        PH_END
        PH_BEGIN(6)
            pg8::Gemm g{(const bf16*)(F.ws + WS_NG + (size_t)SL_POOL * SLAB_BYTES), WL + W_GT / 2, M, NGT, D / 2}; pg8::StaticOrder S; S.init(M, NGT, F.G, F.blk);
            pg8::EpiSig E{(unsigned char*)GATE, 1.f / (FP8_ASCALE * FP8_WSCALE)};
            pg8::gemm_phase<pg8::EpiSig, pg8::StaticOrder, true, true, true>(F.lds + RING_OFF, g, S, E);
        PH_END
        PH_BEGIN(7)
            pg8::Gemm g{CAT, WL + W_CAT / 2, M, D, KCAT}; pg8::StaticOrder S; S.init(M, D, F.G, F.blk);
            pg8::EpiMerge E{(const unsigned char*)GATE, HB};
            pg8::gemm_phase<pg8::EpiMerge, pg8::StaticOrder, true, true>(F.lds + RING_OFF, g, S, E);
        PH_END
        PH_BEGIN(8)
            pg8::Gemm g{HB, WL + W_OUT / 2, M, D, D}; pg8::StaticOrder S; S.init(M, D, F.G, F.blk);
            if constexpr (l == 0) { pg8::EpiResB<true> E{INP(F, IN_X), XBP}; pg8::gemm_phase<pg8::EpiResB<true>, pg8::StaticOrder, true, true>(F.lds + RING_OFF, g, S, E); }
            else { pg8::EpiResB<false> E{XBP, XBP}; pg8::gemm_phase<pg8::EpiResB<false>, pg8::StaticOrder, true, true>(F.lds + RING_OFF, g, S, E); }
        PH_END
        if constexpr (l == 0) {
            PH_BEGIN(9) phase_norm_ffn(F, XBP); PH_END
            PH_BEGIN(10)
                pg8::Gemm g{HB, (const bf16*)(F.ws + WS_WGU), M, 2 * DFF, D}; pg8::StaticOrder S; S.init(M, 2 * DFF, F.G, F.blk);
                pg8::EpiSwiGLU E{(bf16*)(F.ws + WS_ACT0), DFF};
                pg8::gemm_phase<pg8::EpiSwiGLU, pg8::StaticOrder, true, true>(F.lds + RING_OFF, g, S, E);
            PH_END
            PH_BEGIN(11)
                pg8::Gemm g{(const bf16*)(F.ws + WS_ACT0), (const bf16*)(F.ws + WS_WDN), M, D, DFF}; pg8::StaticOrder S; S.init(M, D, F.G, F.blk);
                pg8::EpiResB<false> E{XBP, XBP};
                pg8::gemm_phase<pg8::EpiResB<false>, pg8::StaticOrder, true, true>(F.lds + RING_OFF, g, S, E);
            PH_END
        } else {
            PH_BEGIN(12)
                phase_route1(F, XBP);
                __syncthreads();
                LAS float* scr = (LAS float*)(F.lds + F.wave * 16384);
                for (int it = gw; it < CI_MOE; it += NGWV) conv_item_moe(F, it, scr);
            PH_END
            PH_BEGIN(13) phase_route2(F, XBP); PH_END
#define MOE_UP(k_, S_) do { pg8::Gemm g{(const bf16*)(F.ws + WS_XS + (size_t)(k_) * MOE_KROWS * D), (const bf16*)(F.ws + WS_MOEGU), MOE_KROWS, 2 * DFE, D / 2}; \
                    pg8::EpiSwiGLU8 E{F.ws + WS_ACT1 + (size_t)(k_) * MOE_KROWS * DFE, DFE, 1.f / (FP8_ASCALE * FP8_WSCALE), FP8_ASCALE}; \
                    pg8::gemm_phase<pg8::EpiSwiGLU8, decltype(S_), true, true, true>(F.lds + RING_OFF, g, S_, E); } while (0)
#define MOE_DOWN(k_) do { pg8::Gemm g{(const bf16*)(F.ws + WS_ACT1 + (size_t)(k_) * MOE_KROWS * DFE), (const bf16*)(F.ws + WS_MOEDN), MOE_KROWS, D, DFE / 2}; pg8::MoeOrder S; S.init(nM[k_], D / 256, F.G, F.blk, tile_e + (k_) * MOE_KTILES); \
                    pg8::EpiMoeDown E{(bf16*)(F.ws + ((k_) == 0 ? WS_Y0 : WS_Y1)), (const int*)(sm + MO_ROWTOK) + (k_) * MOE_KROWS, (const float*)(sm + MO_ROWG) + (k_) * MOE_KROWS, 1.f / (FP8_ASCALE * FP8_WSCALE)}; \
                    pg8::gemm_phase<pg8::EpiMoeDown, pg8::MoeOrder, true, true, true>(F.lds + RING_OFF, g, S, E); } while (0)
#define MOE_TABLES unsigned char* sm = F.ws + WS_SM + SM_MOE; LAS int* tile_e = (LAS int*)(F.lds + LDSCTL_OFF + 1024); \
                    for (int i_ = F.tid; i_ < 2 * MOE_KTILES; i_ += NWAVES * 64) tile_e[i_] = __hip_atomic_load((const int*)(sm + MO_TILEE) + i_, RLX_AGENT); __syncthreads(); \
                    const int nM[2] = {__builtin_amdgcn_readfirstlane(__hip_atomic_load((const int*)(sm + MO_NT), RLX_AGENT)), __builtin_amdgcn_readfirstlane(__hip_atomic_load((const int*)(sm + MO_NT) + 1, RLX_AGENT))};
            PH_BEGIN(14)
                MOE_TABLES
                pg8::MoeOrder S; S.init(nM[0], 2 * DFE / 256, F.G, F.blk, tile_e);
                MOE_UP(0, S);
            PH_END
            PH_BEGIN(15)
                MOE_TABLES
                MOE_DOWN(0);
                const int Nd = nM[0] * (D / 256), Nu = nM[1] * (2 * DFE / 256), qd = Nd / F.G, rd = Nd % F.G;
                const float T = (3.5f * (float)Nd + (float)Nu) / (float)F.G;
                float cum = 0.f; int lo_u = 0, hi_u = 0;
                for (int v = 0; v <= F.vcu; ++v) { const int w = (F.G % 8 == 0) ? (v % (F.G / 8)) * 8 + v / (F.G / 8) : v; const float cap = fmaxf(T - 3.5f * (float)(qd + (w < rd ? 1 : 0)), 0.f);
                    lo_u = (int)(cum + 0.5f); cum += cap; hi_u = (int)(cum + 0.5f); }
                if (F.vcu == F.G - 1 || hi_u > Nu) hi_u = Nu; if (lo_u > Nu) lo_u = Nu;
                lo_u = __builtin_amdgcn_readfirstlane(lo_u); hi_u = __builtin_amdgcn_readfirstlane(hi_u);
                pg8::MoeRange R; R.init(nM[1], 2 * DFE / 256, lo_u, hi_u, tile_e + MOE_KTILES);
                MOE_UP(1, R);
            PH_END
            PH_BEGIN(19)
                MOE_TABLES
                MOE_DOWN(1);
            PH_END
#undef MOE_UP
#undef MOE_DOWN
#undef MOE_TABLES
        }
    }
struct Args { const float* in[24]; float* out; unsigned char* ws; int ph_lo, ph_hi; };
__global__ void __launch_bounds__(NWAVES * 64, 2) fwd(Args args) {
    extern __shared__ __attribute__((aligned(16))) unsigned char lds[];
    Frame FK;
    FK.lds = (LAS unsigned char*)lds;
    FK.MISC = (volatile LAS unsigned*)(FK.lds + MISC_OFF);
    FK.tid = threadIdx.x; FK.lane = FK.tid & 63; FK.wave = __builtin_amdgcn_readfirstlane(FK.tid >> 6);
    FK.G = gridDim.x; FK.blk = blockIdx.x; { const int bx = blockIdx.x; FK.vcu = (FK.G % 8 == 0) ? (bx % 8) * (FK.G / 8) + bx / 8 : bx; }
    FK.ws = args.ws; FK.ctl = (gu32*)(args.ws + WS_CTL); FK.out = args.out;
    FK.in = args.in; FK.zi = 0;
    for (int u = FK.tid; u < (LDS_BYTES - LDSCTL_OFF) / 4; u += NWAVES * 64) ((LAS unsigned*)(FK.lds + LDSCTL_OFF))[u] = 0u;
    __syncthreads();
    const int lo = args.ph_lo, hi = args.ph_hi;
    XcdBarrier bar; bar.bar = (unsigned*)(FK.ctl + CW_BAR); bar.x = 0; bar.st = nullptr;
    if (hi - lo > 1) bar = xcd_barrier_post((unsigned*)(FK.ctl + CW_BAR), FK.MISC + 8);
    int ph = 0;
    PH_BEGIN(0)
        LAS float* scr = (LAS float*)(F.lds + F.wave * 16384);
        for (int it = gw; it < CI_MAIN; it += NGWV) conv_item_main(F, it, scr);
        pool_fold(F);
        __syncthreads();
        phase_norm_mix<false>(F, INP(F, IN_X), 0);
    PH_END

    layer_phases<0>(FK, ph, lo, hi, bar, lds);
    layer_phases<1>(FK, ph, lo, hi, bar, lds);
    PH_BEGIN(16) phase_norm_final(F, XBP, F.out, (float*)(F.ws + WS_ACT1)); PH_END
    PH_BEGIN(20) phase_copy_upper(F, (const float*)(F.ws + WS_ACT1), F.out); PH_END
#undef PH_BEGIN
#undef HB
#undef CAT
#undef SLAB
#undef GATE
#undef WL
#undef XBP
#undef PH_END
}

extern "C" void kernel_launch(void* const* d_in, const int* in_sizes, int n_in, void* d_out, int out_size, void* d_ws, size_t ws_size, hipStream_t stream) {
    static int grid = 0;
    if (grid == 0) {
        if (n_in != 24 || in_sizes[0] != M * D || out_size != M * D || ws_size < WS_END) { fprintf(stderr, "kernel_launch: built for 24 inputs, x/out of %d floats, >= %zu bytes of workspace; got n_in %d, in0 %d, out %d, ws %zu; nothing launched\n", M * D, (size_t)WS_END, n_in, n_in > 0 ? in_sizes[0] : -1, out_size, ws_size); grid = -1; return; }
        int dev = 0, cus = 0, per_cu = 0;
        if (hipGetDevice(&dev) != hipSuccess || hipDeviceGetAttribute(&cus, hipDeviceAttributeMultiprocessorCount, dev) != hipSuccess) { fprintf(stderr, "kernel_launch: hipGetDevice / hipDeviceGetAttribute failed\n"); grid = -1; return; }
        if (hipFuncSetAttribute((const void*)fwd, hipFuncAttributeMaxDynamicSharedMemorySize, LDS_BYTES) != hipSuccess) { fprintf(stderr, "kernel_launch: hipFuncSetAttribute failed\n"); grid = -1; return; }
        if (hipOccupancyMaxActiveBlocksPerMultiprocessor(&per_cu, (const void*)fwd, NWAVES * 64, LDS_BYTES) != hipSuccess || per_cu < 1)
            fprintf(stderr, "kernel_launch: note: the occupancy query reports %d workgroups per CU\n", per_cu);
        (void)hipGetLastError();
        grid = cus;
    }
    if (grid < 0) return;
    if (hipMemsetAsync((char*)d_ws + WS_CTL, 0, CTL_ZERO_BYTES, stream) != hipSuccess) { fprintf(stderr, "kernel_launch: hipMemsetAsync failed\n"); return; }
    Args a{};
    for (int i = 0; i < 24; ++i) a.in[i] = (const float*)d_in[i];
    a.out = (float*)d_out; a.ws = (unsigned char*)d_ws;
#if MK_MULTI
    for (int p = 0; p < NPH; ++p) { a.ph_lo = p; a.ph_hi = p + 1; hipLaunchKernelGGL(fwd, dim3(grid), dim3(NWAVES * 64), LDS_BYTES, stream, a); }
#else
    a.ph_lo = 0; a.ph_hi = NPH; hipLaunchKernelGGL(fwd, dim3(grid), dim3(NWAVES * 64), LDS_BYTES, stream, a);
#endif
    const hipError_t le = hipPeekAtLastError();
    if (le != hipSuccess) fprintf(stderr, "kernel_launch: launch failed: %s\n", hipGetErrorName(le));
}
```

```cpp
#include <hip/hip_runtime.h>
#include <cstdio>
#include <cstdint>
namespace pg8 {
#define PG8_LAS __attribute__((address_space(3)))
typedef unsigned short bf16_t;
typedef short bf16x8 __attribute__((ext_vector_type(8)));
typedef float f32x4 __attribute__((ext_vector_type(4)));
typedef unsigned u32x4 __attribute__((ext_vector_type(4)));
constexpr int BM = 256, BK = 64, HALF = 128, HTB = HALF * BK * 2  , STAGE_BYTES = 8 * HTB, NXCD = 8, WGM = 8;

__host__ __device__ __forceinline__ int lds_byte(int r, int c) { const int st = (r >> 4) * 2 + (c >> 5), rr = r & 15, cc = c & 31, ob = rr * 64 + cc * 2; return st * 1024 + (ob ^ (((ob >> 9) & 1) << 5)); }
__host__ __device__ __forceinline__ void stage_rc(int b, int& R, int& C) { const int st = b / 1024, sb = b % 1024, swz = sb ^ (((sb >> 9) & 1) << 5); R = (st >> 1) * 16 + swz / 64; C = (st & 1) * 32 + (swz % 64) / 2; }
__host__ __device__ __forceinline__ int perm32(int rho) { const int n = rho >> 4, i = rho & 15; return 8 * (i >> 2) + 4 * n + (i & 3); }

struct Unit { int pm, pn, pb; };
struct Gemm { const bf16_t* A; const bf16_t* Bt; int M, N, K; };

struct StaticOrder {
    int nM, nN, nwg, G, c;
    __host__ __device__ void init(int M, int N, int G_, int c_) { nM = M / BM; nN = N / BM; nwg = nM * nN; G = G_; c = c_; }
    __host__ __device__ bool next(int i, Unit& u) const {
        const long L = (long)i * G + c; if (L >= nwg) return false;
        int wgid = (int)L; { const int q = nwg / NXCD, r = nwg % NXCD, xcd = wgid % NXCD, off = wgid / NXCD; wgid = (xcd < r ? xcd * (q + 1) : r * (q + 1) + (xcd - r) * q) + off; }
        const int nig = WGM * nN, gid = wgid / nig, fm = gid * WGM, gsz = (nM - fm) < WGM ? (nM - fm) : WGM;
        u.pm = fm + ((wgid % nig) % gsz); u.pn = (wgid % nig) / gsz; u.pb = u.pn; return true;
    }
    __device__ __forceinline__ void a_ready(const Unit&) const {}
    __device__ __forceinline__ void done(const Unit&) const {}
};

__device__ __forceinline__ unsigned cvt_pk_bf16(float lo, float hi) { unsigned r; asm volatile("v_cvt_pk_bf16_f32 %0, %1, %2" : "=v"(r) : "v"(lo), "v"(hi)); return r; }
__device__ __forceinline__ float sigm(float x) { return __builtin_amdgcn_rcpf(1.f + __builtin_amdgcn_exp2f(-1.4426950408889634f * x)); }
typedef int v4i_t __attribute__((ext_vector_type(4)));
typedef int v8i_t __attribute__((ext_vector_type(8)));
__device__ __forceinline__ v8i_t cat8(bf16x8 a, bf16x8 b) { return __builtin_shufflevector(__builtin_bit_cast(v4i_t, a), __builtin_bit_cast(v4i_t, b), 0, 1, 2, 3, 4, 5, 6, 7); }
__device__ __forceinline__ float clamp8(float x) { return __builtin_amdgcn_fmed3f(x, -448.f, 448.f); }
__device__ __forceinline__ unsigned pack_fp8x4(float a, float b, float c, float d) { int w = 0; w = __builtin_amdgcn_cvt_pk_fp8_f32(clamp8(a), clamp8(b), w, false); w = __builtin_amdgcn_cvt_pk_fp8_f32(clamp8(c), clamp8(d), w, true); return (unsigned)w; }
__device__ __forceinline__ float bf_lo(unsigned w) { return __uint_as_float(w << 16); }
__device__ __forceinline__ float bf_hi(unsigned w) { return __uint_as_float(w & 0xffff0000u); }

struct EpiSlab {
    static constexpr bool PERM = true, AFTER_DRAIN = false, HOOK = false;
    bf16_t* O; size_t slab_stride; int qslab; float qscale;
    __device__ __forceinline__ void operator()(const f32x4 (&acc)[2][2][4][2], const Unit& u, int wr, int wc, int fr, int fq) const {
        const int slab = u.pn >> 1; bf16_t* base = O + (size_t)slab * slab_stride; const float sc = (slab == qslab) ? qscale : 1.f;
        const int row0 = u.pm * BM + wr * 64 + fr, col0 = (u.pn & 1) * 256 + wc * 32 + 8 * fq;
#pragma unroll
        for (int ai = 0; ai < 2; ++ai)
#pragma unroll
            for (int m = 0; m < 4; ++m) { bf16_t* rowp = base + (size_t)(row0 + ai * HALF + m * 16) * 512 + col0;
#pragma unroll
                for (int bj = 0; bj < 2; ++bj) { const f32x4 v0 = acc[ai][bj][m][0] * sc, v1 = acc[ai][bj][m][1] * sc;
                    u32x4 w; w.x = cvt_pk_bf16(v0[0], v0[1]); w.y = cvt_pk_bf16(v0[2], v0[3]); w.z = cvt_pk_bf16(v1[0], v1[1]); w.w = cvt_pk_bf16(v1[2], v1[3]);
                    *(u32x4*)(rowp + bj * HALF) = w; } }
    }
};
__device__ __forceinline__ size_t gate_img(int br, int pm, int pn, int piece, int wave, int lane) { return ((((size_t)(br * 512 + pm * 4 + pn) * 16 + piece) * 8 + wave) * 64 + lane) * 8; }
typedef unsigned u32x2g __attribute__((ext_vector_type(2)));
__device__ __forceinline__ float gate_val(float x, float c) { return __builtin_fmaxf(__builtin_fmaf(__builtin_amdgcn_rcpf(1.f + __builtin_amdgcn_exp2f(x * c)), 256.f, 0.5f), 1.f); }
__device__ __forceinline__ f32x4 ub4(unsigned w) { return (f32x4){(float)(w & 0xffu), (float)((w >> 8) & 0xffu), (float)((w >> 16) & 0xffu), (float)(w >> 24)}; }
struct EpiSig {
    static constexpr bool PERM = true, AFTER_DRAIN = false, HOOK = false;
    unsigned char* O; float in_scale;
    __device__ __forceinline__ void operator()(const f32x4 (&acc)[2][2][4][2], const Unit& u, int wr, int wc, int fr, int fq) const {
        const int br = u.pn >> 2, pn = u.pn & 3, wave = wr * 4 + wc, lane = fq * 16 + fr;
#pragma unroll
        for (int ai = 0; ai < 2; ++ai)
#pragma unroll
            for (int m = 0; m < 4; ++m)
#pragma unroll
                for (int bj = 0; bj < 2; ++bj) { const f32x4 v0 = acc[ai][bj][m][0], v1 = acc[ai][bj][m][1];
                    const float c = -1.4426950408889634f * in_scale; u32x2g w; w.x = 0u; w.y = 0u;
#pragma unroll
                    for (int j = 0; j < 4; ++j) { w.x = __builtin_amdgcn_cvt_pk_u8_f32(gate_val(v0[j], c), j, w.x); w.y = __builtin_amdgcn_cvt_pk_u8_f32(gate_val(v1[j], c), j, w.y); }
                    *(u32x2g*)(O + gate_img(br, u.pm, pn, ai * 8 + m * 2 + bj, wave, lane)) = w; }
    }
};
struct EpiMerge {
    static constexpr bool PERM = true, AFTER_DRAIN = false, HOOK = true;
    const unsigned char* G; bf16_t* O;
    __device__ __forceinline__ void hook(f32x4 (&acc)[2][2][4][2], const Unit& u, int t, int wr, int wc, int fr, int fq) const {
        const int i = (t >> 3) - 1; int lane = fq * 16 + fr; const int wave = wr * 4 + wc;
        asm volatile("" : "+v"(lane));
#pragma unroll
        for (int ai = 0; ai < 2; ++ai) {
            u32x2g ga[4][2], gb[4][2];
#pragma unroll
            for (int m = 0; m < 4; ++m)
#pragma unroll
                for (int bj = 0; bj < 2; ++bj) { ga[m][bj] = *(const u32x2g*)(G + gate_img(i, u.pm, u.pn, ai * 8 + m * 2 + bj, wave, lane)); gb[m][bj] = *(const u32x2g*)(G + gate_img(i + 1, u.pm, u.pn, ai * 8 + m * 2 + bj, wave, lane)); }
            __builtin_amdgcn_sched_barrier(0);
#pragma unroll
            for (int m = 0; m < 4; ++m)
#pragma unroll
                for (int bj = 0; bj < 2; ++bj) { const f32x4 a0 = ub4(ga[m][bj].x), a1 = ub4(ga[m][bj].y), b0 = ub4(gb[m][bj].x), b1 = ub4(gb[m][bj].y);
                    f32x4 r0, r1;
#pragma unroll
                    for (int j = 0; j < 4; ++j) { r0[j] = a0[j] * __builtin_amdgcn_rcpf(b0[j]); r1[j] = a1[j] * __builtin_amdgcn_rcpf(b1[j]); }
                    acc[ai][bj][m][0] *= r0; acc[ai][bj][m][1] *= r1; }
            __builtin_amdgcn_sched_barrier(0);
        }
    }
    __device__ __forceinline__ void operator()(const f32x4 (&acc)[2][2][4][2], const Unit& u, int wr, int wc, int fr, int fq) const {
        const int row0 = u.pm * BM + wr * 64 + fr, col0 = u.pn * BM + wc * 32 + 8 * fq, lane = fq * 16 + fr, wave = wr * 4 + wc;
        u32x2g g[2][4][2];
#pragma unroll
        for (int ai = 0; ai < 2; ++ai)
#pragma unroll
            for (int m = 0; m < 4; ++m)
#pragma unroll
                for (int bj = 0; bj < 2; ++bj) g[ai][m][bj] = *(const u32x2g*)(G + gate_img(2, u.pm, u.pn, ai * 8 + m * 2 + bj, wave, lane));
        __builtin_amdgcn_sched_barrier(0);
#pragma unroll
        for (int ai = 0; ai < 2; ++ai)
#pragma unroll
            for (int m = 0; m < 4; ++m) { const size_t off = (size_t)(row0 + ai * HALF + m * 16) * 1024 + col0;
#pragma unroll
                for (int bj = 0; bj < 2; ++bj) { const f32x4 g0 = ub4(g[ai][m][bj].x) * (1.f / 256.f), g1 = ub4(g[ai][m][bj].y) * (1.f / 256.f); const f32x4 v0 = acc[ai][bj][m][0] * g0, v1 = acc[ai][bj][m][1] * g1;
                    u32x4 w; w.x = cvt_pk_bf16(v0[0], v0[1]); w.y = cvt_pk_bf16(v0[2], v0[3]); w.z = cvt_pk_bf16(v1[0], v1[1]); w.w = cvt_pk_bf16(v1[2], v1[3]);
                    *(u32x4*)(O + off + bj * HALF) = w; } }
    }
};
struct EpiRes {
    static constexpr bool PERM = false, AFTER_DRAIN = false, HOOK = false;
    const float* base; float* out; int ldc; float in_scale = 1.f;
    __device__ __forceinline__ void operator()(const f32x4 (&acc)[2][2][4][2], const Unit& u, int wr, int wc, int fr, int fq) const {
        const int row0 = u.pm * BM + wr * 64 + fr, col0 = u.pn * BM + wc * 32 + 4 * fq;
#pragma unroll
        for (int ai = 0; ai < 2; ++ai) {
            f32x4 bs[4][2][2];
#pragma unroll
            for (int m = 0; m < 4; ++m)
#pragma unroll
                for (int bj = 0; bj < 2; ++bj)
#pragma unroll
                    for (int n = 0; n < 2; ++n) bs[m][bj][n] = *(const f32x4*)(base + (size_t)(row0 + ai * HALF + m * 16) * ldc + col0 + bj * HALF + n * 16);
            __builtin_amdgcn_sched_barrier(0);
#pragma unroll
            for (int m = 0; m < 4; ++m)
#pragma unroll
                for (int bj = 0; bj < 2; ++bj)
#pragma unroll
                    for (int n = 0; n < 2; ++n) *(f32x4*)(out + (size_t)(row0 + ai * HALF + m * 16) * ldc + col0 + bj * HALF + n * 16) = bs[m][bj][n] + acc[ai][bj][m][n] * in_scale;
            __builtin_amdgcn_sched_barrier(0);
        }
    }
};
template <bool BASE_F32> struct EpiResB {
    static constexpr bool PERM = true, AFTER_DRAIN = false, HOOK = false;
    const void* base; bf16_t* out; float* ssq_part;
    __device__ __forceinline__ void operator()(const f32x4 (&acc)[2][2][4][2], const Unit& u, int wr, int wc, int fr, int fq) const {
        const int row0 = u.pm * BM + wr * 64 + fr, col0 = u.pn * BM + wc * 32 + 8 * fq;
#pragma unroll
        for (int ai = 0; ai < 2; ++ai) {
            f32x4 b0[4][2], b1[4][2];
            if constexpr (BASE_F32) {
#pragma unroll
                for (int m = 0; m < 4; ++m)
#pragma unroll
                    for (int bj = 0; bj < 2; ++bj) { const float* p = (const float*)base + (size_t)(row0 + ai * HALF + m * 16) * 1024 + col0 + bj * HALF; b0[m][bj] = *(const f32x4*)p; b1[m][bj] = *(const f32x4*)(p + 4); }
            } else {
                u32x4 q[4][2];
#pragma unroll
                for (int m = 0; m < 4; ++m)
#pragma unroll
                    for (int bj = 0; bj < 2; ++bj) q[m][bj] = *(const u32x4*)((const bf16_t*)base + (size_t)(row0 + ai * HALF + m * 16) * 1024 + col0 + bj * HALF);
                __builtin_amdgcn_sched_barrier(0);
#pragma unroll
                for (int m = 0; m < 4; ++m)
#pragma unroll
                    for (int bj = 0; bj < 2; ++bj) { b0[m][bj] = (f32x4){bf_lo(q[m][bj].x), bf_hi(q[m][bj].x), bf_lo(q[m][bj].y), bf_hi(q[m][bj].y)}; b1[m][bj] = (f32x4){bf_lo(q[m][bj].z), bf_hi(q[m][bj].z), bf_lo(q[m][bj].w), bf_hi(q[m][bj].w)}; }
            }
            __builtin_amdgcn_sched_barrier(0);
#pragma unroll
            for (int m = 0; m < 4; ++m) { float ss = 0.f;
#pragma unroll
                for (int bj = 0; bj < 2; ++bj) { const f32x4 v0 = b0[m][bj] + acc[ai][bj][m][0], v1 = b1[m][bj] + acc[ai][bj][m][1];
                    ss += ((v0[0] * v0[0] + v0[1] * v0[1]) + (v0[2] * v0[2] + v0[3] * v0[3])) + ((v1[0] * v1[0] + v1[1] * v1[1]) + (v1[2] * v1[2] + v1[3] * v1[3]));
                    u32x4 w; w.x = cvt_pk_bf16(v0[0], v0[1]); w.y = cvt_pk_bf16(v0[2], v0[3]); w.z = cvt_pk_bf16(v1[0], v1[1]); w.w = cvt_pk_bf16(v1[2], v1[3]);
                    *(u32x4*)(out + (size_t)(row0 + ai * HALF + m * 16) * 1024 + col0 + bj * HALF) = w; }
                if (ssq_part) { ss += __shfl_xor(ss, 16); ss += __shfl_xor(ss, 32); if (fq == 0) ssq_part[(size_t)(row0 + ai * HALF + m * 16) * 16 + u.pn * 4 + wc] = ss; } }
            __builtin_amdgcn_sched_barrier(0);
        }
    }
};
struct EpiSwiGLU {
    static constexpr bool PERM = true, AFTER_DRAIN = false, HOOK = false;
    bf16_t* O; int ldc;
    __device__ __forceinline__ void operator()(const f32x4 (&acc)[2][2][4][2], const Unit& u, int wr, int wc, int fr, int fq) const {
        const int row0 = u.pm * BM + wr * 64 + fr, col0 = u.pn * HALF + wc * 32 + 8 * fq;
#pragma unroll
        for (int ai = 0; ai < 2; ++ai)
#pragma unroll
            for (int m = 0; m < 4; ++m) { f32x4 v0, v1;
#pragma unroll
                for (int j = 0; j < 4; ++j) { const float g0 = acc[ai][0][m][0][j], g1 = acc[ai][0][m][1][j]; v0[j] = g0 * sigm(g0) * acc[ai][1][m][0][j]; v1[j] = g1 * sigm(g1) * acc[ai][1][m][1][j]; }
                u32x4 w; w.x = cvt_pk_bf16(v0[0], v0[1]); w.y = cvt_pk_bf16(v0[2], v0[3]); w.z = cvt_pk_bf16(v1[0], v1[1]); w.w = cvt_pk_bf16(v1[2], v1[3]);
                *(u32x4*)(O + (size_t)(row0 + ai * HALF + m * 16) * ldc + col0) = w; }
    }
};
struct EpiSwiGLUR {
    static constexpr bool PERM = true, AFTER_DRAIN = false, HOOK = false;
    bf16_t* O; int ldc; const float* ssq_part; float inv_d, eps;
    __device__ __forceinline__ void operator()(const f32x4 (&acc)[2][2][4][2], const Unit& u, int wr, int wc, int fr, int fq) const {
        const int row0 = u.pm * BM + wr * 64 + fr, col0 = u.pn * HALF + wc * 32 + 8 * fq;
        f32x4 pp[2][4];
#pragma unroll
        for (int ai = 0; ai < 2; ++ai)
#pragma unroll
            for (int m = 0; m < 4; ++m) pp[ai][m] = *(const f32x4*)(ssq_part + (size_t)(row0 + ai * HALF + m * 16) * 16 + 4 * fq);
#pragma unroll
        for (int ai = 0; ai < 2; ++ai)
#pragma unroll
            for (int m = 0; m < 4; ++m) { float s = (pp[ai][m][0] + pp[ai][m][1]) + (pp[ai][m][2] + pp[ai][m][3]); s += __shfl_xor(s, 16); s += __shfl_xor(s, 32);
                const float rs = __builtin_amdgcn_rsqf(s * inv_d + eps); f32x4 v0, v1;
#pragma unroll
                for (int j = 0; j < 4; ++j) { const float g0 = acc[ai][0][m][0][j] * rs, g1 = acc[ai][0][m][1][j] * rs; v0[j] = g0 * sigm(g0) * (acc[ai][1][m][0][j] * rs); v1[j] = g1 * sigm(g1) * (acc[ai][1][m][1][j] * rs); }
                u32x4 w; w.x = cvt_pk_bf16(v0[0], v0[1]); w.y = cvt_pk_bf16(v0[2], v0[3]); w.z = cvt_pk_bf16(v1[0], v1[1]); w.w = cvt_pk_bf16(v1[2], v1[3]);
                *(u32x4*)(O + (size_t)(row0 + ai * HALF + m * 16) * ldc + col0) = w; }
    }
};
struct EpiSwiGLU8 {
    static constexpr bool PERM = true, AFTER_DRAIN = false, HOOK = false;
    unsigned char* O; int ldc; float in_scale, out_scale;
    __device__ __forceinline__ void operator()(const f32x4 (&acc)[2][2][4][2], const Unit& u, int wr, int wc, int fr, int fq) const {
        const int row0 = u.pm * BM + wr * 64 + fr, col0 = u.pn * HALF + wc * 32 + 8 * fq; const float c1 = in_scale * in_scale * out_scale, c2 = -1.4426950408889634f * in_scale;
#pragma unroll
        for (int ai = 0; ai < 2; ++ai)
#pragma unroll
            for (int m = 0; m < 4; ++m) { f32x4 v0, v1;
#pragma unroll
                for (int j = 0; j < 4; ++j) { const float g0 = acc[ai][0][m][0][j], g1 = acc[ai][0][m][1][j];
                    v0[j] = (g0 * acc[ai][1][m][0][j]) * __builtin_amdgcn_rcpf(1.f + __builtin_amdgcn_exp2f(g0 * c2)) * c1; v1[j] = (g1 * acc[ai][1][m][1][j]) * __builtin_amdgcn_rcpf(1.f + __builtin_amdgcn_exp2f(g1 * c2)) * c1; }
                typedef unsigned u32x2_t __attribute__((ext_vector_type(2)));
                u32x2_t w; w.x = pack_fp8x4(v0[0], v0[1], v0[2], v0[3]); w.y = pack_fp8x4(v1[0], v1[1], v1[2], v1[3]);
                *(u32x2_t*)(O + (size_t)(row0 + ai * HALF + m * 16) * ldc + col0) = w; }
    }
};
struct EpiMoeDown {
    static constexpr bool PERM = true, AFTER_DRAIN = false, HOOK = false;
    bf16_t* Y; const int* row_tok; const float* row_g; float in_scale;
    __device__ __forceinline__ void operator()(const f32x4 (&acc)[2][2][4][2], const Unit& u, int wr, int wc, int fr, int fq) const {
        const int row0 = u.pm * BM + wr * 64 + fr, col0 = u.pn * BM + wc * 32 + 8 * fq;
#pragma unroll
        for (int ai = 0; ai < 2; ++ai)
#pragma unroll
            for (int m = 0; m < 4; ++m) { const int r = row0 + ai * HALF + m * 16; const int tok = row_tok[r]; const float g = row_g[r] * in_scale;
                if (tok >= 0) { bf16_t* p = Y + (size_t)tok * 1024 + col0;
#pragma unroll
                    for (int bj = 0; bj < 2; ++bj) { const f32x4 v0 = acc[ai][bj][m][0] * g, v1 = acc[ai][bj][m][1] * g;
                        u32x4 w; w.x = cvt_pk_bf16(v0[0], v0[1]); w.y = cvt_pk_bf16(v0[2], v0[3]); w.z = cvt_pk_bf16(v1[0], v1[1]); w.w = cvt_pk_bf16(v1[2], v1[3]);
                        *(u32x4*)(p + bj * HALF) = w; } } }
    }
};
struct MoeRange {
    int nM, nN, lo, hi; const PG8_LAS int* tile_e;
    __device__ void init(int nM_, int nN_, int lo_, int hi_, const PG8_LAS int* te) { nM = nM_; nN = nN_; lo = lo_; hi = hi_; tile_e = te; }
    __device__ bool next(int i, Unit& u) const {
        const int wgid = lo + i; if (wgid >= hi) return false;
        const int nig = WGM * nN, gid = wgid / nig, fm = gid * WGM, gsz = (nM - fm) < WGM ? (nM - fm) : WGM;
        u.pm = fm + ((wgid % nig) % gsz); u.pn = (wgid % nig) / gsz;
        const int e = __builtin_amdgcn_readfirstlane(tile_e[u.pm]); u.pb = e * nN + u.pn; return true;
    }
    __device__ __forceinline__ void a_ready(const Unit&) const {}
    __device__ __forceinline__ void done(const Unit&) const {}
};
struct MoeOrder {
    int nM, nN, nwg, G, c; const PG8_LAS int* tile_e;
    __device__ void init(int nM_, int nN_, int G_, int c_, const PG8_LAS int* te) { nM = nM_; nN = nN_; nwg = nM * nN; G = G_; c = c_; tile_e = te; }
    __device__ bool next(int i, Unit& u) const {
        const long L = (long)i * G + c; if (L >= nwg) return false;
        int wgid = (int)L; { const int q = nwg / NXCD, r = nwg % NXCD, xcd = wgid % NXCD, off = wgid / NXCD; wgid = (xcd < r ? xcd * (q + 1) : r * (q + 1) + (xcd - r) * q) + off; }
        const int nig = WGM * nN, gid = wgid / nig, fm = gid * WGM, gsz = (nM - fm) < WGM ? (nM - fm) : WGM;
        u.pm = fm + ((wgid % nig) % gsz); u.pn = (wgid % nig) / gsz;
        const int e = __builtin_amdgcn_readfirstlane(tile_e[u.pm]); u.pb = e * nN + u.pn; return true;
    }
    __device__ __forceinline__ void a_ready(const Unit&) const {}
    __device__ __forceinline__ void done(const Unit&) const {}
};
template <class Epi, class Sched, bool ALIGN_EPI = false, bool SP2 = false, bool FP8 = false>
__device__ __forceinline__ void gemm_phase(PG8_LAS unsigned char* lds, const Gemm g, const Sched& S, const Epi& E) {
    int tid_ = threadIdx.x; asm volatile("" : "+v"(tid_));
    const int tid = tid_, wid = __builtin_amdgcn_readfirstlane(tid >> 6), lane = tid & 63, wr = wid >> 2, wc = wid & 3, fr = lane & 15, fq = lane >> 4;
    const int K = g.K, nt = K / BK;
    unsigned voffA[2], voffB[2];
#pragma unroll
    for (int i = 0; i < 2; ++i) { int R, C; stage_rc(tid * 16 + i * 8192, R, C); const int Rb = Epi::PERM ? ((R & ~31) + perm32(R & 31)) : R;
        voffA[i] = (unsigned)(R * K + C) * 2u; voffB[i] = (unsigned)(Rb * K + C) * 2u; }
    const size_t kstep = (size_t)(BK * 2);
    const size_t hstep = (size_t)HALF * K * 2;
    const size_t tstep = 2 * hstep;
    const unsigned ldsw = (unsigned)wid * 1024u;
    const int aoff = lds_byte(wr * 64 + fr, fq * 8), boff = lds_byte(wc * 32 + fr, fq * 8);
#define PG8_SA(b, h) (((b) * 2 + (h)) * HTB)
#define PG8_SB(b, h) ((4 + (b) * 2 + (h)) * HTB)
#define PG8_STAGE(bufoff, gbase, voff) do { _Pragma("unroll") for (int _i = 0; _i < 2; ++_i) \
        __builtin_amdgcn_global_load_lds((const unsigned*)((const char*)(gbase) + (voff)[_i]), (PG8_LAS unsigned*)(lds + (bufoff) + ldsw + _i * 8192), 16, 0, 0); } while (0)
#define PG8_LDA(dst, b, h) do { _Pragma("unroll") for (int m = 0; m < 4; ++m) _Pragma("unroll") for (int k = 0; k < 2; ++k) dst[m][k] = *(const PG8_LAS bf16x8*)(lds + PG8_SA(b, h) + aoff + m * 2048 + k * 1024); } while (0)
#define PG8_LDB(dst, b, h) do { _Pragma("unroll") for (int n = 0; n < 2; ++n) _Pragma("unroll") for (int k = 0; k < 2; ++k) dst[n][k] = *(const PG8_LAS bf16x8*)(lds + PG8_SB(b, h) + boff + n * 2048 + k * 1024); } while (0)
#define PG8_MMA(ai, bj, At, Bt) do { __builtin_amdgcn_s_setprio(1); \
        if constexpr (FP8) { _Pragma("unroll") for (int m = 0; m < 4; ++m) _Pragma("unroll") for (int n = 0; n < 2; ++n) \
            asm volatile("v_mfma_f32_16x16x128_f8f6f4 %0, %1, %2, %0" : "+v"(acc[ai][bj][m][n]) : "v"(cat8(Bt[n][0], Bt[n][1])), "v"(cat8(At[m][0], At[m][1]))); } \
        else { _Pragma("unroll") for (int m = 0; m < 4; ++m) _Pragma("unroll") for (int n = 0; n < 2; ++n) _Pragma("unroll") for (int k = 0; k < 2; ++k) \
            acc[ai][bj][m][n] = __builtin_amdgcn_mfma_f32_16x16x32_bf16(Bt[n][k], At[m][k], acc[ai][bj][m][n], 0, 0, 0); } \
        __builtin_amdgcn_s_setprio(0); } while (0)
#define PG8_WAIT_V(n) asm volatile("s_waitcnt vmcnt(" #n ")" ::: "memory")
#define PG8_WAIT_L(n) asm volatile("s_waitcnt lgkmcnt(" #n ")" ::: "memory")
#define PG8_BAR __builtin_amdgcn_s_barrier()
#define PG8_SCHED __builtin_amdgcn_sched_barrier(0)
    Unit cur, nxt; int ui = 0;
    if (!S.next(0, cur)) return;
    f32x4 acc[2][2][4][2];
#pragma unroll
    for (int a = 0; a < 2; ++a)
#pragma unroll
        for (int b = 0; b < 2; ++b)
#pragma unroll
            for (int m = 0; m < 4; ++m)
#pragma unroll
                for (int n = 0; n < 2; ++n) acc[a][b][m][n] = (f32x4){0.f, 0.f, 0.f, 0.f};
    bf16x8 At[4][2], B0[2][2], B1[2][2];
    const char* cA = (const char*)g.A + (size_t)cur.pm * tstep; const char* cB = (const char*)g.Bt + (size_t)cur.pb * tstep;
    S.a_ready(cur);
    if constexpr (SP2) {
        PG8_STAGE(PG8_SB(0, 0), cB, voffB); PG8_STAGE(PG8_SB(0, 1), cB + hstep, voffB); PG8_STAGE(PG8_SA(0, 0), cA, voffA); PG8_STAGE(PG8_SA(0, 1), cA + hstep, voffA);
        if (wr == 1) PG8_BAR;
        PG8_WAIT_V(2); PG8_BAR;
        PG8_STAGE(PG8_SB(1, 0), cB + kstep, voffB); PG8_STAGE(PG8_SA(1, 0), cA + kstep, voffA); PG8_STAGE(PG8_SB(1, 1), cB + hstep + kstep, voffB);
        PG8_WAIT_V(6); PG8_BAR;
    } else {
        PG8_STAGE(PG8_SB(0, 0), cB, voffB); PG8_STAGE(PG8_SA(0, 0), cA, voffA); PG8_STAGE(PG8_SB(0, 1), cB + hstep, voffB); PG8_STAGE(PG8_SA(0, 1), cA + hstep, voffA);
        if (wr == 1) PG8_BAR;
        PG8_WAIT_V(4); PG8_BAR;
        PG8_STAGE(PG8_SB(1, 0), cB + kstep, voffB); PG8_STAGE(PG8_SA(1, 0), cA + kstep, voffA); PG8_STAGE(PG8_SB(1, 1), cB + hstep + kstep, voffB);
        PG8_WAIT_V(6); PG8_BAR;
    }
    for (;;) {
        const bool has_next = S.next(ui + 1, nxt);
        const char* nA = has_next ? (const char*)g.A + (size_t)nxt.pm * tstep : cA; const char* nB = has_next ? (const char*)g.Bt + (size_t)nxt.pb * tstep : cB;
        for (int t = 0; t < nt; t += 2) {
            if constexpr (Epi::HOOK) { if (t == 8 || t == 16) E.hook(acc, cur, t, wr, wc, fr, fq); }
            const bool last = (t == nt - 2);
            const char* a1 = cA + (size_t)(t + 1) * kstep;
            const char* a2 = last ? nA : cA + (size_t)(t + 2) * kstep; const char* b2 = last ? nB : cB + (size_t)(t + 2) * kstep;
            const char* a3 = a2 + kstep; const char* b3 = b2 + kstep;
            if (last && has_next) S.a_ready(nxt);
            if constexpr (SP2) {
            PG8_LDB(B0, 0, 0); PG8_LDB(B1, 0, 1); PG8_SCHED; PG8_LDA(At, 0, 0); PG8_STAGE(PG8_SA(1, 1), a1 + hstep, voffA);
            PG8_WAIT_V(8); PG8_WAIT_L(0); PG8_BAR; PG8_MMA(0, 0, At, B0); PG8_MMA(0, 1, At, B1); PG8_BAR; PG8_SCHED;
            PG8_LDA(At, 0, 1); PG8_STAGE(PG8_SB(0, 0), b2, voffB); PG8_STAGE(PG8_SB(0, 1), b2 + hstep, voffB); PG8_STAGE(PG8_SA(0, 0), a2, voffA);
            PG8_WAIT_V(8); PG8_WAIT_L(0); PG8_BAR; PG8_MMA(1, 0, At, B0); PG8_MMA(1, 1, At, B1); PG8_BAR; PG8_SCHED;
            PG8_LDB(B0, 1, 0); PG8_LDB(B1, 1, 1); PG8_SCHED; PG8_LDA(At, 1, 0); PG8_STAGE(PG8_SA(0, 1), a2 + hstep, voffA);
            PG8_WAIT_V(8); PG8_WAIT_L(0); PG8_BAR; PG8_MMA(0, 0, At, B0); PG8_MMA(0, 1, At, B1); PG8_BAR; PG8_SCHED;
            PG8_LDA(At, 1, 1); PG8_STAGE(PG8_SB(1, 0), b3, voffB); PG8_STAGE(PG8_SB(1, 1), b3 + hstep, voffB); PG8_STAGE(PG8_SA(1, 0), a3, voffA);
            PG8_WAIT_V(8); PG8_WAIT_L(0); PG8_BAR; PG8_MMA(1, 0, At, B0); PG8_MMA(1, 1, At, B1); PG8_BAR; PG8_SCHED;
            } else {
            PG8_LDB(B0, 0, 0); PG8_SCHED; PG8_LDA(At, 0, 0); PG8_STAGE(PG8_SA(1, 1), a1 + hstep, voffA);
            PG8_WAIT_L(8); PG8_BAR; PG8_WAIT_L(0); PG8_MMA(0, 0, At, B0); PG8_BAR; PG8_SCHED;
            PG8_LDB(B1, 0, 1); PG8_STAGE(PG8_SB(0, 0), b2, voffB);
            PG8_BAR; PG8_WAIT_L(0); PG8_MMA(0, 1, At, B1); PG8_BAR;
            PG8_LDA(At, 0, 1); PG8_STAGE(PG8_SA(0, 0), a2, voffA);
            PG8_BAR; PG8_WAIT_L(0); PG8_MMA(1, 0, At, B0); PG8_BAR; PG8_SCHED;
            PG8_STAGE(PG8_SB(0, 1), b2 + hstep, voffB);
            PG8_WAIT_V(6); PG8_BAR; PG8_MMA(1, 1, At, B1); PG8_BAR;
            PG8_LDB(B0, 1, 0); PG8_SCHED; PG8_LDA(At, 1, 0); PG8_STAGE(PG8_SA(0, 1), a2 + hstep, voffA);
            PG8_WAIT_L(8); PG8_BAR; PG8_WAIT_L(0); PG8_MMA(0, 0, At, B0); PG8_BAR; PG8_SCHED;
            PG8_LDB(B1, 1, 1); PG8_STAGE(PG8_SB(1, 0), b3, voffB);
            PG8_BAR; PG8_WAIT_L(0); PG8_MMA(0, 1, At, B1); PG8_BAR;
            PG8_LDA(At, 1, 1); PG8_STAGE(PG8_SA(1, 0), a3, voffA);
            PG8_BAR; PG8_WAIT_L(0); PG8_MMA(1, 0, At, B0); PG8_BAR; PG8_SCHED;
            PG8_STAGE(PG8_SB(1, 1), b3 + hstep, voffB);
            PG8_WAIT_V(6); PG8_BAR; PG8_MMA(1, 1, At, B1); PG8_BAR;
            }
        }
        if constexpr (ALIGN_EPI) { if (wr == 0) PG8_BAR; }
        if constexpr (FP8) {
            asm volatile("s_nop 15\n\ts_nop 15" : "+v"(acc[0][0][0][0]), "+v"(acc[0][0][0][1]), "+v"(acc[0][0][1][0]), "+v"(acc[0][0][1][1]), "+v"(acc[0][0][2][0]), "+v"(acc[0][0][2][1]), "+v"(acc[0][0][3][0]), "+v"(acc[0][0][3][1]));
            asm volatile("" : "+v"(acc[0][1][0][0]), "+v"(acc[0][1][0][1]), "+v"(acc[0][1][1][0]), "+v"(acc[0][1][1][1]), "+v"(acc[0][1][2][0]), "+v"(acc[0][1][2][1]), "+v"(acc[0][1][3][0]), "+v"(acc[0][1][3][1]));
            asm volatile("" : "+v"(acc[1][0][0][0]), "+v"(acc[1][0][0][1]), "+v"(acc[1][0][1][0]), "+v"(acc[1][0][1][1]), "+v"(acc[1][0][2][0]), "+v"(acc[1][0][2][1]), "+v"(acc[1][0][3][0]), "+v"(acc[1][0][3][1]));
            asm volatile("" : "+v"(acc[1][1][0][0]), "+v"(acc[1][1][0][1]), "+v"(acc[1][1][1][0]), "+v"(acc[1][1][1][1]), "+v"(acc[1][1][2][0]), "+v"(acc[1][1][2][1]), "+v"(acc[1][1][3][0]), "+v"(acc[1][1][3][1])); }
        if constexpr (!Epi::AFTER_DRAIN) { E(acc, cur, wr, wc, fr, fq); S.done(cur); }
        if (!has_next) break;
#pragma unroll
        for (int a = 0; a < 2; ++a)
#pragma unroll
            for (int b = 0; b < 2; ++b)
#pragma unroll
                for (int m = 0; m < 4; ++m)
#pragma unroll
                    for (int n = 0; n < 2; ++n) acc[a][b][m][n] = (f32x4){0.f, 0.f, 0.f, 0.f};
        cur = nxt; cA = nA; cB = nB; ++ui;
        if constexpr (ALIGN_EPI) { if (wr == 1) PG8_BAR; }
    }
    PG8_WAIT_V(0);
    if constexpr (!ALIGN_EPI) { if (wr == 0) PG8_BAR; }
    PG8_BAR;
    if constexpr (Epi::AFTER_DRAIN) { E.fused(acc, cur, wr, wc, fr, fq, lds, wid, lane); S.done(cur); }
#undef PG8_SA
#undef PG8_SB
#undef PG8_STAGE
#undef PG8_LDA
#undef PG8_LDB
#undef PG8_MMA
#undef PG8_WAIT_V
#undef PG8_WAIT_L
#undef PG8_BAR
#undef PG8_SCHED
}
}
#include <hip/hip_bf16.h>
#include <cmath>
namespace attn_body {
using bf16=__hip_bfloat16;
using bf16x8=__attribute__((ext_vector_type(8)))short;
using s16x4=__attribute__((ext_vector_type(4)))short;
using f32x16=__attribute__((ext_vector_type(16)))float;
using u32x4=__attribute__((ext_vector_type(4)))unsigned;
constexpr int BATCH=4,NHEAD=8,SEQ=8192,D=64,DM=NHEAD*D,DMO=1536,OCOL=1024;
constexpr int NW=8,QBLK=32,QB=QBLK*NW,KVBLK=64,NQB=SEQ/QB;
constexpr int ATTN_PITCH=DM, ATTN_UNIT_ROWS=QB;
__device__ __forceinline__ int crow(int r,int hi){return (r&3)+8*(r>>2)+4*hi;}
#define SBAR() __builtin_amdgcn_sched_barrier(0)
__device__ __forceinline__ void cmask(f32x16&p0,f32x16&p1,int jb,int qrel,int hi){
  const float NEG=-INFINITY; int kb=64*jb+4*hi;
  #pragma unroll
  for(int r=0;r<16;++r){int kv=kb+(r&3)+8*(r>>2); if(kv>qrel)p0[r]=NEG; if(kv+32>qrel)p1[r]=NEG;}
}

constexpr int NSLOT=3, SLOTB=8192;
constexpr int LDS_K=0, LDS_V=NSLOT*SLOTB, LDS_WS=2*NSLOT*SLOTB, LDS_OST=LDS_WS+NW*64*4, LDS_NB=LDS_OST+NW*4096, LDS_BYTES=LDS_NB+SEQ*4;
constexpr float C2=0.125f*1.4426950408889634f;
__device__ __forceinline__ void glds16(const void*gsrc,unsigned lds_dst){unsigned keep;
  asm volatile("s_mov_b32 %0, m0\n\ts_mov_b32 m0, %2\n\ts_nop 0\n\tglobal_load_lds_dwordx4 %1, off\n\ts_mov_b32 m0, %0":"=&s"(keep):"v"(gsrc),"s"(lds_dst):"memory");}
__device__ __forceinline__ float max3f(float a,float b,float c){float r;asm("v_max3_f32 %0, %1, %2, %3":"=v"(r):"v"(a),"v"(b),"v"(c));return r;}
__device__ __forceinline__ float max2f(float a,float b){float r;asm("v_max_f32_e32 %0, %1, %2":"=v"(r):"v"(a),"v"(b));return r;}
__device__ __forceinline__ float fadd_s(float a,float b){float r;asm("v_add_f32_e32 %0, %1, %2":"=v"(r):"v"(a),"v"(b));return r;}
__device__ __forceinline__ float fsub_s(float a,float b){float r;asm("v_sub_f32_e32 %0, %1, %2":"=v"(r):"v"(a),"v"(b));return r;}
typedef float f32x2_t __attribute__((ext_vector_type(2))); typedef __bf16 bf16x2_t __attribute__((ext_vector_type(2)));
__device__ __forceinline__ unsigned cvtpk_s(float lo,float hi){f32x2_t v={lo,hi};bf16x2_t b=__builtin_convertvector(v,bf16x2_t);return __builtin_bit_cast(unsigned,b);}
#define WAIT_BAR(N) asm volatile("s_waitcnt vmcnt(" #N ") lgkmcnt(0)\n\ts_barrier":::"memory")

__device__ __forceinline__ void qkt(f32x16&p0,f32x16&p1,const char*Kslot,const bf16x8*qr,int r32,int hi){
  const char*kb=Kslot+hi*1024+r32*16;
  #pragma unroll
  for(int d0=0;d0<4;++d0){
    const bf16x8 b0=*reinterpret_cast<const bf16x8*>(kb+d0*2048);
    const bf16x8 b1=*reinterpret_cast<const bf16x8*>(kb+d0*2048+512);
    p0=__builtin_amdgcn_mfma_f32_32x32x16_bf16(b0,qr[d0],p0,0,0,0);p1=__builtin_amdgcn_mfma_f32_32x32x16_bf16(b1,qr[d0],p1,0,0,0);}
}
typedef __attribute__((address_space(3))) const char* lds_cptr;
typedef short v4i16_t __attribute__((ext_vector_type(4)));
__device__ __forceinline__ void kload8(bf16x8*kf,lds_cptr kp){
  kf[0]=*(const __attribute__((address_space(3))) bf16x8*)(kp);      kf[1]=*(const __attribute__((address_space(3))) bf16x8*)(kp+512);
  kf[2]=*(const __attribute__((address_space(3))) bf16x8*)(kp+2048); kf[3]=*(const __attribute__((address_space(3))) bf16x8*)(kp+2560);
  kf[4]=*(const __attribute__((address_space(3))) bf16x8*)(kp+4096); kf[5]=*(const __attribute__((address_space(3))) bf16x8*)(kp+4608);
  kf[6]=*(const __attribute__((address_space(3))) bf16x8*)(kp+6144); kf[7]=*(const __attribute__((address_space(3))) bf16x8*)(kp+6656);
}
__device__ __forceinline__ void kload2(bf16x8*kf,lds_cptr kp,int j){ kf[2*j]=*(const __attribute__((address_space(3))) bf16x8*)(kp+j*2048); kf[2*j+1]=*(const __attribute__((address_space(3))) bf16x8*)(kp+j*2048+512); }
__device__ __forceinline__ s16x4 vtr(lds_cptr p){ return __builtin_bit_cast(s16x4,__builtin_amdgcn_ds_read_tr16_b64_v4i16((__attribute__((address_space(3))) v4i16_t*)p)); }
__device__ __forceinline__ float rowmax(const f32x16&p0,const f32x16&p1){
  float a=max3f(p0[0],p0[1],p1[0]),b=max3f(p0[2],p0[3],p1[1]);a=max3f(a,p1[2],p1[3]);
  #pragma unroll
  for(int r=4;r<16;r+=4){a=max3f(a,p0[r],p0[r+1]);b=max3f(b,p0[r+2],p0[r+3]);a=max3f(a,p1[r],p1[r+1]);b=max3f(b,p1[r+2],p1[r+3]);}
  const float m=max2f(a,b);
  auto rr=__builtin_amdgcn_permlane32_swap(__float_as_uint(m),__float_as_uint(m),false,false);
  return max2f(__uint_as_float(rr[0]),__uint_as_float(rr[1]));
}
__device__ __forceinline__ void pv(f32x16*o,int vb,bf16x8 pa0,bf16x8 pa1,bf16x8 pa2,bf16x8 pa3){
  #pragma unroll
  for(int d0=0;d0<2;++d0){s16x4 lo[4],hi[4];
    #pragma unroll
    for(int ks=0;ks<4;++ks){
      asm volatile("ds_read_b64_tr_b16 %0,%1 offset:%c2":"=&v"(lo[ks]):"v"(vb),"i"(d0*4096+ks*1024):"memory");
      asm volatile("ds_read_b64_tr_b16 %0,%1 offset:%c2":"=&v"(hi[ks]):"v"(vb),"i"(d0*4096+ks*1024+512):"memory");}
    asm volatile("s_waitcnt lgkmcnt(0)":::"memory");SBAR();
    #define PK(k) (bf16x8){lo[k][0],lo[k][1],lo[k][2],lo[k][3],hi[k][0],hi[k][1],hi[k][2],hi[k][3]}
    o[d0]=__builtin_amdgcn_mfma_f32_32x32x16_bf16(pa0,PK(0),o[d0],0,0,0);
    o[d0]=__builtin_amdgcn_mfma_f32_32x32x16_bf16(pa1,PK(1),o[d0],0,0,0);
    o[d0]=__builtin_amdgcn_mfma_f32_32x32x16_bf16(pa2,PK(2),o[d0],0,0,0);
    o[d0]=__builtin_amdgcn_mfma_f32_32x32x16_bf16(pa3,PK(3),o[d0],0,0,0);
    #undef PK
  }
}

#ifndef ATTN_STORE16
#define ATTN_STORE16(p,v) (*(u32x4*)(p)=(v))
#endif
typedef float f32x4v __attribute__((ext_vector_type(4)));
__device__ __forceinline__ int attn_t0(int qb,const float*__restrict__ nbg,const float*__restrict__ qnw,const float*__restrict__ knw,const float*__restrict__ xmw,int lane){
  const int q0=qb*QB; float qn=0.f,kn=0.f,xm=3.0e38f; if(lane<8){qn=qnw[qb*8+lane];xm=xmw[qb*8+lane];}
  _Pragma("unroll") for(int i=0;i<4;++i){const int idx=lane*4+i; if(idx<(qb+1)*8)kn=__builtin_fmaxf(kn,knw[idx]);}
  _Pragma("unroll") for(int o_=1;o_<64;o_<<=1){qn=__builtin_fmaxf(qn,__shfl_xor(qn,o_));kn=__builtin_fmaxf(kn,__shfl_xor(kn,o_));xm=__builtin_fminf(xm,__shfl_xor(xm,o_));}
  const float thr=56.f+sqrtf(qn*kn)-xm; const int NT0=(q0+QB)/KVBLK;
  bool c_=(lane>=1)&&(2*lane<=NT0-4); float d_=0.f; if(c_)d_=nbg[128*lane-1]-nbg[q0]; c_=c_&&(d_<=-thr);
  return __builtin_amdgcn_readfirstlane(2*(int)__popcll(__ballot(c_)));
}
template<int THRL> __device__ __forceinline__ void attn_unit(int b,int h,int qb,const bf16*Q,const bf16*__restrict__ K,const bf16*__restrict__ V,bf16*O,const float*__restrict__ nbg,const int t0,char*shm){
  int tid_=threadIdx.x; asm volatile("":"+v"(tid_));
  const int tid=tid_,lane=tid&63,r32=lane&31,hi=lane>>5; const int wid=__builtin_amdgcn_readfirstlane(tid>>6);
  const long rowbase=(long)b*SEQ; const int q0=qb*QB;
  const bf16*Qw=Q+(rowbase+q0+wid*QBLK)*DM+h*D;
  const bf16*Kh=K+(rowbase+(long)t0*KVBLK)*DM+h*D,*Vh=V+(rowbase+(long)t0*KVBLK)*DM+h*D;
  const unsigned lds0=(unsigned)(uintptr_t)shm;
  float*wsf=(float*)(shm+LDS_WS)+wid*64;
  const bf16*ksrc=Kh+(long)lane*DM+wid*8;
  const bf16*vsrc=Vh+(long)(16*(wid&3)+(lane>>2))*DM+(wid>>2)*32+(lane&3)*8;
  const unsigned kdst=lds0+LDS_K+wid*1024, vdst=lds0+LDS_V+wid*1024;
  #define DMA_K(t,slot) glds16(ksrc+(long)(t)*KVBLK*DM,(unsigned)__builtin_amdgcn_readfirstlane(kdst+(slot)))
  #define DMA_V(t,slot) glds16(vsrc+(long)(t)*KVBLK*DM,(unsigned)__builtin_amdgcn_readfirstlane(vdst+(slot)))
  const int vb0=(int)(lds0+LDS_V)+((lane>>4)&1)*32+(lane&3)*8+(4*hi+((lane&15)>>2))*64;
  const char*Kbase=shm+LDS_K; bf16x8 kf[8];
  const lds_cptr shm3=(lds_cptr)shm; const lds_cptr kp0=shm3+LDS_K+hi*1024+r32*16; const lds_cptr vp0=shm3+LDS_V+((lane>>4)&1)*32+(lane&3)*8+(4*hi+((lane&15)>>2))*64;
  const int NT=(q0+QB)/KVBLK-t0;
  typedef __attribute__((address_space(3))) float* lds_fptr;
  const lds_fptr nbl3=(lds_fptr)(shm3+LDS_NB);
  const lds_fptr nbl3o=nbl3+t0*KVBLK;
  DMA_K(0,0);DMA_V(0,0);DMA_K(1,SLOTB);
  { const float ref=nbg[q0+QB-1]; for(int j=t0*KVBLK+tid;j<q0+QB;j+=NW*64) nbl3[j]=nbg[j]-ref; }
  bf16x8 qr[4];
  #pragma unroll
  for(int d0=0;d0<4;++d0)qr[d0]=*reinterpret_cast<const bf16x8*>(&Qw[(long)r32*DM+d0*16+hi*8]);
  float mhat=0.f,l_reg=0.f;f32x16 o[2];o[0]=f32x16{};o[1]=f32x16{};
  const int qrel=wid*QBLK+r32;
  #define CMASK(P0,P1,t) do{int jb_=(t)-(NT-4); if(jb_>=0)cmask(P0,P1,jb_,qrel,hi);}while(0)
  bool resc=false;
  #define START(P0,P1) do{ const float rm=rowmax(P0,P1); resc=false; \
    if(__any(rm>(float)THRL)){ const float dl=__builtin_fmaxf(rm,0.f); mhat=fadd_s(mhat,dl); \
      _Pragma("unroll") for(int r=0;r<16;++r){P0[r]=fsub_s(P0[r],dl);P1[r]=fsub_s(P1[r],dl);} } \
    _Pragma("unroll") for(int r=0;r<16;++r)P0[r]=__builtin_amdgcn_exp2f(P0[r]); }while(0)
  #define BIAS(P0,P1,t) do{ const lds_fptr nbp_=nbl3o+64*(t)+4*hi; \
    _Pragma("unroll") for(int q_=0;q_<4;++q_){ const f32x4v b0_=*(const __attribute__((address_space(3))) f32x4v*)(nbp_+8*q_), b1_=*(const __attribute__((address_space(3))) f32x4v*)(nbp_+32+8*q_); \
      _Pragma("unroll") for(int i_=0;i_<4;++i_){ P0[4*q_+i_]=b0_[i_]-mhat; P1[4*q_+i_]=b1_[i_]-mhat; } } }while(0)
  #define RESC() do{ if(resc){ asm volatile("s_waitcnt lgkmcnt(0)":::"memory"); \
      _Pragma("unroll") for(int d_=0;d_<2;++d_) _Pragma("unroll") for(int r=0;r<16;++r)o[d_][r]*=wsf[crow(r,hi)]; } }while(0)
  f32x16 pA0,pA1,pB0,pB1;
  int sl_prev=0,sl_cur=0,sl_next=SLOTB;
  #define ROT() do{sl_prev=sl_cur;sl_cur=sl_next;sl_next=(sl_next==(NSLOT-1)*SLOTB)?0:sl_next+SLOTB;}while(0)
  DMA_K(2,2*SLOTB);
  WAIT_BAR(3);
  mhat=nbl3[q0+qrel];
  BIAS(pA0,pA1,0);qkt(pA0,pA1,Kbase,qr,r32,hi);asm volatile("s_nop 15\n\ts_nop 7":"+v"(pA0),"+v"(pA1));CMASK(pA0,pA1,0);
  START(pA0,pA1);
  _Pragma("unroll") for(int r=0;r<16;++r)pA1[r]=__builtin_amdgcn_exp2f(pA1[r]);
  WAIT_BAR(0);
  DMA_K(3,0);DMA_V(1,SLOTB);
  ROT();
  kload8(kf,kp0+sl_cur);
  WAIT_BAR(2);
  s16x4 vlo[8],vhi[8]; u32x4 pw0,pw1,pw2,pw3;
  #define PKW(P,B) cvtpk_s(P[B],P[B+1])
  #define PAF(k) __builtin_bit_cast(bf16x8,pw##k)
  #define VFR(i) (bf16x8){vlo[i][0],vlo[i][1],vlo[i][2],vlo[i][3],vhi[i][0],vhi[i][1],vhi[i][2],vhi[i][3]}
  #define PIN(x) asm volatile("":"+v"(x))
  #define MX3(a,b,c) __builtin_fmaxf(__builtin_fmaxf((a),(b)),(c))
  #define GAPA(MF,A0,A1,A2,A3,W0,W1,PW) do{ MF; sacc+=A0; sacc+=A1; sacc+=A2; sacc+=A3; PIN(sacc); W0; W1; PIN(PW); SBAR(); }while(0)
  #define EX(v) __builtin_amdgcn_exp2f(v)
  #define GAPB(MF,X,B) do{ MF; X[B]=EX(X[B]); X[B+1]=EX(X[B+1]); X[B+2]=EX(X[B+2]); X[B+3]=EX(X[B+3]); PIN(X); SBAR(); }while(0)
  #define VRD(i) do{ vlo[i]=vtr(vp_+(((i)>>2)*4096+((i)&3)*1024)); vhi[i]=vtr(vp_+(((i)>>2)*4096+((i)&3)*1024+512)); }while(0)
  #define KRD(G,j) do{ if(G){ kload2(kf,kp0+sl_next,j); SBAR(); } }while(0)
  #define STEP(C0,C1,P0,P1,t,GK,GV,GL) do{ SBAR(); \
    const lds_cptr vp_=vp0+sl_prev; \
    BIAS(C0,C1,t); SBAR(); \
    VRD(0); SBAR(); float sacc=(P0[0]+P0[1]); \
    GAPA(C0=__builtin_amdgcn_mfma_f32_32x32x16_bf16(kf[0],qr[0],C0,0,0,0), P0[2],P0[3],P0[4],P0[5],     pw0[0]=PKW(P0,0), pw0[1]=PKW(P0,2), pw0); \
    VRD(4); SBAR(); GAPA(C1=__builtin_amdgcn_mfma_f32_32x32x16_bf16(kf[1],qr[0],C1,0,0,0), P0[6],P0[7],P0[8],P0[9],     pw0[2]=PKW(P0,4), pw0[3]=PKW(P0,6), pw0); \
    VRD(1); SBAR(); GAPA(C0=__builtin_amdgcn_mfma_f32_32x32x16_bf16(kf[2],qr[1],C0,0,0,0),   P0[10],P0[11],P0[12],P0[13], pw1[0]=PKW(P0,8), pw1[1]=PKW(P0,10), pw1); \
    VRD(5); SBAR(); GAPA(C1=__builtin_amdgcn_mfma_f32_32x32x16_bf16(kf[3],qr[1],C1,0,0,0),   P0[14],P0[15],P1[0],P1[1],   pw1[2]=PKW(P0,12),pw1[3]=PKW(P0,14), pw1); \
    VRD(2); SBAR(); GAPA(C0=__builtin_amdgcn_mfma_f32_32x32x16_bf16(kf[4],qr[2],C0,0,0,0),   P1[2],P1[3],P1[4],P1[5],     pw2[0]=PKW(P1,0), pw2[1]=PKW(P1,2), pw2); \
    VRD(6); SBAR(); GAPA(C1=__builtin_amdgcn_mfma_f32_32x32x16_bf16(kf[5],qr[2],C1,0,0,0),   P1[6],P1[7],P1[8],P1[9],     pw2[2]=PKW(P1,4), pw2[3]=PKW(P1,6), pw2); \
    VRD(3); SBAR(); GAPA(C0=__builtin_amdgcn_mfma_f32_32x32x16_bf16(kf[6],qr[3],C0,0,0,0),   P1[10],P1[11],P1[12],P1[13], pw3[0]=PKW(P1,8), pw3[1]=PKW(P1,10), pw3); \
    VRD(7); SBAR(); GAPA(C1=__builtin_amdgcn_mfma_f32_32x32x16_bf16(kf[7],qr[3],C1,0,0,0),   P1[14],P1[15],0.f,0.f,       pw3[2]=PKW(P1,12),pw3[3]=PKW(P1,14), pw3); \
    l_reg+=sacc; \
    if(GK){DMA_K((t)+3,sl_cur);} if(GV){DMA_V((t)+1,sl_next);} \
    CMASK(C0,C1,t); \
    { float a=MX3(C0[0],C0[1],C1[0]),b=MX3(C0[2],C0[3],C1[1]); a=MX3(a,C1[2],C1[3]); \
      _Pragma("unroll") for(int r=4;r<16;r+=4){a=MX3(a,C0[r],C0[r+1]);b=MX3(b,C0[r+2],C0[r+3]);a=MX3(a,C1[r],C1[r+1]);b=MX3(b,C1[r+2],C1[r+3]);} \
      float rm=__builtin_fmaxf(a,b); { auto rr=__builtin_amdgcn_permlane32_swap(__float_as_uint(rm),__float_as_uint(rm),false,false); rm=__builtin_fmaxf(__uint_as_float(rr[0]),__uint_as_float(rr[1])); } \
      resc=false; \
      if(__builtin_expect(__any(rm>(float)THRL),0)){ const float dl=__builtin_fmaxf(rm,0.f); mhat+=dl; \
        _Pragma("unroll") for(int r=0;r<16;++r){C0[r]-=dl;C1[r]-=dl;} \
        const float f=__builtin_amdgcn_exp2f(-dl); l_reg*=f; if(hi==0)wsf[r32]=f; resc=true; } } \
    SBAR(); \
    GAPB(o[0]=__builtin_amdgcn_mfma_f32_32x32x16_bf16(PAF(0),VFR(0),o[0],0,0,0), C0,0); \
    GAPB(o[1]=__builtin_amdgcn_mfma_f32_32x32x16_bf16(PAF(0),VFR(4),o[1],0,0,0), C0,4); \
    KRD(GL,0); GAPB(o[0]=__builtin_amdgcn_mfma_f32_32x32x16_bf16(PAF(1),VFR(1),o[0],0,0,0), C0,8); \
    KRD(GL,1); GAPB(o[1]=__builtin_amdgcn_mfma_f32_32x32x16_bf16(PAF(1),VFR(5),o[1],0,0,0), C0,12); \
    KRD(GL,2); GAPB(o[0]=__builtin_amdgcn_mfma_f32_32x32x16_bf16(PAF(2),VFR(2),o[0],0,0,0), C1,0); \
    KRD(GL,3); GAPB(o[1]=__builtin_amdgcn_mfma_f32_32x32x16_bf16(PAF(2),VFR(6),o[1],0,0,0), C1,4); \
    GAPB(o[0]=__builtin_amdgcn_mfma_f32_32x32x16_bf16(PAF(3),VFR(3),o[0],0,0,0), C1,8); \
    GAPB(o[1]=__builtin_amdgcn_mfma_f32_32x32x16_bf16(PAF(3),VFR(7),o[1],0,0,0), C1,12); \
    }while(0)
  int t=1;
  #undef CMASK
  #define CMASK(P0,P1,t) do{}while(0)
  for(;t+5<NT;t+=2){
    STEP(pB0,pB1,pA0,pA1,t,true,true,true);     WAIT_BAR(2); RESC(); ROT();
    STEP(pA0,pA1,pB0,pB1,t+1,true,true,true);   WAIT_BAR(2); RESC(); ROT();
  }
  #undef CMASK
  #define CMASK(P0,P1,t) do{int jb_=(t)-(NT-4); if(jb_>=0)cmask(P0,P1,jb_,qrel,hi);}while(0)
  #define ENDW(tt) do{ if((tt)+3<NT){WAIT_BAR(2);} else if((tt)+2<NT){WAIT_BAR(1);} else {WAIT_BAR(0);} }while(0)
  for(;t+1<NT;t+=2){
    STEP(pB0,pB1,pA0,pA1,t,(t+3<NT),(t+1<NT),(t+1<NT));       ENDW(t);   RESC(); ROT();
    STEP(pA0,pA1,pB0,pB1,t+1,(t+4<NT),(t+2<NT),(t+2<NT));     ENDW(t+1); RESC(); ROT();
  }
  STEP(pB0,pB1,pA0,pA1,NT-1,false,false,false); RESC();
  { float sacc=pB0[0]+pB0[1]; _Pragma("unroll") for(int r=2;r<16;++r)sacc+=pB0[r]; _Pragma("unroll") for(int r=0;r<16;++r)sacc+=pB1[r]; l_reg+=sacc;
    pw0=(u32x4){PKW(pB0,0),PKW(pB0,2),PKW(pB0,4),PKW(pB0,6)};pw1=(u32x4){PKW(pB0,8),PKW(pB0,10),PKW(pB0,12),PKW(pB0,14)};pw2=(u32x4){PKW(pB1,0),PKW(pB1,2),PKW(pB1,4),PKW(pB1,6)};pw3=(u32x4){PKW(pB1,8),PKW(pB1,10),PKW(pB1,12),PKW(pB1,14)};
    SBAR(); pv(o,vb0+sl_cur,PAF(0),PAF(1),PAF(2),PAF(3)); }
  #undef PKW
  #undef PAF
  #undef VFR
  #undef PIN
  #undef MX3
  #undef GAPA
  #undef GAPB
  #undef EX
  #undef VRD
  #undef KRD
  #undef STEP
  #undef ENDW
  {auto rr=__builtin_amdgcn_permlane32_swap(__float_as_uint(l_reg),__float_as_uint(l_reg),false,false);l_reg=__uint_as_float(rr[0])+__uint_as_float(rr[1]);}
  if(hi==0)wsf[32+r32]=l_reg;asm volatile("s_waitcnt lgkmcnt(0)":::"memory");
  float rli[16];
  #pragma unroll
  for(int r=0;r<16;++r)rli[r]=__builtin_amdgcn_rcpf(wsf[32+crow(r,hi)]);
  bf16*Ow=O+(rowbase+q0+wid*QBLK)*DMO+OCOL+h*D;
  { bf16*stg=(bf16*)(shm+LDS_OST)+wid*2048;
    #pragma unroll
    for(int r=0;r<16;++r){const int orow=crow(r,hi);
      #pragma unroll
      for(int d0=0;d0<2;++d0)stg[orow*64+d0*32+r32]=__float2bfloat16(o[d0][r]*rli[r]);}
    asm volatile("s_waitcnt lgkmcnt(0)":::"memory");
    #pragma unroll
    for(int i=0;i<4;++i){const int row=i*8+(lane>>3),ch=lane&7; const u32x4 v=*(const u32x4*)(stg+row*64+ch*8); ATTN_STORE16(Ow+(long)row*DMO+ch*8,v);} }
  asm volatile("s_waitcnt lgkmcnt(0)\n\ts_barrier":::"memory");
  #undef DMA_K
  #undef DMA_V
  #undef CMASK
  #undef START
  #undef BIAS
  #undef RESC
  #undef ROT
}
constexpr int ATTN_LDS_BYTES=LDS_BYTES;
struct AttnTensors { const bf16* Q; const bf16* K; const bf16* V; bf16* O; const float* nb; const float* qn; const float* kn; const int* t0tab; };
struct AttnUnit { int bh; int qb; };
struct StaticOrder {
  int vcu,G;
  __device__ __forceinline__ explicit StaticOrder(int grid,int block):vcu((grid%8==0)?(block%8)*(grid/8)+block/8:block),G(grid){}
  __device__ __forceinline__ bool next(int i,AttnUnit&u)const{ const int w=vcu+(i>>2)*G; if(w>=BATCH*NHEAD*8)return false; const int s=w&7,j=i&3; u.bh=((w>>3)+9*j)&31; u.qb=(j==0)?s:(j==1)?15-s:(j==2)?16+s:31-s; return true; }
  __device__ __forceinline__ void a_ready(const AttnUnit&)const{}
  __device__ __forceinline__ void done(const AttnUnit&)const{}
};
template<int THRL=8> __device__ __forceinline__ void attn_phase_dyn(char*lds,const AttnTensors&T,unsigned*ctr,volatile __attribute__((address_space(3))) unsigned*slot){
  const int tid=threadIdx.x,lane=tid&63;
  int ord=0;
  { const float myv=(lane<32)?T.nb[(long)lane*SEQ+SEQ-1]:3.0e38f; int rank=0;
    _Pragma("unroll") for(int j=0;j<32;++j){const float vj=__shfl(myv,j); rank+=(vj<myv||(vj==myv&&j<lane))?1:0;}
    _Pragma("unroll") for(int j=0;j<32;++j){const int rj=__shfl(rank,j); if(rj==lane)ord=j;} }
  if(tid==0){ const unsigned id=__hip_atomic_fetch_add(ctr,1u,__ATOMIC_RELAXED,__HIP_MEMORY_SCOPE_AGENT); *slot=id; }
  asm volatile("s_waitcnt vmcnt(0) lgkmcnt(0)\n\ts_barrier":::"memory");
  for(;;){
    const unsigned uid=*slot;
    if(uid>=(unsigned)(BATCH*NHEAD*NQB))break;
    unsigned nxt=0u; if(tid==0)nxt=__hip_atomic_fetch_add(ctr,1u,__ATOMIC_RELAXED,__HIP_MEMORY_SCOPE_AGENT);
    const int bh=__builtin_amdgcn_readfirstlane(__shfl(ord,(int)(uid>>5))), qb=NQB-1-(int)(uid&31u);
    const int t0=__builtin_amdgcn_readfirstlane(T.t0tab[bh*NQB+qb]);
    attn_unit<THRL>(bh/NHEAD,bh%NHEAD,qb,T.Q,T.K,T.V,T.O,T.nb+(long)bh*SEQ,t0,lds);
    if(tid==0)*slot=nxt;
    asm volatile("s_waitcnt vmcnt(0) lgkmcnt(0)\n\ts_barrier":::"memory");
  }
}
#undef SBAR
#undef WAIT_BAR
}
#define GAS __attribute__((address_space(1)))
#define LAS __attribute__((address_space(3)))
typedef unsigned short bf16;
typedef unsigned v4u __attribute__((ext_vector_type(4)));
typedef float f32x4 __attribute__((ext_vector_type(4)));
typedef short bf16x8 __attribute__((ext_vector_type(8)));
typedef GAS unsigned gu32;
typedef GAS unsigned long long gu64;
#define RLX_AGENT __ATOMIC_RELAXED, __HIP_MEMORY_SCOPE_AGENT
#define LDS_WAIT() asm volatile("s_waitcnt lgkmcnt(0)" ::: "memory")
#define VM_WAIT() asm volatile("s_waitcnt vmcnt(0)" ::: "memory")
__device__ __forceinline__ unsigned long long rt() { return __builtin_amdgcn_s_memrealtime(); }
typedef float f32x2_pk __attribute__((ext_vector_type(2))); typedef __bf16 bf16x2_pk __attribute__((ext_vector_type(2)));
__device__ __forceinline__ unsigned pk2(float lo, float hi) { f32x2_pk v = {lo, hi}; bf16x2_pk r = __builtin_convertvector(v, bf16x2_pk); return __builtin_bit_cast(unsigned, r); }
__device__ __forceinline__ unsigned f2bf(float f) { return pk2(f, 0.f) & 0xffffu; }

#define XB_TMO      128
#define XB_XCNT(j)  (256  + 64 * (j))
#define XB_XSUB(j)  (1280 + 64 * (j))
#define XB_XGEN(j)  (2304 + 64 * (j))
#define XB_TOP      3328
#define XB_TOPGEN   3392
#define XCD_BAR_WORDS 3456
#define XB_SPIN_CAP (1u << 18)

__device__ __forceinline__ unsigned xb_ld(unsigned* p)              { return __hip_atomic_load(p, __ATOMIC_RELAXED, __HIP_MEMORY_SCOPE_AGENT); }
__device__ __forceinline__ unsigned xb_add(unsigned* p, unsigned v) { return __hip_atomic_fetch_add(p, v, __ATOMIC_RELAXED, __HIP_MEMORY_SCOPE_AGENT); }
__device__ __forceinline__ unsigned xb_xcc_id() { return (unsigned)__builtin_amdgcn_s_getreg((3 << 11) | 20) & 0xFu; }
#define XB_SPIN(cond, bar) do { unsigned _sp = 0; while (cond) { __builtin_amdgcn_s_sleep(1); \
    if ((++_sp & 255u) == 0u) { if (xb_ld(&(bar)[XB_TMO])) break; if (_sp > XB_SPIN_CAP) { atomicAdd(&(bar)[XB_TMO], 1u); break; } } } } while (0)

struct XcdBarrier {
    unsigned* bar; unsigned x;
    volatile LAS unsigned* st;
};

__device__ __forceinline__ XcdBarrier xcd_barrier_post(unsigned* bar, volatile LAS unsigned* st) {
    XcdBarrier b; b.bar = bar; b.x = xb_xcc_id(); b.st = st;
    if (threadIdx.x == 0) (void)xb_add(&bar[XB_XCNT(b.x)], 1u);
    return b;
}
__device__ __forceinline__ void xcd_barrier_complete(unsigned* bar, unsigned x, unsigned& nloc, unsigned& nx) {
    const unsigned G = gridDim.x * gridDim.y * gridDim.z;
    unsigned sum, cnt, mine, sp = 0u;
    for (;;) {
        sum = 0u; cnt = 0u; mine = 0u;
#pragma unroll
        for (unsigned j = 0; j < 16; ++j) { const unsigned c = xb_ld(&bar[XB_XCNT(j)]); sum += c; cnt += (c > 0u) ? 1u : 0u; mine = (j == x) ? c : mine; }
        if (sum == G) break;
        __builtin_amdgcn_s_sleep(1);
        if ((++sp & 255u) == 0u) { if (xb_ld(&bar[XB_TMO])) break; if (sp > XB_SPIN_CAP) { atomicAdd(&bar[XB_TMO], 1u); break; } }
    }
    nloc = mine > 0u ? mine : 1u; nx = cnt > 0u ? cnt : 1u;
}

__device__ __forceinline__ void xcd_barrier(const XcdBarrier& b) {
    asm volatile("s_waitcnt vmcnt(0)" ::: "memory");
    __syncthreads();
    if (threadIdx.x == 0) {
        unsigned* bar = b.bar;
        __builtin_amdgcn_s_waitcnt(0);
        unsigned nloc = b.st[0], nx = b.st[1];
        if (nloc == 0u) { xcd_barrier_complete(bar, b.x, nloc, nx); b.st[0] = nloc; b.st[1] = nx; }
        const unsigned old = xb_add(&bar[XB_XSUB(b.x)], 1u);
        const unsigned gen = old / nloc;
        if (old + 1u == (gen + 1u) * nloc) {
            __builtin_amdgcn_fence(__ATOMIC_RELEASE, "agent");
            asm volatile("s_waitcnt vmcnt(0)" ::: "memory");
            const unsigned og = xb_add(&bar[XB_TOP], 1u);
            const unsigned tg = og / nx;
            if (og + 1u == (tg + 1u) * nx) xb_add(&bar[XB_TOPGEN], 1u);
            else XB_SPIN(xb_ld(&bar[XB_TOPGEN]) == tg, bar);
            __builtin_amdgcn_fence(__ATOMIC_ACQUIRE, "agent");
            xb_add(&bar[XB_XGEN(b.x)], 1u);
            asm volatile("s_waitcnt vmcnt(0)" ::: "memory");
        } else {
            XB_SPIN(xb_ld(&bar[XB_XGEN(b.x)]) == gen, bar);
            __builtin_amdgcn_fence(__ATOMIC_ACQUIRE, "agent");
            asm volatile("s_waitcnt vmcnt(0)" ::: "memory");
        }
    }
    __syncthreads();
}

constexpr int NWAVES = 8;
constexpr int BATCH = 4, SEQ = 8192, D = 1024, M = BATCH * SEQ;
constexpr int IN_W = 7184, NGW = 4096, NGT = 3072, NSLAB = 8;
constexpr int SL_POOL = 0, SL_MQ = 1, SL_MK = 2, SL_MV = 3, SL_MO = 4, SL_FQ = 5, SL_FK = 6, SL_FV = 7;
constexpr int ML_H = 4, ML_DH = 128, CHUNK = 64, NCH = SEQ / CHUNK;
constexpr int FX_H = 8;
constexpr int DFF = 2816, NEXP = 8, DFE = 3584;
constexpr float NORM_EPS = 1e-6f;
constexpr int KCAT = 1536;
constexpr int MOE_KROWS = 34816;
constexpr int MOE_KTILES = MOE_KROWS / 256;
constexpr int TOKBLK = 128, NTOKBLK = M / TOKBLK;

constexpr size_t MiB = 1u << 20;
constexpr size_t WS_CTL = 0, CTL_ZERO_BYTES = 1 * MiB;
constexpr size_t WS_W = 1 * MiB;
constexpr size_t W_LAYER = 19 * MiB, W_NG = 0, W_GT = 8 * MiB, W_CAT = 14 * MiB, W_OUT = 17 * MiB;
constexpr size_t WS_WGU = WS_W + 2 * W_LAYER, WS_WDN = WS_WGU + 11 * MiB;
constexpr size_t WS_NG = 56 * MiB, SLAB_BYTES = (size_t)M * 512 * 2;
constexpr size_t WS_GATE = WS_NG + SLAB_BYTES;
constexpr size_t WS_ACT0 = WS_NG;
constexpr size_t WS_HB = 312 * MiB;
constexpr size_t WS_CAT = 376 * MiB;
constexpr size_t WS_MLC = 472 * MiB;
constexpr size_t WS_MOEGU = 1 * MiB;
constexpr size_t WS_MOEDN = 57 * MiB;
constexpr size_t WS_XS = 85 * MiB;
constexpr size_t WS_Y0 = 153 * MiB, WS_Y1 = 217 * MiB;
constexpr size_t WS_ACT1 = 305 * MiB;
constexpr size_t WS_SM = 544 * MiB;
constexpr size_t SM_GATE16 = 0;
constexpr size_t SM_MLB = 2 * MiB, SM_MLA = SM_MLB + 512 * 1024, SM_MLMX = SM_MLA + 512 * 1024;
constexpr size_t SM_FNB = SM_MLMX + 512 * 1024;
constexpr size_t SM_MLN = SM_FNB + 1 * MiB;
constexpr size_t SM_MLM = SM_MLN + 1 * MiB;
constexpr size_t SM_MLDEC = SM_MLM + 16 * 132 * 4;
constexpr size_t SM_FQN = SM_MLDEC + 16 * 128 * 4, SM_FKN = SM_FQN + 32768, SM_FT0 = SM_FKN + 32768, SM_MLBG = SM_FT0 + 4096, SM_FXM = SM_MLBG + 16384;
constexpr size_t SM_MOE = 6 * MiB;
constexpr size_t MO_RSTD = 0, MO_TOKE = MO_RSTD + (size_t)M * 4, MO_TOKG = MO_TOKE + (size_t)M * 8, MO_HIST = MO_TOKG + (size_t)M * 8,
                 MO_ROWTOK = MO_HIST + (size_t)NTOKBLK * 16 * 4, MO_ROWG = MO_ROWTOK + (size_t)2 * MOE_KROWS * 4, MO_TILEE = MO_ROWG + (size_t)2 * MOE_KROWS * 4, MO_NT = MO_TILEE + 2 * MOE_KTILES * 4, MO_END = MO_NT + 64;
static_assert(SM_MOE + MO_END <= 8 * MiB, "small arrays");
constexpr size_t WS_END = 552 * MiB;
static_assert(WS_WDN + (size_t)DFF * D * 2 <= WS_NG && WS_NG + NSLAB * SLAB_BYTES <= WS_HB && WS_HB + (size_t)M * D * 2 <= WS_CAT && WS_CAT + (size_t)M * KCAT * 2 <= WS_MLC && WS_MLC + 64 * MiB <= WS_SM, "d_ws map");
static_assert(WS_MOEGU + (size_t)NEXP * 2 * DFE * D <= WS_MOEDN && WS_MOEDN + (size_t)NEXP * D * DFE <= WS_XS && WS_XS + (size_t)2 * MOE_KROWS * D <= WS_Y0 && WS_Y0 + (size_t)M * D * 2 <= WS_Y1 && WS_Y1 + (size_t)M * D * 2 <= WS_ACT1 && WS_ACT1 + (size_t)2 * MOE_KROWS * DFE <= WS_SM, "d_ws map (MoE)");
constexpr int CW_TMO = 0, CW_CODE = 1, CW_BAR = 4096;

constexpr int RING_OFF = 0, RING_BYTES = 131072;
constexpr int LDSCTL_OFF = RING_BYTES, MISC_OFF = LDSCTL_OFF + 320;
constexpr int LDS_BYTES = 147456;
static_assert(MISC_OFF + 128 <= LDS_BYTES, "LDS map");

struct Frame {
    LAS unsigned char* lds;
    volatile LAS unsigned* MISC;
    gu32* ctl;
    int tid, lane, wave;
    int vcu, G, blk;
    unsigned char* ws;
    const float* const* in; float* out; int zi;
};
#define INP(F, i) ((F).in[(i) + (F).zi])
enum { IN_X = 0, IN_MIXG, IN_WIN, IN_POOLW, IN_POOLS, IN_CONVW, IN_MLBI, IN_MLBF, IN_MLNG, IN_FXBF, IN_WBRP, IN_WBRM, IN_WBRF, IN_WOUT, IN_FFNG, IN_FFG, IN_FFU, IN_FFD, IN_RW, IN_RB, IN_MOEG, IN_MOEU, IN_MOED, IN_FING };

__device__ __forceinline__ float wave_sum(float v) {
#pragma unroll
    for (int o = 1; o < 64; o <<= 1) v += __shfl_xor(v, o);
    return v;
}
__device__ __forceinline__ float wave_max(float v) {
#pragma unroll
    for (int o = 1; o < 64; o <<= 1) v = fmaxf(v, __shfl_xor(v, o));
    return v;
}
__device__ __forceinline__ float sigmoid_f(float x) { return __builtin_amdgcn_rcpf(1.f + __builtin_amdgcn_exp2f(-1.4426950408889634f * x)); }
__device__ __forceinline__ float logsigmoid_f(float x) { return fminf(x, 0.f) - log1pf(expf(-fabsf(x))); }

__device__ __forceinline__ void tr_item(const float* W, int ldw, int srccol0, const float* gain, bf16* WT, int ldt, int drow0, int dcol0, int k0, LAS float* scr, int lane) {
    (void)scr;
    const int ng = lane & 7, kg = lane >> 3;
    f32x4 v[8];
#pragma unroll
    for (int i = 0; i < 8; ++i) v[i] = *(const GAS f32x4*)(W + (size_t)(k0 + 8 * kg + i) * ldw + srccol0 + 4 * ng);
    if (gain) { const f32x4 g0 = *(const GAS f32x4*)(gain + k0 + 8 * kg), g1 = *(const GAS f32x4*)(gain + k0 + 8 * kg + 4);
#pragma unroll
        for (int i = 0; i < 4; ++i) { v[i] = v[i] * g0[i]; v[4 + i] = v[4 + i] * g1[i]; } }
#pragma unroll
    for (int j = 0; j < 4; ++j) { v4u o; o.x = pk2(v[0][j], v[1][j]); o.y = pk2(v[2][j], v[3][j]); o.z = pk2(v[4][j], v[5][j]); o.w = pk2(v[6][j], v[7][j]);
        *(GAS v4u*)(WT + (size_t)(drow0 + 4 * ng + j) * ldt + dcol0 + k0 + 8 * kg) = o; }
}
__device__ __forceinline__ void tr_item_fp8(const float* W, int ldw, int srccol0, const float* gain, float scale, unsigned char* WT8, int ldt, int drow0, int k0, int lane) {
    const int ng = lane & 7, kg = lane >> 3;
    f32x4 v[8];
#pragma unroll
    for (int i = 0; i < 8; ++i) v[i] = *(const GAS f32x4*)(W + (size_t)(k0 + 8 * kg + i) * ldw + srccol0 + 4 * ng);
    f32x4 g0 = (f32x4){scale, scale, scale, scale}, g1 = g0;
    if (gain) { g0 = *(const GAS f32x4*)(gain + k0 + 8 * kg) * scale; g1 = *(const GAS f32x4*)(gain + k0 + 8 * kg + 4) * scale; }
#pragma unroll
    for (int i = 0; i < 4; ++i) { v[i] = v[i] * g0[i]; v[4 + i] = v[4 + i] * g1[i]; }
    typedef unsigned u32x2_t __attribute__((ext_vector_type(2)));
#pragma unroll
    for (int j = 0; j < 4; ++j) { u32x2_t o; o.x = pg8::pack_fp8x4(v[0][j], v[1][j], v[2][j], v[3][j]); o.y = pg8::pack_fp8x4(v[4][j], v[5][j], v[6][j], v[7][j]);
        *(GAS u32x2_t*)(WT8 + (size_t)(drow0 + 4 * ng + j) * ldt + k0 + 8 * kg) = o; }
}
constexpr float FP8_ASCALE = 16.f, FP8_WSCALE = 256.f;
constexpr int CI_NG = 2048, CI_GT = 1536, CI_BR = 256, CI_OUT = 512, CI_LAYER = CI_NG + CI_GT + 2 * CI_BR + CI_OUT, CI_GU = 2816, CI_DN = 1408, CI_MAIN = 2 * CI_LAYER + CI_GU + CI_DN;
__device__ __forceinline__ void conv_item_main(Frame& F, int it, LAS float* scr) {
    if (it < 2 * CI_LAYER) {
        const int l = it / CI_LAYER; int r = it % CI_LAYER; bf16* wl = (bf16*)(F.ws + WS_W + (size_t)l * W_LAYER);
        const float* g = INP(F, IN_MIXG) + l * D; const float* win = INP(F, IN_WIN) + (size_t)l * D * IN_W;
        if (r < CI_NG) { const int nb = r >> 4, kb = r & 15; tr_item(win, IN_W, nb * 32 + (nb * 32 >= 2560 ? 8 : 0), g, wl + W_NG / 2, D, nb * 32, 0, kb * 64, scr, F.lane); return; } r -= CI_NG;
        if (r < CI_GT) { const int nb = r >> 4, kb = r & 15; tr_item_fp8(win, IN_W, 4112 + nb * 32, g, FP8_WSCALE, (unsigned char*)wl + W_GT, D, nb * 32, kb * 64, F.lane); return; } r -= CI_GT;
        if (r < CI_BR) { const int nb = r >> 3, kb = r & 7; tr_item(INP(F, IN_WBRM) + (size_t)l * 512 * D, D, nb * 32, nullptr, wl + W_CAT / 2, KCAT, nb * 32, 512, kb * 64, scr, F.lane); return; } r -= CI_BR;
        if (r < CI_BR) { const int nb = r >> 3, kb = r & 7; tr_item(INP(F, IN_WBRF) + (size_t)l * 512 * D, D, nb * 32, nullptr, wl + W_CAT / 2, KCAT, nb * 32, 1024, kb * 64, scr, F.lane); return; } r -= CI_BR;
        { const int nb = r >> 4, kb = r & 15; tr_item(INP(F, IN_WOUT) + (size_t)l * D * D, D, nb * 32, nullptr, wl + W_OUT / 2, D, nb * 32, 0, kb * 64, scr, F.lane); }
        return;
    }
    it -= 2 * CI_LAYER;
    if (it < CI_GU) { const int nb = it >> 4, kb = it & 15, p = nb >> 3, w = nb & 7;
        tr_item(w < 4 ? INP(F, IN_FFG) : INP(F, IN_FFU), DFF, 128 * p + (w & 3) * 32, INP(F, IN_FFNG), (bf16*)(F.ws + WS_WGU), D, nb * 32, 0, kb * 64, scr, F.lane); return; }
    it -= CI_GU;
    { const int kb = it >> 5, nb = it & 31; tr_item(INP(F, IN_FFD), D, nb * 32, nullptr, (bf16*)(F.ws + WS_WDN), DFF, nb * 32, 0, kb * 64, scr, F.lane); }
}
constexpr int CI_MGU = 3584, CI_MDN = 1792, CI_MEXP = CI_MGU + CI_MDN, CI_MOE = NEXP * CI_MEXP;
__device__ __forceinline__ void conv_item_moe(Frame& F, int it, LAS float* scr) {
    (void)scr;
    const int e = it / CI_MEXP; int r = it % CI_MEXP;
    if (r < CI_MGU) { const int nb = r % 224, kb = r / 224, p = nb >> 3, w = nb & 7;
        tr_item_fp8((w < 4 ? INP(F, IN_MOEG) : INP(F, IN_MOEU)) + (size_t)e * D * DFE, DFE, 128 * p + (w & 3) * 32, INP(F, IN_FFNG) + D, FP8_WSCALE, F.ws + WS_MOEGU + (size_t)e * 2 * DFE * D, D, nb * 32, kb * 64, F.lane); return; }
    r -= CI_MGU;
    { const int kb = r >> 5, nb = r & 31; tr_item_fp8(INP(F, IN_MOED) + (size_t)e * DFE * D, D, nb * 32, nullptr, FP8_WSCALE, F.ws + WS_MOEDN + (size_t)e * D * DFE, DFE, nb * 32, kb * 64, F.lane); }
}
__device__ __forceinline__ void pool_fold(Frame& F) {
    const int gt = F.blk * (NWAVES * 64) + F.tid, NT = F.G * NWAVES * 64;
    for (int o = gt; o < 2 * 4 * 16 * D; o += NT) {
        const int n = o & (D - 1), cb = __builtin_amdgcn_readfirstlane(o >> 10), l = cb >> 6, g = (cb >> 4) & 3, c0 = (cb & 15) * 8;
        const float* wg = INP(F, IN_POOLW) + (size_t)l * 4 * 128 * 128 + (size_t)(g * 128 + c0) * 128; const float* sc = INP(F, IN_POOLS) + l * 512 + g * 128; const float* wb = INP(F, IN_WBRP) + (size_t)l * 512 * D + (size_t)(g * 128) * D + n;
        float a[8];
#pragma unroll
        for (int i = 0; i < 8; ++i) a[i] = 0.f;
#pragma unroll 8
        for (int dd = 0; dd < 128; ++dd) { const float t = sc[dd] * wb[(size_t)dd * D];
#pragma unroll
            for (int i = 0; i < 8; ++i) a[i] += wg[i * 128 + dd] * t; }
        v4u w; w.x = pk2(a[0], a[1]); w.y = pk2(a[2], a[3]); w.z = pk2(a[4], a[5]); w.w = pk2(a[6], a[7]);
        *(GAS v4u*)((bf16*)(F.ws + WS_W + (size_t)l * W_LAYER + W_CAT) + (size_t)n * KCAT + g * 128 + c0) = w;
    }
}

template <bool XB> __device__ __forceinline__ void load_xrow(const void* x, size_t m, int lane, f32x4 (&v)[4]) {
    if constexpr (XB) { typedef unsigned u32x2_t __attribute__((ext_vector_type(2))); const GAS u32x2_t* xr = (const GAS u32x2_t*)((const bf16*)x + m * D) + lane;
#pragma unroll
        for (int j = 0; j < 4; ++j) { const u32x2_t q = xr[64 * j]; v[j] = (f32x4){__uint_as_float(q.x << 16), __uint_as_float(q.x & 0xffff0000u), __uint_as_float(q.y << 16), __uint_as_float(q.y & 0xffff0000u)}; } }
    else { const GAS f32x4* xr = (const GAS f32x4*)((const float*)x + m * D) + lane;
#pragma unroll
        for (int j = 0; j < 4; ++j) v[j] = xr[64 * j]; }
}
template <bool XB> __device__ __forceinline__ void phase_norm_mix(Frame& F, const void* x, int l) {
    LAS float* w16 = (LAS float*)(F.lds);
    const float* g = INP(F, IN_MIXG) + l * D; const float* win = INP(F, IN_WIN) + (size_t)l * D * IN_W;
    for (int idx = F.tid; idx < 16 * D; idx += NWAVES * 64) { const int k = idx >> 4, j = idx & 15, col = j < 8 ? 2560 + j : 4104 + (j - 8); w16[j * D + k] = g[k] * win[(size_t)k * IN_W + col]; }
    __syncthreads();
    bf16* HB = (bf16*)(F.ws + WS_HB); float* gate16 = (float*)(F.ws + WS_SM + SM_GATE16);
    const int gw = F.vcu * NWAVES + F.wave, NGWV = F.G * NWAVES;
    f32x4 nv[4]; if (gw < M) load_xrow<XB>(x, (size_t)gw, F.lane, nv);
    for (int m = gw; m < M; m += NGWV) {
        f32x4 v[4]; float ss = 0.f;
#pragma unroll
        for (int j = 0; j < 4; ++j) v[j] = nv[j];
        if (m + NGWV < M) load_xrow<XB>(x, (size_t)(m + NGWV), F.lane, nv);
#pragma unroll
        for (int j = 0; j < 4; ++j) ss += (v[j].x * v[j].x + v[j].y * v[j].y) + (v[j].z * v[j].z + v[j].w * v[j].w);
        const float rstd = 1.f / sqrtf(wave_sum(ss) * (1.f / D) + NORM_EPS);
        GAS unsigned long long* o8 = (GAS unsigned long long*)(HB + (size_t)m * D) + F.lane;
#pragma unroll
        for (int j = 0; j < 4; ++j) o8[64 * j] = (unsigned long long)pk2(v[j].x * rstd, v[j].y * rstd) | ((unsigned long long)pk2(v[j].z * rstd, v[j].w * rstd) << 32);
        float pp[16];
#pragma unroll
        for (int jj = 0; jj < 16; ++jj) { float p = 0.f;
#pragma unroll
            for (int j = 0; j < 4; ++j) { const f32x4 wv = *(const LAS f32x4*)(w16 + jj * D + 256 * j + 4 * F.lane); p += (v[j].x * wv.x + v[j].y * wv.y) + (v[j].z * wv.z + v[j].w * wv.w); }
            pp[jj] = p; if ((jj & 3) == 3) asm volatile("" ::: "memory"); }
#define TB_STAGE(ST, N) { const bool up = (F.lane >> (ST)) & 1; _Pragma("unroll") for (int i = 0; i < (N); ++i) { const float mine = up ? pp[2 * i + 1] : pp[2 * i], give = up ? pp[2 * i] : pp[2 * i + 1]; pp[i] = mine + __shfl_xor(give, 1 << (ST)); } }
        TB_STAGE(0, 8) TB_STAGE(1, 4) TB_STAGE(2, 2) TB_STAGE(3, 1)
        float keep = pp[0]; keep += __shfl_xor(keep, 16); keep += __shfl_xor(keep, 32); keep *= rstd;
        if (F.lane < 16) gate16[(size_t)m * 16 + F.lane] = keep;
    }
    __syncthreads();
}
__device__ __forceinline__ void phase_norm_ffn(Frame& F, const bf16* x) {
    bf16* HB = (bf16*)(F.ws + WS_HB);
    const int gw = F.vcu * NWAVES + F.wave, NGWV = F.G * NWAVES;
    f32x4 nv[4]; if (gw < M) load_xrow<true>(x, (size_t)gw, F.lane, nv);
    for (int m = gw; m < M; m += NGWV) {
        f32x4 v[4]; float ss = 0.f;
#pragma unroll
        for (int j = 0; j < 4; ++j) v[j] = nv[j];
        if (m + NGWV < M) load_xrow<true>(x, (size_t)(m + NGWV), F.lane, nv);
#pragma unroll
        for (int j = 0; j < 4; ++j) ss += (v[j].x * v[j].x + v[j].y * v[j].y) + (v[j].z * v[j].z + v[j].w * v[j].w);
        const float rstd = 1.f / sqrtf(wave_sum(ss) * (1.f / D) + NORM_EPS);
        GAS unsigned long long* o8 = (GAS unsigned long long*)(HB + (size_t)m * D) + F.lane;
#pragma unroll
        for (int j = 0; j < 4; ++j) o8[64 * j] = (unsigned long long)pk2(v[j].x * rstd, v[j].y * rstd) | ((unsigned long long)pk2(v[j].z * rstd, v[j].w * rstd) << 32);
    }
}
__device__ __forceinline__ void quant_rows_fp8(Frame& F, const bf16* src, unsigned char* dst) {
    const int gw = F.vcu * NWAVES + F.wave, NGWV = F.G * NWAVES;
    for (int m = gw; m < M; m += NGWV) {
        const v4u a = *((const GAS v4u*)(src + (size_t)m * D) + F.lane), b = *((const GAS v4u*)(src + (size_t)m * D) + 64 + F.lane);
        typedef unsigned u32x2_t __attribute__((ext_vector_type(2)));
        u32x2_t o0, o1; const float s = FP8_ASCALE;
        o0.x = pg8::pack_fp8x4(__uint_as_float(a.x << 16) * s, __uint_as_float(a.x & 0xffff0000u) * s, __uint_as_float(a.y << 16) * s, __uint_as_float(a.y & 0xffff0000u) * s);
        o0.y = pg8::pack_fp8x4(__uint_as_float(a.z << 16) * s, __uint_as_float(a.z & 0xffff0000u) * s, __uint_as_float(a.w << 16) * s, __uint_as_float(a.w & 0xffff0000u) * s);
        o1.x = pg8::pack_fp8x4(__uint_as_float(b.x << 16) * s, __uint_as_float(b.x & 0xffff0000u) * s, __uint_as_float(b.y << 16) * s, __uint_as_float(b.y & 0xffff0000u) * s);
        o1.y = pg8::pack_fp8x4(__uint_as_float(b.z << 16) * s, __uint_as_float(b.z & 0xffff0000u) * s, __uint_as_float(b.w << 16) * s, __uint_as_float(b.w & 0xffff0000u) * s);
        *((GAS u32x2_t*)(dst + (size_t)m * D) + F.lane) = o0; *((GAS u32x2_t*)(dst + (size_t)m * D) + 64 + F.lane) = o1;
    }
}
__device__ __forceinline__ void phase_norm_final(Frame& F, const bf16* xb, float* out, float* tmp) {
    const GAS f32x4* gp = (const GAS f32x4*)INP(F, IN_FING) + F.lane; f32x4 gv[4];
#pragma unroll
    for (int j = 0; j < 4; ++j) gv[j] = gp[64 * j];
    const bf16* Y0 = (const bf16*)(F.ws + WS_Y0); const bf16* Y1 = (const bf16*)(F.ws + WS_Y1);
    const int gw = F.vcu * NWAVES + F.wave, NGWV = F.G * NWAVES;
    f32x4 nv[4], na[4], nb_[4]; if (gw < M) { load_xrow<true>(xb, (size_t)gw, F.lane, nv); load_xrow<true>(Y0, (size_t)gw, F.lane, na); load_xrow<true>(Y1, (size_t)gw, F.lane, nb_); }
    for (int m = gw; m < M; m += NGWV) {
        f32x4 v[4]; float ss = 0.f;
#pragma unroll
        for (int j = 0; j < 4; ++j) v[j] = nv[j] + (na[j] + nb_[j]);
        if (m + NGWV < M) { load_xrow<true>(xb, (size_t)(m + NGWV), F.lane, nv); load_xrow<true>(Y0, (size_t)(m + NGWV), F.lane, na); load_xrow<true>(Y1, (size_t)(m + NGWV), F.lane, nb_); }
#pragma unroll
        for (int j = 0; j < 4; ++j) ss += (v[j].x * v[j].x + v[j].y * v[j].y) + (v[j].z * v[j].z + v[j].w * v[j].w);
        const float rstd = 1.f / sqrtf(wave_sum(ss) * (1.f / D) + NORM_EPS);
        GAS f32x4* o = (GAS f32x4*)((m < M / 2 ? out + (size_t)m * D : tmp + (size_t)(m - M / 2) * D)) + F.lane;
#pragma unroll
        for (int j = 0; j < 4; ++j) o[64 * j] = v[j] * rstd * gv[j];
    }
}
__device__ __forceinline__ void phase_copy_upper(Frame& F, const float* tmp, float* out) {
    const size_t n4 = (size_t)(M / 2) * D / 4; const GAS f32x4* s = (const GAS f32x4*)tmp; GAS f32x4* d = (GAS f32x4*)(out + (size_t)(M / 2) * D);
    for (size_t i = (size_t)F.vcu * (NWAVES * 64) + F.tid; i < n4; i += (size_t)F.G * NWAVES * 64) d[i] = s[i];
}

__device__ __forceinline__ void phase_route1(Frame& F, const bf16* x) {
    LAS float* w8 = (LAS float*)(F.lds);
    LAS int* hist = (LAS int*)(F.lds + 32768);
    const float* g = INP(F, IN_FFNG) + D; const float* rw = INP(F, IN_RW);
    for (int idx = F.tid; idx < 8 * D; idx += NWAVES * 64) { const int k = idx >> 3, e = idx & 7; w8[e * D + k] = g[k] * rw[(size_t)k * 8 + e]; }
    unsigned char* sm = F.ws + WS_SM + SM_MOE;
    float* rstd_g = (float*)(sm + MO_RSTD); int* tok_e = (int*)(sm + MO_TOKE); float* tok_g = (float*)(sm + MO_TOKG); int* hist_g = (int*)(sm + MO_HIST);
    for (int blk = F.blk; blk < NTOKBLK; blk += F.G) {
        if (F.tid < 16) hist[F.tid] = 0;
        __syncthreads();
        f32x4 nv[4]; load_xrow<true>(x, (size_t)(blk * TOKBLK + F.wave * (TOKBLK / NWAVES)), F.lane, nv);
        for (int i = 0; i < TOKBLK / NWAVES; ++i) {
            const int m = blk * TOKBLK + F.wave * (TOKBLK / NWAVES) + i;
            f32x4 v[4]; float ss = 0.f;
#pragma unroll
            for (int j = 0; j < 4; ++j) v[j] = nv[j];
            if (i + 1 < TOKBLK / NWAVES) load_xrow<true>(x, (size_t)(m + 1), F.lane, nv);
#pragma unroll
            for (int j = 0; j < 4; ++j) ss += (v[j].x * v[j].x + v[j].y * v[j].y) + (v[j].z * v[j].z + v[j].w * v[j].w);
            const float rstd = 1.f / sqrtf(wave_sum(ss) * (1.f / D) + NORM_EPS);
            float pp[8];
#pragma unroll
            for (int e = 0; e < 8; ++e) { float p = 0.f;
#pragma unroll
                for (int j = 0; j < 4; ++j) { const f32x4 wv = *(const LAS f32x4*)(w8 + e * D + 256 * j + 4 * F.lane); p += (v[j].x * wv.x + v[j].y * wv.y) + (v[j].z * wv.z + v[j].w * wv.w); }
                pp[e] = p; }
            TB_STAGE(0, 4) TB_STAGE(1, 2) TB_STAGE(2, 1)
            float tot = pp[0]; tot += __shfl_xor(tot, 8); tot += __shfl_xor(tot, 16); tot += __shfl_xor(tot, 32);
            float lg[8];
#pragma unroll
            for (int e = 0; e < 8; ++e) lg[e] = __shfl(tot, e) * rstd + INP(F, IN_RB)[e];
            if (F.lane == 0) {
                int e0 = 0; float v0 = lg[0];
#pragma unroll
                for (int e = 1; e < 8; ++e) if (lg[e] > v0) { v0 = lg[e]; e0 = e; }
                int e1 = -1; float v1 = -INFINITY;
#pragma unroll
                for (int e = 0; e < 8; ++e) if (e != e0 && lg[e] > v1) { v1 = lg[e]; e1 = e; }
                const float t = __expf(v1 - v0), g0 = 1.f / (1.f + t), g1 = t * g0;
                rstd_g[m] = rstd; tok_e[2 * m] = e0; tok_e[2 * m + 1] = e1; tok_g[2 * m] = g0; tok_g[2 * m + 1] = g1;
                atomicAdd((int*)&hist[e0], 1); atomicAdd((int*)&hist[8 + e1], 1);
            }
        }
        __syncthreads();
        if (F.tid < 16) hist_g[blk * 16 + F.tid] = hist[F.tid];
        __syncthreads();
    }
}
__device__ __forceinline__ void phase_route2(Frame& F, const bf16* x) {
    LAS int* H = (LAS int*)(F.lds);
    LAS int* tot = (LAS int*)(F.lds + 16384); LAS int* pre = tot + 16; LAS int* start = tot + 32; LAS int* dest = tot + 64; LAS int* te = tot + 320;
    unsigned char* sm = F.ws + WS_SM + SM_MOE;
    const float* rstd_g = (const float*)(sm + MO_RSTD); const int* tok_e = (const int*)(sm + MO_TOKE); const float* tok_g = (const float*)(sm + MO_TOKG); const int* hist_g = (const int*)(sm + MO_HIST);
    int* row_tok = (int*)(sm + MO_ROWTOK); float* row_g = (float*)(sm + MO_ROWG); int* tile_e = (int*)(sm + MO_TILEE); int* ntl = (int*)(sm + MO_NT);
    unsigned char* XS = F.ws + WS_XS;
    for (int blk = F.blk; blk < NTOKBLK; blk += F.G) {
        for (int i = F.tid; i < NTOKBLK * 16; i += NWAVES * 64) H[i] = hist_g[i];
        __syncthreads();
        if (F.tid < 16) { int t = 0, p = 0; for (int b = 0; b < NTOKBLK; ++b) { const int h = H[b * 16 + F.tid]; if (b < blk) p += h; t += h; } tot[F.tid] = t; pre[F.tid] = p; }
        __syncthreads();
        if (F.tid == 0) { for (int k = 0; k < 2; ++k) { int run = 0; for (int e = 0; e < 8; ++e) { start[k * 8 + e] = run; run += ((tot[k * 8 + e] + 255) >> 8) << 8; } if (blk == 0) ntl[k] = run >> 8; } }
        __syncthreads();
        if (F.tid < 2 * TOKBLK) te[F.tid] = tok_e[2 * blk * TOKBLK + F.tid];
        __syncthreads();
        if (F.tid < 16) { const int k = F.tid >> 3, e = F.tid & 7; int cnt = 0; const int base = k * MOE_KROWS + start[F.tid] + pre[F.tid];
            for (int i = 0; i < TOKBLK; ++i) if (te[2 * i + k] == e) { dest[2 * i + k] = base + cnt; ++cnt; }
            if (blk == 0) { const int s0 = start[F.tid], t0 = tot[F.tid], pe = ((t0 + 255) >> 8) << 8;
                for (int tI = s0 >> 8; tI < (s0 + pe) >> 8; ++tI) tile_e[k * MOE_KTILES + tI] = e;
                for (int r = s0 + t0; r < s0 + pe; ++r) { row_tok[k * MOE_KROWS + r] = -1; row_g[k * MOE_KROWS + r] = 0.f; } } }
        __syncthreads();
        for (int i0 = 0; i0 < TOKBLK / NWAVES; i0 += 4) {
            f32x4 xv[4][4]; float rs[4]; float tg[4][2];
#pragma unroll
            for (int q = 0; q < 4; ++q) { const int m = blk * TOKBLK + F.wave * (TOKBLK / NWAVES) + i0 + q; load_xrow<true>(x, (size_t)m, F.lane, xv[q]); rs[q] = rstd_g[m]; tg[q][0] = tok_g[2 * m]; tg[q][1] = tok_g[2 * m + 1]; }
#pragma unroll
            for (int q = 0; q < 4; ++q) { const int li = F.wave * (TOKBLK / NWAVES) + i0 + q, m = blk * TOKBLK + li; const int d0 = dest[2 * li], d1 = dest[2 * li + 1];
                GAS unsigned* o0 = (GAS unsigned*)(XS + (size_t)d0 * D) + F.lane; GAS unsigned* o1 = (GAS unsigned*)(XS + (size_t)d1 * D) + F.lane; const float sc = rs[q] * FP8_ASCALE;
#pragma unroll
                for (int j = 0; j < 4; ++j) { const f32x4 v = xv[q][j]; const unsigned w = pg8::pack_fp8x4(v.x * sc, v.y * sc, v.z * sc, v.w * sc); o0[64 * j] = w; o1[64 * j] = w; }
                if (F.lane == 0) { row_tok[d0] = m; row_g[d0] = tg[q][0]; row_tok[d1] = m; row_g[d1] = tg[q][1]; } }
        }
        __syncthreads();
    }
}

__device__ __forceinline__ float wave_scan_add(float v, int lane) {
#pragma unroll
    for (int d = 1; d < 64; d <<= 1) { const float t = __shfl_up(v, d); if (lane >= d) v += t; }
    return v;
}
__device__ __forceinline__ float wave_scan_max(float v, int lane) {
#pragma unroll
    for (int d = 1; d < 64; d <<= 1) { const float t = __shfl_up(v, d); if (lane >= d) v = fmaxf(v, t); }
    return v;
}
__device__ __forceinline__ void prep_mlstm(Frame& F, int l, int bh) {
    LAS float* Bc = (LAS float*)(F.lds); LAS float* Gc = Bc + NCH; LAS float* mc = Gc + NCH;
    const int b = bh >> 2, h = bh & 3;
    const float* gate16 = (const float*)(F.ws + WS_SM + SM_GATE16);
    float* mlb = (float*)(F.ws + WS_SM + SM_MLB) + (size_t)bh * SEQ; float* mla = (float*)(F.ws + WS_SM + SM_MLA) + (size_t)bh * SEQ; float* mlmx = (float*)(F.ws + WS_SM + SM_MLMX) + (size_t)bh * SEQ;
    float* mlm = (float*)(F.ws + WS_SM + SM_MLM) + bh * 132; float* mldec = (float*)(F.ws + WS_SM + SM_MLDEC) + bh * NCH;
    const float bi = INP(F, IN_MLBI)[l * ML_H + h], bf = INP(F, IN_MLBF)[l * ML_H + h];
    float areg[NCH / NWAVES];
#pragma unroll
    for (int ci = 0; ci < NCH / NWAVES; ++ci) {
        const int c = F.wave + NWAVES * ci, t = c * CHUNK + F.lane; const size_t m = (size_t)b * SEQ + t;
        const float lf = logsigmoid_f(gate16[m * 16 + 4 + h] + bf), li = gate16[m * 16 + h] + bi;
        const float bc = wave_scan_add(lf, F.lane), a = li - bc;
        const float amax = wave_max(a), btot = __shfl(bc, 63);
        mlb[t] = bc; mla[t] = a; areg[ci] = a;
        if (F.lane == 0) { Bc[c] = btot; Gc[c] = btot + amax; }
    }
    __syncthreads();
    if (F.tid == 0) { float mm = 0.f; for (int c = 0; c < NCH; ++c) { mc[c] = mm; const float mn = fmaxf(Bc[c] + mm, Gc[c]); mldec[c] = __expf(Bc[c] + mm - mn); mlm[c] = mm; mm = mn; } mc[NCH] = mm; mlm[NCH] = mm; }
    __syncthreads();
#pragma unroll
    for (int ci = 0; ci < NCH / NWAVES; ++ci) {
        const int c = F.wave + NWAVES * ci, t = c * CHUNK + F.lane;
        mlmx[t] = fmaxf(mc[c], wave_scan_max(areg[ci], F.lane));
    }
    __syncthreads();
}
__device__ __forceinline__ void prep_fox(Frame& F, int l, int bh) {
    LAS float* wtot = (LAS float*)(F.lds);
    const int b = bh >> 3, h = bh & 7;
    const float* gate16 = (const float*)(F.ws + WS_SM + SM_GATE16);
    float* nb = (float*)(F.ws + WS_SM + SM_FNB) + (size_t)bh * SEQ;
    const float bf = INP(F, IN_FXBF)[l * FX_H + h];
    float v[16]; float s = 0.f;
#pragma unroll
    for (int i = 0; i < 16; ++i) { const size_t m = (size_t)b * SEQ + F.tid * 16 + i; s += logsigmoid_f(gate16[m * 16 + 8 + h] + bf); v[i] = s; }
    const float incl = wave_scan_add(s, F.lane);
    if (F.lane == 63) wtot[F.wave] = incl;
    __syncthreads();
    float off = incl - s;
    for (int w = 0; w < F.wave; ++w) off += wtot[w];
#pragma unroll
    for (int i = 0; i < 16; ++i) nb[F.tid * 16 + i] = -1.4426950408889634f * (off + v[i]);
    __syncthreads();
}

__device__ __forceinline__ void unpack8(const v4u q, float (&f)[8]) {
    f[0] = __uint_as_float(q.x << 16); f[1] = __uint_as_float(q.x & 0xffff0000u); f[2] = __uint_as_float(q.y << 16); f[3] = __uint_as_float(q.y & 0xffff0000u);
    f[4] = __uint_as_float(q.z << 16); f[5] = __uint_as_float(q.z & 0xffff0000u); f[6] = __uint_as_float(q.w << 16); f[7] = __uint_as_float(q.w & 0xffff0000u);
}
__device__ __forceinline__ void pool_item(Frame& F, int item) {
    const bf16* U = (const bf16*)(F.ws + WS_NG + SL_POOL * SLAB_BYTES) + F.lane * 8; bf16* CAT = (bf16*)(F.ws + WS_CAT) + F.lane * 8;
    const int grp = F.lane >> 4, w = 2 << grp, m0 = item * 32, tt0 = m0 & (SEQ - 1);
    v4u ring[16];
#pragma unroll
    for (int j = 1; j < 16; ++j) { ring[(16 - j) & 15] = (v4u){0u, 0u, 0u, 0u}; if (tt0 - j >= 0) ring[(16 - j) & 15] = *(const GAS v4u*)(U + (size_t)(m0 - j) * 512); }
    float sum[8];
#pragma unroll
    for (int i = 0; i < 8; ++i) sum[i] = 0.f;
#pragma unroll
    for (int j = 1; j < 16; ++j) { float f[8]; unpack8(ring[(16 - j) & 15], f); const float on = (j < w) ? 1.f : 0.f;
#pragma unroll
        for (int i = 0; i < 8; ++i) sum[i] += on * f[i]; }
#pragma unroll
    for (int r0 = 0; r0 < 32; r0 += 8) {
        v4u cur[8];
#pragma unroll
        for (int j = 0; j < 8; ++j) cur[j] = *(const GAS v4u*)(U + (size_t)(m0 + r0 + j) * 512);
#pragma unroll
        for (int j = 0; j < 8; ++j) { const int r = r0 + j, tt = tt0 + r;
            float c[8]; unpack8(cur[j], c);
#pragma unroll
            for (int i = 0; i < 8; ++i) sum[i] += c[i];
            const int cnt = (tt + 1 < w) ? tt + 1 : w; const float inv = 1.f / (float)cnt;
            v4u o; o.x = pk2(sum[0] * inv - c[0], sum[1] * inv - c[1]); o.y = pk2(sum[2] * inv - c[2], sum[3] * inv - c[3]); o.z = pk2(sum[4] * inv - c[4], sum[5] * inv - c[5]); o.w = pk2(sum[6] * inv - c[6], sum[7] * inv - c[7]);
            *(GAS v4u*)(CAT + (size_t)(m0 + r) * KCAT) = o;
            const v4u a2 = (r - 1 >= 0 || true) ? ((r - 1) >= r0 ? cur[(j - 1) & 7] : ring[(r - 1) & 15]) : ring[0];
            const v4u a4 = ((r - 3) >= r0) ? cur[(j - 3) & 7] : ring[(r - 3) & 15];
            const v4u a8 = ((r - 7) >= r0) ? cur[(j - 7) & 7] : ring[(r - 7) & 15];
            const v4u a16 = ring[(r - 15) & 15];
            v4u old; old.x = grp == 0 ? a2.x : (grp == 1 ? a4.x : (grp == 2 ? a8.x : a16.x)); old.y = grp == 0 ? a2.y : (grp == 1 ? a4.y : (grp == 2 ? a8.y : a16.y));
            old.z = grp == 0 ? a2.z : (grp == 1 ? a4.z : (grp == 2 ? a8.z : a16.z)); old.w = grp == 0 ? a2.w : (grp == 1 ? a4.w : (grp == 2 ? a8.w : a16.w));
            float f[8]; unpack8(old, f);
#pragma unroll
            for (int i = 0; i < 8; ++i) sum[i] -= f[i];
        }
#pragma unroll
        for (int j = 0; j < 8; ++j) ring[(r0 + j) & 15] = cur[j];
    }
}

__device__ __forceinline__ void fox_norm_item(Frame& F, int it) {
    const int bhblk = it >> 3, wv = it & 7, bh = bhblk >> 5, blk = bhblk & 31, b = bh >> 3, h = bh & 7;
    const size_t m = (size_t)b * SEQ + blk * 256 + wv * 32 + (F.lane >> 1); const int col = h * 64 + (F.lane & 1) * 32;
    const bf16* QS = (const bf16*)(F.ws + WS_NG + SL_FQ * SLAB_BYTES) + m * 512 + col; const bf16* KS = (const bf16*)(F.ws + WS_NG + SL_FK * SLAB_BYTES) + m * 512 + col;
    float sq = 0.f, sk = 0.f, dq = 0.f;
#pragma unroll
    for (int i = 0; i < 4; ++i) { float f[8], g[8]; const v4u a = *(const GAS v4u*)(QS + 8 * i), c = *(const GAS v4u*)(KS + 8 * i);
        f[0] = __uint_as_float(a.x << 16); f[1] = __uint_as_float(a.x & 0xffff0000u); f[2] = __uint_as_float(a.y << 16); f[3] = __uint_as_float(a.y & 0xffff0000u); f[4] = __uint_as_float(a.z << 16); f[5] = __uint_as_float(a.z & 0xffff0000u); f[6] = __uint_as_float(a.w << 16); f[7] = __uint_as_float(a.w & 0xffff0000u);
        g[0] = __uint_as_float(c.x << 16); g[1] = __uint_as_float(c.x & 0xffff0000u); g[2] = __uint_as_float(c.y << 16); g[3] = __uint_as_float(c.y & 0xffff0000u); g[4] = __uint_as_float(c.z << 16); g[5] = __uint_as_float(c.z & 0xffff0000u); g[6] = __uint_as_float(c.w << 16); g[7] = __uint_as_float(c.w & 0xffff0000u);
#pragma unroll
        for (int j = 0; j < 8; ++j) { sq += f[j] * f[j]; sk += g[j] * g[j]; dq += f[j] * g[j]; } }
    sq += __shfl_xor(sq, 1); sk += __shfl_xor(sk, 1); dq += __shfl_xor(dq, 1);
    dq = -wave_max(-dq);
    sq = wave_max(sq) * 1.0001f; sk = wave_max(sk) * 1.0001f;
    if (F.lane == 0) { ((float*)(F.ws + WS_SM + SM_FQN))[it] = sq; ((float*)(F.ws + WS_SM + SM_FKN))[it] = sk; ((float*)(F.ws + WS_SM + SM_FXM))[it] = dq; }
}

typedef float f32x16 __attribute__((ext_vector_type(16)));
typedef unsigned u32x2 __attribute__((ext_vector_type(2)));
__device__ __forceinline__ float silu_f(float x) { return x * __builtin_amdgcn_rcpf(1.f + __builtin_amdgcn_exp2f(-1.4426950408889634f * x)); }
__device__ __forceinline__ void conv8(const bf16* slab, size_t m, int tt, int col, const float (&cw)[4][8], float (&o)[8]) {
    v4u q[4];
#pragma unroll
    for (int j = 0; j < 4; ++j) { const size_t mr = (tt - 3 + j >= 0) ? m - 3 + j : m; q[j] = *(const GAS v4u*)(slab + mr * 512 + col); }
#pragma unroll
    for (int i = 0; i < 8; ++i) o[i] = 0.f;
#pragma unroll
    for (int j = 0; j < 4; ++j) { float f[8]; unpack8(q[j], f); const float vld = (tt - 3 + j >= 0) ? 1.f : 0.f;
#pragma unroll
        for (int i = 0; i < 8; ++i) o[i] += (cw[j][i] * vld) * f[i]; }
#pragma unroll
    for (int i = 0; i < 8; ++i) o[i] = silu_f(o[i]);
}
constexpr int KT_P = 72, QS_P = 136;
__device__ __forceinline__ bf16x8 pack_acc8(const f32x16& x, int s) {
    v4u w; w.x = pk2(x[8 * s + 0], x[8 * s + 1]); w.y = pk2(x[8 * s + 2], x[8 * s + 3]); w.z = pk2(x[8 * s + 4], x[8 * s + 5]); w.w = pk2(x[8 * s + 6], x[8 * s + 7]);
    return __builtin_bit_cast(bf16x8, w);
}
__device__ __forceinline__ void conv8r(const v4u (&q)[4], int tt, const LAS float* cw, int col, float (&o)[8]) {
#pragma unroll
    for (int i = 0; i < 8; ++i) o[i] = 0.f;
#pragma unroll
    for (int j = 0; j < 4; ++j) { float f[8]; unpack8(q[j], f); const float vld = (tt - 3 + j >= 0) ? 1.f : 0.f;
        const f32x4 w0 = *(const LAS f32x4*)(cw + j * 512 + col) * vld, w1 = *(const LAS f32x4*)(cw + j * 512 + col + 4) * vld;
#pragma unroll
        for (int i = 0; i < 4; ++i) { o[i] += w0[i] * f[i]; o[4 + i] += w1[i] * f[4 + i]; } }
#pragma unroll
    for (int i = 0; i < 8; ++i) o[i] = silu_f(o[i]);
}
struct RawL { v4u k[2][4]; v4u v[2]; float fp, ip; };
__device__ __forceinline__ void mlstm_L_load(Frame& F, int u, RawL& R) {
    const int bh = u >> 7, c = u & (NCH - 1), b = bh >> 2, h = bh & 3;
    const bf16* KS = (const bf16*)(F.ws + WS_NG + SL_MK * SLAB_BYTES); const bf16* VS = (const bf16*)(F.ws + WS_NG + SL_MV * SLAB_BYTES);
    const int s = F.lane, tt = c * CHUNK + s; const size_t m = (size_t)b * SEQ + tt;
#pragma unroll
    for (int half = 0; half < 2; ++half) { const int col = h * ML_DH + (F.wave + 8 * half) * 8;
#pragma unroll
        for (int j = 0; j < 4; ++j) { const size_t mr = (tt - 3 + j >= 0) ? m - 3 + j : m; R.k[half][j] = *(const GAS v4u*)(KS + mr * 512 + col); }
        R.v[half] = *(const GAS v4u*)(VS + m * 512 + col); }
    const float* gate16 = (const float*)(F.ws + WS_SM + SM_GATE16) + m * 16;
    R.fp = gate16[4 + h]; R.ip = gate16[h];
}
__device__ __forceinline__ void mlstm_L_phase(Frame& F, int l) {
    LAS bf16* Kt = (LAS bf16*)(F.lds); LAS bf16* Vt = Kt + 128 * KT_P; LAS float* wk = (LAS float*)(F.lds + 2 * 128 * KT_P * 2); LAS float* cwk = (LAS float*)(F.lds + 40960);
    for (int i = F.tid; i < 4 * 512; i += NWAVES * 64) cwk[i] = INP(F, IN_CONVW)[(size_t)l * 4 * 1024 + (i >> 9) * 1024 + 512 + (i & 511)];
    const int NU = BATCH * ML_H * NCH;
    float b_f[ML_H], b_i[ML_H];
#pragma unroll
    for (int i = 0; i < ML_H; ++i) { b_f[i] = INP(F, IN_MLBF)[l * ML_H + i]; b_i[i] = INP(F, IN_MLBI)[l * ML_H + i]; }
    int u = F.vcu; if (u >= NU) { __syncthreads(); return; }
    RawL cur; mlstm_L_load(F, u, cur);
    __syncthreads();
    for (; u < NU; u += F.G) {
        const int bh = u >> 7, h = bh & 3;
        if (F.tid < CHUNK) {
            const float lf = logsigmoid_f(cur.fp + b_f[h]), li = cur.ip + b_i[h];
            const float bc = wave_scan_add(lf, F.lane), a = li - bc, amax = wave_max(a);
            wk[F.tid] = __expf(a - amax);
            const int c = u & (NCH - 1);
            ((float*)(F.ws + WS_SM + SM_MLB))[(size_t)bh * SEQ + c * CHUNK + F.tid] = bc; ((float*)(F.ws + WS_SM + SM_MLA))[(size_t)bh * SEQ + c * CHUNK + F.tid] = a;
            if (F.tid == 63) { float* bg = (float*)(F.ws + WS_SM + SM_MLBG) + 2 * u; bg[0] = bc; bg[1] = bc + amax; }
        }
        __syncthreads();
        {   const int s = F.lane, tt = (u & (NCH - 1)) * CHUNK + s;
#pragma unroll
            for (int half = 0; half < 2; ++half) { const int cg = F.wave + 8 * half, col = h * ML_DH + cg * 8;
                float kk[8]; conv8r(cur.k[half], tt, cwk, col, kk);
                float vv[8]; unpack8(cur.v[half], vv); const float ws = wk[s];
#pragma unroll
                for (int i = 0; i < 8; ++i) { Kt[(cg * 8 + i) * KT_P + s] = (bf16)f2bf(kk[i] * 0.08838834764831845f); Vt[(cg * 8 + i) * KT_P + s] = (bf16)f2bf(vv[i] * ws); } }
        }
        __syncthreads();
        if (u + F.G < NU) mlstm_L_load(F, u + F.G, cur);
        {   const int r = F.lane & 31, hi = F.lane >> 5, kb = F.wave >> 1;
            f32x16 acc[2]; acc[0] = f32x16{}; acc[1] = f32x16{};
#pragma unroll
            for (int sp = 0; sp < 4; ++sp) { const bf16x8 a = *(const LAS bf16x8*)(Kt + (kb * 32 + r) * KT_P + 16 * sp + 8 * hi);
#pragma unroll
                for (int j = 0; j < 2; ++j) { const int vb = 2 * (F.wave & 1) + j; const bf16x8 bb = *(const LAS bf16x8*)(Vt + (vb * 32 + r) * KT_P + 16 * sp + 8 * hi);
                    acc[j] = __builtin_amdgcn_mfma_f32_32x32x16_bf16(a, bb, acc[j], 0, 0, 0); } }
            GAS bf16x8* img = (GAS bf16x8*)(F.ws + WS_MLC + (size_t)u * 32768);
#pragma unroll
            for (int j = 0; j < 2; ++j) { const int vb = 2 * (F.wave & 1) + j;
#pragma unroll
                for (int s = 0; s < 2; ++s) img[((vb * 4 + kb) * 2 + s) * 64 + F.lane] = pack_acc8(acc[j], s); }
        }
        if (F.tid < ML_DH) { float a = 0.f;
#pragma unroll 8
            for (int s = 0; s < CHUNK; ++s) a += wk[s] * __uint_as_float((unsigned)Kt[F.tid * KT_P + s] << 16);
            ((float*)(F.ws + WS_SM + SM_MLN))[(size_t)u * ML_DH + F.tid] = a; }
        __syncthreads();
    }
}
__device__ __forceinline__ void mlstm_S(Frame& F) {
    LAS float* dec = (LAS float*)(F.lds); LAS float* cor = dec + NCH;
    for (int unit = F.vcu; unit < 16 * 16; unit += F.G) {
        const int bh = unit >> 4, part = unit & 15;
        if (F.tid == 0) { const float* bg = (const float*)(F.ws + WS_SM + SM_MLBG) + 2 * bh * NCH; float* mlm = (float*)(F.ws + WS_SM + SM_MLM) + bh * 132; float mm = 0.f;
            for (int c = 0; c < NCH; ++c) { const float B = bg[2 * c], G = bg[2 * c + 1], mn = fmaxf(B + mm, G); dec[c] = __expf(B + mm - mn); cor[c] = __expf(G - mn); mlm[c] = mm; mm = mn; }
            mlm[NCH] = mm; }
        __syncthreads();
        {   const int e2 = part * 512 + F.tid; GAS unsigned* p = (GAS unsigned*)(F.ws + WS_MLC + (size_t)bh * NCH * 32768) + e2;
            float r0 = 0.f, r1 = 0.f;
            for (int c0 = 0; c0 < NCH; c0 += 16) { unsigned q[16];
#pragma unroll
                for (int i = 0; i < 16; ++i) q[i] = p[(size_t)(c0 + i) * 8192];
#pragma unroll
                for (int i = 0; i < 16; ++i) { const float d = dec[c0 + i], k = cor[c0 + i]; p[(size_t)(c0 + i) * 8192] = pk2(r0, r1);
                    r0 = d * r0 + k * __uint_as_float(q[i] << 16); r1 = d * r1 + k * __uint_as_float(q[i] & 0xffff0000u); } } }
        if (part == 0 && F.tid < ML_DH) { float* p = (float*)(F.ws + WS_SM + SM_MLN) + (size_t)bh * NCH * ML_DH + F.tid;
            float r = 0.f;
            for (int c0 = 0; c0 < NCH; c0 += 16) { float q[16];
#pragma unroll
                for (int i = 0; i < 16; ++i) q[i] = p[(size_t)(c0 + i) * ML_DH];
#pragma unroll
                for (int i = 0; i < 16; ++i) { p[(size_t)(c0 + i) * ML_DH] = r; r = dec[c0 + i] * r + cor[c0 + i] * q[i]; } } }
        __syncthreads();
    }
}
#define O_BAR() do { asm volatile("s_waitcnt lgkmcnt(0)" ::: "memory"); __builtin_amdgcn_s_barrier(); asm volatile("" ::: "memory"); } while (0)
constexpr int O_RAWQ = 73728, O_RAWK = O_RAWQ + 68 * 256, O_RAWV = O_RAWK + 68 * 256, O_END = O_RAWV + 64 * 256;
static_assert(O_END + 3 * 2 * 1024 <= RING_BYTES, "mLSTM O-phase LDS map");
__device__ __forceinline__ void mlstm_O_dma(Frame& F, int u) {
    const int bh = u >> 7, c = u & (NCH - 1), b = bh >> 2, h = bh & 3;
    const size_t seq0 = (size_t)b * SEQ; const int t0 = c * CHUNK;
    for (int i = F.wave; i < 50; i += NWAVES) {
        const int ten = i < 17 ? 0 : (i < 34 ? 1 : 2), ii = i - 17 * ten, row = 4 * ii + (F.lane >> 4);
        int t = (ten == 2) ? t0 + row : t0 - 3 + row; t = t < 0 ? 0 : (t > t0 + CHUNK - 1 ? t0 + CHUNK - 1 : t);
        const bf16* src = (const bf16*)(F.ws + WS_NG + (size_t)(ten == 0 ? SL_MQ : (ten == 1 ? SL_MK : SL_MV)) * SLAB_BYTES) + (seq0 + t) * 512 + h * ML_DH + (((F.lane & 15) ^ (row & 15)) * 8);
        const int dst = (ten == 0 ? O_RAWQ : (ten == 1 ? O_RAWK : O_RAWV)) + ii * 1024;
        __builtin_amdgcn_global_load_lds((const GAS unsigned*)src, (LAS unsigned*)(F.lds + dst), 16, 0, 0);
    }
}
__device__ __forceinline__ void conv8l(const LAS bf16* raw, int s, int tt, const LAS float* cw, int cg, int col, float (&o)[8]) {
#pragma unroll
    for (int i = 0; i < 8; ++i) o[i] = 0.f;
#pragma unroll
    for (int j = 0; j < 4; ++j) { float f[8]; unpack8(*(const LAS v4u*)(raw + (s + j) * 128 + ((cg ^ ((s + j) & 15)) * 8)), f); const float vld = (tt - 3 + j >= 0) ? 1.f : 0.f;
        const f32x4 w0 = *(const LAS f32x4*)(cw + j * 512 + col) * vld, w1 = *(const LAS f32x4*)(cw + j * 512 + col + 4) * vld;
#pragma unroll
        for (int i = 0; i < 4; ++i) { o[i] += w0[i] * f[i]; o[4 + i] += w1[i] * f[4 + i]; } }
#pragma unroll
    for (int i = 0; i < 8; ++i) o[i] = silu_f(o[i]);
}
__device__ __forceinline__ void mlstm_O_phase(Frame& F, int l) {
    LAS bf16* Qs = (LAS bf16*)(F.lds); LAS bf16* Ks = Qs + 64 * QS_P; LAS bf16* Vt = Ks + 64 * QS_P;
    LAS float* fa = (LAS float*)(F.lds + (2 * 64 * QS_P + 128 * KT_P) * 2); LAS float* fmx = fa + 64; LAS float* fb = fa + 128; LAS float* nvec = fa + 192; LAS float* ssq = fa + 320;
    LAS float* cwq = (LAS float*)(F.lds + 57344); LAS float* cwk = cwq + 4 * 512;
    LAS float* psm = (LAS float*)(F.lds + 55552); LAS float* nqp = psm + 96; LAS bf16x8* pimg = (LAS bf16x8*)(F.lds + O_END);
    const LAS bf16* rawq = (const LAS bf16*)(F.lds + O_RAWQ); const LAS bf16* rawk = (const LAS bf16*)(F.lds + O_RAWK); const LAS bf16* rawv = (const LAS bf16*)(F.lds + O_RAWV);
    for (int i = F.tid; i < 4 * 512; i += NWAVES * 64) { cwq[i] = INP(F, IN_CONVW)[(size_t)l * 4 * 1024 + (i >> 9) * 1024 + (i & 511)]; cwk[i] = INP(F, IN_CONVW)[(size_t)l * 4 * 1024 + (i >> 9) * 1024 + 512 + (i & 511)]; }
    const int NU = BATCH * ML_H * NCH;
    int u = F.vcu; if (u >= NU) { __syncthreads(); return; }
    mlstm_O_dma(F, u);
    const bf16* OS = (const bf16*)(F.ws + WS_NG + SL_MO * SLAB_BYTES);
    const int r = F.lane & 31, hi = F.lane >> 5, tb = F.wave & 1, vb = F.wave >> 1;
    for (; u < NU; u += F.G) {
    const int bh = u >> 7, c = u & (NCH - 1), b = bh >> 2, h = bh & 3;
    asm volatile("s_waitcnt vmcnt(0)" ::: "memory"); O_BAR();
    const float m_c = ((const float*)(F.ws + WS_SM + SM_MLM))[bh * 132 + c];
    bf16x8 cf[4][2];
    {   const GAS bf16x8* img = (const GAS bf16x8*)(F.ws + WS_MLC + (size_t)u * 32768);
#pragma unroll
        for (int kb = 0; kb < 4; ++kb)
#pragma unroll
            for (int s = 0; s < 2; ++s) cf[kb][s] = img[((vb * 4 + kb) * 2 + s) * 64 + F.lane]; }
    u32x2 oww[4];
    {   const size_t m = (size_t)b * SEQ + c * CHUNK + tb * 32 + r;
#pragma unroll
        for (int q = 0; q < 4; ++q) oww[q] = *(const GAS u32x2*)(OS + m * 512 + h * ML_DH + vb * 32 + 8 * q + 4 * hi); }
    float g0 = 0.f, g1 = 0.f, g2 = 0.f;
    {   const float* mlb = (const float*)(F.ws + WS_SM + SM_MLB) + (size_t)bh * SEQ; const float* mla = (const float*)(F.ws + WS_SM + SM_MLA) + (size_t)bh * SEQ; const float* mlmx = (const float*)(F.ws + WS_SM + SM_MLMX) + (size_t)bh * SEQ;
        if (F.tid < CHUNK) { g0 = mla[c * CHUNK + F.tid]; g2 = mlb[c * CHUNK + F.tid]; g1 = fmaxf(m_c, wave_scan_max(g0, F.lane)); }
        else if (F.tid < CHUNK + ML_DH) g0 = ((const float*)(F.ws + WS_SM + SM_MLN))[(size_t)u * ML_DH + F.tid - CHUNK]; }
    {   const int s = F.lane, tt = c * CHUNK + s;
#pragma unroll
        for (int half = 0; half < 2; ++half) { const int cg = F.wave + 8 * half, col = h * ML_DH + cg * 8;
            float qq[8], kk[8], vv[8]; conv8l(rawq, s, tt, cwq, cg, col, qq); conv8l(rawk, s, tt, cwk, cg, col, kk); unpack8(*(const LAS v4u*)(rawv + s * 128 + ((cg ^ (s & 15)) * 8)), vv);
            v4u wq, wkk; wq.x = pk2(qq[0], qq[1]); wq.y = pk2(qq[2], qq[3]); wq.z = pk2(qq[4], qq[5]); wq.w = pk2(qq[6], qq[7]);
            const float sc = 0.08838834764831845f;
            wkk.x = pk2(kk[0] * sc, kk[1] * sc); wkk.y = pk2(kk[2] * sc, kk[3] * sc); wkk.z = pk2(kk[4] * sc, kk[5] * sc); wkk.w = pk2(kk[6] * sc, kk[7] * sc);
            *(LAS v4u*)(Qs + s * QS_P + cg * 8) = wq; *(LAS v4u*)(Ks + s * QS_P + cg * 8) = wkk;
#pragma unroll
            for (int i = 0; i < 8; ++i) Vt[(cg * 8 + i) * KT_P + s] = (bf16)f2bf(vv[i]); }
    }
    if (F.tid < CHUNK) { fa[F.tid] = g0; fmx[F.tid] = g1; fb[F.tid] = g2; }
    else if (F.tid < CHUNK + ML_DH) nvec[F.tid - CHUNK] = g0;
    O_BAR();
    if (u + F.G < NU) mlstm_O_dma(F, u + F.G);
    const int t = tb * 32 + r;
    const float Mx_t = fmx[t], m_t = fb[t] + Mx_t, w_int = __expf(m_c - Mx_t);
    if (F.wave < 3) {
        const int tbs = F.wave ? 1 : 0, sbs = F.wave == 2 ? 1 : 0, ts = tbs * 32 + r; const float Mxs = fmx[ts];
        f32x16 x = f32x16{};
#pragma unroll
        for (int ks = 0; ks < 8; ++ks) { const bf16x8 a = *(const LAS bf16x8*)(Ks + (sbs * 32 + r) * QS_P + 16 * ks + 8 * hi); const bf16x8 q = *(const LAS bf16x8*)(Qs + ts * QS_P + 16 * ks + 8 * hi);
            x = __builtin_amdgcn_mfma_f32_32x32x16_bf16(a, q, x, 0, 0, 0); }
        float ps = 0.f;
#pragma unroll
        for (int rr = 0; rr < 16; ++rr) { const int s = sbs * 32 + (rr & 3) + 8 * (rr >> 2) + 4 * hi; const float pv = (s <= ts) ? __expf(fa[s] - Mxs) * x[rr] : 0.f; x[rr] = pv; ps += pv; }
        ps += __shfl_xor(ps, 32);
        pimg[(F.wave * 2 + 0) * 64 + F.lane] = pack_acc8(x, 0); pimg[(F.wave * 2 + 1) * 64 + F.lane] = pack_acc8(x, 1);
        if (hi == 0) psm[F.wave * 32 + r] = ps;
    }
    {   float nq = 0.f;
#pragma unroll
        for (int i = 0; i < 2; ++i) { float f[8]; unpack8(*(const LAS v4u*)(Qs + t * QS_P + 32 * vb + 16 * hi + 8 * i), f);
#pragma unroll
            for (int j = 0; j < 8; ++j) nq += f[j] * nvec[32 * vb + 16 * hi + 8 * i + j]; }
        nq += __shfl_xor(nq, 32);
        if (hi == 0) nqp[vb * 64 + t] = nq; }
    f32x16 acc = f32x16{};
#pragma unroll
    for (int kb = 0; kb < 4; ++kb)
#pragma unroll
        for (int s = 0; s < 2; ++s) { const u32x2 lo = *(const LAS u32x2*)(Qs + t * QS_P + kb * 32 + 16 * s + 4 * hi), hi2 = *(const LAS u32x2*)(Qs + t * QS_P + kb * 32 + 16 * s + 8 + 4 * hi);
            v4u w; w.x = lo.x; w.y = lo.y; w.z = hi2.x; w.w = hi2.y;
            acc = __builtin_amdgcn_mfma_f32_32x32x16_bf16(cf[kb][s], __builtin_bit_cast(bf16x8, w), acc, 0, 0, 0); }
#pragma unroll
    for (int rr = 0; rr < 16; ++rr) acc[rr] *= w_int;
    O_BAR();
    float psum = 0.f;
#pragma unroll
    for (int sb = 0; sb < 2; ++sb) {
        if (sb <= tb) { const int blk = tb == 0 ? 0 : 1 + sb; psum += psm[blk * 32 + r];
#pragma unroll
            for (int s = 0; s < 2; ++s) { const u32x2 lo = *(const LAS u32x2*)(Vt + (vb * 32 + r) * KT_P + sb * 32 + 16 * s + 4 * hi), hi2 = *(const LAS u32x2*)(Vt + (vb * 32 + r) * KT_P + sb * 32 + 16 * s + 8 + 4 * hi);
                v4u w; w.x = lo.x; w.y = lo.y; w.z = hi2.x; w.w = hi2.y;
                acc = __builtin_amdgcn_mfma_f32_32x32x16_bf16(__builtin_bit_cast(bf16x8, w), pimg[(blk * 2 + s) * 64 + F.lane], acc, 0, 0, 0); }
        }
    }
    const float nq = (nqp[t] + nqp[64 + t]) + (nqp[128 + t] + nqp[192 + t]);
    const float den = w_int * nq + psum, inv = 1.f / fmaxf(fabsf(den), __expf(-m_t));
    float sq = 0.f;
#pragma unroll
    for (int rr = 0; rr < 16; ++rr) { acc[rr] *= inv; sq += acc[rr] * acc[rr]; }
    sq += __shfl_xor(sq, 32);
    if (hi == 0) ssq[vb * 64 + t] = sq;
    O_BAR();
    const float rstd = 1.f / sqrtf((ssq[t] + ssq[64 + t] + ssq[128 + t] + ssq[192 + t]) * (1.f / ML_DH) + NORM_EPS);
    {   const size_t m = (size_t)b * SEQ + c * CHUNK + t; bf16* CAT = (bf16*)(F.ws + WS_CAT);
#pragma unroll
        for (int q = 0; q < 4; ++q) { const int v0 = vb * 32 + 8 * q + 4 * hi, col = h * ML_DH + v0;
            const u32x2 ow = oww[q]; const f32x4 gn = *(const GAS f32x4*)(INP(F, IN_MLNG) + (size_t)l * 512 + col);
            const float o0 = sigmoid_f(__uint_as_float(ow.x << 16)), o1 = sigmoid_f(__uint_as_float(ow.x & 0xffff0000u)), o2 = sigmoid_f(__uint_as_float(ow.y << 16)), o3 = sigmoid_f(__uint_as_float(ow.y & 0xffff0000u));
            u32x2 w; w.x = pk2(acc[4 * q] * rstd * gn.x * o0, acc[4 * q + 1] * rstd * gn.y * o1); w.y = pk2(acc[4 * q + 2] * rstd * gn.z * o2, acc[4 * q + 3] * rstd * gn.w * o3);
            *(GAS u32x2*)(CAT + m * KCAT + 512 + col) = w; }
    }
    }
    asm volatile("s_waitcnt vmcnt(0)" ::: "memory"); O_BAR();
}
#undef O_BAR

#ifndef SUBP
#define SUBP 0
#endif
#ifndef MK_MULTI
#define MK_MULTI 0
#endif
constexpr int NPH = 1 + (8 + 1) + (1 + 8 + 4) + 2;
#ifndef PH_MASK
#define PH_MASK 0xffffffffu
#endif
#ifndef PROBE_MASK
#define PROBE_MASK 0u
#endif
#define PH_BEGIN(id) if (ph >= lo && ph < hi) { if constexpr (((PH_MASK) >> (id)) & 1u) { for (int rep_ = 0; rep_ < 1 + (int)(((PROBE_MASK) >> (id)) & 1u); ++rep_) { Frame F = FK; { size_t z_ = 0; int zi_ = 0; asm volatile("" : "+v"(F.tid), "+s"(z_), "+s"(zi_)); \
        F.lane = F.tid & 63; F.ws = FK.ws + z_; F.out = (float*)((char*)FK.out + z_); F.zi = zi_; } const int gw = F.vcu * NWAVES + F.wave, NGWV = F.G * NWAVES; (void)gw; (void)NGWV;
#define PH_END __syncthreads(); } } if (ph + 1 < hi) { XcdBarrier b2_ = bar; size_t zb_ = 0; asm volatile("" : "+s"(zb_)); b2_.bar = bar.bar + zb_; xcd_barrier(b2_); } } ++ph;
#define HB ((bf16*)(F.ws + WS_HB))
#define CAT ((bf16*)(F.ws + WS_CAT))
#define SLAB ((bf16*)(F.ws + WS_NG))
#define GATE ((bf16*)(F.ws + WS_GATE))
#define WL ((bf16*)(F.ws + WS_W + (size_t)l * W_LAYER))
#define XBP ((bf16*)((char*)F.out + (size_t)M * D * 2))

template <int l> __device__ __forceinline__ void layer_phases(Frame& FK, int& ph, const int lo, const int hi, const XcdBarrier& bar, unsigned char* lds) {
        if constexpr (l > 0) { PH_BEGIN(1) phase_norm_mix<true>(F, XBP, l); PH_END }
        PH_BEGIN(2)
            pg8::Gemm g{HB, WL + W_NG / 2, M, NGW, D}; pg8::StaticOrder S; S.init(M, NGW, F.G, F.blk);
            pg8::EpiSlab E{SLAB, (size_t)M * 512, SL_FQ, attn_body::C2};
            pg8::gemm_phase<pg8::EpiSlab, pg8::StaticOrder, true, true>(F.lds + RING_OFF, g, S, E);
        PH_END
        PH_BEGIN(3)
            for (int s = F.blk; s < BATCH * FX_H; s += F.G) prep_fox(F, l, s);
            for (int rp = 0; rp < (SUBP == 1 ? 2 : 1); ++rp) for (int it = gw; it < M / 32; it += NGWV) pool_item(F, it);
            for (int rp = 0; rp < (SUBP == 2 ? 2 : 1); ++rp) for (int it = gw; it < BATCH * FX_H * 32 * 8; it += NGWV) fox_norm_item(F, it);
            for (int rp = 0; rp < (SUBP == 3 ? 2 : 1); ++rp) mlstm_L_phase(F, l);
        PH_END
        PH_BEGIN(4)
            mlstm_S(F);
            for (int ui = gw; ui < BATCH * FX_H * 32; ui += NGWV) { const int bh = ui >> 5, qb = ui & 31;
                const int t0 = attn_body::attn_t0(qb, (const float*)(F.ws + WS_SM + SM_FNB) + (size_t)bh * SEQ, (const float*)(F.ws + WS_SM + SM_FQN) + bh * 256, (const float*)(F.ws + WS_SM + SM_FKN) + bh * 256, (const float*)(F.ws + WS_SM + SM_FXM) + bh * 256, F.lane);
                if (F.lane == 0) ((int*)(F.ws + WS_SM + SM_FT0))[ui] = t0; }
        PH_END
        PH_BEGIN(18)
            for (int rp = 0; rp < (SUBP == 4 ? 2 : 1); ++rp) mlstm_O_phase(F, l);
            const attn_body::AttnTensors AT{(const attn_body::bf16*)(SLAB + (size_t)SL_FQ * M * 512), (const attn_body::bf16*)(SLAB + (size_t)SL_FK * M * 512), (const attn_body::bf16*)(SLAB + (size_t)SL_FV * M * 512),
                                            (attn_body::bf16*)CAT, (const float*)(F.ws + WS_SM + SM_FNB), (const float*)(F.ws + WS_SM + SM_FQN), (const float*)(F.ws + WS_SM + SM_FKN), (const int*)(F.ws + WS_SM + SM_FT0)};
            attn_body::attn_phase_dyn<8>((char*)lds + RING_OFF, AT, (unsigned*)(F.ctl + 2048 + 64 * l), F.MISC + 0);
            quant_rows_fp8(F, HB, F.ws + WS_NG + (size_t)SL_POOL * SLAB_BYTES);
        PH_END
        PH_BEGIN(6)
            pg8::Gemm g{(const bf16*)(F.ws + WS_NG + (size_t)SL_POOL * SLAB_BYTES), WL + W_GT / 2, M, NGT, D / 2}; pg8::StaticOrder S; S.init(M, NGT, F.G, F.blk);
            pg8::EpiSig E{(unsigned char*)GATE, 1.f / (FP8_ASCALE * FP8_WSCALE)};
            pg8::gemm_phase<pg8::EpiSig, pg8::StaticOrder, true, true, true>(F.lds + RING_OFF, g, S, E);
        PH_END
        PH_BEGIN(7)
            pg8::Gemm g{CAT, WL + W_CAT / 2, M, D, KCAT}; pg8::StaticOrder S; S.init(M, D, F.G, F.blk);
            pg8::EpiMerge E{(const unsigned char*)GATE, HB};
            pg8::gemm_phase<pg8::EpiMerge, pg8::StaticOrder, true, true>(F.lds + RING_OFF, g, S, E);
        PH_END
        PH_BEGIN(8)
            pg8::Gemm g{HB, WL + W_OUT / 2, M, D, D}; pg8::StaticOrder S; S.init(M, D, F.G, F.blk);
            if constexpr (l == 0) { pg8::EpiResB<true> E{INP(F, IN_X), XBP, (float*)(F.ws + WS_SM + SM_GATE16)};     pg8::gemm_phase<pg8::EpiResB<true>, pg8::StaticOrder, true, true>(F.lds + RING_OFF, g, S, E); }
            else { pg8::EpiResB<false> E{XBP, XBP, nullptr}; pg8::gemm_phase<pg8::EpiResB<false>, pg8::StaticOrder, true, true>(F.lds + RING_OFF, g, S, E); }
        PH_END
        if constexpr (l == 0) {
            PH_BEGIN(10)
                pg8::Gemm g{XBP, (const bf16*)(F.ws + WS_WGU), M, 2 * DFF, D}; pg8::StaticOrder S; S.init(M, 2 * DFF, F.G, F.blk);
                pg8::EpiSwiGLUR E{(bf16*)(F.ws + WS_ACT0), DFF, (const float*)(F.ws + WS_SM + SM_GATE16), 1.f / D, NORM_EPS};
                pg8::gemm_phase<pg8::EpiSwiGLUR, pg8::StaticOrder, true, true>(F.lds + RING_OFF, g, S, E);
            PH_END
            PH_BEGIN(11)
                pg8::Gemm g{(const bf16*)(F.ws + WS_ACT0), (const bf16*)(F.ws + WS_WDN), M, D, DFF}; pg8::StaticOrder S; S.init(M, D, F.G, F.blk);
                pg8::EpiResB<false> E{XBP, XBP, nullptr};
                pg8::gemm_phase<pg8::EpiResB<false>, pg8::StaticOrder, true, true>(F.lds + RING_OFF, g, S, E);
            PH_END
        } else {
            PH_BEGIN(12)
                phase_route1(F, XBP);
                __syncthreads();
                LAS float* scr = (LAS float*)(F.lds + F.wave * 16384);
                for (int it = gw; it < CI_MOE; it += NGWV) conv_item_moe(F, it, scr);
            PH_END
            PH_BEGIN(13) phase_route2(F, XBP); PH_END
#define MOE_UP(k_, S_) do { pg8::Gemm g{(const bf16*)(F.ws + WS_XS + (size_t)(k_) * MOE_KROWS * D), (const bf16*)(F.ws + WS_MOEGU), MOE_KROWS, 2 * DFE, D / 2}; \
                    pg8::EpiSwiGLU8 E{F.ws + WS_ACT1 + (size_t)(k_) * MOE_KROWS * DFE, DFE, 1.f / (FP8_ASCALE * FP8_WSCALE), FP8_ASCALE}; \
                    pg8::gemm_phase<pg8::EpiSwiGLU8, decltype(S_), true, true, true>(F.lds + RING_OFF, g, S_, E); } while (0)
#define MOE_DOWN(k_) do { pg8::Gemm g{(const bf16*)(F.ws + WS_ACT1 + (size_t)(k_) * MOE_KROWS * DFE), (const bf16*)(F.ws + WS_MOEDN), MOE_KROWS, D, DFE / 2}; pg8::MoeOrder S; S.init(nM[k_], D / 256, F.G, F.blk, tile_e + (k_) * MOE_KTILES); \
                    pg8::EpiMoeDown E{(bf16*)(F.ws + ((k_) == 0 ? WS_Y0 : WS_Y1)), (const int*)(sm + MO_ROWTOK) + (k_) * MOE_KROWS, (const float*)(sm + MO_ROWG) + (k_) * MOE_KROWS, 1.f / (FP8_ASCALE * FP8_WSCALE)}; \
                    pg8::gemm_phase<pg8::EpiMoeDown, pg8::MoeOrder, true, true, true>(F.lds + RING_OFF, g, S, E); } while (0)
#define MOE_TABLES unsigned char* sm = F.ws + WS_SM + SM_MOE; LAS int* tile_e = (LAS int*)(F.lds + LDSCTL_OFF + 1024); \
                    for (int i_ = F.tid; i_ < 2 * MOE_KTILES; i_ += NWAVES * 64) tile_e[i_] = __hip_atomic_load((const int*)(sm + MO_TILEE) + i_, RLX_AGENT); __syncthreads(); \
                    const int nM[2] = {__builtin_amdgcn_readfirstlane(__hip_atomic_load((const int*)(sm + MO_NT), RLX_AGENT)), __builtin_amdgcn_readfirstlane(__hip_atomic_load((const int*)(sm + MO_NT) + 1, RLX_AGENT))};
            PH_BEGIN(14)
                MOE_TABLES
                pg8::MoeOrder S; S.init(nM[0], 2 * DFE / 256, F.G, F.blk, tile_e);
                MOE_UP(0, S);
            PH_END
            PH_BEGIN(15)
                MOE_TABLES
                MOE_DOWN(0);
                const int Nd = nM[0] * (D / 256), Nu = nM[1] * (2 * DFE / 256), qd = Nd / F.G, rd = Nd % F.G;
                const float T = (3.5f * (float)Nd + (float)Nu) / (float)F.G;
                float cum = 0.f; int lo_u = 0, hi_u = 0;
                for (int v = 0; v <= F.vcu; ++v) { const int w = (F.G % 8 == 0) ? (v % (F.G / 8)) * 8 + v / (F.G / 8) : v; const float cap = fmaxf(T - 3.5f * (float)(qd + (w < rd ? 1 : 0)), 0.f);
                    lo_u = (int)(cum + 0.5f); cum += cap; hi_u = (int)(cum + 0.5f); }
                if (F.vcu == F.G - 1 || hi_u > Nu) hi_u = Nu; if (lo_u > Nu) lo_u = Nu;
                lo_u = __builtin_amdgcn_readfirstlane(lo_u); hi_u = __builtin_amdgcn_readfirstlane(hi_u);
                pg8::MoeRange R; R.init(nM[1], 2 * DFE / 256, lo_u, hi_u, tile_e + MOE_KTILES);
                MOE_UP(1, R);
            PH_END
            PH_BEGIN(19)
                MOE_TABLES
                MOE_DOWN(1);
            PH_END
#undef MOE_UP
#undef MOE_DOWN
#undef MOE_TABLES
        }
    }
struct Args { const float* in[24]; float* out; unsigned char* ws; int ph_lo, ph_hi; };
__global__ void __launch_bounds__(NWAVES * 64, 2) fwd(Args args) {
    extern __shared__ __attribute__((aligned(16))) unsigned char lds[];
    Frame FK;
    FK.lds = (LAS unsigned char*)lds;
    FK.MISC = (volatile LAS unsigned*)(FK.lds + MISC_OFF);
    FK.tid = threadIdx.x; FK.lane = FK.tid & 63; FK.wave = __builtin_amdgcn_readfirstlane(FK.tid >> 6);
    FK.G = gridDim.x; FK.blk = blockIdx.x; { const int bx = blockIdx.x; FK.vcu = (FK.G % 8 == 0) ? (bx % 8) * (FK.G / 8) + bx / 8 : bx; }
    FK.ws = args.ws; FK.ctl = (gu32*)(args.ws + WS_CTL); FK.out = args.out;
    FK.in = args.in; FK.zi = 0;
    for (int u = FK.tid; u < (LDS_BYTES - LDSCTL_OFF) / 4; u += NWAVES * 64) ((LAS unsigned*)(FK.lds + LDSCTL_OFF))[u] = 0u;
    __syncthreads();
    const int lo = args.ph_lo, hi = args.ph_hi;
    XcdBarrier bar; bar.bar = (unsigned*)(FK.ctl + CW_BAR); bar.x = 0; bar.st = nullptr;
    if (hi - lo > 1) bar = xcd_barrier_post((unsigned*)(FK.ctl + CW_BAR), FK.MISC + 8);
    int ph = 0;
    PH_BEGIN(0)
        LAS float* scr = (LAS float*)(F.lds + F.wave * 16384);
        for (int it = gw; it < CI_MAIN; it += NGWV) conv_item_main(F, it, scr);
        pool_fold(F);
        __syncthreads();
        phase_norm_mix<false>(F, INP(F, IN_X), 0);
    PH_END

    layer_phases<0>(FK, ph, lo, hi, bar, lds);
    layer_phases<1>(FK, ph, lo, hi, bar, lds);
    PH_BEGIN(16) phase_norm_final(F, XBP, F.out, (float*)(F.ws + WS_ACT1)); PH_END
    PH_BEGIN(20) phase_copy_upper(F, (const float*)(F.ws + WS_ACT1), F.out); PH_END
#undef PH_BEGIN
#undef HB
#undef CAT
#undef SLAB
#undef GATE
#undef WL
#undef XBP
#undef PH_END
}

extern "C" void kernel_launch(void* const* d_in, const int* in_sizes, int n_in, void* d_out, int out_size, void* d_ws, size_t ws_size, hipStream_t stream) {
    static int grid = 0;
    if (grid == 0) {
        if (n_in != 24 || in_sizes[0] != M * D || out_size != M * D || ws_size < WS_END) { fprintf(stderr, "kernel_launch: built for 24 inputs, x/out of %d floats, >= %zu bytes of workspace; got n_in %d, in0 %d, out %d, ws %zu; nothing launched\n", M * D, (size_t)WS_END, n_in, n_in > 0 ? in_sizes[0] : -1, out_size, ws_size); grid = -1; return; }
        int dev = 0, cus = 0, per_cu = 0;
        if (hipGetDevice(&dev) != hipSuccess || hipDeviceGetAttribute(&cus, hipDeviceAttributeMultiprocessorCount, dev) != hipSuccess) { fprintf(stderr, "kernel_launch: hipGetDevice / hipDeviceGetAttribute failed\n"); grid = -1; return; }
        if (hipFuncSetAttribute((const void*)fwd, hipFuncAttributeMaxDynamicSharedMemorySize, LDS_BYTES) != hipSuccess) { fprintf(stderr, "kernel_launch: hipFuncSetAttribute failed\n"); grid = -1; return; }
        if (hipOccupancyMaxActiveBlocksPerMultiprocessor(&per_cu, (const void*)fwd, NWAVES * 64, LDS_BYTES) != hipSuccess || per_cu < 1)
            fprintf(stderr, "kernel_launch: note: the occupancy query reports %d workgroups per CU\n", per_cu);
        (void)hipGetLastError();
        grid = cus;
    }
    if (grid < 0) return;
    if (hipMemsetAsync((char*)d_ws + WS_CTL, 0, CTL_ZERO_BYTES, stream) != hipSuccess) { fprintf(stderr, "kernel_launch: hipMemsetAsync failed\n"); return; }
    Args a{};
    for (int i = 0; i < 24; ++i) a.in[i] = (const float*)d_in[i];
    a.out = (float*)d_out; a.ws = (unsigned char*)d_ws;
#if MK_MULTI
    for (int p = 0; p < NPH; ++p) { a.ph_lo = p; a.ph_hi = p + 1; hipLaunchKernelGGL(fwd, dim3(grid), dim3(NWAVES * 64), LDS_BYTES, stream, a); }
#else
    a.ph_lo = 0; a.ph_hi = NPH; hipLaunchKernelGGL(fwd, dim3(grid), dim3(NWAVES * 64), LDS_BYTES, stream, a);
#endif
    const hipError_t le = hipPeekAtLastError();
    if (le != hipSuccess) fprintf(stderr, "kernel_launch: launch failed: %s\n", hipGetErrorName(le));
}
```

```cpp
#include <hip/hip_runtime.h>
#include <cstdio>
#include <cstdint>
namespace pg8 {
#define PG8_LAS __attribute__((address_space(3)))
typedef unsigned short bf16_t;
typedef short bf16x8 __attribute__((ext_vector_type(8)));
typedef float f32x4 __attribute__((ext_vector_type(4)));
typedef unsigned u32x4 __attribute__((ext_vector_type(4)));
constexpr int BM = 256, BK = 64, HALF = 128, HTB = HALF * BK * 2  , STAGE_BYTES = 8 * HTB, NXCD = 8, WGM = 8;

__host__ __device__ __forceinline__ int lds_byte(int r, int c) { const int st = (r >> 4) * 2 + (c >> 5), rr = r & 15, cc = c & 31, ob = rr * 64 + cc * 2; return st * 1024 + (ob ^ (((ob >> 9) & 1) << 5)); }
__host__ __device__ __forceinline__ void stage_rc(int b, int& R, int& C) { const int st = b / 1024, sb = b % 1024, swz = sb ^ (((sb >> 9) & 1) << 5); R = (st >> 1) * 16 + swz / 64; C = (st & 1) * 32 + (swz % 64) / 2; }
__host__ __device__ __forceinline__ int perm32(int rho) { const int n = rho >> 4, i = rho & 15; return 8 * (i >> 2) + 4 * n + (i & 3); }

struct Unit { int pm, pn, pb; };
struct Gemm { const bf16_t* A; const bf16_t* Bt; int M, N, K; };

struct StaticOrder {
    int nM, nN, nwg, G, c;
    __host__ __device__ void init(int M, int N, int G_, int c_) { nM = M / BM; nN = N / BM; nwg = nM * nN; G = G_; c = c_; }
    __host__ __device__ bool next(int i, Unit& u) const {
        const long L = (long)i * G + c; if (L >= nwg) return false;
        int wgid = (int)L; { const int q = nwg / NXCD, r = nwg % NXCD, xcd = wgid % NXCD, off = wgid / NXCD; wgid = (xcd < r ? xcd * (q + 1) : r * (q + 1) + (xcd - r) * q) + off; }
        const int nig = WGM * nN, gid = wgid / nig, fm = gid * WGM, gsz = (nM - fm) < WGM ? (nM - fm) : WGM;
        u.pm = fm + ((wgid % nig) % gsz); u.pn = (wgid % nig) / gsz; u.pb = u.pn; return true;
    }
    __device__ __forceinline__ void a_ready(const Unit&) const {}
    __device__ __forceinline__ void done(const Unit&) const {}
};

__device__ __forceinline__ unsigned cvt_pk_bf16(float lo, float hi) { unsigned r; asm volatile("v_cvt_pk_bf16_f32 %0, %1, %2" : "=v"(r) : "v"(lo), "v"(hi)); return r; }
__device__ __forceinline__ float sigm(float x) { return __builtin_amdgcn_rcpf(1.f + __builtin_amdgcn_exp2f(-1.4426950408889634f * x)); }
typedef int v4i_t __attribute__((ext_vector_type(4)));
typedef int v8i_t __attribute__((ext_vector_type(8)));
__device__ __forceinline__ v8i_t cat8(bf16x8 a, bf16x8 b) { return __builtin_shufflevector(__builtin_bit_cast(v4i_t, a), __builtin_bit_cast(v4i_t, b), 0, 1, 2, 3, 4, 5, 6, 7); }
__device__ __forceinline__ float clamp8(float x) { return __builtin_amdgcn_fmed3f(x, -448.f, 448.f); }
__device__ __forceinline__ unsigned pack_fp8x4(float a, float b, float c, float d) { int w = 0; w = __builtin_amdgcn_cvt_pk_fp8_f32(clamp8(a), clamp8(b), w, false); w = __builtin_amdgcn_cvt_pk_fp8_f32(clamp8(c), clamp8(d), w, true); return (unsigned)w; }
__device__ __forceinline__ float bf_lo(unsigned w) { return __uint_as_float(w << 16); }
__device__ __forceinline__ float bf_hi(unsigned w) { return __uint_as_float(w & 0xffff0000u); }

struct EpiSlab {
    static constexpr bool PERM = true, AFTER_DRAIN = false, HOOK = false;
    bf16_t* O; size_t slab_stride; int qslab; float qscale;
    __device__ __forceinline__ void operator()(const f32x4 (&acc)[2][2][4][2], const Unit& u, int wr, int wc, int fr, int fq) const {
        const int slab = u.pn >> 1; bf16_t* base = O + (size_t)slab * slab_stride; const float sc = (slab == qslab) ? qscale : 1.f;
        const int row0 = u.pm * BM + wr * 64 + fr, col0 = (u.pn & 1) * 256 + wc * 32 + 8 * fq;
#pragma unroll
        for (int ai = 0; ai < 2; ++ai)
#pragma unroll
            for (int m = 0; m < 4; ++m) { bf16_t* rowp = base + (size_t)(row0 + ai * HALF + m * 16) * 512 + col0;
#pragma unroll
                for (int bj = 0; bj < 2; ++bj) { const f32x4 v0 = acc[ai][bj][m][0] * sc, v1 = acc[ai][bj][m][1] * sc;
                    u32x4 w; w.x = cvt_pk_bf16(v0[0], v0[1]); w.y = cvt_pk_bf16(v0[2], v0[3]); w.z = cvt_pk_bf16(v1[0], v1[1]); w.w = cvt_pk_bf16(v1[2], v1[3]);
                    *(u32x4*)(rowp + bj * HALF) = w; } }
    }
};
__device__ __forceinline__ size_t gate_img(int br, int pm, int pn, int piece, int wave, int lane) { return ((((size_t)(br * 512 + pm * 4 + pn) * 16 + piece) * 8 + wave) * 64 + lane) * 8; }
typedef unsigned u32x2g __attribute__((ext_vector_type(2)));
__device__ __forceinline__ float gate_val(float x, float c) { return __builtin_fmaxf(__builtin_fmaf(__builtin_amdgcn_rcpf(1.f + __builtin_amdgcn_exp2f(x * c)), 256.f, 0.5f), 1.f); }
__device__ __forceinline__ f32x4 ub4(unsigned w) { return (f32x4){(float)(w & 0xffu), (float)((w >> 8) & 0xffu), (float)((w >> 16) & 0xffu), (float)(w >> 24)}; }
struct EpiSig {
    static constexpr bool PERM = true, AFTER_DRAIN = false, HOOK = false;
    unsigned char* O; float in_scale;
    __device__ __forceinline__ void operator()(const f32x4 (&acc)[2][2][4][2], const Unit& u, int wr, int wc, int fr, int fq) const {
        const int br = u.pn >> 2, pn = u.pn & 3, wave = wr * 4 + wc, lane = fq * 16 + fr;
#pragma unroll
        for (int ai = 0; ai < 2; ++ai)
#pragma unroll
            for (int m = 0; m < 4; ++m)
#pragma unroll
                for (int bj = 0; bj < 2; ++bj) { const f32x4 v0 = acc[ai][bj][m][0], v1 = acc[ai][bj][m][1];
                    const float c = -1.4426950408889634f * in_scale; u32x2g w; w.x = 0u; w.y = 0u;
#pragma unroll
                    for (int j = 0; j < 4; ++j) { w.x = __builtin_amdgcn_cvt_pk_u8_f32(gate_val(v0[j], c), j, w.x); w.y = __builtin_amdgcn_cvt_pk_u8_f32(gate_val(v1[j], c), j, w.y); }
                    *(u32x2g*)(O + gate_img(br, u.pm, pn, ai * 8 + m * 2 + bj, wave, lane)) = w; }
    }
};
struct EpiMerge {
    static constexpr bool PERM = true, AFTER_DRAIN = false, HOOK = true;
    const unsigned char* G; bf16_t* O;
    __device__ __forceinline__ void hook(f32x4 (&acc)[2][2][4][2], const Unit& u, int t, int wr, int wc, int fr, int fq) const {
        const int i = (t >> 3) - 1; int lane = fq * 16 + fr; const int wave = wr * 4 + wc;
        asm volatile("" : "+v"(lane));
#pragma unroll
        for (int ai = 0; ai < 2; ++ai) {
            u32x2g ga[4][2], gb[4][2];
#pragma unroll
            for (int m = 0; m < 4; ++m)
#pragma unroll
                for (int bj = 0; bj < 2; ++bj) { ga[m][bj] = *(const u32x2g*)(G + gate_img(i, u.pm, u.pn, ai * 8 + m * 2 + bj, wave, lane)); gb[m][bj] = *(const u32x2g*)(G + gate_img(i + 1, u.pm, u.pn, ai * 8 + m * 2 + bj, wave, lane)); }
            __builtin_amdgcn_sched_barrier(0);
#pragma unroll
            for (int m = 0; m < 4; ++m)
#pragma unroll
                for (int bj = 0; bj < 2; ++bj) { const f32x4 a0 = ub4(ga[m][bj].x), a1 = ub4(ga[m][bj].y), b0 = ub4(gb[m][bj].x), b1 = ub4(gb[m][bj].y);
                    f32x4 r0, r1;
#pragma unroll
                    for (int j = 0; j < 4; ++j) { r0[j] = a0[j] * __builtin_amdgcn_rcpf(b0[j]); r1[j] = a1[j] * __builtin_amdgcn_rcpf(b1[j]); }
                    acc[ai][bj][m][0] *= r0; acc[ai][bj][m][1] *= r1; }
            __builtin_amdgcn_sched_barrier(0);
        }
    }
    __device__ __forceinline__ void operator()(const f32x4 (&acc)[2][2][4][2], const Unit& u, int wr, int wc, int fr, int fq) const {
        const int row0 = u.pm * BM + wr * 64 + fr, col0 = u.pn * BM + wc * 32 + 8 * fq, lane = fq * 16 + fr, wave = wr * 4 + wc;
        u32x2g g[2][4][2];
#pragma unroll
        for (int ai = 0; ai < 2; ++ai)
#pragma unroll
            for (int m = 0; m < 4; ++m)
#pragma unroll
                for (int bj = 0; bj < 2; ++bj) g[ai][m][bj] = *(const u32x2g*)(G + gate_img(2, u.pm, u.pn, ai * 8 + m * 2 + bj, wave, lane));
        __builtin_amdgcn_sched_barrier(0);
#pragma unroll
        for (int ai = 0; ai < 2; ++ai)
#pragma unroll
            for (int m = 0; m < 4; ++m) { const size_t off = (size_t)(row0 + ai * HALF + m * 16) * 1024 + col0;
#pragma unroll
                for (int bj = 0; bj < 2; ++bj) { const f32x4 g0 = ub4(g[ai][m][bj].x) * (1.f / 256.f), g1 = ub4(g[ai][m][bj].y) * (1.f / 256.f); const f32x4 v0 = acc[ai][bj][m][0] * g0, v1 = acc[ai][bj][m][1] * g1;
                    u32x4 w; w.x = cvt_pk_bf16(v0[0], v0[1]); w.y = cvt_pk_bf16(v0[2], v0[3]); w.z = cvt_pk_bf16(v1[0], v1[1]); w.w = cvt_pk_bf16(v1[2], v1[3]);
                    *(u32x4*)(O + off + bj * HALF) = w; } }
    }
};
struct EpiRes {
    static constexpr bool PERM = false, AFTER_DRAIN = false, HOOK = false;
    const float* base; float* out; int ldc; float in_scale = 1.f;
    __device__ __forceinline__ void operator()(const f32x4 (&acc)[2][2][4][2], const Unit& u, int wr, int wc, int fr, int fq) const {
        const int row0 = u.pm * BM + wr * 64 + fr, col0 = u.pn * BM + wc * 32 + 4 * fq;
#pragma unroll
        for (int ai = 0; ai < 2; ++ai) {
            f32x4 bs[4][2][2];
#pragma unroll
            for (int m = 0; m < 4; ++m)
#pragma unroll
                for (int bj = 0; bj < 2; ++bj)
#pragma unroll
                    for (int n = 0; n < 2; ++n) bs[m][bj][n] = *(const f32x4*)(base + (size_t)(row0 + ai * HALF + m * 16) * ldc + col0 + bj * HALF + n * 16);
            __builtin_amdgcn_sched_barrier(0);
#pragma unroll
            for (int m = 0; m < 4; ++m)
#pragma unroll
                for (int bj = 0; bj < 2; ++bj)
#pragma unroll
                    for (int n = 0; n < 2; ++n) *(f32x4*)(out + (size_t)(row0 + ai * HALF + m * 16) * ldc + col0 + bj * HALF + n * 16) = bs[m][bj][n] + acc[ai][bj][m][n] * in_scale;
            __builtin_amdgcn_sched_barrier(0);
        }
    }
};
template <bool BASE_F32> struct EpiResB {
    static constexpr bool PERM = true, AFTER_DRAIN = false, HOOK = false;
    static constexpr int XLD = 2048;
    const void* base; bf16_t* out; float* ssq_part;
    __device__ __forceinline__ void operator()(const f32x4 (&acc)[2][2][4][2], const Unit& u, int wr, int wc, int fr, int fq) const {
        const int row0 = u.pm * BM + wr * 64 + fr, col0 = u.pn * BM + wc * 32 + 8 * fq;
#pragma unroll
        for (int ai = 0; ai < 2; ++ai) {
            f32x4 b0[4][2], b1[4][2];
            if constexpr (BASE_F32) {
#pragma unroll
                for (int m = 0; m < 4; ++m)
#pragma unroll
                    for (int bj = 0; bj < 2; ++bj) { const float* p = (const float*)base + (size_t)(row0 + ai * HALF + m * 16) * 1024 + col0 + bj * HALF; b0[m][bj] = *(const f32x4*)p; b1[m][bj] = *(const f32x4*)(p + 4); }
            } else {
                u32x4 q[4][2];
#pragma unroll
                for (int m = 0; m < 4; ++m)
#pragma unroll
                    for (int bj = 0; bj < 2; ++bj) q[m][bj] = *(const u32x4*)((const bf16_t*)base + (size_t)(row0 + ai * HALF + m * 16) * XLD + col0 + bj * HALF);
                __builtin_amdgcn_sched_barrier(0);
#pragma unroll
                for (int m = 0; m < 4; ++m)
#pragma unroll
                    for (int bj = 0; bj < 2; ++bj) { b0[m][bj] = (f32x4){bf_lo(q[m][bj].x), bf_hi(q[m][bj].x), bf_lo(q[m][bj].y), bf_hi(q[m][bj].y)}; b1[m][bj] = (f32x4){bf_lo(q[m][bj].z), bf_hi(q[m][bj].z), bf_lo(q[m][bj].w), bf_hi(q[m][bj].w)}; }
            }
            __builtin_amdgcn_sched_barrier(0);
#pragma unroll
            for (int m = 0; m < 4; ++m) { float ss = 0.f;
#pragma unroll
                for (int bj = 0; bj < 2; ++bj) { const f32x4 v0 = b0[m][bj] + acc[ai][bj][m][0], v1 = b1[m][bj] + acc[ai][bj][m][1];
                    ss += ((v0[0] * v0[0] + v0[1] * v0[1]) + (v0[2] * v0[2] + v0[3] * v0[3])) + ((v1[0] * v1[0] + v1[1] * v1[1]) + (v1[2] * v1[2] + v1[3] * v1[3]));
                    u32x4 w; w.x = cvt_pk_bf16(v0[0], v0[1]); w.y = cvt_pk_bf16(v0[2], v0[3]); w.z = cvt_pk_bf16(v1[0], v1[1]); w.w = cvt_pk_bf16(v1[2], v1[3]);
                    *(u32x4*)(out + (size_t)(row0 + ai * HALF + m * 16) * XLD + col0 + bj * HALF) = w; }
                if (ssq_part) { ss += __shfl_xor(ss, 16); ss += __shfl_xor(ss, 32); if (fq == 0) ssq_part[(size_t)(row0 + ai * HALF + m * 16) * 16 + u.pn * 4 + wc] = ss; } }
            __builtin_amdgcn_sched_barrier(0);
        }
    }
};
struct EpiSwiGLU {
    static constexpr bool PERM = true, AFTER_DRAIN = false, HOOK = false;
    bf16_t* O; int ldc;
    __device__ __forceinline__ void operator()(const f32x4 (&acc)[2][2][4][2], const Unit& u, int wr, int wc, int fr, int fq) const {
        const int row0 = u.pm * BM + wr * 64 + fr, col0 = u.pn * HALF + wc * 32 + 8 * fq;
#pragma unroll
        for (int ai = 0; ai < 2; ++ai)
#pragma unroll
            for (int m = 0; m < 4; ++m) { f32x4 v0, v1;
#pragma unroll
                for (int j = 0; j < 4; ++j) { const float g0 = acc[ai][0][m][0][j], g1 = acc[ai][0][m][1][j]; v0[j] = g0 * sigm(g0) * acc[ai][1][m][0][j]; v1[j] = g1 * sigm(g1) * acc[ai][1][m][1][j]; }
                u32x4 w; w.x = cvt_pk_bf16(v0[0], v0[1]); w.y = cvt_pk_bf16(v0[2], v0[3]); w.z = cvt_pk_bf16(v1[0], v1[1]); w.w = cvt_pk_bf16(v1[2], v1[3]);
                *(u32x4*)(O + (size_t)(row0 + ai * HALF + m * 16) * ldc + col0) = w; }
    }
};
struct EpiSwiGLUR {
    static constexpr bool PERM = true, AFTER_DRAIN = false, HOOK = false;
    bf16_t* O; int ldc; const float* ssq_part; float inv_d, eps;
    __device__ __forceinline__ void operator()(const f32x4 (&acc)[2][2][4][2], const Unit& u, int wr, int wc, int fr, int fq) const {
        const int row0 = u.pm * BM + wr * 64 + fr, col0 = u.pn * HALF + wc * 32 + 8 * fq;
        f32x4 pp[2][4];
#pragma unroll
        for (int ai = 0; ai < 2; ++ai)
#pragma unroll
            for (int m = 0; m < 4; ++m) pp[ai][m] = *(const f32x4*)(ssq_part + (size_t)(row0 + ai * HALF + m * 16) * 16 + 4 * fq);
#pragma unroll
        for (int ai = 0; ai < 2; ++ai)
#pragma unroll
            for (int m = 0; m < 4; ++m) { float s = (pp[ai][m][0] + pp[ai][m][1]) + (pp[ai][m][2] + pp[ai][m][3]); s += __shfl_xor(s, 16); s += __shfl_xor(s, 32);
                const float rs = __builtin_amdgcn_rsqf(s * inv_d + eps); f32x4 v0, v1;
#pragma unroll
                for (int j = 0; j < 4; ++j) { const float g0 = acc[ai][0][m][0][j] * rs, g1 = acc[ai][0][m][1][j] * rs; v0[j] = g0 * sigm(g0) * (acc[ai][1][m][0][j] * rs); v1[j] = g1 * sigm(g1) * (acc[ai][1][m][1][j] * rs); }
                u32x4 w; w.x = cvt_pk_bf16(v0[0], v0[1]); w.y = cvt_pk_bf16(v0[2], v0[3]); w.z = cvt_pk_bf16(v1[0], v1[1]); w.w = cvt_pk_bf16(v1[2], v1[3]);
                *(u32x4*)(O + (size_t)(row0 + ai * HALF + m * 16) * ldc + col0) = w; }
    }
};
struct EpiSwiGLU8 {
    static constexpr bool PERM = true, AFTER_DRAIN = false, HOOK = false;
    unsigned char* O; int ldc; float in_scale, out_scale;
    __device__ __forceinline__ void operator()(const f32x4 (&acc)[2][2][4][2], const Unit& u, int wr, int wc, int fr, int fq) const {
        const int row0 = u.pm * BM + wr * 64 + fr, col0 = u.pn * HALF + wc * 32 + 8 * fq; const float c1 = in_scale * in_scale * out_scale, c2 = -1.4426950408889634f * in_scale;
#pragma unroll
        for (int ai = 0; ai < 2; ++ai)
#pragma unroll
            for (int m = 0; m < 4; ++m) { f32x4 v0, v1;
#pragma unroll
                for (int j = 0; j < 4; ++j) { const float g0 = acc[ai][0][m][0][j], g1 = acc[ai][0][m][1][j];
                    v0[j] = (g0 * acc[ai][1][m][0][j]) * __builtin_amdgcn_rcpf(1.f + __builtin_amdgcn_exp2f(g0 * c2)) * c1; v1[j] = (g1 * acc[ai][1][m][1][j]) * __builtin_amdgcn_rcpf(1.f + __builtin_amdgcn_exp2f(g1 * c2)) * c1; }
                typedef unsigned u32x2_t __attribute__((ext_vector_type(2)));
                u32x2_t w; w.x = pack_fp8x4(v0[0], v0[1], v0[2], v0[3]); w.y = pack_fp8x4(v1[0], v1[1], v1[2], v1[3]);
                *(u32x2_t*)(O + (size_t)(row0 + ai * HALF + m * 16) * ldc + col0) = w; }
    }
};
struct EpiMoeDown {
    static constexpr bool PERM = true, AFTER_DRAIN = false, HOOK = false;
    bf16_t* Y; const int* row_tok; const float* row_g; float in_scale;
    __device__ __forceinline__ void operator()(const f32x4 (&acc)[2][2][4][2], const Unit& u, int wr, int wc, int fr, int fq) const {
        const int row0 = u.pm * BM + wr * 64 + fr, col0 = u.pn * BM + wc * 32 + 8 * fq;
#pragma unroll
        for (int ai = 0; ai < 2; ++ai)
#pragma unroll
            for (int m = 0; m < 4; ++m) { const int r = row0 + ai * HALF + m * 16; const int tok = row_tok[r]; const float g = row_g[r] * in_scale;
                if (tok >= 0) { bf16_t* p = Y + (size_t)tok * 1024 + col0;
#pragma unroll
                    for (int bj = 0; bj < 2; ++bj) { const f32x4 v0 = acc[ai][bj][m][0] * g, v1 = acc[ai][bj][m][1] * g;
                        u32x4 w; w.x = cvt_pk_bf16(v0[0], v0[1]); w.y = cvt_pk_bf16(v0[2], v0[3]); w.z = cvt_pk_bf16(v1[0], v1[1]); w.w = cvt_pk_bf16(v1[2], v1[3]);
                        *(u32x4*)(p + bj * HALF) = w; } } }
    }
};
struct MoeRange {
    int nM, nN, lo, hi; const PG8_LAS int* tile_e;
    __device__ void init(int nM_, int nN_, int lo_, int hi_, const PG8_LAS int* te) { nM = nM_; nN = nN_; lo = lo_; hi = hi_; tile_e = te; }
    __device__ bool next(int i, Unit& u) const {
        const int wgid = lo + i; if (wgid >= hi) return false;
        const int nig = WGM * nN, gid = wgid / nig, fm = gid * WGM, gsz = (nM - fm) < WGM ? (nM - fm) : WGM;
        u.pm = fm + ((wgid % nig) % gsz); u.pn = (wgid % nig) / gsz;
        const int e = __builtin_amdgcn_readfirstlane(tile_e[u.pm]); u.pb = e * nN + u.pn; return true;
    }
    __device__ __forceinline__ void a_ready(const Unit&) const {}
    __device__ __forceinline__ void done(const Unit&) const {}
};
struct MoeOrder {
    int nM, nN, nwg, G, c; const PG8_LAS int* tile_e;
    __device__ void init(int nM_, int nN_, int G_, int c_, const PG8_LAS int* te) { nM = nM_; nN = nN_; nwg = nM * nN; G = G_; c = c_; tile_e = te; }
    __device__ bool next(int i, Unit& u) const {
        const long L = (long)i * G + c; if (L >= nwg) return false;
        int wgid = (int)L; { const int q = nwg / NXCD, r = nwg % NXCD, xcd = wgid % NXCD, off = wgid / NXCD; wgid = (xcd < r ? xcd * (q + 1) : r * (q + 1) + (xcd - r) * q) + off; }
        const int nig = WGM * nN, gid = wgid / nig, fm = gid * WGM, gsz = (nM - fm) < WGM ? (nM - fm) : WGM;
        u.pm = fm + ((wgid % nig) % gsz); u.pn = (wgid % nig) / gsz;
        const int e = __builtin_amdgcn_readfirstlane(tile_e[u.pm]); u.pb = e * nN + u.pn; return true;
    }
    __device__ __forceinline__ void a_ready(const Unit&) const {}
    __device__ __forceinline__ void done(const Unit&) const {}
};
template <class Epi, class Sched, bool ALIGN_EPI = false, bool SP2 = false, bool FP8 = false, int LDA = 0>
__device__ __forceinline__ void gemm_phase(PG8_LAS unsigned char* lds, const Gemm g, const Sched& S, const Epi& E) {
    int tid_ = threadIdx.x; asm volatile("" : "+v"(tid_));
    const int tid = tid_, wid = __builtin_amdgcn_readfirstlane(tid >> 6), lane = tid & 63, wr = wid >> 2, wc = wid & 3, fr = lane & 15, fq = lane >> 4;
    const int K = g.K, nt = K / BK;
    unsigned voffA[2], voffB[2];
#pragma unroll
    for (int i = 0; i < 2; ++i) { int R, C; stage_rc(tid * 16 + i * 8192, R, C); const int Rb = Epi::PERM ? ((R & ~31) + perm32(R & 31)) : R;
        voffA[i] = (unsigned)(R * (LDA ? LDA : K) + C) * 2u; voffB[i] = (unsigned)(Rb * K + C) * 2u; }
    const size_t kstep = (size_t)(BK * 2);
    const size_t hstep = (size_t)HALF * K * 2;
    const size_t tstep = 2 * hstep;
    const size_t hstepA = (size_t)HALF * (LDA ? LDA : K) * 2, tstepA = 2 * hstepA;
    const unsigned ldsw = (unsigned)wid * 1024u;
    const int aoff = lds_byte(wr * 64 + fr, fq * 8), boff = lds_byte(wc * 32 + fr, fq * 8);
#define PG8_SA(b, h) (((b) * 2 + (h)) * HTB)
#define PG8_SB(b, h) ((4 + (b) * 2 + (h)) * HTB)
#define PG8_STAGE(bufoff, gbase, voff) do { _Pragma("unroll") for (int _i = 0; _i < 2; ++_i) \
        __builtin_amdgcn_global_load_lds((const unsigned*)((const char*)(gbase) + (voff)[_i]), (PG8_LAS unsigned*)(lds + (bufoff) + ldsw + _i * 8192), 16, 0, 0); } while (0)
#define PG8_LDA(dst, b, h) do { _Pragma("unroll") for (int m = 0; m < 4; ++m) _Pragma("unroll") for (int k = 0; k < 2; ++k) dst[m][k] = *(const PG8_LAS bf16x8*)(lds + PG8_SA(b, h) + aoff + m * 2048 + k * 1024); } while (0)
#define PG8_LDB(dst, b, h) do { _Pragma("unroll") for (int n = 0; n < 2; ++n) _Pragma("unroll") for (int k = 0; k < 2; ++k) dst[n][k] = *(const PG8_LAS bf16x8*)(lds + PG8_SB(b, h) + boff + n * 2048 + k * 1024); } while (0)
#define PG8_MMA(ai, bj, At, Bt) do { __builtin_amdgcn_s_setprio(1); \
        if constexpr (FP8) { _Pragma("unroll") for (int m = 0; m < 4; ++m) _Pragma("unroll") for (int n = 0; n < 2; ++n) \
            asm volatile("v_mfma_f32_16x16x128_f8f6f4 %0, %1, %2, %0" : "+v"(acc[ai][bj][m][n]) : "v"(cat8(Bt[n][0], Bt[n][1])), "v"(cat8(At[m][0], At[m][1]))); } \
        else { _Pragma("unroll") for (int m = 0; m < 4; ++m) _Pragma("unroll") for (int n = 0; n < 2; ++n) _Pragma("unroll") for (int k = 0; k < 2; ++k) \
            acc[ai][bj][m][n] = __builtin_amdgcn_mfma_f32_16x16x32_bf16(Bt[n][k], At[m][k], acc[ai][bj][m][n], 0, 0, 0); } \
        __builtin_amdgcn_s_setprio(0); } while (0)
#define PG8_WAIT_V(n) asm volatile("s_waitcnt vmcnt(" #n ")" ::: "memory")
#define PG8_WAIT_L(n) asm volatile("s_waitcnt lgkmcnt(" #n ")" ::: "memory")
#define PG8_BAR __builtin_amdgcn_s_barrier()
#define PG8_SCHED __builtin_amdgcn_sched_barrier(0)
    Unit cur, nxt; int ui = 0;
    if (!S.next(0, cur)) return;
    f32x4 acc[2][2][4][2];
#pragma unroll
    for (int a = 0; a < 2; ++a)
#pragma unroll
        for (int b = 0; b < 2; ++b)
#pragma unroll
            for (int m = 0; m < 4; ++m)
#pragma unroll
                for (int n = 0; n < 2; ++n) acc[a][b][m][n] = (f32x4){0.f, 0.f, 0.f, 0.f};
    bf16x8 At[4][2], B0[2][2], B1[2][2];
    const char* cA = (const char*)g.A + (size_t)cur.pm * tstepA; const char* cB = (const char*)g.Bt + (size_t)cur.pb * tstep;
    S.a_ready(cur);
    if constexpr (SP2) {
        PG8_STAGE(PG8_SB(0, 0), cB, voffB); PG8_STAGE(PG8_SB(0, 1), cB + hstep, voffB); PG8_STAGE(PG8_SA(0, 0), cA, voffA); PG8_STAGE(PG8_SA(0, 1), cA + hstepA, voffA);
        if (wr == 1) PG8_BAR;
        PG8_WAIT_V(2); PG8_BAR;
        PG8_STAGE(PG8_SB(1, 0), cB + kstep, voffB); PG8_STAGE(PG8_SA(1, 0), cA + kstep, voffA); PG8_STAGE(PG8_SB(1, 1), cB + hstep + kstep, voffB);
        PG8_WAIT_V(6); PG8_BAR;
    } else {
        PG8_STAGE(PG8_SB(0, 0), cB, voffB); PG8_STAGE(PG8_SA(0, 0), cA, voffA); PG8_STAGE(PG8_SB(0, 1), cB + hstep, voffB); PG8_STAGE(PG8_SA(0, 1), cA + hstepA, voffA);
        if (wr == 1) PG8_BAR;
        PG8_WAIT_V(4); PG8_BAR;
        PG8_STAGE(PG8_SB(1, 0), cB + kstep, voffB); PG8_STAGE(PG8_SA(1, 0), cA + kstep, voffA); PG8_STAGE(PG8_SB(1, 1), cB + hstep + kstep, voffB);
        PG8_WAIT_V(6); PG8_BAR;
    }
    for (;;) {
        const bool has_next = S.next(ui + 1, nxt);
        const char* nA = has_next ? (const char*)g.A + (size_t)nxt.pm * tstepA : cA; const char* nB = has_next ? (const char*)g.Bt + (size_t)nxt.pb * tstep : cB;
        for (int t = 0; t < nt; t += 2) {
            if constexpr (Epi::HOOK) { if (t == 8 || t == 16) E.hook(acc, cur, t, wr, wc, fr, fq); }
            const bool last = (t == nt - 2);
            const char* a1 = cA + (size_t)(t + 1) * kstep;
            const char* a2 = last ? nA : cA + (size_t)(t + 2) * kstep; const char* b2 = last ? nB : cB + (size_t)(t + 2) * kstep;
            const char* a3 = a2 + kstep; const char* b3 = b2 + kstep;
            if (last && has_next) S.a_ready(nxt);
            if constexpr (SP2) {
            PG8_LDB(B0, 0, 0); PG8_LDB(B1, 0, 1); PG8_SCHED; PG8_LDA(At, 0, 0); PG8_STAGE(PG8_SA(1, 1), a1 + hstepA, voffA);
            PG8_WAIT_V(8); PG8_WAIT_L(0); PG8_BAR; PG8_MMA(0, 0, At, B0); PG8_MMA(0, 1, At, B1); PG8_BAR; PG8_SCHED;
            PG8_LDA(At, 0, 1); PG8_STAGE(PG8_SB(0, 0), b2, voffB); PG8_STAGE(PG8_SB(0, 1), b2 + hstep, voffB); PG8_STAGE(PG8_SA(0, 0), a2, voffA);
            PG8_WAIT_V(8); PG8_WAIT_L(0); PG8_BAR; PG8_MMA(1, 0, At, B0); PG8_MMA(1, 1, At, B1); PG8_BAR; PG8_SCHED;
            PG8_LDB(B0, 1, 0); PG8_LDB(B1, 1, 1); PG8_SCHED; PG8_LDA(At, 1, 0); PG8_STAGE(PG8_SA(0, 1), a2 + hstepA, voffA);
            PG8_WAIT_V(8); PG8_WAIT_L(0); PG8_BAR; PG8_MMA(0, 0, At, B0); PG8_MMA(0, 1, At, B1); PG8_BAR; PG8_SCHED;
            PG8_LDA(At, 1, 1); PG8_STAGE(PG8_SB(1, 0), b3, voffB); PG8_STAGE(PG8_SB(1, 1), b3 + hstep, voffB); PG8_STAGE(PG8_SA(1, 0), a3, voffA);
            PG8_WAIT_V(8); PG8_WAIT_L(0); PG8_BAR; PG8_MMA(1, 0, At, B0); PG8_MMA(1, 1, At, B1); PG8_BAR; PG8_SCHED;
            } else {
            PG8_LDB(B0, 0, 0); PG8_SCHED; PG8_LDA(At, 0, 0); PG8_STAGE(PG8_SA(1, 1), a1 + hstepA, voffA);
            PG8_WAIT_L(8); PG8_BAR; PG8_WAIT_L(0); PG8_MMA(0, 0, At, B0); PG8_BAR; PG8_SCHED;
            PG8_LDB(B1, 0, 1); PG8_STAGE(PG8_SB(0, 0), b2, voffB);
            PG8_BAR; PG8_WAIT_L(0); PG8_MMA(0, 1, At, B1); PG8_BAR;
            PG8_LDA(At, 0, 1); PG8_STAGE(PG8_SA(0, 0), a2, voffA);
            PG8_BAR; PG8_WAIT_L(0); PG8_MMA(1, 0, At, B0); PG8_BAR; PG8_SCHED;
            PG8_STAGE(PG8_SB(0, 1), b2 + hstep, voffB);
            PG8_WAIT_V(6); PG8_BAR; PG8_MMA(1, 1, At, B1); PG8_BAR;
            PG8_LDB(B0, 1, 0); PG8_SCHED; PG8_LDA(At, 1, 0); PG8_STAGE(PG8_SA(0, 1), a2 + hstepA, voffA);
            PG8_WAIT_L(8); PG8_BAR; PG8_WAIT_L(0); PG8_MMA(0, 0, At, B0); PG8_BAR; PG8_SCHED;
            PG8_LDB(B1, 1, 1); PG8_STAGE(PG8_SB(1, 0), b3, voffB);
            PG8_BAR; PG8_WAIT_L(0); PG8_MMA(0, 1, At, B1); PG8_BAR;
            PG8_LDA(At, 1, 1); PG8_STAGE(PG8_SA(1, 0), a3, voffA);
            PG8_BAR; PG8_WAIT_L(0); PG8_MMA(1, 0, At, B0); PG8_BAR; PG8_SCHED;
            PG8_STAGE(PG8_SB(1, 1), b3 + hstep, voffB);
            PG8_WAIT_V(6); PG8_BAR; PG8_MMA(1, 1, At, B1); PG8_BAR;
            }
        }
        if constexpr (ALIGN_EPI) { if (wr == 0) PG8_BAR; }
        if constexpr (FP8) {
            asm volatile("s_nop 15\n\ts_nop 15" : "+v"(acc[0][0][0][0]), "+v"(acc[0][0][0][1]), "+v"(acc[0][0][1][0]), "+v"(acc[0][0][1][1]), "+v"(acc[0][0][2][0]), "+v"(acc[0][0][2][1]), "+v"(acc[0][0][3][0]), "+v"(acc[0][0][3][1]));
            asm volatile("" : "+v"(acc[0][1][0][0]), "+v"(acc[0][1][0][1]), "+v"(acc[0][1][1][0]), "+v"(acc[0][1][1][1]), "+v"(acc[0][1][2][0]), "+v"(acc[0][1][2][1]), "+v"(acc[0][1][3][0]), "+v"(acc[0][1][3][1]));
            asm volatile("" : "+v"(acc[1][0][0][0]), "+v"(acc[1][0][0][1]), "+v"(acc[1][0][1][0]), "+v"(acc[1][0][1][1]), "+v"(acc[1][0][2][0]), "+v"(acc[1][0][2][1]), "+v"(acc[1][0][3][0]), "+v"(acc[1][0][3][1]));
            asm volatile("" : "+v"(acc[1][1][0][0]), "+v"(acc[1][1][0][1]), "+v"(acc[1][1][1][0]), "+v"(acc[1][1][1][1]), "+v"(acc[1][1][2][0]), "+v"(acc[1][1][2][1]), "+v"(acc[1][1][3][0]), "+v"(acc[1][1][3][1])); }
        if constexpr (!Epi::AFTER_DRAIN) { E(acc, cur, wr, wc, fr, fq); S.done(cur); }
        if (!has_next) break;
#pragma unroll
        for (int a = 0; a < 2; ++a)
#pragma unroll
            for (int b = 0; b < 2; ++b)
#pragma unroll
                for (int m = 0; m < 4; ++m)
#pragma unroll
                    for (int n = 0; n < 2; ++n) acc[a][b][m][n] = (f32x4){0.f, 0.f, 0.f, 0.f};
        cur = nxt; cA = nA; cB = nB; ++ui;
        if constexpr (ALIGN_EPI) { if (wr == 1) PG8_BAR; }
    }
    PG8_WAIT_V(0);
    if constexpr (!ALIGN_EPI) { if (wr == 0) PG8_BAR; }
    PG8_BAR;
    if constexpr (Epi::AFTER_DRAIN) { E.fused(acc, cur, wr, wc, fr, fq, lds, wid, lane); S.done(cur); }
#undef PG8_SA
#undef PG8_SB
#undef PG8_STAGE
#undef PG8_LDA
#undef PG8_LDB
#undef PG8_MMA
#undef PG8_WAIT_V
#undef PG8_WAIT_L
#undef PG8_BAR
#undef PG8_SCHED
}
}
#include <hip/hip_bf16.h>
#include <cmath>
namespace attn_body {
using bf16=__hip_bfloat16;
using bf16x8=__attribute__((ext_vector_type(8)))short;
using s16x4=__attribute__((ext_vector_type(4)))short;
using f32x16=__attribute__((ext_vector_type(16)))float;
using u32x4=__attribute__((ext_vector_type(4)))unsigned;
constexpr int BATCH=4,NHEAD=8,SEQ=8192,D=64,DM=NHEAD*D,DMO=1536,OCOL=1024;
constexpr int NW=8,QBLK=32,QB=QBLK*NW,KVBLK=64,NQB=SEQ/QB;
constexpr int ATTN_PITCH=DM, ATTN_UNIT_ROWS=QB;
__device__ __forceinline__ int crow(int r,int hi){return (r&3)+8*(r>>2)+4*hi;}
#define SBAR() __builtin_amdgcn_sched_barrier(0)
__device__ __forceinline__ void cmask(f32x16&p0,f32x16&p1,int jb,int qrel,int hi){
  const float NEG=-INFINITY; int kb=64*jb+4*hi;
  #pragma unroll
  for(int r=0;r<16;++r){int kv=kb+(r&3)+8*(r>>2); if(kv>qrel)p0[r]=NEG; if(kv+32>qrel)p1[r]=NEG;}
}

constexpr int NSLOT=3, SLOTB=8192;
constexpr int LDS_K=0, LDS_V=NSLOT*SLOTB, LDS_WS=2*NSLOT*SLOTB, LDS_OST=LDS_WS+NW*64*4, LDS_NB=LDS_OST+NW*4096, LDS_BYTES=LDS_NB+SEQ*4;
constexpr float C2=0.125f*1.4426950408889634f;
__device__ __forceinline__ void glds16(const void*gsrc,unsigned lds_dst){unsigned keep;
  asm volatile("s_mov_b32 %0, m0\n\ts_mov_b32 m0, %2\n\ts_nop 0\n\tglobal_load_lds_dwordx4 %1, off\n\ts_mov_b32 m0, %0":"=&s"(keep):"v"(gsrc),"s"(lds_dst):"memory");}
__device__ __forceinline__ float max3f(float a,float b,float c){float r;asm("v_max3_f32 %0, %1, %2, %3":"=v"(r):"v"(a),"v"(b),"v"(c));return r;}
__device__ __forceinline__ float max2f(float a,float b){float r;asm("v_max_f32_e32 %0, %1, %2":"=v"(r):"v"(a),"v"(b));return r;}
__device__ __forceinline__ float fadd_s(float a,float b){float r;asm("v_add_f32_e32 %0, %1, %2":"=v"(r):"v"(a),"v"(b));return r;}
__device__ __forceinline__ float fsub_s(float a,float b){float r;asm("v_sub_f32_e32 %0, %1, %2":"=v"(r):"v"(a),"v"(b));return r;}
typedef float f32x2_t __attribute__((ext_vector_type(2))); typedef __bf16 bf16x2_t __attribute__((ext_vector_type(2)));
__device__ __forceinline__ unsigned cvtpk_s(float lo,float hi){f32x2_t v={lo,hi};bf16x2_t b=__builtin_convertvector(v,bf16x2_t);return __builtin_bit_cast(unsigned,b);}
#define WAIT_BAR(N) asm volatile("s_waitcnt vmcnt(" #N ") lgkmcnt(0)\n\ts_barrier":::"memory")

__device__ __forceinline__ void qkt(f32x16&p0,f32x16&p1,const char*Kslot,const bf16x8*qr,int r32,int hi){
  const char*kb=Kslot+hi*1024+r32*16;
  #pragma unroll
  for(int d0=0;d0<4;++d0){
    const bf16x8 b0=*reinterpret_cast<const bf16x8*>(kb+d0*2048);
    const bf16x8 b1=*reinterpret_cast<const bf16x8*>(kb+d0*2048+512);
    p0=__builtin_amdgcn_mfma_f32_32x32x16_bf16(b0,qr[d0],p0,0,0,0);p1=__builtin_amdgcn_mfma_f32_32x32x16_bf16(b1,qr[d0],p1,0,0,0);}
}
typedef __attribute__((address_space(3))) const char* lds_cptr;
typedef short v4i16_t __attribute__((ext_vector_type(4)));
__device__ __forceinline__ void kload8(bf16x8*kf,lds_cptr kp){
  kf[0]=*(const __attribute__((address_space(3))) bf16x8*)(kp);      kf[1]=*(const __attribute__((address_space(3))) bf16x8*)(kp+512);
  kf[2]=*(const __attribute__((address_space(3))) bf16x8*)(kp+2048); kf[3]=*(const __attribute__((address_space(3))) bf16x8*)(kp+2560);
  kf[4]=*(const __attribute__((address_space(3))) bf16x8*)(kp+4096); kf[5]=*(const __attribute__((address_space(3))) bf16x8*)(kp+4608);
  kf[6]=*(const __attribute__((address_space(3))) bf16x8*)(kp+6144); kf[7]=*(const __attribute__((address_space(3))) bf16x8*)(kp+6656);
}
__device__ __forceinline__ void kload2(bf16x8*kf,lds_cptr kp,int j){ kf[2*j]=*(const __attribute__((address_space(3))) bf16x8*)(kp+j*2048); kf[2*j+1]=*(const __attribute__((address_space(3))) bf16x8*)(kp+j*2048+512); }
__device__ __forceinline__ s16x4 vtr(lds_cptr p){ return __builtin_bit_cast(s16x4,__builtin_amdgcn_ds_read_tr16_b64_v4i16((__attribute__((address_space(3))) v4i16_t*)p)); }
__device__ __forceinline__ float rowmax(const f32x16&p0,const f32x16&p1){
  float a=max3f(p0[0],p0[1],p1[0]),b=max3f(p0[2],p0[3],p1[1]);a=max3f(a,p1[2],p1[3]);
  #pragma unroll
  for(int r=4;r<16;r+=4){a=max3f(a,p0[r],p0[r+1]);b=max3f(b,p0[r+2],p0[r+3]);a=max3f(a,p1[r],p1[r+1]);b=max3f(b,p1[r+2],p1[r+3]);}
  const float m=max2f(a,b);
  auto rr=__builtin_amdgcn_permlane32_swap(__float_as_uint(m),__float_as_uint(m),false,false);
  return max2f(__uint_as_float(rr[0]),__uint_as_float(rr[1]));
}
__device__ __forceinline__ void pv(f32x16*o,int vb,bf16x8 pa0,bf16x8 pa1,bf16x8 pa2,bf16x8 pa3){
  #pragma unroll
  for(int d0=0;d0<2;++d0){s16x4 lo[4],hi[4];
    #pragma unroll
    for(int ks=0;ks<4;++ks){
      asm volatile("ds_read_b64_tr_b16 %0,%1 offset:%c2":"=&v"(lo[ks]):"v"(vb),"i"(d0*4096+ks*1024):"memory");
      asm volatile("ds_read_b64_tr_b16 %0,%1 offset:%c2":"=&v"(hi[ks]):"v"(vb),"i"(d0*4096+ks*1024+512):"memory");}
    asm volatile("s_waitcnt lgkmcnt(0)":::"memory");SBAR();
    #define PK(k) (bf16x8){lo[k][0],lo[k][1],lo[k][2],lo[k][3],hi[k][0],hi[k][1],hi[k][2],hi[k][3]}
    o[d0]=__builtin_amdgcn_mfma_f32_32x32x16_bf16(pa0,PK(0),o[d0],0,0,0);
    o[d0]=__builtin_amdgcn_mfma_f32_32x32x16_bf16(pa1,PK(1),o[d0],0,0,0);
    o[d0]=__builtin_amdgcn_mfma_f32_32x32x16_bf16(pa2,PK(2),o[d0],0,0,0);
    o[d0]=__builtin_amdgcn_mfma_f32_32x32x16_bf16(pa3,PK(3),o[d0],0,0,0);
    #undef PK
  }
}

#ifndef ATTN_STORE16
#define ATTN_STORE16(p,v) (*(u32x4*)(p)=(v))
#endif
typedef float f32x4v __attribute__((ext_vector_type(4)));
__device__ __forceinline__ int attn_t0(int qb,const float*__restrict__ nbg,const float*__restrict__ qnw,const float*__restrict__ knw,const float*__restrict__ xmw,int lane){
  const int q0=qb*QB; float qn=0.f,kn=0.f,xm=3.0e38f; if(lane<8){qn=qnw[qb*8+lane];xm=xmw[qb*8+lane];}
  _Pragma("unroll") for(int i=0;i<4;++i){const int idx=lane*4+i; if(idx<(qb+1)*8)kn=__builtin_fmaxf(kn,knw[idx]);}
  _Pragma("unroll") for(int o_=1;o_<64;o_<<=1){qn=__builtin_fmaxf(qn,__shfl_xor(qn,o_));kn=__builtin_fmaxf(kn,__shfl_xor(kn,o_));xm=__builtin_fminf(xm,__shfl_xor(xm,o_));}
  const float thr=56.f+sqrtf(qn*kn)-xm; const int NT0=(q0+QB)/KVBLK;
  bool c_=(lane>=1)&&(2*lane<=NT0-4); float d_=0.f; if(c_)d_=nbg[128*lane-1]-nbg[q0]; c_=c_&&(d_<=-thr);
  return __builtin_amdgcn_readfirstlane(2*(int)__popcll(__ballot(c_)));
}
template<int THRL> __device__ __forceinline__ void attn_unit(int b,int h,int qb,const bf16*Q,const bf16*__restrict__ K,const bf16*__restrict__ V,bf16*O,const float*__restrict__ nbg,const int t0,char*shm){
  int tid_=threadIdx.x; asm volatile("":"+v"(tid_));
  const int tid=tid_,lane=tid&63,r32=lane&31,hi=lane>>5; const int wid=__builtin_amdgcn_readfirstlane(tid>>6);
  const long rowbase=(long)b*SEQ; const int q0=qb*QB;
  const bf16*Qw=Q+(rowbase+q0+wid*QBLK)*DM+h*D;
  const bf16*Kh=K+(rowbase+(long)t0*KVBLK)*DM+h*D,*Vh=V+(rowbase+(long)t0*KVBLK)*DM+h*D;
  const unsigned lds0=(unsigned)(uintptr_t)shm;
  float*wsf=(float*)(shm+LDS_WS)+wid*64;
  const bf16*ksrc=Kh+(long)lane*DM+wid*8;
  const bf16*vsrc=Vh+(long)(16*(wid&3)+(lane>>2))*DM+(wid>>2)*32+(lane&3)*8;
  const unsigned kdst=lds0+LDS_K+wid*1024, vdst=lds0+LDS_V+wid*1024;
  #define DMA_K(t,slot) glds16(ksrc+(long)(t)*KVBLK*DM,(unsigned)__builtin_amdgcn_readfirstlane(kdst+(slot)))
  #define DMA_V(t,slot) glds16(vsrc+(long)(t)*KVBLK*DM,(unsigned)__builtin_amdgcn_readfirstlane(vdst+(slot)))
  const int vb0=(int)(lds0+LDS_V)+((lane>>4)&1)*32+(lane&3)*8+(4*hi+((lane&15)>>2))*64;
  const char*Kbase=shm+LDS_K; bf16x8 kf[8];
  const lds_cptr shm3=(lds_cptr)shm; const lds_cptr kp0=shm3+LDS_K+hi*1024+r32*16; const lds_cptr vp0=shm3+LDS_V+((lane>>4)&1)*32+(lane&3)*8+(4*hi+((lane&15)>>2))*64;
  const int NT=(q0+QB)/KVBLK-t0;
  typedef __attribute__((address_space(3))) float* lds_fptr;
  const lds_fptr nbl3=(lds_fptr)(shm3+LDS_NB);
  const lds_fptr nbl3o=nbl3+t0*KVBLK;
  DMA_K(0,0);DMA_V(0,0);DMA_K(1,SLOTB);
  { const float ref=nbg[q0+QB-1]; for(int j=t0*KVBLK+tid;j<q0+QB;j+=NW*64) nbl3[j]=nbg[j]-ref; }
  bf16x8 qr[4];
  #pragma unroll
  for(int d0=0;d0<4;++d0)qr[d0]=*reinterpret_cast<const bf16x8*>(&Qw[(long)r32*DM+d0*16+hi*8]);
  float mhat=0.f,l_reg=0.f;f32x16 o[2];o[0]=f32x16{};o[1]=f32x16{};
  const int qrel=wid*QBLK+r32;
  #define CMASK(P0,P1,t) do{int jb_=(t)-(NT-4); if(jb_>=0)cmask(P0,P1,jb_,qrel,hi);}while(0)
  bool resc=false;
  #define START(P0,P1) do{ const float rm=rowmax(P0,P1); resc=false; \
    if(__any(rm>(float)THRL)){ const float dl=__builtin_fmaxf(rm,0.f); mhat=fadd_s(mhat,dl); \
      _Pragma("unroll") for(int r=0;r<16;++r){P0[r]=fsub_s(P0[r],dl);P1[r]=fsub_s(P1[r],dl);} } \
    _Pragma("unroll") for(int r=0;r<16;++r)P0[r]=__builtin_amdgcn_exp2f(P0[r]); }while(0)
  #define BIAS(P0,P1,t) do{ const lds_fptr nbp_=nbl3o+64*(t)+4*hi; \
    _Pragma("unroll") for(int q_=0;q_<4;++q_){ const f32x4v b0_=*(const __attribute__((address_space(3))) f32x4v*)(nbp_+8*q_), b1_=*(const __attribute__((address_space(3))) f32x4v*)(nbp_+32+8*q_); \
      _Pragma("unroll") for(int i_=0;i_<4;++i_){ P0[4*q_+i_]=b0_[i_]-mhat; P1[4*q_+i_]=b1_[i_]-mhat; } } }while(0)
  #define RESC() do{ if(resc){ asm volatile("s_waitcnt lgkmcnt(0)":::"memory"); \
      _Pragma("unroll") for(int d_=0;d_<2;++d_) _Pragma("unroll") for(int r=0;r<16;++r)o[d_][r]*=wsf[crow(r,hi)]; } }while(0)
  f32x16 pA0,pA1,pB0,pB1;
  int sl_prev=0,sl_cur=0,sl_next=SLOTB;
  #define ROT() do{sl_prev=sl_cur;sl_cur=sl_next;sl_next=(sl_next==(NSLOT-1)*SLOTB)?0:sl_next+SLOTB;}while(0)
  DMA_K(2,2*SLOTB);
  WAIT_BAR(3);
  mhat=nbl3[q0+qrel];
  BIAS(pA0,pA1,0);qkt(pA0,pA1,Kbase,qr,r32,hi);asm volatile("s_nop 15\n\ts_nop 7":"+v"(pA0),"+v"(pA1));CMASK(pA0,pA1,0);
  START(pA0,pA1);
  _Pragma("unroll") for(int r=0;r<16;++r)pA1[r]=__builtin_amdgcn_exp2f(pA1[r]);
  WAIT_BAR(0);
  DMA_K(3,0);DMA_V(1,SLOTB);
  ROT();
  kload8(kf,kp0+sl_cur);
  WAIT_BAR(2);
  s16x4 vlo[8],vhi[8]; u32x4 pw0,pw1,pw2,pw3;
  #define PKW(P,B) cvtpk_s(P[B],P[B+1])
  #define PAF(k) __builtin_bit_cast(bf16x8,pw##k)
  #define VFR(i) (bf16x8){vlo[i][0],vlo[i][1],vlo[i][2],vlo[i][3],vhi[i][0],vhi[i][1],vhi[i][2],vhi[i][3]}
  #define PIN(x) asm volatile("":"+v"(x))
  #define MX3(a,b,c) __builtin_fmaxf(__builtin_fmaxf((a),(b)),(c))
  #define GAPA(MF,A0,A1,A2,A3,W0,W1,PW) do{ MF; sacc+=A0; sacc+=A1; sacc+=A2; sacc+=A3; PIN(sacc); W0; W1; PIN(PW); SBAR(); }while(0)
  #define EX(v) __builtin_amdgcn_exp2f(v)
  #define GAPB(MF,X,B) do{ MF; X[B]=EX(X[B]); X[B+1]=EX(X[B+1]); X[B+2]=EX(X[B+2]); X[B+3]=EX(X[B+3]); PIN(X); SBAR(); }while(0)
  #define VRD(i) do{ vlo[i]=vtr(vp_+(((i)>>2)*4096+((i)&3)*1024)); vhi[i]=vtr(vp_+(((i)>>2)*4096+((i)&3)*1024+512)); }while(0)
  #define KRD(G,j) do{ if(G){ kload2(kf,kp0+sl_next,j); SBAR(); } }while(0)
  #define STEP(C0,C1,P0,P1,t,GK,GV,GL) do{ SBAR(); \
    const lds_cptr vp_=vp0+sl_prev; \
    BIAS(C0,C1,t); SBAR(); \
    VRD(0); SBAR(); float sacc=(P0[0]+P0[1]); \
    GAPA(C0=__builtin_amdgcn_mfma_f32_32x32x16_bf16(kf[0],qr[0],C0,0,0,0), P0[2],P0[3],P0[4],P0[5],     pw0[0]=PKW(P0,0), pw0[1]=PKW(P0,2), pw0); \
    VRD(4); SBAR(); GAPA(C1=__builtin_amdgcn_mfma_f32_32x32x16_bf16(kf[1],qr[0],C1,0,0,0), P0[6],P0[7],P0[8],P0[9],     pw0[2]=PKW(P0,4), pw0[3]=PKW(P0,6), pw0); \
    VRD(1); SBAR(); GAPA(C0=__builtin_amdgcn_mfma_f32_32x32x16_bf16(kf[2],qr[1],C0,0,0,0),   P0[10],P0[11],P0[12],P0[13], pw1[0]=PKW(P0,8), pw1[1]=PKW(P0,10), pw1); \
    VRD(5); SBAR(); GAPA(C1=__builtin_amdgcn_mfma_f32_32x32x16_bf16(kf[3],qr[1],C1,0,0,0),   P0[14],P0[15],P1[0],P1[1],   pw1[2]=PKW(P0,12),pw1[3]=PKW(P0,14), pw1); \
    VRD(2); SBAR(); GAPA(C0=__builtin_amdgcn_mfma_f32_32x32x16_bf16(kf[4],qr[2],C0,0,0,0),   P1[2],P1[3],P1[4],P1[5],     pw2[0]=PKW(P1,0), pw2[1]=PKW(P1,2), pw2); \
    VRD(6); SBAR(); GAPA(C1=__builtin_amdgcn_mfma_f32_32x32x16_bf16(kf[5],qr[2],C1,0,0,0),   P1[6],P1[7],P1[8],P1[9],     pw2[2]=PKW(P1,4), pw2[3]=PKW(P1,6), pw2); \
    VRD(3); SBAR(); GAPA(C0=__builtin_amdgcn_mfma_f32_32x32x16_bf16(kf[6],qr[3],C0,0,0,0),   P1[10],P1[11],P1[12],P1[13], pw3[0]=PKW(P1,8), pw3[1]=PKW(P1,10), pw3); \
    VRD(7); SBAR(); GAPA(C1=__builtin_amdgcn_mfma_f32_32x32x16_bf16(kf[7],qr[3],C1,0,0,0),   P1[14],P1[15],0.f,0.f,       pw3[2]=PKW(P1,12),pw3[3]=PKW(P1,14), pw3); \
    l_reg+=sacc; \
    if(GK){DMA_K((t)+3,sl_cur);} if(GV){DMA_V((t)+1,sl_next);} \
    CMASK(C0,C1,t); \
    { float a=MX3(C0[0],C0[1],C1[0]),b=MX3(C0[2],C0[3],C1[1]); a=MX3(a,C1[2],C1[3]); \
      _Pragma("unroll") for(int r=4;r<16;r+=4){a=MX3(a,C0[r],C0[r+1]);b=MX3(b,C0[r+2],C0[r+3]);a=MX3(a,C1[r],C1[r+1]);b=MX3(b,C1[r+2],C1[r+3]);} \
      float rm=__builtin_fmaxf(a,b); { auto rr=__builtin_amdgcn_permlane32_swap(__float_as_uint(rm),__float_as_uint(rm),false,false); rm=__builtin_fmaxf(__uint_as_float(rr[0]),__uint_as_float(rr[1])); } \
      resc=false; \
      if(__builtin_expect(__any(rm>(float)THRL),0)){ const float dl=__builtin_fmaxf(rm,0.f); mhat+=dl; \
        _Pragma("unroll") for(int r=0;r<16;++r){C0[r]-=dl;C1[r]-=dl;} \
        const float f=__builtin_amdgcn_exp2f(-dl); l_reg*=f; if(hi==0)wsf[r32]=f; resc=true; } } \
    SBAR(); \
    GAPB(o[0]=__builtin_amdgcn_mfma_f32_32x32x16_bf16(PAF(0),VFR(0),o[0],0,0,0), C0,0); \
    GAPB(o[1]=__builtin_amdgcn_mfma_f32_32x32x16_bf16(PAF(0),VFR(4),o[1],0,0,0), C0,4); \
    KRD(GL,0); GAPB(o[0]=__builtin_amdgcn_mfma_f32_32x32x16_bf16(PAF(1),VFR(1),o[0],0,0,0), C0,8); \
    KRD(GL,1); GAPB(o[1]=__builtin_amdgcn_mfma_f32_32x32x16_bf16(PAF(1),VFR(5),o[1],0,0,0), C0,12); \
    KRD(GL,2); GAPB(o[0]=__builtin_amdgcn_mfma_f32_32x32x16_bf16(PAF(2),VFR(2),o[0],0,0,0), C1,0); \
    KRD(GL,3); GAPB(o[1]=__builtin_amdgcn_mfma_f32_32x32x16_bf16(PAF(2),VFR(6),o[1],0,0,0), C1,4); \
    GAPB(o[0]=__builtin_amdgcn_mfma_f32_32x32x16_bf16(PAF(3),VFR(3),o[0],0,0,0), C1,8); \
    GAPB(o[1]=__builtin_amdgcn_mfma_f32_32x32x16_bf16(PAF(3),VFR(7),o[1],0,0,0), C1,12); \
    }while(0)
  int t=1;
  #undef CMASK
  #define CMASK(P0,P1,t) do{}while(0)
  for(;t+5<NT;t+=2){
    STEP(pB0,pB1,pA0,pA1,t,true,true,true);     WAIT_BAR(2); RESC(); ROT();
    STEP(pA0,pA1,pB0,pB1,t+1,true,true,true);   WAIT_BAR(2); RESC(); ROT();
  }
  #undef CMASK
  #define CMASK(P0,P1,t) do{int jb_=(t)-(NT-4); if(jb_>=0)cmask(P0,P1,jb_,qrel,hi);}while(0)
  #define ENDW(tt) do{ if((tt)+3<NT){WAIT_BAR(2);} else if((tt)+2<NT){WAIT_BAR(1);} else {WAIT_BAR(0);} }while(0)
  for(;t+1<NT;t+=2){
    STEP(pB0,pB1,pA0,pA1,t,(t+3<NT),(t+1<NT),(t+1<NT));       ENDW(t);   RESC(); ROT();
    STEP(pA0,pA1,pB0,pB1,t+1,(t+4<NT),(t+2<NT),(t+2<NT));     ENDW(t+1); RESC(); ROT();
  }
  STEP(pB0,pB1,pA0,pA1,NT-1,false,false,false); RESC();
  { float sacc=pB0[0]+pB0[1]; _Pragma("unroll") for(int r=2;r<16;++r)sacc+=pB0[r]; _Pragma("unroll") for(int r=0;r<16;++r)sacc+=pB1[r]; l_reg+=sacc;
    pw0=(u32x4){PKW(pB0,0),PKW(pB0,2),PKW(pB0,4),PKW(pB0,6)};pw1=(u32x4){PKW(pB0,8),PKW(pB0,10),PKW(pB0,12),PKW(pB0,14)};pw2=(u32x4){PKW(pB1,0),PKW(pB1,2),PKW(pB1,4),PKW(pB1,6)};pw3=(u32x4){PKW(pB1,8),PKW(pB1,10),PKW(pB1,12),PKW(pB1,14)};
    SBAR(); pv(o,vb0+sl_cur,PAF(0),PAF(1),PAF(2),PAF(3)); }
  #undef PKW
  #undef PAF
  #undef VFR
  #undef PIN
  #undef MX3
  #undef GAPA
  #undef GAPB
  #undef EX
  #undef VRD
  #undef KRD
  #undef STEP
  #undef ENDW
  {auto rr=__builtin_amdgcn_permlane32_swap(__float_as_uint(l_reg),__float_as_uint(l_reg),false,false);l_reg=__uint_as_float(rr[0])+__uint_as_float(rr[1]);}
  if(hi==0)wsf[32+r32]=l_reg;asm volatile("s_waitcnt lgkmcnt(0)":::"memory");
  float rli[16];
  #pragma unroll
  for(int r=0;r<16;++r)rli[r]=__builtin_amdgcn_rcpf(wsf[32+crow(r,hi)]);
  bf16*Ow=O+(rowbase+q0+wid*QBLK)*DMO+OCOL+h*D;
  { bf16*stg=(bf16*)(shm+LDS_OST)+wid*2048;
    #pragma unroll
    for(int r=0;r<16;++r){const int orow=crow(r,hi);
      #pragma unroll
      for(int d0=0;d0<2;++d0)stg[orow*64+d0*32+r32]=__float2bfloat16(o[d0][r]*rli[r]);}
    asm volatile("s_waitcnt lgkmcnt(0)":::"memory");
    #pragma unroll
    for(int i=0;i<4;++i){const int row=i*8+(lane>>3),ch=lane&7; const u32x4 v=*(const u32x4*)(stg+row*64+ch*8); ATTN_STORE16(Ow+(long)row*DMO+ch*8,v);} }
  asm volatile("s_waitcnt lgkmcnt(0)\n\ts_barrier":::"memory");
  #undef DMA_K
  #undef DMA_V
  #undef CMASK
  #undef START
  #undef BIAS
  #undef RESC
  #undef ROT
}
constexpr int ATTN_LDS_BYTES=LDS_BYTES;
struct AttnTensors { const bf16* Q; const bf16* K; const bf16* V; bf16* O; const float* nb; const float* qn; const float* kn; const int* t0tab; };
struct AttnUnit { int bh; int qb; };
struct StaticOrder {
  int vcu,G;
  __device__ __forceinline__ explicit StaticOrder(int grid,int block):vcu((grid%8==0)?(block%8)*(grid/8)+block/8:block),G(grid){}
  __device__ __forceinline__ bool next(int i,AttnUnit&u)const{ const int w=vcu+(i>>2)*G; if(w>=BATCH*NHEAD*8)return false; const int s=w&7,j=i&3; u.bh=((w>>3)+9*j)&31; u.qb=(j==0)?s:(j==1)?15-s:(j==2)?16+s:31-s; return true; }
  __device__ __forceinline__ void a_ready(const AttnUnit&)const{}
  __device__ __forceinline__ void done(const AttnUnit&)const{}
};
template<int THRL=8> __device__ __forceinline__ void attn_phase_dyn(char*lds,const AttnTensors&T,unsigned*ctr,volatile __attribute__((address_space(3))) unsigned*slot){
  const int tid=threadIdx.x,lane=tid&63;
  int ord=0;
  { const float myv=(lane<32)?T.nb[(long)lane*SEQ+SEQ-1]:3.0e38f; int rank=0;
    _Pragma("unroll") for(int j=0;j<32;++j){const float vj=__shfl(myv,j); rank+=(vj<myv||(vj==myv&&j<lane))?1:0;}
    _Pragma("unroll") for(int j=0;j<32;++j){const int rj=__shfl(rank,j); if(rj==lane)ord=j;} }
  if(tid==0){ const unsigned id=__hip_atomic_fetch_add(ctr,1u,__ATOMIC_RELAXED,__HIP_MEMORY_SCOPE_AGENT); *slot=id; }
  asm volatile("s_waitcnt vmcnt(0) lgkmcnt(0)\n\ts_barrier":::"memory");
  for(;;){
    const unsigned uid=*slot;
    if(uid>=(unsigned)(BATCH*NHEAD*NQB))break;
    unsigned nxt=0u; if(tid==0)nxt=__hip_atomic_fetch_add(ctr,1u,__ATOMIC_RELAXED,__HIP_MEMORY_SCOPE_AGENT);
    const int bh=__builtin_amdgcn_readfirstlane(__shfl(ord,(int)(uid>>5))), qb=NQB-1-(int)(uid&31u);
    const int t0=__builtin_amdgcn_readfirstlane(T.t0tab[bh*NQB+qb]);
    attn_unit<THRL>(bh/NHEAD,bh%NHEAD,qb,T.Q,T.K,T.V,T.O,T.nb+(long)bh*SEQ,t0,lds);
    if(tid==0)*slot=nxt;
    asm volatile("s_waitcnt vmcnt(0) lgkmcnt(0)\n\ts_barrier":::"memory");
  }
}
#undef SBAR
#undef WAIT_BAR
}
#define GAS __attribute__((address_space(1)))
#define LAS __attribute__((address_space(3)))
typedef unsigned short bf16;
typedef unsigned v4u __attribute__((ext_vector_type(4)));
typedef float f32x4 __attribute__((ext_vector_type(4)));
typedef short bf16x8 __attribute__((ext_vector_type(8)));
typedef GAS unsigned gu32;
typedef GAS unsigned long long gu64;
#define RLX_AGENT __ATOMIC_RELAXED, __HIP_MEMORY_SCOPE_AGENT
#define LDS_WAIT() asm volatile("s_waitcnt lgkmcnt(0)" ::: "memory")
#define VM_WAIT() asm volatile("s_waitcnt vmcnt(0)" ::: "memory")
__device__ __forceinline__ unsigned long long rt() { return __builtin_amdgcn_s_memrealtime(); }
typedef float f32x2_pk __attribute__((ext_vector_type(2))); typedef __bf16 bf16x2_pk __attribute__((ext_vector_type(2)));
__device__ __forceinline__ unsigned pk2(float lo, float hi) { f32x2_pk v = {lo, hi}; bf16x2_pk r = __builtin_convertvector(v, bf16x2_pk); return __builtin_bit_cast(unsigned, r); }
__device__ __forceinline__ unsigned f2bf(float f) { return pk2(f, 0.f) & 0xffffu; }

#define XB_TMO      128
#define XB_XCNT(j)  (256  + 64 * (j))
#define XB_XSUB(j)  (1280 + 64 * (j))
#define XB_XGEN(j)  (2304 + 64 * (j))
#define XB_TOP      3328
#define XB_TOPGEN   3392
#define XCD_BAR_WORDS 3456
#define XB_SPIN_CAP (1u << 18)

__device__ __forceinline__ unsigned xb_ld(unsigned* p)              { return __hip_atomic_load(p, __ATOMIC_RELAXED, __HIP_MEMORY_SCOPE_AGENT); }
__device__ __forceinline__ unsigned xb_add(unsigned* p, unsigned v) { return __hip_atomic_fetch_add(p, v, __ATOMIC_RELAXED, __HIP_MEMORY_SCOPE_AGENT); }
__device__ __forceinline__ unsigned xb_xcc_id() { return (unsigned)__builtin_amdgcn_s_getreg((3 << 11) | 20) & 0xFu; }
#define XB_SPIN(cond, bar) do { unsigned _sp = 0; while (cond) { __builtin_amdgcn_s_sleep(1); \
    if ((++_sp & 255u) == 0u) { if (xb_ld(&(bar)[XB_TMO])) break; if (_sp > XB_SPIN_CAP) { atomicAdd(&(bar)[XB_TMO], 1u); break; } } } } while (0)

struct XcdBarrier {
    unsigned* bar; unsigned x;
    volatile LAS unsigned* st;
};

__device__ __forceinline__ XcdBarrier xcd_barrier_post(unsigned* bar, volatile LAS unsigned* st) {
    XcdBarrier b; b.bar = bar; b.x = xb_xcc_id(); b.st = st;
    if (threadIdx.x == 0) (void)xb_add(&bar[XB_XCNT(b.x)], 1u);
    return b;
}
__device__ __forceinline__ void xcd_barrier_complete(unsigned* bar, unsigned x, unsigned& nloc, unsigned& nx) {
    const unsigned G = gridDim.x * gridDim.y * gridDim.z;
    unsigned sum, cnt, mine, sp = 0u;
    for (;;) {
        sum = 0u; cnt = 0u; mine = 0u;
#pragma unroll
        for (unsigned j = 0; j < 16; ++j) { const unsigned c = xb_ld(&bar[XB_XCNT(j)]); sum += c; cnt += (c > 0u) ? 1u : 0u; mine = (j == x) ? c : mine; }
        if (sum == G) break;
        __builtin_amdgcn_s_sleep(1);
        if ((++sp & 255u) == 0u) { if (xb_ld(&bar[XB_TMO])) break; if (sp > XB_SPIN_CAP) { atomicAdd(&bar[XB_TMO], 1u); break; } }
    }
    nloc = mine > 0u ? mine : 1u; nx = cnt > 0u ? cnt : 1u;
}

__device__ __forceinline__ void xcd_barrier(const XcdBarrier& b) {
    asm volatile("s_waitcnt vmcnt(0)" ::: "memory");
    __syncthreads();
    if (threadIdx.x == 0) {
        unsigned* bar = b.bar;
        __builtin_amdgcn_s_waitcnt(0);
        unsigned nloc = b.st[0], nx = b.st[1];
        if (nloc == 0u) { xcd_barrier_complete(bar, b.x, nloc, nx); b.st[0] = nloc; b.st[1] = nx; }
        const unsigned old = xb_add(&bar[XB_XSUB(b.x)], 1u);
        const unsigned gen = old / nloc;
        if (old + 1u == (gen + 1u) * nloc) {
            __builtin_amdgcn_fence(__ATOMIC_RELEASE, "agent");
            asm volatile("s_waitcnt vmcnt(0)" ::: "memory");
            const unsigned og = xb_add(&bar[XB_TOP], 1u);
            const unsigned tg = og / nx;
            if (og + 1u == (tg + 1u) * nx) xb_add(&bar[XB_TOPGEN], 1u);
            else XB_SPIN(xb_ld(&bar[XB_TOPGEN]) == tg, bar);
            __builtin_amdgcn_fence(__ATOMIC_ACQUIRE, "agent");
            xb_add(&bar[XB_XGEN(b.x)], 1u);
            asm volatile("s_waitcnt vmcnt(0)" ::: "memory");
        } else {
            XB_SPIN(xb_ld(&bar[XB_XGEN(b.x)]) == gen, bar);
            __builtin_amdgcn_fence(__ATOMIC_ACQUIRE, "agent");
            asm volatile("s_waitcnt vmcnt(0)" ::: "memory");
        }
    }
    __syncthreads();
}

constexpr int NWAVES = 8;
constexpr int BATCH = 4, SEQ = 8192, D = 1024, M = BATCH * SEQ;
constexpr int IN_W = 7184, NGW = 4096, NGT = 3072, NSLAB = 8;
constexpr int SL_POOL = 0, SL_MQ = 1, SL_MK = 2, SL_MV = 3, SL_MO = 4, SL_FQ = 5, SL_FK = 6, SL_FV = 7;
constexpr int ML_H = 4, ML_DH = 128, CHUNK = 64, NCH = SEQ / CHUNK;
constexpr int FX_H = 8;
constexpr int DFF = 2816, NEXP = 8, DFE = 3584;
constexpr float NORM_EPS = 1e-6f;
constexpr int XLD = 2 * D;
constexpr int KCAT = 1536;
constexpr int MOE_KROWS = 34816;
constexpr int MOE_KTILES = MOE_KROWS / 256;
constexpr int TOKBLK = 128, NTOKBLK = M / TOKBLK;

constexpr size_t MiB = 1u << 20;
constexpr size_t WS_CTL = 0, CTL_ZERO_BYTES = 1 * MiB;
constexpr size_t WS_W = 1 * MiB;
constexpr size_t W_LAYER = 19 * MiB, W_NG = 0, W_GT = 8 * MiB, W_CAT = 14 * MiB, W_OUT = 17 * MiB;
constexpr size_t WS_WGU = WS_W + 2 * W_LAYER, WS_WDN = WS_WGU + 11 * MiB;
constexpr size_t WS_NG = 56 * MiB, SLAB_BYTES = (size_t)M * 512 * 2;
constexpr size_t WS_GATE = WS_NG + SLAB_BYTES;
constexpr size_t WS_ACT0 = WS_NG;
constexpr size_t WS_HB = 312 * MiB;
constexpr size_t WS_CAT = 376 * MiB;
constexpr size_t WS_MLC = 472 * MiB;
constexpr size_t WS_MOEGU = 1 * MiB;
constexpr size_t WS_MOEDN = 57 * MiB;
constexpr size_t WS_XS = 85 * MiB;
constexpr size_t WS_Y0 = 153 * MiB, WS_Y1 = 217 * MiB;
constexpr size_t WS_ACT1 = 305 * MiB;
constexpr size_t WS_SM = 544 * MiB;
constexpr size_t SM_GATE16 = 0;
constexpr size_t SM_MLB = 2 * MiB, SM_MLA = SM_MLB + 512 * 1024, SM_MLMX = SM_MLA + 512 * 1024;
constexpr size_t SM_FNB = SM_MLMX + 512 * 1024;
constexpr size_t SM_MLN = SM_FNB + 1 * MiB;
constexpr size_t SM_MLM = SM_MLN + 1 * MiB;
constexpr size_t SM_MLDEC = SM_MLM + 16 * 132 * 4;
constexpr size_t SM_FQN = SM_MLDEC + 16 * 128 * 4, SM_FKN = SM_FQN + 32768, SM_FT0 = SM_FKN + 32768, SM_MLBG = SM_FT0 + 4096, SM_FXM = SM_MLBG + 16384;
constexpr size_t SM_MOE = 6 * MiB;
constexpr size_t MO_RSTD = 0, MO_TOKE = MO_RSTD + (size_t)M * 4, MO_TOKG = MO_TOKE + (size_t)M * 8, MO_HIST = MO_TOKG + (size_t)M * 8,
                 MO_ROWTOK = MO_HIST + (size_t)NTOKBLK * 16 * 4, MO_ROWG = MO_ROWTOK + (size_t)2 * MOE_KROWS * 4, MO_TILEE = MO_ROWG + (size_t)2 * MOE_KROWS * 4, MO_NT = MO_TILEE + 2 * MOE_KTILES * 4, MO_END = MO_NT + 64;
static_assert(SM_MOE + MO_END <= 8 * MiB, "small arrays");
constexpr size_t WS_END = 552 * MiB;
static_assert(WS_WDN + (size_t)DFF * D * 2 <= WS_NG && WS_NG + NSLAB * SLAB_BYTES <= WS_HB && WS_HB + (size_t)M * D * 2 <= WS_CAT && WS_CAT + (size_t)M * KCAT * 2 <= WS_MLC && WS_MLC + 64 * MiB <= WS_SM, "d_ws map");
static_assert(WS_MOEGU + (size_t)NEXP * 2 * DFE * D <= WS_MOEDN && WS_MOEDN + (size_t)NEXP * D * DFE <= WS_XS && WS_XS + (size_t)2 * MOE_KROWS * D <= WS_Y0 && WS_Y0 + (size_t)M * D * 2 <= WS_Y1 && WS_Y1 + (size_t)M * D * 2 <= WS_ACT1 && WS_ACT1 + (size_t)2 * MOE_KROWS * DFE <= WS_SM, "d_ws map (MoE)");
constexpr int CW_TMO = 0, CW_CODE = 1, CW_BAR = 4096;

constexpr int RING_OFF = 0, RING_BYTES = 131072;
constexpr int LDSCTL_OFF = RING_BYTES, MISC_OFF = LDSCTL_OFF + 320;
constexpr int LDS_BYTES = 147456;
static_assert(MISC_OFF + 128 <= LDS_BYTES, "LDS map");

struct Frame {
    LAS unsigned char* lds;
    volatile LAS unsigned* MISC;
    gu32* ctl;
    int tid, lane, wave;
    int vcu, G, blk;
    unsigned char* ws;
    const float* const* in; float* out; int zi;
};
#define INP(F, i) ((F).in[(i) + (F).zi])
enum { IN_X = 0, IN_MIXG, IN_WIN, IN_POOLW, IN_POOLS, IN_CONVW, IN_MLBI, IN_MLBF, IN_MLNG, IN_FXBF, IN_WBRP, IN_WBRM, IN_WBRF, IN_WOUT, IN_FFNG, IN_FFG, IN_FFU, IN_FFD, IN_RW, IN_RB, IN_MOEG, IN_MOEU, IN_MOED, IN_FING };

__device__ __forceinline__ float wave_sum(float v) {
#pragma unroll
    for (int o = 1; o < 64; o <<= 1) v += __shfl_xor(v, o);
    return v;
}
__device__ __forceinline__ float wave_max(float v) {
#pragma unroll
    for (int o = 1; o < 64; o <<= 1) v = fmaxf(v, __shfl_xor(v, o));
    return v;
}
__device__ __forceinline__ float sigmoid_f(float x) { return __builtin_amdgcn_rcpf(1.f + __builtin_amdgcn_exp2f(-1.4426950408889634f * x)); }
__device__ __forceinline__ float logsigmoid_f(float x) { return fminf(x, 0.f) - log1pf(expf(-fabsf(x))); }

__device__ __forceinline__ void tr_item(const float* W, int ldw, int srccol0, const float* gain, bf16* WT, int ldt, int drow0, int dcol0, int k0, LAS float* scr, int lane) {
    (void)scr;
    const int ng = lane & 7, kg = lane >> 3;
    f32x4 v[8];
#pragma unroll
    for (int i = 0; i < 8; ++i) v[i] = *(const GAS f32x4*)(W + (size_t)(k0 + 8 * kg + i) * ldw + srccol0 + 4 * ng);
    if (gain) { const f32x4 g0 = *(const GAS f32x4*)(gain + k0 + 8 * kg), g1 = *(const GAS f32x4*)(gain + k0 + 8 * kg + 4);
#pragma unroll
        for (int i = 0; i < 4; ++i) { v[i] = v[i] * g0[i]; v[4 + i] = v[4 + i] * g1[i]; } }
#pragma unroll
    for (int j = 0; j < 4; ++j) { v4u o; o.x = pk2(v[0][j], v[1][j]); o.y = pk2(v[2][j], v[3][j]); o.z = pk2(v[4][j], v[5][j]); o.w = pk2(v[6][j], v[7][j]);
        *(GAS v4u*)(WT + (size_t)(drow0 + 4 * ng + j) * ldt + dcol0 + k0 + 8 * kg) = o; }
}
__device__ __forceinline__ void tr_item_fp8(const float* W, int ldw, int srccol0, const float* gain, float scale, unsigned char* WT8, int ldt, int drow0, int k0, int lane) {
    const int ng = lane & 7, kg = lane >> 3;
    f32x4 v[8];
#pragma unroll
    for (int i = 0; i < 8; ++i) v[i] = *(const GAS f32x4*)(W + (size_t)(k0 + 8 * kg + i) * ldw + srccol0 + 4 * ng);
    f32x4 g0 = (f32x4){scale, scale, scale, scale}, g1 = g0;
    if (gain) { g0 = *(const GAS f32x4*)(gain + k0 + 8 * kg) * scale; g1 = *(const GAS f32x4*)(gain + k0 + 8 * kg + 4) * scale; }
#pragma unroll
    for (int i = 0; i < 4; ++i) { v[i] = v[i] * g0[i]; v[4 + i] = v[4 + i] * g1[i]; }
    typedef unsigned u32x2_t __attribute__((ext_vector_type(2)));
#pragma unroll
    for (int j = 0; j < 4; ++j) { u32x2_t o; o.x = pg8::pack_fp8x4(v[0][j], v[1][j], v[2][j], v[3][j]); o.y = pg8::pack_fp8x4(v[4][j], v[5][j], v[6][j], v[7][j]);
        *(GAS u32x2_t*)(WT8 + (size_t)(drow0 + 4 * ng + j) * ldt + k0 + 8 * kg) = o; }
}
constexpr float FP8_ASCALE = 16.f, FP8_WSCALE = 256.f;
constexpr int CI_NG = 2048, CI_GT = 1536, CI_BR = 256, CI_OUT = 512, CI_LAYER = CI_NG + CI_GT + 2 * CI_BR + CI_OUT, CI_GU = 2816, CI_DN = 1408, CI_MAIN = 2 * CI_LAYER + CI_GU + CI_DN;
__device__ __forceinline__ void conv_item_main(Frame& F, int it, LAS float* scr) {
    if (it < 2 * CI_LAYER) {
        const int l = it / CI_LAYER; int r = it % CI_LAYER; bf16* wl = (bf16*)(F.ws + WS_W + (size_t)l * W_LAYER);
        const float* g = INP(F, IN_MIXG) + l * D; const float* win = INP(F, IN_WIN) + (size_t)l * D * IN_W;
        if (r < CI_NG) { const int nb = r >> 4, kb = r & 15; tr_item(win, IN_W, nb * 32 + (nb * 32 >= 2560 ? 8 : 0), g, wl + W_NG / 2, D, nb * 32, 0, kb * 64, scr, F.lane); return; } r -= CI_NG;
        if (r < CI_GT) { const int nb = r >> 4, kb = r & 15; tr_item_fp8(win, IN_W, 4112 + nb * 32, g, FP8_WSCALE, (unsigned char*)wl + W_GT, D, nb * 32, kb * 64, F.lane); return; } r -= CI_GT;
        if (r < CI_BR) { const int nb = r >> 3, kb = r & 7; tr_item(INP(F, IN_WBRM) + (size_t)l * 512 * D, D, nb * 32, nullptr, wl + W_CAT / 2, KCAT, nb * 32, 512, kb * 64, scr, F.lane); return; } r -= CI_BR;
        if (r < CI_BR) { const int nb = r >> 3, kb = r & 7; tr_item(INP(F, IN_WBRF) + (size_t)l * 512 * D, D, nb * 32, nullptr, wl + W_CAT / 2, KCAT, nb * 32, 1024, kb * 64, scr, F.lane); return; } r -= CI_BR;
        { const int nb = r >> 4, kb = r & 15; tr_item(INP(F, IN_WOUT) + (size_t)l * D * D, D, nb * 32, nullptr, wl + W_OUT / 2, D, nb * 32, 0, kb * 64, scr, F.lane); }
        return;
    }
    it -= 2 * CI_LAYER;
    if (it < CI_GU) { const int nb = it >> 4, kb = it & 15, p = nb >> 3, w = nb & 7;
        tr_item(w < 4 ? INP(F, IN_FFG) : INP(F, IN_FFU), DFF, 128 * p + (w & 3) * 32, INP(F, IN_FFNG), (bf16*)(F.ws + WS_WGU), D, nb * 32, 0, kb * 64, scr, F.lane); return; }
    it -= CI_GU;
    { const int kb = it >> 5, nb = it & 31; tr_item(INP(F, IN_FFD), D, nb * 32, nullptr, (bf16*)(F.ws + WS_WDN), DFF, nb * 32, 0, kb * 64, scr, F.lane); }
}
constexpr int CI_MGU = 3584, CI_MDN = 1792, CI_MEXP = CI_MGU + CI_MDN, CI_MOE = NEXP * CI_MEXP;
__device__ __forceinline__ void conv_item_moe(Frame& F, int it, LAS float* scr) {
    (void)scr;
    const int e = it / CI_MEXP; int r = it % CI_MEXP;
    if (r < CI_MGU) { const int nb = r % 224, kb = r / 224, p = nb >> 3, w = nb & 7;
        tr_item_fp8((w < 4 ? INP(F, IN_MOEG) : INP(F, IN_MOEU)) + (size_t)e * D * DFE, DFE, 128 * p + (w & 3) * 32, INP(F, IN_FFNG) + D, FP8_WSCALE, F.ws + WS_MOEGU + (size_t)e * 2 * DFE * D, D, nb * 32, kb * 64, F.lane); return; }
    r -= CI_MGU;
    { const int kb = r >> 5, nb = r & 31; tr_item_fp8(INP(F, IN_MOED) + (size_t)e * DFE * D, D, nb * 32, nullptr, FP8_WSCALE, F.ws + WS_MOEDN + (size_t)e * D * DFE, DFE, nb * 32, kb * 64, F.lane); }
}
__device__ __forceinline__ void pool_fold(Frame& F) {
    const int gt = F.blk * (NWAVES * 64) + F.tid, NT = F.G * NWAVES * 64;
    for (int o = gt; o < 2 * 4 * 16 * D; o += NT) {
        const int n = o & (D - 1), cb = __builtin_amdgcn_readfirstlane(o >> 10), l = cb >> 6, g = (cb >> 4) & 3, c0 = (cb & 15) * 8;
        const float* wg = INP(F, IN_POOLW) + (size_t)l * 4 * 128 * 128 + (size_t)(g * 128 + c0) * 128; const float* sc = INP(F, IN_POOLS) + l * 512 + g * 128; const float* wb = INP(F, IN_WBRP) + (size_t)l * 512 * D + (size_t)(g * 128) * D + n;
        float a[8];
#pragma unroll
        for (int i = 0; i < 8; ++i) a[i] = 0.f;
#pragma unroll 8
        for (int dd = 0; dd < 128; ++dd) { const float t = sc[dd] * wb[(size_t)dd * D];
#pragma unroll
            for (int i = 0; i < 8; ++i) a[i] += wg[i * 128 + dd] * t; }
        v4u w; w.x = pk2(a[0], a[1]); w.y = pk2(a[2], a[3]); w.z = pk2(a[4], a[5]); w.w = pk2(a[6], a[7]);
        *(GAS v4u*)((bf16*)(F.ws + WS_W + (size_t)l * W_LAYER + W_CAT) + (size_t)n * KCAT + g * 128 + c0) = w;
    }
}

template <bool XB, int LD = D> __device__ __forceinline__ void load_xrow(const void* x, size_t m, int lane, f32x4 (&v)[4]) {
    if constexpr (XB) { typedef unsigned u32x2_t __attribute__((ext_vector_type(2))); const GAS u32x2_t* xr = (const GAS u32x2_t*)((const bf16*)x + m * LD) + lane;
#pragma unroll
        for (int j = 0; j < 4; ++j) { const u32x2_t q = xr[64 * j]; v[j] = (f32x4){__uint_as_float(q.x << 16), __uint_as_float(q.x & 0xffff0000u), __uint_as_float(q.y << 16), __uint_as_float(q.y & 0xffff0000u)}; } }
    else { const GAS f32x4* xr = (const GAS f32x4*)((const float*)x + m * D) + lane;
#pragma unroll
        for (int j = 0; j < 4; ++j) v[j] = xr[64 * j]; }
}
template <bool XB> __device__ __forceinline__ void phase_norm_mix(Frame& F, const void* x, int l) {
    LAS float* w16 = (LAS float*)(F.lds);
    const float* g = INP(F, IN_MIXG) + l * D; const float* win = INP(F, IN_WIN) + (size_t)l * D * IN_W;
    for (int idx = F.tid; idx < 16 * D; idx += NWAVES * 64) { const int k = idx >> 4, j = idx & 15, col = j < 8 ? 2560 + j : 4104 + (j - 8); w16[j * D + k] = g[k] * win[(size_t)k * IN_W + col]; }
    __syncthreads();
    bf16* HB = (bf16*)(F.ws + WS_HB); float* gate16 = (float*)(F.ws + WS_SM + SM_GATE16);
    const int gw = F.vcu * NWAVES + F.wave, NGWV = F.G * NWAVES;
    f32x4 nv[4]; if (gw < M) load_xrow<XB, XB ? XLD : D>(x, (size_t)gw, F.lane, nv);
    for (int m = gw; m < M; m += NGWV) {
        f32x4 v[4]; float ss = 0.f;
#pragma unroll
        for (int j = 0; j < 4; ++j) v[j] = nv[j];
        if (m + NGWV < M) load_xrow<XB, XB ? XLD : D>(x, (size_t)(m + NGWV), F.lane, nv);
#pragma unroll
        for (int j = 0; j < 4; ++j) ss += (v[j].x * v[j].x + v[j].y * v[j].y) + (v[j].z * v[j].z + v[j].w * v[j].w);
        const float rstd = 1.f / sqrtf(wave_sum(ss) * (1.f / D) + NORM_EPS);
        GAS unsigned long long* o8 = (GAS unsigned long long*)(HB + (size_t)m * D) + F.lane;
#pragma unroll
        for (int j = 0; j < 4; ++j) o8[64 * j] = (unsigned long long)pk2(v[j].x * rstd, v[j].y * rstd) | ((unsigned long long)pk2(v[j].z * rstd, v[j].w * rstd) << 32);
        float pp[16];
#pragma unroll
        for (int jj = 0; jj < 16; ++jj) { float p = 0.f;
#pragma unroll
            for (int j = 0; j < 4; ++j) { const f32x4 wv = *(const LAS f32x4*)(w16 + jj * D + 256 * j + 4 * F.lane); p += (v[j].x * wv.x + v[j].y * wv.y) + (v[j].z * wv.z + v[j].w * wv.w); }
            pp[jj] = p; if ((jj & 3) == 3) asm volatile("" ::: "memory"); }
#define TB_STAGE(ST, N) { const bool up = (F.lane >> (ST)) & 1; _Pragma("unroll") for (int i = 0; i < (N); ++i) { const float mine = up ? pp[2 * i + 1] : pp[2 * i], give = up ? pp[2 * i] : pp[2 * i + 1]; pp[i] = mine + __shfl_xor(give, 1 << (ST)); } }
        TB_STAGE(0, 8) TB_STAGE(1, 4) TB_STAGE(2, 2) TB_STAGE(3, 1)
        float keep = pp[0]; keep += __shfl_xor(keep, 16); keep += __shfl_xor(keep, 32); keep *= rstd;
        if (F.lane < 16) gate16[(size_t)m * 16 + F.lane] = keep;
    }
    __syncthreads();
}
__device__ __forceinline__ void phase_norm_ffn(Frame& F, const bf16* x) {
    bf16* HB = (bf16*)(F.ws + WS_HB);
    const int gw = F.vcu * NWAVES + F.wave, NGWV = F.G * NWAVES;
    f32x4 nv[4]; if (gw < M) load_xrow<true, XLD>(x, (size_t)gw, F.lane, nv);
    for (int m = gw; m < M; m += NGWV) {
        f32x4 v[4]; float ss = 0.f;
#pragma unroll
        for (int j = 0; j < 4; ++j) v[j] = nv[j];
        if (m + NGWV < M) load_xrow<true, XLD>(x, (size_t)(m + NGWV), F.lane, nv);
#pragma unroll
        for (int j = 0; j < 4; ++j) ss += (v[j].x * v[j].x + v[j].y * v[j].y) + (v[j].z * v[j].z + v[j].w * v[j].w);
        const float rstd = 1.f / sqrtf(wave_sum(ss) * (1.f / D) + NORM_EPS);
        GAS unsigned long long* o8 = (GAS unsigned long long*)(HB + (size_t)m * D) + F.lane;
#pragma unroll
        for (int j = 0; j < 4; ++j) o8[64 * j] = (unsigned long long)pk2(v[j].x * rstd, v[j].y * rstd) | ((unsigned long long)pk2(v[j].z * rstd, v[j].w * rstd) << 32);
    }
}
__device__ __forceinline__ void quant_rows_fp8(Frame& F, const bf16* src, unsigned char* dst) {
    const int gw = F.vcu * NWAVES + F.wave, NGWV = F.G * NWAVES;
    for (int m = gw; m < M; m += NGWV) {
        const v4u a = *((const GAS v4u*)(src + (size_t)m * D) + F.lane), b = *((const GAS v4u*)(src + (size_t)m * D) + 64 + F.lane);
        typedef unsigned u32x2_t __attribute__((ext_vector_type(2)));
        u32x2_t o0, o1; const float s = FP8_ASCALE;
        o0.x = pg8::pack_fp8x4(__uint_as_float(a.x << 16) * s, __uint_as_float(a.x & 0xffff0000u) * s, __uint_as_float(a.y << 16) * s, __uint_as_float(a.y & 0xffff0000u) * s);
        o0.y = pg8::pack_fp8x4(__uint_as_float(a.z << 16) * s, __uint_as_float(a.z & 0xffff0000u) * s, __uint_as_float(a.w << 16) * s, __uint_as_float(a.w & 0xffff0000u) * s);
        o1.x = pg8::pack_fp8x4(__uint_as_float(b.x << 16) * s, __uint_as_float(b.x & 0xffff0000u) * s, __uint_as_float(b.y << 16) * s, __uint_as_float(b.y & 0xffff0000u) * s);
        o1.y = pg8::pack_fp8x4(__uint_as_float(b.z << 16) * s, __uint_as_float(b.z & 0xffff0000u) * s, __uint_as_float(b.w << 16) * s, __uint_as_float(b.w & 0xffff0000u) * s);
        *((GAS u32x2_t*)(dst + (size_t)m * D) + F.lane) = o0; *((GAS u32x2_t*)(dst + (size_t)m * D) + 64 + F.lane) = o1;
    }
}
__device__ __forceinline__ void phase_norm_final(Frame& F, const bf16* xb, float* out) {
    const GAS f32x4* gp = (const GAS f32x4*)INP(F, IN_FING) + F.lane; f32x4 gv[4];
#pragma unroll
    for (int j = 0; j < 4; ++j) gv[j] = gp[64 * j];
    const bf16* Y0 = (const bf16*)(F.ws + WS_Y0); const bf16* Y1 = (const bf16*)(F.ws + WS_Y1);
    const int gw = F.vcu * NWAVES + F.wave, NGWV = F.G * NWAVES;
    f32x4 nv[4], na[4], nb_[4]; if (gw < M) { load_xrow<true, XLD>(xb, (size_t)gw, F.lane, nv); load_xrow<true>(Y0, (size_t)gw, F.lane, na); load_xrow<true>(Y1, (size_t)gw, F.lane, nb_); }
    for (int m = gw; m < M; m += NGWV) {
        f32x4 v[4]; float ss = 0.f;
#pragma unroll
        for (int j = 0; j < 4; ++j) v[j] = nv[j] + (na[j] + nb_[j]);
        if (m + NGWV < M) { load_xrow<true, XLD>(xb, (size_t)(m + NGWV), F.lane, nv); load_xrow<true>(Y0, (size_t)(m + NGWV), F.lane, na); load_xrow<true>(Y1, (size_t)(m + NGWV), F.lane, nb_); }
#pragma unroll
        for (int j = 0; j < 4; ++j) ss += (v[j].x * v[j].x + v[j].y * v[j].y) + (v[j].z * v[j].z + v[j].w * v[j].w);
        const float rstd = 1.f / sqrtf(wave_sum(ss) * (1.f / D) + NORM_EPS);
        GAS f32x4* o = (GAS f32x4*)(out + (size_t)m * D) + F.lane;
#pragma unroll
        for (int j = 0; j < 4; ++j) o[64 * j] = v[j] * rstd * gv[j];
    }
}

__device__ __forceinline__ void phase_route1(Frame& F, const bf16* x) {
    LAS float* w8 = (LAS float*)(F.lds);
    LAS int* hist = (LAS int*)(F.lds + 32768);
    const float* g = INP(F, IN_FFNG) + D; const float* rw = INP(F, IN_RW);
    for (int idx = F.tid; idx < 8 * D; idx += NWAVES * 64) { const int k = idx >> 3, e = idx & 7; w8[e * D + k] = g[k] * rw[(size_t)k * 8 + e]; }
    unsigned char* sm = F.ws + WS_SM + SM_MOE;
    float* rstd_g = (float*)(sm + MO_RSTD); int* tok_e = (int*)(sm + MO_TOKE); float* tok_g = (float*)(sm + MO_TOKG); int* hist_g = (int*)(sm + MO_HIST);
    for (int blk = F.blk; blk < NTOKBLK; blk += F.G) {
        if (F.tid < 16) hist[F.tid] = 0;
        __syncthreads();
        f32x4 nv[4]; load_xrow<true, XLD>(x, (size_t)(blk * TOKBLK + F.wave * (TOKBLK / NWAVES)), F.lane, nv);
        for (int i = 0; i < TOKBLK / NWAVES; ++i) {
            const int m = blk * TOKBLK + F.wave * (TOKBLK / NWAVES) + i;
            f32x4 v[4]; float ss = 0.f;
#pragma unroll
            for (int j = 0; j < 4; ++j) v[j] = nv[j];
            if (i + 1 < TOKBLK / NWAVES) load_xrow<true, XLD>(x, (size_t)(m + 1), F.lane, nv);
#pragma unroll
            for (int j = 0; j < 4; ++j) ss += (v[j].x * v[j].x + v[j].y * v[j].y) + (v[j].z * v[j].z + v[j].w * v[j].w);
            const float rstd = 1.f / sqrtf(wave_sum(ss) * (1.f / D) + NORM_EPS);
            float pp[8];
#pragma unroll
            for (int e = 0; e < 8; ++e) { float p = 0.f;
#pragma unroll
                for (int j = 0; j < 4; ++j) { const f32x4 wv = *(const LAS f32x4*)(w8 + e * D + 256 * j + 4 * F.lane); p += (v[j].x * wv.x + v[j].y * wv.y) + (v[j].z * wv.z + v[j].w * wv.w); }
                pp[e] = p; }
            TB_STAGE(0, 4) TB_STAGE(1, 2) TB_STAGE(2, 1)
            float tot = pp[0]; tot += __shfl_xor(tot, 8); tot += __shfl_xor(tot, 16); tot += __shfl_xor(tot, 32);
            float lg[8];
#pragma unroll
            for (int e = 0; e < 8; ++e) lg[e] = __shfl(tot, e) * rstd + INP(F, IN_RB)[e];
            if (F.lane == 0) {
                int e0 = 0; float v0 = lg[0];
#pragma unroll
                for (int e = 1; e < 8; ++e) if (lg[e] > v0) { v0 = lg[e]; e0 = e; }
                int e1 = -1; float v1 = -INFINITY;
#pragma unroll
                for (int e = 0; e < 8; ++e) if (e != e0 && lg[e] > v1) { v1 = lg[e]; e1 = e; }
                const float t = __expf(v1 - v0), g0 = 1.f / (1.f + t), g1 = t * g0;
                rstd_g[m] = rstd; tok_e[2 * m] = e0; tok_e[2 * m + 1] = e1; tok_g[2 * m] = g0; tok_g[2 * m + 1] = g1;
                atomicAdd((int*)&hist[e0], 1); atomicAdd((int*)&hist[8 + e1], 1);
            }
        }
        __syncthreads();
        if (F.tid < 16) hist_g[blk * 16 + F.tid] = hist[F.tid];
        __syncthreads();
    }
}
__device__ __forceinline__ void phase_route2(Frame& F, const bf16* x) {
    LAS int* H = (LAS int*)(F.lds);
    LAS int* tot = (LAS int*)(F.lds + 16384); LAS int* pre = tot + 16; LAS int* start = tot + 32; LAS int* dest = tot + 64; LAS int* te = tot + 320;
    unsigned char* sm = F.ws + WS_SM + SM_MOE;
    const float* rstd_g = (const float*)(sm + MO_RSTD); const int* tok_e = (const int*)(sm + MO_TOKE); const float* tok_g = (const float*)(sm + MO_TOKG); const int* hist_g = (const int*)(sm + MO_HIST);
    int* row_tok = (int*)(sm + MO_ROWTOK); float* row_g = (float*)(sm + MO_ROWG); int* tile_e = (int*)(sm + MO_TILEE); int* ntl = (int*)(sm + MO_NT);
    unsigned char* XS = F.ws + WS_XS;
    for (int blk = F.blk; blk < NTOKBLK; blk += F.G) {
        for (int i = F.tid; i < NTOKBLK * 16; i += NWAVES * 64) H[i] = hist_g[i];
        __syncthreads();
        if (F.tid < 16) { int t = 0, p = 0; for (int b = 0; b < NTOKBLK; ++b) { const int h = H[b * 16 + F.tid]; if (b < blk) p += h; t += h; } tot[F.tid] = t; pre[F.tid] = p; }
        __syncthreads();
        if (F.tid == 0) { for (int k = 0; k < 2; ++k) { int run = 0; for (int e = 0; e < 8; ++e) { start[k * 8 + e] = run; run += ((tot[k * 8 + e] + 255) >> 8) << 8; } if (blk == 0) ntl[k] = run >> 8; } }
        __syncthreads();
        if (F.tid < 2 * TOKBLK) te[F.tid] = tok_e[2 * blk * TOKBLK + F.tid];
        __syncthreads();
        if (F.tid < 16) { const int k = F.tid >> 3, e = F.tid & 7; int cnt = 0; const int base = k * MOE_KROWS + start[F.tid] + pre[F.tid];
            for (int i = 0; i < TOKBLK; ++i) if (te[2 * i + k] == e) { dest[2 * i + k] = base + cnt; ++cnt; }
            if (blk == 0) { const int s0 = start[F.tid], t0 = tot[F.tid], pe = ((t0 + 255) >> 8) << 8;
                for (int tI = s0 >> 8; tI < (s0 + pe) >> 8; ++tI) tile_e[k * MOE_KTILES + tI] = e;
                for (int r = s0 + t0; r < s0 + pe; ++r) { row_tok[k * MOE_KROWS + r] = -1; row_g[k * MOE_KROWS + r] = 0.f; } } }
        __syncthreads();
        for (int i0 = 0; i0 < TOKBLK / NWAVES; i0 += 4) {
            f32x4 xv[4][4]; float rs[4]; float tg[4][2];
#pragma unroll
            for (int q = 0; q < 4; ++q) { const int m = blk * TOKBLK + F.wave * (TOKBLK / NWAVES) + i0 + q; load_xrow<true, XLD>(x, (size_t)m, F.lane, xv[q]); rs[q] = rstd_g[m]; tg[q][0] = tok_g[2 * m]; tg[q][1] = tok_g[2 * m + 1]; }
#pragma unroll
            for (int q = 0; q < 4; ++q) { const int li = F.wave * (TOKBLK / NWAVES) + i0 + q, m = blk * TOKBLK + li; const int d0 = dest[2 * li], d1 = dest[2 * li + 1];
                GAS unsigned* o0 = (GAS unsigned*)(XS + (size_t)d0 * D) + F.lane; GAS unsigned* o1 = (GAS unsigned*)(XS + (size_t)d1 * D) + F.lane; const float sc = rs[q] * FP8_ASCALE;
#pragma unroll
                for (int j = 0; j < 4; ++j) { const f32x4 v = xv[q][j]; const unsigned w = pg8::pack_fp8x4(v.x * sc, v.y * sc, v.z * sc, v.w * sc); o0[64 * j] = w; o1[64 * j] = w; }
                if (F.lane == 0) { row_tok[d0] = m; row_g[d0] = tg[q][0]; row_tok[d1] = m; row_g[d1] = tg[q][1]; } }
        }
        __syncthreads();
    }
}

__device__ __forceinline__ float wave_scan_add(float v, int lane) {
#pragma unroll
    for (int d = 1; d < 64; d <<= 1) { const float t = __shfl_up(v, d); if (lane >= d) v += t; }
    return v;
}
__device__ __forceinline__ float wave_scan_max(float v, int lane) {
#pragma unroll
    for (int d = 1; d < 64; d <<= 1) { const float t = __shfl_up(v, d); if (lane >= d) v = fmaxf(v, t); }
    return v;
}
__device__ __forceinline__ void prep_mlstm(Frame& F, int l, int bh) {
    LAS float* Bc = (LAS float*)(F.lds); LAS float* Gc = Bc + NCH; LAS float* mc = Gc + NCH;
    const int b = bh >> 2, h = bh & 3;
    const float* gate16 = (const float*)(F.ws + WS_SM + SM_GATE16);
    float* mlb = (float*)(F.ws + WS_SM + SM_MLB) + (size_t)bh * SEQ; float* mla = (float*)(F.ws + WS_SM + SM_MLA) + (size_t)bh * SEQ; float* mlmx = (float*)(F.ws + WS_SM + SM_MLMX) + (size_t)bh * SEQ;
    float* mlm = (float*)(F.ws + WS_SM + SM_MLM) + bh * 132; float* mldec = (float*)(F.ws + WS_SM + SM_MLDEC) + bh * NCH;
    const float bi = INP(F, IN_MLBI)[l * ML_H + h], bf = INP(F, IN_MLBF)[l * ML_H + h];
    float areg[NCH / NWAVES];
#pragma unroll
    for (int ci = 0; ci < NCH / NWAVES; ++ci) {
        const int c = F.wave + NWAVES * ci, t = c * CHUNK + F.lane; const size_t m = (size_t)b * SEQ + t;
        const float lf = logsigmoid_f(gate16[m * 16 + 4 + h] + bf), li = gate16[m * 16 + h] + bi;
        const float bc = wave_scan_add(lf, F.lane), a = li - bc;
        const float amax = wave_max(a), btot = __shfl(bc, 63);
        mlb[t] = bc; mla[t] = a; areg[ci] = a;
        if (F.lane == 0) { Bc[c] = btot; Gc[c] = btot + amax; }
    }
    __syncthreads();
    if (F.tid == 0) { float mm = 0.f; for (int c = 0; c < NCH; ++c) { mc[c] = mm; const float mn = fmaxf(Bc[c] + mm, Gc[c]); mldec[c] = __expf(Bc[c] + mm - mn); mlm[c] = mm; mm = mn; } mc[NCH] = mm; mlm[NCH] = mm; }
    __syncthreads();
#pragma unroll
    for (int ci = 0; ci < NCH / NWAVES; ++ci) {
        const int c = F.wave + NWAVES * ci, t = c * CHUNK + F.lane;
        mlmx[t] = fmaxf(mc[c], wave_scan_max(areg[ci], F.lane));
    }
    __syncthreads();
}
__device__ __forceinline__ void prep_fox(Frame& F, int l, int bh) {
    LAS float* wtot = (LAS float*)(F.lds);
    const int b = bh >> 3, h = bh & 7;
    const float* gate16 = (const float*)(F.ws + WS_SM + SM_GATE16);
    float* nb = (float*)(F.ws + WS_SM + SM_FNB) + (size_t)bh * SEQ;
    const float bf = INP(F, IN_FXBF)[l * FX_H + h];
    float v[16]; float s = 0.f;
#pragma unroll
    for (int i = 0; i < 16; ++i) { const size_t m = (size_t)b * SEQ + F.tid * 16 + i; s += logsigmoid_f(gate16[m * 16 + 8 + h] + bf); v[i] = s; }
    const float incl = wave_scan_add(s, F.lane);
    if (F.lane == 63) wtot[F.wave] = incl;
    __syncthreads();
    float off = incl - s;
    for (int w = 0; w < F.wave; ++w) off += wtot[w];
#pragma unroll
    for (int i = 0; i < 16; ++i) nb[F.tid * 16 + i] = -1.4426950408889634f * (off + v[i]);
    __syncthreads();
}

__device__ __forceinline__ void unpack8(const v4u q, float (&f)[8]) {
    f[0] = __uint_as_float(q.x << 16); f[1] = __uint_as_float(q.x & 0xffff0000u); f[2] = __uint_as_float(q.y << 16); f[3] = __uint_as_float(q.y & 0xffff0000u);
    f[4] = __uint_as_float(q.z << 16); f[5] = __uint_as_float(q.z & 0xffff0000u); f[6] = __uint_as_float(q.w << 16); f[7] = __uint_as_float(q.w & 0xffff0000u);
}
__device__ __forceinline__ void pool_item(Frame& F, int item) {
    const bf16* U = (const bf16*)(F.ws + WS_NG + SL_POOL * SLAB_BYTES) + F.lane * 8; bf16* CAT = (bf16*)(F.ws + WS_CAT) + F.lane * 8;
    const int grp = F.lane >> 4, w = 2 << grp, m0 = item * 32, tt0 = m0 & (SEQ - 1);
    v4u ring[16];
#pragma unroll
    for (int j = 1; j < 16; ++j) { ring[(16 - j) & 15] = (v4u){0u, 0u, 0u, 0u}; if (tt0 - j >= 0) ring[(16 - j) & 15] = *(const GAS v4u*)(U + (size_t)(m0 - j) * 512); }
    float sum[8];
#pragma unroll
    for (int i = 0; i < 8; ++i) sum[i] = 0.f;
#pragma unroll
    for (int j = 1; j < 16; ++j) { float f[8]; unpack8(ring[(16 - j) & 15], f); const float on = (j < w) ? 1.f : 0.f;
#pragma unroll
        for (int i = 0; i < 8; ++i) sum[i] += on * f[i]; }
#pragma unroll
    for (int r0 = 0; r0 < 32; r0 += 8) {
        v4u cur[8];
#pragma unroll
        for (int j = 0; j < 8; ++j) cur[j] = *(const GAS v4u*)(U + (size_t)(m0 + r0 + j) * 512);
#pragma unroll
        for (int j = 0; j < 8; ++j) { const int r = r0 + j, tt = tt0 + r;
            float c[8]; unpack8(cur[j], c);
#pragma unroll
            for (int i = 0; i < 8; ++i) sum[i] += c[i];
            const int cnt = (tt + 1 < w) ? tt + 1 : w; const float inv = 1.f / (float)cnt;
            v4u o; o.x = pk2(sum[0] * inv - c[0], sum[1] * inv - c[1]); o.y = pk2(sum[2] * inv - c[2], sum[3] * inv - c[3]); o.z = pk2(sum[4] * inv - c[4], sum[5] * inv - c[5]); o.w = pk2(sum[6] * inv - c[6], sum[7] * inv - c[7]);
            *(GAS v4u*)(CAT + (size_t)(m0 + r) * KCAT) = o;
            const v4u a2 = (r - 1 >= 0 || true) ? ((r - 1) >= r0 ? cur[(j - 1) & 7] : ring[(r - 1) & 15]) : ring[0];
            const v4u a4 = ((r - 3) >= r0) ? cur[(j - 3) & 7] : ring[(r - 3) & 15];
            const v4u a8 = ((r - 7) >= r0) ? cur[(j - 7) & 7] : ring[(r - 7) & 15];
            const v4u a16 = ring[(r - 15) & 15];
            v4u old; old.x = grp == 0 ? a2.x : (grp == 1 ? a4.x : (grp == 2 ? a8.x : a16.x)); old.y = grp == 0 ? a2.y : (grp == 1 ? a4.y : (grp == 2 ? a8.y : a16.y));
            old.z = grp == 0 ? a2.z : (grp == 1 ? a4.z : (grp == 2 ? a8.z : a16.z)); old.w = grp == 0 ? a2.w : (grp == 1 ? a4.w : (grp == 2 ? a8.w : a16.w));
            float f[8]; unpack8(old, f);
#pragma unroll
            for (int i = 0; i < 8; ++i) sum[i] -= f[i];
        }
#pragma unroll
        for (int j = 0; j < 8; ++j) ring[(r0 + j) & 15] = cur[j];
    }
}

__device__ __forceinline__ void fox_norm_item(Frame& F, int it) {
    const int bhblk = it >> 3, wv = it & 7, bh = bhblk >> 5, blk = bhblk & 31, b = bh >> 3, h = bh & 7;
    const size_t m = (size_t)b * SEQ + blk * 256 + wv * 32 + (F.lane >> 1); const int col = h * 64 + (F.lane & 1) * 32;
    const bf16* QS = (const bf16*)(F.ws + WS_NG + SL_FQ * SLAB_BYTES) + m * 512 + col; const bf16* KS = (const bf16*)(F.ws + WS_NG + SL_FK * SLAB_BYTES) + m * 512 + col;
    float sq = 0.f, sk = 0.f, dq = 0.f;
#pragma unroll
    for (int i = 0; i < 4; ++i) { float f[8], g[8]; const v4u a = *(const GAS v4u*)(QS + 8 * i), c = *(const GAS v4u*)(KS + 8 * i);
        f[0] = __uint_as_float(a.x << 16); f[1] = __uint_as_float(a.x & 0xffff0000u); f[2] = __uint_as_float(a.y << 16); f[3] = __uint_as_float(a.y & 0xffff0000u); f[4] = __uint_as_float(a.z << 16); f[5] = __uint_as_float(a.z & 0xffff0000u); f[6] = __uint_as_float(a.w << 16); f[7] = __uint_as_float(a.w & 0xffff0000u);
        g[0] = __uint_as_float(c.x << 16); g[1] = __uint_as_float(c.x & 0xffff0000u); g[2] = __uint_as_float(c.y << 16); g[3] = __uint_as_float(c.y & 0xffff0000u); g[4] = __uint_as_float(c.z << 16); g[5] = __uint_as_float(c.z & 0xffff0000u); g[6] = __uint_as_float(c.w << 16); g[7] = __uint_as_float(c.w & 0xffff0000u);
#pragma unroll
        for (int j = 0; j < 8; ++j) { sq += f[j] * f[j]; sk += g[j] * g[j]; dq += f[j] * g[j]; } }
    sq += __shfl_xor(sq, 1); sk += __shfl_xor(sk, 1); dq += __shfl_xor(dq, 1);
    dq = -wave_max(-dq);
    sq = wave_max(sq) * 1.0001f; sk = wave_max(sk) * 1.0001f;
    if (F.lane == 0) { ((float*)(F.ws + WS_SM + SM_FQN))[it] = sq; ((float*)(F.ws + WS_SM + SM_FKN))[it] = sk; ((float*)(F.ws + WS_SM + SM_FXM))[it] = dq; }
}

typedef float f32x16 __attribute__((ext_vector_type(16)));
typedef unsigned u32x2 __attribute__((ext_vector_type(2)));
__device__ __forceinline__ float silu_f(float x) { return x * __builtin_amdgcn_rcpf(1.f + __builtin_amdgcn_exp2f(-1.4426950408889634f * x)); }
__device__ __forceinline__ void conv8(const bf16* slab, size_t m, int tt, int col, const float (&cw)[4][8], float (&o)[8]) {
    v4u q[4];
#pragma unroll
    for (int j = 0; j < 4; ++j) { const size_t mr = (tt - 3 + j >= 0) ? m - 3 + j : m; q[j] = *(const GAS v4u*)(slab + mr * 512 + col); }
#pragma unroll
    for (int i = 0; i < 8; ++i) o[i] = 0.f;
#pragma unroll
    for (int j = 0; j < 4; ++j) { float f[8]; unpack8(q[j], f); const float vld = (tt - 3 + j >= 0) ? 1.f : 0.f;
#pragma unroll
        for (int i = 0; i < 8; ++i) o[i] += (cw[j][i] * vld) * f[i]; }
#pragma unroll
    for (int i = 0; i < 8; ++i) o[i] = silu_f(o[i]);
}
constexpr int KT_P = 72, QS_P = 136;
__device__ __forceinline__ bf16x8 pack_acc8(const f32x16& x, int s) {
    v4u w; w.x = pk2(x[8 * s + 0], x[8 * s + 1]); w.y = pk2(x[8 * s + 2], x[8 * s + 3]); w.z = pk2(x[8 * s + 4], x[8 * s + 5]); w.w = pk2(x[8 * s + 6], x[8 * s + 7]);
    return __builtin_bit_cast(bf16x8, w);
}
__device__ __forceinline__ void conv8r(const v4u (&q)[4], int tt, const LAS float* cw, int col, float (&o)[8]) {
#pragma unroll
    for (int i = 0; i < 8; ++i) o[i] = 0.f;
#pragma unroll
    for (int j = 0; j < 4; ++j) { float f[8]; unpack8(q[j], f); const float vld = (tt - 3 + j >= 0) ? 1.f : 0.f;
        const f32x4 w0 = *(const LAS f32x4*)(cw + j * 512 + col) * vld, w1 = *(const LAS f32x4*)(cw + j * 512 + col + 4) * vld;
#pragma unroll
        for (int i = 0; i < 4; ++i) { o[i] += w0[i] * f[i]; o[4 + i] += w1[i] * f[4 + i]; } }
#pragma unroll
    for (int i = 0; i < 8; ++i) o[i] = silu_f(o[i]);
}
struct RawL { v4u k[2][4]; v4u v[2]; float fp, ip; };
__device__ __forceinline__ void mlstm_L_load(Frame& F, int u, RawL& R) {
    const int bh = u >> 7, c = u & (NCH - 1), b = bh >> 2, h = bh & 3;
    const bf16* KS = (const bf16*)(F.ws + WS_NG + SL_MK * SLAB_BYTES); const bf16* VS = (const bf16*)(F.ws + WS_NG + SL_MV * SLAB_BYTES);
    const int s = F.lane, tt = c * CHUNK + s; const size_t m = (size_t)b * SEQ + tt;
#pragma unroll
    for (int half = 0; half < 2; ++half) { const int col = h * ML_DH + (F.wave + 8 * half) * 8;
#pragma unroll
        for (int j = 0; j < 4; ++j) { const size_t mr = (tt - 3 + j >= 0) ? m - 3 + j : m; R.k[half][j] = *(const GAS v4u*)(KS + mr * 512 + col); }
        R.v[half] = *(const GAS v4u*)(VS + m * 512 + col); }
    const float* gate16 = (const float*)(F.ws + WS_SM + SM_GATE16) + m * 16;
    R.fp = gate16[4 + h]; R.ip = gate16[h];
}
__device__ __forceinline__ void mlstm_L_phase(Frame& F, int l) {
    LAS bf16* Kt = (LAS bf16*)(F.lds); LAS bf16* Vt = Kt + 128 * KT_P; LAS float* wk = (LAS float*)(F.lds + 2 * 128 * KT_P * 2); LAS float* cwk = (LAS float*)(F.lds + 40960);
    for (int i = F.tid; i < 4 * 512; i += NWAVES * 64) cwk[i] = INP(F, IN_CONVW)[(size_t)l * 4 * 1024 + (i >> 9) * 1024 + 512 + (i & 511)];
    const int NU = BATCH * ML_H * NCH;
    float b_f[ML_H], b_i[ML_H];
#pragma unroll
    for (int i = 0; i < ML_H; ++i) { b_f[i] = INP(F, IN_MLBF)[l * ML_H + i]; b_i[i] = INP(F, IN_MLBI)[l * ML_H + i]; }
    int u = F.vcu; if (u >= NU) { __syncthreads(); return; }
    RawL cur; mlstm_L_load(F, u, cur);
    __syncthreads();
    for (; u < NU; u += F.G) {
        const int bh = u >> 7, h = bh & 3;
        if (F.tid < CHUNK) {
            const float lf = logsigmoid_f(cur.fp + b_f[h]), li = cur.ip + b_i[h];
            const float bc = wave_scan_add(lf, F.lane), a = li - bc, amax = wave_max(a);
            wk[F.tid] = __expf(a - amax);
            const int c = u & (NCH - 1);
            ((float*)(F.ws + WS_SM + SM_MLB))[(size_t)bh * SEQ + c * CHUNK + F.tid] = bc; ((float*)(F.ws + WS_SM + SM_MLA))[(size_t)bh * SEQ + c * CHUNK + F.tid] = a;
            if (F.tid == 63) { float* bg = (float*)(F.ws + WS_SM + SM_MLBG) + 2 * u; bg[0] = bc; bg[1] = bc + amax; }
        }
        __syncthreads();
        {   const int s = F.lane, tt = (u & (NCH - 1)) * CHUNK + s;
#pragma unroll
            for (int half = 0; half < 2; ++half) { const int cg = F.wave + 8 * half, col = h * ML_DH + cg * 8;
                float kk[8]; conv8r(cur.k[half], tt, cwk, col, kk);
                float vv[8]; unpack8(cur.v[half], vv); const float ws = wk[s];
#pragma unroll
                for (int i = 0; i < 8; ++i) { Kt[(cg * 8 + i) * KT_P + s] = (bf16)f2bf(kk[i] * 0.08838834764831845f); Vt[(cg * 8 + i) * KT_P + s] = (bf16)f2bf(vv[i] * ws); } }
        }
        __syncthreads();
        if (u + F.G < NU) mlstm_L_load(F, u + F.G, cur);
        {   const int r = F.lane & 31, hi = F.lane >> 5, kb = F.wave >> 1;
            f32x16 acc[2]; acc[0] = f32x16{}; acc[1] = f32x16{};
#pragma unroll
            for (int sp = 0; sp < 4; ++sp) { const bf16x8 a = *(const LAS bf16x8*)(Kt + (kb * 32 + r) * KT_P + 16 * sp + 8 * hi);
#pragma unroll
                for (int j = 0; j < 2; ++j) { const int vb = 2 * (F.wave & 1) + j; const bf16x8 bb = *(const LAS bf16x8*)(Vt + (vb * 32 + r) * KT_P + 16 * sp + 8 * hi);
                    acc[j] = __builtin_amdgcn_mfma_f32_32x32x16_bf16(a, bb, acc[j], 0, 0, 0); } }
            GAS bf16x8* img = (GAS bf16x8*)(F.ws + WS_MLC + (size_t)u * 32768);
#pragma unroll
            for (int j = 0; j < 2; ++j) { const int vb = 2 * (F.wave & 1) + j;
#pragma unroll
                for (int s = 0; s < 2; ++s) img[((vb * 4 + kb) * 2 + s) * 64 + F.lane] = pack_acc8(acc[j], s); }
        }
        if (F.tid < ML_DH) { float a = 0.f;
#pragma unroll 8
            for (int s = 0; s < CHUNK; ++s) a += wk[s] * __uint_as_float((unsigned)Kt[F.tid * KT_P + s] << 16);
            ((float*)(F.ws + WS_SM + SM_MLN))[(size_t)u * ML_DH + F.tid] = a; }
        __syncthreads();
    }
}
__device__ __forceinline__ void mlstm_S(Frame& F) {
    LAS float* dec = (LAS float*)(F.lds); LAS float* cor = dec + NCH;
    for (int unit = F.vcu; unit < 16 * 16; unit += F.G) {
        const int bh = unit >> 4, part = unit & 15;
        if (F.tid == 0) { const float* bg = (const float*)(F.ws + WS_SM + SM_MLBG) + 2 * bh * NCH; float* mlm = (float*)(F.ws + WS_SM + SM_MLM) + bh * 132; float mm = 0.f;
            for (int c = 0; c < NCH; ++c) { const float B = bg[2 * c], G = bg[2 * c + 1], mn = fmaxf(B + mm, G); dec[c] = __expf(B + mm - mn); cor[c] = __expf(G - mn); mlm[c] = mm; mm = mn; }
            mlm[NCH] = mm; }
        __syncthreads();
        {   const int e2 = part * 512 + F.tid; GAS unsigned* p = (GAS unsigned*)(F.ws + WS_MLC + (size_t)bh * NCH * 32768) + e2;
            float r0 = 0.f, r1 = 0.f;
            for (int c0 = 0; c0 < NCH; c0 += 16) { unsigned q[16];
#pragma unroll
                for (int i = 0; i < 16; ++i) q[i] = p[(size_t)(c0 + i) * 8192];
#pragma unroll
                for (int i = 0; i < 16; ++i) { const float d = dec[c0 + i], k = cor[c0 + i]; p[(size_t)(c0 + i) * 8192] = pk2(r0, r1);
                    r0 = d * r0 + k * __uint_as_float(q[i] << 16); r1 = d * r1 + k * __uint_as_float(q[i] & 0xffff0000u); } } }
        if (part == 0 && F.tid < ML_DH) { float* p = (float*)(F.ws + WS_SM + SM_MLN) + (size_t)bh * NCH * ML_DH + F.tid;
            float r = 0.f;
            for (int c0 = 0; c0 < NCH; c0 += 16) { float q[16];
#pragma unroll
                for (int i = 0; i < 16; ++i) q[i] = p[(size_t)(c0 + i) * ML_DH];
#pragma unroll
                for (int i = 0; i < 16; ++i) { p[(size_t)(c0 + i) * ML_DH] = r; r = dec[c0 + i] * r + cor[c0 + i] * q[i]; } } }
        __syncthreads();
    }
}
#define O_BAR() do { asm volatile("s_waitcnt lgkmcnt(0)" ::: "memory"); __builtin_amdgcn_s_barrier(); asm volatile("" ::: "memory"); } while (0)
constexpr int O_RAWQ = 73728, O_RAWK = O_RAWQ + 68 * 256, O_RAWV = O_RAWK + 68 * 256, O_END = O_RAWV + 64 * 256;
static_assert(O_END + 3 * 2 * 1024 <= RING_BYTES, "mLSTM O-phase LDS map");
__device__ __forceinline__ void mlstm_O_dma(Frame& F, int u) {
    const int bh = u >> 7, c = u & (NCH - 1), b = bh >> 2, h = bh & 3;
    const size_t seq0 = (size_t)b * SEQ; const int t0 = c * CHUNK;
    for (int i = F.wave; i < 50; i += NWAVES) {
        const int ten = i < 17 ? 0 : (i < 34 ? 1 : 2), ii = i - 17 * ten, row = 4 * ii + (F.lane >> 4);
        int t = (ten == 2) ? t0 + row : t0 - 3 + row; t = t < 0 ? 0 : (t > t0 + CHUNK - 1 ? t0 + CHUNK - 1 : t);
        const bf16* src = (const bf16*)(F.ws + WS_NG + (size_t)(ten == 0 ? SL_MQ : (ten == 1 ? SL_MK : SL_MV)) * SLAB_BYTES) + (seq0 + t) * 512 + h * ML_DH + (((F.lane & 15) ^ (row & 15)) * 8);
        const int dst = (ten == 0 ? O_RAWQ : (ten == 1 ? O_RAWK : O_RAWV)) + ii * 1024;
        __builtin_amdgcn_global_load_lds((const GAS unsigned*)src, (LAS unsigned*)(F.lds + dst), 16, 0, 0);
    }
}
__device__ __forceinline__ void conv8l(const LAS bf16* raw, int s, int tt, const LAS float* cw, int cg, int col, float (&o)[8]) {
#pragma unroll
    for (int i = 0; i < 8; ++i) o[i] = 0.f;
#pragma unroll
    for (int j = 0; j < 4; ++j) { float f[8]; unpack8(*(const LAS v4u*)(raw + (s + j) * 128 + ((cg ^ ((s + j) & 15)) * 8)), f); const float vld = (tt - 3 + j >= 0) ? 1.f : 0.f;
        const f32x4 w0 = *(const LAS f32x4*)(cw + j * 512 + col) * vld, w1 = *(const LAS f32x4*)(cw + j * 512 + col + 4) * vld;
#pragma unroll
        for (int i = 0; i < 4; ++i) { o[i] += w0[i] * f[i]; o[4 + i] += w1[i] * f[4 + i]; } }
#pragma unroll
    for (int i = 0; i < 8; ++i) o[i] = silu_f(o[i]);
}
__device__ __forceinline__ void mlstm_O_phase(Frame& F, int l) {
    LAS bf16* Qs = (LAS bf16*)(F.lds); LAS bf16* Ks = Qs + 64 * QS_P; LAS bf16* Vt = Ks + 64 * QS_P;
    LAS float* fa = (LAS float*)(F.lds + (2 * 64 * QS_P + 128 * KT_P) * 2); LAS float* fmx = fa + 64; LAS float* fb = fa + 128; LAS float* nvec = fa + 192; LAS float* ssq = fa + 320;
    LAS float* cwq = (LAS float*)(F.lds + 57344); LAS float* cwk = cwq + 4 * 512;
    LAS float* psm = (LAS float*)(F.lds + 55552); LAS float* nqp = psm + 96; LAS bf16x8* pimg = (LAS bf16x8*)(F.lds + O_END);
    const LAS bf16* rawq = (const LAS bf16*)(F.lds + O_RAWQ); const LAS bf16* rawk = (const LAS bf16*)(F.lds + O_RAWK); const LAS bf16* rawv = (const LAS bf16*)(F.lds + O_RAWV);
    for (int i = F.tid; i < 4 * 512; i += NWAVES * 64) { cwq[i] = INP(F, IN_CONVW)[(size_t)l * 4 * 1024 + (i >> 9) * 1024 + (i & 511)]; cwk[i] = INP(F, IN_CONVW)[(size_t)l * 4 * 1024 + (i >> 9) * 1024 + 512 + (i & 511)]; }
    const int NU = BATCH * ML_H * NCH;
    int u = F.vcu; if (u >= NU) { __syncthreads(); return; }
    mlstm_O_dma(F, u);
    const bf16* OS = (const bf16*)(F.ws + WS_NG + SL_MO * SLAB_BYTES);
    const int r = F.lane & 31, hi = F.lane >> 5, tb = F.wave & 1, vb = F.wave >> 1;
    for (; u < NU; u += F.G) {
    const int bh = u >> 7, c = u & (NCH - 1), b = bh >> 2, h = bh & 3;
    asm volatile("s_waitcnt vmcnt(0)" ::: "memory"); O_BAR();
    const float m_c = ((const float*)(F.ws + WS_SM + SM_MLM))[bh * 132 + c];
    bf16x8 cf[4][2];
    {   const GAS bf16x8* img = (const GAS bf16x8*)(F.ws + WS_MLC + (size_t)u * 32768);
#pragma unroll
        for (int kb = 0; kb < 4; ++kb)
#pragma unroll
            for (int s = 0; s < 2; ++s) cf[kb][s] = img[((vb * 4 + kb) * 2 + s) * 64 + F.lane]; }
    u32x2 oww[4];
    {   const size_t m = (size_t)b * SEQ + c * CHUNK + tb * 32 + r;
#pragma unroll
        for (int q = 0; q < 4; ++q) oww[q] = *(const GAS u32x2*)(OS + m * 512 + h * ML_DH + vb * 32 + 8 * q + 4 * hi); }
    float g0 = 0.f, g1 = 0.f, g2 = 0.f;
    {   const float* mlb = (const float*)(F.ws + WS_SM + SM_MLB) + (size_t)bh * SEQ; const float* mla = (const float*)(F.ws + WS_SM + SM_MLA) + (size_t)bh * SEQ; const float* mlmx = (const float*)(F.ws + WS_SM + SM_MLMX) + (size_t)bh * SEQ;
        if (F.tid < CHUNK) { g0 = mla[c * CHUNK + F.tid]; g2 = mlb[c * CHUNK + F.tid]; g1 = fmaxf(m_c, wave_scan_max(g0, F.lane)); }
        else if (F.tid < CHUNK + ML_DH) g0 = ((const float*)(F.ws + WS_SM + SM_MLN))[(size_t)u * ML_DH + F.tid - CHUNK]; }
    {   const int s = F.lane, tt = c * CHUNK + s;
#pragma unroll
        for (int half = 0; half < 2; ++half) { const int cg = F.wave + 8 * half, col = h * ML_DH + cg * 8;
            float qq[8], kk[8], vv[8]; conv8l(rawq, s, tt, cwq, cg, col, qq); conv8l(rawk, s, tt, cwk, cg, col, kk); unpack8(*(const LAS v4u*)(rawv + s * 128 + ((cg ^ (s & 15)) * 8)), vv);
            v4u wq, wkk; wq.x = pk2(qq[0], qq[1]); wq.y = pk2(qq[2], qq[3]); wq.z = pk2(qq[4], qq[5]); wq.w = pk2(qq[6], qq[7]);
            const float sc = 0.08838834764831845f;
            wkk.x = pk2(kk[0] * sc, kk[1] * sc); wkk.y = pk2(kk[2] * sc, kk[3] * sc); wkk.z = pk2(kk[4] * sc, kk[5] * sc); wkk.w = pk2(kk[6] * sc, kk[7] * sc);
            *(LAS v4u*)(Qs + s * QS_P + cg * 8) = wq; *(LAS v4u*)(Ks + s * QS_P + cg * 8) = wkk;
#pragma unroll
            for (int i = 0; i < 8; ++i) Vt[(cg * 8 + i) * KT_P + s] = (bf16)f2bf(vv[i]); }
    }
    if (F.tid < CHUNK) { fa[F.tid] = g0; fmx[F.tid] = g1; fb[F.tid] = g2; }
    else if (F.tid < CHUNK + ML_DH) nvec[F.tid - CHUNK] = g0;
    O_BAR();
    if (u + F.G < NU) mlstm_O_dma(F, u + F.G);
    const int t = tb * 32 + r;
    const float Mx_t = fmx[t], m_t = fb[t] + Mx_t, w_int = __expf(m_c - Mx_t);
    if (F.wave < 3) {
        const int tbs = F.wave ? 1 : 0, sbs = F.wave == 2 ? 1 : 0, ts = tbs * 32 + r; const float Mxs = fmx[ts];
        f32x16 x = f32x16{};
#pragma unroll
        for (int ks = 0; ks < 8; ++ks) { const bf16x8 a = *(const LAS bf16x8*)(Ks + (sbs * 32 + r) * QS_P + 16 * ks + 8 * hi); const bf16x8 q = *(const LAS bf16x8*)(Qs + ts * QS_P + 16 * ks + 8 * hi);
            x = __builtin_amdgcn_mfma_f32_32x32x16_bf16(a, q, x, 0, 0, 0); }
        float ps = 0.f;
#pragma unroll
        for (int rr = 0; rr < 16; ++rr) { const int s = sbs * 32 + (rr & 3) + 8 * (rr >> 2) + 4 * hi; const float pv = (s <= ts) ? __expf(fa[s] - Mxs) * x[rr] : 0.f; x[rr] = pv; ps += pv; }
        ps += __shfl_xor(ps, 32);
        pimg[(F.wave * 2 + 0) * 64 + F.lane] = pack_acc8(x, 0); pimg[(F.wave * 2 + 1) * 64 + F.lane] = pack_acc8(x, 1);
        if (hi == 0) psm[F.wave * 32 + r] = ps;
    }
    {   float nq = 0.f;
#pragma unroll
        for (int i = 0; i < 2; ++i) { float f[8]; unpack8(*(const LAS v4u*)(Qs + t * QS_P + 32 * vb + 16 * hi + 8 * i), f);
#pragma unroll
            for (int j = 0; j < 8; ++j) nq += f[j] * nvec[32 * vb + 16 * hi + 8 * i + j]; }
        nq += __shfl_xor(nq, 32);
        if (hi == 0) nqp[vb * 64 + t] = nq; }
    f32x16 acc = f32x16{};
#pragma unroll
    for (int kb = 0; kb < 4; ++kb)
#pragma unroll
        for (int s = 0; s < 2; ++s) { const u32x2 lo = *(const LAS u32x2*)(Qs + t * QS_P + kb * 32 + 16 * s + 4 * hi), hi2 = *(const LAS u32x2*)(Qs + t * QS_P + kb * 32 + 16 * s + 8 + 4 * hi);
            v4u w; w.x = lo.x; w.y = lo.y; w.z = hi2.x; w.w = hi2.y;
            acc = __builtin_amdgcn_mfma_f32_32x32x16_bf16(cf[kb][s], __builtin_bit_cast(bf16x8, w), acc, 0, 0, 0); }
#pragma unroll
    for (int rr = 0; rr < 16; ++rr) acc[rr] *= w_int;
    O_BAR();
    float psum = 0.f;
#pragma unroll
    for (int sb = 0; sb < 2; ++sb) {
        if (sb <= tb) { const int blk = tb == 0 ? 0 : 1 + sb; psum += psm[blk * 32 + r];
#pragma unroll
            for (int s = 0; s < 2; ++s) { const u32x2 lo = *(const LAS u32x2*)(Vt + (vb * 32 + r) * KT_P + sb * 32 + 16 * s + 4 * hi), hi2 = *(const LAS u32x2*)(Vt + (vb * 32 + r) * KT_P + sb * 32 + 16 * s + 8 + 4 * hi);
                v4u w; w.x = lo.x; w.y = lo.y; w.z = hi2.x; w.w = hi2.y;
                acc = __builtin_amdgcn_mfma_f32_32x32x16_bf16(__builtin_bit_cast(bf16x8, w), pimg[(blk * 2 + s) * 64 + F.lane], acc, 0, 0, 0); }
        }
    }
    const float nq = (nqp[t] + nqp[64 + t]) + (nqp[128 + t] + nqp[192 + t]);
    const float den = w_int * nq + psum, inv = 1.f / fmaxf(fabsf(den), __expf(-m_t));
    float sq = 0.f;
#pragma unroll
    for (int rr = 0; rr < 16; ++rr) { acc[rr] *= inv; sq += acc[rr] * acc[rr]; }
    sq += __shfl_xor(sq, 32);
    if (hi == 0) ssq[vb * 64 + t] = sq;
    O_BAR();
    const float rstd = 1.f / sqrtf((ssq[t] + ssq[64 + t] + ssq[128 + t] + ssq[192 + t]) * (1.f / ML_DH) + NORM_EPS);
    {   const size_t m = (size_t)b * SEQ + c * CHUNK + t; bf16* CAT = (bf16*)(F.ws + WS_CAT);
#pragma unroll
        for (int q = 0; q < 4; ++q) { const int v0 = vb * 32 + 8 * q + 4 * hi, col = h * ML_DH + v0;
            const u32x2 ow = oww[q]; const f32x4 gn = *(const GAS f32x4*)(INP(F, IN_MLNG) + (size_t)l * 512 + col);
            const float o0 = sigmoid_f(__uint_as_float(ow.x << 16)), o1 = sigmoid_f(__uint_as_float(ow.x & 0xffff0000u)), o2 = sigmoid_f(__uint_as_float(ow.y << 16)), o3 = sigmoid_f(__uint_as_float(ow.y & 0xffff0000u));
            u32x2 w; w.x = pk2(acc[4 * q] * rstd * gn.x * o0, acc[4 * q + 1] * rstd * gn.y * o1); w.y = pk2(acc[4 * q + 2] * rstd * gn.z * o2, acc[4 * q + 3] * rstd * gn.w * o3);
            *(GAS u32x2*)(CAT + m * KCAT + 512 + col) = w; }
    }
    }
    asm volatile("s_waitcnt vmcnt(0)" ::: "memory"); O_BAR();
}
#undef O_BAR

#ifndef SUBP
#define SUBP 0
#endif
#ifndef MK_MULTI
#define MK_MULTI 0
#endif
constexpr int NPH = 1 + (8 + 1) + (1 + 8 + 4) + 1;
#ifndef PH_MASK
#define PH_MASK 0xffffffffu
#endif
#ifndef PROBE_MASK
#define PROBE_MASK 0u
#endif
#define PH_BEGIN(id) if (ph >= lo && ph < hi) { if constexpr (((PH_MASK) >> (id)) & 1u) { for (int rep_ = 0; rep_ < 1 + (int)(((PROBE_MASK) >> (id)) & 1u); ++rep_) { Frame F = FK; { size_t z_ = 0; int zi_ = 0; asm volatile("" : "+v"(F.tid), "+s"(z_), "+s"(zi_)); \
        F.lane = F.tid & 63; F.ws = FK.ws + z_; F.out = (float*)((char*)FK.out + z_); F.zi = zi_; } const int gw = F.vcu * NWAVES + F.wave, NGWV = F.G * NWAVES; (void)gw; (void)NGWV;
#define PH_END __syncthreads(); } } if (ph + 1 < hi) { XcdBarrier b2_ = bar; size_t zb_ = 0; asm volatile("" : "+s"(zb_)); b2_.bar = bar.bar + zb_; xcd_barrier(b2_); } } ++ph;
#define HB ((bf16*)(F.ws + WS_HB))
#define CAT ((bf16*)(F.ws + WS_CAT))
#define SLAB ((bf16*)(F.ws + WS_NG))
#define GATE ((bf16*)(F.ws + WS_GATE))
#define WL ((bf16*)(F.ws + WS_W + (size_t)l * W_LAYER))
#define XBP ((bf16*)F.out)

template <int l> __device__ __forceinline__ void layer_phases(Frame& FK, int& ph, const int lo, const int hi, const XcdBarrier& bar, unsigned char* lds) {
        if constexpr (l > 0) { PH_BEGIN(1) phase_norm_mix<true>(F, XBP, l); PH_END }
        PH_BEGIN(2)
            pg8::Gemm g{HB, WL + W_NG / 2, M, NGW, D}; pg8::StaticOrder S; S.init(M, NGW, F.G, F.blk);
            pg8::EpiSlab E{SLAB, (size_t)M * 512, SL_FQ, attn_body::C2};
            pg8::gemm_phase<pg8::EpiSlab, pg8::StaticOrder, true, true>(F.lds + RING_OFF, g, S, E);
        PH_END
        PH_BEGIN(3)
            for (int s = F.blk; s < BATCH * FX_H; s += F.G) prep_fox(F, l, s);
            for (int rp = 0; rp < (SUBP == 1 ? 2 : 1); ++rp) for (int it = gw; it < M / 32; it += NGWV) pool_item(F, it);
            for (int rp = 0; rp < (SUBP == 2 ? 2 : 1); ++rp) for (int it = gw; it < BATCH * FX_H * 32 * 8; it += NGWV) fox_norm_item(F, it);
            for (int rp = 0; rp < (SUBP == 3 ? 2 : 1); ++rp) mlstm_L_phase(F, l);
        PH_END
        PH_BEGIN(4)
            mlstm_S(F);
            for (int ui = gw; ui < BATCH * FX_H * 32; ui += NGWV) { const int bh = ui >> 5, qb = ui & 31;
                const int t0 = attn_body::attn_t0(qb, (const float*)(F.ws + WS_SM + SM_FNB) + (size_t)bh * SEQ, (const float*)(F.ws + WS_SM + SM_FQN) + bh * 256, (const float*)(F.ws + WS_SM + SM_FKN) + bh * 256, (const float*)(F.ws + WS_SM + SM_FXM) + bh * 256, F.lane);
                if (F.lane == 0) ((int*)(F.ws + WS_SM + SM_FT0))[ui] = t0; }
        PH_END
        PH_BEGIN(18)
            for (int rp = 0; rp < (SUBP == 4 ? 2 : 1); ++rp) mlstm_O_phase(F, l);
            const attn_body::AttnTensors AT{(const attn_body::bf16*)(SLAB + (size_t)SL_FQ * M * 512), (const attn_body::bf16*)(SLAB + (size_t)SL_FK * M * 512), (const attn_body::bf16*)(SLAB + (size_t)SL_FV * M * 512),
                                            (attn_body::bf16*)CAT, (const float*)(F.ws + WS_SM + SM_FNB), (const float*)(F.ws + WS_SM + SM_FQN), (const float*)(F.ws + WS_SM + SM_FKN), (const int*)(F.ws + WS_SM + SM_FT0)};
            attn_body::attn_phase_dyn<8>((char*)lds + RING_OFF, AT, (unsigned*)(F.ctl + 2048 + 64 * l), F.MISC + 0);
            quant_rows_fp8(F, HB, F.ws + WS_NG + (size_t)SL_POOL * SLAB_BYTES);
        PH_END
        PH_BEGIN(6)
            pg8::Gemm g{(const bf16*)(F.ws + WS_NG + (size_t)SL_POOL * SLAB_BYTES), WL + W_GT / 2, M, NGT, D / 2}; pg8::StaticOrder S; S.init(M, NGT, F.G, F.blk);
            pg8::EpiSig E{(unsigned char*)GATE, 1.f / (FP8_ASCALE * FP8_WSCALE)};
            pg8::gemm_phase<pg8::EpiSig, pg8::StaticOrder, true, true, true>(F.lds + RING_OFF, g, S, E);
        PH_END
        PH_BEGIN(7)
            pg8::Gemm g{CAT, WL + W_CAT / 2, M, D, KCAT}; pg8::StaticOrder S; S.init(M, D, F.G, F.blk);
            pg8::EpiMerge E{(const unsigned char*)GATE, HB};
            pg8::gemm_phase<pg8::EpiMerge, pg8::StaticOrder, true, true>(F.lds + RING_OFF, g, S, E);
        PH_END
        PH_BEGIN(8)
            pg8::Gemm g{HB, WL + W_OUT / 2, M, D, D}; pg8::StaticOrder S; S.init(M, D, F.G, F.blk);
            if constexpr (l == 0) { pg8::EpiResB<true> E{INP(F, IN_X), XBP, (float*)(F.ws + WS_SM + SM_GATE16)};     pg8::gemm_phase<pg8::EpiResB<true>, pg8::StaticOrder, true, true>(F.lds + RING_OFF, g, S, E); }
            else { pg8::EpiResB<false> E{XBP, XBP, nullptr}; pg8::gemm_phase<pg8::EpiResB<false>, pg8::StaticOrder, true, true>(F.lds + RING_OFF, g, S, E); }
        PH_END
        if constexpr (l == 0) {
            PH_BEGIN(10)
                pg8::Gemm g{XBP, (const bf16*)(F.ws + WS_WGU), M, 2 * DFF, D}; pg8::StaticOrder S; S.init(M, 2 * DFF, F.G, F.blk);
                pg8::EpiSwiGLUR E{(bf16*)(F.ws + WS_ACT0), DFF, (const float*)(F.ws + WS_SM + SM_GATE16), 1.f / D, NORM_EPS};
                pg8::gemm_phase<pg8::EpiSwiGLUR, pg8::StaticOrder, true, true, false, XLD>(F.lds + RING_OFF, g, S, E);
            PH_END
            PH_BEGIN(11)
                pg8::Gemm g{(const bf16*)(F.ws + WS_ACT0), (const bf16*)(F.ws + WS_WDN), M, D, DFF}; pg8::StaticOrder S; S.init(M, D, F.G, F.blk);
                pg8::EpiResB<false> E{XBP, XBP, nullptr};
                pg8::gemm_phase<pg8::EpiResB<false>, pg8::StaticOrder, true, true>(F.lds + RING_OFF, g, S, E);
            PH_END
        } else {
            PH_BEGIN(12)
                phase_route1(F, XBP);
                __syncthreads();
                LAS float* scr = (LAS float*)(F.lds + F.wave * 16384);
                for (int it = gw; it < CI_MOE; it += NGWV) conv_item_moe(F, it, scr);
            PH_END
            PH_BEGIN(13) phase_route2(F, XBP); PH_END
#define MOE_UP(k_, S_) do { pg8::Gemm g{(const bf16*)(F.ws + WS_XS + (size_t)(k_) * MOE_KROWS * D), (const bf16*)(F.ws + WS_MOEGU), MOE_KROWS, 2 * DFE, D / 2}; \
                    pg8::EpiSwiGLU8 E{F.ws + WS_ACT1 + (size_t)(k_) * MOE_KROWS * DFE, DFE, 1.f / (FP8_ASCALE * FP8_WSCALE), FP8_ASCALE}; \
                    pg8::gemm_phase<pg8::EpiSwiGLU8, decltype(S_), true, true, true>(F.lds + RING_OFF, g, S_, E); } while (0)
#define MOE_DOWN(k_) do { pg8::Gemm g{(const bf16*)(F.ws + WS_ACT1 + (size_t)(k_) * MOE_KROWS * DFE), (const bf16*)(F.ws + WS_MOEDN), MOE_KROWS, D, DFE / 2}; pg8::MoeOrder S; S.init(nM[k_], D / 256, F.G, F.blk, tile_e + (k_) * MOE_KTILES); \
                    pg8::EpiMoeDown E{(bf16*)(F.ws + ((k_) == 0 ? WS_Y0 : WS_Y1)), (const int*)(sm + MO_ROWTOK) + (k_) * MOE_KROWS, (const float*)(sm + MO_ROWG) + (k_) * MOE_KROWS, 1.f / (FP8_ASCALE * FP8_WSCALE)}; \
                    pg8::gemm_phase<pg8::EpiMoeDown, pg8::MoeOrder, true, true, true>(F.lds + RING_OFF, g, S, E); } while (0)
#define MOE_TABLES unsigned char* sm = F.ws + WS_SM + SM_MOE; LAS int* tile_e = (LAS int*)(F.lds + LDSCTL_OFF + 1024); \
                    for (int i_ = F.tid; i_ < 2 * MOE_KTILES; i_ += NWAVES * 64) tile_e[i_] = __hip_atomic_load((const int*)(sm + MO_TILEE) + i_, RLX_AGENT); __syncthreads(); \
                    const int nM[2] = {__builtin_amdgcn_readfirstlane(__hip_atomic_load((const int*)(sm + MO_NT), RLX_AGENT)), __builtin_amdgcn_readfirstlane(__hip_atomic_load((const int*)(sm + MO_NT) + 1, RLX_AGENT))};
            PH_BEGIN(14)
                MOE_TABLES
                pg8::MoeOrder S; S.init(nM[0], 2 * DFE / 256, F.G, F.blk, tile_e);
                MOE_UP(0, S);
            PH_END
            PH_BEGIN(15)
                MOE_TABLES
                MOE_DOWN(0);
                const int Nd = nM[0] * (D / 256), Nu = nM[1] * (2 * DFE / 256), qd = Nd / F.G, rd = Nd % F.G;
                const float T = (3.5f * (float)Nd + (float)Nu) / (float)F.G;
                float cum = 0.f; int lo_u = 0, hi_u = 0;
                for (int v = 0; v <= F.vcu; ++v) { const int w = (F.G % 8 == 0) ? (v % (F.G / 8)) * 8 + v / (F.G / 8) : v; const float cap = fmaxf(T - 3.5f * (float)(qd + (w < rd ? 1 : 0)), 0.f);
                    lo_u = (int)(cum + 0.5f); cum += cap; hi_u = (int)(cum + 0.5f); }
                if (F.vcu == F.G - 1 || hi_u > Nu) hi_u = Nu; if (lo_u > Nu) lo_u = Nu;
                lo_u = __builtin_amdgcn_readfirstlane(lo_u); hi_u = __builtin_amdgcn_readfirstlane(hi_u);
                pg8::MoeRange R; R.init(nM[1], 2 * DFE / 256, lo_u, hi_u, tile_e + MOE_KTILES);
                MOE_UP(1, R);
            PH_END
            PH_BEGIN(19)
                MOE_TABLES
                MOE_DOWN(1);
            PH_END
#undef MOE_UP
#undef MOE_DOWN
#undef MOE_TABLES
        }
    }
struct Args { const float* in[24]; float* out; unsigned char* ws; int ph_lo, ph_hi; };
__global__ void __launch_bounds__(NWAVES * 64, 2) fwd(Args args) {
    extern __shared__ __attribute__((aligned(16))) unsigned char lds[];
    Frame FK;
    FK.lds = (LAS unsigned char*)lds;
    FK.MISC = (volatile LAS unsigned*)(FK.lds + MISC_OFF);
    FK.tid = threadIdx.x; FK.lane = FK.tid & 63; FK.wave = __builtin_amdgcn_readfirstlane(FK.tid >> 6);
    FK.G = gridDim.x; FK.blk = blockIdx.x; { const int bx = blockIdx.x; FK.vcu = (FK.G % 8 == 0) ? (bx % 8) * (FK.G / 8) + bx / 8 : bx; }
    FK.ws = args.ws; FK.ctl = (gu32*)(args.ws + WS_CTL); FK.out = args.out;
    FK.in = args.in; FK.zi = 0;
    for (int u = FK.tid; u < (LDS_BYTES - LDSCTL_OFF) / 4; u += NWAVES * 64) ((LAS unsigned*)(FK.lds + LDSCTL_OFF))[u] = 0u;
    __syncthreads();
    const int lo = args.ph_lo, hi = args.ph_hi;
    XcdBarrier bar; bar.bar = (unsigned*)(FK.ctl + CW_BAR); bar.x = 0; bar.st = nullptr;
    if (hi - lo > 1) bar = xcd_barrier_post((unsigned*)(FK.ctl + CW_BAR), FK.MISC + 8);
    int ph = 0;
    PH_BEGIN(0)
        LAS float* scr = (LAS float*)(F.lds + F.wave * 16384);
        for (int it = gw; it < CI_MAIN; it += NGWV) conv_item_main(F, it, scr);
        pool_fold(F);
        __syncthreads();
        phase_norm_mix<false>(F, INP(F, IN_X), 0);
    PH_END

    layer_phases<0>(FK, ph, lo, hi, bar, lds);
    layer_phases<1>(FK, ph, lo, hi, bar, lds);
    PH_BEGIN(16) phase_norm_final(F, XBP, F.out); PH_END
#undef PH_BEGIN
#undef HB
#undef CAT
#undef SLAB
#undef GATE
#undef WL
#undef XBP
#undef PH_END
}

extern "C" void kernel_launch(void* const* d_in, const int* in_sizes, int n_in, void* d_out, int out_size, void* d_ws, size_t ws_size, hipStream_t stream) {
    static int grid = 0;
    if (grid == 0) {
        if (n_in != 24 || in_sizes[0] != M * D || out_size != M * D || ws_size < WS_END) { fprintf(stderr, "kernel_launch: built for 24 inputs, x/out of %d floats, >= %zu bytes of workspace; got n_in %d, in0 %d, out %d, ws %zu; nothing launched\n", M * D, (size_t)WS_END, n_in, n_in > 0 ? in_sizes[0] : -1, out_size, ws_size); grid = -1; return; }
        int dev = 0, cus = 0, per_cu = 0;
        if (hipGetDevice(&dev) != hipSuccess || hipDeviceGetAttribute(&cus, hipDeviceAttributeMultiprocessorCount, dev) != hipSuccess) { fprintf(stderr, "kernel_launch: hipGetDevice / hipDeviceGetAttribute failed\n"); grid = -1; return; }
        if (hipFuncSetAttribute((const void*)fwd, hipFuncAttributeMaxDynamicSharedMemorySize, LDS_BYTES) != hipSuccess) { fprintf(stderr, "kernel_launch: hipFuncSetAttribute failed\n"); grid = -1; return; }
        if (hipOccupancyMaxActiveBlocksPerMultiprocessor(&per_cu, (const void*)fwd, NWAVES * 64, LDS_BYTES) != hipSuccess || per_cu < 1)
            fprintf(stderr, "kernel_launch: note: the occupancy query reports %d workgroups per CU\n", per_cu);
        (void)hipGetLastError();
        grid = cus;
    }
    if (grid < 0) return;
    if (hipMemsetAsync((char*)d_ws + WS_CTL, 0, CTL_ZERO_BYTES, stream) != hipSuccess) { fprintf(stderr, "kernel_launch: hipMemsetAsync failed\n"); return; }
    Args a{};
    for (int i = 0; i < 24; ++i) a.in[i] = (const float*)d_in[i];
    a.out = (float*)d_out; a.ws = (unsigned char*)d_ws;
#if MK_MULTI
    for (int p = 0; p < NPH; ++p) { a.ph_lo = p; a.ph_hi = p + 1; hipLaunchKernelGGL(fwd, dim3(grid), dim3(NWAVES * 64), LDS_BYTES, stream, a); }
#else
    a.ph_lo = 0; a.ph_hi = NPH; hipLaunchKernelGGL(fwd, dim3(grid), dim3(NWAVES * 64), LDS_BYTES, stream, a);
#endif
    const hipError_t le = hipPeekAtLastError();
    if (le != hipSuccess) fprintf(stderr, "kernel_launch: launch failed: %s\n", hipGetErrorName(le));
}
```

```cpp
#include <hip/hip_runtime.h>
#include <cstdio>
#include <cstdint>
namespace pg8 {
#define PG8_LAS __attribute__((address_space(3)))
typedef unsigned short bf16_t;
typedef short bf16x8 __attribute__((ext_vector_type(8)));
typedef float f32x4 __attribute__((ext_vector_type(4)));
typedef unsigned u32x4 __attribute__((ext_vector_type(4)));
constexpr int BM = 256, BK = 64, HALF = 128, HTB = HALF * BK * 2  , STAGE_BYTES = 8 * HTB, NXCD = 8, WGM = 8;

__host__ __device__ __forceinline__ int lds_byte(int r, int c) { const int st = (r >> 4) * 2 + (c >> 5), rr = r & 15, cc = c & 31, ob = rr * 64 + cc * 2; return st * 1024 + (ob ^ (((ob >> 9) & 1) << 5)); }
__host__ __device__ __forceinline__ void stage_rc(int b, int& R, int& C) { const int st = b / 1024, sb = b % 1024, swz = sb ^ (((sb >> 9) & 1) << 5); R = (st >> 1) * 16 + swz / 64; C = (st & 1) * 32 + (swz % 64) / 2; }
__host__ __device__ __forceinline__ int perm32(int rho) { const int n = rho >> 4, i = rho & 15; return 8 * (i >> 2) + 4 * n + (i & 3); }

struct Unit { int pm, pn, pb; };
struct Gemm { const bf16_t* A; const bf16_t* Bt; int M, N, K; };

struct StaticOrder {
    int nM, nN, nwg, G, c;
    __host__ __device__ void init(int M, int N, int G_, int c_) { nM = M / BM; nN = N / BM; nwg = nM * nN; G = G_; c = c_; }
    __host__ __device__ bool next(int i, Unit& u) const {
        const long L = (long)i * G + c; if (L >= nwg) return false;
        int wgid = (int)L; { const int q = nwg / NXCD, r = nwg % NXCD, xcd = wgid % NXCD, off = wgid / NXCD; wgid = (xcd < r ? xcd * (q + 1) : r * (q + 1) + (xcd - r) * q) + off; }
        const int nig = WGM * nN, gid = wgid / nig, fm = gid * WGM, gsz = (nM - fm) < WGM ? (nM - fm) : WGM;
        u.pm = fm + ((wgid % nig) % gsz); u.pn = (wgid % nig) / gsz; u.pb = u.pn; return true;
    }
    __device__ __forceinline__ void a_ready(const Unit&) const {}
    __device__ __forceinline__ void done(const Unit&) const {}
};

__device__ __forceinline__ unsigned cvt_pk_bf16(float lo, float hi) { unsigned r; asm volatile("v_cvt_pk_bf16_f32 %0, %1, %2" : "=v"(r) : "v"(lo), "v"(hi)); return r; }
__device__ __forceinline__ float sigm(float x) { return __builtin_amdgcn_rcpf(1.f + __builtin_amdgcn_exp2f(-1.4426950408889634f * x)); }
typedef int v4i_t __attribute__((ext_vector_type(4)));
typedef int v8i_t __attribute__((ext_vector_type(8)));
__device__ __forceinline__ v8i_t cat8(bf16x8 a, bf16x8 b) { return __builtin_shufflevector(__builtin_bit_cast(v4i_t, a), __builtin_bit_cast(v4i_t, b), 0, 1, 2, 3, 4, 5, 6, 7); }
__device__ __forceinline__ float clamp8(float x) { return __builtin_amdgcn_fmed3f(x, -448.f, 448.f); }
__device__ __forceinline__ unsigned pack_fp8x4(float a, float b, float c, float d) { int w = 0; w = __builtin_amdgcn_cvt_pk_fp8_f32(clamp8(a), clamp8(b), w, false); w = __builtin_amdgcn_cvt_pk_fp8_f32(clamp8(c), clamp8(d), w, true); return (unsigned)w; }
__device__ __forceinline__ float bf_lo(unsigned w) { return __uint_as_float(w << 16); }
__device__ __forceinline__ float bf_hi(unsigned w) { return __uint_as_float(w & 0xffff0000u); }

struct EpiSlab {
    static constexpr bool PERM = true, AFTER_DRAIN = false, HOOK = false;
    bf16_t* O; size_t slab_stride; int qslab; float qscale;
    __device__ __forceinline__ void operator()(const f32x4 (&acc)[2][2][4][2], const Unit& u, int wr, int wc, int fr, int fq) const {
        const int slab = u.pn >> 1; bf16_t* base = O + (size_t)slab * slab_stride; const float sc = (slab == qslab) ? qscale : 1.f;
        const int row0 = u.pm * BM + wr * 64 + fr, col0 = (u.pn & 1) * 256 + wc * 32 + 8 * fq;
#pragma unroll
        for (int ai = 0; ai < 2; ++ai)
#pragma unroll
            for (int m = 0; m < 4; ++m) { bf16_t* rowp = base + (size_t)(row0 + ai * HALF + m * 16) * 512 + col0;
#pragma unroll
                for (int bj = 0; bj < 2; ++bj) { const f32x4 v0 = acc[ai][bj][m][0] * sc, v1 = acc[ai][bj][m][1] * sc;
                    u32x4 w; w.x = cvt_pk_bf16(v0[0], v0[1]); w.y = cvt_pk_bf16(v0[2], v0[3]); w.z = cvt_pk_bf16(v1[0], v1[1]); w.w = cvt_pk_bf16(v1[2], v1[3]);
                    *(u32x4*)(rowp + bj * HALF) = w; } }
    }
};
__device__ __forceinline__ size_t gate_img(int br, int pm, int pn, int piece, int wave, int lane) { return ((((size_t)(br * 512 + pm * 4 + pn) * 16 + piece) * 8 + wave) * 64 + lane) * 8; }
typedef unsigned u32x2g __attribute__((ext_vector_type(2)));
__device__ __forceinline__ float gate_val(float x, float c) { return __builtin_fmaxf(__builtin_fmaf(__builtin_amdgcn_rcpf(1.f + __builtin_amdgcn_exp2f(x * c)), 256.f, 0.5f), 1.f); }
__device__ __forceinline__ f32x4 ub4(unsigned w) { return (f32x4){(float)(w & 0xffu), (float)((w >> 8) & 0xffu), (float)((w >> 16) & 0xffu), (float)(w >> 24)}; }
struct EpiSig {
    static constexpr bool PERM = true, AFTER_DRAIN = false, HOOK = false;
    unsigned char* O; float in_scale;
    __device__ __forceinline__ void operator()(const f32x4 (&acc)[2][2][4][2], const Unit& u, int wr, int wc, int fr, int fq) const {
        const int br = u.pn >> 2, pn = u.pn & 3, wave = wr * 4 + wc, lane = fq * 16 + fr;
#pragma unroll
        for (int ai = 0; ai < 2; ++ai)
#pragma unroll
            for (int m = 0; m < 4; ++m)
#pragma unroll
                for (int bj = 0; bj < 2; ++bj) { const f32x4 v0 = acc[ai][bj][m][0], v1 = acc[ai][bj][m][1];
                    const float c = -1.4426950408889634f * in_scale; u32x2g w; w.x = 0u; w.y = 0u;
#pragma unroll
                    for (int j = 0; j < 4; ++j) { w.x = __builtin_amdgcn_cvt_pk_u8_f32(gate_val(v0[j], c), j, w.x); w.y = __builtin_amdgcn_cvt_pk_u8_f32(gate_val(v1[j], c), j, w.y); }
                    *(u32x2g*)(O + gate_img(br, u.pm, pn, ai * 8 + m * 2 + bj, wave, lane)) = w; }
    }
};
struct EpiMerge {
    static constexpr bool PERM = true, AFTER_DRAIN = false, HOOK = true;
    const unsigned char* G; bf16_t* O;
    __device__ __forceinline__ void hook(f32x4 (&acc)[2][2][4][2], const Unit& u, int t, int wr, int wc, int fr, int fq) const {
        const int i = (t >> 3) - 1; int lane = fq * 16 + fr; const int wave = wr * 4 + wc;
        asm volatile("" : "+v"(lane));
#pragma unroll
        for (int ai = 0; ai < 2; ++ai) {
            u32x2g ga[4][2], gb[4][2];
#pragma unroll
            for (int m = 0; m < 4; ++m)
#pragma unroll
                for (int bj = 0; bj < 2; ++bj) { ga[m][bj] = *(const u32x2g*)(G + gate_img(i, u.pm, u.pn, ai * 8 + m * 2 + bj, wave, lane)); gb[m][bj] = *(const u32x2g*)(G + gate_img(i + 1, u.pm, u.pn, ai * 8 + m * 2 + bj, wave, lane)); }
            __builtin_amdgcn_sched_barrier(0);
#pragma unroll
            for (int m = 0; m < 4; ++m)
#pragma unroll
                for (int bj = 0; bj < 2; ++bj) { const f32x4 a0 = ub4(ga[m][bj].x), a1 = ub4(ga[m][bj].y), b0 = ub4(gb[m][bj].x), b1 = ub4(gb[m][bj].y);
                    f32x4 r0, r1;
#pragma unroll
                    for (int j = 0; j < 4; ++j) { r0[j] = a0[j] * __builtin_amdgcn_rcpf(b0[j]); r1[j] = a1[j] * __builtin_amdgcn_rcpf(b1[j]); }
                    acc[ai][bj][m][0] *= r0; acc[ai][bj][m][1] *= r1; }
            __builtin_amdgcn_sched_barrier(0);
        }
    }
    __device__ __forceinline__ void operator()(const f32x4 (&acc)[2][2][4][2], const Unit& u, int wr, int wc, int fr, int fq) const {
        const int row0 = u.pm * BM + wr * 64 + fr, col0 = u.pn * BM + wc * 32 + 8 * fq, lane = fq * 16 + fr, wave = wr * 4 + wc;
        u32x2g g[2][4][2];
#pragma unroll
        for (int ai = 0; ai < 2; ++ai)
#pragma unroll
            for (int m = 0; m < 4; ++m)
#pragma unroll
                for (int bj = 0; bj < 2; ++bj) g[ai][m][bj] = *(const u32x2g*)(G + gate_img(2, u.pm, u.pn, ai * 8 + m * 2 + bj, wave, lane));
        __builtin_amdgcn_sched_barrier(0);
#pragma unroll
        for (int ai = 0; ai < 2; ++ai)
#pragma unroll
            for (int m = 0; m < 4; ++m) { const size_t off = (size_t)(row0 + ai * HALF + m * 16) * 1024 + col0;
#pragma unroll
                for (int bj = 0; bj < 2; ++bj) { const f32x4 g0 = ub4(g[ai][m][bj].x) * (1.f / 256.f), g1 = ub4(g[ai][m][bj].y) * (1.f / 256.f); const f32x4 v0 = acc[ai][bj][m][0] * g0, v1 = acc[ai][bj][m][1] * g1;
                    u32x4 w; w.x = cvt_pk_bf16(v0[0], v0[1]); w.y = cvt_pk_bf16(v0[2], v0[3]); w.z = cvt_pk_bf16(v1[0], v1[1]); w.w = cvt_pk_bf16(v1[2], v1[3]);
                    *(u32x4*)(O + off + bj * HALF) = w; } }
    }
};
struct EpiRes {
    static constexpr bool PERM = false, AFTER_DRAIN = false, HOOK = false;
    const float* base; float* out; int ldc; float in_scale = 1.f;
    __device__ __forceinline__ void operator()(const f32x4 (&acc)[2][2][4][2], const Unit& u, int wr, int wc, int fr, int fq) const {
        const int row0 = u.pm * BM + wr * 64 + fr, col0 = u.pn * BM + wc * 32 + 4 * fq;
#pragma unroll
        for (int ai = 0; ai < 2; ++ai) {
            f32x4 bs[4][2][2];
#pragma unroll
            for (int m = 0; m < 4; ++m)
#pragma unroll
                for (int bj = 0; bj < 2; ++bj)
#pragma unroll
                    for (int n = 0; n < 2; ++n) bs[m][bj][n] = *(const f32x4*)(base + (size_t)(row0 + ai * HALF + m * 16) * ldc + col0 + bj * HALF + n * 16);
            __builtin_amdgcn_sched_barrier(0);
#pragma unroll
            for (int m = 0; m < 4; ++m)
#pragma unroll
                for (int bj = 0; bj < 2; ++bj)
#pragma unroll
                    for (int n = 0; n < 2; ++n) *(f32x4*)(out + (size_t)(row0 + ai * HALF + m * 16) * ldc + col0 + bj * HALF + n * 16) = bs[m][bj][n] + acc[ai][bj][m][n] * in_scale;
            __builtin_amdgcn_sched_barrier(0);
        }
    }
};
template <bool BASE_F32> struct EpiResB {
    static constexpr bool PERM = true, AFTER_DRAIN = false, HOOK = false;
    static constexpr int XLD = 2048, XROT = 16;
    const void* base; bf16_t* out; float* ssq_part;
    __device__ __forceinline__ void operator()(const f32x4 (&acc)[2][2][4][2], const Unit& u, int wr, int wc, int fr, int fq) const {
        const int row0 = u.pm * BM + wr * 64 + fr, col0 = u.pn * BM + wc * 32 + 8 * fq;
#pragma unroll
        for (int ai = 0; ai < 2; ++ai) {
            f32x4 b0[4][2], b1[4][2];
            if constexpr (BASE_F32) {
#pragma unroll
                for (int m = 0; m < 4; ++m)
#pragma unroll
                    for (int bj = 0; bj < 2; ++bj) { const float* p = (const float*)base + (size_t)(row0 + ai * HALF + m * 16) * 1024 + col0 + bj * HALF; b0[m][bj] = *(const f32x4*)p; b1[m][bj] = *(const f32x4*)(p + 4); }
            } else {
                u32x4 q[4][2];
#pragma unroll
                for (int m = 0; m < 4; ++m)
#pragma unroll
                    for (int bj = 0; bj < 2; ++bj) q[m][bj] = *(const u32x4*)((const bf16_t*)base + (size_t)(row0 + ai * HALF + m * 16) * XLD + ((row0 + m * 16) & (XROT - 1)) * 64 + col0 + bj * HALF);
                __builtin_amdgcn_sched_barrier(0);
#pragma unroll
                for (int m = 0; m < 4; ++m)
#pragma unroll
                    for (int bj = 0; bj < 2; ++bj) { b0[m][bj] = (f32x4){bf_lo(q[m][bj].x), bf_hi(q[m][bj].x), bf_lo(q[m][bj].y), bf_hi(q[m][bj].y)}; b1[m][bj] = (f32x4){bf_lo(q[m][bj].z), bf_hi(q[m][bj].z), bf_lo(q[m][bj].w), bf_hi(q[m][bj].w)}; }
            }
            __builtin_amdgcn_sched_barrier(0);
#pragma unroll
            for (int m = 0; m < 4; ++m) { float ss = 0.f;
#pragma unroll
                for (int bj = 0; bj < 2; ++bj) { const f32x4 v0 = b0[m][bj] + acc[ai][bj][m][0], v1 = b1[m][bj] + acc[ai][bj][m][1];
                    ss += ((v0[0] * v0[0] + v0[1] * v0[1]) + (v0[2] * v0[2] + v0[3] * v0[3])) + ((v1[0] * v1[0] + v1[1] * v1[1]) + (v1[2] * v1[2] + v1[3] * v1[3]));
                    u32x4 w; w.x = cvt_pk_bf16(v0[0], v0[1]); w.y = cvt_pk_bf16(v0[2], v0[3]); w.z = cvt_pk_bf16(v1[0], v1[1]); w.w = cvt_pk_bf16(v1[2], v1[3]);
                    *(u32x4*)(out + (size_t)(row0 + ai * HALF + m * 16) * XLD + ((row0 + m * 16) & (XROT - 1)) * 64 + col0 + bj * HALF) = w; }
                if (ssq_part) { ss += __shfl_xor(ss, 16); ss += __shfl_xor(ss, 32); if (fq == 0) ssq_part[(size_t)(row0 + ai * HALF + m * 16) * 16 + u.pn * 4 + wc] = ss; } }
            __builtin_amdgcn_sched_barrier(0);
        }
    }
};
struct EpiSwiGLU {
    static constexpr bool PERM = true, AFTER_DRAIN = false, HOOK = false;
    bf16_t* O; int ldc;
    __device__ __forceinline__ void operator()(const f32x4 (&acc)[2][2][4][2], const Unit& u, int wr, int wc, int fr, int fq) const {
        const int row0 = u.pm * BM + wr * 64 + fr, col0 = u.pn * HALF + wc * 32 + 8 * fq;
#pragma unroll
        for (int ai = 0; ai < 2; ++ai)
#pragma unroll
            for (int m = 0; m < 4; ++m) { f32x4 v0, v1;
#pragma unroll
                for (int j = 0; j < 4; ++j) { const float g0 = acc[ai][0][m][0][j], g1 = acc[ai][0][m][1][j]; v0[j] = g0 * sigm(g0) * acc[ai][1][m][0][j]; v1[j] = g1 * sigm(g1) * acc[ai][1][m][1][j]; }
                u32x4 w; w.x = cvt_pk_bf16(v0[0], v0[1]); w.y = cvt_pk_bf16(v0[2], v0[3]); w.z = cvt_pk_bf16(v1[0], v1[1]); w.w = cvt_pk_bf16(v1[2], v1[3]);
                *(u32x4*)(O + (size_t)(row0 + ai * HALF + m * 16) * ldc + col0) = w; }
    }
};
struct EpiSwiGLUR {
    static constexpr bool PERM = true, AFTER_DRAIN = false, HOOK = false;
    bf16_t* O; int ldc; const float* ssq_part; float inv_d, eps;
    __device__ __forceinline__ void operator()(const f32x4 (&acc)[2][2][4][2], const Unit& u, int wr, int wc, int fr, int fq) const {
        const int row0 = u.pm * BM + wr * 64 + fr, col0 = u.pn * HALF + wc * 32 + 8 * fq;
        f32x4 pp[2][4];
#pragma unroll
        for (int ai = 0; ai < 2; ++ai)
#pragma unroll
            for (int m = 0; m < 4; ++m) pp[ai][m] = *(const f32x4*)(ssq_part + (size_t)(row0 + ai * HALF + m * 16) * 16 + 4 * fq);
#pragma unroll
        for (int ai = 0; ai < 2; ++ai)
#pragma unroll
            for (int m = 0; m < 4; ++m) { float s = (pp[ai][m][0] + pp[ai][m][1]) + (pp[ai][m][2] + pp[ai][m][3]); s += __shfl_xor(s, 16); s += __shfl_xor(s, 32);
                const float rs = __builtin_amdgcn_rsqf(s * inv_d + eps); f32x4 v0, v1;
#pragma unroll
                for (int j = 0; j < 4; ++j) { const float g0 = acc[ai][0][m][0][j] * rs, g1 = acc[ai][0][m][1][j] * rs; v0[j] = g0 * sigm(g0) * (acc[ai][1][m][0][j] * rs); v1[j] = g1 * sigm(g1) * (acc[ai][1][m][1][j] * rs); }
                u32x4 w; w.x = cvt_pk_bf16(v0[0], v0[1]); w.y = cvt_pk_bf16(v0[2], v0[3]); w.z = cvt_pk_bf16(v1[0], v1[1]); w.w = cvt_pk_bf16(v1[2], v1[3]);
                *(u32x4*)(O + (size_t)(row0 + ai * HALF + m * 16) * ldc + col0) = w; }
    }
};
struct EpiSwiGLU8 {
    static constexpr bool PERM = true, AFTER_DRAIN = false, HOOK = false;
    unsigned char* O; int ldc; float in_scale, out_scale;
    __device__ __forceinline__ void operator()(const f32x4 (&acc)[2][2][4][2], const Unit& u, int wr, int wc, int fr, int fq) const {
        const int row0 = u.pm * BM + wr * 64 + fr, col0 = u.pn * HALF + wc * 32 + 8 * fq; const float c1 = in_scale * in_scale * out_scale, c2 = -1.4426950408889634f * in_scale;
#pragma unroll
        for (int ai = 0; ai < 2; ++ai)
#pragma unroll
            for (int m = 0; m < 4; ++m) { f32x4 v0, v1;
#pragma unroll
                for (int j = 0; j < 4; ++j) { const float g0 = acc[ai][0][m][0][j], g1 = acc[ai][0][m][1][j];
                    v0[j] = (g0 * acc[ai][1][m][0][j]) * __builtin_amdgcn_rcpf(1.f + __builtin_amdgcn_exp2f(g0 * c2)) * c1; v1[j] = (g1 * acc[ai][1][m][1][j]) * __builtin_amdgcn_rcpf(1.f + __builtin_amdgcn_exp2f(g1 * c2)) * c1; }
                typedef unsigned u32x2_t __attribute__((ext_vector_type(2)));
                u32x2_t w; w.x = pack_fp8x4(v0[0], v0[1], v0[2], v0[3]); w.y = pack_fp8x4(v1[0], v1[1], v1[2], v1[3]);
                *(u32x2_t*)(O + (size_t)(row0 + ai * HALF + m * 16) * ldc + col0) = w; }
    }
};
struct EpiMoeDown {
    static constexpr bool PERM = true, AFTER_DRAIN = false, HOOK = false;
    bf16_t* Y; const int* row_tok; const float* row_g; float in_scale;
    __device__ __forceinline__ void operator()(const f32x4 (&acc)[2][2][4][2], const Unit& u, int wr, int wc, int fr, int fq) const {
        const int row0 = u.pm * BM + wr * 64 + fr, col0 = u.pn * BM + wc * 32 + 8 * fq;
#pragma unroll
        for (int ai = 0; ai < 2; ++ai)
#pragma unroll
            for (int m = 0; m < 4; ++m) { const int r = row0 + ai * HALF + m * 16; const int tok = row_tok[r]; const float g = row_g[r] * in_scale;
                if (tok >= 0) { bf16_t* p = Y + (size_t)tok * 1024 + col0;
#pragma unroll
                    for (int bj = 0; bj < 2; ++bj) { const f32x4 v0 = acc[ai][bj][m][0] * g, v1 = acc[ai][bj][m][1] * g;
                        u32x4 w; w.x = cvt_pk_bf16(v0[0], v0[1]); w.y = cvt_pk_bf16(v0[2], v0[3]); w.z = cvt_pk_bf16(v1[0], v1[1]); w.w = cvt_pk_bf16(v1[2], v1[3]);
                        *(u32x4*)(p + bj * HALF) = w; } } }
    }
};
struct MoeRange {
    int nM, nN, lo, hi; const PG8_LAS int* tile_e;
    __device__ void init(int nM_, int nN_, int lo_, int hi_, const PG8_LAS int* te) { nM = nM_; nN = nN_; lo = lo_; hi = hi_; tile_e = te; }
    __device__ bool next(int i, Unit& u) const {
        const int wgid = lo + i; if (wgid >= hi) return false;
        const int nig = WGM * nN, gid = wgid / nig, fm = gid * WGM, gsz = (nM - fm) < WGM ? (nM - fm) : WGM;
        u.pm = fm + ((wgid % nig) % gsz); u.pn = (wgid % nig) / gsz;
        const int e = __builtin_amdgcn_readfirstlane(tile_e[u.pm]); u.pb = e * nN + u.pn; return true;
    }
    __device__ __forceinline__ void a_ready(const Unit&) const {}
    __device__ __forceinline__ void done(const Unit&) const {}
};
struct MoeOrder {
    int nM, nN, nwg, G, c; const PG8_LAS int* tile_e;
    __device__ void init(int nM_, int nN_, int G_, int c_, const PG8_LAS int* te) { nM = nM_; nN = nN_; nwg = nM * nN; G = G_; c = c_; tile_e = te; }
    __device__ bool next(int i, Unit& u) const {
        const long L = (long)i * G + c; if (L >= nwg) return false;
        int wgid = (int)L; { const int q = nwg / NXCD, r = nwg % NXCD, xcd = wgid % NXCD, off = wgid / NXCD; wgid = (xcd < r ? xcd * (q + 1) : r * (q + 1) + (xcd - r) * q) + off; }
        const int nig = WGM * nN, gid = wgid / nig, fm = gid * WGM, gsz = (nM - fm) < WGM ? (nM - fm) : WGM;
        u.pm = fm + ((wgid % nig) % gsz); u.pn = (wgid % nig) / gsz;
        const int e = __builtin_amdgcn_readfirstlane(tile_e[u.pm]); u.pb = e * nN + u.pn; return true;
    }
    __device__ __forceinline__ void a_ready(const Unit&) const {}
    __device__ __forceinline__ void done(const Unit&) const {}
};
template <class Epi, class Sched, bool ALIGN_EPI = false, bool SP2 = false, bool FP8 = false, int LDA = 0, int ROTA = 0>
__device__ __forceinline__ void gemm_phase(PG8_LAS unsigned char* lds, const Gemm g, const Sched& S, const Epi& E) {
    int tid_ = threadIdx.x; asm volatile("" : "+v"(tid_));
    const int tid = tid_, wid = __builtin_amdgcn_readfirstlane(tid >> 6), lane = tid & 63, wr = wid >> 2, wc = wid & 3, fr = lane & 15, fq = lane >> 4;
    const int K = g.K, nt = K / BK;
    unsigned voffA[2], voffB[2];
#pragma unroll
    for (int i = 0; i < 2; ++i) { int R, C; stage_rc(tid * 16 + i * 8192, R, C); const int Rb = Epi::PERM ? ((R & ~31) + perm32(R & 31)) : R;
        voffA[i] = (unsigned)(R * (LDA ? LDA : K) + C) * 2u + (ROTA ? (unsigned)(R & (ROTA - 1)) * 128u : 0u); voffB[i] = (unsigned)(Rb * K + C) * 2u; }
    const size_t kstep = (size_t)(BK * 2);
    const size_t hstep = (size_t)HALF * K * 2;
    const size_t tstep = 2 * hstep;
    const size_t hstepA = (size_t)HALF * (LDA ? LDA : K) * 2, tstepA = 2 * hstepA;
    const unsigned ldsw = (unsigned)wid * 1024u;
    const int aoff = lds_byte(wr * 64 + fr, fq * 8), boff = lds_byte(wc * 32 + fr, fq * 8);
#define PG8_SA(b, h) (((b) * 2 + (h)) * HTB)
#define PG8_SB(b, h) ((4 + (b) * 2 + (h)) * HTB)
#define PG8_STAGE(bufoff, gbase, voff) do { _Pragma("unroll") for (int _i = 0; _i < 2; ++_i) \
        __builtin_amdgcn_global_load_lds((const unsigned*)((const char*)(gbase) + (voff)[_i]), (PG8_LAS unsigned*)(lds + (bufoff) + ldsw + _i * 8192), 16, 0, 0); } while (0)
#define PG8_LDA(dst, b, h) do { _Pragma("unroll") for (int m = 0; m < 4; ++m) _Pragma("unroll") for (int k = 0; k < 2; ++k) dst[m][k] = *(const PG8_LAS bf16x8*)(lds + PG8_SA(b, h) + aoff + m * 2048 + k * 1024); } while (0)
#define PG8_LDB(dst, b, h) do { _Pragma("unroll") for (int n = 0; n < 2; ++n) _Pragma("unroll") for (int k = 0; k < 2; ++k) dst[n][k] = *(const PG8_LAS bf16x8*)(lds + PG8_SB(b, h) + boff + n * 2048 + k * 1024); } while (0)
#define PG8_MMA(ai, bj, At, Bt) do { __builtin_amdgcn_s_setprio(1); \
        if constexpr (FP8) { _Pragma("unroll") for (int m = 0; m < 4; ++m) _Pragma("unroll") for (int n = 0; n < 2; ++n) \
            asm volatile("v_mfma_f32_16x16x128_f8f6f4 %0, %1, %2, %0" : "+v"(acc[ai][bj][m][n]) : "v"(cat8(Bt[n][0], Bt[n][1])), "v"(cat8(At[m][0], At[m][1]))); } \
        else { _Pragma("unroll") for (int m = 0; m < 4; ++m) _Pragma("unroll") for (int n = 0; n < 2; ++n) _Pragma("unroll") for (int k = 0; k < 2; ++k) \
            acc[ai][bj][m][n] = __builtin_amdgcn_mfma_f32_16x16x32_bf16(Bt[n][k], At[m][k], acc[ai][bj][m][n], 0, 0, 0); } \
        __builtin_amdgcn_s_setprio(0); } while (0)
#define PG8_WAIT_V(n) asm volatile("s_waitcnt vmcnt(" #n ")" ::: "memory")
#define PG8_WAIT_L(n) asm volatile("s_waitcnt lgkmcnt(" #n ")" ::: "memory")
#define PG8_BAR __builtin_amdgcn_s_barrier()
#define PG8_SCHED __builtin_amdgcn_sched_barrier(0)
    Unit cur, nxt; int ui = 0;
    if (!S.next(0, cur)) return;
    f32x4 acc[2][2][4][2];
#pragma unroll
    for (int a = 0; a < 2; ++a)
#pragma unroll
        for (int b = 0; b < 2; ++b)
#pragma unroll
            for (int m = 0; m < 4; ++m)
#pragma unroll
                for (int n = 0; n < 2; ++n) acc[a][b][m][n] = (f32x4){0.f, 0.f, 0.f, 0.f};
    bf16x8 At[4][2], B0[2][2], B1[2][2];
    const char* cA = (const char*)g.A + (size_t)cur.pm * tstepA; const char* cB = (const char*)g.Bt + (size_t)cur.pb * tstep;
    S.a_ready(cur);
    if constexpr (SP2) {
        PG8_STAGE(PG8_SB(0, 0), cB, voffB); PG8_STAGE(PG8_SB(0, 1), cB + hstep, voffB); PG8_STAGE(PG8_SA(0, 0), cA, voffA); PG8_STAGE(PG8_SA(0, 1), cA + hstepA, voffA);
        if (wr == 1) PG8_BAR;
        PG8_WAIT_V(2); PG8_BAR;
        PG8_STAGE(PG8_SB(1, 0), cB + kstep, voffB); PG8_STAGE(PG8_SA(1, 0), cA + kstep, voffA); PG8_STAGE(PG8_SB(1, 1), cB + hstep + kstep, voffB);
        PG8_WAIT_V(6); PG8_BAR;
    } else {
        PG8_STAGE(PG8_SB(0, 0), cB, voffB); PG8_STAGE(PG8_SA(0, 0), cA, voffA); PG8_STAGE(PG8_SB(0, 1), cB + hstep, voffB); PG8_STAGE(PG8_SA(0, 1), cA + hstepA, voffA);
        if (wr == 1) PG8_BAR;
        PG8_WAIT_V(4); PG8_BAR;
        PG8_STAGE(PG8_SB(1, 0), cB + kstep, voffB); PG8_STAGE(PG8_SA(1, 0), cA + kstep, voffA); PG8_STAGE(PG8_SB(1, 1), cB + hstep + kstep, voffB);
        PG8_WAIT_V(6); PG8_BAR;
    }
    for (;;) {
        const bool has_next = S.next(ui + 1, nxt);
        const char* nA = has_next ? (const char*)g.A + (size_t)nxt.pm * tstepA : cA; const char* nB = has_next ? (const char*)g.Bt + (size_t)nxt.pb * tstep : cB;
        for (int t = 0; t < nt; t += 2) {
            if constexpr (Epi::HOOK) { if (t == 8 || t == 16) E.hook(acc, cur, t, wr, wc, fr, fq); }
            const bool last = (t == nt - 2);
            const char* a1 = cA + (size_t)(t + 1) * kstep;
            const char* a2 = last ? nA : cA + (size_t)(t + 2) * kstep; const char* b2 = last ? nB : cB + (size_t)(t + 2) * kstep;
            const char* a3 = a2 + kstep; const char* b3 = b2 + kstep;
            if (last && has_next) S.a_ready(nxt);
            if constexpr (SP2) {
            PG8_LDB(B0, 0, 0); PG8_LDB(B1, 0, 1); PG8_SCHED; PG8_LDA(At, 0, 0); PG8_STAGE(PG8_SA(1, 1), a1 + hstepA, voffA);
            PG8_WAIT_V(8); PG8_WAIT_L(0); PG8_BAR; PG8_MMA(0, 0, At, B0); PG8_MMA(0, 1, At, B1); PG8_BAR; PG8_SCHED;
            PG8_LDA(At, 0, 1); PG8_STAGE(PG8_SB(0, 0), b2, voffB); PG8_STAGE(PG8_SB(0, 1), b2 + hstep, voffB); PG8_STAGE(PG8_SA(0, 0), a2, voffA);
            PG8_WAIT_V(8); PG8_WAIT_L(0); PG8_BAR; PG8_MMA(1, 0, At, B0); PG8_MMA(1, 1, At, B1); PG8_BAR; PG8_SCHED;
            PG8_LDB(B0, 1, 0); PG8_LDB(B1, 1, 1); PG8_SCHED; PG8_LDA(At, 1, 0); PG8_STAGE(PG8_SA(0, 1), a2 + hstepA, voffA);
            PG8_WAIT_V(8); PG8_WAIT_L(0); PG8_BAR; PG8_MMA(0, 0, At, B0); PG8_MMA(0, 1, At, B1); PG8_BAR; PG8_SCHED;
            PG8_LDA(At, 1, 1); PG8_STAGE(PG8_SB(1, 0), b3, voffB); PG8_STAGE(PG8_SB(1, 1), b3 + hstep, voffB); PG8_STAGE(PG8_SA(1, 0), a3, voffA);
            PG8_WAIT_V(8); PG8_WAIT_L(0); PG8_BAR; PG8_MMA(1, 0, At, B0); PG8_MMA(1, 1, At, B1); PG8_BAR; PG8_SCHED;
            } else {
            PG8_LDB(B0, 0, 0); PG8_SCHED; PG8_LDA(At, 0, 0); PG8_STAGE(PG8_SA(1, 1), a1 + hstepA, voffA);
            PG8_WAIT_L(8); PG8_BAR; PG8_WAIT_L(0); PG8_MMA(0, 0, At, B0); PG8_BAR; PG8_SCHED;
            PG8_LDB(B1, 0, 1); PG8_STAGE(PG8_SB(0, 0), b2, voffB);
            PG8_BAR; PG8_WAIT_L(0); PG8_MMA(0, 1, At, B1); PG8_BAR;
            PG8_LDA(At, 0, 1); PG8_STAGE(PG8_SA(0, 0), a2, voffA);
            PG8_BAR; PG8_WAIT_L(0); PG8_MMA(1, 0, At, B0); PG8_BAR; PG8_SCHED;
            PG8_STAGE(PG8_SB(0, 1), b2 + hstep, voffB);
            PG8_WAIT_V(6); PG8_BAR; PG8_MMA(1, 1, At, B1); PG8_BAR;
            PG8_LDB(B0, 1, 0); PG8_SCHED; PG8_LDA(At, 1, 0); PG8_STAGE(PG8_SA(0, 1), a2 + hstepA, voffA);
            PG8_WAIT_L(8); PG8_BAR; PG8_WAIT_L(0); PG8_MMA(0, 0, At, B0); PG8_BAR; PG8_SCHED;
            PG8_LDB(B1, 1, 1); PG8_STAGE(PG8_SB(1, 0), b3, voffB);
            PG8_BAR; PG8_WAIT_L(0); PG8_MMA(0, 1, At, B1); PG8_BAR;
            PG8_LDA(At, 1, 1); PG8_STAGE(PG8_SA(1, 0), a3, voffA);
            PG8_BAR; PG8_WAIT_L(0); PG8_MMA(1, 0, At, B0); PG8_BAR; PG8_SCHED;
            PG8_STAGE(PG8_SB(1, 1), b3 + hstep, voffB);
            PG8_WAIT_V(6); PG8_BAR; PG8_MMA(1, 1, At, B1); PG8_BAR;
            }
        }
        if constexpr (ALIGN_EPI) { if (wr == 0) PG8_BAR; }
        if constexpr (FP8) {
            asm volatile("s_nop 15\n\ts_nop 15" : "+v"(acc[0][0][0][0]), "+v"(acc[0][0][0][1]), "+v"(acc[0][0][1][0]), "+v"(acc[0][0][1][1]), "+v"(acc[0][0][2][0]), "+v"(acc[0][0][2][1]), "+v"(acc[0][0][3][0]), "+v"(acc[0][0][3][1]));
            asm volatile("" : "+v"(acc[0][1][0][0]), "+v"(acc[0][1][0][1]), "+v"(acc[0][1][1][0]), "+v"(acc[0][1][1][1]), "+v"(acc[0][1][2][0]), "+v"(acc[0][1][2][1]), "+v"(acc[0][1][3][0]), "+v"(acc[0][1][3][1]));
            asm volatile("" : "+v"(acc[1][0][0][0]), "+v"(acc[1][0][0][1]), "+v"(acc[1][0][1][0]), "+v"(acc[1][0][1][1]), "+v"(acc[1][0][2][0]), "+v"(acc[1][0][2][1]), "+v"(acc[1][0][3][0]), "+v"(acc[1][0][3][1]));
            asm volatile("" : "+v"(acc[1][1][0][0]), "+v"(acc[1][1][0][1]), "+v"(acc[1][1][1][0]), "+v"(acc[1][1][1][1]), "+v"(acc[1][1][2][0]), "+v"(acc[1][1][2][1]), "+v"(acc[1][1][3][0]), "+v"(acc[1][1][3][1])); }
        if constexpr (!Epi::AFTER_DRAIN) { E(acc, cur, wr, wc, fr, fq); S.done(cur); }
        if (!has_next) break;
#pragma unroll
        for (int a = 0; a < 2; ++a)
#pragma unroll
            for (int b = 0; b < 2; ++b)
#pragma unroll
                for (int m = 0; m < 4; ++m)
#pragma unroll
                    for (int n = 0; n < 2; ++n) acc[a][b][m][n] = (f32x4){0.f, 0.f, 0.f, 0.f};
        cur = nxt; cA = nA; cB = nB; ++ui;
        if constexpr (ALIGN_EPI) { if (wr == 1) PG8_BAR; }
    }
    PG8_WAIT_V(0);
    if constexpr (!ALIGN_EPI) { if (wr == 0) PG8_BAR; }
    PG8_BAR;
    if constexpr (Epi::AFTER_DRAIN) { E.fused(acc, cur, wr, wc, fr, fq, lds, wid, lane); S.done(cur); }
#undef PG8_SA
#undef PG8_SB
#undef PG8_STAGE
#undef PG8_LDA
#undef PG8_LDB
#undef PG8_MMA
#undef PG8_WAIT_V
#undef PG8_WAIT_L
#undef PG8_BAR
#undef PG8_SCHED
}
}
#include <hip/hip_bf16.h>
#include <cmath>
namespace attn_body {
using bf16=__hip_bfloat16;
using bf16x8=__attribute__((ext_vector_type(8)))short;
using s16x4=__attribute__((ext_vector_type(4)))short;
using f32x16=__attribute__((ext_vector_type(16)))float;
using u32x4=__attribute__((ext_vector_type(4)))unsigned;
constexpr int BATCH=4,NHEAD=8,SEQ=8192,D=64,DM=NHEAD*D,DMO=1536,OCOL=1024;
constexpr int NW=8,QBLK=32,QB=QBLK*NW,KVBLK=64,NQB=SEQ/QB;
constexpr int ATTN_PITCH=DM, ATTN_UNIT_ROWS=QB;
__device__ __forceinline__ int crow(int r,int hi){return (r&3)+8*(r>>2)+4*hi;}
#define SBAR() __builtin_amdgcn_sched_barrier(0)
__device__ __forceinline__ void cmask(f32x16&p0,f32x16&p1,int jb,int qrel,int hi){
  const float NEG=-INFINITY; int kb=64*jb+4*hi;
  #pragma unroll
  for(int r=0;r<16;++r){int kv=kb+(r&3)+8*(r>>2); if(kv>qrel)p0[r]=NEG; if(kv+32>qrel)p1[r]=NEG;}
}

constexpr int NSLOT=3, SLOTB=8192;
constexpr int LDS_K=0, LDS_V=NSLOT*SLOTB, LDS_WS=2*NSLOT*SLOTB, LDS_OST=LDS_WS+NW*64*4, LDS_NB=LDS_OST+NW*4096, LDS_BYTES=LDS_NB+SEQ*4;
constexpr float C2=0.125f*1.4426950408889634f;
__device__ __forceinline__ void glds16(const void*gsrc,unsigned lds_dst){unsigned keep;
  asm volatile("s_mov_b32 %0, m0\n\ts_mov_b32 m0, %2\n\ts_nop 0\n\tglobal_load_lds_dwordx4 %1, off\n\ts_mov_b32 m0, %0":"=&s"(keep):"v"(gsrc),"s"(lds_dst):"memory");}
__device__ __forceinline__ float max3f(float a,float b,float c){float r;asm("v_max3_f32 %0, %1, %2, %3":"=v"(r):"v"(a),"v"(b),"v"(c));return r;}
__device__ __forceinline__ float max2f(float a,float b){float r;asm("v_max_f32_e32 %0, %1, %2":"=v"(r):"v"(a),"v"(b));return r;}
__device__ __forceinline__ float fadd_s(float a,float b){float r;asm("v_add_f32_e32 %0, %1, %2":"=v"(r):"v"(a),"v"(b));return r;}
__device__ __forceinline__ float fsub_s(float a,float b){float r;asm("v_sub_f32_e32 %0, %1, %2":"=v"(r):"v"(a),"v"(b));return r;}
typedef float f32x2_t __attribute__((ext_vector_type(2))); typedef __bf16 bf16x2_t __attribute__((ext_vector_type(2)));
__device__ __forceinline__ unsigned cvtpk_s(float lo,float hi){f32x2_t v={lo,hi};bf16x2_t b=__builtin_convertvector(v,bf16x2_t);return __builtin_bit_cast(unsigned,b);}
#define WAIT_BAR(N) asm volatile("s_waitcnt vmcnt(" #N ") lgkmcnt(0)\n\ts_barrier":::"memory")

__device__ __forceinline__ void qkt(f32x16&p0,f32x16&p1,const char*Kslot,const bf16x8*qr,int r32,int hi){
  const char*kb=Kslot+hi*1024+r32*16;
  #pragma unroll
  for(int d0=0;d0<4;++d0){
    const bf16x8 b0=*reinterpret_cast<const bf16x8*>(kb+d0*2048);
    const bf16x8 b1=*reinterpret_cast<const bf16x8*>(kb+d0*2048+512);
    p0=__builtin_amdgcn_mfma_f32_32x32x16_bf16(b0,qr[d0],p0,0,0,0);p1=__builtin_amdgcn_mfma_f32_32x32x16_bf16(b1,qr[d0],p1,0,0,0);}
}
typedef __attribute__((address_space(3))) const char* lds_cptr;
typedef short v4i16_t __attribute__((ext_vector_type(4)));
__device__ __forceinline__ void kload8(bf16x8*kf,lds_cptr kp){
  kf[0]=*(const __attribute__((address_space(3))) bf16x8*)(kp);      kf[1]=*(const __attribute__((address_space(3))) bf16x8*)(kp+512);
  kf[2]=*(const __attribute__((address_space(3))) bf16x8*)(kp+2048); kf[3]=*(const __attribute__((address_space(3))) bf16x8*)(kp+2560);
  kf[4]=*(const __attribute__((address_space(3))) bf16x8*)(kp+4096); kf[5]=*(const __attribute__((address_space(3))) bf16x8*)(kp+4608);
  kf[6]=*(const __attribute__((address_space(3))) bf16x8*)(kp+6144); kf[7]=*(const __attribute__((address_space(3))) bf16x8*)(kp+6656);
}
__device__ __forceinline__ void kload2(bf16x8*kf,lds_cptr kp,int j){ kf[2*j]=*(const __attribute__((address_space(3))) bf16x8*)(kp+j*2048); kf[2*j+1]=*(const __attribute__((address_space(3))) bf16x8*)(kp+j*2048+512); }
__device__ __forceinline__ s16x4 vtr(lds_cptr p){ return __builtin_bit_cast(s16x4,__builtin_amdgcn_ds_read_tr16_b64_v4i16((__attribute__((address_space(3))) v4i16_t*)p)); }
__device__ __forceinline__ float rowmax(const f32x16&p0,const f32x16&p1){
  float a=max3f(p0[0],p0[1],p1[0]),b=max3f(p0[2],p0[3],p1[1]);a=max3f(a,p1[2],p1[3]);
  #pragma unroll
  for(int r=4;r<16;r+=4){a=max3f(a,p0[r],p0[r+1]);b=max3f(b,p0[r+2],p0[r+3]);a=max3f(a,p1[r],p1[r+1]);b=max3f(b,p1[r+2],p1[r+3]);}
  const float m=max2f(a,b);
  auto rr=__builtin_amdgcn_permlane32_swap(__float_as_uint(m),__float_as_uint(m),false,false);
  return max2f(__uint_as_float(rr[0]),__uint_as_float(rr[1]));
}
__device__ __forceinline__ void pv(f32x16*o,int vb,bf16x8 pa0,bf16x8 pa1,bf16x8 pa2,bf16x8 pa3){
  #pragma unroll
  for(int d0=0;d0<2;++d0){s16x4 lo[4],hi[4];
    #pragma unroll
    for(int ks=0;ks<4;++ks){
      asm volatile("ds_read_b64_tr_b16 %0,%1 offset:%c2":"=&v"(lo[ks]):"v"(vb),"i"(d0*4096+ks*1024):"memory");
      asm volatile("ds_read_b64_tr_b16 %0,%1 offset:%c2":"=&v"(hi[ks]):"v"(vb),"i"(d0*4096+ks*1024+512):"memory");}
    asm volatile("s_waitcnt lgkmcnt(0)":::"memory");SBAR();
    #define PK(k) (bf16x8){lo[k][0],lo[k][1],lo[k][2],lo[k][3],hi[k][0],hi[k][1],hi[k][2],hi[k][3]}
    o[d0]=__builtin_amdgcn_mfma_f32_32x32x16_bf16(pa0,PK(0),o[d0],0,0,0);
    o[d0]=__builtin_amdgcn_mfma_f32_32x32x16_bf16(pa1,PK(1),o[d0],0,0,0);
    o[d0]=__builtin_amdgcn_mfma_f32_32x32x16_bf16(pa2,PK(2),o[d0],0,0,0);
    o[d0]=__builtin_amdgcn_mfma_f32_32x32x16_bf16(pa3,PK(3),o[d0],0,0,0);
    #undef PK
  }
}

#ifndef ATTN_STORE16
#define ATTN_STORE16(p,v) (*(u32x4*)(p)=(v))
#endif
typedef float f32x4v __attribute__((ext_vector_type(4)));
__device__ __forceinline__ int attn_t0(int qb,const float*__restrict__ nbg,const float*__restrict__ qnw,const float*__restrict__ knw,const float*__restrict__ xmw,int lane){
  const int q0=qb*QB; float qn=0.f,kn=0.f,xm=3.0e38f; if(lane<8){qn=qnw[qb*8+lane];xm=xmw[qb*8+lane];}
  _Pragma("unroll") for(int i=0;i<4;++i){const int idx=lane*4+i; if(idx<(qb+1)*8)kn=__builtin_fmaxf(kn,knw[idx]);}
  _Pragma("unroll") for(int o_=1;o_<64;o_<<=1){qn=__builtin_fmaxf(qn,__shfl_xor(qn,o_));kn=__builtin_fmaxf(kn,__shfl_xor(kn,o_));xm=__builtin_fminf(xm,__shfl_xor(xm,o_));}
  const float thr=56.f+sqrtf(qn*kn)-xm; const int NT0=(q0+QB)/KVBLK;
  bool c_=(lane>=1)&&(2*lane<=NT0-4); float d_=0.f; if(c_)d_=nbg[128*lane-1]-nbg[q0]; c_=c_&&(d_<=-thr);
  return __builtin_amdgcn_readfirstlane(2*(int)__popcll(__ballot(c_)));
}
template<int THRL> __device__ __forceinline__ void attn_unit(int b,int h,int qb,const bf16*Q,const bf16*__restrict__ K,const bf16*__restrict__ V,bf16*O,const float*__restrict__ nbg,const int t0,char*shm){
  int tid_=threadIdx.x; asm volatile("":"+v"(tid_));
  const int tid=tid_,lane=tid&63,r32=lane&31,hi=lane>>5; const int wid=__builtin_amdgcn_readfirstlane(tid>>6);
  const long rowbase=(long)b*SEQ; const int q0=qb*QB;
  const bf16*Qw=Q+(rowbase+q0+wid*QBLK)*DM+h*D;
  const bf16*Kh=K+(rowbase+(long)t0*KVBLK)*DM+h*D,*Vh=V+(rowbase+(long)t0*KVBLK)*DM+h*D;
  const unsigned lds0=(unsigned)(uintptr_t)shm;
  float*wsf=(float*)(shm+LDS_WS)+wid*64;
  const bf16*ksrc=Kh+(long)lane*DM+wid*8;
  const bf16*vsrc=Vh+(long)(16*(wid&3)+(lane>>2))*DM+(wid>>2)*32+(lane&3)*8;
  const unsigned kdst=lds0+LDS_K+wid*1024, vdst=lds0+LDS_V+wid*1024;
  #define DMA_K(t,slot) glds16(ksrc+(long)(t)*KVBLK*DM,(unsigned)__builtin_amdgcn_readfirstlane(kdst+(slot)))
  #define DMA_V(t,slot) glds16(vsrc+(long)(t)*KVBLK*DM,(unsigned)__builtin_amdgcn_readfirstlane(vdst+(slot)))
  const int vb0=(int)(lds0+LDS_V)+((lane>>4)&1)*32+(lane&3)*8+(4*hi+((lane&15)>>2))*64;
  const char*Kbase=shm+LDS_K; bf16x8 kf[8];
  const lds_cptr shm3=(lds_cptr)shm; const lds_cptr kp0=shm3+LDS_K+hi*1024+r32*16; const lds_cptr vp0=shm3+LDS_V+((lane>>4)&1)*32+(lane&3)*8+(4*hi+((lane&15)>>2))*64;
  const int NT=(q0+QB)/KVBLK-t0;
  typedef __attribute__((address_space(3))) float* lds_fptr;
  const lds_fptr nbl3=(lds_fptr)(shm3+LDS_NB);
  const lds_fptr nbl3o=nbl3+t0*KVBLK;
  DMA_K(0,0);DMA_V(0,0);DMA_K(1,SLOTB);
  { const float ref=nbg[q0+QB-1]; for(int j=t0*KVBLK+tid;j<q0+QB;j+=NW*64) nbl3[j]=nbg[j]-ref; }
  bf16x8 qr[4];
  #pragma unroll
  for(int d0=0;d0<4;++d0)qr[d0]=*reinterpret_cast<const bf16x8*>(&Qw[(long)r32*DM+d0*16+hi*8]);
  float mhat=0.f,l_reg=0.f;f32x16 o[2];o[0]=f32x16{};o[1]=f32x16{};
  const int qrel=wid*QBLK+r32;
  #define CMASK(P0,P1,t) do{int jb_=(t)-(NT-4); if(jb_>=0)cmask(P0,P1,jb_,qrel,hi);}while(0)
  bool resc=false;
  #define START(P0,P1) do{ const float rm=rowmax(P0,P1); resc=false; \
    if(__any(rm>(float)THRL)){ const float dl=__builtin_fmaxf(rm,0.f); mhat=fadd_s(mhat,dl); \
      _Pragma("unroll") for(int r=0;r<16;++r){P0[r]=fsub_s(P0[r],dl);P1[r]=fsub_s(P1[r],dl);} } \
    _Pragma("unroll") for(int r=0;r<16;++r)P0[r]=__builtin_amdgcn_exp2f(P0[r]); }while(0)
  #define BIAS(P0,P1,t) do{ const lds_fptr nbp_=nbl3o+64*(t)+4*hi; \
    _Pragma("unroll") for(int q_=0;q_<4;++q_){ const f32x4v b0_=*(const __attribute__((address_space(3))) f32x4v*)(nbp_+8*q_), b1_=*(const __attribute__((address_space(3))) f32x4v*)(nbp_+32+8*q_); \
      _Pragma("unroll") for(int i_=0;i_<4;++i_){ P0[4*q_+i_]=b0_[i_]-mhat; P1[4*q_+i_]=b1_[i_]-mhat; } } }while(0)
  #define RESC() do{ if(resc){ asm volatile("s_waitcnt lgkmcnt(0)":::"memory"); \
      _Pragma("unroll") for(int d_=0;d_<2;++d_) _Pragma("unroll") for(int r=0;r<16;++r)o[d_][r]*=wsf[crow(r,hi)]; } }while(0)
  f32x16 pA0,pA1,pB0,pB1;
  int sl_prev=0,sl_cur=0,sl_next=SLOTB;
  #define ROT() do{sl_prev=sl_cur;sl_cur=sl_next;sl_next=(sl_next==(NSLOT-1)*SLOTB)?0:sl_next+SLOTB;}while(0)
  DMA_K(2,2*SLOTB);
  WAIT_BAR(3);
  mhat=nbl3[q0+qrel];
  BIAS(pA0,pA1,0);qkt(pA0,pA1,Kbase,qr,r32,hi);asm volatile("s_nop 15\n\ts_nop 7":"+v"(pA0),"+v"(pA1));CMASK(pA0,pA1,0);
  START(pA0,pA1);
  _Pragma("unroll") for(int r=0;r<16;++r)pA1[r]=__builtin_amdgcn_exp2f(pA1[r]);
  WAIT_BAR(0);
  DMA_K(3,0);DMA_V(1,SLOTB);
  ROT();
  kload8(kf,kp0+sl_cur);
  WAIT_BAR(2);
  s16x4 vlo[8],vhi[8]; u32x4 pw0,pw1,pw2,pw3;
  #define PKW(P,B) cvtpk_s(P[B],P[B+1])
  #define PAF(k) __builtin_bit_cast(bf16x8,pw##k)
  #define VFR(i) (bf16x8){vlo[i][0],vlo[i][1],vlo[i][2],vlo[i][3],vhi[i][0],vhi[i][1],vhi[i][2],vhi[i][3]}
  #define PIN(x) asm volatile("":"+v"(x))
  #define MX3(a,b,c) __builtin_fmaxf(__builtin_fmaxf((a),(b)),(c))
  #define GAPA(MF,A0,A1,A2,A3,W0,W1,PW) do{ MF; sacc+=A0; sacc+=A1; sacc+=A2; sacc+=A3; PIN(sacc); W0; W1; PIN(PW); SBAR(); }while(0)
  #define EX(v) __builtin_amdgcn_exp2f(v)
  #define GAPB(MF,X,B) do{ MF; X[B]=EX(X[B]); X[B+1]=EX(X[B+1]); X[B+2]=EX(X[B+2]); X[B+3]=EX(X[B+3]); PIN(X); SBAR(); }while(0)
  #define VRD(i) do{ vlo[i]=vtr(vp_+(((i)>>2)*4096+((i)&3)*1024)); vhi[i]=vtr(vp_+(((i)>>2)*4096+((i)&3)*1024+512)); }while(0)
  #define KRD(G,j) do{ if(G){ kload2(kf,kp0+sl_next,j); SBAR(); } }while(0)
  #define STEP(C0,C1,P0,P1,t,GK,GV,GL) do{ SBAR(); \
    const lds_cptr vp_=vp0+sl_prev; \
    BIAS(C0,C1,t); SBAR(); \
    VRD(0); SBAR(); float sacc=(P0[0]+P0[1]); \
    GAPA(C0=__builtin_amdgcn_mfma_f32_32x32x16_bf16(kf[0],qr[0],C0,0,0,0), P0[2],P0[3],P0[4],P0[5],     pw0[0]=PKW(P0,0), pw0[1]=PKW(P0,2), pw0); \
    VRD(4); SBAR(); GAPA(C1=__builtin_amdgcn_mfma_f32_32x32x16_bf16(kf[1],qr[0],C1,0,0,0), P0[6],P0[7],P0[8],P0[9],     pw0[2]=PKW(P0,4), pw0[3]=PKW(P0,6), pw0); \
    VRD(1); SBAR(); GAPA(C0=__builtin_amdgcn_mfma_f32_32x32x16_bf16(kf[2],qr[1],C0,0,0,0),   P0[10],P0[11],P0[12],P0[13], pw1[0]=PKW(P0,8), pw1[1]=PKW(P0,10), pw1); \
    VRD(5); SBAR(); GAPA(C1=__builtin_amdgcn_mfma_f32_32x32x16_bf16(kf[3],qr[1],C1,0,0,0),   P0[14],P0[15],P1[0],P1[1],   pw1[2]=PKW(P0,12),pw1[3]=PKW(P0,14), pw1); \
    VRD(2); SBAR(); GAPA(C0=__builtin_amdgcn_mfma_f32_32x32x16_bf16(kf[4],qr[2],C0,0,0,0),   P1[2],P1[3],P1[4],P1[5],     pw2[0]=PKW(P1,0), pw2[1]=PKW(P1,2), pw2); \
    VRD(6); SBAR(); GAPA(C1=__builtin_amdgcn_mfma_f32_32x32x16_bf16(kf[5],qr[2],C1,0,0,0),   P1[6],P1[7],P1[8],P1[9],     pw2[2]=PKW(P1,4), pw2[3]=PKW(P1,6), pw2); \
    VRD(3); SBAR(); GAPA(C0=__builtin_amdgcn_mfma_f32_32x32x16_bf16(kf[6],qr[3],C0,0,0,0),   P1[10],P1[11],P1[12],P1[13], pw3[0]=PKW(P1,8), pw3[1]=PKW(P1,10), pw3); \
    VRD(7); SBAR(); GAPA(C1=__builtin_amdgcn_mfma_f32_32x32x16_bf16(kf[7],qr[3],C1,0,0,0),   P1[14],P1[15],0.f,0.f,       pw3[2]=PKW(P1,12),pw3[3]=PKW(P1,14), pw3); \
    l_reg+=sacc; \
    if(GK){DMA_K((t)+3,sl_cur);} if(GV){DMA_V((t)+1,sl_next);} \
    CMASK(C0,C1,t); \
    { float a=MX3(C0[0],C0[1],C1[0]),b=MX3(C0[2],C0[3],C1[1]); a=MX3(a,C1[2],C1[3]); \
      _Pragma("unroll") for(int r=4;r<16;r+=4){a=MX3(a,C0[r],C0[r+1]);b=MX3(b,C0[r+2],C0[r+3]);a=MX3(a,C1[r],C1[r+1]);b=MX3(b,C1[r+2],C1[r+3]);} \
      float rm=__builtin_fmaxf(a,b); { auto rr=__builtin_amdgcn_permlane32_swap(__float_as_uint(rm),__float_as_uint(rm),false,false); rm=__builtin_fmaxf(__uint_as_float(rr[0]),__uint_as_float(rr[1])); } \
      resc=false; \
      if(__builtin_expect(__any(rm>(float)THRL),0)){ const float dl=__builtin_fmaxf(rm,0.f); mhat+=dl; \
        _Pragma("unroll") for(int r=0;r<16;++r){C0[r]-=dl;C1[r]-=dl;} \
        const float f=__builtin_amdgcn_exp2f(-dl); l_reg*=f; if(hi==0)wsf[r32]=f; resc=true; } } \
    SBAR(); \
    GAPB(o[0]=__builtin_amdgcn_mfma_f32_32x32x16_bf16(PAF(0),VFR(0),o[0],0,0,0), C0,0); \
    GAPB(o[1]=__builtin_amdgcn_mfma_f32_32x32x16_bf16(PAF(0),VFR(4),o[1],0,0,0), C0,4); \
    KRD(GL,0); GAPB(o[0]=__builtin_amdgcn_mfma_f32_32x32x16_bf16(PAF(1),VFR(1),o[0],0,0,0), C0,8); \
    KRD(GL,1); GAPB(o[1]=__builtin_amdgcn_mfma_f32_32x32x16_bf16(PAF(1),VFR(5),o[1],0,0,0), C0,12); \
    KRD(GL,2); GAPB(o[0]=__builtin_amdgcn_mfma_f32_32x32x16_bf16(PAF(2),VFR(2),o[0],0,0,0), C1,0); \
    KRD(GL,3); GAPB(o[1]=__builtin_amdgcn_mfma_f32_32x32x16_bf16(PAF(2),VFR(6),o[1],0,0,0), C1,4); \
    GAPB(o[0]=__builtin_amdgcn_mfma_f32_32x32x16_bf16(PAF(3),VFR(3),o[0],0,0,0), C1,8); \
    GAPB(o[1]=__builtin_amdgcn_mfma_f32_32x32x16_bf16(PAF(3),VFR(7),o[1],0,0,0), C1,12); \
    }while(0)
  int t=1;
  #undef CMASK
  #define CMASK(P0,P1,t) do{}while(0)
  for(;t+5<NT;t+=2){
    STEP(pB0,pB1,pA0,pA1,t,true,true,true);     WAIT_BAR(2); RESC(); ROT();
    STEP(pA0,pA1,pB0,pB1,t+1,true,true,true);   WAIT_BAR(2); RESC(); ROT();
  }
  #undef CMASK
  #define CMASK(P0,P1,t) do{int jb_=(t)-(NT-4); if(jb_>=0)cmask(P0,P1,jb_,qrel,hi);}while(0)
  #define ENDW(tt) do{ if((tt)+3<NT){WAIT_BAR(2);} else if((tt)+2<NT){WAIT_BAR(1);} else {WAIT_BAR(0);} }while(0)
  for(;t+1<NT;t+=2){
    STEP(pB0,pB1,pA0,pA1,t,(t+3<NT),(t+1<NT),(t+1<NT));       ENDW(t);   RESC(); ROT();
    STEP(pA0,pA1,pB0,pB1,t+1,(t+4<NT),(t+2<NT),(t+2<NT));     ENDW(t+1); RESC(); ROT();
  }
  STEP(pB0,pB1,pA0,pA1,NT-1,false,false,false); RESC();
  { float sacc=pB0[0]+pB0[1]; _Pragma("unroll") for(int r=2;r<16;++r)sacc+=pB0[r]; _Pragma("unroll") for(int r=0;r<16;++r)sacc+=pB1[r]; l_reg+=sacc;
    pw0=(u32x4){PKW(pB0,0),PKW(pB0,2),PKW(pB0,4),PKW(pB0,6)};pw1=(u32x4){PKW(pB0,8),PKW(pB0,10),PKW(pB0,12),PKW(pB0,14)};pw2=(u32x4){PKW(pB1,0),PKW(pB1,2),PKW(pB1,4),PKW(pB1,6)};pw3=(u32x4){PKW(pB1,8),PKW(pB1,10),PKW(pB1,12),PKW(pB1,14)};
    SBAR(); pv(o,vb0+sl_cur,PAF(0),PAF(1),PAF(2),PAF(3)); }
  #undef PKW
  #undef PAF
  #undef VFR
  #undef PIN
  #undef MX3
  #undef GAPA
  #undef GAPB
  #undef EX
  #undef VRD
  #undef KRD
  #undef STEP
  #undef ENDW
  {auto rr=__builtin_amdgcn_permlane32_swap(__float_as_uint(l_reg),__float_as_uint(l_reg),false,false);l_reg=__uint_as_float(rr[0])+__uint_as_float(rr[1]);}
  if(hi==0)wsf[32+r32]=l_reg;asm volatile("s_waitcnt lgkmcnt(0)":::"memory");
  float rli[16];
  #pragma unroll
  for(int r=0;r<16;++r)rli[r]=__builtin_amdgcn_rcpf(wsf[32+crow(r,hi)]);
  bf16*Ow=O+(rowbase+q0+wid*QBLK)*DMO+OCOL+h*D;
  { bf16*stg=(bf16*)(shm+LDS_OST)+wid*2048;
    #pragma unroll
    for(int r=0;r<16;++r){const int orow=crow(r,hi);
      #pragma unroll
      for(int d0=0;d0<2;++d0)stg[orow*64+d0*32+r32]=__float2bfloat16(o[d0][r]*rli[r]);}
    asm volatile("s_waitcnt lgkmcnt(0)":::"memory");
    #pragma unroll
    for(int i=0;i<4;++i){const int row=i*8+(lane>>3),ch=lane&7; const u32x4 v=*(const u32x4*)(stg+row*64+ch*8); ATTN_STORE16(Ow+(long)row*DMO+ch*8,v);} }
  asm volatile("s_waitcnt lgkmcnt(0)\n\ts_barrier":::"memory");
  #undef DMA_K
  #undef DMA_V
  #undef CMASK
  #undef START
  #undef BIAS
  #undef RESC
  #undef ROT
}
constexpr int ATTN_LDS_BYTES=LDS_BYTES;
struct AttnTensors { const bf16* Q; const bf16* K; const bf16* V; bf16* O; const float* nb; const float* qn; const float* kn; const int* t0tab; };
struct AttnUnit { int bh; int qb; };
struct StaticOrder {
  int vcu,G;
  __device__ __forceinline__ explicit StaticOrder(int grid,int block):vcu((grid%8==0)?(block%8)*(grid/8)+block/8:block),G(grid){}
  __device__ __forceinline__ bool next(int i,AttnUnit&u)const{ const int w=vcu+(i>>2)*G; if(w>=BATCH*NHEAD*8)return false; const int s=w&7,j=i&3; u.bh=((w>>3)+9*j)&31; u.qb=(j==0)?s:(j==1)?15-s:(j==2)?16+s:31-s; return true; }
  __device__ __forceinline__ void a_ready(const AttnUnit&)const{}
  __device__ __forceinline__ void done(const AttnUnit&)const{}
};
template<int THRL=8> __device__ __forceinline__ void attn_phase_dyn(char*lds,const AttnTensors&T,unsigned*ctr,volatile __attribute__((address_space(3))) unsigned*slot){
  const int tid=threadIdx.x,lane=tid&63;
  int ord=0;
  { const float myv=(lane<32)?T.nb[(long)lane*SEQ+SEQ-1]:3.0e38f; int rank=0;
    _Pragma("unroll") for(int j=0;j<32;++j){const float vj=__shfl(myv,j); rank+=(vj<myv||(vj==myv&&j<lane))?1:0;}
    _Pragma("unroll") for(int j=0;j<32;++j){const int rj=__shfl(rank,j); if(rj==lane)ord=j;} }
  if(tid==0){ const unsigned id=__hip_atomic_fetch_add(ctr,1u,__ATOMIC_RELAXED,__HIP_MEMORY_SCOPE_AGENT); *slot=id; }
  asm volatile("s_waitcnt vmcnt(0) lgkmcnt(0)\n\ts_barrier":::"memory");
  for(;;){
    const unsigned uid=*slot;
    if(uid>=(unsigned)(BATCH*NHEAD*NQB))break;
    unsigned nxt=0u; if(tid==0)nxt=__hip_atomic_fetch_add(ctr,1u,__ATOMIC_RELAXED,__HIP_MEMORY_SCOPE_AGENT);
    const int bh=__builtin_amdgcn_readfirstlane(__shfl(ord,(int)(uid>>5))), qb=NQB-1-(int)(uid&31u);
    const int t0=__builtin_amdgcn_readfirstlane(T.t0tab[bh*NQB+qb]);
    attn_unit<THRL>(bh/NHEAD,bh%NHEAD,qb,T.Q,T.K,T.V,T.O,T.nb+(long)bh*SEQ,t0,lds);
    if(tid==0)*slot=nxt;
    asm volatile("s_waitcnt vmcnt(0) lgkmcnt(0)\n\ts_barrier":::"memory");
  }
}
#undef SBAR
#undef WAIT_BAR
}
#define GAS __attribute__((address_space(1)))
#define LAS __attribute__((address_space(3)))
typedef unsigned short bf16;
typedef unsigned v4u __attribute__((ext_vector_type(4)));
typedef float f32x4 __attribute__((ext_vector_type(4)));
typedef short bf16x8 __attribute__((ext_vector_type(8)));
typedef GAS unsigned gu32;
typedef GAS unsigned long long gu64;
#define RLX_AGENT __ATOMIC_RELAXED, __HIP_MEMORY_SCOPE_AGENT
#define LDS_WAIT() asm volatile("s_waitcnt lgkmcnt(0)" ::: "memory")
#define VM_WAIT() asm volatile("s_waitcnt vmcnt(0)" ::: "memory")
__device__ __forceinline__ unsigned long long rt() { return __builtin_amdgcn_s_memrealtime(); }
typedef float f32x2_pk __attribute__((ext_vector_type(2))); typedef __bf16 bf16x2_pk __attribute__((ext_vector_type(2)));
__device__ __forceinline__ unsigned pk2(float lo, float hi) { f32x2_pk v = {lo, hi}; bf16x2_pk r = __builtin_convertvector(v, bf16x2_pk); return __builtin_bit_cast(unsigned, r); }
__device__ __forceinline__ unsigned f2bf(float f) { return pk2(f, 0.f) & 0xffffu; }

#define XB_TMO      128
#define XB_XCNT(j)  (256  + 64 * (j))
#define XB_XSUB(j)  (1280 + 64 * (j))
#define XB_XGEN(j)  (2304 + 64 * (j))
#define XB_TOP      3328
#define XB_TOPGEN   3392
#define XCD_BAR_WORDS 3456
#define XB_SPIN_CAP (1u << 18)

__device__ __forceinline__ unsigned xb_ld(unsigned* p)              { return __hip_atomic_load(p, __ATOMIC_RELAXED, __HIP_MEMORY_SCOPE_AGENT); }
__device__ __forceinline__ unsigned xb_add(unsigned* p, unsigned v) { return __hip_atomic_fetch_add(p, v, __ATOMIC_RELAXED, __HIP_MEMORY_SCOPE_AGENT); }
__device__ __forceinline__ unsigned xb_xcc_id() { return (unsigned)__builtin_amdgcn_s_getreg((3 << 11) | 20) & 0xFu; }
#define XB_SPIN(cond, bar) do { unsigned _sp = 0; while (cond) { __builtin_amdgcn_s_sleep(1); \
    if ((++_sp & 255u) == 0u) { if (xb_ld(&(bar)[XB_TMO])) break; if (_sp > XB_SPIN_CAP) { atomicAdd(&(bar)[XB_TMO], 1u); break; } } } } while (0)

struct XcdBarrier {
    unsigned* bar; unsigned x;
    volatile LAS unsigned* st;
};

__device__ __forceinline__ XcdBarrier xcd_barrier_post(unsigned* bar, volatile LAS unsigned* st) {
    XcdBarrier b; b.bar = bar; b.x = xb_xcc_id(); b.st = st;
    if (threadIdx.x == 0) (void)xb_add(&bar[XB_XCNT(b.x)], 1u);
    return b;
}
__device__ __forceinline__ void xcd_barrier_complete(unsigned* bar, unsigned x, unsigned& nloc, unsigned& nx) {
    const unsigned G = gridDim.x * gridDim.y * gridDim.z;
    unsigned sum, cnt, mine, sp = 0u;
    for (;;) {
        sum = 0u; cnt = 0u; mine = 0u;
#pragma unroll
        for (unsigned j = 0; j < 16; ++j) { const unsigned c = xb_ld(&bar[XB_XCNT(j)]); sum += c; cnt += (c > 0u) ? 1u : 0u; mine = (j == x) ? c : mine; }
        if (sum == G) break;
        __builtin_amdgcn_s_sleep(1);
        if ((++sp & 255u) == 0u) { if (xb_ld(&bar[XB_TMO])) break; if (sp > XB_SPIN_CAP) { atomicAdd(&bar[XB_TMO], 1u); break; } }
    }
    nloc = mine > 0u ? mine : 1u; nx = cnt > 0u ? cnt : 1u;
}

__device__ __forceinline__ void xcd_barrier(const XcdBarrier& b) {
    asm volatile("s_waitcnt vmcnt(0)" ::: "memory");
    __syncthreads();
    if (threadIdx.x == 0) {
        unsigned* bar = b.bar;
        __builtin_amdgcn_s_waitcnt(0);
        unsigned nloc = b.st[0], nx = b.st[1];
        if (nloc == 0u) { xcd_barrier_complete(bar, b.x, nloc, nx); b.st[0] = nloc; b.st[1] = nx; }
        const unsigned old = xb_add(&bar[XB_XSUB(b.x)], 1u);
        const unsigned gen = old / nloc;
        if (old + 1u == (gen + 1u) * nloc) {
            __builtin_amdgcn_fence(__ATOMIC_RELEASE, "agent");
            asm volatile("s_waitcnt vmcnt(0)" ::: "memory");
            const unsigned og = xb_add(&bar[XB_TOP], 1u);
            const unsigned tg = og / nx;
            if (og + 1u == (tg + 1u) * nx) xb_add(&bar[XB_TOPGEN], 1u);
            else XB_SPIN(xb_ld(&bar[XB_TOPGEN]) == tg, bar);
            __builtin_amdgcn_fence(__ATOMIC_ACQUIRE, "agent");
            xb_add(&bar[XB_XGEN(b.x)], 1u);
            asm volatile("s_waitcnt vmcnt(0)" ::: "memory");
        } else {
            XB_SPIN(xb_ld(&bar[XB_XGEN(b.x)]) == gen, bar);
            __builtin_amdgcn_fence(__ATOMIC_ACQUIRE, "agent");
            asm volatile("s_waitcnt vmcnt(0)" ::: "memory");
        }
    }
    __syncthreads();
}

constexpr int NWAVES = 8;
constexpr int BATCH = 4, SEQ = 8192, D = 1024, M = BATCH * SEQ;
constexpr int IN_W = 7184, NGW = 4096, NGT = 3072, NSLAB = 8;
constexpr int SL_POOL = 0, SL_MQ = 1, SL_MK = 2, SL_MV = 3, SL_MO = 4, SL_FQ = 5, SL_FK = 6, SL_FV = 7;
constexpr int ML_H = 4, ML_DH = 128, CHUNK = 64, NCH = SEQ / CHUNK;
constexpr int FX_H = 8;
constexpr int DFF = 2816, NEXP = 8, DFE = 3584;
constexpr float NORM_EPS = 1e-6f;
constexpr int XLD = 2 * D;
constexpr int XROT = 16;
constexpr int KCAT = 1536;
constexpr int MOE_KROWS = 34816;
constexpr int MOE_KTILES = MOE_KROWS / 256;
constexpr int TOKBLK = 128, NTOKBLK = M / TOKBLK;

constexpr size_t MiB = 1u << 20;
constexpr size_t WS_CTL = 0, CTL_ZERO_BYTES = 1 * MiB;
constexpr size_t WS_W = 1 * MiB;
constexpr size_t W_LAYER = 19 * MiB, W_NG = 0, W_GT = 8 * MiB, W_CAT = 14 * MiB, W_OUT = 17 * MiB;
constexpr size_t WS_WGU = WS_W + 2 * W_LAYER, WS_WDN = WS_WGU + 11 * MiB;
constexpr size_t WS_NG = 56 * MiB, SLAB_BYTES = (size_t)M * 512 * 2;
constexpr size_t WS_GATE = WS_NG + SLAB_BYTES;
constexpr size_t WS_ACT0 = WS_NG;
constexpr size_t WS_HB = 312 * MiB;
constexpr size_t WS_CAT = 376 * MiB;
constexpr size_t WS_MLC = 472 * MiB;
constexpr size_t WS_MOEGU = 1 * MiB;
constexpr size_t WS_MOEDN = 57 * MiB;
constexpr size_t WS_XS = 85 * MiB;
constexpr size_t WS_Y0 = 153 * MiB, WS_Y1 = 217 * MiB;
constexpr size_t WS_ACT1 = 305 * MiB;
constexpr size_t WS_SM = 544 * MiB;
constexpr size_t SM_GATE16 = 0;
constexpr size_t SM_MLB = 2 * MiB, SM_MLA = SM_MLB + 512 * 1024, SM_MLMX = SM_MLA + 512 * 1024;
constexpr size_t SM_FNB = SM_MLMX + 512 * 1024;
constexpr size_t SM_MLN = SM_FNB + 1 * MiB;
constexpr size_t SM_MLM = SM_MLN + 1 * MiB;
constexpr size_t SM_MLDEC = SM_MLM + 16 * 132 * 4;
constexpr size_t SM_FQN = SM_MLDEC + 16 * 128 * 4, SM_FKN = SM_FQN + 32768, SM_FT0 = SM_FKN + 32768, SM_MLBG = SM_FT0 + 4096, SM_FXM = SM_MLBG + 16384;
constexpr size_t SM_MOE = 6 * MiB;
constexpr size_t MO_RSTD = 0, MO_TOKE = MO_RSTD + (size_t)M * 4, MO_TOKG = MO_TOKE + (size_t)M * 8, MO_HIST = MO_TOKG + (size_t)M * 8,
                 MO_ROWTOK = MO_HIST + (size_t)NTOKBLK * 16 * 4, MO_ROWG = MO_ROWTOK + (size_t)2 * MOE_KROWS * 4, MO_TILEE = MO_ROWG + (size_t)2 * MOE_KROWS * 4, MO_NT = MO_TILEE + 2 * MOE_KTILES * 4, MO_END = MO_NT + 64;
static_assert(SM_MOE + MO_END <= 8 * MiB, "small arrays");
constexpr size_t WS_END = 552 * MiB;
static_assert(WS_WDN + (size_t)DFF * D * 2 <= WS_NG && WS_NG + NSLAB * SLAB_BYTES <= WS_HB && WS_HB + (size_t)M * D * 2 <= WS_CAT && WS_CAT + (size_t)M * KCAT * 2 <= WS_MLC && WS_MLC + 64 * MiB <= WS_SM, "d_ws map");
static_assert(WS_MOEGU + (size_t)NEXP * 2 * DFE * D <= WS_MOEDN && WS_MOEDN + (size_t)NEXP * D * DFE <= WS_XS && WS_XS + (size_t)2 * MOE_KROWS * D <= WS_Y0 && WS_Y0 + (size_t)M * D * 2 <= WS_Y1 && WS_Y1 + (size_t)M * D * 2 <= WS_ACT1 && WS_ACT1 + (size_t)2 * MOE_KROWS * DFE <= WS_SM, "d_ws map (MoE)");
constexpr int CW_TMO = 0, CW_CODE = 1, CW_BAR = 4096;

constexpr int RING_OFF = 0, RING_BYTES = 131072;
constexpr int LDSCTL_OFF = RING_BYTES, MISC_OFF = LDSCTL_OFF + 320;
constexpr int LDS_BYTES = 147456;
static_assert(MISC_OFF + 128 <= LDS_BYTES, "LDS map");

struct Frame {
    LAS unsigned char* lds;
    volatile LAS unsigned* MISC;
    gu32* ctl;
    int tid, lane, wave;
    int vcu, G, blk;
    unsigned char* ws;
    const float* const* in; float* out; int zi;
};
#define INP(F, i) ((F).in[(i) + (F).zi])
enum { IN_X = 0, IN_MIXG, IN_WIN, IN_POOLW, IN_POOLS, IN_CONVW, IN_MLBI, IN_MLBF, IN_MLNG, IN_FXBF, IN_WBRP, IN_WBRM, IN_WBRF, IN_WOUT, IN_FFNG, IN_FFG, IN_FFU, IN_FFD, IN_RW, IN_RB, IN_MOEG, IN_MOEU, IN_MOED, IN_FING };

__device__ __forceinline__ float wave_sum(float v) {
#pragma unroll
    for (int o = 1; o < 64; o <<= 1) v += __shfl_xor(v, o);
    return v;
}
__device__ __forceinline__ float wave_max(float v) {
#pragma unroll
    for (int o = 1; o < 64; o <<= 1) v = fmaxf(v, __shfl_xor(v, o));
    return v;
}
__device__ __forceinline__ float sigmoid_f(float x) { return __builtin_amdgcn_rcpf(1.f + __builtin_amdgcn_exp2f(-1.4426950408889634f * x)); }
__device__ __forceinline__ float logsigmoid_f(float x) { return fminf(x, 0.f) - log1pf(expf(-fabsf(x))); }

__device__ __forceinline__ void tr_item(const float* W, int ldw, int srccol0, const float* gain, bf16* WT, int ldt, int drow0, int dcol0, int k0, LAS float* scr, int lane) {
    (void)scr;
    const int ng = lane & 7, kg = lane >> 3;
    f32x4 v[8];
#pragma unroll
    for (int i = 0; i < 8; ++i) v[i] = *(const GAS f32x4*)(W + (size_t)(k0 + 8 * kg + i) * ldw + srccol0 + 4 * ng);
    if (gain) { const f32x4 g0 = *(const GAS f32x4*)(gain + k0 + 8 * kg), g1 = *(const GAS f32x4*)(gain + k0 + 8 * kg + 4);
#pragma unroll
        for (int i = 0; i < 4; ++i) { v[i] = v[i] * g0[i]; v[4 + i] = v[4 + i] * g1[i]; } }
#pragma unroll
    for (int j = 0; j < 4; ++j) { v4u o; o.x = pk2(v[0][j], v[1][j]); o.y = pk2(v[2][j], v[3][j]); o.z = pk2(v[4][j], v[5][j]); o.w = pk2(v[6][j], v[7][j]);
        *(GAS v4u*)(WT + (size_t)(drow0 + 4 * ng + j) * ldt + dcol0 + k0 + 8 * kg) = o; }
}
__device__ __forceinline__ void tr_item_fp8(const float* W, int ldw, int srccol0, const float* gain, float scale, unsigned char* WT8, int ldt, int drow0, int k0, int lane) {
    const int ng = lane & 7, kg = lane >> 3;
    f32x4 v[8];
#pragma unroll
    for (int i = 0; i < 8; ++i) v[i] = *(const GAS f32x4*)(W + (size_t)(k0 + 8 * kg + i) * ldw + srccol0 + 4 * ng);
    f32x4 g0 = (f32x4){scale, scale, scale, scale}, g1 = g0;
    if (gain) { g0 = *(const GAS f32x4*)(gain + k0 + 8 * kg) * scale; g1 = *(const GAS f32x4*)(gain + k0 + 8 * kg + 4) * scale; }
#pragma unroll
    for (int i = 0; i < 4; ++i) { v[i] = v[i] * g0[i]; v[4 + i] = v[4 + i] * g1[i]; }
    typedef unsigned u32x2_t __attribute__((ext_vector_type(2)));
#pragma unroll
    for (int j = 0; j < 4; ++j) { u32x2_t o; o.x = pg8::pack_fp8x4(v[0][j], v[1][j], v[2][j], v[3][j]); o.y = pg8::pack_fp8x4(v[4][j], v[5][j], v[6][j], v[7][j]);
        *(GAS u32x2_t*)(WT8 + (size_t)(drow0 + 4 * ng + j) * ldt + k0 + 8 * kg) = o; }
}
constexpr float FP8_ASCALE = 16.f, FP8_WSCALE = 256.f;
constexpr int CI_NG = 2048, CI_GT = 1536, CI_BR = 256, CI_OUT = 512, CI_LAYER = CI_NG + CI_GT + 2 * CI_BR + CI_OUT, CI_GU = 2816, CI_DN = 1408, CI_MAIN = 2 * CI_LAYER + CI_GU + CI_DN;
__device__ __forceinline__ void conv_item_main(Frame& F, int it, LAS float* scr) {
    if (it < 2 * CI_LAYER) {
        const int l = it / CI_LAYER; int r = it % CI_LAYER; bf16* wl = (bf16*)(F.ws + WS_W + (size_t)l * W_LAYER);
        const float* g = INP(F, IN_MIXG) + l * D; const float* win = INP(F, IN_WIN) + (size_t)l * D * IN_W;
        if (r < CI_NG) { const int nb = r >> 4, kb = r & 15; tr_item(win, IN_W, nb * 32 + (nb * 32 >= 2560 ? 8 : 0), g, wl + W_NG / 2, D, nb * 32, 0, kb * 64, scr, F.lane); return; } r -= CI_NG;
        if (r < CI_GT) { const int nb = r >> 4, kb = r & 15; tr_item_fp8(win, IN_W, 4112 + nb * 32, g, FP8_WSCALE, (unsigned char*)wl + W_GT, D, nb * 32, kb * 64, F.lane); return; } r -= CI_GT;
        if (r < CI_BR) { const int nb = r >> 3, kb = r & 7; tr_item(INP(F, IN_WBRM) + (size_t)l * 512 * D, D, nb * 32, nullptr, wl + W_CAT / 2, KCAT, nb * 32, 512, kb * 64, scr, F.lane); return; } r -= CI_BR;
        if (r < CI_BR) { const int nb = r >> 3, kb = r & 7; tr_item(INP(F, IN_WBRF) + (size_t)l * 512 * D, D, nb * 32, nullptr, wl + W_CAT / 2, KCAT, nb * 32, 1024, kb * 64, scr, F.lane); return; } r -= CI_BR;
        { const int nb = r >> 4, kb = r & 15; tr_item(INP(F, IN_WOUT) + (size_t)l * D * D, D, nb * 32, nullptr, wl + W_OUT / 2, D, nb * 32, 0, kb * 64, scr, F.lane); }
        return;
    }
    it -= 2 * CI_LAYER;
    if (it < CI_GU) { const int nb = it >> 4, kb = it & 15, p = nb >> 3, w = nb & 7;
        tr_item(w < 4 ? INP(F, IN_FFG) : INP(F, IN_FFU), DFF, 128 * p + (w & 3) * 32, INP(F, IN_FFNG), (bf16*)(F.ws + WS_WGU), D, nb * 32, 0, kb * 64, scr, F.lane); return; }
    it -= CI_GU;
    { const int kb = it >> 5, nb = it & 31; tr_item(INP(F, IN_FFD), D, nb * 32, nullptr, (bf16*)(F.ws + WS_WDN), DFF, nb * 32, 0, kb * 64, scr, F.lane); }
}
constexpr int CI_MGU = 3584, CI_MDN = 1792, CI_MEXP = CI_MGU + CI_MDN, CI_MOE = NEXP * CI_MEXP;
__device__ __forceinline__ void conv_item_moe(Frame& F, int it, LAS float* scr) {
    (void)scr;
    const int e = it / CI_MEXP; int r = it % CI_MEXP;
    if (r < CI_MGU) { const int nb = r % 224, kb = r / 224, p = nb >> 3, w = nb & 7;
        tr_item_fp8((w < 4 ? INP(F, IN_MOEG) : INP(F, IN_MOEU)) + (size_t)e * D * DFE, DFE, 128 * p + (w & 3) * 32, INP(F, IN_FFNG) + D, FP8_WSCALE, F.ws + WS_MOEGU + (size_t)e * 2 * DFE * D, D, nb * 32, kb * 64, F.lane); return; }
    r -= CI_MGU;
    { const int kb = r >> 5, nb = r & 31; tr_item_fp8(INP(F, IN_MOED) + (size_t)e * DFE * D, D, nb * 32, nullptr, FP8_WSCALE, F.ws + WS_MOEDN + (size_t)e * D * DFE, DFE, nb * 32, kb * 64, F.lane); }
}
__device__ __forceinline__ void pool_fold(Frame& F) {
    const int gt = F.blk * (NWAVES * 64) + F.tid, NT = F.G * NWAVES * 64;
    for (int o = gt; o < 2 * 4 * 16 * D; o += NT) {
        const int n = o & (D - 1), cb = __builtin_amdgcn_readfirstlane(o >> 10), l = cb >> 6, g = (cb >> 4) & 3, c0 = (cb & 15) * 8;
        const float* wg = INP(F, IN_POOLW) + (size_t)l * 4 * 128 * 128 + (size_t)(g * 128 + c0) * 128; const float* sc = INP(F, IN_POOLS) + l * 512 + g * 128; const float* wb = INP(F, IN_WBRP) + (size_t)l * 512 * D + (size_t)(g * 128) * D + n;
        float a[8];
#pragma unroll
        for (int i = 0; i < 8; ++i) a[i] = 0.f;
#pragma unroll 8
        for (int dd = 0; dd < 128; ++dd) { const float t = sc[dd] * wb[(size_t)dd * D];
#pragma unroll
            for (int i = 0; i < 8; ++i) a[i] += wg[i * 128 + dd] * t; }
        v4u w; w.x = pk2(a[0], a[1]); w.y = pk2(a[2], a[3]); w.z = pk2(a[4], a[5]); w.w = pk2(a[6], a[7]);
        *(GAS v4u*)((bf16*)(F.ws + WS_W + (size_t)l * W_LAYER + W_CAT) + (size_t)n * KCAT + g * 128 + c0) = w;
    }
}

template <bool XB, int LD = D, int ROT = 0> __device__ __forceinline__ void load_xrow(const void* x, size_t m, int lane, f32x4 (&v)[4]) {
    if constexpr (XB) { typedef unsigned u32x2_t __attribute__((ext_vector_type(2))); const GAS u32x2_t* xr = (const GAS u32x2_t*)((const bf16*)x + m * LD + (ROT ? (m & (ROT - 1)) * 64 : 0)) + lane;
#pragma unroll
        for (int j = 0; j < 4; ++j) { const u32x2_t q = xr[64 * j]; v[j] = (f32x4){__uint_as_float(q.x << 16), __uint_as_float(q.x & 0xffff0000u), __uint_as_float(q.y << 16), __uint_as_float(q.y & 0xffff0000u)}; } }
    else { const GAS f32x4* xr = (const GAS f32x4*)((const float*)x + m * D) + lane;
#pragma unroll
        for (int j = 0; j < 4; ++j) v[j] = xr[64 * j]; }
}
template <bool XB> __device__ __forceinline__ void phase_norm_mix(Frame& F, const void* x, int l) {
    LAS float* w16 = (LAS float*)(F.lds);
    const float* g = INP(F, IN_MIXG) + l * D; const float* win = INP(F, IN_WIN) + (size_t)l * D * IN_W;
    for (int idx = F.tid; idx < 16 * D; idx += NWAVES * 64) { const int k = idx >> 4, j = idx & 15, col = j < 8 ? 2560 + j : 4104 + (j - 8); w16[j * D + k] = g[k] * win[(size_t)k * IN_W + col]; }
    __syncthreads();
    bf16* HB = (bf16*)(F.ws + WS_HB); float* gate16 = (float*)(F.ws + WS_SM + SM_GATE16);
    const int gw = F.vcu * NWAVES + F.wave, NGWV = F.G * NWAVES;
    f32x4 nv[4]; if (gw < M) load_xrow<XB, XB ? XLD : D, XB ? XROT : 0>(x, (size_t)gw, F.lane, nv);
    for (int m = gw; m < M; m += NGWV) {
        f32x4 v[4]; float ss = 0.f;
#pragma unroll
        for (int j = 0; j < 4; ++j) v[j] = nv[j];
        if (m + NGWV < M) load_xrow<XB, XB ? XLD : D, XB ? XROT : 0>(x, (size_t)(m + NGWV), F.lane, nv);
#pragma unroll
        for (int j = 0; j < 4; ++j) ss += (v[j].x * v[j].x + v[j].y * v[j].y) + (v[j].z * v[j].z + v[j].w * v[j].w);
        const float rstd = 1.f / sqrtf(wave_sum(ss) * (1.f / D) + NORM_EPS);
        GAS unsigned long long* o8 = (GAS unsigned long long*)(HB + (size_t)m * D) + F.lane;
#pragma unroll
        for (int j = 0; j < 4; ++j) o8[64 * j] = (unsigned long long)pk2(v[j].x * rstd, v[j].y * rstd) | ((unsigned long long)pk2(v[j].z * rstd, v[j].w * rstd) << 32);
        float pp[16];
#pragma unroll
        for (int jj = 0; jj < 16; ++jj) { float p = 0.f;
#pragma unroll
            for (int j = 0; j < 4; ++j) { const f32x4 wv = *(const LAS f32x4*)(w16 + jj * D + 256 * j + 4 * F.lane); p += (v[j].x * wv.x + v[j].y * wv.y) + (v[j].z * wv.z + v[j].w * wv.w); }
            pp[jj] = p; if ((jj & 3) == 3) asm volatile("" ::: "memory"); }
#define TB_STAGE(ST, N) { const bool up = (F.lane >> (ST)) & 1; _Pragma("unroll") for (int i = 0; i < (N); ++i) { const float mine = up ? pp[2 * i + 1] : pp[2 * i], give = up ? pp[2 * i] : pp[2 * i + 1]; pp[i] = mine + __shfl_xor(give, 1 << (ST)); } }
        TB_STAGE(0, 8) TB_STAGE(1, 4) TB_STAGE(2, 2) TB_STAGE(3, 1)
        float keep = pp[0]; keep += __shfl_xor(keep, 16); keep += __shfl_xor(keep, 32); keep *= rstd;
        if (F.lane < 16) gate16[(size_t)m * 16 + F.lane] = keep;
    }
    __syncthreads();
}
__device__ __forceinline__ void phase_norm_ffn(Frame& F, const bf16* x) {
    bf16* HB = (bf16*)(F.ws + WS_HB);
    const int gw = F.vcu * NWAVES + F.wave, NGWV = F.G * NWAVES;
    f32x4 nv[4]; if (gw < M) load_xrow<true, XLD, XROT>(x, (size_t)gw, F.lane, nv);
    for (int m = gw; m < M; m += NGWV) {
        f32x4 v[4]; float ss = 0.f;
#pragma unroll
        for (int j = 0; j < 4; ++j) v[j] = nv[j];
        if (m + NGWV < M) load_xrow<true, XLD, XROT>(x, (size_t)(m + NGWV), F.lane, nv);
#pragma unroll
        for (int j = 0; j < 4; ++j) ss += (v[j].x * v[j].x + v[j].y * v[j].y) + (v[j].z * v[j].z + v[j].w * v[j].w);
        const float rstd = 1.f / sqrtf(wave_sum(ss) * (1.f / D) + NORM_EPS);
        GAS unsigned long long* o8 = (GAS unsigned long long*)(HB + (size_t)m * D) + F.lane;
#pragma unroll
        for (int j = 0; j < 4; ++j) o8[64 * j] = (unsigned long long)pk2(v[j].x * rstd, v[j].y * rstd) | ((unsigned long long)pk2(v[j].z * rstd, v[j].w * rstd) << 32);
    }
}
__device__ __forceinline__ void quant_rows_fp8(Frame& F, const bf16* src, unsigned char* dst) {
    const int gw = F.vcu * NWAVES + F.wave, NGWV = F.G * NWAVES;
    for (int m = gw; m < M; m += NGWV) {
        const v4u a = *((const GAS v4u*)(src + (size_t)m * D) + F.lane), b = *((const GAS v4u*)(src + (size_t)m * D) + 64 + F.lane);
        typedef unsigned u32x2_t __attribute__((ext_vector_type(2)));
        u32x2_t o0, o1; const float s = FP8_ASCALE;
        o0.x = pg8::pack_fp8x4(__uint_as_float(a.x << 16) * s, __uint_as_float(a.x & 0xffff0000u) * s, __uint_as_float(a.y << 16) * s, __uint_as_float(a.y & 0xffff0000u) * s);
        o0.y = pg8::pack_fp8x4(__uint_as_float(a.z << 16) * s, __uint_as_float(a.z & 0xffff0000u) * s, __uint_as_float(a.w << 16) * s, __uint_as_float(a.w & 0xffff0000u) * s);
        o1.x = pg8::pack_fp8x4(__uint_as_float(b.x << 16) * s, __uint_as_float(b.x & 0xffff0000u) * s, __uint_as_float(b.y << 16) * s, __uint_as_float(b.y & 0xffff0000u) * s);
        o1.y = pg8::pack_fp8x4(__uint_as_float(b.z << 16) * s, __uint_as_float(b.z & 0xffff0000u) * s, __uint_as_float(b.w << 16) * s, __uint_as_float(b.w & 0xffff0000u) * s);
        *((GAS u32x2_t*)(dst + (size_t)m * D) + F.lane) = o0; *((GAS u32x2_t*)(dst + (size_t)m * D) + 64 + F.lane) = o1;
    }
}
__device__ __forceinline__ void phase_norm_final(Frame& F, const bf16* xb, float* out) {
    const GAS f32x4* gp = (const GAS f32x4*)INP(F, IN_FING) + F.lane; f32x4 gv[4];
#pragma unroll
    for (int j = 0; j < 4; ++j) gv[j] = gp[64 * j];
    const bf16* Y0 = (const bf16*)(F.ws + WS_Y0); const bf16* Y1 = (const bf16*)(F.ws + WS_Y1);
    const int gw = F.vcu * NWAVES + F.wave, NGWV = F.G * NWAVES;
    f32x4 nv[4], na[4], nb_[4]; if (gw < M) { load_xrow<true, XLD, XROT>(xb, (size_t)gw, F.lane, nv); load_xrow<true>(Y0, (size_t)gw, F.lane, na); load_xrow<true>(Y1, (size_t)gw, F.lane, nb_); }
    for (int m = gw; m < M; m += NGWV) {
        f32x4 v[4]; float ss = 0.f;
#pragma unroll
        for (int j = 0; j < 4; ++j) v[j] = nv[j] + (na[j] + nb_[j]);
        if (m + NGWV < M) { load_xrow<true, XLD, XROT>(xb, (size_t)(m + NGWV), F.lane, nv); load_xrow<true>(Y0, (size_t)(m + NGWV), F.lane, na); load_xrow<true>(Y1, (size_t)(m + NGWV), F.lane, nb_); }
#pragma unroll
        for (int j = 0; j < 4; ++j) ss += (v[j].x * v[j].x + v[j].y * v[j].y) + (v[j].z * v[j].z + v[j].w * v[j].w);
        const float rstd = 1.f / sqrtf(wave_sum(ss) * (1.f / D) + NORM_EPS);
        GAS f32x4* o = (GAS f32x4*)(out + (size_t)m * D) + F.lane;
#pragma unroll
        for (int j = 0; j < 4; ++j) o[64 * j] = v[j] * rstd * gv[j];
    }
}

__device__ __forceinline__ void phase_route1(Frame& F, const bf16* x) {
    LAS float* w8 = (LAS float*)(F.lds);
    LAS int* hist = (LAS int*)(F.lds + 32768);
    const float* g = INP(F, IN_FFNG) + D; const float* rw = INP(F, IN_RW);
    for (int idx = F.tid; idx < 8 * D; idx += NWAVES * 64) { const int k = idx >> 3, e = idx & 7; w8[e * D + k] = g[k] * rw[(size_t)k * 8 + e]; }
    unsigned char* sm = F.ws + WS_SM + SM_MOE;
    float* rstd_g = (float*)(sm + MO_RSTD); int* tok_e = (int*)(sm + MO_TOKE); float* tok_g = (float*)(sm + MO_TOKG); int* hist_g = (int*)(sm + MO_HIST);
    for (int blk = F.blk; blk < NTOKBLK; blk += F.G) {
        if (F.tid < 16) hist[F.tid] = 0;
        __syncthreads();
        f32x4 nv[4]; load_xrow<true, XLD, XROT>(x, (size_t)(blk * TOKBLK + F.wave * (TOKBLK / NWAVES)), F.lane, nv);
        for (int i = 0; i < TOKBLK / NWAVES; ++i) {
            const int m = blk * TOKBLK + F.wave * (TOKBLK / NWAVES) + i;
            f32x4 v[4]; float ss = 0.f;
#pragma unroll
            for (int j = 0; j < 4; ++j) v[j] = nv[j];
            if (i + 1 < TOKBLK / NWAVES) load_xrow<true, XLD, XROT>(x, (size_t)(m + 1), F.lane, nv);
#pragma unroll
            for (int j = 0; j < 4; ++j) ss += (v[j].x * v[j].x + v[j].y * v[j].y) + (v[j].z * v[j].z + v[j].w * v[j].w);
            const float rstd = 1.f / sqrtf(wave_sum(ss) * (1.f / D) + NORM_EPS);
            float pp[8];
#pragma unroll
            for (int e = 0; e < 8; ++e) { float p = 0.f;
#pragma unroll
                for (int j = 0; j < 4; ++j) { const f32x4 wv = *(const LAS f32x4*)(w8 + e * D + 256 * j + 4 * F.lane); p += (v[j].x * wv.x + v[j].y * wv.y) + (v[j].z * wv.z + v[j].w * wv.w); }
                pp[e] = p; }
            TB_STAGE(0, 4) TB_STAGE(1, 2) TB_STAGE(2, 1)
            float tot = pp[0]; tot += __shfl_xor(tot, 8); tot += __shfl_xor(tot, 16); tot += __shfl_xor(tot, 32);
            float lg[8];
#pragma unroll
            for (int e = 0; e < 8; ++e) lg[e] = __shfl(tot, e) * rstd + INP(F, IN_RB)[e];
            if (F.lane == 0) {
                int e0 = 0; float v0 = lg[0];
#pragma unroll
                for (int e = 1; e < 8; ++e) if (lg[e] > v0) { v0 = lg[e]; e0 = e; }
                int e1 = -1; float v1 = -INFINITY;
#pragma unroll
                for (int e = 0; e < 8; ++e) if (e != e0 && lg[e] > v1) { v1 = lg[e]; e1 = e; }
                const float t = __expf(v1 - v0), g0 = 1.f / (1.f + t), g1 = t * g0;
                rstd_g[m] = rstd; tok_e[2 * m] = e0; tok_e[2 * m + 1] = e1; tok_g[2 * m] = g0; tok_g[2 * m + 1] = g1;
                atomicAdd((int*)&hist[e0], 1); atomicAdd((int*)&hist[8 + e1], 1);
            }
        }
        __syncthreads();
        if (F.tid < 16) hist_g[blk * 16 + F.tid] = hist[F.tid];
        __syncthreads();
    }
}
__device__ __forceinline__ void phase_route2(Frame& F, const bf16* x) {
    LAS int* H = (LAS int*)(F.lds);
    LAS int* tot = (LAS int*)(F.lds + 16384); LAS int* pre = tot + 16; LAS int* start = tot + 32; LAS int* dest = tot + 64; LAS int* te = tot + 320;
    unsigned char* sm = F.ws + WS_SM + SM_MOE;
    const float* rstd_g = (const float*)(sm + MO_RSTD); const int* tok_e = (const int*)(sm + MO_TOKE); const float* tok_g = (const float*)(sm + MO_TOKG); const int* hist_g = (const int*)(sm + MO_HIST);
    int* row_tok = (int*)(sm + MO_ROWTOK); float* row_g = (float*)(sm + MO_ROWG); int* tile_e = (int*)(sm + MO_TILEE); int* ntl = (int*)(sm + MO_NT);
    unsigned char* XS = F.ws + WS_XS;
    for (int blk = F.blk; blk < NTOKBLK; blk += F.G) {
        for (int i = F.tid; i < NTOKBLK * 16; i += NWAVES * 64) H[i] = hist_g[i];
        __syncthreads();
        if (F.tid < 16) { int t = 0, p = 0; for (int b = 0; b < NTOKBLK; ++b) { const int h = H[b * 16 + F.tid]; if (b < blk) p += h; t += h; } tot[F.tid] = t; pre[F.tid] = p; }
        __syncthreads();
        if (F.tid == 0) { for (int k = 0; k < 2; ++k) { int run = 0; for (int e = 0; e < 8; ++e) { start[k * 8 + e] = run; run += ((tot[k * 8 + e] + 255) >> 8) << 8; } if (blk == 0) ntl[k] = run >> 8; } }
        __syncthreads();
        if (F.tid < 2 * TOKBLK) te[F.tid] = tok_e[2 * blk * TOKBLK + F.tid];
        __syncthreads();
        if (F.tid < 16) { const int k = F.tid >> 3, e = F.tid & 7; int cnt = 0; const int base = k * MOE_KROWS + start[F.tid] + pre[F.tid];
            for (int i = 0; i < TOKBLK; ++i) if (te[2 * i + k] == e) { dest[2 * i + k] = base + cnt; ++cnt; }
            if (blk == 0) { const int s0 = start[F.tid], t0 = tot[F.tid], pe = ((t0 + 255) >> 8) << 8;
                for (int tI = s0 >> 8; tI < (s0 + pe) >> 8; ++tI) tile_e[k * MOE_KTILES + tI] = e;
                for (int r = s0 + t0; r < s0 + pe; ++r) { row_tok[k * MOE_KROWS + r] = -1; row_g[k * MOE_KROWS + r] = 0.f; } } }
        __syncthreads();
        for (int i0 = 0; i0 < TOKBLK / NWAVES; i0 += 4) {
            f32x4 xv[4][4]; float rs[4]; float tg[4][2];
#pragma unroll
            for (int q = 0; q < 4; ++q) { const int m = blk * TOKBLK + F.wave * (TOKBLK / NWAVES) + i0 + q; load_xrow<true, XLD, XROT>(x, (size_t)m, F.lane, xv[q]); rs[q] = rstd_g[m]; tg[q][0] = tok_g[2 * m]; tg[q][1] = tok_g[2 * m + 1]; }
#pragma unroll
            for (int q = 0; q < 4; ++q) { const int li = F.wave * (TOKBLK / NWAVES) + i0 + q, m = blk * TOKBLK + li; const int d0 = dest[2 * li], d1 = dest[2 * li + 1];
                GAS unsigned* o0 = (GAS unsigned*)(XS + (size_t)d0 * D) + F.lane; GAS unsigned* o1 = (GAS unsigned*)(XS + (size_t)d1 * D) + F.lane; const float sc = rs[q] * FP8_ASCALE;
#pragma unroll
                for (int j = 0; j < 4; ++j) { const f32x4 v = xv[q][j]; const unsigned w = pg8::pack_fp8x4(v.x * sc, v.y * sc, v.z * sc, v.w * sc); o0[64 * j] = w; o1[64 * j] = w; }
                if (F.lane == 0) { row_tok[d0] = m; row_g[d0] = tg[q][0]; row_tok[d1] = m; row_g[d1] = tg[q][1]; } }
        }
        __syncthreads();
    }
}

__device__ __forceinline__ float wave_scan_add(float v, int lane) {
#pragma unroll
    for (int d = 1; d < 64; d <<= 1) { const float t = __shfl_up(v, d); if (lane >= d) v += t; }
    return v;
}
__device__ __forceinline__ float wave_scan_max(float v, int lane) {
#pragma unroll
    for (int d = 1; d < 64; d <<= 1) { const float t = __shfl_up(v, d); if (lane >= d) v = fmaxf(v, t); }
    return v;
}
__device__ __forceinline__ void prep_mlstm(Frame& F, int l, int bh) {
    LAS float* Bc = (LAS float*)(F.lds); LAS float* Gc = Bc + NCH; LAS float* mc = Gc + NCH;
    const int b = bh >> 2, h = bh & 3;
    const float* gate16 = (const float*)(F.ws + WS_SM + SM_GATE16);
    float* mlb = (float*)(F.ws + WS_SM + SM_MLB) + (size_t)bh * SEQ; float* mla = (float*)(F.ws + WS_SM + SM_MLA) + (size_t)bh * SEQ; float* mlmx = (float*)(F.ws + WS_SM + SM_MLMX) + (size_t)bh * SEQ;
    float* mlm = (float*)(F.ws + WS_SM + SM_MLM) + bh * 132; float* mldec = (float*)(F.ws + WS_SM + SM_MLDEC) + bh * NCH;
    const float bi = INP(F, IN_MLBI)[l * ML_H + h], bf = INP(F, IN_MLBF)[l * ML_H + h];
    float areg[NCH / NWAVES];
#pragma unroll
    for (int ci = 0; ci < NCH / NWAVES; ++ci) {
        const int c = F.wave + NWAVES * ci, t = c * CHUNK + F.lane; const size_t m = (size_t)b * SEQ + t;
        const float lf = logsigmoid_f(gate16[m * 16 + 4 + h] + bf), li = gate16[m * 16 + h] + bi;
        const float bc = wave_scan_add(lf, F.lane), a = li - bc;
        const float amax = wave_max(a), btot = __shfl(bc, 63);
        mlb[t] = bc; mla[t] = a; areg[ci] = a;
        if (F.lane == 0) { Bc[c] = btot; Gc[c] = btot + amax; }
    }
    __syncthreads();
    if (F.tid == 0) { float mm = 0.f; for (int c = 0; c < NCH; ++c) { mc[c] = mm; const float mn = fmaxf(Bc[c] + mm, Gc[c]); mldec[c] = __expf(Bc[c] + mm - mn); mlm[c] = mm; mm = mn; } mc[NCH] = mm; mlm[NCH] = mm; }
    __syncthreads();
#pragma unroll
    for (int ci = 0; ci < NCH / NWAVES; ++ci) {
        const int c = F.wave + NWAVES * ci, t = c * CHUNK + F.lane;
        mlmx[t] = fmaxf(mc[c], wave_scan_max(areg[ci], F.lane));
    }
    __syncthreads();
}
__device__ __forceinline__ void prep_fox(Frame& F, int l, int bh) {
    LAS float* wtot = (LAS float*)(F.lds);
    const int b = bh >> 3, h = bh & 7;
    const float* gate16 = (const float*)(F.ws + WS_SM + SM_GATE16);
    float* nb = (float*)(F.ws + WS_SM + SM_FNB) + (size_t)bh * SEQ;
    const float bf = INP(F, IN_FXBF)[l * FX_H + h];
    float v[16]; float s = 0.f;
#pragma unroll
    for (int i = 0; i < 16; ++i) { const size_t m = (size_t)b * SEQ + F.tid * 16 + i; s += logsigmoid_f(gate16[m * 16 + 8 + h] + bf); v[i] = s; }
    const float incl = wave_scan_add(s, F.lane);
    if (F.lane == 63) wtot[F.wave] = incl;
    __syncthreads();
    float off = incl - s;
    for (int w = 0; w < F.wave; ++w) off += wtot[w];
#pragma unroll
    for (int i = 0; i < 16; ++i) nb[F.tid * 16 + i] = -1.4426950408889634f * (off + v[i]);
    __syncthreads();
}

__device__ __forceinline__ void unpack8(const v4u q, float (&f)[8]) {
    f[0] = __uint_as_float(q.x << 16); f[1] = __uint_as_float(q.x & 0xffff0000u); f[2] = __uint_as_float(q.y << 16); f[3] = __uint_as_float(q.y & 0xffff0000u);
    f[4] = __uint_as_float(q.z << 16); f[5] = __uint_as_float(q.z & 0xffff0000u); f[6] = __uint_as_float(q.w << 16); f[7] = __uint_as_float(q.w & 0xffff0000u);
}
__device__ __forceinline__ void pool_item(Frame& F, int item) {
    const bf16* U = (const bf16*)(F.ws + WS_NG + SL_POOL * SLAB_BYTES) + F.lane * 8; bf16* CAT = (bf16*)(F.ws + WS_CAT) + F.lane * 8;
    const int grp = F.lane >> 4, w = 2 << grp, m0 = item * 32, tt0 = m0 & (SEQ - 1);
    v4u ring[16];
#pragma unroll
    for (int j = 1; j < 16; ++j) { ring[(16 - j) & 15] = (v4u){0u, 0u, 0u, 0u}; if (tt0 - j >= 0) ring[(16 - j) & 15] = *(const GAS v4u*)(U + (size_t)(m0 - j) * 512); }
    float sum[8];
#pragma unroll
    for (int i = 0; i < 8; ++i) sum[i] = 0.f;
#pragma unroll
    for (int j = 1; j < 16; ++j) { float f[8]; unpack8(ring[(16 - j) & 15], f); const float on = (j < w) ? 1.f : 0.f;
#pragma unroll
        for (int i = 0; i < 8; ++i) sum[i] += on * f[i]; }
#pragma unroll
    for (int r0 = 0; r0 < 32; r0 += 8) {
        v4u cur[8];
#pragma unroll
        for (int j = 0; j < 8; ++j) cur[j] = *(const GAS v4u*)(U + (size_t)(m0 + r0 + j) * 512);
#pragma unroll
        for (int j = 0; j < 8; ++j) { const int r = r0 + j, tt = tt0 + r;
            float c[8]; unpack8(cur[j], c);
#pragma unroll
            for (int i = 0; i < 8; ++i) sum[i] += c[i];
            const int cnt = (tt + 1 < w) ? tt + 1 : w; const float inv = 1.f / (float)cnt;
            v4u o; o.x = pk2(sum[0] * inv - c[0], sum[1] * inv - c[1]); o.y = pk2(sum[2] * inv - c[2], sum[3] * inv - c[3]); o.z = pk2(sum[4] * inv - c[4], sum[5] * inv - c[5]); o.w = pk2(sum[6] * inv - c[6], sum[7] * inv - c[7]);
            *(GAS v4u*)(CAT + (size_t)(m0 + r) * KCAT) = o;
            const v4u a2 = (r - 1 >= 0 || true) ? ((r - 1) >= r0 ? cur[(j - 1) & 7] : ring[(r - 1) & 15]) : ring[0];
            const v4u a4 = ((r - 3) >= r0) ? cur[(j - 3) & 7] : ring[(r - 3) & 15];
            const v4u a8 = ((r - 7) >= r0) ? cur[(j - 7) & 7] : ring[(r - 7) & 15];
            const v4u a16 = ring[(r - 15) & 15];
            v4u old; old.x = grp == 0 ? a2.x : (grp == 1 ? a4.x : (grp == 2 ? a8.x : a16.x)); old.y = grp == 0 ? a2.y : (grp == 1 ? a4.y : (grp == 2 ? a8.y : a16.y));
            old.z = grp == 0 ? a2.z : (grp == 1 ? a4.z : (grp == 2 ? a8.z : a16.z)); old.w = grp == 0 ? a2.w : (grp == 1 ? a4.w : (grp == 2 ? a8.w : a16.w));
            float f[8]; unpack8(old, f);
#pragma unroll
            for (int i = 0; i < 8; ++i) sum[i] -= f[i];
        }
#pragma unroll
        for (int j = 0; j < 8; ++j) ring[(r0 + j) & 15] = cur[j];
    }
}

__device__ __forceinline__ void fox_norm_item(Frame& F, int it) {
    const int bhblk = it >> 3, wv = it & 7, bh = bhblk >> 5, blk = bhblk & 31, b = bh >> 3, h = bh & 7;
    const size_t m = (size_t)b * SEQ + blk * 256 + wv * 32 + (F.lane >> 1); const int col = h * 64 + (F.lane & 1) * 32;
    const bf16* QS = (const bf16*)(F.ws + WS_NG + SL_FQ * SLAB_BYTES) + m * 512 + col; const bf16* KS = (const bf16*)(F.ws + WS_NG + SL_FK * SLAB_BYTES) + m * 512 + col;
    float sq = 0.f, sk = 0.f, dq = 0.f;
#pragma unroll
    for (int i = 0; i < 4; ++i) { float f[8], g[8]; const v4u a = *(const GAS v4u*)(QS + 8 * i), c = *(const GAS v4u*)(KS + 8 * i);
        f[0] = __uint_as_float(a.x << 16); f[1] = __uint_as_float(a.x & 0xffff0000u); f[2] = __uint_as_float(a.y << 16); f[3] = __uint_as_float(a.y & 0xffff0000u); f[4] = __uint_as_float(a.z << 16); f[5] = __uint_as_float(a.z & 0xffff0000u); f[6] = __uint_as_float(a.w << 16); f[7] = __uint_as_float(a.w & 0xffff0000u);
        g[0] = __uint_as_float(c.x << 16); g[1] = __uint_as_float(c.x & 0xffff0000u); g[2] = __uint_as_float(c.y << 16); g[3] = __uint_as_float(c.y & 0xffff0000u); g[4] = __uint_as_float(c.z << 16); g[5] = __uint_as_float(c.z & 0xffff0000u); g[6] = __uint_as_float(c.w << 16); g[7] = __uint_as_float(c.w & 0xffff0000u);
#pragma unroll
        for (int j = 0; j < 8; ++j) { sq += f[j] * f[j]; sk += g[j] * g[j]; dq += f[j] * g[j]; } }
    sq += __shfl_xor(sq, 1); sk += __shfl_xor(sk, 1); dq += __shfl_xor(dq, 1);
    dq = -wave_max(-dq);
    sq = wave_max(sq) * 1.0001f; sk = wave_max(sk) * 1.0001f;
    if (F.lane == 0) { ((float*)(F.ws + WS_SM + SM_FQN))[it] = sq; ((float*)(F.ws + WS_SM + SM_FKN))[it] = sk; ((float*)(F.ws + WS_SM + SM_FXM))[it] = dq; }
}

typedef float f32x16 __attribute__((ext_vector_type(16)));
typedef unsigned u32x2 __attribute__((ext_vector_type(2)));
__device__ __forceinline__ float silu_f(float x) { return x * __builtin_amdgcn_rcpf(1.f + __builtin_amdgcn_exp2f(-1.4426950408889634f * x)); }
__device__ __forceinline__ void conv8(const bf16* slab, size_t m, int tt, int col, const float (&cw)[4][8], float (&o)[8]) {
    v4u q[4];
#pragma unroll
    for (int j = 0; j < 4; ++j) { const size_t mr = (tt - 3 + j >= 0) ? m - 3 + j : m; q[j] = *(const GAS v4u*)(slab + mr * 512 + col); }
#pragma unroll
    for (int i = 0; i < 8; ++i) o[i] = 0.f;
#pragma unroll
    for (int j = 0; j < 4; ++j) { float f[8]; unpack8(q[j], f); const float vld = (tt - 3 + j >= 0) ? 1.f : 0.f;
#pragma unroll
        for (int i = 0; i < 8; ++i) o[i] += (cw[j][i] * vld) * f[i]; }
#pragma unroll
    for (int i = 0; i < 8; ++i) o[i] = silu_f(o[i]);
}
constexpr int KT_P = 72, QS_P = 136;
__device__ __forceinline__ bf16x8 pack_acc8(const f32x16& x, int s) {
    v4u w; w.x = pk2(x[8 * s + 0], x[8 * s + 1]); w.y = pk2(x[8 * s + 2], x[8 * s + 3]); w.z = pk2(x[8 * s + 4], x[8 * s + 5]); w.w = pk2(x[8 * s + 6], x[8 * s + 7]);
    return __builtin_bit_cast(bf16x8, w);
}
__device__ __forceinline__ void conv8r(const v4u (&q)[4], int tt, const LAS float* cw, int col, float (&o)[8]) {
#pragma unroll
    for (int i = 0; i < 8; ++i) o[i] = 0.f;
#pragma unroll
    for (int j = 0; j < 4; ++j) { float f[8]; unpack8(q[j], f); const float vld = (tt - 3 + j >= 0) ? 1.f : 0.f;
        const f32x4 w0 = *(const LAS f32x4*)(cw + j * 512 + col) * vld, w1 = *(const LAS f32x4*)(cw + j * 512 + col + 4) * vld;
#pragma unroll
        for (int i = 0; i < 4; ++i) { o[i] += w0[i] * f[i]; o[4 + i] += w1[i] * f[4 + i]; } }
#pragma unroll
    for (int i = 0; i < 8; ++i) o[i] = silu_f(o[i]);
}
struct RawL { v4u k[2][4]; v4u v[2]; float fp, ip; };
__device__ __forceinline__ void mlstm_L_load(Frame& F, int u, RawL& R) {
    const int bh = u >> 7, c = u & (NCH - 1), b = bh >> 2, h = bh & 3;
    const bf16* KS = (const bf16*)(F.ws + WS_NG + SL_MK * SLAB_BYTES); const bf16* VS = (const bf16*)(F.ws + WS_NG + SL_MV * SLAB_BYTES);
    const int s = F.lane, tt = c * CHUNK + s; const size_t m = (size_t)b * SEQ + tt;
#pragma unroll
    for (int half = 0; half < 2; ++half) { const int col = h * ML_DH + (F.wave + 8 * half) * 8;
#pragma unroll
        for (int j = 0; j < 4; ++j) { const size_t mr = (tt - 3 + j >= 0) ? m - 3 + j : m; R.k[half][j] = *(const GAS v4u*)(KS + mr * 512 + col); }
        R.v[half] = *(const GAS v4u*)(VS + m * 512 + col); }
    const float* gate16 = (const float*)(F.ws + WS_SM + SM_GATE16) + m * 16;
    R.fp = gate16[4 + h]; R.ip = gate16[h];
}
__device__ __forceinline__ void mlstm_L_phase(Frame& F, int l) {
    LAS bf16* Kt = (LAS bf16*)(F.lds); LAS bf16* Vt = Kt + 128 * KT_P; LAS float* wk = (LAS float*)(F.lds + 2 * 128 * KT_P * 2); LAS float* cwk = (LAS float*)(F.lds + 40960);
    for (int i = F.tid; i < 4 * 512; i += NWAVES * 64) cwk[i] = INP(F, IN_CONVW)[(size_t)l * 4 * 1024 + (i >> 9) * 1024 + 512 + (i & 511)];
    const int NU = BATCH * ML_H * NCH;
    float b_f[ML_H], b_i[ML_H];
#pragma unroll
    for (int i = 0; i < ML_H; ++i) { b_f[i] = INP(F, IN_MLBF)[l * ML_H + i]; b_i[i] = INP(F, IN_MLBI)[l * ML_H + i]; }
    int u = F.vcu; if (u >= NU) { __syncthreads(); return; }
    RawL cur; mlstm_L_load(F, u, cur);
    __syncthreads();
    for (; u < NU; u += F.G) {
        const int bh = u >> 7, h = bh & 3;
        if (F.tid < CHUNK) {
            const float lf = logsigmoid_f(cur.fp + b_f[h]), li = cur.ip + b_i[h];
            const float bc = wave_scan_add(lf, F.lane), a = li - bc, amax = wave_max(a);
            wk[F.tid] = __expf(a - amax);
            const int c = u & (NCH - 1);
            ((float*)(F.ws + WS_SM + SM_MLB))[(size_t)bh * SEQ + c * CHUNK + F.tid] = bc; ((float*)(F.ws + WS_SM + SM_MLA))[(size_t)bh * SEQ + c * CHUNK + F.tid] = a;
            if (F.tid == 63) { float* bg = (float*)(F.ws + WS_SM + SM_MLBG) + 2 * u; bg[0] = bc; bg[1] = bc + amax; }
        }
        __syncthreads();
        {   const int s = F.lane, tt = (u & (NCH - 1)) * CHUNK + s;
#pragma unroll
            for (int half = 0; half < 2; ++half) { const int cg = F.wave + 8 * half, col = h * ML_DH + cg * 8;
                float kk[8]; conv8r(cur.k[half], tt, cwk, col, kk);
                float vv[8]; unpack8(cur.v[half], vv); const float ws = wk[s];
#pragma unroll
                for (int i = 0; i < 8; ++i) { Kt[(cg * 8 + i) * KT_P + s] = (bf16)f2bf(kk[i] * 0.08838834764831845f); Vt[(cg * 8 + i) * KT_P + s] = (bf16)f2bf(vv[i] * ws); } }
        }
        __syncthreads();
        if (u + F.G < NU) mlstm_L_load(F, u + F.G, cur);
        {   const int r = F.lane & 31, hi = F.lane >> 5, kb = F.wave >> 1;
            f32x16 acc[2]; acc[0] = f32x16{}; acc[1] = f32x16{};
#pragma unroll
            for (int sp = 0; sp < 4; ++sp) { const bf16x8 a = *(const LAS bf16x8*)(Kt + (kb * 32 + r) * KT_P + 16 * sp + 8 * hi);
#pragma unroll
                for (int j = 0; j < 2; ++j) { const int vb = 2 * (F.wave & 1) + j; const bf16x8 bb = *(const LAS bf16x8*)(Vt + (vb * 32 + r) * KT_P + 16 * sp + 8 * hi);
                    acc[j] = __builtin_amdgcn_mfma_f32_32x32x16_bf16(a, bb, acc[j], 0, 0, 0); } }
            GAS bf16x8* img = (GAS bf16x8*)(F.ws + WS_MLC + (size_t)u * 32768);
#pragma unroll
            for (int j = 0; j < 2; ++j) { const int vb = 2 * (F.wave & 1) + j;
#pragma unroll
                for (int s = 0; s < 2; ++s) img[((vb * 4 + kb) * 2 + s) * 64 + F.lane] = pack_acc8(acc[j], s); }
        }
        if (F.tid < ML_DH) { float a = 0.f;
#pragma unroll 8
            for (int s = 0; s < CHUNK; ++s) a += wk[s] * __uint_as_float((unsigned)Kt[F.tid * KT_P + s] << 16);
            ((float*)(F.ws + WS_SM + SM_MLN))[(size_t)u * ML_DH + F.tid] = a; }
        __syncthreads();
    }
}
__device__ __forceinline__ void mlstm_S(Frame& F) {
    LAS float* dec = (LAS float*)(F.lds); LAS float* cor = dec + NCH;
    for (int unit = F.vcu; unit < 16 * 16; unit += F.G) {
        const int bh = unit >> 4, part = unit & 15;
        if (F.tid == 0) { const float* bg = (const float*)(F.ws + WS_SM + SM_MLBG) + 2 * bh * NCH; float* mlm = (float*)(F.ws + WS_SM + SM_MLM) + bh * 132; float mm = 0.f;
            for (int c = 0; c < NCH; ++c) { const float B = bg[2 * c], G = bg[2 * c + 1], mn = fmaxf(B + mm, G); dec[c] = __expf(B + mm - mn); cor[c] = __expf(G - mn); mlm[c] = mm; mm = mn; }
            mlm[NCH] = mm; }
        __syncthreads();
        {   const int e2 = part * 512 + F.tid; GAS unsigned* p = (GAS unsigned*)(F.ws + WS_MLC + (size_t)bh * NCH * 32768) + e2;
            float r0 = 0.f, r1 = 0.f;
            for (int c0 = 0; c0 < NCH; c0 += 16) { unsigned q[16];
#pragma unroll
                for (int i = 0; i < 16; ++i) q[i] = p[(size_t)(c0 + i) * 8192];
#pragma unroll
                for (int i = 0; i < 16; ++i) { const float d = dec[c0 + i], k = cor[c0 + i]; p[(size_t)(c0 + i) * 8192] = pk2(r0, r1);
                    r0 = d * r0 + k * __uint_as_float(q[i] << 16); r1 = d * r1 + k * __uint_as_float(q[i] & 0xffff0000u); } } }
        if (part == 0 && F.tid < ML_DH) { float* p = (float*)(F.ws + WS_SM + SM_MLN) + (size_t)bh * NCH * ML_DH + F.tid;
            float r = 0.f;
            for (int c0 = 0; c0 < NCH; c0 += 16) { float q[16];
#pragma unroll
                for (int i = 0; i < 16; ++i) q[i] = p[(size_t)(c0 + i) * ML_DH];
#pragma unroll
                for (int i = 0; i < 16; ++i) { p[(size_t)(c0 + i) * ML_DH] = r; r = dec[c0 + i] * r + cor[c0 + i] * q[i]; } } }
        __syncthreads();
    }
}
#define O_BAR() do { asm volatile("s_waitcnt lgkmcnt(0)" ::: "memory"); __builtin_amdgcn_s_barrier(); asm volatile("" ::: "memory"); } while (0)
constexpr int O_RAWQ = 73728, O_RAWK = O_RAWQ + 68 * 256, O_RAWV = O_RAWK + 68 * 256, O_END = O_RAWV + 64 * 256;
static_assert(O_END + 3 * 2 * 1024 <= RING_BYTES, "mLSTM O-phase LDS map");
__device__ __forceinline__ void mlstm_O_dma(Frame& F, int u) {
    const int bh = u >> 7, c = u & (NCH - 1), b = bh >> 2, h = bh & 3;
    const size_t seq0 = (size_t)b * SEQ; const int t0 = c * CHUNK;
    for (int i = F.wave; i < 50; i += NWAVES) {
        const int ten = i < 17 ? 0 : (i < 34 ? 1 : 2), ii = i - 17 * ten, row = 4 * ii + (F.lane >> 4);
        int t = (ten == 2) ? t0 + row : t0 - 3 + row; t = t < 0 ? 0 : (t > t0 + CHUNK - 1 ? t0 + CHUNK - 1 : t);
        const bf16* src = (const bf16*)(F.ws + WS_NG + (size_t)(ten == 0 ? SL_MQ : (ten == 1 ? SL_MK : SL_MV)) * SLAB_BYTES) + (seq0 + t) * 512 + h * ML_DH + (((F.lane & 15) ^ (row & 15)) * 8);
        const int dst = (ten == 0 ? O_RAWQ : (ten == 1 ? O_RAWK : O_RAWV)) + ii * 1024;
        __builtin_amdgcn_global_load_lds((const GAS unsigned*)src, (LAS unsigned*)(F.lds + dst), 16, 0, 0);
    }
}
__device__ __forceinline__ void conv8l(const LAS bf16* raw, int s, int tt, const LAS float* cw, int cg, int col, float (&o)[8]) {
#pragma unroll
    for (int i = 0; i < 8; ++i) o[i] = 0.f;
#pragma unroll
    for (int j = 0; j < 4; ++j) { float f[8]; unpack8(*(const LAS v4u*)(raw + (s + j) * 128 + ((cg ^ ((s + j) & 15)) * 8)), f); const float vld = (tt - 3 + j >= 0) ? 1.f : 0.f;
        const f32x4 w0 = *(const LAS f32x4*)(cw + j * 512 + col) * vld, w1 = *(const LAS f32x4*)(cw + j * 512 + col + 4) * vld;
#pragma unroll
        for (int i = 0; i < 4; ++i) { o[i] += w0[i] * f[i]; o[4 + i] += w1[i] * f[4 + i]; } }
#pragma unroll
    for (int i = 0; i < 8; ++i) o[i] = silu_f(o[i]);
}
__device__ __forceinline__ void mlstm_O_phase(Frame& F, int l) {
    LAS bf16* Qs = (LAS bf16*)(F.lds); LAS bf16* Ks = Qs + 64 * QS_P; LAS bf16* Vt = Ks + 64 * QS_P;
    LAS float* fa = (LAS float*)(F.lds + (2 * 64 * QS_P + 128 * KT_P) * 2); LAS float* fmx = fa + 64; LAS float* fb = fa + 128; LAS float* nvec = fa + 192; LAS float* ssq = fa + 320;
    LAS float* cwq = (LAS float*)(F.lds + 57344); LAS float* cwk = cwq + 4 * 512;
    LAS float* psm = (LAS float*)(F.lds + 55552); LAS float* nqp = psm + 96; LAS bf16x8* pimg = (LAS bf16x8*)(F.lds + O_END);
    const LAS bf16* rawq = (const LAS bf16*)(F.lds + O_RAWQ); const LAS bf16* rawk = (const LAS bf16*)(F.lds + O_RAWK); const LAS bf16* rawv = (const LAS bf16*)(F.lds + O_RAWV);
    for (int i = F.tid; i < 4 * 512; i += NWAVES * 64) { cwq[i] = INP(F, IN_CONVW)[(size_t)l * 4 * 1024 + (i >> 9) * 1024 + (i & 511)]; cwk[i] = INP(F, IN_CONVW)[(size_t)l * 4 * 1024 + (i >> 9) * 1024 + 512 + (i & 511)]; }
    const int NU = BATCH * ML_H * NCH;
    int u = F.vcu; if (u >= NU) { __syncthreads(); return; }
    mlstm_O_dma(F, u);
    const bf16* OS = (const bf16*)(F.ws + WS_NG + SL_MO * SLAB_BYTES);
    const int r = F.lane & 31, hi = F.lane >> 5, tb = F.wave & 1, vb = F.wave >> 1;
    for (; u < NU; u += F.G) {
    const int bh = u >> 7, c = u & (NCH - 1), b = bh >> 2, h = bh & 3;
    asm volatile("s_waitcnt vmcnt(0)" ::: "memory"); O_BAR();
    const float m_c = ((const float*)(F.ws + WS_SM + SM_MLM))[bh * 132 + c];
    bf16x8 cf[4][2];
    {   const GAS bf16x8* img = (const GAS bf16x8*)(F.ws + WS_MLC + (size_t)u * 32768);
#pragma unroll
        for (int kb = 0; kb < 4; ++kb)
#pragma unroll
            for (int s = 0; s < 2; ++s) cf[kb][s] = img[((vb * 4 + kb) * 2 + s) * 64 + F.lane]; }
    u32x2 oww[4];
    {   const size_t m = (size_t)b * SEQ + c * CHUNK + tb * 32 + r;
#pragma unroll
        for (int q = 0; q < 4; ++q) oww[q] = *(const GAS u32x2*)(OS + m * 512 + h * ML_DH + vb * 32 + 8 * q + 4 * hi); }
    float g0 = 0.f, g1 = 0.f, g2 = 0.f;
    {   const float* mlb = (const float*)(F.ws + WS_SM + SM_MLB) + (size_t)bh * SEQ; const float* mla = (const float*)(F.ws + WS_SM + SM_MLA) + (size_t)bh * SEQ; const float* mlmx = (const float*)(F.ws + WS_SM + SM_MLMX) + (size_t)bh * SEQ;
        if (F.tid < CHUNK) { g0 = mla[c * CHUNK + F.tid]; g2 = mlb[c * CHUNK + F.tid]; g1 = fmaxf(m_c, wave_scan_max(g0, F.lane)); }
        else if (F.tid < CHUNK + ML_DH) g0 = ((const float*)(F.ws + WS_SM + SM_MLN))[(size_t)u * ML_DH + F.tid - CHUNK]; }
    {   const int s = F.lane, tt = c * CHUNK + s;
#pragma unroll
        for (int half = 0; half < 2; ++half) { const int cg = F.wave + 8 * half, col = h * ML_DH + cg * 8;
            float qq[8], kk[8], vv[8]; conv8l(rawq, s, tt, cwq, cg, col, qq); conv8l(rawk, s, tt, cwk, cg, col, kk); unpack8(*(const LAS v4u*)(rawv + s * 128 + ((cg ^ (s & 15)) * 8)), vv);
            v4u wq, wkk; wq.x = pk2(qq[0], qq[1]); wq.y = pk2(qq[2], qq[3]); wq.z = pk2(qq[4], qq[5]); wq.w = pk2(qq[6], qq[7]);
            const float sc = 0.08838834764831845f;
            wkk.x = pk2(kk[0] * sc, kk[1] * sc); wkk.y = pk2(kk[2] * sc, kk[3] * sc); wkk.z = pk2(kk[4] * sc, kk[5] * sc); wkk.w = pk2(kk[6] * sc, kk[7] * sc);
            *(LAS v4u*)(Qs + s * QS_P + cg * 8) = wq; *(LAS v4u*)(Ks + s * QS_P + cg * 8) = wkk;
#pragma unroll
            for (int i = 0; i < 8; ++i) Vt[(cg * 8 + i) * KT_P + s] = (bf16)f2bf(vv[i]); }
    }
    if (F.tid < CHUNK) { fa[F.tid] = g0; fmx[F.tid] = g1; fb[F.tid] = g2; }
    else if (F.tid < CHUNK + ML_DH) nvec[F.tid - CHUNK] = g0;
    O_BAR();
    if (u + F.G < NU) mlstm_O_dma(F, u + F.G);
    const int t = tb * 32 + r;
    const float Mx_t = fmx[t], m_t = fb[t] + Mx_t, w_int = __expf(m_c - Mx_t);
    if (F.wave < 3) {
        const int tbs = F.wave ? 1 : 0, sbs = F.wave == 2 ? 1 : 0, ts = tbs * 32 + r; const float Mxs = fmx[ts];
        f32x16 x = f32x16{};
#pragma unroll
        for (int ks = 0; ks < 8; ++ks) { const bf16x8 a = *(const LAS bf16x8*)(Ks + (sbs * 32 + r) * QS_P + 16 * ks + 8 * hi); const bf16x8 q = *(const LAS bf16x8*)(Qs + ts * QS_P + 16 * ks + 8 * hi);
            x = __builtin_amdgcn_mfma_f32_32x32x16_bf16(a, q, x, 0, 0, 0); }
        float ps = 0.f;
#pragma unroll
        for (int rr = 0; rr < 16; ++rr) { const int s = sbs * 32 + (rr & 3) + 8 * (rr >> 2) + 4 * hi; const float pv = (s <= ts) ? __expf(fa[s] - Mxs) * x[rr] : 0.f; x[rr] = pv; ps += pv; }
        ps += __shfl_xor(ps, 32);
        pimg[(F.wave * 2 + 0) * 64 + F.lane] = pack_acc8(x, 0); pimg[(F.wave * 2 + 1) * 64 + F.lane] = pack_acc8(x, 1);
        if (hi == 0) psm[F.wave * 32 + r] = ps;
    }
    {   float nq = 0.f;
#pragma unroll
        for (int i = 0; i < 2; ++i) { float f[8]; unpack8(*(const LAS v4u*)(Qs + t * QS_P + 32 * vb + 16 * hi + 8 * i), f);
#pragma unroll
            for (int j = 0; j < 8; ++j) nq += f[j] * nvec[32 * vb + 16 * hi + 8 * i + j]; }
        nq += __shfl_xor(nq, 32);
        if (hi == 0) nqp[vb * 64 + t] = nq; }
    f32x16 acc = f32x16{};
#pragma unroll
    for (int kb = 0; kb < 4; ++kb)
#pragma unroll
        for (int s = 0; s < 2; ++s) { const u32x2 lo = *(const LAS u32x2*)(Qs + t * QS_P + kb * 32 + 16 * s + 4 * hi), hi2 = *(const LAS u32x2*)(Qs + t * QS_P + kb * 32 + 16 * s + 8 + 4 * hi);
            v4u w; w.x = lo.x; w.y = lo.y; w.z = hi2.x; w.w = hi2.y;
            acc = __builtin_amdgcn_mfma_f32_32x32x16_bf16(cf[kb][s], __builtin_bit_cast(bf16x8, w), acc, 0, 0, 0); }
#pragma unroll
    for (int rr = 0; rr < 16; ++rr) acc[rr] *= w_int;
    O_BAR();
    float psum = 0.f;
#pragma unroll
    for (int sb = 0; sb < 2; ++sb) {
        if (sb <= tb) { const int blk = tb == 0 ? 0 : 1 + sb; psum += psm[blk * 32 + r];
#pragma unroll
            for (int s = 0; s < 2; ++s) { const u32x2 lo = *(const LAS u32x2*)(Vt + (vb * 32 + r) * KT_P + sb * 32 + 16 * s + 4 * hi), hi2 = *(const LAS u32x2*)(Vt + (vb * 32 + r) * KT_P + sb * 32 + 16 * s + 8 + 4 * hi);
                v4u w; w.x = lo.x; w.y = lo.y; w.z = hi2.x; w.w = hi2.y;
                acc = __builtin_amdgcn_mfma_f32_32x32x16_bf16(__builtin_bit_cast(bf16x8, w), pimg[(blk * 2 + s) * 64 + F.lane], acc, 0, 0, 0); }
        }
    }
    const float nq = (nqp[t] + nqp[64 + t]) + (nqp[128 + t] + nqp[192 + t]);
    const float den = w_int * nq + psum, inv = 1.f / fmaxf(fabsf(den), __expf(-m_t));
    float sq = 0.f;
#pragma unroll
    for (int rr = 0; rr < 16; ++rr) { acc[rr] *= inv; sq += acc[rr] * acc[rr]; }
    sq += __shfl_xor(sq, 32);
    if (hi == 0) ssq[vb * 64 + t] = sq;
    O_BAR();
    const float rstd = 1.f / sqrtf((ssq[t] + ssq[64 + t] + ssq[128 + t] + ssq[192 + t]) * (1.f / ML_DH) + NORM_EPS);
    {   const size_t m = (size_t)b * SEQ + c * CHUNK + t; bf16* CAT = (bf16*)(F.ws + WS_CAT);
#pragma unroll
        for (int q = 0; q < 4; ++q) { const int v0 = vb * 32 + 8 * q + 4 * hi, col = h * ML_DH + v0;
            const u32x2 ow = oww[q]; const f32x4 gn = *(const GAS f32x4*)(INP(F, IN_MLNG) + (size_t)l * 512 + col);
            const float o0 = sigmoid_f(__uint_as_float(ow.x << 16)), o1 = sigmoid_f(__uint_as_float(ow.x & 0xffff0000u)), o2 = sigmoid_f(__uint_as_float(ow.y << 16)), o3 = sigmoid_f(__uint_as_float(ow.y & 0xffff0000u));
            u32x2 w; w.x = pk2(acc[4 * q] * rstd * gn.x * o0, acc[4 * q + 1] * rstd * gn.y * o1); w.y = pk2(acc[4 * q + 2] * rstd * gn.z * o2, acc[4 * q + 3] * rstd * gn.w * o3);
            *(GAS u32x2*)(CAT + m * KCAT + 512 + col) = w; }
    }
    }
    asm volatile("s_waitcnt vmcnt(0)" ::: "memory"); O_BAR();
}
#undef O_BAR

#ifndef SUBP
#define SUBP 0
#endif
#ifndef MK_MULTI
#define MK_MULTI 0
#endif
constexpr int NPH = 1 + (8 + 1) + (1 + 8 + 4) + 1;
#ifndef PH_MASK
#define PH_MASK 0xffffffffu
#endif
#ifndef PROBE_MASK
#define PROBE_MASK 0u
#endif
#define PH_BEGIN(id) if (ph >= lo && ph < hi) { if constexpr (((PH_MASK) >> (id)) & 1u) { for (int rep_ = 0; rep_ < 1 + (int)(((PROBE_MASK) >> (id)) & 1u); ++rep_) { Frame F = FK; { size_t z_ = 0; int zi_ = 0; asm volatile("" : "+v"(F.tid), "+s"(z_), "+s"(zi_)); \
        F.lane = F.tid & 63; F.ws = FK.ws + z_; F.out = (float*)((char*)FK.out + z_); F.zi = zi_; } const int gw = F.vcu * NWAVES + F.wave, NGWV = F.G * NWAVES; (void)gw; (void)NGWV;
#define PH_END __syncthreads(); } } if (ph + 1 < hi) { XcdBarrier b2_ = bar; size_t zb_ = 0; asm volatile("" : "+s"(zb_)); b2_.bar = bar.bar + zb_; xcd_barrier(b2_); } } ++ph;
#define HB ((bf16*)(F.ws + WS_HB))
#define CAT ((bf16*)(F.ws + WS_CAT))
#define SLAB ((bf16*)(F.ws + WS_NG))
#define GATE ((bf16*)(F.ws + WS_GATE))
#define WL ((bf16*)(F.ws + WS_W + (size_t)l * W_LAYER))
#define XBP ((bf16*)F.out)

template <int l> __device__ __forceinline__ void layer_phases(Frame& FK, int& ph, const int lo, const int hi, const XcdBarrier& bar, unsigned char* lds) {
        if constexpr (l > 0) { PH_BEGIN(1) phase_norm_mix<true>(F, XBP, l); PH_END }
        PH_BEGIN(2)
            pg8::Gemm g{HB, WL + W_NG / 2, M, NGW, D}; pg8::StaticOrder S; S.init(M, NGW, F.G, F.blk);
            pg8::EpiSlab E{SLAB, (size_t)M * 512, SL_FQ, attn_body::C2};
            pg8::gemm_phase<pg8::EpiSlab, pg8::StaticOrder, true, true>(F.lds + RING_OFF, g, S, E);
        PH_END
        PH_BEGIN(3)
            for (int s = F.blk; s < BATCH * FX_H; s += F.G) prep_fox(F, l, s);
            for (int rp = 0; rp < (SUBP == 1 ? 2 : 1); ++rp) for (int it = gw; it < M / 32; it += NGWV) pool_item(F, it);
            for (int rp = 0; rp < (SUBP == 2 ? 2 : 1); ++rp) for (int it = gw; it < BATCH * FX_H * 32 * 8; it += NGWV) fox_norm_item(F, it);
            for (int rp = 0; rp < (SUBP == 3 ? 2 : 1); ++rp) mlstm_L_phase(F, l);
        PH_END
        PH_BEGIN(4)
            mlstm_S(F);
            for (int ui = gw; ui < BATCH * FX_H * 32; ui += NGWV) { const int bh = ui >> 5, qb = ui & 31;
                const int t0 = attn_body::attn_t0(qb, (const float*)(F.ws + WS_SM + SM_FNB) + (size_t)bh * SEQ, (const float*)(F.ws + WS_SM + SM_FQN) + bh * 256, (const float*)(F.ws + WS_SM + SM_FKN) + bh * 256, (const float*)(F.ws + WS_SM + SM_FXM) + bh * 256, F.lane);
                if (F.lane == 0) ((int*)(F.ws + WS_SM + SM_FT0))[ui] = t0; }
        PH_END
        PH_BEGIN(18)
            for (int rp = 0; rp < (SUBP == 4 ? 2 : 1); ++rp) mlstm_O_phase(F, l);
            const attn_body::AttnTensors AT{(const attn_body::bf16*)(SLAB + (size_t)SL_FQ * M * 512), (const attn_body::bf16*)(SLAB + (size_t)SL_FK * M * 512), (const attn_body::bf16*)(SLAB + (size_t)SL_FV * M * 512),
                                            (attn_body::bf16*)CAT, (const float*)(F.ws + WS_SM + SM_FNB), (const float*)(F.ws + WS_SM + SM_FQN), (const float*)(F.ws + WS_SM + SM_FKN), (const int*)(F.ws + WS_SM + SM_FT0)};
            attn_body::attn_phase_dyn<8>((char*)lds + RING_OFF, AT, (unsigned*)(F.ctl + 2048 + 64 * l), F.MISC + 0);
            quant_rows_fp8(F, HB, F.ws + WS_NG + (size_t)SL_POOL * SLAB_BYTES);
        PH_END
        PH_BEGIN(6)
            pg8::Gemm g{(const bf16*)(F.ws + WS_NG + (size_t)SL_POOL * SLAB_BYTES), WL + W_GT / 2, M, NGT, D / 2}; pg8::StaticOrder S; S.init(M, NGT, F.G, F.blk);
            pg8::EpiSig E{(unsigned char*)GATE, 1.f / (FP8_ASCALE * FP8_WSCALE)};
            pg8::gemm_phase<pg8::EpiSig, pg8::StaticOrder, true, true, true>(F.lds + RING_OFF, g, S, E);
        PH_END
        PH_BEGIN(7)
            pg8::Gemm g{CAT, WL + W_CAT / 2, M, D, KCAT}; pg8::StaticOrder S; S.init(M, D, F.G, F.blk);
            pg8::EpiMerge E{(const unsigned char*)GATE, HB};
            pg8::gemm_phase<pg8::EpiMerge, pg8::StaticOrder, true, true>(F.lds + RING_OFF, g, S, E);
        PH_END
        PH_BEGIN(8)
            pg8::Gemm g{HB, WL + W_OUT / 2, M, D, D}; pg8::StaticOrder S; S.init(M, D, F.G, F.blk);
            if constexpr (l == 0) { pg8::EpiResB<true> E{INP(F, IN_X), XBP, (float*)(F.ws + WS_SM + SM_GATE16)};     pg8::gemm_phase<pg8::EpiResB<true>, pg8::StaticOrder, true, true>(F.lds + RING_OFF, g, S, E); }
            else { pg8::EpiResB<false> E{XBP, XBP, nullptr}; pg8::gemm_phase<pg8::EpiResB<false>, pg8::StaticOrder, true, true>(F.lds + RING_OFF, g, S, E); }
        PH_END
        if constexpr (l == 0) {
            PH_BEGIN(10)
                pg8::Gemm g{XBP, (const bf16*)(F.ws + WS_WGU), M, 2 * DFF, D}; pg8::StaticOrder S; S.init(M, 2 * DFF, F.G, F.blk);
                pg8::EpiSwiGLUR E{(bf16*)(F.ws + WS_ACT0), DFF, (const float*)(F.ws + WS_SM + SM_GATE16), 1.f / D, NORM_EPS};
                pg8::gemm_phase<pg8::EpiSwiGLUR, pg8::StaticOrder, true, true, false, XLD, XROT>(F.lds + RING_OFF, g, S, E);
            PH_END
            PH_BEGIN(11)
                pg8::Gemm g{(const bf16*)(F.ws + WS_ACT0), (const bf16*)(F.ws + WS_WDN), M, D, DFF}; pg8::StaticOrder S; S.init(M, D, F.G, F.blk);
                pg8::EpiResB<false> E{XBP, XBP, nullptr};
                pg8::gemm_phase<pg8::EpiResB<false>, pg8::StaticOrder, true, true>(F.lds + RING_OFF, g, S, E);
            PH_END
        } else {
            PH_BEGIN(12)
                phase_route1(F, XBP);
                __syncthreads();
                LAS float* scr = (LAS float*)(F.lds + F.wave * 16384);
                for (int it = gw; it < CI_MOE; it += NGWV) conv_item_moe(F, it, scr);
            PH_END
            PH_BEGIN(13) phase_route2(F, XBP); PH_END
#define MOE_UP(k_, S_) do { pg8::Gemm g{(const bf16*)(F.ws + WS_XS + (size_t)(k_) * MOE_KROWS * D), (const bf16*)(F.ws + WS_MOEGU), MOE_KROWS, 2 * DFE, D / 2}; \
                    pg8::EpiSwiGLU8 E{F.ws + WS_ACT1 + (size_t)(k_) * MOE_KROWS * DFE, DFE, 1.f / (FP8_ASCALE * FP8_WSCALE), FP8_ASCALE}; \
                    pg8::gemm_phase<pg8::EpiSwiGLU8, decltype(S_), true, true, true>(F.lds + RING_OFF, g, S_, E); } while (0)
#define MOE_DOWN(k_) do { pg8::Gemm g{(const bf16*)(F.ws + WS_ACT1 + (size_t)(k_) * MOE_KROWS * DFE), (const bf16*)(F.ws + WS_MOEDN), MOE_KROWS, D, DFE / 2}; pg8::MoeOrder S; S.init(nM[k_], D / 256, F.G, F.blk, tile_e + (k_) * MOE_KTILES); \
                    pg8::EpiMoeDown E{(bf16*)(F.ws + ((k_) == 0 ? WS_Y0 : WS_Y1)), (const int*)(sm + MO_ROWTOK) + (k_) * MOE_KROWS, (const float*)(sm + MO_ROWG) + (k_) * MOE_KROWS, 1.f / (FP8_ASCALE * FP8_WSCALE)}; \
                    pg8::gemm_phase<pg8::EpiMoeDown, pg8::MoeOrder, true, true, true>(F.lds + RING_OFF, g, S, E); } while (0)
#define MOE_TABLES unsigned char* sm = F.ws + WS_SM + SM_MOE; LAS int* tile_e = (LAS int*)(F.lds + LDSCTL_OFF + 1024); \
                    for (int i_ = F.tid; i_ < 2 * MOE_KTILES; i_ += NWAVES * 64) tile_e[i_] = __hip_atomic_load((const int*)(sm + MO_TILEE) + i_, RLX_AGENT); __syncthreads(); \
                    const int nM[2] = {__builtin_amdgcn_readfirstlane(__hip_atomic_load((const int*)(sm + MO_NT), RLX_AGENT)), __builtin_amdgcn_readfirstlane(__hip_atomic_load((const int*)(sm + MO_NT) + 1, RLX_AGENT))};
            PH_BEGIN(14)
                MOE_TABLES
                pg8::MoeOrder S; S.init(nM[0], 2 * DFE / 256, F.G, F.blk, tile_e);
                MOE_UP(0, S);
            PH_END
            PH_BEGIN(15)
                MOE_TABLES
                MOE_DOWN(0);
                const int Nd = nM[0] * (D / 256), Nu = nM[1] * (2 * DFE / 256), qd = Nd / F.G, rd = Nd % F.G;
                const float T = (3.5f * (float)Nd + (float)Nu) / (float)F.G;
                float cum = 0.f; int lo_u = 0, hi_u = 0;
                for (int v = 0; v <= F.vcu; ++v) { const int w = (F.G % 8 == 0) ? (v % (F.G / 8)) * 8 + v / (F.G / 8) : v; const float cap = fmaxf(T - 3.5f * (float)(qd + (w < rd ? 1 : 0)), 0.f);
                    lo_u = (int)(cum + 0.5f); cum += cap; hi_u = (int)(cum + 0.5f); }
                if (F.vcu == F.G - 1 || hi_u > Nu) hi_u = Nu; if (lo_u > Nu) lo_u = Nu;
                lo_u = __builtin_amdgcn_readfirstlane(lo_u); hi_u = __builtin_amdgcn_readfirstlane(hi_u);
                pg8::MoeRange R; R.init(nM[1], 2 * DFE / 256, lo_u, hi_u, tile_e + MOE_KTILES);
                MOE_UP(1, R);
            PH_END
            PH_BEGIN(19)
                MOE_TABLES
                MOE_DOWN(1);
            PH_END
#undef MOE_UP
#undef MOE_DOWN
#undef MOE_TABLES
        }
    }
struct Args { const float* in[24]; float* out; unsigned char* ws; int ph_lo, ph_hi; };
__global__ void __launch_bounds__(NWAVES * 64, 2) fwd(Args args) {
    extern __shared__ __attribute__((aligned(16))) unsigned char lds[];
    Frame FK;
    FK.lds = (LAS unsigned char*)lds;
    FK.MISC = (volatile LAS unsigned*)(FK.lds + MISC_OFF);
    FK.tid = threadIdx.x; FK.lane = FK.tid & 63; FK.wave = __builtin_amdgcn_readfirstlane(FK.tid >> 6);
    FK.G = gridDim.x; FK.blk = blockIdx.x; { const int bx = blockIdx.x; FK.vcu = (FK.G % 8 == 0) ? (bx % 8) * (FK.G / 8) + bx / 8 : bx; }
    FK.ws = args.ws; FK.ctl = (gu32*)(args.ws + WS_CTL); FK.out = args.out;
    FK.in = args.in; FK.zi = 0;
    for (int u = FK.tid; u < (LDS_BYTES - LDSCTL_OFF) / 4; u += NWAVES * 64) ((LAS unsigned*)(FK.lds + LDSCTL_OFF))[u] = 0u;
    __syncthreads();
    const int lo = args.ph_lo, hi = args.ph_hi;
    XcdBarrier bar; bar.bar = (unsigned*)(FK.ctl + CW_BAR); bar.x = 0; bar.st = nullptr;
    if (hi - lo > 1) bar = xcd_barrier_post((unsigned*)(FK.ctl + CW_BAR), FK.MISC + 8);
    int ph = 0;
    PH_BEGIN(0)
        LAS float* scr = (LAS float*)(F.lds + F.wave * 16384);
        for (int it = gw; it < CI_MAIN; it += NGWV) conv_item_main(F, it, scr);
        pool_fold(F);
        __syncthreads();
        phase_norm_mix<false>(F, INP(F, IN_X), 0);
    PH_END

    layer_phases<0>(FK, ph, lo, hi, bar, lds);
    layer_phases<1>(FK, ph, lo, hi, bar, lds);
    PH_BEGIN(16) phase_norm_final(F, XBP, F.out); PH_END
#undef PH_BEGIN
#undef HB
#undef CAT
#undef SLAB
#undef GATE
#undef WL
#undef XBP
#undef PH_END
}

extern "C" void kernel_launch(void* const* d_in, const int* in_sizes, int n_in, void* d_out, int out_size, void* d_ws, size_t ws_size, hipStream_t stream) {
    static int grid = 0;
    if (grid == 0) {
        if (n_in != 24 || in_sizes[0] != M * D || out_size != M * D || ws_size < WS_END) { fprintf(stderr, "kernel_launch: built for 24 inputs, x/out of %d floats, >= %zu bytes of workspace; got n_in %d, in0 %d, out %d, ws %zu; nothing launched\n", M * D, (size_t)WS_END, n_in, n_in > 0 ? in_sizes[0] : -1, out_size, ws_size); grid = -1; return; }
        int dev = 0, cus = 0, per_cu = 0;
        if (hipGetDevice(&dev) != hipSuccess || hipDeviceGetAttribute(&cus, hipDeviceAttributeMultiprocessorCount, dev) != hipSuccess) { fprintf(stderr, "kernel_launch: hipGetDevice / hipDeviceGetAttribute failed\n"); grid = -1; return; }
        if (hipFuncSetAttribute((const void*)fwd, hipFuncAttributeMaxDynamicSharedMemorySize, LDS_BYTES) != hipSuccess) { fprintf(stderr, "kernel_launch: hipFuncSetAttribute failed\n"); grid = -1; return; }
        if (hipOccupancyMaxActiveBlocksPerMultiprocessor(&per_cu, (const void*)fwd, NWAVES * 64, LDS_BYTES) != hipSuccess || per_cu < 1)
            fprintf(stderr, "kernel_launch: note: the occupancy query reports %d workgroups per CU\n", per_cu);
        (void)hipGetLastError();
        grid = cus;
    }
    if (grid < 0) return;
    if (hipMemsetAsync((char*)d_ws + WS_CTL, 0, CTL_ZERO_BYTES, stream) != hipSuccess) { fprintf(stderr, "kernel_launch: hipMemsetAsync failed\n"); return; }
    Args a{};
    for (int i = 0; i < 24; ++i) a.in[i] = (const float*)d_in[i];
    a.out = (float*)d_out; a.ws = (unsigned char*)d_ws;
#if MK_MULTI
    for (int p = 0; p < NPH; ++p) { a.ph_lo = p; a.ph_hi = p + 1; hipLaunchKernelGGL(fwd, dim3(grid), dim3(NWAVES * 64), LDS_BYTES, stream, a); }
#else
    a.ph_lo = 0; a.ph_hi = NPH; hipLaunchKernelGGL(fwd, dim3(grid), dim3(NWAVES * 64), LDS_BYTES, stream, a);
#endif
    const hipError_t le = hipPeekAtLastError();
    if (le != hipSuccess) fprintf(stderr, "kernel_launch: launch failed: %s\n", hipGetErrorName(le));
}
```

```cpp
#include <hip/hip_runtime.h>
#include <cstdio>
#include <cstdint>
namespace pg8 {
#define PG8_LAS __attribute__((address_space(3)))
typedef unsigned short bf16_t;
typedef short bf16x8 __attribute__((ext_vector_type(8)));
typedef float f32x4 __attribute__((ext_vector_type(4)));
typedef unsigned u32x4 __attribute__((ext_vector_type(4)));
constexpr int BM = 256, BK = 64, HALF = 128, HTB = HALF * BK * 2  , STAGE_BYTES = 8 * HTB, NXCD = 8, WGM = 8;

__host__ __device__ __forceinline__ int lds_byte(int r, int c) { const int st = (r >> 4) * 2 + (c >> 5), rr = r & 15, cc = c & 31, ob = rr * 64 + cc * 2; return st * 1024 + (ob ^ (((ob >> 9) & 1) << 5)); }
__host__ __device__ __forceinline__ void stage_rc(int b, int& R, int& C) { const int st = b / 1024, sb = b % 1024, swz = sb ^ (((sb >> 9) & 1) << 5); R = (st >> 1) * 16 + swz / 64; C = (st & 1) * 32 + (swz % 64) / 2; }
__host__ __device__ __forceinline__ int perm32(int rho) { const int n = rho >> 4, i = rho & 15; return 8 * (i >> 2) + 4 * n + (i & 3); }

struct Unit { int pm, pn, pb; };
struct Gemm { const bf16_t* A; const bf16_t* Bt; int M, N, K; };

struct StaticOrder {
    int nM, nN, nwg, G, c;
    __host__ __device__ void init(int M, int N, int G_, int c_) { nM = M / BM; nN = N / BM; nwg = nM * nN; G = G_; c = c_; }
    __host__ __device__ bool next(int i, Unit& u) const {
        const long L = (long)i * G + c; if (L >= nwg) return false;
        int wgid = (int)L; { const int q = nwg / NXCD, r = nwg % NXCD, xcd = wgid % NXCD, off = wgid / NXCD; wgid = (xcd < r ? xcd * (q + 1) : r * (q + 1) + (xcd - r) * q) + off; }
        const int nig = WGM * nN, gid = wgid / nig, fm = gid * WGM, gsz = (nM - fm) < WGM ? (nM - fm) : WGM;
        u.pm = fm + ((wgid % nig) % gsz); u.pn = (wgid % nig) / gsz; u.pb = u.pn; return true;
    }
    __device__ __forceinline__ void a_ready(const Unit&) const {}
    __device__ __forceinline__ void done(const Unit&) const {}
};

__device__ __forceinline__ unsigned cvt_pk_bf16(float lo, float hi) { unsigned r; asm volatile("v_cvt_pk_bf16_f32 %0, %1, %2" : "=v"(r) : "v"(lo), "v"(hi)); return r; }
__device__ __forceinline__ float sigm(float x) { return __builtin_amdgcn_rcpf(1.f + __builtin_amdgcn_exp2f(-1.4426950408889634f * x)); }
typedef int v4i_t __attribute__((ext_vector_type(4)));
typedef int v8i_t __attribute__((ext_vector_type(8)));
__device__ __forceinline__ v8i_t cat8(bf16x8 a, bf16x8 b) { return __builtin_shufflevector(__builtin_bit_cast(v4i_t, a), __builtin_bit_cast(v4i_t, b), 0, 1, 2, 3, 4, 5, 6, 7); }
__device__ __forceinline__ float clamp8(float x) { return __builtin_amdgcn_fmed3f(x, -448.f, 448.f); }
__device__ __forceinline__ unsigned pack_fp8x4(float a, float b, float c, float d) { int w = 0; w = __builtin_amdgcn_cvt_pk_fp8_f32(clamp8(a), clamp8(b), w, false); w = __builtin_amdgcn_cvt_pk_fp8_f32(clamp8(c), clamp8(d), w, true); return (unsigned)w; }
__device__ __forceinline__ float bf_lo(unsigned w) { return __uint_as_float(w << 16); }
__device__ __forceinline__ float bf_hi(unsigned w) { return __uint_as_float(w & 0xffff0000u); }

struct EpiSlab {
    static constexpr bool PERM = true, AFTER_DRAIN = false, HOOK = false;
    bf16_t* O; size_t slab_stride; int qslab; float qscale;
    __device__ __forceinline__ void operator()(const f32x4 (&acc)[2][2][4][2], const Unit& u, int wr, int wc, int fr, int fq) const {
        const int slab = u.pn >> 1; bf16_t* base = O + (size_t)slab * slab_stride; const float sc = (slab == qslab) ? qscale : 1.f;
        const int row0 = u.pm * BM + wr * 64 + fr, col0 = (u.pn & 1) * 256 + wc * 32 + 8 * fq;
#pragma unroll
        for (int ai = 0; ai < 2; ++ai)
#pragma unroll
            for (int m = 0; m < 4; ++m) { bf16_t* rowp = base + (size_t)(row0 + ai * HALF + m * 16) * 512 + col0;
#pragma unroll
                for (int bj = 0; bj < 2; ++bj) { const f32x4 v0 = acc[ai][bj][m][0] * sc, v1 = acc[ai][bj][m][1] * sc;
                    u32x4 w; w.x = cvt_pk_bf16(v0[0], v0[1]); w.y = cvt_pk_bf16(v0[2], v0[3]); w.z = cvt_pk_bf16(v1[0], v1[1]); w.w = cvt_pk_bf16(v1[2], v1[3]);
                    *(u32x4*)(rowp + bj * HALF) = w; } }
    }
};
__device__ __forceinline__ size_t gate_img(int br, int pm, int pn, int piece, int wave, int lane) { return ((((size_t)(br * 512 + pm * 4 + pn) * 16 + piece) * 8 + wave) * 64 + lane) * 8; }
typedef unsigned u32x2g __attribute__((ext_vector_type(2)));
__device__ __forceinline__ float gate_val(float x, float c) { return __builtin_fmaxf(__builtin_fmaf(__builtin_amdgcn_rcpf(1.f + __builtin_amdgcn_exp2f(x * c)), 256.f, 0.5f), 1.f); }
__device__ __forceinline__ f32x4 ub4(unsigned w) { return (f32x4){(float)(w & 0xffu), (float)((w >> 8) & 0xffu), (float)((w >> 16) & 0xffu), (float)(w >> 24)}; }
struct EpiSig {
    static constexpr bool PERM = true, AFTER_DRAIN = false, HOOK = false;
    unsigned char* O; float in_scale;
    __device__ __forceinline__ void operator()(const f32x4 (&acc)[2][2][4][2], const Unit& u, int wr, int wc, int fr, int fq) const {
        const int br = u.pn >> 2, pn = u.pn & 3, wave = wr * 4 + wc, lane = fq * 16 + fr;
#pragma unroll
        for (int ai = 0; ai < 2; ++ai)
#pragma unroll
            for (int m = 0; m < 4; ++m)
#pragma unroll
                for (int bj = 0; bj < 2; ++bj) { const f32x4 v0 = acc[ai][bj][m][0], v1 = acc[ai][bj][m][1];
                    const float c = -1.4426950408889634f * in_scale; u32x2g w; w.x = 0u; w.y = 0u;
#pragma unroll
                    for (int j = 0; j < 4; ++j) { w.x = __builtin_amdgcn_cvt_pk_u8_f32(gate_val(v0[j], c), j, w.x); w.y = __builtin_amdgcn_cvt_pk_u8_f32(gate_val(v1[j], c), j, w.y); }
                    *(u32x2g*)(O + gate_img(br, u.pm, pn, ai * 8 + m * 2 + bj, wave, lane)) = w; }
    }
};
struct EpiMerge {
    static constexpr bool PERM = true, AFTER_DRAIN = false, HOOK = true;
    const unsigned char* G; bf16_t* O;
    __device__ __forceinline__ void hook(f32x4 (&acc)[2][2][4][2], const Unit& u, int t, int wr, int wc, int fr, int fq) const {
        const int i = (t >> 3) - 1; int lane = fq * 16 + fr; const int wave = wr * 4 + wc;
        asm volatile("" : "+v"(lane));
#pragma unroll
        for (int ai = 0; ai < 2; ++ai) {
            u32x2g ga[4][2], gb[4][2];
#pragma unroll
            for (int m = 0; m < 4; ++m)
#pragma unroll
                for (int bj = 0; bj < 2; ++bj) { ga[m][bj] = *(const u32x2g*)(G + gate_img(i, u.pm, u.pn, ai * 8 + m * 2 + bj, wave, lane)); gb[m][bj] = *(const u32x2g*)(G + gate_img(i + 1, u.pm, u.pn, ai * 8 + m * 2 + bj, wave, lane)); }
            __builtin_amdgcn_sched_barrier(0);
#pragma unroll
            for (int m = 0; m < 4; ++m)
#pragma unroll
                for (int bj = 0; bj < 2; ++bj) { const f32x4 a0 = ub4(ga[m][bj].x), a1 = ub4(ga[m][bj].y), b0 = ub4(gb[m][bj].x), b1 = ub4(gb[m][bj].y);
                    f32x4 r0, r1;
#pragma unroll
                    for (int j = 0; j < 4; ++j) { r0[j] = a0[j] * __builtin_amdgcn_rcpf(b0[j]); r1[j] = a1[j] * __builtin_amdgcn_rcpf(b1[j]); }
                    acc[ai][bj][m][0] *= r0; acc[ai][bj][m][1] *= r1; }
            __builtin_amdgcn_sched_barrier(0);
        }
    }
    __device__ __forceinline__ void operator()(const f32x4 (&acc)[2][2][4][2], const Unit& u, int wr, int wc, int fr, int fq) const {
        const int row0 = u.pm * BM + wr * 64 + fr, col0 = u.pn * BM + wc * 32 + 8 * fq, lane = fq * 16 + fr, wave = wr * 4 + wc;
        u32x2g g[2][4][2];
#pragma unroll
        for (int ai = 0; ai < 2; ++ai)
#pragma unroll
            for (int m = 0; m < 4; ++m)
#pragma unroll
                for (int bj = 0; bj < 2; ++bj) g[ai][m][bj] = *(const u32x2g*)(G + gate_img(2, u.pm, u.pn, ai * 8 + m * 2 + bj, wave, lane));
        __builtin_amdgcn_sched_barrier(0);
#pragma unroll
        for (int ai = 0; ai < 2; ++ai)
#pragma unroll
            for (int m = 0; m < 4; ++m) { const size_t off = (size_t)(row0 + ai * HALF + m * 16) * 1024 + col0;
#pragma unroll
                for (int bj = 0; bj < 2; ++bj) { const f32x4 g0 = ub4(g[ai][m][bj].x) * (1.f / 256.f), g1 = ub4(g[ai][m][bj].y) * (1.f / 256.f); const f32x4 v0 = acc[ai][bj][m][0] * g0, v1 = acc[ai][bj][m][1] * g1;
                    u32x4 w; w.x = cvt_pk_bf16(v0[0], v0[1]); w.y = cvt_pk_bf16(v0[2], v0[3]); w.z = cvt_pk_bf16(v1[0], v1[1]); w.w = cvt_pk_bf16(v1[2], v1[3]);
                    *(u32x4*)(O + off + bj * HALF) = w; } }
    }
};
struct EpiRes {
    static constexpr bool PERM = false, AFTER_DRAIN = false, HOOK = false;
    const float* base; float* out; int ldc; float in_scale = 1.f;
    __device__ __forceinline__ void operator()(const f32x4 (&acc)[2][2][4][2], const Unit& u, int wr, int wc, int fr, int fq) const {
        const int row0 = u.pm * BM + wr * 64 + fr, col0 = u.pn * BM + wc * 32 + 4 * fq;
#pragma unroll
        for (int ai = 0; ai < 2; ++ai) {
            f32x4 bs[4][2][2];
#pragma unroll
            for (int m = 0; m < 4; ++m)
#pragma unroll
                for (int bj = 0; bj < 2; ++bj)
#pragma unroll
                    for (int n = 0; n < 2; ++n) bs[m][bj][n] = *(const f32x4*)(base + (size_t)(row0 + ai * HALF + m * 16) * ldc + col0 + bj * HALF + n * 16);
            __builtin_amdgcn_sched_barrier(0);
#pragma unroll
            for (int m = 0; m < 4; ++m)
#pragma unroll
                for (int bj = 0; bj < 2; ++bj)
#pragma unroll
                    for (int n = 0; n < 2; ++n) *(f32x4*)(out + (size_t)(row0 + ai * HALF + m * 16) * ldc + col0 + bj * HALF + n * 16) = bs[m][bj][n] + acc[ai][bj][m][n] * in_scale;
            __builtin_amdgcn_sched_barrier(0);
        }
    }
};
template <bool BASE_F32> struct EpiResB {
    static constexpr bool PERM = true, AFTER_DRAIN = false, HOOK = false;
    static constexpr int XLD = 2048, XROT = 16;
    const void* base; bf16_t* out; float* ssq_part;
    __device__ __forceinline__ void operator()(const f32x4 (&acc)[2][2][4][2], const Unit& u, int wr, int wc, int fr, int fq) const {
        const int row0 = u.pm * BM + wr * 64 + fr, col0 = u.pn * BM + wc * 32 + 8 * fq;
#pragma unroll
        for (int ai = 0; ai < 2; ++ai) {
            f32x4 b0[4][2], b1[4][2];
            if constexpr (BASE_F32) {
#pragma unroll
                for (int m = 0; m < 4; ++m)
#pragma unroll
                    for (int bj = 0; bj < 2; ++bj) { const float* p = (const float*)base + (size_t)(row0 + ai * HALF + m * 16) * 1024 + col0 + bj * HALF; b0[m][bj] = *(const f32x4*)p; b1[m][bj] = *(const f32x4*)(p + 4); }
            } else {
                u32x4 q[4][2];
#pragma unroll
                for (int m = 0; m < 4; ++m)
#pragma unroll
                    for (int bj = 0; bj < 2; ++bj) q[m][bj] = *(const u32x4*)((const bf16_t*)base + (size_t)(row0 + ai * HALF + m * 16) * XLD + ((row0 + m * 16) & (XROT - 1)) * 64 + col0 + bj * HALF);
                __builtin_amdgcn_sched_barrier(0);
#pragma unroll
                for (int m = 0; m < 4; ++m)
#pragma unroll
                    for (int bj = 0; bj < 2; ++bj) { b0[m][bj] = (f32x4){bf_lo(q[m][bj].x), bf_hi(q[m][bj].x), bf_lo(q[m][bj].y), bf_hi(q[m][bj].y)}; b1[m][bj] = (f32x4){bf_lo(q[m][bj].z), bf_hi(q[m][bj].z), bf_lo(q[m][bj].w), bf_hi(q[m][bj].w)}; }
            }
            __builtin_amdgcn_sched_barrier(0);
#pragma unroll
            for (int m = 0; m < 4; ++m) { float ss = 0.f;
#pragma unroll
                for (int bj = 0; bj < 2; ++bj) { const f32x4 v0 = b0[m][bj] + acc[ai][bj][m][0], v1 = b1[m][bj] + acc[ai][bj][m][1];
                    ss += ((v0[0] * v0[0] + v0[1] * v0[1]) + (v0[2] * v0[2] + v0[3] * v0[3])) + ((v1[0] * v1[0] + v1[1] * v1[1]) + (v1[2] * v1[2] + v1[3] * v1[3]));
                    u32x4 w; w.x = cvt_pk_bf16(v0[0], v0[1]); w.y = cvt_pk_bf16(v0[2], v0[3]); w.z = cvt_pk_bf16(v1[0], v1[1]); w.w = cvt_pk_bf16(v1[2], v1[3]);
                    *(u32x4*)(out + (size_t)(row0 + ai * HALF + m * 16) * XLD + ((row0 + m * 16) & (XROT - 1)) * 64 + col0 + bj * HALF) = w; }
                if (ssq_part) { ss += __shfl_xor(ss, 16); ss += __shfl_xor(ss, 32); if (fq == 0) ssq_part[(size_t)(row0 + ai * HALF + m * 16) * 16 + u.pn * 4 + wc] = ss; } }
            __builtin_amdgcn_sched_barrier(0);
        }
    }
};
struct EpiSwiGLU {
    static constexpr bool PERM = true, AFTER_DRAIN = false, HOOK = false;
    bf16_t* O; int ldc;
    __device__ __forceinline__ void operator()(const f32x4 (&acc)[2][2][4][2], const Unit& u, int wr, int wc, int fr, int fq) const {
        const int row0 = u.pm * BM + wr * 64 + fr, col0 = u.pn * HALF + wc * 32 + 8 * fq;
#pragma unroll
        for (int ai = 0; ai < 2; ++ai)
#pragma unroll
            for (int m = 0; m < 4; ++m) { f32x4 v0, v1;
#pragma unroll
                for (int j = 0; j < 4; ++j) { const float g0 = acc[ai][0][m][0][j], g1 = acc[ai][0][m][1][j]; v0[j] = g0 * sigm(g0) * acc[ai][1][m][0][j]; v1[j] = g1 * sigm(g1) * acc[ai][1][m][1][j]; }
                u32x4 w; w.x = cvt_pk_bf16(v0[0], v0[1]); w.y = cvt_pk_bf16(v0[2], v0[3]); w.z = cvt_pk_bf16(v1[0], v1[1]); w.w = cvt_pk_bf16(v1[2], v1[3]);
                *(u32x4*)(O + (size_t)(row0 + ai * HALF + m * 16) * ldc + col0) = w; }
    }
};
struct EpiSwiGLUR {
    static constexpr bool PERM = true, AFTER_DRAIN = false, HOOK = false;
    bf16_t* O; int ldc; const float* ssq_part; float inv_d, eps;
    __device__ __forceinline__ void operator()(const f32x4 (&acc)[2][2][4][2], const Unit& u, int wr, int wc, int fr, int fq) const {
        const int row0 = u.pm * BM + wr * 64 + fr, col0 = u.pn * HALF + wc * 32 + 8 * fq;
        f32x4 pp[2][4];
#pragma unroll
        for (int ai = 0; ai < 2; ++ai)
#pragma unroll
            for (int m = 0; m < 4; ++m) pp[ai][m] = *(const f32x4*)(ssq_part + (size_t)(row0 + ai * HALF + m * 16) * 16 + 4 * fq);
#pragma unroll
        for (int ai = 0; ai < 2; ++ai)
#pragma unroll
            for (int m = 0; m < 4; ++m) { float s = (pp[ai][m][0] + pp[ai][m][1]) + (pp[ai][m][2] + pp[ai][m][3]); s += __shfl_xor(s, 16); s += __shfl_xor(s, 32);
                const float rs = __builtin_amdgcn_rsqf(s * inv_d + eps); f32x4 v0, v1;
#pragma unroll
                for (int j = 0; j < 4; ++j) { const float g0 = acc[ai][0][m][0][j] * rs, g1 = acc[ai][0][m][1][j] * rs; v0[j] = g0 * sigm(g0) * (acc[ai][1][m][0][j] * rs); v1[j] = g1 * sigm(g1) * (acc[ai][1][m][1][j] * rs); }
                u32x4 w; w.x = cvt_pk_bf16(v0[0], v0[1]); w.y = cvt_pk_bf16(v0[2], v0[3]); w.z = cvt_pk_bf16(v1[0], v1[1]); w.w = cvt_pk_bf16(v1[2], v1[3]);
                *(u32x4*)(O + (size_t)(row0 + ai * HALF + m * 16) * ldc + col0) = w; }
    }
};
struct EpiSwiGLU8 {
    static constexpr bool PERM = true, AFTER_DRAIN = false, HOOK = false;
    unsigned char* O; int ldc; float in_scale, out_scale;
    __device__ __forceinline__ void operator()(const f32x4 (&acc)[2][2][4][2], const Unit& u, int wr, int wc, int fr, int fq) const {
        const int row0 = u.pm * BM + wr * 64 + fr, col0 = u.pn * HALF + wc * 32 + 8 * fq; const float c1 = in_scale * in_scale * out_scale, c2 = -1.4426950408889634f * in_scale;
#pragma unroll
        for (int ai = 0; ai < 2; ++ai)
#pragma unroll
            for (int m = 0; m < 4; ++m) { f32x4 v0, v1;
#pragma unroll
                for (int j = 0; j < 4; ++j) { const float g0 = acc[ai][0][m][0][j], g1 = acc[ai][0][m][1][j];
                    v0[j] = (g0 * acc[ai][1][m][0][j]) * __builtin_amdgcn_rcpf(1.f + __builtin_amdgcn_exp2f(g0 * c2)) * c1; v1[j] = (g1 * acc[ai][1][m][1][j]) * __builtin_amdgcn_rcpf(1.f + __builtin_amdgcn_exp2f(g1 * c2)) * c1; }
                typedef unsigned u32x2_t __attribute__((ext_vector_type(2)));
                u32x2_t w; w.x = pack_fp8x4(v0[0], v0[1], v0[2], v0[3]); w.y = pack_fp8x4(v1[0], v1[1], v1[2], v1[3]);
                *(u32x2_t*)(O + (size_t)(row0 + ai * HALF + m * 16) * ldc + col0) = w; }
    }
};
struct EpiMoeDown {
    static constexpr bool PERM = true, AFTER_DRAIN = false, HOOK = false;
    bf16_t* Y; const int* row_tok; const float* row_g; float in_scale;
    __device__ __forceinline__ void operator()(const f32x4 (&acc)[2][2][4][2], const Unit& u, int wr, int wc, int fr, int fq) const {
        const int row0 = u.pm * BM + wr * 64 + fr, col0 = u.pn * BM + wc * 32 + 8 * fq;
#pragma unroll
        for (int ai = 0; ai < 2; ++ai)
#pragma unroll
            for (int m = 0; m < 4; ++m) { const int r = row0 + ai * HALF + m * 16; const int tok = row_tok[r]; const float g = row_g[r] * in_scale;
                if (tok >= 0) { bf16_t* p = Y + (size_t)tok * 1024 + col0;
#pragma unroll
                    for (int bj = 0; bj < 2; ++bj) { const f32x4 v0 = acc[ai][bj][m][0] * g, v1 = acc[ai][bj][m][1] * g;
                        u32x4 w; w.x = cvt_pk_bf16(v0[0], v0[1]); w.y = cvt_pk_bf16(v0[2], v0[3]); w.z = cvt_pk_bf16(v1[0], v1[1]); w.w = cvt_pk_bf16(v1[2], v1[3]);
                        *(u32x4*)(p + bj * HALF) = w; } } }
    }
};
struct MoeRange {
    int nM, nN, lo, hi; const PG8_LAS int* tile_e;
    __device__ void init(int nM_, int nN_, int lo_, int hi_, const PG8_LAS int* te) { nM = nM_; nN = nN_; lo = lo_; hi = hi_; tile_e = te; }
    __device__ bool next(int i, Unit& u) const {
        const int wgid = lo + i; if (wgid >= hi) return false;
        const int nig = WGM * nN, gid = wgid / nig, fm = gid * WGM, gsz = (nM - fm) < WGM ? (nM - fm) : WGM;
        u.pm = fm + ((wgid % nig) % gsz); u.pn = (wgid % nig) / gsz;
        const int e = __builtin_amdgcn_readfirstlane(tile_e[u.pm]); u.pb = e * nN + u.pn; return true;
    }
    __device__ __forceinline__ void a_ready(const Unit&) const {}
    __device__ __forceinline__ void done(const Unit&) const {}
};
struct MoeOrderHL {
    int nM, nN, nwg, G, c, heavy, R0; const PG8_LAS int* tile_e;
    __device__ void init(int nM_, int nN_, int G_, int c_, int heavy_, float rho, const PG8_LAS int* te) { nM = nM_; nN = nN_; nwg = nM * nN; G = G_; c = c_; heavy = heavy_; tile_e = te;
        const int cpx = G / NXCD, hx = heavy / NXCD; const float r0 = ((float)(nwg / NXCD) - rho * (float)(cpx - hx)) / (float)cpx + 0.5f; R0 = r0 > 0.f ? (int)r0 : 0; if (heavy == 0) R0 = 1 << 20; }
    __device__ bool next(int i, Unit& u) const {
        const int cpx = G / NXCD, x = c % NXCD, j = c / NXCD, hx = heavy > x ? (heavy - x + NXCD - 1) / NXCD : 0;
        const int q = nwg / NXCD, r = nwg % NXCD, qx = q + (x < r ? 1 : 0), start = x < r ? x * (q + 1) : r * (q + 1) + (x - r) * q;
        int p;
        if (i < R0) p = i * cpx + j; else { if (j < hx) return false; p = R0 * cpx + (i - R0) * (cpx - hx) + (j - hx); }
        if (p >= qx) return false;
        const int wgid = start + p, nig = WGM * nN, gid = wgid / nig, fm = gid * WGM, gsz = (nM - fm) < WGM ? (nM - fm) : WGM;
        u.pm = fm + ((wgid % nig) % gsz); u.pn = (wgid % nig) / gsz;
        const int e = __builtin_amdgcn_readfirstlane(tile_e[u.pm]); u.pb = e * nN + u.pn; return true;
    }
    __device__ __forceinline__ void a_ready(const Unit&) const {}
    __device__ __forceinline__ void done(const Unit&) const {}
};
struct MoeOrder {
    int nM, nN, nwg, G, c; const PG8_LAS int* tile_e;
    __device__ void init(int nM_, int nN_, int G_, int c_, const PG8_LAS int* te) { nM = nM_; nN = nN_; nwg = nM * nN; G = G_; c = c_; tile_e = te; }
    __device__ bool next(int i, Unit& u) const {
        const long L = (long)i * G + c; if (L >= nwg) return false;
        int wgid = (int)L; { const int q = nwg / NXCD, r = nwg % NXCD, xcd = wgid % NXCD, off = wgid / NXCD; wgid = (xcd < r ? xcd * (q + 1) : r * (q + 1) + (xcd - r) * q) + off; }
        const int nig = WGM * nN, gid = wgid / nig, fm = gid * WGM, gsz = (nM - fm) < WGM ? (nM - fm) : WGM;
        u.pm = fm + ((wgid % nig) % gsz); u.pn = (wgid % nig) / gsz;
        const int e = __builtin_amdgcn_readfirstlane(tile_e[u.pm]); u.pb = e * nN + u.pn; return true;
    }
    __device__ __forceinline__ void a_ready(const Unit&) const {}
    __device__ __forceinline__ void done(const Unit&) const {}
};
template <class Epi, class Sched, bool ALIGN_EPI = false, bool SP2 = false, bool FP8 = false, int LDA = 0, int ROTA = 0>
__device__ __forceinline__ void gemm_phase(PG8_LAS unsigned char* lds, const Gemm g, const Sched& S, const Epi& E) {
    int tid_ = threadIdx.x; asm volatile("" : "+v"(tid_));
    const int tid = tid_, wid = __builtin_amdgcn_readfirstlane(tid >> 6), lane = tid & 63, wr = wid >> 2, wc = wid & 3, fr = lane & 15, fq = lane >> 4;
    const int K = g.K, nt = K / BK;
    unsigned voffA[2], voffB[2];
#pragma unroll
    for (int i = 0; i < 2; ++i) { int R, C; stage_rc(tid * 16 + i * 8192, R, C); const int Rb = Epi::PERM ? ((R & ~31) + perm32(R & 31)) : R;
        voffA[i] = (unsigned)(R * (LDA ? LDA : K) + C) * 2u + (ROTA ? (unsigned)(R & (ROTA - 1)) * 128u : 0u); voffB[i] = (unsigned)(Rb * K + C) * 2u; }
    const size_t kstep = (size_t)(BK * 2);
    const size_t hstep = (size_t)HALF * K * 2;
    const size_t tstep = 2 * hstep;
    const size_t hstepA = (size_t)HALF * (LDA ? LDA : K) * 2, tstepA = 2 * hstepA;
    const unsigned ldsw = (unsigned)wid * 1024u;
    const int aoff = lds_byte(wr * 64 + fr, fq * 8), boff = lds_byte(wc * 32 + fr, fq * 8);
#define PG8_SA(b, h) (((b) * 2 + (h)) * HTB)
#define PG8_SB(b, h) ((4 + (b) * 2 + (h)) * HTB)
#define PG8_STAGE(bufoff, gbase, voff) do { _Pragma("unroll") for (int _i = 0; _i < 2; ++_i) \
        __builtin_amdgcn_global_load_lds((const unsigned*)((const char*)(gbase) + (voff)[_i]), (PG8_LAS unsigned*)(lds + (bufoff) + ldsw + _i * 8192), 16, 0, 0); } while (0)
#define PG8_LDA(dst, b, h) do { _Pragma("unroll") for (int m = 0; m < 4; ++m) _Pragma("unroll") for (int k = 0; k < 2; ++k) dst[m][k] = *(const PG8_LAS bf16x8*)(lds + PG8_SA(b, h) + aoff + m * 2048 + k * 1024); } while (0)
#define PG8_LDB(dst, b, h) do { _Pragma("unroll") for (int n = 0; n < 2; ++n) _Pragma("unroll") for (int k = 0; k < 2; ++k) dst[n][k] = *(const PG8_LAS bf16x8*)(lds + PG8_SB(b, h) + boff + n * 2048 + k * 1024); } while (0)
#define PG8_MMA(ai, bj, At, Bt) do { __builtin_amdgcn_s_setprio(1); \
        if constexpr (FP8) { _Pragma("unroll") for (int m = 0; m < 4; ++m) _Pragma("unroll") for (int n = 0; n < 2; ++n) \
            asm volatile("v_mfma_f32_16x16x128_f8f6f4 %0, %1, %2, %0" : "+v"(acc[ai][bj][m][n]) : "v"(cat8(Bt[n][0], Bt[n][1])), "v"(cat8(At[m][0], At[m][1]))); } \
        else { _Pragma("unroll") for (int m = 0; m < 4; ++m) _Pragma("unroll") for (int n = 0; n < 2; ++n) _Pragma("unroll") for (int k = 0; k < 2; ++k) \
            acc[ai][bj][m][n] = __builtin_amdgcn_mfma_f32_16x16x32_bf16(Bt[n][k], At[m][k], acc[ai][bj][m][n], 0, 0, 0); } \
        __builtin_amdgcn_s_setprio(0); } while (0)
#define PG8_WAIT_V(n) asm volatile("s_waitcnt vmcnt(" #n ")" ::: "memory")
#define PG8_WAIT_L(n) asm volatile("s_waitcnt lgkmcnt(" #n ")" ::: "memory")
#define PG8_BAR __builtin_amdgcn_s_barrier()
#define PG8_SCHED __builtin_amdgcn_sched_barrier(0)
    Unit cur, nxt; int ui = 0;
    if (!S.next(0, cur)) return;
    f32x4 acc[2][2][4][2];
#pragma unroll
    for (int a = 0; a < 2; ++a)
#pragma unroll
        for (int b = 0; b < 2; ++b)
#pragma unroll
            for (int m = 0; m < 4; ++m)
#pragma unroll
                for (int n = 0; n < 2; ++n) acc[a][b][m][n] = (f32x4){0.f, 0.f, 0.f, 0.f};
    bf16x8 At[4][2], B0[2][2], B1[2][2];
    const char* cA = (const char*)g.A + (size_t)cur.pm * tstepA; const char* cB = (const char*)g.Bt + (size_t)cur.pb * tstep;
    S.a_ready(cur);
    if constexpr (SP2) {
        PG8_STAGE(PG8_SB(0, 0), cB, voffB); PG8_STAGE(PG8_SB(0, 1), cB + hstep, voffB); PG8_STAGE(PG8_SA(0, 0), cA, voffA); PG8_STAGE(PG8_SA(0, 1), cA + hstepA, voffA);
        if (wr == 1) PG8_BAR;
        PG8_WAIT_V(2); PG8_BAR;
        PG8_STAGE(PG8_SB(1, 0), cB + kstep, voffB); PG8_STAGE(PG8_SA(1, 0), cA + kstep, voffA); PG8_STAGE(PG8_SB(1, 1), cB + hstep + kstep, voffB);
        PG8_WAIT_V(6); PG8_BAR;
    } else {
        PG8_STAGE(PG8_SB(0, 0), cB, voffB); PG8_STAGE(PG8_SA(0, 0), cA, voffA); PG8_STAGE(PG8_SB(0, 1), cB + hstep, voffB); PG8_STAGE(PG8_SA(0, 1), cA + hstepA, voffA);
        if (wr == 1) PG8_BAR;
        PG8_WAIT_V(4); PG8_BAR;
        PG8_STAGE(PG8_SB(1, 0), cB + kstep, voffB); PG8_STAGE(PG8_SA(1, 0), cA + kstep, voffA); PG8_STAGE(PG8_SB(1, 1), cB + hstep + kstep, voffB);
        PG8_WAIT_V(6); PG8_BAR;
    }
    for (;;) {
        const bool has_next = S.next(ui + 1, nxt);
        const char* nA = has_next ? (const char*)g.A + (size_t)nxt.pm * tstepA : cA; const char* nB = has_next ? (const char*)g.Bt + (size_t)nxt.pb * tstep : cB;
        for (int t = 0; t < nt; t += 2) {
            if constexpr (Epi::HOOK) { if (t == 8 || t == 16) E.hook(acc, cur, t, wr, wc, fr, fq); }
            const bool last = (t == nt - 2);
            const char* a1 = cA + (size_t)(t + 1) * kstep;
            const char* a2 = last ? nA : cA + (size_t)(t + 2) * kstep; const char* b2 = last ? nB : cB + (size_t)(t + 2) * kstep;
            const char* a3 = a2 + kstep; const char* b3 = b2 + kstep;
            if (last && has_next) S.a_ready(nxt);
            if constexpr (SP2) {
            PG8_LDB(B0, 0, 0); PG8_LDB(B1, 0, 1); PG8_SCHED; PG8_LDA(At, 0, 0); PG8_STAGE(PG8_SA(1, 1), a1 + hstepA, voffA);
            PG8_WAIT_V(8); PG8_WAIT_L(0); PG8_BAR; PG8_MMA(0, 0, At, B0); PG8_MMA(0, 1, At, B1); PG8_BAR; PG8_SCHED;
            PG8_LDA(At, 0, 1); PG8_STAGE(PG8_SB(0, 0), b2, voffB); PG8_STAGE(PG8_SB(0, 1), b2 + hstep, voffB); PG8_STAGE(PG8_SA(0, 0), a2, voffA);
            PG8_WAIT_V(8); PG8_WAIT_L(0); PG8_BAR; PG8_MMA(1, 0, At, B0); PG8_MMA(1, 1, At, B1); PG8_BAR; PG8_SCHED;
            PG8_LDB(B0, 1, 0); PG8_LDB(B1, 1, 1); PG8_SCHED; PG8_LDA(At, 1, 0); PG8_STAGE(PG8_SA(0, 1), a2 + hstepA, voffA);
            PG8_WAIT_V(8); PG8_WAIT_L(0); PG8_BAR; PG8_MMA(0, 0, At, B0); PG8_MMA(0, 1, At, B1); PG8_BAR; PG8_SCHED;
            PG8_LDA(At, 1, 1); PG8_STAGE(PG8_SB(1, 0), b3, voffB); PG8_STAGE(PG8_SB(1, 1), b3 + hstep, voffB); PG8_STAGE(PG8_SA(1, 0), a3, voffA);
            PG8_WAIT_V(8); PG8_WAIT_L(0); PG8_BAR; PG8_MMA(1, 0, At, B0); PG8_MMA(1, 1, At, B1); PG8_BAR; PG8_SCHED;
            } else {
            PG8_LDB(B0, 0, 0); PG8_SCHED; PG8_LDA(At, 0, 0); PG8_STAGE(PG8_SA(1, 1), a1 + hstepA, voffA);
            PG8_WAIT_L(8); PG8_BAR; PG8_WAIT_L(0); PG8_MMA(0, 0, At, B0); PG8_BAR; PG8_SCHED;
            PG8_LDB(B1, 0, 1); PG8_STAGE(PG8_SB(0, 0), b2, voffB);
            PG8_BAR; PG8_WAIT_L(0); PG8_MMA(0, 1, At, B1); PG8_BAR;
            PG8_LDA(At, 0, 1); PG8_STAGE(PG8_SA(0, 0), a2, voffA);
            PG8_BAR; PG8_WAIT_L(0); PG8_MMA(1, 0, At, B0); PG8_BAR; PG8_SCHED;
            PG8_STAGE(PG8_SB(0, 1), b2 + hstep, voffB);
            PG8_WAIT_V(6); PG8_BAR; PG8_MMA(1, 1, At, B1); PG8_BAR;
            PG8_LDB(B0, 1, 0); PG8_SCHED; PG8_LDA(At, 1, 0); PG8_STAGE(PG8_SA(0, 1), a2 + hstepA, voffA);
            PG8_WAIT_L(8); PG8_BAR; PG8_WAIT_L(0); PG8_MMA(0, 0, At, B0); PG8_BAR; PG8_SCHED;
            PG8_LDB(B1, 1, 1); PG8_STAGE(PG8_SB(1, 0), b3, voffB);
            PG8_BAR; PG8_WAIT_L(0); PG8_MMA(0, 1, At, B1); PG8_BAR;
            PG8_LDA(At, 1, 1); PG8_STAGE(PG8_SA(1, 0), a3, voffA);
            PG8_BAR; PG8_WAIT_L(0); PG8_MMA(1, 0, At, B0); PG8_BAR; PG8_SCHED;
            PG8_STAGE(PG8_SB(1, 1), b3 + hstep, voffB);
            PG8_WAIT_V(6); PG8_BAR; PG8_MMA(1, 1, At, B1); PG8_BAR;
            }
        }
        if constexpr (ALIGN_EPI) { if (wr == 0) PG8_BAR; }
        if constexpr (FP8) {
            asm volatile("s_nop 15\n\ts_nop 15" : "+v"(acc[0][0][0][0]), "+v"(acc[0][0][0][1]), "+v"(acc[0][0][1][0]), "+v"(acc[0][0][1][1]), "+v"(acc[0][0][2][0]), "+v"(acc[0][0][2][1]), "+v"(acc[0][0][3][0]), "+v"(acc[0][0][3][1]));
            asm volatile("" : "+v"(acc[0][1][0][0]), "+v"(acc[0][1][0][1]), "+v"(acc[0][1][1][0]), "+v"(acc[0][1][1][1]), "+v"(acc[0][1][2][0]), "+v"(acc[0][1][2][1]), "+v"(acc[0][1][3][0]), "+v"(acc[0][1][3][1]));
            asm volatile("" : "+v"(acc[1][0][0][0]), "+v"(acc[1][0][0][1]), "+v"(acc[1][0][1][0]), "+v"(acc[1][0][1][1]), "+v"(acc[1][0][2][0]), "+v"(acc[1][0][2][1]), "+v"(acc[1][0][3][0]), "+v"(acc[1][0][3][1]));
            asm volatile("" : "+v"(acc[1][1][0][0]), "+v"(acc[1][1][0][1]), "+v"(acc[1][1][1][0]), "+v"(acc[1][1][1][1]), "+v"(acc[1][1][2][0]), "+v"(acc[1][1][2][1]), "+v"(acc[1][1][3][0]), "+v"(acc[1][1][3][1])); }
        if constexpr (!Epi::AFTER_DRAIN) { E(acc, cur, wr, wc, fr, fq); S.done(cur); }
        if (!has_next) break;
#pragma unroll
        for (int a = 0; a < 2; ++a)
#pragma unroll
            for (int b = 0; b < 2; ++b)
#pragma unroll
                for (int m = 0; m < 4; ++m)
#pragma unroll
                    for (int n = 0; n < 2; ++n) acc[a][b][m][n] = (f32x4){0.f, 0.f, 0.f, 0.f};
        cur = nxt; cA = nA; cB = nB; ++ui;
        if constexpr (ALIGN_EPI) { if (wr == 1) PG8_BAR; }
    }
    PG8_WAIT_V(0);
    if constexpr (!ALIGN_EPI) { if (wr == 0) PG8_BAR; }
    PG8_BAR;
    if constexpr (Epi::AFTER_DRAIN) { E.fused(acc, cur, wr, wc, fr, fq, lds, wid, lane); S.done(cur); }
#undef PG8_SA
#undef PG8_SB
#undef PG8_STAGE
#undef PG8_LDA
#undef PG8_LDB
#undef PG8_MMA
#undef PG8_WAIT_V
#undef PG8_WAIT_L
#undef PG8_BAR
#undef PG8_SCHED
}
}
#include <hip/hip_bf16.h>
#include <cmath>
namespace attn_body {
using bf16=__hip_bfloat16;
using bf16x8=__attribute__((ext_vector_type(8)))short;
using s16x4=__attribute__((ext_vector_type(4)))short;
using f32x16=__attribute__((ext_vector_type(16)))float;
using u32x4=__attribute__((ext_vector_type(4)))unsigned;
constexpr int BATCH=4,NHEAD=8,SEQ=8192,D=64,DM=NHEAD*D,DMO=1536,OCOL=1024;
constexpr int NW=8,QBLK=32,QB=QBLK*NW,KVBLK=64,NQB=SEQ/QB;
constexpr int ATTN_PITCH=DM, ATTN_UNIT_ROWS=QB;
__device__ __forceinline__ int crow(int r,int hi){return (r&3)+8*(r>>2)+4*hi;}
#define SBAR() __builtin_amdgcn_sched_barrier(0)
__device__ __forceinline__ void cmask(f32x16&p0,f32x16&p1,int jb,int qrel,int hi){
  const float NEG=-INFINITY; int kb=64*jb+4*hi;
  #pragma unroll
  for(int r=0;r<16;++r){int kv=kb+(r&3)+8*(r>>2); if(kv>qrel)p0[r]=NEG; if(kv+32>qrel)p1[r]=NEG;}
}

constexpr int NSLOT=3, SLOTB=8192;
constexpr int LDS_K=0, LDS_V=NSLOT*SLOTB, LDS_WS=2*NSLOT*SLOTB, LDS_OST=LDS_WS+NW*64*4, LDS_NB=LDS_OST+NW*4096, LDS_BYTES=LDS_NB+SEQ*4;
constexpr float C2=0.125f*1.4426950408889634f;
__device__ __forceinline__ void glds16(const void*gsrc,unsigned lds_dst){unsigned keep;
  asm volatile("s_mov_b32 %0, m0\n\ts_mov_b32 m0, %2\n\ts_nop 0\n\tglobal_load_lds_dwordx4 %1, off\n\ts_mov_b32 m0, %0":"=&s"(keep):"v"(gsrc),"s"(lds_dst):"memory");}
__device__ __forceinline__ float max3f(float a,float b,float c){float r;asm("v_max3_f32 %0, %1, %2, %3":"=v"(r):"v"(a),"v"(b),"v"(c));return r;}
__device__ __forceinline__ float max2f(float a,float b){float r;asm("v_max_f32_e32 %0, %1, %2":"=v"(r):"v"(a),"v"(b));return r;}
__device__ __forceinline__ float fadd_s(float a,float b){float r;asm("v_add_f32_e32 %0, %1, %2":"=v"(r):"v"(a),"v"(b));return r;}
__device__ __forceinline__ float fsub_s(float a,float b){float r;asm("v_sub_f32_e32 %0, %1, %2":"=v"(r):"v"(a),"v"(b));return r;}
typedef float f32x2_t __attribute__((ext_vector_type(2))); typedef __bf16 bf16x2_t __attribute__((ext_vector_type(2)));
__device__ __forceinline__ unsigned cvtpk_s(float lo,float hi){f32x2_t v={lo,hi};bf16x2_t b=__builtin_convertvector(v,bf16x2_t);return __builtin_bit_cast(unsigned,b);}
#define WAIT_BAR(N) asm volatile("s_waitcnt vmcnt(" #N ") lgkmcnt(0)\n\ts_barrier":::"memory")

__device__ __forceinline__ void qkt(f32x16&p0,f32x16&p1,const char*Kslot,const bf16x8*qr,int r32,int hi){
  const char*kb=Kslot+hi*1024+r32*16;
  #pragma unroll
  for(int d0=0;d0<4;++d0){
    const bf16x8 b0=*reinterpret_cast<const bf16x8*>(kb+d0*2048);
    const bf16x8 b1=*reinterpret_cast<const bf16x8*>(kb+d0*2048+512);
    p0=__builtin_amdgcn_mfma_f32_32x32x16_bf16(b0,qr[d0],p0,0,0,0);p1=__builtin_amdgcn_mfma_f32_32x32x16_bf16(b1,qr[d0],p1,0,0,0);}
}
typedef __attribute__((address_space(3))) const char* lds_cptr;
typedef short v4i16_t __attribute__((ext_vector_type(4)));
__device__ __forceinline__ void kload8(bf16x8*kf,lds_cptr kp){
  kf[0]=*(const __attribute__((address_space(3))) bf16x8*)(kp);      kf[1]=*(const __attribute__((address_space(3))) bf16x8*)(kp+512);
  kf[2]=*(const __attribute__((address_space(3))) bf16x8*)(kp+2048); kf[3]=*(const __attribute__((address_space(3))) bf16x8*)(kp+2560);
  kf[4]=*(const __attribute__((address_space(3))) bf16x8*)(kp+4096); kf[5]=*(const __attribute__((address_space(3))) bf16x8*)(kp+4608);
  kf[6]=*(const __attribute__((address_space(3))) bf16x8*)(kp+6144); kf[7]=*(const __attribute__((address_space(3))) bf16x8*)(kp+6656);
}
__device__ __forceinline__ void kload2(bf16x8*kf,lds_cptr kp,int j){ kf[2*j]=*(const __attribute__((address_space(3))) bf16x8*)(kp+j*2048); kf[2*j+1]=*(const __attribute__((address_space(3))) bf16x8*)(kp+j*2048+512); }
__device__ __forceinline__ s16x4 vtr(lds_cptr p){ return __builtin_bit_cast(s16x4,__builtin_amdgcn_ds_read_tr16_b64_v4i16((__attribute__((address_space(3))) v4i16_t*)p)); }
__device__ __forceinline__ float rowmax(const f32x16&p0,const f32x16&p1){
  float a=max3f(p0[0],p0[1],p1[0]),b=max3f(p0[2],p0[3],p1[1]);a=max3f(a,p1[2],p1[3]);
  #pragma unroll
  for(int r=4;r<16;r+=4){a=max3f(a,p0[r],p0[r+1]);b=max3f(b,p0[r+2],p0[r+3]);a=max3f(a,p1[r],p1[r+1]);b=max3f(b,p1[r+2],p1[r+3]);}
  const float m=max2f(a,b);
  auto rr=__builtin_amdgcn_permlane32_swap(__float_as_uint(m),__float_as_uint(m),false,false);
  return max2f(__uint_as_float(rr[0]),__uint_as_float(rr[1]));
}
__device__ __forceinline__ void pv(f32x16*o,int vb,bf16x8 pa0,bf16x8 pa1,bf16x8 pa2,bf16x8 pa3){
  #pragma unroll
  for(int d0=0;d0<2;++d0){s16x4 lo[4],hi[4];
    #pragma unroll
    for(int ks=0;ks<4;++ks){
      asm volatile("ds_read_b64_tr_b16 %0,%1 offset:%c2":"=&v"(lo[ks]):"v"(vb),"i"(d0*4096+ks*1024):"memory");
      asm volatile("ds_read_b64_tr_b16 %0,%1 offset:%c2":"=&v"(hi[ks]):"v"(vb),"i"(d0*4096+ks*1024+512):"memory");}
    asm volatile("s_waitcnt lgkmcnt(0)":::"memory");SBAR();
    #define PK(k) (bf16x8){lo[k][0],lo[k][1],lo[k][2],lo[k][3],hi[k][0],hi[k][1],hi[k][2],hi[k][3]}
    o[d0]=__builtin_amdgcn_mfma_f32_32x32x16_bf16(pa0,PK(0),o[d0],0,0,0);
    o[d0]=__builtin_amdgcn_mfma_f32_32x32x16_bf16(pa1,PK(1),o[d0],0,0,0);
    o[d0]=__builtin_amdgcn_mfma_f32_32x32x16_bf16(pa2,PK(2),o[d0],0,0,0);
    o[d0]=__builtin_amdgcn_mfma_f32_32x32x16_bf16(pa3,PK(3),o[d0],0,0,0);
    #undef PK
  }
}

#ifndef ATTN_STORE16
#define ATTN_STORE16(p,v) (*(u32x4*)(p)=(v))
#endif
typedef float f32x4v __attribute__((ext_vector_type(4)));
__device__ __forceinline__ int attn_t0(int qb,const float*__restrict__ nbg,const float*__restrict__ qnw,const float*__restrict__ knw,const float*__restrict__ xmw,int lane){
  const int q0=qb*QB; float qn=0.f,kn=0.f,xm=3.0e38f; if(lane<8){qn=qnw[qb*8+lane];xm=xmw[qb*8+lane];}
  _Pragma("unroll") for(int i=0;i<4;++i){const int idx=lane*4+i; if(idx<(qb+1)*8)kn=__builtin_fmaxf(kn,knw[idx]);}
  _Pragma("unroll") for(int o_=1;o_<64;o_<<=1){qn=__builtin_fmaxf(qn,__shfl_xor(qn,o_));kn=__builtin_fmaxf(kn,__shfl_xor(kn,o_));xm=__builtin_fminf(xm,__shfl_xor(xm,o_));}
  const float thr=56.f+sqrtf(qn*kn)-xm; const int NT0=(q0+QB)/KVBLK;
  bool c_=(lane>=1)&&(2*lane<=NT0-4); float d_=0.f; if(c_)d_=nbg[128*lane-1]-nbg[q0]; c_=c_&&(d_<=-thr);
  return __builtin_amdgcn_readfirstlane(2*(int)__popcll(__ballot(c_)));
}
template<int THRL> __device__ __forceinline__ void attn_unit(int b,int h,int qb,const bf16*Q,const bf16*__restrict__ K,const bf16*__restrict__ V,bf16*O,const float*__restrict__ nbg,const int t0,char*shm){
  int tid_=threadIdx.x; asm volatile("":"+v"(tid_));
  const int tid=tid_,lane=tid&63,r32=lane&31,hi=lane>>5; const int wid=__builtin_amdgcn_readfirstlane(tid>>6);
  const long rowbase=(long)b*SEQ; const int q0=qb*QB;
  const bf16*Qw=Q+(rowbase+q0+wid*QBLK)*DM+h*D;
  const bf16*Kh=K+(rowbase+(long)t0*KVBLK)*DM+h*D,*Vh=V+(rowbase+(long)t0*KVBLK)*DM+h*D;
  const unsigned lds0=(unsigned)(uintptr_t)shm;
  float*wsf=(float*)(shm+LDS_WS)+wid*64;
  const bf16*ksrc=Kh+(long)lane*DM+wid*8;
  const bf16*vsrc=Vh+(long)(16*(wid&3)+(lane>>2))*DM+(wid>>2)*32+(lane&3)*8;
  const unsigned kdst=lds0+LDS_K+wid*1024, vdst=lds0+LDS_V+wid*1024;
  #define DMA_K(t,slot) glds16(ksrc+(long)(t)*KVBLK*DM,(unsigned)__builtin_amdgcn_readfirstlane(kdst+(slot)))
  #define DMA_V(t,slot) glds16(vsrc+(long)(t)*KVBLK*DM,(unsigned)__builtin_amdgcn_readfirstlane(vdst+(slot)))
  const int vb0=(int)(lds0+LDS_V)+((lane>>4)&1)*32+(lane&3)*8+(4*hi+((lane&15)>>2))*64;
  const char*Kbase=shm+LDS_K; bf16x8 kf[8];
  const lds_cptr shm3=(lds_cptr)shm; const lds_cptr kp0=shm3+LDS_K+hi*1024+r32*16; const lds_cptr vp0=shm3+LDS_V+((lane>>4)&1)*32+(lane&3)*8+(4*hi+((lane&15)>>2))*64;
  const int NT=(q0+QB)/KVBLK-t0;
  typedef __attribute__((address_space(3))) float* lds_fptr;
  const lds_fptr nbl3=(lds_fptr)(shm3+LDS_NB);
  const lds_fptr nbl3o=nbl3+t0*KVBLK;
  DMA_K(0,0);DMA_V(0,0);DMA_K(1,SLOTB);
  { const float ref=nbg[q0+QB-1]; for(int j=t0*KVBLK+tid;j<q0+QB;j+=NW*64) nbl3[j]=nbg[j]-ref; }
  bf16x8 qr[4];
  #pragma unroll
  for(int d0=0;d0<4;++d0)qr[d0]=*reinterpret_cast<const bf16x8*>(&Qw[(long)r32*DM+d0*16+hi*8]);
  float mhat=0.f,l_reg=0.f;f32x16 o[2];o[0]=f32x16{};o[1]=f32x16{};
  const int qrel=wid*QBLK+r32;
  #define CMASK(P0,P1,t) do{int jb_=(t)-(NT-4); if(jb_>=0)cmask(P0,P1,jb_,qrel,hi);}while(0)
  bool resc=false;
  #define START(P0,P1) do{ const float rm=rowmax(P0,P1); resc=false; \
    if(__any(rm>(float)THRL)){ const float dl=__builtin_fmaxf(rm,0.f); mhat=fadd_s(mhat,dl); \
      _Pragma("unroll") for(int r=0;r<16;++r){P0[r]=fsub_s(P0[r],dl);P1[r]=fsub_s(P1[r],dl);} } \
    _Pragma("unroll") for(int r=0;r<16;++r)P0[r]=__builtin_amdgcn_exp2f(P0[r]); }while(0)
  #define BIAS(P0,P1,t) do{ const lds_fptr nbp_=nbl3o+64*(t)+4*hi; \
    _Pragma("unroll") for(int q_=0;q_<4;++q_){ const f32x4v b0_=*(const __attribute__((address_space(3))) f32x4v*)(nbp_+8*q_), b1_=*(const __attribute__((address_space(3))) f32x4v*)(nbp_+32+8*q_); \
      _Pragma("unroll") for(int i_=0;i_<4;++i_){ P0[4*q_+i_]=b0_[i_]-mhat; P1[4*q_+i_]=b1_[i_]-mhat; } } }while(0)
  #define RESC() do{ if(resc){ asm volatile("s_waitcnt lgkmcnt(0)":::"memory"); \
      _Pragma("unroll") for(int d_=0;d_<2;++d_) _Pragma("unroll") for(int r=0;r<16;++r)o[d_][r]*=wsf[crow(r,hi)]; } }while(0)
  f32x16 pA0,pA1,pB0,pB1;
  int sl_prev=0,sl_cur=0,sl_next=SLOTB;
  #define ROT() do{sl_prev=sl_cur;sl_cur=sl_next;sl_next=(sl_next==(NSLOT-1)*SLOTB)?0:sl_next+SLOTB;}while(0)
  DMA_K(2,2*SLOTB);
  WAIT_BAR(3);
  mhat=nbl3[q0+qrel];
  BIAS(pA0,pA1,0);qkt(pA0,pA1,Kbase,qr,r32,hi);asm volatile("s_nop 15\n\ts_nop 7":"+v"(pA0),"+v"(pA1));CMASK(pA0,pA1,0);
  START(pA0,pA1);
  _Pragma("unroll") for(int r=0;r<16;++r)pA1[r]=__builtin_amdgcn_exp2f(pA1[r]);
  WAIT_BAR(0);
  DMA_K(3,0);DMA_V(1,SLOTB);
  ROT();
  kload8(kf,kp0+sl_cur);
  WAIT_BAR(2);
  s16x4 vlo[8],vhi[8]; u32x4 pw0,pw1,pw2,pw3;
  #define PKW(P,B) cvtpk_s(P[B],P[B+1])
  #define PAF(k) __builtin_bit_cast(bf16x8,pw##k)
  #define VFR(i) (bf16x8){vlo[i][0],vlo[i][1],vlo[i][2],vlo[i][3],vhi[i][0],vhi[i][1],vhi[i][2],vhi[i][3]}
  #define PIN(x) asm volatile("":"+v"(x))
  #define MX3(a,b,c) __builtin_fmaxf(__builtin_fmaxf((a),(b)),(c))
  #define GAPA(MF,A0,A1,A2,A3,W0,W1,PW) do{ MF; sacc+=A0; sacc+=A1; sacc+=A2; sacc+=A3; PIN(sacc); W0; W1; PIN(PW); SBAR(); }while(0)
  #define EX(v) __builtin_amdgcn_exp2f(v)
  #define GAPB(MF,X,B) do{ MF; X[B]=EX(X[B]); X[B+1]=EX(X[B+1]); X[B+2]=EX(X[B+2]); X[B+3]=EX(X[B+3]); PIN(X); SBAR(); }while(0)
  #define VRD(i) do{ vlo[i]=vtr(vp_+(((i)>>2)*4096+((i)&3)*1024)); vhi[i]=vtr(vp_+(((i)>>2)*4096+((i)&3)*1024+512)); }while(0)
  #define KRD(G,j) do{ if(G){ kload2(kf,kp0+sl_next,j); SBAR(); } }while(0)
  #define STEP(C0,C1,P0,P1,t,GK,GV,GL) do{ SBAR(); \
    const lds_cptr vp_=vp0+sl_prev; \
    BIAS(C0,C1,t); SBAR(); \
    VRD(0); SBAR(); float sacc=(P0[0]+P0[1]); \
    GAPA(C0=__builtin_amdgcn_mfma_f32_32x32x16_bf16(kf[0],qr[0],C0,0,0,0), P0[2],P0[3],P0[4],P0[5],     pw0[0]=PKW(P0,0), pw0[1]=PKW(P0,2), pw0); \
    VRD(4); SBAR(); GAPA(C1=__builtin_amdgcn_mfma_f32_32x32x16_bf16(kf[1],qr[0],C1,0,0,0), P0[6],P0[7],P0[8],P0[9],     pw0[2]=PKW(P0,4), pw0[3]=PKW(P0,6), pw0); \
    VRD(1); SBAR(); GAPA(C0=__builtin_amdgcn_mfma_f32_32x32x16_bf16(kf[2],qr[1],C0,0,0,0),   P0[10],P0[11],P0[12],P0[13], pw1[0]=PKW(P0,8), pw1[1]=PKW(P0,10), pw1); \
    VRD(5); SBAR(); GAPA(C1=__builtin_amdgcn_mfma_f32_32x32x16_bf16(kf[3],qr[1],C1,0,0,0),   P0[14],P0[15],P1[0],P1[1],   pw1[2]=PKW(P0,12),pw1[3]=PKW(P0,14), pw1); \
    VRD(2); SBAR(); GAPA(C0=__builtin_amdgcn_mfma_f32_32x32x16_bf16(kf[4],qr[2],C0,0,0,0),   P1[2],P1[3],P1[4],P1[5],     pw2[0]=PKW(P1,0), pw2[1]=PKW(P1,2), pw2); \
    VRD(6); SBAR(); GAPA(C1=__builtin_amdgcn_mfma_f32_32x32x16_bf16(kf[5],qr[2],C1,0,0,0),   P1[6],P1[7],P1[8],P1[9],     pw2[2]=PKW(P1,4), pw2[3]=PKW(P1,6), pw2); \
    VRD(3); SBAR(); GAPA(C0=__builtin_amdgcn_mfma_f32_32x32x16_bf16(kf[6],qr[3],C0,0,0,0),   P1[10],P1[11],P1[12],P1[13], pw3[0]=PKW(P1,8), pw3[1]=PKW(P1,10), pw3); \
    VRD(7); SBAR(); GAPA(C1=__builtin_amdgcn_mfma_f32_32x32x16_bf16(kf[7],qr[3],C1,0,0,0),   P1[14],P1[15],0.f,0.f,       pw3[2]=PKW(P1,12),pw3[3]=PKW(P1,14), pw3); \
    l_reg+=sacc; \
    if(GK){DMA_K((t)+3,sl_cur);} if(GV){DMA_V((t)+1,sl_next);} \
    CMASK(C0,C1,t); \
    { float a=MX3(C0[0],C0[1],C1[0]),b=MX3(C0[2],C0[3],C1[1]); a=MX3(a,C1[2],C1[3]); \
      _Pragma("unroll") for(int r=4;r<16;r+=4){a=MX3(a,C0[r],C0[r+1]);b=MX3(b,C0[r+2],C0[r+3]);a=MX3(a,C1[r],C1[r+1]);b=MX3(b,C1[r+2],C1[r+3]);} \
      float rm=__builtin_fmaxf(a,b); { auto rr=__builtin_amdgcn_permlane32_swap(__float_as_uint(rm),__float_as_uint(rm),false,false); rm=__builtin_fmaxf(__uint_as_float(rr[0]),__uint_as_float(rr[1])); } \
      resc=false; \
      if(__builtin_expect(__any(rm>(float)THRL),0)){ const float dl=__builtin_fmaxf(rm,0.f); mhat+=dl; \
        _Pragma("unroll") for(int r=0;r<16;++r){C0[r]-=dl;C1[r]-=dl;} \
        const float f=__builtin_amdgcn_exp2f(-dl); l_reg*=f; if(hi==0)wsf[r32]=f; resc=true; } } \
    SBAR(); \
    GAPB(o[0]=__builtin_amdgcn_mfma_f32_32x32x16_bf16(PAF(0),VFR(0),o[0],0,0,0), C0,0); \
    GAPB(o[1]=__builtin_amdgcn_mfma_f32_32x32x16_bf16(PAF(0),VFR(4),o[1],0,0,0), C0,4); \
    KRD(GL,0); GAPB(o[0]=__builtin_amdgcn_mfma_f32_32x32x16_bf16(PAF(1),VFR(1),o[0],0,0,0), C0,8); \
    KRD(GL,1); GAPB(o[1]=__builtin_amdgcn_mfma_f32_32x32x16_bf16(PAF(1),VFR(5),o[1],0,0,0), C0,12); \
    KRD(GL,2); GAPB(o[0]=__builtin_amdgcn_mfma_f32_32x32x16_bf16(PAF(2),VFR(2),o[0],0,0,0), C1,0); \
    KRD(GL,3); GAPB(o[1]=__builtin_amdgcn_mfma_f32_32x32x16_bf16(PAF(2),VFR(6),o[1],0,0,0), C1,4); \
    GAPB(o[0]=__builtin_amdgcn_mfma_f32_32x32x16_bf16(PAF(3),VFR(3),o[0],0,0,0), C1,8); \
    GAPB(o[1]=__builtin_amdgcn_mfma_f32_32x32x16_bf16(PAF(3),VFR(7),o[1],0,0,0), C1,12); \
    }while(0)
  int t=1;
  #undef CMASK
  #define CMASK(P0,P1,t) do{}while(0)
  for(;t+5<NT;t+=2){
    STEP(pB0,pB1,pA0,pA1,t,true,true,true);     WAIT_BAR(2); RESC(); ROT();
    STEP(pA0,pA1,pB0,pB1,t+1,true,true,true);   WAIT_BAR(2); RESC(); ROT();
  }
  #undef CMASK
  #define CMASK(P0,P1,t) do{int jb_=(t)-(NT-4); if(jb_>=0)cmask(P0,P1,jb_,qrel,hi);}while(0)
  #define ENDW(tt) do{ if((tt)+3<NT){WAIT_BAR(2);} else if((tt)+2<NT){WAIT_BAR(1);} else {WAIT_BAR(0);} }while(0)
  for(;t+1<NT;t+=2){
    STEP(pB0,pB1,pA0,pA1,t,(t+3<NT),(t+1<NT),(t+1<NT));       ENDW(t);   RESC(); ROT();
    STEP(pA0,pA1,pB0,pB1,t+1,(t+4<NT),(t+2<NT),(t+2<NT));     ENDW(t+1); RESC(); ROT();
  }
  STEP(pB0,pB1,pA0,pA1,NT-1,false,false,false); RESC();
  { float sacc=pB0[0]+pB0[1]; _Pragma("unroll") for(int r=2;r<16;++r)sacc+=pB0[r]; _Pragma("unroll") for(int r=0;r<16;++r)sacc+=pB1[r]; l_reg+=sacc;
    pw0=(u32x4){PKW(pB0,0),PKW(pB0,2),PKW(pB0,4),PKW(pB0,6)};pw1=(u32x4){PKW(pB0,8),PKW(pB0,10),PKW(pB0,12),PKW(pB0,14)};pw2=(u32x4){PKW(pB1,0),PKW(pB1,2),PKW(pB1,4),PKW(pB1,6)};pw3=(u32x4){PKW(pB1,8),PKW(pB1,10),PKW(pB1,12),PKW(pB1,14)};
    SBAR(); pv(o,vb0+sl_cur,PAF(0),PAF(1),PAF(2),PAF(3)); }
  #undef PKW
  #undef PAF
  #undef VFR
  #undef PIN
  #undef MX3
  #undef GAPA
  #undef GAPB
  #undef EX
  #undef VRD
  #undef KRD
  #undef STEP
  #undef ENDW
  {auto rr=__builtin_amdgcn_permlane32_swap(__float_as_uint(l_reg),__float_as_uint(l_reg),false,false);l_reg=__uint_as_float(rr[0])+__uint_as_float(rr[1]);}
  if(hi==0)wsf[32+r32]=l_reg;asm volatile("s_waitcnt lgkmcnt(0)":::"memory");
  float rli[16];
  #pragma unroll
  for(int r=0;r<16;++r)rli[r]=__builtin_amdgcn_rcpf(wsf[32+crow(r,hi)]);
  bf16*Ow=O+(rowbase+q0+wid*QBLK)*DMO+OCOL+h*D;
  { bf16*stg=(bf16*)(shm+LDS_OST)+wid*2048;
    #pragma unroll
    for(int r=0;r<16;++r){const int orow=crow(r,hi);
      #pragma unroll
      for(int d0=0;d0<2;++d0)stg[orow*64+d0*32+r32]=__float2bfloat16(o[d0][r]*rli[r]);}
    asm volatile("s_waitcnt lgkmcnt(0)":::"memory");
    #pragma unroll
    for(int i=0;i<4;++i){const int row=i*8+(lane>>3),ch=lane&7; const u32x4 v=*(const u32x4*)(stg+row*64+ch*8); ATTN_STORE16(Ow+(long)row*DMO+ch*8,v);} }
  asm volatile("s_waitcnt lgkmcnt(0)\n\ts_barrier":::"memory");
  #undef DMA_K
  #undef DMA_V
  #undef CMASK
  #undef START
  #undef BIAS
  #undef RESC
  #undef ROT
}
constexpr int ATTN_LDS_BYTES=LDS_BYTES;
struct AttnTensors { const bf16* Q; const bf16* K; const bf16* V; bf16* O; const float* nb; const float* qn; const float* kn; const int* t0tab; };
struct AttnUnit { int bh; int qb; };
struct StaticOrder {
  int vcu,G;
  __device__ __forceinline__ explicit StaticOrder(int grid,int block):vcu((grid%8==0)?(block%8)*(grid/8)+block/8:block),G(grid){}
  __device__ __forceinline__ bool next(int i,AttnUnit&u)const{ const int w=vcu+(i>>2)*G; if(w>=BATCH*NHEAD*8)return false; const int s=w&7,j=i&3; u.bh=((w>>3)+9*j)&31; u.qb=(j==0)?s:(j==1)?15-s:(j==2)?16+s:31-s; return true; }
  __device__ __forceinline__ void a_ready(const AttnUnit&)const{}
  __device__ __forceinline__ void done(const AttnUnit&)const{}
};
template<int THRL=8> __device__ __forceinline__ void attn_phase_dyn(char*lds,const AttnTensors&T,unsigned*ctr,volatile __attribute__((address_space(3))) unsigned*slot){
  const int tid=threadIdx.x,lane=tid&63;
  int ord=0;
  { const float myv=(lane<32)?T.nb[(long)lane*SEQ+SEQ-1]:3.0e38f; int rank=0;
    _Pragma("unroll") for(int j=0;j<32;++j){const float vj=__shfl(myv,j); rank+=(vj<myv||(vj==myv&&j<lane))?1:0;}
    _Pragma("unroll") for(int j=0;j<32;++j){const int rj=__shfl(rank,j); if(rj==lane)ord=j;} }
  if(tid==0){ const unsigned id=__hip_atomic_fetch_add(ctr,1u,__ATOMIC_RELAXED,__HIP_MEMORY_SCOPE_AGENT); *slot=id; }
  asm volatile("s_waitcnt vmcnt(0) lgkmcnt(0)\n\ts_barrier":::"memory");
  for(;;){
    const unsigned uid=*slot;
    if(uid>=(unsigned)(BATCH*NHEAD*NQB))break;
    unsigned nxt=0u; if(tid==0)nxt=__hip_atomic_fetch_add(ctr,1u,__ATOMIC_RELAXED,__HIP_MEMORY_SCOPE_AGENT);
    const int bh=__builtin_amdgcn_readfirstlane(__shfl(ord,(int)(uid>>5))), qb=NQB-1-(int)(uid&31u);
    const int t0=__builtin_amdgcn_readfirstlane(T.t0tab[bh*NQB+qb]);
    attn_unit<THRL>(bh/NHEAD,bh%NHEAD,qb,T.Q,T.K,T.V,T.O,T.nb+(long)bh*SEQ,t0,lds);
    if(tid==0)*slot=nxt;
    asm volatile("s_waitcnt vmcnt(0) lgkmcnt(0)\n\ts_barrier":::"memory");
  }
}
#undef SBAR
#undef WAIT_BAR
}
#define GAS __attribute__((address_space(1)))
#define LAS __attribute__((address_space(3)))
typedef unsigned short bf16;
typedef unsigned v4u __attribute__((ext_vector_type(4)));
typedef float f32x4 __attribute__((ext_vector_type(4)));
typedef short bf16x8 __attribute__((ext_vector_type(8)));
typedef GAS unsigned gu32;
typedef GAS unsigned long long gu64;
#define RLX_AGENT __ATOMIC_RELAXED, __HIP_MEMORY_SCOPE_AGENT
#define LDS_WAIT() asm volatile("s_waitcnt lgkmcnt(0)" ::: "memory")
#define VM_WAIT() asm volatile("s_waitcnt vmcnt(0)" ::: "memory")
__device__ __forceinline__ unsigned long long rt() { return __builtin_amdgcn_s_memrealtime(); }
typedef float f32x2_pk __attribute__((ext_vector_type(2))); typedef __bf16 bf16x2_pk __attribute__((ext_vector_type(2)));
__device__ __forceinline__ unsigned pk2(float lo, float hi) { f32x2_pk v = {lo, hi}; bf16x2_pk r = __builtin_convertvector(v, bf16x2_pk); return __builtin_bit_cast(unsigned, r); }
__device__ __forceinline__ unsigned f2bf(float f) { return pk2(f, 0.f) & 0xffffu; }

#define XB_TMO      128
#define XB_XCNT(j)  (256  + 64 * (j))
#define XB_XSUB(j)  (1280 + 64 * (j))
#define XB_XGEN(j)  (2304 + 64 * (j))
#define XB_TOP      3328
#define XB_TOPGEN   3392
#define XCD_BAR_WORDS 3456
#define XB_SPIN_CAP (1u << 18)

__device__ __forceinline__ unsigned xb_ld(unsigned* p)              { return __hip_atomic_load(p, __ATOMIC_RELAXED, __HIP_MEMORY_SCOPE_AGENT); }
__device__ __forceinline__ unsigned xb_add(unsigned* p, unsigned v) { return __hip_atomic_fetch_add(p, v, __ATOMIC_RELAXED, __HIP_MEMORY_SCOPE_AGENT); }
__device__ __forceinline__ unsigned xb_xcc_id() { return (unsigned)__builtin_amdgcn_s_getreg((3 << 11) | 20) & 0xFu; }
#define XB_SPIN(cond, bar) do { unsigned _sp = 0; while (cond) { __builtin_amdgcn_s_sleep(1); \
    if ((++_sp & 255u) == 0u) { if (xb_ld(&(bar)[XB_TMO])) break; if (_sp > XB_SPIN_CAP) { atomicAdd(&(bar)[XB_TMO], 1u); break; } } } } while (0)

struct XcdBarrier {
    unsigned* bar; unsigned x;
    volatile LAS unsigned* st;
};

__device__ __forceinline__ XcdBarrier xcd_barrier_post(unsigned* bar, volatile LAS unsigned* st) {
    XcdBarrier b; b.bar = bar; b.x = xb_xcc_id(); b.st = st;
    if (threadIdx.x == 0) (void)xb_add(&bar[XB_XCNT(b.x)], 1u);
    return b;
}
__device__ __forceinline__ void xcd_barrier_complete(unsigned* bar, unsigned x, unsigned& nloc, unsigned& nx) {
    const unsigned G = gridDim.x * gridDim.y * gridDim.z;
    unsigned sum, cnt, mine, sp = 0u;
    for (;;) {
        sum = 0u; cnt = 0u; mine = 0u;
#pragma unroll
        for (unsigned j = 0; j < 16; ++j) { const unsigned c = xb_ld(&bar[XB_XCNT(j)]); sum += c; cnt += (c > 0u) ? 1u : 0u; mine = (j == x) ? c : mine; }
        if (sum == G) break;
        __builtin_amdgcn_s_sleep(1);
        if ((++sp & 255u) == 0u) { if (xb_ld(&bar[XB_TMO])) break; if (sp > XB_SPIN_CAP) { atomicAdd(&bar[XB_TMO], 1u); break; } }
    }
    nloc = mine > 0u ? mine : 1u; nx = cnt > 0u ? cnt : 1u;
}

__device__ __forceinline__ void xcd_barrier(const XcdBarrier& b) {
    asm volatile("s_waitcnt vmcnt(0)" ::: "memory");
    __syncthreads();
    if (threadIdx.x == 0) {
        unsigned* bar = b.bar;
        __builtin_amdgcn_s_waitcnt(0);
        unsigned nloc = b.st[0], nx = b.st[1];
        if (nloc == 0u) { xcd_barrier_complete(bar, b.x, nloc, nx); b.st[0] = nloc; b.st[1] = nx; }
        const unsigned old = xb_add(&bar[XB_XSUB(b.x)], 1u);
        const unsigned gen = old / nloc;
        if (old + 1u == (gen + 1u) * nloc) {
            __builtin_amdgcn_fence(__ATOMIC_RELEASE, "agent");
            asm volatile("s_waitcnt vmcnt(0)" ::: "memory");
            const unsigned og = xb_add(&bar[XB_TOP], 1u);
            const unsigned tg = og / nx;
            if (og + 1u == (tg + 1u) * nx) xb_add(&bar[XB_TOPGEN], 1u);
            else XB_SPIN(xb_ld(&bar[XB_TOPGEN]) == tg, bar);
            __builtin_amdgcn_fence(__ATOMIC_ACQUIRE, "agent");
            xb_add(&bar[XB_XGEN(b.x)], 1u);
            asm volatile("s_waitcnt vmcnt(0)" ::: "memory");
        } else {
            XB_SPIN(xb_ld(&bar[XB_XGEN(b.x)]) == gen, bar);
            __builtin_amdgcn_fence(__ATOMIC_ACQUIRE, "agent");
            asm volatile("s_waitcnt vmcnt(0)" ::: "memory");
        }
    }
    __syncthreads();
}

constexpr int NWAVES = 8;
constexpr int BATCH = 4, SEQ = 8192, D = 1024, M = BATCH * SEQ;
constexpr int IN_W = 7184, NGW = 4096, NGT = 3072, NSLAB = 8;
constexpr int SL_POOL = 0, SL_MQ = 1, SL_MK = 2, SL_MV = 3, SL_MO = 4, SL_FQ = 5, SL_FK = 6, SL_FV = 7;
constexpr int ML_H = 4, ML_DH = 128, CHUNK = 64, NCH = SEQ / CHUNK;
constexpr int FX_H = 8;
constexpr int DFF = 2816, NEXP = 8, DFE = 3584;
constexpr float NORM_EPS = 1e-6f;
constexpr int XLD = 2 * D;
constexpr int XROT = 16;
constexpr int KCAT = 1536;
constexpr int MOE_KROWS = 34816;
constexpr int MOE_KTILES = MOE_KROWS / 256;
constexpr int TOKBLK = 128, NTOKBLK = M / TOKBLK;

constexpr size_t MiB = 1u << 20;
constexpr size_t WS_CTL = 0, CTL_ZERO_BYTES = 1 * MiB;
constexpr size_t WS_W = 1 * MiB;
constexpr size_t W_LAYER = 19 * MiB, W_NG = 0, W_GT = 8 * MiB, W_CAT = 14 * MiB, W_OUT = 17 * MiB;
constexpr size_t WS_WGU = WS_W + 2 * W_LAYER, WS_WDN = WS_WGU + 11 * MiB;
constexpr size_t WS_NG = 56 * MiB, SLAB_BYTES = (size_t)M * 512 * 2;
constexpr size_t WS_GATE = WS_NG + SLAB_BYTES;
constexpr size_t WS_ACT0 = WS_NG;
constexpr size_t WS_HB = 312 * MiB;
constexpr size_t WS_CAT = 376 * MiB;
constexpr size_t WS_MLC = 472 * MiB;
constexpr size_t WS_MOEGU = 1 * MiB;
constexpr size_t WS_MOEDN = 57 * MiB;
constexpr size_t WS_XS = 85 * MiB;
constexpr size_t WS_Y0 = 153 * MiB, WS_Y1 = 217 * MiB;
constexpr size_t WS_ACT1 = 305 * MiB;
constexpr size_t WS_SM = 544 * MiB;
constexpr size_t SM_GATE16 = 0;
constexpr size_t SM_MLB = 2 * MiB, SM_MLA = SM_MLB + 512 * 1024, SM_MLMX = SM_MLA + 512 * 1024;
constexpr size_t SM_FNB = SM_MLMX + 512 * 1024;
constexpr size_t SM_MLN = SM_FNB + 1 * MiB;
constexpr size_t SM_MLM = SM_MLN + 1 * MiB;
constexpr size_t SM_MLDEC = SM_MLM + 16 * 132 * 4;
constexpr size_t SM_FQN = SM_MLDEC + 16 * 128 * 4, SM_FKN = SM_FQN + 32768, SM_FT0 = SM_FKN + 32768, SM_MLBG = SM_FT0 + 4096, SM_FXM = SM_MLBG + 16384;
constexpr size_t SM_MOE = 6 * MiB;
constexpr size_t MO_RSTD = 0, MO_TOKE = MO_RSTD + (size_t)M * 4, MO_TOKG = MO_TOKE + (size_t)M * 8, MO_HIST = MO_TOKG + (size_t)M * 8,
                 MO_ROWTOK = MO_HIST + (size_t)NTOKBLK * 16 * 4, MO_ROWG = MO_ROWTOK + (size_t)2 * MOE_KROWS * 4, MO_TILEE = MO_ROWG + (size_t)2 * MOE_KROWS * 4, MO_NT = MO_TILEE + 2 * MOE_KTILES * 4, MO_END = MO_NT + 64;
static_assert(SM_MOE + MO_END <= 8 * MiB, "small arrays");
constexpr size_t WS_END = 552 * MiB;
static_assert(WS_WDN + (size_t)DFF * D * 2 <= WS_NG && WS_NG + NSLAB * SLAB_BYTES <= WS_HB && WS_HB + (size_t)M * D * 2 <= WS_CAT && WS_CAT + (size_t)M * KCAT * 2 <= WS_MLC && WS_MLC + 64 * MiB <= WS_SM, "d_ws map");
static_assert(WS_MOEGU + (size_t)NEXP * 2 * DFE * D <= WS_MOEDN && WS_MOEDN + (size_t)NEXP * D * DFE <= WS_XS && WS_XS + (size_t)2 * MOE_KROWS * D <= WS_Y0 && WS_Y0 + (size_t)M * D * 2 <= WS_Y1 && WS_Y1 + (size_t)M * D * 2 <= WS_ACT1 && WS_ACT1 + (size_t)2 * MOE_KROWS * DFE <= WS_SM, "d_ws map (MoE)");
constexpr int CW_TMO = 0, CW_CODE = 1, CW_BAR = 4096;

constexpr int RING_OFF = 0, RING_BYTES = 131072;
constexpr int LDSCTL_OFF = RING_BYTES, MISC_OFF = LDSCTL_OFF + 320;
constexpr int LDS_BYTES = 147456;
static_assert(MISC_OFF + 128 <= LDS_BYTES, "LDS map");

struct Frame {
    LAS unsigned char* lds;
    volatile LAS unsigned* MISC;
    gu32* ctl;
    int tid, lane, wave;
    int vcu, G, blk;
    unsigned char* ws;
    const float* const* in; float* out; int zi;
};
#define INP(F, i) ((F).in[(i) + (F).zi])
enum { IN_X = 0, IN_MIXG, IN_WIN, IN_POOLW, IN_POOLS, IN_CONVW, IN_MLBI, IN_MLBF, IN_MLNG, IN_FXBF, IN_WBRP, IN_WBRM, IN_WBRF, IN_WOUT, IN_FFNG, IN_FFG, IN_FFU, IN_FFD, IN_RW, IN_RB, IN_MOEG, IN_MOEU, IN_MOED, IN_FING };

__device__ __forceinline__ float wave_sum(float v) {
#pragma unroll
    for (int o = 1; o < 64; o <<= 1) v += __shfl_xor(v, o);
    return v;
}
__device__ __forceinline__ float wave_max(float v) {
#pragma unroll
    for (int o = 1; o < 64; o <<= 1) v = fmaxf(v, __shfl_xor(v, o));
    return v;
}
__device__ __forceinline__ float sigmoid_f(float x) { return __builtin_amdgcn_rcpf(1.f + __builtin_amdgcn_exp2f(-1.4426950408889634f * x)); }
__device__ __forceinline__ float logsigmoid_f(float x) { return fminf(x, 0.f) - log1pf(expf(-fabsf(x))); }

__device__ __forceinline__ void tr_item(const float* W, int ldw, int srccol0, const float* gain, bf16* WT, int ldt, int drow0, int dcol0, int k0, LAS float* scr, int lane) {
    (void)scr;
    const int ng = lane & 7, kg = lane >> 3;
    f32x4 v[8];
#pragma unroll
    for (int i = 0; i < 8; ++i) v[i] = *(const GAS f32x4*)(W + (size_t)(k0 + 8 * kg + i) * ldw + srccol0 + 4 * ng);
    if (gain) { const f32x4 g0 = *(const GAS f32x4*)(gain + k0 + 8 * kg), g1 = *(const GAS f32x4*)(gain + k0 + 8 * kg + 4);
#pragma unroll
        for (int i = 0; i < 4; ++i) { v[i] = v[i] * g0[i]; v[4 + i] = v[4 + i] * g1[i]; } }
#pragma unroll
    for (int j = 0; j < 4; ++j) { v4u o; o.x = pk2(v[0][j], v[1][j]); o.y = pk2(v[2][j], v[3][j]); o.z = pk2(v[4][j], v[5][j]); o.w = pk2(v[6][j], v[7][j]);
        *(GAS v4u*)(WT + (size_t)(drow0 + 4 * ng + j) * ldt + dcol0 + k0 + 8 * kg) = o; }
}
__device__ __forceinline__ void tr_item_fp8(const float* W, int ldw, int srccol0, const float* gain, float scale, unsigned char* WT8, int ldt, int drow0, int k0, int lane) {
    const int ng = lane & 7, kg = lane >> 3;
    f32x4 v[8];
#pragma unroll
    for (int i = 0; i < 8; ++i) v[i] = *(const GAS f32x4*)(W + (size_t)(k0 + 8 * kg + i) * ldw + srccol0 + 4 * ng);
    f32x4 g0 = (f32x4){scale, scale, scale, scale}, g1 = g0;
    if (gain) { g0 = *(const GAS f32x4*)(gain + k0 + 8 * kg) * scale; g1 = *(const GAS f32x4*)(gain + k0 + 8 * kg + 4) * scale; }
#pragma unroll
    for (int i = 0; i < 4; ++i) { v[i] = v[i] * g0[i]; v[4 + i] = v[4 + i] * g1[i]; }
    typedef unsigned u32x2_t __attribute__((ext_vector_type(2)));
#pragma unroll
    for (int j = 0; j < 4; ++j) { u32x2_t o; o.x = pg8::pack_fp8x4(v[0][j], v[1][j], v[2][j], v[3][j]); o.y = pg8::pack_fp8x4(v[4][j], v[5][j], v[6][j], v[7][j]);
        *(GAS u32x2_t*)(WT8 + (size_t)(drow0 + 4 * ng + j) * ldt + k0 + 8 * kg) = o; }
}
constexpr float FP8_ASCALE = 16.f, FP8_WSCALE = 256.f;
constexpr int CI_NG = 2048, CI_GT = 1536, CI_BR = 256, CI_OUT = 512, CI_LAYER = CI_NG + CI_GT + 2 * CI_BR + CI_OUT, CI_GU = 2816, CI_DN = 1408, CI_MAIN = 2 * CI_LAYER + CI_GU + CI_DN;
__device__ __forceinline__ void conv_item_main(Frame& F, int it, LAS float* scr) {
    if (it < 2 * CI_LAYER) {
        const int l = it / CI_LAYER; int r = it % CI_LAYER; bf16* wl = (bf16*)(F.ws + WS_W + (size_t)l * W_LAYER);
        const float* g = INP(F, IN_MIXG) + l * D; const float* win = INP(F, IN_WIN) + (size_t)l * D * IN_W;
        if (r < CI_NG) { const int nb = r >> 4, kb = r & 15; tr_item(win, IN_W, nb * 32 + (nb * 32 >= 2560 ? 8 : 0), g, wl + W_NG / 2, D, nb * 32, 0, kb * 64, scr, F.lane); return; } r -= CI_NG;
        if (r < CI_GT) { const int nb = r >> 4, kb = r & 15; tr_item_fp8(win, IN_W, 4112 + nb * 32, g, FP8_WSCALE, (unsigned char*)wl + W_GT, D, nb * 32, kb * 64, F.lane); return; } r -= CI_GT;
        if (r < CI_BR) { const int nb = r >> 3, kb = r & 7; tr_item(INP(F, IN_WBRM) + (size_t)l * 512 * D, D, nb * 32, nullptr, wl + W_CAT / 2, KCAT, nb * 32, 512, kb * 64, scr, F.lane); return; } r -= CI_BR;
        if (r < CI_BR) { const int nb = r >> 3, kb = r & 7; tr_item(INP(F, IN_WBRF) + (size_t)l * 512 * D, D, nb * 32, nullptr, wl + W_CAT / 2, KCAT, nb * 32, 1024, kb * 64, scr, F.lane); return; } r -= CI_BR;
        { const int nb = r >> 4, kb = r & 15; tr_item(INP(F, IN_WOUT) + (size_t)l * D * D, D, nb * 32, nullptr, wl + W_OUT / 2, D, nb * 32, 0, kb * 64, scr, F.lane); }
        return;
    }
    it -= 2 * CI_LAYER;
    if (it < CI_GU) { const int nb = it >> 4, kb = it & 15, p = nb >> 3, w = nb & 7;
        tr_item(w < 4 ? INP(F, IN_FFG) : INP(F, IN_FFU), DFF, 128 * p + (w & 3) * 32, INP(F, IN_FFNG), (bf16*)(F.ws + WS_WGU), D, nb * 32, 0, kb * 64, scr, F.lane); return; }
    it -= CI_GU;
    { const int kb = it >> 5, nb = it & 31; tr_item(INP(F, IN_FFD), D, nb * 32, nullptr, (bf16*)(F.ws + WS_WDN), DFF, nb * 32, 0, kb * 64, scr, F.lane); }
}
constexpr int CI_MGU = 3584, CI_MDN = 1792, CI_MEXP = CI_MGU + CI_MDN, CI_MOE = NEXP * CI_MEXP;
__device__ __forceinline__ void conv_item_moe(Frame& F, int it, LAS float* scr) {
    (void)scr;
    const int e = it / CI_MEXP; int r = it % CI_MEXP;
    if (r < CI_MGU) { const int nb = r % 224, kb = r / 224, p = nb >> 3, w = nb & 7;
        tr_item_fp8((w < 4 ? INP(F, IN_MOEG) : INP(F, IN_MOEU)) + (size_t)e * D * DFE, DFE, 128 * p + (w & 3) * 32, INP(F, IN_FFNG) + D, FP8_WSCALE, F.ws + WS_MOEGU + (size_t)e * 2 * DFE * D, D, nb * 32, kb * 64, F.lane); return; }
    r -= CI_MGU;
    { const int kb = r >> 5, nb = r & 31; tr_item_fp8(INP(F, IN_MOED) + (size_t)e * DFE * D, D, nb * 32, nullptr, FP8_WSCALE, F.ws + WS_MOEDN + (size_t)e * D * DFE, DFE, nb * 32, kb * 64, F.lane); }
}
__device__ __forceinline__ void pool_fold(Frame& F) {
    const int gt = F.blk * (NWAVES * 64) + F.tid, NT = F.G * NWAVES * 64;
    for (int o = gt; o < 2 * 4 * 16 * D; o += NT) {
        const int n = o & (D - 1), cb = __builtin_amdgcn_readfirstlane(o >> 10), l = cb >> 6, g = (cb >> 4) & 3, c0 = (cb & 15) * 8;
        const float* wg = INP(F, IN_POOLW) + (size_t)l * 4 * 128 * 128 + (size_t)(g * 128 + c0) * 128; const float* sc = INP(F, IN_POOLS) + l * 512 + g * 128; const float* wb = INP(F, IN_WBRP) + (size_t)l * 512 * D + (size_t)(g * 128) * D + n;
        float a[8];
#pragma unroll
        for (int i = 0; i < 8; ++i) a[i] = 0.f;
#pragma unroll 8
        for (int dd = 0; dd < 128; ++dd) { const float t = sc[dd] * wb[(size_t)dd * D];
#pragma unroll
            for (int i = 0; i < 8; ++i) a[i] += wg[i * 128 + dd] * t; }
        v4u w; w.x = pk2(a[0], a[1]); w.y = pk2(a[2], a[3]); w.z = pk2(a[4], a[5]); w.w = pk2(a[6], a[7]);
        *(GAS v4u*)((bf16*)(F.ws + WS_W + (size_t)l * W_LAYER + W_CAT) + (size_t)n * KCAT + g * 128 + c0) = w;
    }
}

template <bool XB, int LD = D, int ROT = 0> __device__ __forceinline__ void load_xrow(const void* x, size_t m, int lane, f32x4 (&v)[4]) {
    if constexpr (XB) { typedef unsigned u32x2_t __attribute__((ext_vector_type(2))); const GAS u32x2_t* xr = (const GAS u32x2_t*)((const bf16*)x + m * LD + (ROT ? (m & (ROT - 1)) * 64 : 0)) + lane;
#pragma unroll
        for (int j = 0; j < 4; ++j) { const u32x2_t q = xr[64 * j]; v[j] = (f32x4){__uint_as_float(q.x << 16), __uint_as_float(q.x & 0xffff0000u), __uint_as_float(q.y << 16), __uint_as_float(q.y & 0xffff0000u)}; } }
    else { const GAS f32x4* xr = (const GAS f32x4*)((const float*)x + m * D) + lane;
#pragma unroll
        for (int j = 0; j < 4; ++j) v[j] = xr[64 * j]; }
}
template <bool XB> __device__ __forceinline__ void phase_norm_mix(Frame& F, const void* x, int l) {
    LAS float* w16 = (LAS float*)(F.lds);
    const float* g = INP(F, IN_MIXG) + l * D; const float* win = INP(F, IN_WIN) + (size_t)l * D * IN_W;
    for (int idx = F.tid; idx < 16 * D; idx += NWAVES * 64) { const int k = idx >> 4, j = idx & 15, col = j < 8 ? 2560 + j : 4104 + (j - 8); w16[j * D + k] = g[k] * win[(size_t)k * IN_W + col]; }
    __syncthreads();
    bf16* HB = (bf16*)(F.ws + WS_HB); float* gate16 = (float*)(F.ws + WS_SM + SM_GATE16);
    const int gw = F.vcu * NWAVES + F.wave, NGWV = F.G * NWAVES;
    f32x4 nv[4]; if (gw < M) load_xrow<XB, XB ? XLD : D, XB ? XROT : 0>(x, (size_t)gw, F.lane, nv);
    for (int m = gw; m < M; m += NGWV) {
        f32x4 v[4]; float ss = 0.f;
#pragma unroll
        for (int j = 0; j < 4; ++j) v[j] = nv[j];
        if (m + NGWV < M) load_xrow<XB, XB ? XLD : D, XB ? XROT : 0>(x, (size_t)(m + NGWV), F.lane, nv);
#pragma unroll
        for (int j = 0; j < 4; ++j) ss += (v[j].x * v[j].x + v[j].y * v[j].y) + (v[j].z * v[j].z + v[j].w * v[j].w);
        const float rstd = 1.f / sqrtf(wave_sum(ss) * (1.f / D) + NORM_EPS);
        GAS unsigned long long* o8 = (GAS unsigned long long*)(HB + (size_t)m * D) + F.lane;
#pragma unroll
        for (int j = 0; j < 4; ++j) o8[64 * j] = (unsigned long long)pk2(v[j].x * rstd, v[j].y * rstd) | ((unsigned long long)pk2(v[j].z * rstd, v[j].w * rstd) << 32);
        float pp[16];
#pragma unroll
        for (int jj = 0; jj < 16; ++jj) { float p = 0.f;
#pragma unroll
            for (int j = 0; j < 4; ++j) { const f32x4 wv = *(const LAS f32x4*)(w16 + jj * D + 256 * j + 4 * F.lane); p += (v[j].x * wv.x + v[j].y * wv.y) + (v[j].z * wv.z + v[j].w * wv.w); }
            pp[jj] = p; if ((jj & 3) == 3) asm volatile("" ::: "memory"); }
#define TB_STAGE(ST, N) { const bool up = (F.lane >> (ST)) & 1; _Pragma("unroll") for (int i = 0; i < (N); ++i) { const float mine = up ? pp[2 * i + 1] : pp[2 * i], give = up ? pp[2 * i] : pp[2 * i + 1]; pp[i] = mine + __shfl_xor(give, 1 << (ST)); } }
        TB_STAGE(0, 8) TB_STAGE(1, 4) TB_STAGE(2, 2) TB_STAGE(3, 1)
        float keep = pp[0]; keep += __shfl_xor(keep, 16); keep += __shfl_xor(keep, 32); keep *= rstd;
        if (F.lane < 16) gate16[(size_t)m * 16 + F.lane] = keep;
    }
    __syncthreads();
}
__device__ __forceinline__ void phase_norm_ffn(Frame& F, const bf16* x) {
    bf16* HB = (bf16*)(F.ws + WS_HB);
    const int gw = F.vcu * NWAVES + F.wave, NGWV = F.G * NWAVES;
    f32x4 nv[4]; if (gw < M) load_xrow<true, XLD, XROT>(x, (size_t)gw, F.lane, nv);
    for (int m = gw; m < M; m += NGWV) {
        f32x4 v[4]; float ss = 0.f;
#pragma unroll
        for (int j = 0; j < 4; ++j) v[j] = nv[j];
        if (m + NGWV < M) load_xrow<true, XLD, XROT>(x, (size_t)(m + NGWV), F.lane, nv);
#pragma unroll
        for (int j = 0; j < 4; ++j) ss += (v[j].x * v[j].x + v[j].y * v[j].y) + (v[j].z * v[j].z + v[j].w * v[j].w);
        const float rstd = 1.f / sqrtf(wave_sum(ss) * (1.f / D) + NORM_EPS);
        GAS unsigned long long* o8 = (GAS unsigned long long*)(HB + (size_t)m * D) + F.lane;
#pragma unroll
        for (int j = 0; j < 4; ++j) o8[64 * j] = (unsigned long long)pk2(v[j].x * rstd, v[j].y * rstd) | ((unsigned long long)pk2(v[j].z * rstd, v[j].w * rstd) << 32);
    }
}
__device__ __forceinline__ void quant_rows_fp8(Frame& F, const bf16* src, unsigned char* dst) {
    const int gw = F.vcu * NWAVES + F.wave, NGWV = F.G * NWAVES;
    for (int m = gw; m < M; m += NGWV) {
        const v4u a = *((const GAS v4u*)(src + (size_t)m * D) + F.lane), b = *((const GAS v4u*)(src + (size_t)m * D) + 64 + F.lane);
        typedef unsigned u32x2_t __attribute__((ext_vector_type(2)));
        u32x2_t o0, o1; const float s = FP8_ASCALE;
        o0.x = pg8::pack_fp8x4(__uint_as_float(a.x << 16) * s, __uint_as_float(a.x & 0xffff0000u) * s, __uint_as_float(a.y << 16) * s, __uint_as_float(a.y & 0xffff0000u) * s);
        o0.y = pg8::pack_fp8x4(__uint_as_float(a.z << 16) * s, __uint_as_float(a.z & 0xffff0000u) * s, __uint_as_float(a.w << 16) * s, __uint_as_float(a.w & 0xffff0000u) * s);
        o1.x = pg8::pack_fp8x4(__uint_as_float(b.x << 16) * s, __uint_as_float(b.x & 0xffff0000u) * s, __uint_as_float(b.y << 16) * s, __uint_as_float(b.y & 0xffff0000u) * s);
        o1.y = pg8::pack_fp8x4(__uint_as_float(b.z << 16) * s, __uint_as_float(b.z & 0xffff0000u) * s, __uint_as_float(b.w << 16) * s, __uint_as_float(b.w & 0xffff0000u) * s);
        *((GAS u32x2_t*)(dst + (size_t)m * D) + F.lane) = o0; *((GAS u32x2_t*)(dst + (size_t)m * D) + 64 + F.lane) = o1;
    }
}
__device__ __forceinline__ void phase_norm_final(Frame& F, const bf16* xb, float* out) {
    const GAS f32x4* gp = (const GAS f32x4*)INP(F, IN_FING) + F.lane; f32x4 gv[4];
#pragma unroll
    for (int j = 0; j < 4; ++j) gv[j] = gp[64 * j];
    const bf16* Y0 = (const bf16*)(F.ws + WS_Y0); const bf16* Y1 = (const bf16*)(F.ws + WS_Y1);
    const int gw = F.vcu * NWAVES + F.wave, NGWV = F.G * NWAVES;
    f32x4 nv[4], na[4], nb_[4]; if (gw < M) { load_xrow<true, XLD, XROT>(xb, (size_t)gw, F.lane, nv); load_xrow<true>(Y0, (size_t)gw, F.lane, na); load_xrow<true>(Y1, (size_t)gw, F.lane, nb_); }
    for (int m = gw; m < M; m += NGWV) {
        f32x4 v[4]; float ss = 0.f;
#pragma unroll
        for (int j = 0; j < 4; ++j) v[j] = nv[j] + (na[j] + nb_[j]);
        if (m + NGWV < M) { load_xrow<true, XLD, XROT>(xb, (size_t)(m + NGWV), F.lane, nv); load_xrow<true>(Y0, (size_t)(m + NGWV), F.lane, na); load_xrow<true>(Y1, (size_t)(m + NGWV), F.lane, nb_); }
#pragma unroll
        for (int j = 0; j < 4; ++j) ss += (v[j].x * v[j].x + v[j].y * v[j].y) + (v[j].z * v[j].z + v[j].w * v[j].w);
        const float rstd = 1.f / sqrtf(wave_sum(ss) * (1.f / D) + NORM_EPS);
        GAS f32x4* o = (GAS f32x4*)(out + (size_t)m * D) + F.lane;
#pragma unroll
        for (int j = 0; j < 4; ++j) o[64 * j] = v[j] * rstd * gv[j];
    }
}

__device__ __forceinline__ void phase_route1(Frame& F, const bf16* x) {
    LAS float* w8 = (LAS float*)(F.lds);
    LAS int* hist = (LAS int*)(F.lds + 32768);
    const float* g = INP(F, IN_FFNG) + D; const float* rw = INP(F, IN_RW);
    for (int idx = F.tid; idx < 8 * D; idx += NWAVES * 64) { const int k = idx >> 3, e = idx & 7; w8[e * D + k] = g[k] * rw[(size_t)k * 8 + e]; }
    unsigned char* sm = F.ws + WS_SM + SM_MOE;
    float* rstd_g = (float*)(sm + MO_RSTD); int* tok_e = (int*)(sm + MO_TOKE); float* tok_g = (float*)(sm + MO_TOKG); int* hist_g = (int*)(sm + MO_HIST);
    for (int blk = F.blk; blk < NTOKBLK; blk += F.G) {
        if (F.tid < 16) hist[F.tid] = 0;
        __syncthreads();
        f32x4 nv[4]; load_xrow<true, XLD, XROT>(x, (size_t)(blk * TOKBLK + F.wave * (TOKBLK / NWAVES)), F.lane, nv);
        for (int i = 0; i < TOKBLK / NWAVES; ++i) {
            const int m = blk * TOKBLK + F.wave * (TOKBLK / NWAVES) + i;
            f32x4 v[4]; float ss = 0.f;
#pragma unroll
            for (int j = 0; j < 4; ++j) v[j] = nv[j];
            if (i + 1 < TOKBLK / NWAVES) load_xrow<true, XLD, XROT>(x, (size_t)(m + 1), F.lane, nv);
#pragma unroll
            for (int j = 0; j < 4; ++j) ss += (v[j].x * v[j].x + v[j].y * v[j].y) + (v[j].z * v[j].z + v[j].w * v[j].w);
            const float rstd = 1.f / sqrtf(wave_sum(ss) * (1.f / D) + NORM_EPS);
            float pp[8];
#pragma unroll
            for (int e = 0; e < 8; ++e) { float p = 0.f;
#pragma unroll
                for (int j = 0; j < 4; ++j) { const f32x4 wv = *(const LAS f32x4*)(w8 + e * D + 256 * j + 4 * F.lane); p += (v[j].x * wv.x + v[j].y * wv.y) + (v[j].z * wv.z + v[j].w * wv.w); }
                pp[e] = p; }
            TB_STAGE(0, 4) TB_STAGE(1, 2) TB_STAGE(2, 1)
            float tot = pp[0]; tot += __shfl_xor(tot, 8); tot += __shfl_xor(tot, 16); tot += __shfl_xor(tot, 32);
            float lg[8];
#pragma unroll
            for (int e = 0; e < 8; ++e) lg[e] = __shfl(tot, e) * rstd + INP(F, IN_RB)[e];
            if (F.lane == 0) {
                int e0 = 0; float v0 = lg[0];
#pragma unroll
                for (int e = 1; e < 8; ++e) if (lg[e] > v0) { v0 = lg[e]; e0 = e; }
                int e1 = -1; float v1 = -INFINITY;
#pragma unroll
                for (int e = 0; e < 8; ++e) if (e != e0 && lg[e] > v1) { v1 = lg[e]; e1 = e; }
                const float t = __expf(v1 - v0), g0 = 1.f / (1.f + t), g1 = t * g0;
                rstd_g[m] = rstd; tok_e[2 * m] = e0; tok_e[2 * m + 1] = e1; tok_g[2 * m] = g0; tok_g[2 * m + 1] = g1;
                atomicAdd((int*)&hist[e0], 1); atomicAdd((int*)&hist[8 + e1], 1);
            }
        }
        __syncthreads();
        if (F.tid < 16) hist_g[blk * 16 + F.tid] = hist[F.tid];
        __syncthreads();
    }
}
__device__ __forceinline__ void phase_route2(Frame& F, const bf16* x) {
    LAS int* H = (LAS int*)(F.lds);
    LAS int* tot = (LAS int*)(F.lds + 16384); LAS int* pre = tot + 16; LAS int* start = tot + 32; LAS int* dest = tot + 64; LAS int* te = tot + 320;
    unsigned char* sm = F.ws + WS_SM + SM_MOE;
    const float* rstd_g = (const float*)(sm + MO_RSTD); const int* tok_e = (const int*)(sm + MO_TOKE); const float* tok_g = (const float*)(sm + MO_TOKG); const int* hist_g = (const int*)(sm + MO_HIST);
    int* row_tok = (int*)(sm + MO_ROWTOK); float* row_g = (float*)(sm + MO_ROWG); int* tile_e = (int*)(sm + MO_TILEE); int* ntl = (int*)(sm + MO_NT);
    unsigned char* XS = F.ws + WS_XS;
    for (int blk = F.blk; blk < NTOKBLK; blk += F.G) {
        for (int i = F.tid; i < NTOKBLK * 16; i += NWAVES * 64) H[i] = hist_g[i];
        __syncthreads();
        if (F.tid < 16) { int t = 0, p = 0; for (int b = 0; b < NTOKBLK; ++b) { const int h = H[b * 16 + F.tid]; if (b < blk) p += h; t += h; } tot[F.tid] = t; pre[F.tid] = p; }
        __syncthreads();
        if (F.tid == 0) { for (int k = 0; k < 2; ++k) { int run = 0; for (int e = 0; e < 8; ++e) { start[k * 8 + e] = run; run += ((tot[k * 8 + e] + 255) >> 8) << 8; } if (blk == 0) ntl[k] = run >> 8; } }
        __syncthreads();
        if (F.tid < 2 * TOKBLK) te[F.tid] = tok_e[2 * blk * TOKBLK + F.tid];
        __syncthreads();
        if (F.tid < 16) { const int k = F.tid >> 3, e = F.tid & 7; int cnt = 0; const int base = k * MOE_KROWS + start[F.tid] + pre[F.tid];
            for (int i = 0; i < TOKBLK; ++i) if (te[2 * i + k] == e) { dest[2 * i + k] = base + cnt; ++cnt; }
            if (blk == 0) { const int s0 = start[F.tid], t0 = tot[F.tid], pe = ((t0 + 255) >> 8) << 8;
                for (int tI = s0 >> 8; tI < (s0 + pe) >> 8; ++tI) tile_e[k * MOE_KTILES + tI] = e;
                for (int r = s0 + t0; r < s0 + pe; ++r) { row_tok[k * MOE_KROWS + r] = -1; row_g[k * MOE_KROWS + r] = 0.f; } } }
        __syncthreads();
        for (int i0 = 0; i0 < TOKBLK / NWAVES; i0 += 4) {
            f32x4 xv[4][4]; float rs[4]; float tg[4][2];
#pragma unroll
            for (int q = 0; q < 4; ++q) { const int m = blk * TOKBLK + F.wave * (TOKBLK / NWAVES) + i0 + q; load_xrow<true, XLD, XROT>(x, (size_t)m, F.lane, xv[q]); rs[q] = rstd_g[m]; tg[q][0] = tok_g[2 * m]; tg[q][1] = tok_g[2 * m + 1]; }
#pragma unroll
            for (int q = 0; q < 4; ++q) { const int li = F.wave * (TOKBLK / NWAVES) + i0 + q, m = blk * TOKBLK + li; const int d0 = dest[2 * li], d1 = dest[2 * li + 1];
                GAS unsigned* o0 = (GAS unsigned*)(XS + (size_t)d0 * D) + F.lane; GAS unsigned* o1 = (GAS unsigned*)(XS + (size_t)d1 * D) + F.lane; const float sc = rs[q] * FP8_ASCALE;
#pragma unroll
                for (int j = 0; j < 4; ++j) { const f32x4 v = xv[q][j]; const unsigned w = pg8::pack_fp8x4(v.x * sc, v.y * sc, v.z * sc, v.w * sc); o0[64 * j] = w; o1[64 * j] = w; }
                if (F.lane == 0) { row_tok[d0] = m; row_g[d0] = tg[q][0]; row_tok[d1] = m; row_g[d1] = tg[q][1]; } }
        }
        __syncthreads();
    }
}

__device__ __forceinline__ float wave_scan_add(float v, int lane) {
#pragma unroll
    for (int d = 1; d < 64; d <<= 1) { const float t = __shfl_up(v, d); if (lane >= d) v += t; }
    return v;
}
__device__ __forceinline__ float wave_scan_max(float v, int lane) {
#pragma unroll
    for (int d = 1; d < 64; d <<= 1) { const float t = __shfl_up(v, d); if (lane >= d) v = fmaxf(v, t); }
    return v;
}
__device__ __forceinline__ void prep_mlstm(Frame& F, int l, int bh) {
    LAS float* Bc = (LAS float*)(F.lds); LAS float* Gc = Bc + NCH; LAS float* mc = Gc + NCH;
    const int b = bh >> 2, h = bh & 3;
    const float* gate16 = (const float*)(F.ws + WS_SM + SM_GATE16);
    float* mlb = (float*)(F.ws + WS_SM + SM_MLB) + (size_t)bh * SEQ; float* mla = (float*)(F.ws + WS_SM + SM_MLA) + (size_t)bh * SEQ; float* mlmx = (float*)(F.ws + WS_SM + SM_MLMX) + (size_t)bh * SEQ;
    float* mlm = (float*)(F.ws + WS_SM + SM_MLM) + bh * 132; float* mldec = (float*)(F.ws + WS_SM + SM_MLDEC) + bh * NCH;
    const float bi = INP(F, IN_MLBI)[l * ML_H + h], bf = INP(F, IN_MLBF)[l * ML_H + h];
    float areg[NCH / NWAVES];
#pragma unroll
    for (int ci = 0; ci < NCH / NWAVES; ++ci) {
        const int c = F.wave + NWAVES * ci, t = c * CHUNK + F.lane; const size_t m = (size_t)b * SEQ + t;
        const float lf = logsigmoid_f(gate16[m * 16 + 4 + h] + bf), li = gate16[m * 16 + h] + bi;
        const float bc = wave_scan_add(lf, F.lane), a = li - bc;
        const float amax = wave_max(a), btot = __shfl(bc, 63);
        mlb[t] = bc; mla[t] = a; areg[ci] = a;
        if (F.lane == 0) { Bc[c] = btot; Gc[c] = btot + amax; }
    }
    __syncthreads();
    if (F.tid == 0) { float mm = 0.f; for (int c = 0; c < NCH; ++c) { mc[c] = mm; const float mn = fmaxf(Bc[c] + mm, Gc[c]); mldec[c] = __expf(Bc[c] + mm - mn); mlm[c] = mm; mm = mn; } mc[NCH] = mm; mlm[NCH] = mm; }
    __syncthreads();
#pragma unroll
    for (int ci = 0; ci < NCH / NWAVES; ++ci) {
        const int c = F.wave + NWAVES * ci, t = c * CHUNK + F.lane;
        mlmx[t] = fmaxf(mc[c], wave_scan_max(areg[ci], F.lane));
    }
    __syncthreads();
}
__device__ __forceinline__ void prep_fox(Frame& F, int l, int bh) {
    LAS float* wtot = (LAS float*)(F.lds);
    const int b = bh >> 3, h = bh & 7;
    const float* gate16 = (const float*)(F.ws + WS_SM + SM_GATE16);
    float* nb = (float*)(F.ws + WS_SM + SM_FNB) + (size_t)bh * SEQ;
    const float bf = INP(F, IN_FXBF)[l * FX_H + h];
    float v[16]; float s = 0.f;
#pragma unroll
    for (int i = 0; i < 16; ++i) { const size_t m = (size_t)b * SEQ + F.tid * 16 + i; s += logsigmoid_f(gate16[m * 16 + 8 + h] + bf); v[i] = s; }
    const float incl = wave_scan_add(s, F.lane);
    if (F.lane == 63) wtot[F.wave] = incl;
    __syncthreads();
    float off = incl - s;
    for (int w = 0; w < F.wave; ++w) off += wtot[w];
#pragma unroll
    for (int i = 0; i < 16; ++i) nb[F.tid * 16 + i] = -1.4426950408889634f * (off + v[i]);
    __syncthreads();
}

__device__ __forceinline__ void unpack8(const v4u q, float (&f)[8]) {
    f[0] = __uint_as_float(q.x << 16); f[1] = __uint_as_float(q.x & 0xffff0000u); f[2] = __uint_as_float(q.y << 16); f[3] = __uint_as_float(q.y & 0xffff0000u);
    f[4] = __uint_as_float(q.z << 16); f[5] = __uint_as_float(q.z & 0xffff0000u); f[6] = __uint_as_float(q.w << 16); f[7] = __uint_as_float(q.w & 0xffff0000u);
}
__device__ __forceinline__ void pool_item(Frame& F, int item) {
    const bf16* U = (const bf16*)(F.ws + WS_NG + SL_POOL * SLAB_BYTES) + F.lane * 8; bf16* CAT = (bf16*)(F.ws + WS_CAT) + F.lane * 8;
    const int grp = F.lane >> 4, w = 2 << grp, m0 = item * 32, tt0 = m0 & (SEQ - 1);
    v4u ring[16];
#pragma unroll
    for (int j = 1; j < 16; ++j) { ring[(16 - j) & 15] = (v4u){0u, 0u, 0u, 0u}; if (tt0 - j >= 0) ring[(16 - j) & 15] = *(const GAS v4u*)(U + (size_t)(m0 - j) * 512); }
    float sum[8];
#pragma unroll
    for (int i = 0; i < 8; ++i) sum[i] = 0.f;
#pragma unroll
    for (int j = 1; j < 16; ++j) { float f[8]; unpack8(ring[(16 - j) & 15], f); const float on = (j < w) ? 1.f : 0.f;
#pragma unroll
        for (int i = 0; i < 8; ++i) sum[i] += on * f[i]; }
#pragma unroll
    for (int r0 = 0; r0 < 32; r0 += 8) {
        v4u cur[8];
#pragma unroll
        for (int j = 0; j < 8; ++j) cur[j] = *(const GAS v4u*)(U + (size_t)(m0 + r0 + j) * 512);
#pragma unroll
        for (int j = 0; j < 8; ++j) { const int r = r0 + j, tt = tt0 + r;
            float c[8]; unpack8(cur[j], c);
#pragma unroll
            for (int i = 0; i < 8; ++i) sum[i] += c[i];
            const int cnt = (tt + 1 < w) ? tt + 1 : w; const float inv = 1.f / (float)cnt;
            v4u o; o.x = pk2(sum[0] * inv - c[0], sum[1] * inv - c[1]); o.y = pk2(sum[2] * inv - c[2], sum[3] * inv - c[3]); o.z = pk2(sum[4] * inv - c[4], sum[5] * inv - c[5]); o.w = pk2(sum[6] * inv - c[6], sum[7] * inv - c[7]);
            *(GAS v4u*)(CAT + (size_t)(m0 + r) * KCAT) = o;
            const v4u a2 = (r - 1 >= 0 || true) ? ((r - 1) >= r0 ? cur[(j - 1) & 7] : ring[(r - 1) & 15]) : ring[0];
            const v4u a4 = ((r - 3) >= r0) ? cur[(j - 3) & 7] : ring[(r - 3) & 15];
            const v4u a8 = ((r - 7) >= r0) ? cur[(j - 7) & 7] : ring[(r - 7) & 15];
            const v4u a16 = ring[(r - 15) & 15];
            v4u old; old.x = grp == 0 ? a2.x : (grp == 1 ? a4.x : (grp == 2 ? a8.x : a16.x)); old.y = grp == 0 ? a2.y : (grp == 1 ? a4.y : (grp == 2 ? a8.y : a16.y));
            old.z = grp == 0 ? a2.z : (grp == 1 ? a4.z : (grp == 2 ? a8.z : a16.z)); old.w = grp == 0 ? a2.w : (grp == 1 ? a4.w : (grp == 2 ? a8.w : a16.w));
            float f[8]; unpack8(old, f);
#pragma unroll
            for (int i = 0; i < 8; ++i) sum[i] -= f[i];
        }
#pragma unroll
        for (int j = 0; j < 8; ++j) ring[(r0 + j) & 15] = cur[j];
    }
}

__device__ __forceinline__ void fox_norm_item(Frame& F, int it) {
    const int bhblk = it >> 3, wv = it & 7, bh = bhblk >> 5, blk = bhblk & 31, b = bh >> 3, h = bh & 7;
    const size_t m = (size_t)b * SEQ + blk * 256 + wv * 32 + (F.lane >> 1); const int col = h * 64 + (F.lane & 1) * 32;
    const bf16* QS = (const bf16*)(F.ws + WS_NG + SL_FQ * SLAB_BYTES) + m * 512 + col; const bf16* KS = (const bf16*)(F.ws + WS_NG + SL_FK * SLAB_BYTES) + m * 512 + col;
    float sq = 0.f, sk = 0.f, dq = 0.f;
#pragma unroll
    for (int i = 0; i < 4; ++i) { float f[8], g[8]; const v4u a = *(const GAS v4u*)(QS + 8 * i), c = *(const GAS v4u*)(KS + 8 * i);
        f[0] = __uint_as_float(a.x << 16); f[1] = __uint_as_float(a.x & 0xffff0000u); f[2] = __uint_as_float(a.y << 16); f[3] = __uint_as_float(a.y & 0xffff0000u); f[4] = __uint_as_float(a.z << 16); f[5] = __uint_as_float(a.z & 0xffff0000u); f[6] = __uint_as_float(a.w << 16); f[7] = __uint_as_float(a.w & 0xffff0000u);
        g[0] = __uint_as_float(c.x << 16); g[1] = __uint_as_float(c.x & 0xffff0000u); g[2] = __uint_as_float(c.y << 16); g[3] = __uint_as_float(c.y & 0xffff0000u); g[4] = __uint_as_float(c.z << 16); g[5] = __uint_as_float(c.z & 0xffff0000u); g[6] = __uint_as_float(c.w << 16); g[7] = __uint_as_float(c.w & 0xffff0000u);
#pragma unroll
        for (int j = 0; j < 8; ++j) { sq += f[j] * f[j]; sk += g[j] * g[j]; dq += f[j] * g[j]; } }
    sq += __shfl_xor(sq, 1); sk += __shfl_xor(sk, 1); dq += __shfl_xor(dq, 1);
    dq = -wave_max(-dq);
    sq = wave_max(sq) * 1.0001f; sk = wave_max(sk) * 1.0001f;
    if (F.lane == 0) { ((float*)(F.ws + WS_SM + SM_FQN))[it] = sq; ((float*)(F.ws + WS_SM + SM_FKN))[it] = sk; ((float*)(F.ws + WS_SM + SM_FXM))[it] = dq; }
}

typedef float f32x16 __attribute__((ext_vector_type(16)));
typedef unsigned u32x2 __attribute__((ext_vector_type(2)));
__device__ __forceinline__ float silu_f(float x) { return x * __builtin_amdgcn_rcpf(1.f + __builtin_amdgcn_exp2f(-1.4426950408889634f * x)); }
__device__ __forceinline__ void conv8(const bf16* slab, size_t m, int tt, int col, const float (&cw)[4][8], float (&o)[8]) {
    v4u q[4];
#pragma unroll
    for (int j = 0; j < 4; ++j) { const size_t mr = (tt - 3 + j >= 0) ? m - 3 + j : m; q[j] = *(const GAS v4u*)(slab + mr * 512 + col); }
#pragma unroll
    for (int i = 0; i < 8; ++i) o[i] = 0.f;
#pragma unroll
    for (int j = 0; j < 4; ++j) { float f[8]; unpack8(q[j], f); const float vld = (tt - 3 + j >= 0) ? 1.f : 0.f;
#pragma unroll
        for (int i = 0; i < 8; ++i) o[i] += (cw[j][i] * vld) * f[i]; }
#pragma unroll
    for (int i = 0; i < 8; ++i) o[i] = silu_f(o[i]);
}
constexpr int KT_P = 72, QS_P = 136;
__device__ __forceinline__ bf16x8 pack_acc8(const f32x16& x, int s) {
    v4u w; w.x = pk2(x[8 * s + 0], x[8 * s + 1]); w.y = pk2(x[8 * s + 2], x[8 * s + 3]); w.z = pk2(x[8 * s + 4], x[8 * s + 5]); w.w = pk2(x[8 * s + 6], x[8 * s + 7]);
    return __builtin_bit_cast(bf16x8, w);
}
__device__ __forceinline__ void conv8r(const v4u (&q)[4], int tt, const LAS float* cw, int col, float (&o)[8]) {
#pragma unroll
    for (int i = 0; i < 8; ++i) o[i] = 0.f;
#pragma unroll
    for (int j = 0; j < 4; ++j) { float f[8]; unpack8(q[j], f); const float vld = (tt - 3 + j >= 0) ? 1.f : 0.f;
        const f32x4 w0 = *(const LAS f32x4*)(cw + j * 512 + col) * vld, w1 = *(const LAS f32x4*)(cw + j * 512 + col + 4) * vld;
#pragma unroll
        for (int i = 0; i < 4; ++i) { o[i] += w0[i] * f[i]; o[4 + i] += w1[i] * f[4 + i]; } }
#pragma unroll
    for (int i = 0; i < 8; ++i) o[i] = silu_f(o[i]);
}
struct RawL { v4u k[2][4]; v4u v[2]; float fp, ip; };
__device__ __forceinline__ void mlstm_L_load(Frame& F, int u, RawL& R) {
    const int bh = u >> 7, c = u & (NCH - 1), b = bh >> 2, h = bh & 3;
    const bf16* KS = (const bf16*)(F.ws + WS_NG + SL_MK * SLAB_BYTES); const bf16* VS = (const bf16*)(F.ws + WS_NG + SL_MV * SLAB_BYTES);
    const int s = F.lane, tt = c * CHUNK + s; const size_t m = (size_t)b * SEQ + tt;
#pragma unroll
    for (int half = 0; half < 2; ++half) { const int col = h * ML_DH + (F.wave + 8 * half) * 8;
#pragma unroll
        for (int j = 0; j < 4; ++j) { const size_t mr = (tt - 3 + j >= 0) ? m - 3 + j : m; R.k[half][j] = *(const GAS v4u*)(KS + mr * 512 + col); }
        R.v[half] = *(const GAS v4u*)(VS + m * 512 + col); }
    const float* gate16 = (const float*)(F.ws + WS_SM + SM_GATE16) + m * 16;
    R.fp = gate16[4 + h]; R.ip = gate16[h];
}
__device__ __forceinline__ void mlstm_L_phase(Frame& F, int l) {
    LAS bf16* Kt = (LAS bf16*)(F.lds); LAS bf16* Vt = Kt + 128 * KT_P; LAS float* wk = (LAS float*)(F.lds + 2 * 128 * KT_P * 2); LAS float* cwk = (LAS float*)(F.lds + 40960);
    for (int i = F.tid; i < 4 * 512; i += NWAVES * 64) cwk[i] = INP(F, IN_CONVW)[(size_t)l * 4 * 1024 + (i >> 9) * 1024 + 512 + (i & 511)];
    const int NU = BATCH * ML_H * NCH;
    float b_f[ML_H], b_i[ML_H];
#pragma unroll
    for (int i = 0; i < ML_H; ++i) { b_f[i] = INP(F, IN_MLBF)[l * ML_H + i]; b_i[i] = INP(F, IN_MLBI)[l * ML_H + i]; }
    int u = F.vcu; if (u >= NU) { __syncthreads(); return; }
    RawL cur; mlstm_L_load(F, u, cur);
    __syncthreads();
    for (; u < NU; u += F.G) {
        const int bh = u >> 7, h = bh & 3;
        if (F.tid < CHUNK) {
            const float lf = logsigmoid_f(cur.fp + b_f[h]), li = cur.ip + b_i[h];
            const float bc = wave_scan_add(lf, F.lane), a = li - bc, amax = wave_max(a);
            wk[F.tid] = __expf(a - amax);
            const int c = u & (NCH - 1);
            ((float*)(F.ws + WS_SM + SM_MLB))[(size_t)bh * SEQ + c * CHUNK + F.tid] = bc; ((float*)(F.ws + WS_SM + SM_MLA))[(size_t)bh * SEQ + c * CHUNK + F.tid] = a;
            if (F.tid == 63) { float* bg = (float*)(F.ws + WS_SM + SM_MLBG) + 2 * u; bg[0] = bc; bg[1] = bc + amax; }
        }
        __syncthreads();
        {   const int s = F.lane, tt = (u & (NCH - 1)) * CHUNK + s;
#pragma unroll
            for (int half = 0; half < 2; ++half) { const int cg = F.wave + 8 * half, col = h * ML_DH + cg * 8;
                float kk[8]; conv8r(cur.k[half], tt, cwk, col, kk);
                float vv[8]; unpack8(cur.v[half], vv); const float ws = wk[s];
#pragma unroll
                for (int i = 0; i < 8; ++i) { Kt[(cg * 8 + i) * KT_P + s] = (bf16)f2bf(kk[i] * 0.08838834764831845f); Vt[(cg * 8 + i) * KT_P + s] = (bf16)f2bf(vv[i] * ws); } }
        }
        __syncthreads();
        if (u + F.G < NU) mlstm_L_load(F, u + F.G, cur);
        {   const int r = F.lane & 31, hi = F.lane >> 5, kb = F.wave >> 1;
            f32x16 acc[2]; acc[0] = f32x16{}; acc[1] = f32x16{};
#pragma unroll
            for (int sp = 0; sp < 4; ++sp) { const bf16x8 a = *(const LAS bf16x8*)(Kt + (kb * 32 + r) * KT_P + 16 * sp + 8 * hi);
#pragma unroll
                for (int j = 0; j < 2; ++j) { const int vb = 2 * (F.wave & 1) + j; const bf16x8 bb = *(const LAS bf16x8*)(Vt + (vb * 32 + r) * KT_P + 16 * sp + 8 * hi);
                    acc[j] = __builtin_amdgcn_mfma_f32_32x32x16_bf16(a, bb, acc[j], 0, 0, 0); } }
            GAS bf16x8* img = (GAS bf16x8*)(F.ws + WS_MLC + (size_t)u * 32768);
#pragma unroll
            for (int j = 0; j < 2; ++j) { const int vb = 2 * (F.wave & 1) + j;
#pragma unroll
                for (int s = 0; s < 2; ++s) img[((vb * 4 + kb) * 2 + s) * 64 + F.lane] = pack_acc8(acc[j], s); }
        }
        if (F.tid < ML_DH) { float a = 0.f;
#pragma unroll 8
            for (int s = 0; s < CHUNK; ++s) a += wk[s] * __uint_as_float((unsigned)Kt[F.tid * KT_P + s] << 16);
            ((float*)(F.ws + WS_SM + SM_MLN))[(size_t)u * ML_DH + F.tid] = a; }
        __syncthreads();
    }
}
__device__ __forceinline__ void mlstm_S(Frame& F) {
    LAS float* dec = (LAS float*)(F.lds); LAS float* cor = dec + NCH;
    for (int unit = F.vcu; unit < 16 * 16; unit += F.G) {
        const int bh = unit >> 4, part = unit & 15;
        if (F.tid == 0) { const float* bg = (const float*)(F.ws + WS_SM + SM_MLBG) + 2 * bh * NCH; float* mlm = (float*)(F.ws + WS_SM + SM_MLM) + bh * 132; float mm = 0.f;
            for (int c = 0; c < NCH; ++c) { const float B = bg[2 * c], G = bg[2 * c + 1], mn = fmaxf(B + mm, G); dec[c] = __expf(B + mm - mn); cor[c] = __expf(G - mn); mlm[c] = mm; mm = mn; }
            mlm[NCH] = mm; }
        __syncthreads();
        {   const int e2 = part * 512 + F.tid; GAS unsigned* p = (GAS unsigned*)(F.ws + WS_MLC + (size_t)bh * NCH * 32768) + e2;
            float r0 = 0.f, r1 = 0.f;
            for (int c0 = 0; c0 < NCH; c0 += 16) { unsigned q[16];
#pragma unroll
                for (int i = 0; i < 16; ++i) q[i] = p[(size_t)(c0 + i) * 8192];
#pragma unroll
                for (int i = 0; i < 16; ++i) { const float d = dec[c0 + i], k = cor[c0 + i]; p[(size_t)(c0 + i) * 8192] = pk2(r0, r1);
                    r0 = d * r0 + k * __uint_as_float(q[i] << 16); r1 = d * r1 + k * __uint_as_float(q[i] & 0xffff0000u); } } }
        if (part == 0 && F.tid < ML_DH) { float* p = (float*)(F.ws + WS_SM + SM_MLN) + (size_t)bh * NCH * ML_DH + F.tid;
            float r = 0.f;
            for (int c0 = 0; c0 < NCH; c0 += 16) { float q[16];
#pragma unroll
                for (int i = 0; i < 16; ++i) q[i] = p[(size_t)(c0 + i) * ML_DH];
#pragma unroll
                for (int i = 0; i < 16; ++i) { p[(size_t)(c0 + i) * ML_DH] = r; r = dec[c0 + i] * r + cor[c0 + i] * q[i]; } } }
        __syncthreads();
    }
}
#define O_BAR() do { asm volatile("s_waitcnt lgkmcnt(0)" ::: "memory"); __builtin_amdgcn_s_barrier(); asm volatile("" ::: "memory"); } while (0)
constexpr int O_RAWQ = 73728, O_RAWK = O_RAWQ + 68 * 256, O_RAWV = O_RAWK + 68 * 256, O_END = O_RAWV + 64 * 256;
static_assert(O_END + 3 * 2 * 1024 <= RING_BYTES, "mLSTM O-phase LDS map");
__device__ __forceinline__ void mlstm_O_dma(Frame& F, int u) {
    const int bh = u >> 7, c = u & (NCH - 1), b = bh >> 2, h = bh & 3;
    const size_t seq0 = (size_t)b * SEQ; const int t0 = c * CHUNK;
    for (int i = F.wave; i < 50; i += NWAVES) {
        const int ten = i < 17 ? 0 : (i < 34 ? 1 : 2), ii = i - 17 * ten, row = 4 * ii + (F.lane >> 4);
        int t = (ten == 2) ? t0 + row : t0 - 3 + row; t = t < 0 ? 0 : (t > t0 + CHUNK - 1 ? t0 + CHUNK - 1 : t);
        const bf16* src = (const bf16*)(F.ws + WS_NG + (size_t)(ten == 0 ? SL_MQ : (ten == 1 ? SL_MK : SL_MV)) * SLAB_BYTES) + (seq0 + t) * 512 + h * ML_DH + (((F.lane & 15) ^ (row & 15)) * 8);
        const int dst = (ten == 0 ? O_RAWQ : (ten == 1 ? O_RAWK : O_RAWV)) + ii * 1024;
        __builtin_amdgcn_global_load_lds((const GAS unsigned*)src, (LAS unsigned*)(F.lds + dst), 16, 0, 0);
    }
}
__device__ __forceinline__ void conv8l(const LAS bf16* raw, int s, int tt, const LAS float* cw, int cg, int col, float (&o)[8]) {
#pragma unroll
    for (int i = 0; i < 8; ++i) o[i] = 0.f;
#pragma unroll
    for (int j = 0; j < 4; ++j) { float f[8]; unpack8(*(const LAS v4u*)(raw + (s + j) * 128 + ((cg ^ ((s + j) & 15)) * 8)), f); const float vld = (tt - 3 + j >= 0) ? 1.f : 0.f;
        const f32x4 w0 = *(const LAS f32x4*)(cw + j * 512 + col) * vld, w1 = *(const LAS f32x4*)(cw + j * 512 + col + 4) * vld;
#pragma unroll
        for (int i = 0; i < 4; ++i) { o[i] += w0[i] * f[i]; o[4 + i] += w1[i] * f[4 + i]; } }
#pragma unroll
    for (int i = 0; i < 8; ++i) o[i] = silu_f(o[i]);
}
__device__ __forceinline__ void mlstm_O_phase(Frame& F, int l) {
    LAS bf16* Qs = (LAS bf16*)(F.lds); LAS bf16* Ks = Qs + 64 * QS_P; LAS bf16* Vt = Ks + 64 * QS_P;
    LAS float* fa = (LAS float*)(F.lds + (2 * 64 * QS_P + 128 * KT_P) * 2); LAS float* fmx = fa + 64; LAS float* fb = fa + 128; LAS float* nvec = fa + 192; LAS float* ssq = fa + 320;
    LAS float* cwq = (LAS float*)(F.lds + 57344); LAS float* cwk = cwq + 4 * 512;
    LAS float* psm = (LAS float*)(F.lds + 55552); LAS float* nqp = psm + 96; LAS bf16x8* pimg = (LAS bf16x8*)(F.lds + O_END);
    const LAS bf16* rawq = (const LAS bf16*)(F.lds + O_RAWQ); const LAS bf16* rawk = (const LAS bf16*)(F.lds + O_RAWK); const LAS bf16* rawv = (const LAS bf16*)(F.lds + O_RAWV);
    for (int i = F.tid; i < 4 * 512; i += NWAVES * 64) { cwq[i] = INP(F, IN_CONVW)[(size_t)l * 4 * 1024 + (i >> 9) * 1024 + (i & 511)]; cwk[i] = INP(F, IN_CONVW)[(size_t)l * 4 * 1024 + (i >> 9) * 1024 + 512 + (i & 511)]; }
    const int NU = BATCH * ML_H * NCH;
    int u = F.vcu; if (u >= NU) { __syncthreads(); return; }
    mlstm_O_dma(F, u);
    const bf16* OS = (const bf16*)(F.ws + WS_NG + SL_MO * SLAB_BYTES);
    const int r = F.lane & 31, hi = F.lane >> 5, tb = F.wave & 1, vb = F.wave >> 1;
    for (; u < NU; u += F.G) {
    const int bh = u >> 7, c = u & (NCH - 1), b = bh >> 2, h = bh & 3;
    asm volatile("s_waitcnt vmcnt(0)" ::: "memory"); O_BAR();
    const float m_c = ((const float*)(F.ws + WS_SM + SM_MLM))[bh * 132 + c];
    bf16x8 cf[4][2];
    {   const GAS bf16x8* img = (const GAS bf16x8*)(F.ws + WS_MLC + (size_t)u * 32768);
#pragma unroll
        for (int kb = 0; kb < 4; ++kb)
#pragma unroll
            for (int s = 0; s < 2; ++s) cf[kb][s] = img[((vb * 4 + kb) * 2 + s) * 64 + F.lane]; }
    u32x2 oww[4];
    {   const size_t m = (size_t)b * SEQ + c * CHUNK + tb * 32 + r;
#pragma unroll
        for (int q = 0; q < 4; ++q) oww[q] = *(const GAS u32x2*)(OS + m * 512 + h * ML_DH + vb * 32 + 8 * q + 4 * hi); }
    float g0 = 0.f, g1 = 0.f, g2 = 0.f;
    {   const float* mlb = (const float*)(F.ws + WS_SM + SM_MLB) + (size_t)bh * SEQ; const float* mla = (const float*)(F.ws + WS_SM + SM_MLA) + (size_t)bh * SEQ; const float* mlmx = (const float*)(F.ws + WS_SM + SM_MLMX) + (size_t)bh * SEQ;
        if (F.tid < CHUNK) { g0 = mla[c * CHUNK + F.tid]; g2 = mlb[c * CHUNK + F.tid]; g1 = fmaxf(m_c, wave_scan_max(g0, F.lane)); }
        else if (F.tid < CHUNK + ML_DH) g0 = ((const float*)(F.ws + WS_SM + SM_MLN))[(size_t)u * ML_DH + F.tid - CHUNK]; }
    {   const int s = F.lane, tt = c * CHUNK + s;
#pragma unroll
        for (int half = 0; half < 2; ++half) { const int cg = F.wave + 8 * half, col = h * ML_DH + cg * 8;
            float qq[8], kk[8], vv[8]; conv8l(rawq, s, tt, cwq, cg, col, qq); conv8l(rawk, s, tt, cwk, cg, col, kk); unpack8(*(const LAS v4u*)(rawv + s * 128 + ((cg ^ (s & 15)) * 8)), vv);
            v4u wq, wkk; wq.x = pk2(qq[0], qq[1]); wq.y = pk2(qq[2], qq[3]); wq.z = pk2(qq[4], qq[5]); wq.w = pk2(qq[6], qq[7]);
            const float sc = 0.08838834764831845f;
            wkk.x = pk2(kk[0] * sc, kk[1] * sc); wkk.y = pk2(kk[2] * sc, kk[3] * sc); wkk.z = pk2(kk[4] * sc, kk[5] * sc); wkk.w = pk2(kk[6] * sc, kk[7] * sc);
            *(LAS v4u*)(Qs + s * QS_P + cg * 8) = wq; *(LAS v4u*)(Ks + s * QS_P + cg * 8) = wkk;
#pragma unroll
            for (int i = 0; i < 8; ++i) Vt[(cg * 8 + i) * KT_P + s] = (bf16)f2bf(vv[i]); }
    }
    if (F.tid < CHUNK) { fa[F.tid] = g0; fmx[F.tid] = g1; fb[F.tid] = g2; }
    else if (F.tid < CHUNK + ML_DH) nvec[F.tid - CHUNK] = g0;
    O_BAR();
    if (u + F.G < NU) mlstm_O_dma(F, u + F.G);
    const int t = tb * 32 + r;
    const float Mx_t = fmx[t], m_t = fb[t] + Mx_t, w_int = __expf(m_c - Mx_t);
    if (F.wave < 3) {
        const int tbs = F.wave ? 1 : 0, sbs = F.wave == 2 ? 1 : 0, ts = tbs * 32 + r; const float Mxs = fmx[ts];
        f32x16 x = f32x16{};
#pragma unroll
        for (int ks = 0; ks < 8; ++ks) { const bf16x8 a = *(const LAS bf16x8*)(Ks + (sbs * 32 + r) * QS_P + 16 * ks + 8 * hi); const bf16x8 q = *(const LAS bf16x8*)(Qs + ts * QS_P + 16 * ks + 8 * hi);
            x = __builtin_amdgcn_mfma_f32_32x32x16_bf16(a, q, x, 0, 0, 0); }
        float ps = 0.f;
#pragma unroll
        for (int rr = 0; rr < 16; ++rr) { const int s = sbs * 32 + (rr & 3) + 8 * (rr >> 2) + 4 * hi; const float pv = (s <= ts) ? __expf(fa[s] - Mxs) * x[rr] : 0.f; x[rr] = pv; ps += pv; }
        ps += __shfl_xor(ps, 32);
        pimg[(F.wave * 2 + 0) * 64 + F.lane] = pack_acc8(x, 0); pimg[(F.wave * 2 + 1) * 64 + F.lane] = pack_acc8(x, 1);
        if (hi == 0) psm[F.wave * 32 + r] = ps;
    }
    {   float nq = 0.f;
#pragma unroll
        for (int i = 0; i < 2; ++i) { float f[8]; unpack8(*(const LAS v4u*)(Qs + t * QS_P + 32 * vb + 16 * hi + 8 * i), f);
#pragma unroll
            for (int j = 0; j < 8; ++j) nq += f[j] * nvec[32 * vb + 16 * hi + 8 * i + j]; }
        nq += __shfl_xor(nq, 32);
        if (hi == 0) nqp[vb * 64 + t] = nq; }
    f32x16 acc = f32x16{};
#pragma unroll
    for (int kb = 0; kb < 4; ++kb)
#pragma unroll
        for (int s = 0; s < 2; ++s) { const u32x2 lo = *(const LAS u32x2*)(Qs + t * QS_P + kb * 32 + 16 * s + 4 * hi), hi2 = *(const LAS u32x2*)(Qs + t * QS_P + kb * 32 + 16 * s + 8 + 4 * hi);
            v4u w; w.x = lo.x; w.y = lo.y; w.z = hi2.x; w.w = hi2.y;
            acc = __builtin_amdgcn_mfma_f32_32x32x16_bf16(cf[kb][s], __builtin_bit_cast(bf16x8, w), acc, 0, 0, 0); }
#pragma unroll
    for (int rr = 0; rr < 16; ++rr) acc[rr] *= w_int;
    O_BAR();
    float psum = 0.f;
#pragma unroll
    for (int sb = 0; sb < 2; ++sb) {
        if (sb <= tb) { const int blk = tb == 0 ? 0 : 1 + sb; psum += psm[blk * 32 + r];
#pragma unroll
            for (int s = 0; s < 2; ++s) { const u32x2 lo = *(const LAS u32x2*)(Vt + (vb * 32 + r) * KT_P + sb * 32 + 16 * s + 4 * hi), hi2 = *(const LAS u32x2*)(Vt + (vb * 32 + r) * KT_P + sb * 32 + 16 * s + 8 + 4 * hi);
                v4u w; w.x = lo.x; w.y = lo.y; w.z = hi2.x; w.w = hi2.y;
                acc = __builtin_amdgcn_mfma_f32_32x32x16_bf16(__builtin_bit_cast(bf16x8, w), pimg[(blk * 2 + s) * 64 + F.lane], acc, 0, 0, 0); }
        }
    }
    const float nq = (nqp[t] + nqp[64 + t]) + (nqp[128 + t] + nqp[192 + t]);
    const float den = w_int * nq + psum, inv = 1.f / fmaxf(fabsf(den), __expf(-m_t));
    float sq = 0.f;
#pragma unroll
    for (int rr = 0; rr < 16; ++rr) { acc[rr] *= inv; sq += acc[rr] * acc[rr]; }
    sq += __shfl_xor(sq, 32);
    if (hi == 0) ssq[vb * 64 + t] = sq;
    O_BAR();
    const float rstd = 1.f / sqrtf((ssq[t] + ssq[64 + t] + ssq[128 + t] + ssq[192 + t]) * (1.f / ML_DH) + NORM_EPS);
    {   const size_t m = (size_t)b * SEQ + c * CHUNK + t; bf16* CAT = (bf16*)(F.ws + WS_CAT);
#pragma unroll
        for (int q = 0; q < 4; ++q) { const int v0 = vb * 32 + 8 * q + 4 * hi, col = h * ML_DH + v0;
            const u32x2 ow = oww[q]; const f32x4 gn = *(const GAS f32x4*)(INP(F, IN_MLNG) + (size_t)l * 512 + col);
            const float o0 = sigmoid_f(__uint_as_float(ow.x << 16)), o1 = sigmoid_f(__uint_as_float(ow.x & 0xffff0000u)), o2 = sigmoid_f(__uint_as_float(ow.y << 16)), o3 = sigmoid_f(__uint_as_float(ow.y & 0xffff0000u));
            u32x2 w; w.x = pk2(acc[4 * q] * rstd * gn.x * o0, acc[4 * q + 1] * rstd * gn.y * o1); w.y = pk2(acc[4 * q + 2] * rstd * gn.z * o2, acc[4 * q + 3] * rstd * gn.w * o3);
            *(GAS u32x2*)(CAT + m * KCAT + 512 + col) = w; }
    }
    }
    asm volatile("s_waitcnt vmcnt(0)" ::: "memory"); O_BAR();
}
#undef O_BAR

#ifndef SUBP
#define SUBP 0
#endif
#ifndef MK_MULTI
#define MK_MULTI 0
#endif
constexpr int NPH = 1 + (8 + 1) + (1 + 8 + 4) + 1;
#ifndef PH_MASK
#define PH_MASK 0xffffffffu
#endif
#ifndef PROBE_MASK
#define PROBE_MASK 0u
#endif
#define PH_BEGIN(id) if (ph >= lo && ph < hi) { if constexpr (((PH_MASK) >> (id)) & 1u) { for (int rep_ = 0; rep_ < 1 + (int)(((PROBE_MASK) >> (id)) & 1u); ++rep_) { Frame F = FK; { size_t z_ = 0; int zi_ = 0; asm volatile("" : "+v"(F.tid), "+s"(z_), "+s"(zi_)); \
        F.lane = F.tid & 63; F.ws = FK.ws + z_; F.out = (float*)((char*)FK.out + z_); F.zi = zi_; } const int gw = F.vcu * NWAVES + F.wave, NGWV = F.G * NWAVES; (void)gw; (void)NGWV;
#define PH_END __syncthreads(); } } if (ph + 1 < hi) { XcdBarrier b2_ = bar; size_t zb_ = 0; asm volatile("" : "+s"(zb_)); b2_.bar = bar.bar + zb_; xcd_barrier(b2_); } } ++ph;
#define HB ((bf16*)(F.ws + WS_HB))
#define CAT ((bf16*)(F.ws + WS_CAT))
#define SLAB ((bf16*)(F.ws + WS_NG))
#define GATE ((bf16*)(F.ws + WS_GATE))
#define WL ((bf16*)(F.ws + WS_W + (size_t)l * W_LAYER))
#define XBP ((bf16*)F.out)

template <int l> __device__ __forceinline__ void layer_phases(Frame& FK, int& ph, const int lo, const int hi, const XcdBarrier& bar, unsigned char* lds) {
        if constexpr (l > 0) { PH_BEGIN(1) phase_norm_mix<true>(F, XBP, l); PH_END }
        PH_BEGIN(2)
            pg8::Gemm g{HB, WL + W_NG / 2, M, NGW, D}; pg8::StaticOrder S; S.init(M, NGW, F.G, F.blk);
            pg8::EpiSlab E{SLAB, (size_t)M * 512, SL_FQ, attn_body::C2};
            pg8::gemm_phase<pg8::EpiSlab, pg8::StaticOrder, true, true>(F.lds + RING_OFF, g, S, E);
        PH_END
        PH_BEGIN(3)
            for (int s = F.blk; s < BATCH * FX_H; s += F.G) prep_fox(F, l, s);
            for (int rp = 0; rp < (SUBP == 1 ? 2 : 1); ++rp) for (int it = gw; it < M / 32; it += NGWV) pool_item(F, it);
            for (int rp = 0; rp < (SUBP == 2 ? 2 : 1); ++rp) for (int it = gw; it < BATCH * FX_H * 32 * 8; it += NGWV) fox_norm_item(F, it);
            for (int rp = 0; rp < (SUBP == 3 ? 2 : 1); ++rp) mlstm_L_phase(F, l);
        PH_END
        PH_BEGIN(4)
            mlstm_S(F);
            for (int ui = gw; ui < BATCH * FX_H * 32; ui += NGWV) { const int bh = ui >> 5, qb = ui & 31;
                const int t0 = attn_body::attn_t0(qb, (const float*)(F.ws + WS_SM + SM_FNB) + (size_t)bh * SEQ, (const float*)(F.ws + WS_SM + SM_FQN) + bh * 256, (const float*)(F.ws + WS_SM + SM_FKN) + bh * 256, (const float*)(F.ws + WS_SM + SM_FXM) + bh * 256, F.lane);
                if (F.lane == 0) ((int*)(F.ws + WS_SM + SM_FT0))[ui] = t0; }
        PH_END
        PH_BEGIN(18)
            for (int rp = 0; rp < (SUBP == 4 ? 2 : 1); ++rp) mlstm_O_phase(F, l);
            const attn_body::AttnTensors AT{(const attn_body::bf16*)(SLAB + (size_t)SL_FQ * M * 512), (const attn_body::bf16*)(SLAB + (size_t)SL_FK * M * 512), (const attn_body::bf16*)(SLAB + (size_t)SL_FV * M * 512),
                                            (attn_body::bf16*)CAT, (const float*)(F.ws + WS_SM + SM_FNB), (const float*)(F.ws + WS_SM + SM_FQN), (const float*)(F.ws + WS_SM + SM_FKN), (const int*)(F.ws + WS_SM + SM_FT0)};
            attn_body::attn_phase_dyn<8>((char*)lds + RING_OFF, AT, (unsigned*)(F.ctl + 2048 + 64 * l), F.MISC + 0);
            quant_rows_fp8(F, HB, F.ws + WS_NG + (size_t)SL_POOL * SLAB_BYTES);
        PH_END
        PH_BEGIN(6)
            pg8::Gemm g{(const bf16*)(F.ws + WS_NG + (size_t)SL_POOL * SLAB_BYTES), WL + W_GT / 2, M, NGT, D / 2}; pg8::StaticOrder S; S.init(M, NGT, F.G, F.blk);
            pg8::EpiSig E{(unsigned char*)GATE, 1.f / (FP8_ASCALE * FP8_WSCALE)};
            pg8::gemm_phase<pg8::EpiSig, pg8::StaticOrder, true, true, true>(F.lds + RING_OFF, g, S, E);
        PH_END
        PH_BEGIN(7)
            pg8::Gemm g{CAT, WL + W_CAT / 2, M, D, KCAT}; pg8::StaticOrder S; S.init(M, D, F.G, F.blk);
            pg8::EpiMerge E{(const unsigned char*)GATE, HB};
            pg8::gemm_phase<pg8::EpiMerge, pg8::StaticOrder, true, true>(F.lds + RING_OFF, g, S, E);
        PH_END
        PH_BEGIN(8)
            pg8::Gemm g{HB, WL + W_OUT / 2, M, D, D}; pg8::StaticOrder S; S.init(M, D, F.G, F.blk);
            if constexpr (l == 0) { pg8::EpiResB<true> E{INP(F, IN_X), XBP, (float*)(F.ws + WS_SM + SM_GATE16)};     pg8::gemm_phase<pg8::EpiResB<true>, pg8::StaticOrder, true, true>(F.lds + RING_OFF, g, S, E); }
            else { pg8::EpiResB<false> E{XBP, XBP, nullptr}; pg8::gemm_phase<pg8::EpiResB<false>, pg8::StaticOrder, true, true>(F.lds + RING_OFF, g, S, E); }
        PH_END
        if constexpr (l == 0) {
            PH_BEGIN(10)
                pg8::Gemm g{XBP, (const bf16*)(F.ws + WS_WGU), M, 2 * DFF, D}; pg8::StaticOrder S; S.init(M, 2 * DFF, F.G, F.blk);
                pg8::EpiSwiGLUR E{(bf16*)(F.ws + WS_ACT0), DFF, (const float*)(F.ws + WS_SM + SM_GATE16), 1.f / D, NORM_EPS};
                pg8::gemm_phase<pg8::EpiSwiGLUR, pg8::StaticOrder, true, true, false, XLD, XROT>(F.lds + RING_OFF, g, S, E);
            PH_END
            PH_BEGIN(11)
                pg8::Gemm g{(const bf16*)(F.ws + WS_ACT0), (const bf16*)(F.ws + WS_WDN), M, D, DFF}; pg8::StaticOrder S; S.init(M, D, F.G, F.blk);
                pg8::EpiResB<false> E{XBP, XBP, nullptr};
                pg8::gemm_phase<pg8::EpiResB<false>, pg8::StaticOrder, true, true>(F.lds + RING_OFF, g, S, E);
            PH_END
        } else {
            PH_BEGIN(12)
                phase_route1(F, XBP);
                __syncthreads();
                LAS float* scr = (LAS float*)(F.lds + F.wave * 16384);
                for (int it = gw; it < CI_MOE; it += NGWV) conv_item_moe(F, it, scr);
            PH_END
            PH_BEGIN(13) phase_route2(F, XBP); PH_END
#define MOE_UP(k_, S_) do { pg8::Gemm g{(const bf16*)(F.ws + WS_XS + (size_t)(k_) * MOE_KROWS * D), (const bf16*)(F.ws + WS_MOEGU), MOE_KROWS, 2 * DFE, D / 2}; \
                    pg8::EpiSwiGLU8 E{F.ws + WS_ACT1 + (size_t)(k_) * MOE_KROWS * DFE, DFE, 1.f / (FP8_ASCALE * FP8_WSCALE), FP8_ASCALE}; \
                    pg8::gemm_phase<pg8::EpiSwiGLU8, decltype(S_), true, true, true>(F.lds + RING_OFF, g, S_, E); } while (0)
#define MOE_DOWN(k_) do { pg8::Gemm g{(const bf16*)(F.ws + WS_ACT1 + (size_t)(k_) * MOE_KROWS * DFE), (const bf16*)(F.ws + WS_MOEDN), MOE_KROWS, D, DFE / 2}; pg8::MoeOrder S; S.init(nM[k_], D / 256, F.G, F.blk, tile_e + (k_) * MOE_KTILES); \
                    pg8::EpiMoeDown E{(bf16*)(F.ws + ((k_) == 0 ? WS_Y0 : WS_Y1)), (const int*)(sm + MO_ROWTOK) + (k_) * MOE_KROWS, (const float*)(sm + MO_ROWG) + (k_) * MOE_KROWS, 1.f / (FP8_ASCALE * FP8_WSCALE)}; \
                    pg8::gemm_phase<pg8::EpiMoeDown, pg8::MoeOrder, true, true, true>(F.lds + RING_OFF, g, S, E); } while (0)
#define MOE_TABLES unsigned char* sm = F.ws + WS_SM + SM_MOE; LAS int* tile_e = (LAS int*)(F.lds + LDSCTL_OFF + 1024); \
                    for (int i_ = F.tid; i_ < 2 * MOE_KTILES; i_ += NWAVES * 64) tile_e[i_] = __hip_atomic_load((const int*)(sm + MO_TILEE) + i_, RLX_AGENT); __syncthreads(); \
                    const int nM[2] = {__builtin_amdgcn_readfirstlane(__hip_atomic_load((const int*)(sm + MO_NT), RLX_AGENT)), __builtin_amdgcn_readfirstlane(__hip_atomic_load((const int*)(sm + MO_NT) + 1, RLX_AGENT))};
            PH_BEGIN(14)
                MOE_TABLES
                pg8::MoeOrder S; S.init(nM[0], 2 * DFE / 256, F.G, F.blk, tile_e);
                MOE_UP(0, S);
            PH_END
            PH_BEGIN(15)
                MOE_TABLES
                MOE_DOWN(0);
                { const int Nd = nM[0] * (D / 256); pg8::MoeOrderHL R; R.init(nM[1], 2 * DFE / 256, F.G, F.blk, (F.G % 8 == 0) ? Nd % F.G : 0, 3.5f, tile_e + MOE_KTILES);
                  MOE_UP(1, R); }
            PH_END
            PH_BEGIN(19)
                MOE_TABLES
                MOE_DOWN(1);
            PH_END
#undef MOE_UP
#undef MOE_DOWN
#undef MOE_TABLES
        }
    }
struct Args { const float* in[24]; float* out; unsigned char* ws; int ph_lo, ph_hi; };
__global__ void __launch_bounds__(NWAVES * 64, 2) fwd(Args args) {
    extern __shared__ __attribute__((aligned(16))) unsigned char lds[];
    Frame FK;
    FK.lds = (LAS unsigned char*)lds;
    FK.MISC = (volatile LAS unsigned*)(FK.lds + MISC_OFF);
    FK.tid = threadIdx.x; FK.lane = FK.tid & 63; FK.wave = __builtin_amdgcn_readfirstlane(FK.tid >> 6);
    FK.G = gridDim.x; FK.blk = blockIdx.x; { const int bx = blockIdx.x; FK.vcu = (FK.G % 8 == 0) ? (bx % 8) * (FK.G / 8) + bx / 8 : bx; }
    FK.ws = args.ws; FK.ctl = (gu32*)(args.ws + WS_CTL); FK.out = args.out;
    FK.in = args.in; FK.zi = 0;
    for (int u = FK.tid; u < (LDS_BYTES - LDSCTL_OFF) / 4; u += NWAVES * 64) ((LAS unsigned*)(FK.lds + LDSCTL_OFF))[u] = 0u;
    __syncthreads();
    const int lo = args.ph_lo, hi = args.ph_hi;
    XcdBarrier bar; bar.bar = (unsigned*)(FK.ctl + CW_BAR); bar.x = 0; bar.st = nullptr;
    if (hi - lo > 1) bar = xcd_barrier_post((unsigned*)(FK.ctl + CW_BAR), FK.MISC + 8);
    int ph = 0;
    PH_BEGIN(0)
        LAS float* scr = (LAS float*)(F.lds + F.wave * 16384);
        for (int it = gw; it < CI_MAIN; it += NGWV) conv_item_main(F, it, scr);
        pool_fold(F);
        __syncthreads();
        phase_norm_mix<false>(F, INP(F, IN_X), 0);
    PH_END

    layer_phases<0>(FK, ph, lo, hi, bar, lds);
    layer_phases<1>(FK, ph, lo, hi, bar, lds);
    PH_BEGIN(16) phase_norm_final(F, XBP, F.out); PH_END
#undef PH_BEGIN
#undef HB
#undef CAT
#undef SLAB
#undef GATE
#undef WL
#undef XBP
#undef PH_END
}

extern "C" void kernel_launch(void* const* d_in, const int* in_sizes, int n_in, void* d_out, int out_size, void* d_ws, size_t ws_size, hipStream_t stream) {
    static int grid = 0;
    if (grid == 0) {
        if (n_in != 24 || in_sizes[0] != M * D || out_size != M * D || ws_size < WS_END) { fprintf(stderr, "kernel_launch: built for 24 inputs, x/out of %d floats, >= %zu bytes of workspace; got n_in %d, in0 %d, out %d, ws %zu; nothing launched\n", M * D, (size_t)WS_END, n_in, n_in > 0 ? in_sizes[0] : -1, out_size, ws_size); grid = -1; return; }
        int dev = 0, cus = 0, per_cu = 0;
        if (hipGetDevice(&dev) != hipSuccess || hipDeviceGetAttribute(&cus, hipDeviceAttributeMultiprocessorCount, dev) != hipSuccess) { fprintf(stderr, "kernel_launch: hipGetDevice / hipDeviceGetAttribute failed\n"); grid = -1; return; }
        if (hipFuncSetAttribute((const void*)fwd, hipFuncAttributeMaxDynamicSharedMemorySize, LDS_BYTES) != hipSuccess) { fprintf(stderr, "kernel_launch: hipFuncSetAttribute failed\n"); grid = -1; return; }
        if (hipOccupancyMaxActiveBlocksPerMultiprocessor(&per_cu, (const void*)fwd, NWAVES * 64, LDS_BYTES) != hipSuccess || per_cu < 1)
            fprintf(stderr, "kernel_launch: note: the occupancy query reports %d workgroups per CU\n", per_cu);
        (void)hipGetLastError();
        grid = cus;
    }
    if (grid < 0) return;
    if (hipMemsetAsync((char*)d_ws + WS_CTL, 0, CTL_ZERO_BYTES, stream) != hipSuccess) { fprintf(stderr, "kernel_launch: hipMemsetAsync failed\n"); return; }
    Args a{};
    for (int i = 0; i < 24; ++i) a.in[i] = (const float*)d_in[i];
    a.out = (float*)d_out; a.ws = (unsigned char*)d_ws;
#if MK_MULTI
    for (int p = 0; p < NPH; ++p) { a.ph_lo = p; a.ph_hi = p + 1; hipLaunchKernelGGL(fwd, dim3(grid), dim3(NWAVES * 64), LDS_BYTES, stream, a); }
#else
    a.ph_lo = 0; a.ph_hi = NPH; hipLaunchKernelGGL(fwd, dim3(grid), dim3(NWAVES * 64), LDS_BYTES, stream, a);
#endif
    const hipError_t le = hipPeekAtLastError();
    if (le != hipSuccess) fprintf(stderr, "kernel_launch: launch failed: %s\n", hipGetErrorName(le));
}
```

```cpp
#include <hip/hip_runtime.h>
#include <cstdio>
#include <cstdint>
namespace pg8 {
#define PG8_LAS __attribute__((address_space(3)))
typedef unsigned short bf16_t;
typedef short bf16x8 __attribute__((ext_vector_type(8)));
typedef float f32x4 __attribute__((ext_vector_type(4)));
typedef unsigned u32x4 __attribute__((ext_vector_type(4)));
constexpr int BM = 256, BK = 64, HALF = 128, HTB = HALF * BK * 2  , STAGE_BYTES = 8 * HTB, NXCD = 8, WGM = 8;

__host__ __device__ __forceinline__ int lds_byte(int r, int c) { const int st = (r >> 4) * 2 + (c >> 5), rr = r & 15, cc = c & 31, ob = rr * 64 + cc * 2; return st * 1024 + (ob ^ (((ob >> 9) & 1) << 5)); }
__host__ __device__ __forceinline__ void stage_rc(int b, int& R, int& C) { const int st = b / 1024, sb = b % 1024, swz = sb ^ (((sb >> 9) & 1) << 5); R = (st >> 1) * 16 + swz / 64; C = (st & 1) * 32 + (swz % 64) / 2; }
__host__ __device__ __forceinline__ int perm32(int rho) { const int n = rho >> 4, i = rho & 15; return 8 * (i >> 2) + 4 * n + (i & 3); }

struct Unit { int pm, pn, pb; };
struct Gemm { const bf16_t* A; const bf16_t* Bt; int M, N, K; };

struct StaticOrder {
    int nM, nN, nwg, G, c;
    __host__ __device__ void init(int M, int N, int G_, int c_) { nM = M / BM; nN = N / BM; nwg = nM * nN; G = G_; c = c_; }
    __host__ __device__ bool next(int i, Unit& u) const {
        const long L = (long)i * G + c; if (L >= nwg) return false;
        int wgid = (int)L; { const int q = nwg / NXCD, r = nwg % NXCD, xcd = wgid % NXCD, off = wgid / NXCD; wgid = (xcd < r ? xcd * (q + 1) : r * (q + 1) + (xcd - r) * q) + off; }
        const int nig = WGM * nN, gid = wgid / nig, fm = gid * WGM, gsz = (nM - fm) < WGM ? (nM - fm) : WGM;
        u.pm = fm + ((wgid % nig) % gsz); u.pn = (wgid % nig) / gsz; u.pb = u.pn; return true;
    }
    __device__ __forceinline__ void a_ready(const Unit&) const {}
    __device__ __forceinline__ void done(const Unit&) const {}
};

__device__ __forceinline__ unsigned cvt_pk_bf16(float lo, float hi) { unsigned r; asm volatile("v_cvt_pk_bf16_f32 %0, %1, %2" : "=v"(r) : "v"(lo), "v"(hi)); return r; }
__device__ __forceinline__ float sigm(float x) { return __builtin_amdgcn_rcpf(1.f + __builtin_amdgcn_exp2f(-1.4426950408889634f * x)); }
typedef int v4i_t __attribute__((ext_vector_type(4)));
typedef int v8i_t __attribute__((ext_vector_type(8)));
__device__ __forceinline__ v8i_t cat8(bf16x8 a, bf16x8 b) { return __builtin_shufflevector(__builtin_bit_cast(v4i_t, a), __builtin_bit_cast(v4i_t, b), 0, 1, 2, 3, 4, 5, 6, 7); }
__device__ __forceinline__ float clamp8(float x) { return __builtin_amdgcn_fmed3f(x, -448.f, 448.f); }
__device__ __forceinline__ unsigned pack_fp8x4(float a, float b, float c, float d) { int w = 0; w = __builtin_amdgcn_cvt_pk_fp8_f32(clamp8(a), clamp8(b), w, false); w = __builtin_amdgcn_cvt_pk_fp8_f32(clamp8(c), clamp8(d), w, true); return (unsigned)w; }
__device__ __forceinline__ float bf_lo(unsigned w) { return __uint_as_float(w << 16); }
__device__ __forceinline__ float bf_hi(unsigned w) { return __uint_as_float(w & 0xffff0000u); }

struct EpiSlab {
    static constexpr bool PERM = true, AFTER_DRAIN = false, HOOK = false;
    bf16_t* O; size_t slab_stride; int qslab; float qscale;
    __device__ __forceinline__ void operator()(const f32x4 (&acc)[2][2][4][2], const Unit& u, int wr, int wc, int fr, int fq) const {
        const int slab = u.pn >> 1; bf16_t* base = O + (size_t)slab * slab_stride; const float sc = (slab == qslab) ? qscale : 1.f;
        const int row0 = u.pm * BM + wr * 64 + fr, col0 = (u.pn & 1) * 256 + wc * 32 + 8 * fq;
#pragma unroll
        for (int ai = 0; ai < 2; ++ai)
#pragma unroll
            for (int m = 0; m < 4; ++m) { bf16_t* rowp = base + (size_t)(row0 + ai * HALF + m * 16) * 512 + col0;
#pragma unroll
                for (int bj = 0; bj < 2; ++bj) { const f32x4 v0 = acc[ai][bj][m][0] * sc, v1 = acc[ai][bj][m][1] * sc;
                    u32x4 w; w.x = cvt_pk_bf16(v0[0], v0[1]); w.y = cvt_pk_bf16(v0[2], v0[3]); w.z = cvt_pk_bf16(v1[0], v1[1]); w.w = cvt_pk_bf16(v1[2], v1[3]);
                    *(u32x4*)(rowp + bj * HALF) = w; } }
    }
};
__device__ __forceinline__ size_t gate_img(int br, int pm, int pn, int piece, int wave, int lane) { return ((((size_t)(br * 512 + pm * 4 + pn) * 16 + piece) * 8 + wave) * 64 + lane) * 8; }
typedef unsigned u32x2g __attribute__((ext_vector_type(2)));
__device__ __forceinline__ float gate_val(float x, float c) { return __builtin_fmaxf(__builtin_fmaf(__builtin_amdgcn_rcpf(1.f + __builtin_amdgcn_exp2f(x * c)), 256.f, 0.5f), 1.f); }
__device__ __forceinline__ f32x4 ub4(unsigned w) { return (f32x4){(float)(w & 0xffu), (float)((w >> 8) & 0xffu), (float)((w >> 16) & 0xffu), (float)(w >> 24)}; }
struct EpiSig {
    static constexpr bool PERM = true, AFTER_DRAIN = false, HOOK = false;
    unsigned char* O; float in_scale;
    __device__ __forceinline__ void operator()(const f32x4 (&acc)[2][2][4][2], const Unit& u, int wr, int wc, int fr, int fq) const {
        const int br = u.pn >> 2, pn = u.pn & 3, wave = wr * 4 + wc, lane = fq * 16 + fr;
#pragma unroll
        for (int ai = 0; ai < 2; ++ai)
#pragma unroll
            for (int m = 0; m < 4; ++m)
#pragma unroll
                for (int bj = 0; bj < 2; ++bj) { const f32x4 v0 = acc[ai][bj][m][0], v1 = acc[ai][bj][m][1];
                    const float c = -1.4426950408889634f * in_scale; u32x2g w; w.x = 0u; w.y = 0u;
#pragma unroll
                    for (int j = 0; j < 4; ++j) { w.x = __builtin_amdgcn_cvt_pk_u8_f32(gate_val(v0[j], c), j, w.x); w.y = __builtin_amdgcn_cvt_pk_u8_f32(gate_val(v1[j], c), j, w.y); }
                    *(u32x2g*)(O + gate_img(br, u.pm, pn, ai * 8 + m * 2 + bj, wave, lane)) = w; }
    }
};
struct EpiMerge {
    static constexpr bool PERM = true, AFTER_DRAIN = false, HOOK = true;
    const unsigned char* G; bf16_t* O;
    __device__ __forceinline__ void hook(f32x4 (&acc)[2][2][4][2], const Unit& u, int t, int wr, int wc, int fr, int fq) const {
        const int i = (t >> 3) - 1; int lane = fq * 16 + fr; const int wave = wr * 4 + wc;
        asm volatile("" : "+v"(lane));
#pragma unroll
        for (int ai = 0; ai < 2; ++ai) {
            u32x2g ga[4][2], gb[4][2];
#pragma unroll
            for (int m = 0; m < 4; ++m)
#pragma unroll
                for (int bj = 0; bj < 2; ++bj) { ga[m][bj] = *(const u32x2g*)(G + gate_img(i, u.pm, u.pn, ai * 8 + m * 2 + bj, wave, lane)); gb[m][bj] = *(const u32x2g*)(G + gate_img(i + 1, u.pm, u.pn, ai * 8 + m * 2 + bj, wave, lane)); }
            __builtin_amdgcn_sched_barrier(0);
#pragma unroll
            for (int m = 0; m < 4; ++m)
#pragma unroll
                for (int bj = 0; bj < 2; ++bj) { const f32x4 a0 = ub4(ga[m][bj].x), a1 = ub4(ga[m][bj].y), b0 = ub4(gb[m][bj].x), b1 = ub4(gb[m][bj].y);
                    f32x4 r0, r1;
#pragma unroll
                    for (int j = 0; j < 4; ++j) { r0[j] = a0[j] * __builtin_amdgcn_rcpf(b0[j]); r1[j] = a1[j] * __builtin_amdgcn_rcpf(b1[j]); }
                    acc[ai][bj][m][0] *= r0; acc[ai][bj][m][1] *= r1; }
            __builtin_amdgcn_sched_barrier(0);
        }
    }
    __device__ __forceinline__ void operator()(const f32x4 (&acc)[2][2][4][2], const Unit& u, int wr, int wc, int fr, int fq) const {
        const int row0 = u.pm * BM + wr * 64 + fr, col0 = u.pn * BM + wc * 32 + 8 * fq, lane = fq * 16 + fr, wave = wr * 4 + wc;
        u32x2g g[2][4][2];
#pragma unroll
        for (int ai = 0; ai < 2; ++ai)
#pragma unroll
            for (int m = 0; m < 4; ++m)
#pragma unroll
                for (int bj = 0; bj < 2; ++bj) g[ai][m][bj] = *(const u32x2g*)(G + gate_img(2, u.pm, u.pn, ai * 8 + m * 2 + bj, wave, lane));
        __builtin_amdgcn_sched_barrier(0);
#pragma unroll
        for (int ai = 0; ai < 2; ++ai)
#pragma unroll
            for (int m = 0; m < 4; ++m) { const size_t off = (size_t)(row0 + ai * HALF + m * 16) * 1024 + col0;
#pragma unroll
                for (int bj = 0; bj < 2; ++bj) { const f32x4 g0 = ub4(g[ai][m][bj].x) * (1.f / 256.f), g1 = ub4(g[ai][m][bj].y) * (1.f / 256.f); const f32x4 v0 = acc[ai][bj][m][0] * g0, v1 = acc[ai][bj][m][1] * g1;
                    u32x4 w; w.x = cvt_pk_bf16(v0[0], v0[1]); w.y = cvt_pk_bf16(v0[2], v0[3]); w.z = cvt_pk_bf16(v1[0], v1[1]); w.w = cvt_pk_bf16(v1[2], v1[3]);
                    *(u32x4*)(O + off + bj * HALF) = w; } }
    }
};
struct EpiRes {
    static constexpr bool PERM = false, AFTER_DRAIN = false, HOOK = false;
    const float* base; float* out; int ldc; float in_scale = 1.f;
    __device__ __forceinline__ void operator()(const f32x4 (&acc)[2][2][4][2], const Unit& u, int wr, int wc, int fr, int fq) const {
        const int row0 = u.pm * BM + wr * 64 + fr, col0 = u.pn * BM + wc * 32 + 4 * fq;
#pragma unroll
        for (int ai = 0; ai < 2; ++ai) {
            f32x4 bs[4][2][2];
#pragma unroll
            for (int m = 0; m < 4; ++m)
#pragma unroll
                for (int bj = 0; bj < 2; ++bj)
#pragma unroll
                    for (int n = 0; n < 2; ++n) bs[m][bj][n] = *(const f32x4*)(base + (size_t)(row0 + ai * HALF + m * 16) * ldc + col0 + bj * HALF + n * 16);
            __builtin_amdgcn_sched_barrier(0);
#pragma unroll
            for (int m = 0; m < 4; ++m)
#pragma unroll
                for (int bj = 0; bj < 2; ++bj)
#pragma unroll
                    for (int n = 0; n < 2; ++n) *(f32x4*)(out + (size_t)(row0 + ai * HALF + m * 16) * ldc + col0 + bj * HALF + n * 16) = bs[m][bj][n] + acc[ai][bj][m][n] * in_scale;
            __builtin_amdgcn_sched_barrier(0);
        }
    }
};
template <bool BASE_F32> struct EpiResB {
    static constexpr bool PERM = true, AFTER_DRAIN = false, HOOK = false;
    static constexpr int XLD = 2048, XROT = 16;
    const void* base; bf16_t* out; float* ssq_part;
    __device__ __forceinline__ void operator()(const f32x4 (&acc)[2][2][4][2], const Unit& u, int wr, int wc, int fr, int fq) const {
        const int row0 = u.pm * BM + wr * 64 + fr, col0 = u.pn * BM + wc * 32 + 8 * fq;
#pragma unroll
        for (int ai = 0; ai < 2; ++ai) {
            f32x4 b0[4][2], b1[4][2];
            if constexpr (BASE_F32) {
#pragma unroll
                for (int m = 0; m < 4; ++m)
#pragma unroll
                    for (int bj = 0; bj < 2; ++bj) { const float* p = (const float*)base + (size_t)(row0 + ai * HALF + m * 16) * 1024 + col0 + bj * HALF; b0[m][bj] = *(const f32x4*)p; b1[m][bj] = *(const f32x4*)(p + 4); }
            } else {
                u32x4 q[4][2];
#pragma unroll
                for (int m = 0; m < 4; ++m)
#pragma unroll
                    for (int bj = 0; bj < 2; ++bj) q[m][bj] = *(const u32x4*)((const bf16_t*)base + (size_t)(row0 + ai * HALF + m * 16) * XLD + ((row0 + m * 16) & (XROT - 1)) * 64 + col0 + bj * HALF);
                __builtin_amdgcn_sched_barrier(0);
#pragma unroll
                for (int m = 0; m < 4; ++m)
#pragma unroll
                    for (int bj = 0; bj < 2; ++bj) { b0[m][bj] = (f32x4){bf_lo(q[m][bj].x), bf_hi(q[m][bj].x), bf_lo(q[m][bj].y), bf_hi(q[m][bj].y)}; b1[m][bj] = (f32x4){bf_lo(q[m][bj].z), bf_hi(q[m][bj].z), bf_lo(q[m][bj].w), bf_hi(q[m][bj].w)}; }
            }
            __builtin_amdgcn_sched_barrier(0);
#pragma unroll
            for (int m = 0; m < 4; ++m) { float ss = 0.f;
#pragma unroll
                for (int bj = 0; bj < 2; ++bj) { const f32x4 v0 = b0[m][bj] + acc[ai][bj][m][0], v1 = b1[m][bj] + acc[ai][bj][m][1];
                    ss += ((v0[0] * v0[0] + v0[1] * v0[1]) + (v0[2] * v0[2] + v0[3] * v0[3])) + ((v1[0] * v1[0] + v1[1] * v1[1]) + (v1[2] * v1[2] + v1[3] * v1[3]));
                    u32x4 w; w.x = cvt_pk_bf16(v0[0], v0[1]); w.y = cvt_pk_bf16(v0[2], v0[3]); w.z = cvt_pk_bf16(v1[0], v1[1]); w.w = cvt_pk_bf16(v1[2], v1[3]);
                    *(u32x4*)(out + (size_t)(row0 + ai * HALF + m * 16) * XLD + ((row0 + m * 16) & (XROT - 1)) * 64 + col0 + bj * HALF) = w; }
                if (ssq_part) { ss += __shfl_xor(ss, 16); ss += __shfl_xor(ss, 32); if (fq == 0) ssq_part[(size_t)(row0 + ai * HALF + m * 16) * 16 + u.pn * 4 + wc] = ss; } }
            __builtin_amdgcn_sched_barrier(0);
        }
    }
};
struct EpiSwiGLU {
    static constexpr bool PERM = true, AFTER_DRAIN = false, HOOK = false;
    bf16_t* O; int ldc;
    __device__ __forceinline__ void operator()(const f32x4 (&acc)[2][2][4][2], const Unit& u, int wr, int wc, int fr, int fq) const {
        const int row0 = u.pm * BM + wr * 64 + fr, col0 = u.pn * HALF + wc * 32 + 8 * fq;
#pragma unroll
        for (int ai = 0; ai < 2; ++ai)
#pragma unroll
            for (int m = 0; m < 4; ++m) { f32x4 v0, v1;
#pragma unroll
                for (int j = 0; j < 4; ++j) { const float g0 = acc[ai][0][m][0][j], g1 = acc[ai][0][m][1][j]; v0[j] = g0 * sigm(g0) * acc[ai][1][m][0][j]; v1[j] = g1 * sigm(g1) * acc[ai][1][m][1][j]; }
                u32x4 w; w.x = cvt_pk_bf16(v0[0], v0[1]); w.y = cvt_pk_bf16(v0[2], v0[3]); w.z = cvt_pk_bf16(v1[0], v1[1]); w.w = cvt_pk_bf16(v1[2], v1[3]);
                *(u32x4*)(O + (size_t)(row0 + ai * HALF + m * 16) * ldc + col0) = w; }
    }
};
struct EpiSwiGLUR {
    static constexpr bool PERM = true, AFTER_DRAIN = false, HOOK = false;
    bf16_t* O; int ldc; const float* ssq_part; float inv_d, eps;
    __device__ __forceinline__ void operator()(const f32x4 (&acc)[2][2][4][2], const Unit& u, int wr, int wc, int fr, int fq) const {
        const int row0 = u.pm * BM + wr * 64 + fr, col0 = u.pn * HALF + wc * 32 + 8 * fq;
        f32x4 pp[2][4];
#pragma unroll
        for (int ai = 0; ai < 2; ++ai)
#pragma unroll
            for (int m = 0; m < 4; ++m) pp[ai][m] = *(const f32x4*)(ssq_part + (size_t)(row0 + ai * HALF + m * 16) * 16 + 4 * fq);
#pragma unroll
        for (int ai = 0; ai < 2; ++ai)
#pragma unroll
            for (int m = 0; m < 4; ++m) { float s = (pp[ai][m][0] + pp[ai][m][1]) + (pp[ai][m][2] + pp[ai][m][3]); s += __shfl_xor(s, 16); s += __shfl_xor(s, 32);
                const float rs = __builtin_amdgcn_rsqf(s * inv_d + eps); f32x4 v0, v1;
#pragma unroll
                for (int j = 0; j < 4; ++j) { const float g0 = acc[ai][0][m][0][j] * rs, g1 = acc[ai][0][m][1][j] * rs; v0[j] = g0 * sigm(g0) * (acc[ai][1][m][0][j] * rs); v1[j] = g1 * sigm(g1) * (acc[ai][1][m][1][j] * rs); }
                u32x4 w; w.x = cvt_pk_bf16(v0[0], v0[1]); w.y = cvt_pk_bf16(v0[2], v0[3]); w.z = cvt_pk_bf16(v1[0], v1[1]); w.w = cvt_pk_bf16(v1[2], v1[3]);
                *(u32x4*)(O + (size_t)(row0 + ai * HALF + m * 16) * ldc + col0) = w; }
    }
};
struct EpiSwiGLU8 {
    static constexpr bool PERM = true, AFTER_DRAIN = false, HOOK = false;
    unsigned char* O; int ldc; float in_scale, out_scale;
    __device__ __forceinline__ void operator()(const f32x4 (&acc)[2][2][4][2], const Unit& u, int wr, int wc, int fr, int fq) const {
        const int row0 = u.pm * BM + wr * 64 + fr, col0 = u.pn * HALF + wc * 32 + 8 * fq; const float c1 = in_scale * in_scale * out_scale, c2 = -1.4426950408889634f * in_scale;
#pragma unroll
        for (int ai = 0; ai < 2; ++ai)
#pragma unroll
            for (int m = 0; m < 4; ++m) { f32x4 v0, v1;
#pragma unroll
                for (int j = 0; j < 4; ++j) { const float g0 = acc[ai][0][m][0][j], g1 = acc[ai][0][m][1][j];
                    v0[j] = (g0 * acc[ai][1][m][0][j]) * __builtin_amdgcn_rcpf(1.f + __builtin_amdgcn_exp2f(g0 * c2)) * c1; v1[j] = (g1 * acc[ai][1][m][1][j]) * __builtin_amdgcn_rcpf(1.f + __builtin_amdgcn_exp2f(g1 * c2)) * c1; }
                typedef unsigned u32x2_t __attribute__((ext_vector_type(2)));
                u32x2_t w; w.x = pack_fp8x4(v0[0], v0[1], v0[2], v0[3]); w.y = pack_fp8x4(v1[0], v1[1], v1[2], v1[3]);
                *(u32x2_t*)(O + (size_t)(row0 + ai * HALF + m * 16) * ldc + col0) = w; }
    }
};
struct EpiMoeDown {
    static constexpr bool PERM = true, AFTER_DRAIN = false, HOOK = false;
    bf16_t* Y; const int* row_tok; const float* row_g; float in_scale;
    __device__ __forceinline__ void operator()(const f32x4 (&acc)[2][2][4][2], const Unit& u, int wr, int wc, int fr, int fq) const {
        const int row0 = u.pm * BM + wr * 64 + fr, col0 = u.pn * BM + wc * 32 + 8 * fq;
#pragma unroll
        for (int ai = 0; ai < 2; ++ai)
#pragma unroll
            for (int m = 0; m < 4; ++m) { const int r = row0 + ai * HALF + m * 16; const int tok = row_tok[r]; const float g = row_g[r] * in_scale;
                if (tok >= 0) { bf16_t* p = Y + (size_t)tok * 1024 + col0;
#pragma unroll
                    for (int bj = 0; bj < 2; ++bj) { const f32x4 v0 = acc[ai][bj][m][0] * g, v1 = acc[ai][bj][m][1] * g;
                        u32x4 w; w.x = cvt_pk_bf16(v0[0], v0[1]); w.y = cvt_pk_bf16(v0[2], v0[3]); w.z = cvt_pk_bf16(v1[0], v1[1]); w.w = cvt_pk_bf16(v1[2], v1[3]);
                        *(u32x4*)(p + bj * HALF) = w; } } }
    }
};
struct MoeRange {
    int nM, nN, lo, hi; const PG8_LAS int* tile_e;
    __device__ void init(int nM_, int nN_, int lo_, int hi_, const PG8_LAS int* te) { nM = nM_; nN = nN_; lo = lo_; hi = hi_; tile_e = te; }
    __device__ bool next(int i, Unit& u) const {
        const int wgid = lo + i; if (wgid >= hi) return false;
        const int nig = WGM * nN, gid = wgid / nig, fm = gid * WGM, gsz = (nM - fm) < WGM ? (nM - fm) : WGM;
        u.pm = fm + ((wgid % nig) % gsz); u.pn = (wgid % nig) / gsz;
        const int e = __builtin_amdgcn_readfirstlane(tile_e[u.pm]); u.pb = e * nN + u.pn; return true;
    }
    __device__ __forceinline__ void a_ready(const Unit&) const {}
    __device__ __forceinline__ void done(const Unit&) const {}
};
struct MoeOrderHL {
    int nM, nN, nwg, G, c, heavy, R0; const PG8_LAS int* tile_e;
    __device__ void init(int nM_, int nN_, int G_, int c_, int heavy_, float rho, const PG8_LAS int* te) { nM = nM_; nN = nN_; nwg = nM * nN; G = G_; c = c_; heavy = heavy_; tile_e = te;
        const int cpx = G / NXCD, hx = heavy / NXCD; const float r0 = ((float)(nwg / NXCD) - rho * (float)(cpx - hx)) / (float)cpx + 0.5f; R0 = r0 > 0.f ? (int)r0 : 0; if (heavy == 0) R0 = 1 << 20; }
    __device__ bool next(int i, Unit& u) const {
        const int cpx = G / NXCD, x = c % NXCD, j = c / NXCD, hx = heavy > x ? (heavy - x + NXCD - 1) / NXCD : 0;
        const int q = nwg / NXCD, r = nwg % NXCD, qx = q + (x < r ? 1 : 0), start = x < r ? x * (q + 1) : r * (q + 1) + (x - r) * q;
        int p;
        if (i < R0) p = i * cpx + j; else { if (j < hx) return false; p = R0 * cpx + (i - R0) * (cpx - hx) + (j - hx); }
        if (p >= qx) return false;
        const int wgid = start + p, nig = WGM * nN, gid = wgid / nig, fm = gid * WGM, gsz = (nM - fm) < WGM ? (nM - fm) : WGM;
        u.pm = fm + ((wgid % nig) % gsz); u.pn = (wgid % nig) / gsz;
        const int e = __builtin_amdgcn_readfirstlane(tile_e[u.pm]); u.pb = e * nN + u.pn; return true;
    }
    __device__ __forceinline__ void a_ready(const Unit&) const {}
    __device__ __forceinline__ void done(const Unit&) const {}
};
struct MoeOrder {
    int nM, nN, nwg, G, c, off, lo, hi; const PG8_LAS int* tile_e;
    __device__ void init(int nM_, int nN_, int G_, int c_, const PG8_LAS int* te, int off_ = 0, int lo_ = 0, int hi_ = 0x7fffffff) { nM = nM_; nN = nN_; nwg = nM * nN; G = G_; c = c_; tile_e = te; off = off_; lo = lo_; hi = hi_ < nwg ? hi_ : nwg; }
    __device__ bool next(int i, Unit& u) const {
        const long L = (long)i * G + c + off; if (L < lo || L >= hi) return false;
        int wgid = (int)L; { const int q = nwg / NXCD, r = nwg % NXCD, xcd = wgid % NXCD, off_ = wgid / NXCD; wgid = (xcd < r ? xcd * (q + 1) : r * (q + 1) + (xcd - r) * q) + off_; }
        const int nig = WGM * nN, gid = wgid / nig, fm = gid * WGM, gsz = (nM - fm) < WGM ? (nM - fm) : WGM;
        u.pm = fm + ((wgid % nig) % gsz); u.pn = (wgid % nig) / gsz;
        const int e = __builtin_amdgcn_readfirstlane(tile_e[u.pm]); u.pb = e * nN + u.pn; return true;
    }
    __device__ __forceinline__ void a_ready(const Unit&) const {}
    __device__ __forceinline__ void done(const Unit&) const {}
};
template <class Epi, class Sched, bool ALIGN_EPI = false, bool SP2 = false, bool FP8 = false, int LDA = 0, int ROTA = 0>
__device__ __forceinline__ void gemm_phase(PG8_LAS unsigned char* lds, const Gemm g, const Sched& S, const Epi& E) {
    int tid_ = threadIdx.x; asm volatile("" : "+v"(tid_));
    const int tid = tid_, wid = __builtin_amdgcn_readfirstlane(tid >> 6), lane = tid & 63, wr = wid >> 2, wc = wid & 3, fr = lane & 15, fq = lane >> 4;
    const int K = g.K, nt = K / BK;
    unsigned voffA[2], voffB[2];
#pragma unroll
    for (int i = 0; i < 2; ++i) { int R, C; stage_rc(tid * 16 + i * 8192, R, C); const int Rb = Epi::PERM ? ((R & ~31) + perm32(R & 31)) : R;
        voffA[i] = (unsigned)(R * (LDA ? LDA : K) + C) * 2u + (ROTA ? (unsigned)(R & (ROTA - 1)) * 128u : 0u); voffB[i] = (unsigned)(Rb * K + C) * 2u; }
    const size_t kstep = (size_t)(BK * 2);
    const size_t hstep = (size_t)HALF * K * 2;
    const size_t tstep = 2 * hstep;
    const size_t hstepA = (size_t)HALF * (LDA ? LDA : K) * 2, tstepA = 2 * hstepA;
    const unsigned ldsw = (unsigned)wid * 1024u;
    const int aoff = lds_byte(wr * 64 + fr, fq * 8), boff = lds_byte(wc * 32 + fr, fq * 8);
#define PG8_SA(b, h) (((b) * 2 + (h)) * HTB)
#define PG8_SB(b, h) ((4 + (b) * 2 + (h)) * HTB)
#define PG8_STAGE(bufoff, gbase, voff) do { _Pragma("unroll") for (int _i = 0; _i < 2; ++_i) \
        __builtin_amdgcn_global_load_lds((const unsigned*)((const char*)(gbase) + (voff)[_i]), (PG8_LAS unsigned*)(lds + (bufoff) + ldsw + _i * 8192), 16, 0, 0); } while (0)
#define PG8_LDA(dst, b, h) do { _Pragma("unroll") for (int m = 0; m < 4; ++m) _Pragma("unroll") for (int k = 0; k < 2; ++k) dst[m][k] = *(const PG8_LAS bf16x8*)(lds + PG8_SA(b, h) + aoff + m * 2048 + k * 1024); } while (0)
#define PG8_LDB(dst, b, h) do { _Pragma("unroll") for (int n = 0; n < 2; ++n) _Pragma("unroll") for (int k = 0; k < 2; ++k) dst[n][k] = *(const PG8_LAS bf16x8*)(lds + PG8_SB(b, h) + boff + n * 2048 + k * 1024); } while (0)
#define PG8_MMA(ai, bj, At, Bt) do { __builtin_amdgcn_s_setprio(1); \
        if constexpr (FP8) { _Pragma("unroll") for (int m = 0; m < 4; ++m) _Pragma("unroll") for (int n = 0; n < 2; ++n) \
            asm volatile("v_mfma_f32_16x16x128_f8f6f4 %0, %1, %2, %0" : "+v"(acc[ai][bj][m][n]) : "v"(cat8(Bt[n][0], Bt[n][1])), "v"(cat8(At[m][0], At[m][1]))); } \
        else { _Pragma("unroll") for (int m = 0; m < 4; ++m) _Pragma("unroll") for (int n = 0; n < 2; ++n) _Pragma("unroll") for (int k = 0; k < 2; ++k) \
            acc[ai][bj][m][n] = __builtin_amdgcn_mfma_f32_16x16x32_bf16(Bt[n][k], At[m][k], acc[ai][bj][m][n], 0, 0, 0); } \
        __builtin_amdgcn_s_setprio(0); } while (0)
#define PG8_WAIT_V(n) asm volatile("s_waitcnt vmcnt(" #n ")" ::: "memory")
#define PG8_WAIT_L(n) asm volatile("s_waitcnt lgkmcnt(" #n ")" ::: "memory")
#define PG8_BAR __builtin_amdgcn_s_barrier()
#define PG8_SCHED __builtin_amdgcn_sched_barrier(0)
    Unit cur, nxt; int ui = 0;
    if (!S.next(0, cur)) return;
    f32x4 acc[2][2][4][2];
#pragma unroll
    for (int a = 0; a < 2; ++a)
#pragma unroll
        for (int b = 0; b < 2; ++b)
#pragma unroll
            for (int m = 0; m < 4; ++m)
#pragma unroll
                for (int n = 0; n < 2; ++n) acc[a][b][m][n] = (f32x4){0.f, 0.f, 0.f, 0.f};
    bf16x8 At[4][2], B0[2][2], B1[2][2];
    const char* cA = (const char*)g.A + (size_t)cur.pm * tstepA; const char* cB = (const char*)g.Bt + (size_t)cur.pb * tstep;
    S.a_ready(cur);
    if constexpr (SP2) {
        PG8_STAGE(PG8_SB(0, 0), cB, voffB); PG8_STAGE(PG8_SB(0, 1), cB + hstep, voffB); PG8_STAGE(PG8_SA(0, 0), cA, voffA); PG8_STAGE(PG8_SA(0, 1), cA + hstepA, voffA);
        if (wr == 1) PG8_BAR;
        PG8_WAIT_V(2); PG8_BAR;
        PG8_STAGE(PG8_SB(1, 0), cB + kstep, voffB); PG8_STAGE(PG8_SA(1, 0), cA + kstep, voffA); PG8_STAGE(PG8_SB(1, 1), cB + hstep + kstep, voffB);
        PG8_WAIT_V(6); PG8_BAR;
    } else {
        PG8_STAGE(PG8_SB(0, 0), cB, voffB); PG8_STAGE(PG8_SA(0, 0), cA, voffA); PG8_STAGE(PG8_SB(0, 1), cB + hstep, voffB); PG8_STAGE(PG8_SA(0, 1), cA + hstepA, voffA);
        if (wr == 1) PG8_BAR;
        PG8_WAIT_V(4); PG8_BAR;
        PG8_STAGE(PG8_SB(1, 0), cB + kstep, voffB); PG8_STAGE(PG8_SA(1, 0), cA + kstep, voffA); PG8_STAGE(PG8_SB(1, 1), cB + hstep + kstep, voffB);
        PG8_WAIT_V(6); PG8_BAR;
    }
    for (;;) {
        const bool has_next = S.next(ui + 1, nxt);
        const char* nA = has_next ? (const char*)g.A + (size_t)nxt.pm * tstepA : cA; const char* nB = has_next ? (const char*)g.Bt + (size_t)nxt.pb * tstep : cB;
        for (int t = 0; t < nt; t += 2) {
            if constexpr (Epi::HOOK) { if (t == 8 || t == 16) E.hook(acc, cur, t, wr, wc, fr, fq); }
            const bool last = (t == nt - 2);
            const char* a1 = cA + (size_t)(t + 1) * kstep;
            const char* a2 = last ? nA : cA + (size_t)(t + 2) * kstep; const char* b2 = last ? nB : cB + (size_t)(t + 2) * kstep;
            const char* a3 = a2 + kstep; const char* b3 = b2 + kstep;
            if (last && has_next) S.a_ready(nxt);
            if constexpr (SP2) {
            PG8_LDB(B0, 0, 0); PG8_LDB(B1, 0, 1); PG8_SCHED; PG8_LDA(At, 0, 0); PG8_STAGE(PG8_SA(1, 1), a1 + hstepA, voffA);
            PG8_WAIT_V(8); PG8_WAIT_L(0); PG8_BAR; PG8_MMA(0, 0, At, B0); PG8_MMA(0, 1, At, B1); PG8_BAR; PG8_SCHED;
            PG8_LDA(At, 0, 1); PG8_STAGE(PG8_SB(0, 0), b2, voffB); PG8_STAGE(PG8_SB(0, 1), b2 + hstep, voffB); PG8_STAGE(PG8_SA(0, 0), a2, voffA);
            PG8_WAIT_V(8); PG8_WAIT_L(0); PG8_BAR; PG8_MMA(1, 0, At, B0); PG8_MMA(1, 1, At, B1); PG8_BAR; PG8_SCHED;
            PG8_LDB(B0, 1, 0); PG8_LDB(B1, 1, 1); PG8_SCHED; PG8_LDA(At, 1, 0); PG8_STAGE(PG8_SA(0, 1), a2 + hstepA, voffA);
            PG8_WAIT_V(8); PG8_WAIT_L(0); PG8_BAR; PG8_MMA(0, 0, At, B0); PG8_MMA(0, 1, At, B1); PG8_BAR; PG8_SCHED;
            PG8_LDA(At, 1, 1); PG8_STAGE(PG8_SB(1, 0), b3, voffB); PG8_STAGE(PG8_SB(1, 1), b3 + hstep, voffB); PG8_STAGE(PG8_SA(1, 0), a3, voffA);
            PG8_WAIT_V(8); PG8_WAIT_L(0); PG8_BAR; PG8_MMA(1, 0, At, B0); PG8_MMA(1, 1, At, B1); PG8_BAR; PG8_SCHED;
            } else {
            PG8_LDB(B0, 0, 0); PG8_SCHED; PG8_LDA(At, 0, 0); PG8_STAGE(PG8_SA(1, 1), a1 + hstepA, voffA);
            PG8_WAIT_L(8); PG8_BAR; PG8_WAIT_L(0); PG8_MMA(0, 0, At, B0); PG8_BAR; PG8_SCHED;
            PG8_LDB(B1, 0, 1); PG8_STAGE(PG8_SB(0, 0), b2, voffB);
            PG8_BAR; PG8_WAIT_L(0); PG8_MMA(0, 1, At, B1); PG8_BAR;
            PG8_LDA(At, 0, 1); PG8_STAGE(PG8_SA(0, 0), a2, voffA);
            PG8_BAR; PG8_WAIT_L(0); PG8_MMA(1, 0, At, B0); PG8_BAR; PG8_SCHED;
            PG8_STAGE(PG8_SB(0, 1), b2 + hstep, voffB);
            PG8_WAIT_V(6); PG8_BAR; PG8_MMA(1, 1, At, B1); PG8_BAR;
            PG8_LDB(B0, 1, 0); PG8_SCHED; PG8_LDA(At, 1, 0); PG8_STAGE(PG8_SA(0, 1), a2 + hstepA, voffA);
            PG8_WAIT_L(8); PG8_BAR; PG8_WAIT_L(0); PG8_MMA(0, 0, At, B0); PG8_BAR; PG8_SCHED;
            PG8_LDB(B1, 1, 1); PG8_STAGE(PG8_SB(1, 0), b3, voffB);
            PG8_BAR; PG8_WAIT_L(0); PG8_MMA(0, 1, At, B1); PG8_BAR;
            PG8_LDA(At, 1, 1); PG8_STAGE(PG8_SA(1, 0), a3, voffA);
            PG8_BAR; PG8_WAIT_L(0); PG8_MMA(1, 0, At, B0); PG8_BAR; PG8_SCHED;
            PG8_STAGE(PG8_SB(1, 1), b3 + hstep, voffB);
            PG8_WAIT_V(6); PG8_BAR; PG8_MMA(1, 1, At, B1); PG8_BAR;
            }
        }
        if constexpr (ALIGN_EPI) { if (wr == 0) PG8_BAR; }
        if constexpr (FP8) {
            asm volatile("s_nop 15\n\ts_nop 15" : "+v"(acc[0][0][0][0]), "+v"(acc[0][0][0][1]), "+v"(acc[0][0][1][0]), "+v"(acc[0][0][1][1]), "+v"(acc[0][0][2][0]), "+v"(acc[0][0][2][1]), "+v"(acc[0][0][3][0]), "+v"(acc[0][0][3][1]));
            asm volatile("" : "+v"(acc[0][1][0][0]), "+v"(acc[0][1][0][1]), "+v"(acc[0][1][1][0]), "+v"(acc[0][1][1][1]), "+v"(acc[0][1][2][0]), "+v"(acc[0][1][2][1]), "+v"(acc[0][1][3][0]), "+v"(acc[0][1][3][1]));
            asm volatile("" : "+v"(acc[1][0][0][0]), "+v"(acc[1][0][0][1]), "+v"(acc[1][0][1][0]), "+v"(acc[1][0][1][1]), "+v"(acc[1][0][2][0]), "+v"(acc[1][0][2][1]), "+v"(acc[1][0][3][0]), "+v"(acc[1][0][3][1]));
            asm volatile("" : "+v"(acc[1][1][0][0]), "+v"(acc[1][1][0][1]), "+v"(acc[1][1][1][0]), "+v"(acc[1][1][1][1]), "+v"(acc[1][1][2][0]), "+v"(acc[1][1][2][1]), "+v"(acc[1][1][3][0]), "+v"(acc[1][1][3][1])); }
        if constexpr (!Epi::AFTER_DRAIN) { E(acc, cur, wr, wc, fr, fq); S.done(cur); }
        if (!has_next) break;
#pragma unroll
        for (int a = 0; a < 2; ++a)
#pragma unroll
            for (int b = 0; b < 2; ++b)
#pragma unroll
                for (int m = 0; m < 4; ++m)
#pragma unroll
                    for (int n = 0; n < 2; ++n) acc[a][b][m][n] = (f32x4){0.f, 0.f, 0.f, 0.f};
        cur = nxt; cA = nA; cB = nB; ++ui;
        if constexpr (ALIGN_EPI) { if (wr == 1) PG8_BAR; }
    }
    PG8_WAIT_V(0);
    if constexpr (!ALIGN_EPI) { if (wr == 0) PG8_BAR; }
    PG8_BAR;
    if constexpr (Epi::AFTER_DRAIN) { E.fused(acc, cur, wr, wc, fr, fq, lds, wid, lane); S.done(cur); }
#undef PG8_SA
#undef PG8_SB
#undef PG8_STAGE
#undef PG8_LDA
#undef PG8_LDB
#undef PG8_MMA
#undef PG8_WAIT_V
#undef PG8_WAIT_L
#undef PG8_BAR
#undef PG8_SCHED
}
}
#include <hip/hip_bf16.h>
#include <cmath>
namespace attn_body {
using bf16=__hip_bfloat16;
using bf16x8=__attribute__((ext_vector_type(8)))short;
using s16x4=__attribute__((ext_vector_type(4)))short;
using f32x16=__attribute__((ext_vector_type(16)))float;
using u32x4=__attribute__((ext_vector_type(4)))unsigned;
constexpr int BATCH=4,NHEAD=8,SEQ=8192,D=64,DM=NHEAD*D,DMO=1536,OCOL=1024;
constexpr int NW=8,QBLK=32,QB=QBLK*NW,KVBLK=64,NQB=SEQ/QB;
constexpr int ATTN_PITCH=DM, ATTN_UNIT_ROWS=QB;
__device__ __forceinline__ int crow(int r,int hi){return (r&3)+8*(r>>2)+4*hi;}
#define SBAR() __builtin_amdgcn_sched_barrier(0)
__device__ __forceinline__ void cmask(f32x16&p0,f32x16&p1,int jb,int qrel,int hi){
  const float NEG=-INFINITY; int kb=64*jb+4*hi;
  #pragma unroll
  for(int r=0;r<16;++r){int kv=kb+(r&3)+8*(r>>2); if(kv>qrel)p0[r]=NEG; if(kv+32>qrel)p1[r]=NEG;}
}

constexpr int NSLOT=3, SLOTB=8192;
constexpr int LDS_K=0, LDS_V=NSLOT*SLOTB, LDS_WS=2*NSLOT*SLOTB, LDS_OST=LDS_WS+NW*64*4, LDS_NB=LDS_OST+NW*4096, LDS_BYTES=LDS_NB+SEQ*4;
constexpr float C2=0.125f*1.4426950408889634f;
__device__ __forceinline__ void glds16(const void*gsrc,unsigned lds_dst){unsigned keep;
  asm volatile("s_mov_b32 %0, m0\n\ts_mov_b32 m0, %2\n\ts_nop 0\n\tglobal_load_lds_dwordx4 %1, off\n\ts_mov_b32 m0, %0":"=&s"(keep):"v"(gsrc),"s"(lds_dst):"memory");}
__device__ __forceinline__ float max3f(float a,float b,float c){float r;asm("v_max3_f32 %0, %1, %2, %3":"=v"(r):"v"(a),"v"(b),"v"(c));return r;}
__device__ __forceinline__ float max2f(float a,float b){float r;asm("v_max_f32_e32 %0, %1, %2":"=v"(r):"v"(a),"v"(b));return r;}
__device__ __forceinline__ float fadd_s(float a,float b){float r;asm("v_add_f32_e32 %0, %1, %2":"=v"(r):"v"(a),"v"(b));return r;}
__device__ __forceinline__ float fsub_s(float a,float b){float r;asm("v_sub_f32_e32 %0, %1, %2":"=v"(r):"v"(a),"v"(b));return r;}
typedef float f32x2_t __attribute__((ext_vector_type(2))); typedef __bf16 bf16x2_t __attribute__((ext_vector_type(2)));
__device__ __forceinline__ unsigned cvtpk_s(float lo,float hi){f32x2_t v={lo,hi};bf16x2_t b=__builtin_convertvector(v,bf16x2_t);return __builtin_bit_cast(unsigned,b);}
#define WAIT_BAR(N) asm volatile("s_waitcnt vmcnt(" #N ") lgkmcnt(0)\n\ts_barrier":::"memory")

__device__ __forceinline__ void qkt(f32x16&p0,f32x16&p1,const char*Kslot,const bf16x8*qr,int r32,int hi){
  const char*kb=Kslot+hi*1024+r32*16;
  #pragma unroll
  for(int d0=0;d0<4;++d0){
    const bf16x8 b0=*reinterpret_cast<const bf16x8*>(kb+d0*2048);
    const bf16x8 b1=*reinterpret_cast<const bf16x8*>(kb+d0*2048+512);
    p0=__builtin_amdgcn_mfma_f32_32x32x16_bf16(b0,qr[d0],p0,0,0,0);p1=__builtin_amdgcn_mfma_f32_32x32x16_bf16(b1,qr[d0],p1,0,0,0);}
}
typedef __attribute__((address_space(3))) const char* lds_cptr;
typedef short v4i16_t __attribute__((ext_vector_type(4)));
__device__ __forceinline__ void kload8(bf16x8*kf,lds_cptr kp){
  kf[0]=*(const __attribute__((address_space(3))) bf16x8*)(kp);      kf[1]=*(const __attribute__((address_space(3))) bf16x8*)(kp+512);
  kf[2]=*(const __attribute__((address_space(3))) bf16x8*)(kp+2048); kf[3]=*(const __attribute__((address_space(3))) bf16x8*)(kp+2560);
  kf[4]=*(const __attribute__((address_space(3))) bf16x8*)(kp+4096); kf[5]=*(const __attribute__((address_space(3))) bf16x8*)(kp+4608);
  kf[6]=*(const __attribute__((address_space(3))) bf16x8*)(kp+6144); kf[7]=*(const __attribute__((address_space(3))) bf16x8*)(kp+6656);
}
__device__ __forceinline__ void kload2(bf16x8*kf,lds_cptr kp,int j){ kf[2*j]=*(const __attribute__((address_space(3))) bf16x8*)(kp+j*2048); kf[2*j+1]=*(const __attribute__((address_space(3))) bf16x8*)(kp+j*2048+512); }
__device__ __forceinline__ s16x4 vtr(lds_cptr p){ return __builtin_bit_cast(s16x4,__builtin_amdgcn_ds_read_tr16_b64_v4i16((__attribute__((address_space(3))) v4i16_t*)p)); }
__device__ __forceinline__ float rowmax(const f32x16&p0,const f32x16&p1){
  float a=max3f(p0[0],p0[1],p1[0]),b=max3f(p0[2],p0[3],p1[1]);a=max3f(a,p1[2],p1[3]);
  #pragma unroll
  for(int r=4;r<16;r+=4){a=max3f(a,p0[r],p0[r+1]);b=max3f(b,p0[r+2],p0[r+3]);a=max3f(a,p1[r],p1[r+1]);b=max3f(b,p1[r+2],p1[r+3]);}
  const float m=max2f(a,b);
  auto rr=__builtin_amdgcn_permlane32_swap(__float_as_uint(m),__float_as_uint(m),false,false);
  return max2f(__uint_as_float(rr[0]),__uint_as_float(rr[1]));
}
__device__ __forceinline__ void pv(f32x16*o,int vb,bf16x8 pa0,bf16x8 pa1,bf16x8 pa2,bf16x8 pa3){
  #pragma unroll
  for(int d0=0;d0<2;++d0){s16x4 lo[4],hi[4];
    #pragma unroll
    for(int ks=0;ks<4;++ks){
      asm volatile("ds_read_b64_tr_b16 %0,%1 offset:%c2":"=&v"(lo[ks]):"v"(vb),"i"(d0*4096+ks*1024):"memory");
      asm volatile("ds_read_b64_tr_b16 %0,%1 offset:%c2":"=&v"(hi[ks]):"v"(vb),"i"(d0*4096+ks*1024+512):"memory");}
    asm volatile("s_waitcnt lgkmcnt(0)":::"memory");SBAR();
    #define PK(k) (bf16x8){lo[k][0],lo[k][1],lo[k][2],lo[k][3],hi[k][0],hi[k][1],hi[k][2],hi[k][3]}
    o[d0]=__builtin_amdgcn_mfma_f32_32x32x16_bf16(pa0,PK(0),o[d0],0,0,0);
    o[d0]=__builtin_amdgcn_mfma_f32_32x32x16_bf16(pa1,PK(1),o[d0],0,0,0);
    o[d0]=__builtin_amdgcn_mfma_f32_32x32x16_bf16(pa2,PK(2),o[d0],0,0,0);
    o[d0]=__builtin_amdgcn_mfma_f32_32x32x16_bf16(pa3,PK(3),o[d0],0,0,0);
    #undef PK
  }
}

#ifndef ATTN_STORE16
#define ATTN_STORE16(p,v) (*(u32x4*)(p)=(v))
#endif
typedef float f32x4v __attribute__((ext_vector_type(4)));
__device__ __forceinline__ int attn_t0(int qb,const float*__restrict__ nbg,const float*__restrict__ qnw,const float*__restrict__ knw,const float*__restrict__ xmw,int lane){
  const int q0=qb*QB; float qn=0.f,kn=0.f,xm=3.0e38f; if(lane<8){qn=qnw[qb*8+lane];xm=xmw[qb*8+lane];}
  _Pragma("unroll") for(int i=0;i<4;++i){const int idx=lane*4+i; if(idx<(qb+1)*8)kn=__builtin_fmaxf(kn,knw[idx]);}
  _Pragma("unroll") for(int o_=1;o_<64;o_<<=1){qn=__builtin_fmaxf(qn,__shfl_xor(qn,o_));kn=__builtin_fmaxf(kn,__shfl_xor(kn,o_));xm=__builtin_fminf(xm,__shfl_xor(xm,o_));}
  const float thr=56.f+sqrtf(qn*kn)-xm; const int NT0=(q0+QB)/KVBLK;
  bool c_=(lane>=1)&&(2*lane<=NT0-4); float d_=0.f; if(c_)d_=nbg[128*lane-1]-nbg[q0]; c_=c_&&(d_<=-thr);
  return __builtin_amdgcn_readfirstlane(2*(int)__popcll(__ballot(c_)));
}
template<int THRL> __device__ __forceinline__ void attn_unit(int b,int h,int qb,const bf16*Q,const bf16*__restrict__ K,const bf16*__restrict__ V,bf16*O,const float*__restrict__ nbg,const int t0,char*shm){
  int tid_=threadIdx.x; asm volatile("":"+v"(tid_));
  const int tid=tid_,lane=tid&63,r32=lane&31,hi=lane>>5; const int wid=__builtin_amdgcn_readfirstlane(tid>>6);
  const long rowbase=(long)b*SEQ; const int q0=qb*QB;
  const bf16*Qw=Q+(rowbase+q0+wid*QBLK)*DM+h*D;
  const bf16*Kh=K+(rowbase+(long)t0*KVBLK)*DM+h*D,*Vh=V+(rowbase+(long)t0*KVBLK)*DM+h*D;
  const unsigned lds0=(unsigned)(uintptr_t)shm;
  float*wsf=(float*)(shm+LDS_WS)+wid*64;
  const bf16*ksrc=Kh+(long)lane*DM+wid*8;
  const bf16*vsrc=Vh+(long)(16*(wid&3)+(lane>>2))*DM+(wid>>2)*32+(lane&3)*8;
  const unsigned kdst=lds0+LDS_K+wid*1024, vdst=lds0+LDS_V+wid*1024;
  #define DMA_K(t,slot) glds16(ksrc+(long)(t)*KVBLK*DM,(unsigned)__builtin_amdgcn_readfirstlane(kdst+(slot)))
  #define DMA_V(t,slot) glds16(vsrc+(long)(t)*KVBLK*DM,(unsigned)__builtin_amdgcn_readfirstlane(vdst+(slot)))
  const int vb0=(int)(lds0+LDS_V)+((lane>>4)&1)*32+(lane&3)*8+(4*hi+((lane&15)>>2))*64;
  const char*Kbase=shm+LDS_K; bf16x8 kf[8];
  const lds_cptr shm3=(lds_cptr)shm; const lds_cptr kp0=shm3+LDS_K+hi*1024+r32*16; const lds_cptr vp0=shm3+LDS_V+((lane>>4)&1)*32+(lane&3)*8+(4*hi+((lane&15)>>2))*64;
  const int NT=(q0+QB)/KVBLK-t0;
  typedef __attribute__((address_space(3))) float* lds_fptr;
  const lds_fptr nbl3=(lds_fptr)(shm3+LDS_NB);
  const lds_fptr nbl3o=nbl3+t0*KVBLK;
  DMA_K(0,0);DMA_V(0,0);DMA_K(1,SLOTB);
  { const float ref=nbg[q0+QB-1]; for(int j=t0*KVBLK+tid;j<q0+QB;j+=NW*64) nbl3[j]=nbg[j]-ref; }
  bf16x8 qr[4];
  #pragma unroll
  for(int d0=0;d0<4;++d0)qr[d0]=*reinterpret_cast<const bf16x8*>(&Qw[(long)r32*DM+d0*16+hi*8]);
  float mhat=0.f,l_reg=0.f;f32x16 o[2];o[0]=f32x16{};o[1]=f32x16{};
  const int qrel=wid*QBLK+r32;
  #define CMASK(P0,P1,t) do{int jb_=(t)-(NT-4); if(jb_>=0)cmask(P0,P1,jb_,qrel,hi);}while(0)
  bool resc=false;
  #define START(P0,P1) do{ const float rm=rowmax(P0,P1); resc=false; \
    if(__any(rm>(float)THRL)){ const float dl=__builtin_fmaxf(rm,0.f); mhat=fadd_s(mhat,dl); \
      _Pragma("unroll") for(int r=0;r<16;++r){P0[r]=fsub_s(P0[r],dl);P1[r]=fsub_s(P1[r],dl);} } \
    _Pragma("unroll") for(int r=0;r<16;++r)P0[r]=__builtin_amdgcn_exp2f(P0[r]); }while(0)
  #define BIAS(P0,P1,t) do{ const lds_fptr nbp_=nbl3o+64*(t)+4*hi; \
    _Pragma("unroll") for(int q_=0;q_<4;++q_){ const f32x4v b0_=*(const __attribute__((address_space(3))) f32x4v*)(nbp_+8*q_), b1_=*(const __attribute__((address_space(3))) f32x4v*)(nbp_+32+8*q_); \
      _Pragma("unroll") for(int i_=0;i_<4;++i_){ P0[4*q_+i_]=b0_[i_]-mhat; P1[4*q_+i_]=b1_[i_]-mhat; } } }while(0)
  #define RESC() do{ if(resc){ asm volatile("s_waitcnt lgkmcnt(0)":::"memory"); \
      _Pragma("unroll") for(int d_=0;d_<2;++d_) _Pragma("unroll") for(int r=0;r<16;++r)o[d_][r]*=wsf[crow(r,hi)]; } }while(0)
  f32x16 pA0,pA1,pB0,pB1;
  int sl_prev=0,sl_cur=0,sl_next=SLOTB;
  #define ROT() do{sl_prev=sl_cur;sl_cur=sl_next;sl_next=(sl_next==(NSLOT-1)*SLOTB)?0:sl_next+SLOTB;}while(0)
  DMA_K(2,2*SLOTB);
  WAIT_BAR(3);
  mhat=nbl3[q0+qrel];
  BIAS(pA0,pA1,0);qkt(pA0,pA1,Kbase,qr,r32,hi);asm volatile("s_nop 15\n\ts_nop 7":"+v"(pA0),"+v"(pA1));CMASK(pA0,pA1,0);
  START(pA0,pA1);
  _Pragma("unroll") for(int r=0;r<16;++r)pA1[r]=__builtin_amdgcn_exp2f(pA1[r]);
  WAIT_BAR(0);
  DMA_K(3,0);DMA_V(1,SLOTB);
  ROT();
  kload8(kf,kp0+sl_cur);
  WAIT_BAR(2);
  s16x4 vlo[8],vhi[8]; u32x4 pw0,pw1,pw2,pw3;
  #define PKW(P,B) cvtpk_s(P[B],P[B+1])
  #define PAF(k) __builtin_bit_cast(bf16x8,pw##k)
  #define VFR(i) (bf16x8){vlo[i][0],vlo[i][1],vlo[i][2],vlo[i][3],vhi[i][0],vhi[i][1],vhi[i][2],vhi[i][3]}
  #define PIN(x) asm volatile("":"+v"(x))
  #define MX3(a,b,c) __builtin_fmaxf(__builtin_fmaxf((a),(b)),(c))
  #define GAPA(MF,A0,A1,A2,A3,W0,W1,PW) do{ MF; sacc+=A0; sacc+=A1; sacc+=A2; sacc+=A3; PIN(sacc); W0; W1; PIN(PW); SBAR(); }while(0)
  #define EX(v) __builtin_amdgcn_exp2f(v)
  #define GAPB(MF,X,B) do{ MF; X[B]=EX(X[B]); X[B+1]=EX(X[B+1]); X[B+2]=EX(X[B+2]); X[B+3]=EX(X[B+3]); PIN(X); SBAR(); }while(0)
  #define VRD(i) do{ vlo[i]=vtr(vp_+(((i)>>2)*4096+((i)&3)*1024)); vhi[i]=vtr(vp_+(((i)>>2)*4096+((i)&3)*1024+512)); }while(0)
  #define KRD(G,j) do{ if(G){ kload2(kf,kp0+sl_next,j); SBAR(); } }while(0)
  #define STEP(C0,C1,P0,P1,t,GK,GV,GL) do{ SBAR(); \
    const lds_cptr vp_=vp0+sl_prev; \
    BIAS(C0,C1,t); SBAR(); \
    VRD(0); SBAR(); float sacc=(P0[0]+P0[1]); \
    GAPA(C0=__builtin_amdgcn_mfma_f32_32x32x16_bf16(kf[0],qr[0],C0,0,0,0), P0[2],P0[3],P0[4],P0[5],     pw0[0]=PKW(P0,0), pw0[1]=PKW(P0,2), pw0); \
    VRD(4); SBAR(); GAPA(C1=__builtin_amdgcn_mfma_f32_32x32x16_bf16(kf[1],qr[0],C1,0,0,0), P0[6],P0[7],P0[8],P0[9],     pw0[2]=PKW(P0,4), pw0[3]=PKW(P0,6), pw0); \
    VRD(1); SBAR(); GAPA(C0=__builtin_amdgcn_mfma_f32_32x32x16_bf16(kf[2],qr[1],C0,0,0,0),   P0[10],P0[11],P0[12],P0[13], pw1[0]=PKW(P0,8), pw1[1]=PKW(P0,10), pw1); \
    VRD(5); SBAR(); GAPA(C1=__builtin_amdgcn_mfma_f32_32x32x16_bf16(kf[3],qr[1],C1,0,0,0),   P0[14],P0[15],P1[0],P1[1],   pw1[2]=PKW(P0,12),pw1[3]=PKW(P0,14), pw1); \
    VRD(2); SBAR(); GAPA(C0=__builtin_amdgcn_mfma_f32_32x32x16_bf16(kf[4],qr[2],C0,0,0,0),   P1[2],P1[3],P1[4],P1[5],     pw2[0]=PKW(P1,0), pw2[1]=PKW(P1,2), pw2); \
    VRD(6); SBAR(); GAPA(C1=__builtin_amdgcn_mfma_f32_32x32x16_bf16(kf[5],qr[2],C1,0,0,0),   P1[6],P1[7],P1[8],P1[9],     pw2[2]=PKW(P1,4), pw2[3]=PKW(P1,6), pw2); \
    VRD(3); SBAR(); GAPA(C0=__builtin_amdgcn_mfma_f32_32x32x16_bf16(kf[6],qr[3],C0,0,0,0),   P1[10],P1[11],P1[12],P1[13], pw3[0]=PKW(P1,8), pw3[1]=PKW(P1,10), pw3); \
    VRD(7); SBAR(); GAPA(C1=__builtin_amdgcn_mfma_f32_32x32x16_bf16(kf[7],qr[3],C1,0,0,0),   P1[14],P1[15],0.f,0.f,       pw3[2]=PKW(P1,12),pw3[3]=PKW(P1,14), pw3); \
    l_reg+=sacc; \
    if(GK){DMA_K((t)+3,sl_cur);} if(GV){DMA_V((t)+1,sl_next);} \
    CMASK(C0,C1,t); \
    { float a=MX3(C0[0],C0[1],C1[0]),b=MX3(C0[2],C0[3],C1[1]); a=MX3(a,C1[2],C1[3]); \
      _Pragma("unroll") for(int r=4;r<16;r+=4){a=MX3(a,C0[r],C0[r+1]);b=MX3(b,C0[r+2],C0[r+3]);a=MX3(a,C1[r],C1[r+1]);b=MX3(b,C1[r+2],C1[r+3]);} \
      float rm=__builtin_fmaxf(a,b); { auto rr=__builtin_amdgcn_permlane32_swap(__float_as_uint(rm),__float_as_uint(rm),false,false); rm=__builtin_fmaxf(__uint_as_float(rr[0]),__uint_as_float(rr[1])); } \
      resc=false; \
      if(__builtin_expect(__any(rm>(float)THRL),0)){ const float dl=__builtin_fmaxf(rm,0.f); mhat+=dl; \
        _Pragma("unroll") for(int r=0;r<16;++r){C0[r]-=dl;C1[r]-=dl;} \
        const float f=__builtin_amdgcn_exp2f(-dl); l_reg*=f; if(hi==0)wsf[r32]=f; resc=true; } } \
    SBAR(); \
    GAPB(o[0]=__builtin_amdgcn_mfma_f32_32x32x16_bf16(PAF(0),VFR(0),o[0],0,0,0), C0,0); \
    GAPB(o[1]=__builtin_amdgcn_mfma_f32_32x32x16_bf16(PAF(0),VFR(4),o[1],0,0,0), C0,4); \
    KRD(GL,0); GAPB(o[0]=__builtin_amdgcn_mfma_f32_32x32x16_bf16(PAF(1),VFR(1),o[0],0,0,0), C0,8); \
    KRD(GL,1); GAPB(o[1]=__builtin_amdgcn_mfma_f32_32x32x16_bf16(PAF(1),VFR(5),o[1],0,0,0), C0,12); \
    KRD(GL,2); GAPB(o[0]=__builtin_amdgcn_mfma_f32_32x32x16_bf16(PAF(2),VFR(2),o[0],0,0,0), C1,0); \
    KRD(GL,3); GAPB(o[1]=__builtin_amdgcn_mfma_f32_32x32x16_bf16(PAF(2),VFR(6),o[1],0,0,0), C1,4); \
    GAPB(o[0]=__builtin_amdgcn_mfma_f32_32x32x16_bf16(PAF(3),VFR(3),o[0],0,0,0), C1,8); \
    GAPB(o[1]=__builtin_amdgcn_mfma_f32_32x32x16_bf16(PAF(3),VFR(7),o[1],0,0,0), C1,12); \
    }while(0)
  int t=1;
  #undef CMASK
  #define CMASK(P0,P1,t) do{}while(0)
  for(;t+5<NT;t+=2){
    STEP(pB0,pB1,pA0,pA1,t,true,true,true);     WAIT_BAR(2); RESC(); ROT();
    STEP(pA0,pA1,pB0,pB1,t+1,true,true,true);   WAIT_BAR(2); RESC(); ROT();
  }
  #undef CMASK
  #define CMASK(P0,P1,t) do{int jb_=(t)-(NT-4); if(jb_>=0)cmask(P0,P1,jb_,qrel,hi);}while(0)
  #define ENDW(tt) do{ if((tt)+3<NT){WAIT_BAR(2);} else if((tt)+2<NT){WAIT_BAR(1);} else {WAIT_BAR(0);} }while(0)
  for(;t+1<NT;t+=2){
    STEP(pB0,pB1,pA0,pA1,t,(t+3<NT),(t+1<NT),(t+1<NT));       ENDW(t);   RESC(); ROT();
    STEP(pA0,pA1,pB0,pB1,t+1,(t+4<NT),(t+2<NT),(t+2<NT));     ENDW(t+1); RESC(); ROT();
  }
  STEP(pB0,pB1,pA0,pA1,NT-1,false,false,false); RESC();
  { float sacc=pB0[0]+pB0[1]; _Pragma("unroll") for(int r=2;r<16;++r)sacc+=pB0[r]; _Pragma("unroll") for(int r=0;r<16;++r)sacc+=pB1[r]; l_reg+=sacc;
    pw0=(u32x4){PKW(pB0,0),PKW(pB0,2),PKW(pB0,4),PKW(pB0,6)};pw1=(u32x4){PKW(pB0,8),PKW(pB0,10),PKW(pB0,12),PKW(pB0,14)};pw2=(u32x4){PKW(pB1,0),PKW(pB1,2),PKW(pB1,4),PKW(pB1,6)};pw3=(u32x4){PKW(pB1,8),PKW(pB1,10),PKW(pB1,12),PKW(pB1,14)};
    SBAR(); pv(o,vb0+sl_cur,PAF(0),PAF(1),PAF(2),PAF(3)); }
  #undef PKW
  #undef PAF
  #undef VFR
  #undef PIN
  #undef MX3
  #undef GAPA
  #undef GAPB
  #undef EX
  #undef VRD
  #undef KRD
  #undef STEP
  #undef ENDW
  {auto rr=__builtin_amdgcn_permlane32_swap(__float_as_uint(l_reg),__float_as_uint(l_reg),false,false);l_reg=__uint_as_float(rr[0])+__uint_as_float(rr[1]);}
  if(hi==0)wsf[32+r32]=l_reg;asm volatile("s_waitcnt lgkmcnt(0)":::"memory");
  float rli[16];
  #pragma unroll
  for(int r=0;r<16;++r)rli[r]=__builtin_amdgcn_rcpf(wsf[32+crow(r,hi)]);
  bf16*Ow=O+(rowbase+q0+wid*QBLK)*DMO+OCOL+h*D;
  { bf16*stg=(bf16*)(shm+LDS_OST)+wid*2048;
    #pragma unroll
    for(int r=0;r<16;++r){const int orow=crow(r,hi);
      #pragma unroll
      for(int d0=0;d0<2;++d0)stg[orow*64+d0*32+r32]=__float2bfloat16(o[d0][r]*rli[r]);}
    asm volatile("s_waitcnt lgkmcnt(0)":::"memory");
    #pragma unroll
    for(int i=0;i<4;++i){const int row=i*8+(lane>>3),ch=lane&7; const u32x4 v=*(const u32x4*)(stg+row*64+ch*8); ATTN_STORE16(Ow+(long)row*DMO+ch*8,v);} }
  asm volatile("s_waitcnt lgkmcnt(0)\n\ts_barrier":::"memory");
  #undef DMA_K
  #undef DMA_V
  #undef CMASK
  #undef START
  #undef BIAS
  #undef RESC
  #undef ROT
}
constexpr int ATTN_LDS_BYTES=LDS_BYTES;
struct AttnTensors { const bf16* Q; const bf16* K; const bf16* V; bf16* O; const float* nb; const float* qn; const float* kn; const int* t0tab; };
struct AttnUnit { int bh; int qb; };
struct StaticOrder {
  int vcu,G;
  __device__ __forceinline__ explicit StaticOrder(int grid,int block):vcu((grid%8==0)?(block%8)*(grid/8)+block/8:block),G(grid){}
  __device__ __forceinline__ bool next(int i,AttnUnit&u)const{ const int w=vcu+(i>>2)*G; if(w>=BATCH*NHEAD*8)return false; const int s=w&7,j=i&3; u.bh=((w>>3)+9*j)&31; u.qb=(j==0)?s:(j==1)?15-s:(j==2)?16+s:31-s; return true; }
  __device__ __forceinline__ void a_ready(const AttnUnit&)const{}
  __device__ __forceinline__ void done(const AttnUnit&)const{}
};
template<int THRL=8> __device__ __forceinline__ void attn_phase_dyn(char*lds,const AttnTensors&T,unsigned*ctr,volatile __attribute__((address_space(3))) unsigned*slot){
  const int tid=threadIdx.x,lane=tid&63;
  int ord=0;
  { const float myv=(lane<32)?T.nb[(long)lane*SEQ+SEQ-1]:3.0e38f; int rank=0;
    _Pragma("unroll") for(int j=0;j<32;++j){const float vj=__shfl(myv,j); rank+=(vj<myv||(vj==myv&&j<lane))?1:0;}
    _Pragma("unroll") for(int j=0;j<32;++j){const int rj=__shfl(rank,j); if(rj==lane)ord=j;} }
  if(tid==0){ const unsigned id=__hip_atomic_fetch_add(ctr,1u,__ATOMIC_RELAXED,__HIP_MEMORY_SCOPE_AGENT); *slot=id; }
  asm volatile("s_waitcnt vmcnt(0) lgkmcnt(0)\n\ts_barrier":::"memory");
  for(;;){
    const unsigned uid=*slot;
    if(uid>=(unsigned)(BATCH*NHEAD*NQB))break;
    unsigned nxt=0u; if(tid==0)nxt=__hip_atomic_fetch_add(ctr,1u,__ATOMIC_RELAXED,__HIP_MEMORY_SCOPE_AGENT);
    const int bh=__builtin_amdgcn_readfirstlane(__shfl(ord,(int)(uid>>5))), qb=NQB-1-(int)(uid&31u);
    const int t0=__builtin_amdgcn_readfirstlane(T.t0tab[bh*NQB+qb]);
    attn_unit<THRL>(bh/NHEAD,bh%NHEAD,qb,T.Q,T.K,T.V,T.O,T.nb+(long)bh*SEQ,t0,lds);
    if(tid==0)*slot=nxt;
    asm volatile("s_waitcnt vmcnt(0) lgkmcnt(0)\n\ts_barrier":::"memory");
  }
}
#undef SBAR
#undef WAIT_BAR
}
#define GAS __attribute__((address_space(1)))
#define LAS __attribute__((address_space(3)))
typedef unsigned short bf16;
typedef unsigned v4u __attribute__((ext_vector_type(4)));
typedef float f32x4 __attribute__((ext_vector_type(4)));
typedef short bf16x8 __attribute__((ext_vector_type(8)));
typedef GAS unsigned gu32;
typedef GAS unsigned long long gu64;
#define RLX_AGENT __ATOMIC_RELAXED, __HIP_MEMORY_SCOPE_AGENT
#define LDS_WAIT() asm volatile("s_waitcnt lgkmcnt(0)" ::: "memory")
#define VM_WAIT() asm volatile("s_waitcnt vmcnt(0)" ::: "memory")
__device__ __forceinline__ unsigned long long rt() { return __builtin_amdgcn_s_memrealtime(); }
typedef float f32x2_pk __attribute__((ext_vector_type(2))); typedef __bf16 bf16x2_pk __attribute__((ext_vector_type(2)));
__device__ __forceinline__ unsigned pk2(float lo, float hi) { f32x2_pk v = {lo, hi}; bf16x2_pk r = __builtin_convertvector(v, bf16x2_pk); return __builtin_bit_cast(unsigned, r); }
__device__ __forceinline__ unsigned f2bf(float f) { return pk2(f, 0.f) & 0xffffu; }

#define XB_TMO      128
#define XB_XCNT(j)  (256  + 64 * (j))
#define XB_XSUB(j)  (1280 + 64 * (j))
#define XB_XGEN(j)  (2304 + 64 * (j))
#define XB_TOP      3328
#define XB_TOPGEN   3392
#define XCD_BAR_WORDS 3456
#define XB_SPIN_CAP (1u << 18)

__device__ __forceinline__ unsigned xb_ld(unsigned* p)              { return __hip_atomic_load(p, __ATOMIC_RELAXED, __HIP_MEMORY_SCOPE_AGENT); }
__device__ __forceinline__ unsigned xb_add(unsigned* p, unsigned v) { return __hip_atomic_fetch_add(p, v, __ATOMIC_RELAXED, __HIP_MEMORY_SCOPE_AGENT); }
__device__ __forceinline__ unsigned xb_xcc_id() { return (unsigned)__builtin_amdgcn_s_getreg((3 << 11) | 20) & 0xFu; }
#define XB_SPIN(cond, bar) do { unsigned _sp = 0; while (cond) { __builtin_amdgcn_s_sleep(1); \
    if ((++_sp & 255u) == 0u) { if (xb_ld(&(bar)[XB_TMO])) break; if (_sp > XB_SPIN_CAP) { atomicAdd(&(bar)[XB_TMO], 1u); break; } } } } while (0)

struct XcdBarrier {
    unsigned* bar; unsigned x;
    volatile LAS unsigned* st;
};

__device__ __forceinline__ XcdBarrier xcd_barrier_post(unsigned* bar, volatile LAS unsigned* st) {
    XcdBarrier b; b.bar = bar; b.x = xb_xcc_id(); b.st = st;
    if (threadIdx.x == 0) (void)xb_add(&bar[XB_XCNT(b.x)], 1u);
    return b;
}
__device__ __forceinline__ void xcd_barrier_complete(unsigned* bar, unsigned x, unsigned& nloc, unsigned& nx) {
    const unsigned G = gridDim.x * gridDim.y * gridDim.z;
    unsigned sum, cnt, mine, sp = 0u;
    for (;;) {
        sum = 0u; cnt = 0u; mine = 0u;
#pragma unroll
        for (unsigned j = 0; j < 16; ++j) { const unsigned c = xb_ld(&bar[XB_XCNT(j)]); sum += c; cnt += (c > 0u) ? 1u : 0u; mine = (j == x) ? c : mine; }
        if (sum == G) break;
        __builtin_amdgcn_s_sleep(1);
        if ((++sp & 255u) == 0u) { if (xb_ld(&bar[XB_TMO])) break; if (sp > XB_SPIN_CAP) { atomicAdd(&bar[XB_TMO], 1u); break; } }
    }
    nloc = mine > 0u ? mine : 1u; nx = cnt > 0u ? cnt : 1u;
}

__device__ __forceinline__ void xcd_barrier(const XcdBarrier& b) {
    asm volatile("s_waitcnt vmcnt(0)" ::: "memory");
    __syncthreads();
    if (threadIdx.x == 0) {
        unsigned* bar = b.bar;
        __builtin_amdgcn_s_waitcnt(0);
        unsigned nloc = b.st[0], nx = b.st[1];
        if (nloc == 0u) { xcd_barrier_complete(bar, b.x, nloc, nx); b.st[0] = nloc; b.st[1] = nx; }
        const unsigned old = xb_add(&bar[XB_XSUB(b.x)], 1u);
        const unsigned gen = old / nloc;
        if (old + 1u == (gen + 1u) * nloc) {
            __builtin_amdgcn_fence(__ATOMIC_RELEASE, "agent");
            asm volatile("s_waitcnt vmcnt(0)" ::: "memory");
            const unsigned og = xb_add(&bar[XB_TOP], 1u);
            const unsigned tg = og / nx;
            if (og + 1u == (tg + 1u) * nx) xb_add(&bar[XB_TOPGEN], 1u);
            else XB_SPIN(xb_ld(&bar[XB_TOPGEN]) == tg, bar);
            __builtin_amdgcn_fence(__ATOMIC_ACQUIRE, "agent");
            xb_add(&bar[XB_XGEN(b.x)], 1u);
            asm volatile("s_waitcnt vmcnt(0)" ::: "memory");
        } else {
            XB_SPIN(xb_ld(&bar[XB_XGEN(b.x)]) == gen, bar);
            __builtin_amdgcn_fence(__ATOMIC_ACQUIRE, "agent");
            asm volatile("s_waitcnt vmcnt(0)" ::: "memory");
        }
    }
    __syncthreads();
}

constexpr int NWAVES = 8;
constexpr int BATCH = 4, SEQ = 8192, D = 1024, M = BATCH * SEQ;
constexpr int IN_W = 7184, NGW = 4096, NGT = 3072, NSLAB = 8;
constexpr int SL_POOL = 0, SL_MQ = 1, SL_MK = 2, SL_MV = 3, SL_MO = 4, SL_FQ = 5, SL_FK = 6, SL_FV = 7;
constexpr int ML_H = 4, ML_DH = 128, CHUNK = 64, NCH = SEQ / CHUNK;
constexpr int FX_H = 8;
constexpr int DFF = 2816, NEXP = 8, DFE = 3584;
constexpr float NORM_EPS = 1e-6f;
constexpr int XLD = 2 * D;
constexpr int XROT = 16;
constexpr int KCAT = 1536;
constexpr int MOE_KROWS = 34816;
constexpr int MOE_KTILES = MOE_KROWS / 256;
constexpr int TOKBLK = 128, NTOKBLK = M / TOKBLK;

constexpr size_t MiB = 1u << 20;
constexpr size_t WS_CTL = 0, CTL_ZERO_BYTES = 1 * MiB;
constexpr size_t WS_W = 1 * MiB;
constexpr size_t W_LAYER = 19 * MiB, W_NG = 0, W_GT = 8 * MiB, W_CAT = 14 * MiB, W_OUT = 17 * MiB;
constexpr size_t WS_WGU = WS_W + 2 * W_LAYER, WS_WDN = WS_WGU + 11 * MiB;
constexpr size_t WS_NG = 56 * MiB, SLAB_BYTES = (size_t)M * 512 * 2;
constexpr size_t WS_GATE = WS_NG + SLAB_BYTES;
constexpr size_t WS_ACT0 = WS_NG;
constexpr size_t WS_HB = 312 * MiB;
constexpr size_t WS_CAT = 376 * MiB;
constexpr size_t WS_MLC = 472 * MiB;
constexpr size_t WS_MOEGU = 1 * MiB;
constexpr size_t WS_MOEDN = 57 * MiB;
constexpr size_t WS_XS = 85 * MiB;
constexpr size_t WS_Y0 = 153 * MiB, WS_Y1 = 217 * MiB;
constexpr size_t WS_ACT1 = 305 * MiB;
constexpr size_t WS_SM = 544 * MiB;
constexpr size_t SM_GATE16 = 0;
constexpr size_t SM_MLB = 2 * MiB, SM_MLA = SM_MLB + 512 * 1024, SM_MLMX = SM_MLA + 512 * 1024;
constexpr size_t SM_FNB = SM_MLMX + 512 * 1024;
constexpr size_t SM_MLN = SM_FNB + 1 * MiB;
constexpr size_t SM_MLM = SM_MLN + 1 * MiB;
constexpr size_t SM_MLDEC = SM_MLM + 16 * 132 * 4;
constexpr size_t SM_FQN = SM_MLDEC + 16 * 128 * 4, SM_FKN = SM_FQN + 32768, SM_FT0 = SM_FKN + 32768, SM_MLBG = SM_FT0 + 4096, SM_FXM = SM_MLBG + 16384;
constexpr size_t SM_MOE = 6 * MiB;
constexpr size_t MO_RSTD = 0, MO_TOKE = MO_RSTD + (size_t)M * 4, MO_TOKG = MO_TOKE + (size_t)M * 8, MO_HIST = MO_TOKG + (size_t)M * 8,
                 MO_ROWTOK = MO_HIST + (size_t)NTOKBLK * 16 * 4, MO_ROWG = MO_ROWTOK + (size_t)2 * MOE_KROWS * 4, MO_TILEE = MO_ROWG + (size_t)2 * MOE_KROWS * 4, MO_NT = MO_TILEE + 2 * MOE_KTILES * 4, MO_END = MO_NT + 64;
static_assert(SM_MOE + MO_END <= 8 * MiB, "small arrays");
constexpr size_t WS_END = 552 * MiB;
static_assert(WS_WDN + (size_t)DFF * D * 2 <= WS_NG && WS_NG + NSLAB * SLAB_BYTES <= WS_HB && WS_HB + (size_t)M * D * 2 <= WS_CAT && WS_CAT + (size_t)M * KCAT * 2 <= WS_MLC && WS_MLC + 64 * MiB <= WS_SM, "d_ws map");
static_assert(WS_MOEGU + (size_t)NEXP * 2 * DFE * D <= WS_MOEDN && WS_MOEDN + (size_t)NEXP * D * DFE <= WS_XS && WS_XS + (size_t)2 * MOE_KROWS * D <= WS_Y0 && WS_Y0 + (size_t)M * D * 2 <= WS_Y1 && WS_Y1 + (size_t)M * D * 2 <= WS_ACT1 && WS_ACT1 + (size_t)2 * MOE_KROWS * DFE <= WS_SM, "d_ws map (MoE)");
constexpr int CW_TMO = 0, CW_CODE = 1, CW_BAR = 4096;

constexpr int RING_OFF = 0, RING_BYTES = 131072;
constexpr int LDSCTL_OFF = RING_BYTES, MISC_OFF = LDSCTL_OFF + 320;
constexpr int LDS_BYTES = 147456;
static_assert(MISC_OFF + 128 <= LDS_BYTES, "LDS map");

struct Frame {
    LAS unsigned char* lds;
    volatile LAS unsigned* MISC;
    gu32* ctl;
    int tid, lane, wave;
    int vcu, G, blk;
    unsigned char* ws;
    const float* const* in; float* out; int zi;
};
#define INP(F, i) ((F).in[(i) + (F).zi])
enum { IN_X = 0, IN_MIXG, IN_WIN, IN_POOLW, IN_POOLS, IN_CONVW, IN_MLBI, IN_MLBF, IN_MLNG, IN_FXBF, IN_WBRP, IN_WBRM, IN_WBRF, IN_WOUT, IN_FFNG, IN_FFG, IN_FFU, IN_FFD, IN_RW, IN_RB, IN_MOEG, IN_MOEU, IN_MOED, IN_FING };

__device__ __forceinline__ float wave_sum(float v) {
#pragma unroll
    for (int o = 1; o < 64; o <<= 1) v += __shfl_xor(v, o);
    return v;
}
__device__ __forceinline__ float wave_max(float v) {
#pragma unroll
    for (int o = 1; o < 64; o <<= 1) v = fmaxf(v, __shfl_xor(v, o));
    return v;
}
__device__ __forceinline__ float sigmoid_f(float x) { return __builtin_amdgcn_rcpf(1.f + __builtin_amdgcn_exp2f(-1.4426950408889634f * x)); }
__device__ __forceinline__ float logsigmoid_f(float x) { return fminf(x, 0.f) - log1pf(expf(-fabsf(x))); }

__device__ __forceinline__ void tr_item(const float* W, int ldw, int srccol0, const float* gain, bf16* WT, int ldt, int drow0, int dcol0, int k0, LAS float* scr, int lane) {
    (void)scr;
    const int ng = lane & 7, kg = lane >> 3;
    f32x4 v[8];
#pragma unroll
    for (int i = 0; i < 8; ++i) v[i] = *(const GAS f32x4*)(W + (size_t)(k0 + 8 * kg + i) * ldw + srccol0 + 4 * ng);
    if (gain) { const f32x4 g0 = *(const GAS f32x4*)(gain + k0 + 8 * kg), g1 = *(const GAS f32x4*)(gain + k0 + 8 * kg + 4);
#pragma unroll
        for (int i = 0; i < 4; ++i) { v[i] = v[i] * g0[i]; v[4 + i] = v[4 + i] * g1[i]; } }
#pragma unroll
    for (int j = 0; j < 4; ++j) { v4u o; o.x = pk2(v[0][j], v[1][j]); o.y = pk2(v[2][j], v[3][j]); o.z = pk2(v[4][j], v[5][j]); o.w = pk2(v[6][j], v[7][j]);
        *(GAS v4u*)(WT + (size_t)(drow0 + 4 * ng + j) * ldt + dcol0 + k0 + 8 * kg) = o; }
}
__device__ __forceinline__ void tr_item_fp8(const float* W, int ldw, int srccol0, const float* gain, float scale, unsigned char* WT8, int ldt, int drow0, int k0, int lane) {
    const int ng = lane & 7, kg = lane >> 3;
    f32x4 v[8];
#pragma unroll
    for (int i = 0; i < 8; ++i) v[i] = *(const GAS f32x4*)(W + (size_t)(k0 + 8 * kg + i) * ldw + srccol0 + 4 * ng);
    f32x4 g0 = (f32x4){scale, scale, scale, scale}, g1 = g0;
    if (gain) { g0 = *(const GAS f32x4*)(gain + k0 + 8 * kg) * scale; g1 = *(const GAS f32x4*)(gain + k0 + 8 * kg + 4) * scale; }
#pragma unroll
    for (int i = 0; i < 4; ++i) { v[i] = v[i] * g0[i]; v[4 + i] = v[4 + i] * g1[i]; }
    typedef unsigned u32x2_t __attribute__((ext_vector_type(2)));
#pragma unroll
    for (int j = 0; j < 4; ++j) { u32x2_t o; o.x = pg8::pack_fp8x4(v[0][j], v[1][j], v[2][j], v[3][j]); o.y = pg8::pack_fp8x4(v[4][j], v[5][j], v[6][j], v[7][j]);
        *(GAS u32x2_t*)(WT8 + (size_t)(drow0 + 4 * ng + j) * ldt + k0 + 8 * kg) = o; }
}
constexpr float FP8_ASCALE = 16.f, FP8_WSCALE = 256.f;
constexpr int CI_NG = 2048, CI_GT = 1536, CI_BR = 256, CI_OUT = 512, CI_LAYER = CI_NG + CI_GT + 2 * CI_BR + CI_OUT, CI_GU = 2816, CI_DN = 1408, CI_MAIN = 2 * CI_LAYER + CI_GU + CI_DN;
__device__ __forceinline__ void conv_item_main(Frame& F, int it, LAS float* scr) {
    if (it < 2 * CI_LAYER) {
        const int l = it / CI_LAYER; int r = it % CI_LAYER; bf16* wl = (bf16*)(F.ws + WS_W + (size_t)l * W_LAYER);
        const float* g = INP(F, IN_MIXG) + l * D; const float* win = INP(F, IN_WIN) + (size_t)l * D * IN_W;
        if (r < CI_NG) { const int nb = r >> 4, kb = r & 15; tr_item(win, IN_W, nb * 32 + (nb * 32 >= 2560 ? 8 : 0), g, wl + W_NG / 2, D, nb * 32, 0, kb * 64, scr, F.lane); return; } r -= CI_NG;
        if (r < CI_GT) { const int nb = r >> 4, kb = r & 15; tr_item_fp8(win, IN_W, 4112 + nb * 32, g, FP8_WSCALE, (unsigned char*)wl + W_GT, D, nb * 32, kb * 64, F.lane); return; } r -= CI_GT;
        if (r < CI_BR) { const int nb = r >> 3, kb = r & 7; tr_item(INP(F, IN_WBRM) + (size_t)l * 512 * D, D, nb * 32, nullptr, wl + W_CAT / 2, KCAT, nb * 32, 512, kb * 64, scr, F.lane); return; } r -= CI_BR;
        if (r < CI_BR) { const int nb = r >> 3, kb = r & 7; tr_item(INP(F, IN_WBRF) + (size_t)l * 512 * D, D, nb * 32, nullptr, wl + W_CAT / 2, KCAT, nb * 32, 1024, kb * 64, scr, F.lane); return; } r -= CI_BR;
        { const int nb = r >> 4, kb = r & 15; tr_item(INP(F, IN_WOUT) + (size_t)l * D * D, D, nb * 32, nullptr, wl + W_OUT / 2, D, nb * 32, 0, kb * 64, scr, F.lane); }
        return;
    }
    it -= 2 * CI_LAYER;
    if (it < CI_GU) { const int nb = it >> 4, kb = it & 15, p = nb >> 3, w = nb & 7;
        tr_item(w < 4 ? INP(F, IN_FFG) : INP(F, IN_FFU), DFF, 128 * p + (w & 3) * 32, INP(F, IN_FFNG), (bf16*)(F.ws + WS_WGU), D, nb * 32, 0, kb * 64, scr, F.lane); return; }
    it -= CI_GU;
    { const int kb = it >> 5, nb = it & 31; tr_item(INP(F, IN_FFD), D, nb * 32, nullptr, (bf16*)(F.ws + WS_WDN), DFF, nb * 32, 0, kb * 64, scr, F.lane); }
}
constexpr int CI_MGU = 3584, CI_MDN = 1792, CI_MEXP = CI_MGU + CI_MDN, CI_MOE = NEXP * CI_MEXP;
__device__ __forceinline__ void conv_item_moe(Frame& F, int it, LAS float* scr) {
    (void)scr;
    const int e = it / CI_MEXP; int r = it % CI_MEXP;
    if (r < CI_MGU) { const int nb = r % 224, kb = r / 224, p = nb >> 3, w = nb & 7;
        tr_item_fp8((w < 4 ? INP(F, IN_MOEG) : INP(F, IN_MOEU)) + (size_t)e * D * DFE, DFE, 128 * p + (w & 3) * 32, INP(F, IN_FFNG) + D, FP8_WSCALE, F.ws + WS_MOEGU + (size_t)e * 2 * DFE * D, D, nb * 32, kb * 64, F.lane); return; }
    r -= CI_MGU;
    { const int kb = r >> 5, nb = r & 31; tr_item_fp8(INP(F, IN_MOED) + (size_t)e * DFE * D, D, nb * 32, nullptr, FP8_WSCALE, F.ws + WS_MOEDN + (size_t)e * D * DFE, DFE, nb * 32, kb * 64, F.lane); }
}
__device__ __forceinline__ void pool_fold(Frame& F) {
    const int gt = F.blk * (NWAVES * 64) + F.tid, NT = F.G * NWAVES * 64;
    for (int o = gt; o < 2 * 4 * 16 * D; o += NT) {
        const int n = o & (D - 1), cb = __builtin_amdgcn_readfirstlane(o >> 10), l = cb >> 6, g = (cb >> 4) & 3, c0 = (cb & 15) * 8;
        const float* wg = INP(F, IN_POOLW) + (size_t)l * 4 * 128 * 128 + (size_t)(g * 128 + c0) * 128; const float* sc = INP(F, IN_POOLS) + l * 512 + g * 128; const float* wb = INP(F, IN_WBRP) + (size_t)l * 512 * D + (size_t)(g * 128) * D + n;
        float a[8];
#pragma unroll
        for (int i = 0; i < 8; ++i) a[i] = 0.f;
#pragma unroll 8
        for (int dd = 0; dd < 128; ++dd) { const float t = sc[dd] * wb[(size_t)dd * D];
#pragma unroll
            for (int i = 0; i < 8; ++i) a[i] += wg[i * 128 + dd] * t; }
        v4u w; w.x = pk2(a[0], a[1]); w.y = pk2(a[2], a[3]); w.z = pk2(a[4], a[5]); w.w = pk2(a[6], a[7]);
        *(GAS v4u*)((bf16*)(F.ws + WS_W + (size_t)l * W_LAYER + W_CAT) + (size_t)n * KCAT + g * 128 + c0) = w;
    }
}

template <bool XB, int LD = D, int ROT = 0> __device__ __forceinline__ void load_xrow(const void* x, size_t m, int lane, f32x4 (&v)[4]) {
    if constexpr (XB) { typedef unsigned u32x2_t __attribute__((ext_vector_type(2))); const GAS u32x2_t* xr = (const GAS u32x2_t*)((const bf16*)x + m * LD + (ROT ? (m & (ROT - 1)) * 64 : 0)) + lane;
#pragma unroll
        for (int j = 0; j < 4; ++j) { const u32x2_t q = xr[64 * j]; v[j] = (f32x4){__uint_as_float(q.x << 16), __uint_as_float(q.x & 0xffff0000u), __uint_as_float(q.y << 16), __uint_as_float(q.y & 0xffff0000u)}; } }
    else { const GAS f32x4* xr = (const GAS f32x4*)((const float*)x + m * D) + lane;
#pragma unroll
        for (int j = 0; j < 4; ++j) v[j] = xr[64 * j]; }
}
template <bool XB> __device__ __forceinline__ void phase_norm_mix(Frame& F, const void* x, int l) {
    LAS float* w16 = (LAS float*)(F.lds);
    const float* g = INP(F, IN_MIXG) + l * D; const float* win = INP(F, IN_WIN) + (size_t)l * D * IN_W;
    for (int idx = F.tid; idx < 16 * D; idx += NWAVES * 64) { const int k = idx >> 4, j = idx & 15, col = j < 8 ? 2560 + j : 4104 + (j - 8); w16[j * D + k] = g[k] * win[(size_t)k * IN_W + col]; }
    __syncthreads();
    bf16* HB = (bf16*)(F.ws + WS_HB); float* gate16 = (float*)(F.ws + WS_SM + SM_GATE16);
    const int gw = F.vcu * NWAVES + F.wave, NGWV = F.G * NWAVES;
    f32x4 nv[4]; if (gw < M) load_xrow<XB, XB ? XLD : D, XB ? XROT : 0>(x, (size_t)gw, F.lane, nv);
    for (int m = gw; m < M; m += NGWV) {
        f32x4 v[4]; float ss = 0.f;
#pragma unroll
        for (int j = 0; j < 4; ++j) v[j] = nv[j];
        if (m + NGWV < M) load_xrow<XB, XB ? XLD : D, XB ? XROT : 0>(x, (size_t)(m + NGWV), F.lane, nv);
#pragma unroll
        for (int j = 0; j < 4; ++j) ss += (v[j].x * v[j].x + v[j].y * v[j].y) + (v[j].z * v[j].z + v[j].w * v[j].w);
        const float rstd = 1.f / sqrtf(wave_sum(ss) * (1.f / D) + NORM_EPS);
        GAS unsigned long long* o8 = (GAS unsigned long long*)(HB + (size_t)m * D) + F.lane;
#pragma unroll
        for (int j = 0; j < 4; ++j) o8[64 * j] = (unsigned long long)pk2(v[j].x * rstd, v[j].y * rstd) | ((unsigned long long)pk2(v[j].z * rstd, v[j].w * rstd) << 32);
        float pp[16];
#pragma unroll
        for (int jj = 0; jj < 16; ++jj) { float p = 0.f;
#pragma unroll
            for (int j = 0; j < 4; ++j) { const f32x4 wv = *(const LAS f32x4*)(w16 + jj * D + 256 * j + 4 * F.lane); p += (v[j].x * wv.x + v[j].y * wv.y) + (v[j].z * wv.z + v[j].w * wv.w); }
            pp[jj] = p; if ((jj & 3) == 3) asm volatile("" ::: "memory"); }
#define TB_STAGE(ST, N) { const bool up = (F.lane >> (ST)) & 1; _Pragma("unroll") for (int i = 0; i < (N); ++i) { const float mine = up ? pp[2 * i + 1] : pp[2 * i], give = up ? pp[2 * i] : pp[2 * i + 1]; pp[i] = mine + __shfl_xor(give, 1 << (ST)); } }
        TB_STAGE(0, 8) TB_STAGE(1, 4) TB_STAGE(2, 2) TB_STAGE(3, 1)
        float keep = pp[0]; keep += __shfl_xor(keep, 16); keep += __shfl_xor(keep, 32); keep *= rstd;
        if (F.lane < 16) gate16[(size_t)m * 16 + F.lane] = keep;
    }
    __syncthreads();
}
__device__ __forceinline__ void phase_norm_ffn(Frame& F, const bf16* x) {
    bf16* HB = (bf16*)(F.ws + WS_HB);
    const int gw = F.vcu * NWAVES + F.wave, NGWV = F.G * NWAVES;
    f32x4 nv[4]; if (gw < M) load_xrow<true, XLD, XROT>(x, (size_t)gw, F.lane, nv);
    for (int m = gw; m < M; m += NGWV) {
        f32x4 v[4]; float ss = 0.f;
#pragma unroll
        for (int j = 0; j < 4; ++j) v[j] = nv[j];
        if (m + NGWV < M) load_xrow<true, XLD, XROT>(x, (size_t)(m + NGWV), F.lane, nv);
#pragma unroll
        for (int j = 0; j < 4; ++j) ss += (v[j].x * v[j].x + v[j].y * v[j].y) + (v[j].z * v[j].z + v[j].w * v[j].w);
        const float rstd = 1.f / sqrtf(wave_sum(ss) * (1.f / D) + NORM_EPS);
        GAS unsigned long long* o8 = (GAS unsigned long long*)(HB + (size_t)m * D) + F.lane;
#pragma unroll
        for (int j = 0; j < 4; ++j) o8[64 * j] = (unsigned long long)pk2(v[j].x * rstd, v[j].y * rstd) | ((unsigned long long)pk2(v[j].z * rstd, v[j].w * rstd) << 32);
    }
}
__device__ __forceinline__ void quant_rows_fp8(Frame& F, const bf16* src, unsigned char* dst) {
    const int gw = F.vcu * NWAVES + F.wave, NGWV = F.G * NWAVES;
    for (int m = gw; m < M; m += NGWV) {
        const v4u a = *((const GAS v4u*)(src + (size_t)m * D) + F.lane), b = *((const GAS v4u*)(src + (size_t)m * D) + 64 + F.lane);
        typedef unsigned u32x2_t __attribute__((ext_vector_type(2)));
        u32x2_t o0, o1; const float s = FP8_ASCALE;
        o0.x = pg8::pack_fp8x4(__uint_as_float(a.x << 16) * s, __uint_as_float(a.x & 0xffff0000u) * s, __uint_as_float(a.y << 16) * s, __uint_as_float(a.y & 0xffff0000u) * s);
        o0.y = pg8::pack_fp8x4(__uint_as_float(a.z << 16) * s, __uint_as_float(a.z & 0xffff0000u) * s, __uint_as_float(a.w << 16) * s, __uint_as_float(a.w & 0xffff0000u) * s);
        o1.x = pg8::pack_fp8x4(__uint_as_float(b.x << 16) * s, __uint_as_float(b.x & 0xffff0000u) * s, __uint_as_float(b.y << 16) * s, __uint_as_float(b.y & 0xffff0000u) * s);
        o1.y = pg8::pack_fp8x4(__uint_as_float(b.z << 16) * s, __uint_as_float(b.z & 0xffff0000u) * s, __uint_as_float(b.w << 16) * s, __uint_as_float(b.w & 0xffff0000u) * s);
        *((GAS u32x2_t*)(dst + (size_t)m * D) + F.lane) = o0; *((GAS u32x2_t*)(dst + (size_t)m * D) + 64 + F.lane) = o1;
    }
}
__device__ __forceinline__ void phase_norm_final(Frame& F, const bf16* xb, float* out) {
    const GAS f32x4* gp = (const GAS f32x4*)INP(F, IN_FING) + F.lane; f32x4 gv[4];
#pragma unroll
    for (int j = 0; j < 4; ++j) gv[j] = gp[64 * j];
    const bf16* Y0 = (const bf16*)(F.ws + WS_Y0); const bf16* Y1 = (const bf16*)(F.ws + WS_Y1);
    const int gw = F.vcu * NWAVES + F.wave, NGWV = F.G * NWAVES;
    f32x4 nv[4], na[4], nb_[4]; if (gw < M) { load_xrow<true, XLD, XROT>(xb, (size_t)gw, F.lane, nv); load_xrow<true>(Y0, (size_t)gw, F.lane, na); load_xrow<true>(Y1, (size_t)gw, F.lane, nb_); }
    for (int m = gw; m < M; m += NGWV) {
        f32x4 v[4]; float ss = 0.f;
#pragma unroll
        for (int j = 0; j < 4; ++j) v[j] = nv[j] + (na[j] + nb_[j]);
        if (m + NGWV < M) { load_xrow<true, XLD, XROT>(xb, (size_t)(m + NGWV), F.lane, nv); load_xrow<true>(Y0, (size_t)(m + NGWV), F.lane, na); load_xrow<true>(Y1, (size_t)(m + NGWV), F.lane, nb_); }
#pragma unroll
        for (int j = 0; j < 4; ++j) ss += (v[j].x * v[j].x + v[j].y * v[j].y) + (v[j].z * v[j].z + v[j].w * v[j].w);
        const float rstd = 1.f / sqrtf(wave_sum(ss) * (1.f / D) + NORM_EPS);
        GAS f32x4* o = (GAS f32x4*)(out + (size_t)m * D) + F.lane;
#pragma unroll
        for (int j = 0; j < 4; ++j) o[64 * j] = v[j] * rstd * gv[j];
    }
}

__device__ __forceinline__ void phase_route1(Frame& F, const bf16* x) {
    LAS float* w8 = (LAS float*)(F.lds);
    LAS int* hist = (LAS int*)(F.lds + 32768);
    const float* g = INP(F, IN_FFNG) + D; const float* rw = INP(F, IN_RW);
    for (int idx = F.tid; idx < 8 * D; idx += NWAVES * 64) { const int k = idx >> 3, e = idx & 7; w8[e * D + k] = g[k] * rw[(size_t)k * 8 + e]; }
    unsigned char* sm = F.ws + WS_SM + SM_MOE;
    float* rstd_g = (float*)(sm + MO_RSTD); int* tok_e = (int*)(sm + MO_TOKE); float* tok_g = (float*)(sm + MO_TOKG); int* hist_g = (int*)(sm + MO_HIST);
    for (int blk = F.blk; blk < NTOKBLK; blk += F.G) {
        if (F.tid < 16) hist[F.tid] = 0;
        __syncthreads();
        f32x4 nv[4]; load_xrow<true, XLD, XROT>(x, (size_t)(blk * TOKBLK + F.wave * (TOKBLK / NWAVES)), F.lane, nv);
        for (int i = 0; i < TOKBLK / NWAVES; ++i) {
            const int m = blk * TOKBLK + F.wave * (TOKBLK / NWAVES) + i;
            f32x4 v[4]; float ss = 0.f;
#pragma unroll
            for (int j = 0; j < 4; ++j) v[j] = nv[j];
            if (i + 1 < TOKBLK / NWAVES) load_xrow<true, XLD, XROT>(x, (size_t)(m + 1), F.lane, nv);
#pragma unroll
            for (int j = 0; j < 4; ++j) ss += (v[j].x * v[j].x + v[j].y * v[j].y) + (v[j].z * v[j].z + v[j].w * v[j].w);
            const float rstd = 1.f / sqrtf(wave_sum(ss) * (1.f / D) + NORM_EPS);
            float pp[8];
#pragma unroll
            for (int e = 0; e < 8; ++e) { float p = 0.f;
#pragma unroll
                for (int j = 0; j < 4; ++j) { const f32x4 wv = *(const LAS f32x4*)(w8 + e * D + 256 * j + 4 * F.lane); p += (v[j].x * wv.x + v[j].y * wv.y) + (v[j].z * wv.z + v[j].w * wv.w); }
                pp[e] = p; }
            TB_STAGE(0, 4) TB_STAGE(1, 2) TB_STAGE(2, 1)
            float tot = pp[0]; tot += __shfl_xor(tot, 8); tot += __shfl_xor(tot, 16); tot += __shfl_xor(tot, 32);
            float lg[8];
#pragma unroll
            for (int e = 0; e < 8; ++e) lg[e] = __shfl(tot, e) * rstd + INP(F, IN_RB)[e];
            if (F.lane == 0) {
                int e0 = 0; float v0 = lg[0];
#pragma unroll
                for (int e = 1; e < 8; ++e) if (lg[e] > v0) { v0 = lg[e]; e0 = e; }
                int e1 = -1; float v1 = -INFINITY;
#pragma unroll
                for (int e = 0; e < 8; ++e) if (e != e0 && lg[e] > v1) { v1 = lg[e]; e1 = e; }
                const float t = __expf(v1 - v0), g0 = 1.f / (1.f + t), g1 = t * g0;
                rstd_g[m] = rstd; tok_e[2 * m] = e0; tok_e[2 * m + 1] = e1; tok_g[2 * m] = g0; tok_g[2 * m + 1] = g1;
                atomicAdd((int*)&hist[e0], 1); atomicAdd((int*)&hist[8 + e1], 1);
            }
        }
        __syncthreads();
        if (F.tid < 16) hist_g[blk * 16 + F.tid] = hist[F.tid];
        __syncthreads();
    }
}
__device__ __forceinline__ void phase_route2(Frame& F, const bf16* x) {
    LAS int* H = (LAS int*)(F.lds);
    LAS int* tot = (LAS int*)(F.lds + 16384); LAS int* pre = tot + 16; LAS int* start = tot + 32; LAS int* dest = tot + 64; LAS int* te = tot + 320;
    unsigned char* sm = F.ws + WS_SM + SM_MOE;
    const float* rstd_g = (const float*)(sm + MO_RSTD); const int* tok_e = (const int*)(sm + MO_TOKE); const float* tok_g = (const float*)(sm + MO_TOKG); const int* hist_g = (const int*)(sm + MO_HIST);
    int* row_tok = (int*)(sm + MO_ROWTOK); float* row_g = (float*)(sm + MO_ROWG); int* tile_e = (int*)(sm + MO_TILEE); int* ntl = (int*)(sm + MO_NT);
    unsigned char* XS = F.ws + WS_XS;
    for (int blk = F.blk; blk < NTOKBLK; blk += F.G) {
        for (int i = F.tid; i < NTOKBLK * 16; i += NWAVES * 64) H[i] = hist_g[i];
        __syncthreads();
        if (F.tid < 16) { int t = 0, p = 0; for (int b = 0; b < NTOKBLK; ++b) { const int h = H[b * 16 + F.tid]; if (b < blk) p += h; t += h; } tot[F.tid] = t; pre[F.tid] = p; }
        __syncthreads();
        if (F.tid == 0) { for (int k = 0; k < 2; ++k) { int run = 0; for (int e = 0; e < 8; ++e) { start[k * 8 + e] = run; run += ((tot[k * 8 + e] + 255) >> 8) << 8; } if (blk == 0) ntl[k] = run >> 8; } }
        __syncthreads();
        if (F.tid < 2 * TOKBLK) te[F.tid] = tok_e[2 * blk * TOKBLK + F.tid];
        __syncthreads();
        if (F.tid < 16) { const int k = F.tid >> 3, e = F.tid & 7; int cnt = 0; const int base = k * MOE_KROWS + start[F.tid] + pre[F.tid];
            for (int i = 0; i < TOKBLK; ++i) if (te[2 * i + k] == e) { dest[2 * i + k] = base + cnt; ++cnt; }
            if (blk == 0) { const int s0 = start[F.tid], t0 = tot[F.tid], pe = ((t0 + 255) >> 8) << 8;
                for (int tI = s0 >> 8; tI < (s0 + pe) >> 8; ++tI) tile_e[k * MOE_KTILES + tI] = e;
                for (int r = s0 + t0; r < s0 + pe; ++r) { row_tok[k * MOE_KROWS + r] = -1; row_g[k * MOE_KROWS + r] = 0.f; } } }
        __syncthreads();
        for (int i0 = 0; i0 < TOKBLK / NWAVES; i0 += 4) {
            f32x4 xv[4][4]; float rs[4]; float tg[4][2];
#pragma unroll
            for (int q = 0; q < 4; ++q) { const int m = blk * TOKBLK + F.wave * (TOKBLK / NWAVES) + i0 + q; load_xrow<true, XLD, XROT>(x, (size_t)m, F.lane, xv[q]); rs[q] = rstd_g[m]; tg[q][0] = tok_g[2 * m]; tg[q][1] = tok_g[2 * m + 1]; }
#pragma unroll
            for (int q = 0; q < 4; ++q) { const int li = F.wave * (TOKBLK / NWAVES) + i0 + q, m = blk * TOKBLK + li; const int d0 = dest[2 * li], d1 = dest[2 * li + 1];
                GAS unsigned* o0 = (GAS unsigned*)(XS + (size_t)d0 * D) + F.lane; GAS unsigned* o1 = (GAS unsigned*)(XS + (size_t)d1 * D) + F.lane; const float sc = rs[q] * FP8_ASCALE;
#pragma unroll
                for (int j = 0; j < 4; ++j) { const f32x4 v = xv[q][j]; const unsigned w = pg8::pack_fp8x4(v.x * sc, v.y * sc, v.z * sc, v.w * sc); o0[64 * j] = w; o1[64 * j] = w; }
                if (F.lane == 0) { row_tok[d0] = m; row_g[d0] = tg[q][0]; row_tok[d1] = m; row_g[d1] = tg[q][1]; } }
        }
        __syncthreads();
    }
}

__device__ __forceinline__ float wave_scan_add(float v, int lane) {
#pragma unroll
    for (int d = 1; d < 64; d <<= 1) { const float t = __shfl_up(v, d); if (lane >= d) v += t; }
    return v;
}
__device__ __forceinline__ float wave_scan_max(float v, int lane) {
#pragma unroll
    for (int d = 1; d < 64; d <<= 1) { const float t = __shfl_up(v, d); if (lane >= d) v = fmaxf(v, t); }
    return v;
}
__device__ __forceinline__ void prep_mlstm(Frame& F, int l, int bh) {
    LAS float* Bc = (LAS float*)(F.lds); LAS float* Gc = Bc + NCH; LAS float* mc = Gc + NCH;
    const int b = bh >> 2, h = bh & 3;
    const float* gate16 = (const float*)(F.ws + WS_SM + SM_GATE16);
    float* mlb = (float*)(F.ws + WS_SM + SM_MLB) + (size_t)bh * SEQ; float* mla = (float*)(F.ws + WS_SM + SM_MLA) + (size_t)bh * SEQ; float* mlmx = (float*)(F.ws + WS_SM + SM_MLMX) + (size_t)bh * SEQ;
    float* mlm = (float*)(F.ws + WS_SM + SM_MLM) + bh * 132; float* mldec = (float*)(F.ws + WS_SM + SM_MLDEC) + bh * NCH;
    const float bi = INP(F, IN_MLBI)[l * ML_H + h], bf = INP(F, IN_MLBF)[l * ML_H + h];
    float areg[NCH / NWAVES];
#pragma unroll
    for (int ci = 0; ci < NCH / NWAVES; ++ci) {
        const int c = F.wave + NWAVES * ci, t = c * CHUNK + F.lane; const size_t m = (size_t)b * SEQ + t;
        const float lf = logsigmoid_f(gate16[m * 16 + 4 + h] + bf), li = gate16[m * 16 + h] + bi;
        const float bc = wave_scan_add(lf, F.lane), a = li - bc;
        const float amax = wave_max(a), btot = __shfl(bc, 63);
        mlb[t] = bc; mla[t] = a; areg[ci] = a;
        if (F.lane == 0) { Bc[c] = btot; Gc[c] = btot + amax; }
    }
    __syncthreads();
    if (F.tid == 0) { float mm = 0.f; for (int c = 0; c < NCH; ++c) { mc[c] = mm; const float mn = fmaxf(Bc[c] + mm, Gc[c]); mldec[c] = __expf(Bc[c] + mm - mn); mlm[c] = mm; mm = mn; } mc[NCH] = mm; mlm[NCH] = mm; }
    __syncthreads();
#pragma unroll
    for (int ci = 0; ci < NCH / NWAVES; ++ci) {
        const int c = F.wave + NWAVES * ci, t = c * CHUNK + F.lane;
        mlmx[t] = fmaxf(mc[c], wave_scan_max(areg[ci], F.lane));
    }
    __syncthreads();
}
__device__ __forceinline__ void prep_fox(Frame& F, int l, int bh) {
    LAS float* wtot = (LAS float*)(F.lds);
    const int b = bh >> 3, h = bh & 7;
    const float* gate16 = (const float*)(F.ws + WS_SM + SM_GATE16);
    float* nb = (float*)(F.ws + WS_SM + SM_FNB) + (size_t)bh * SEQ;
    const float bf = INP(F, IN_FXBF)[l * FX_H + h];
    float v[16]; float s = 0.f;
#pragma unroll
    for (int i = 0; i < 16; ++i) { const size_t m = (size_t)b * SEQ + F.tid * 16 + i; s += logsigmoid_f(gate16[m * 16 + 8 + h] + bf); v[i] = s; }
    const float incl = wave_scan_add(s, F.lane);
    if (F.lane == 63) wtot[F.wave] = incl;
    __syncthreads();
    float off = incl - s;
    for (int w = 0; w < F.wave; ++w) off += wtot[w];
#pragma unroll
    for (int i = 0; i < 16; ++i) nb[F.tid * 16 + i] = -1.4426950408889634f * (off + v[i]);
    __syncthreads();
}

__device__ __forceinline__ void unpack8(const v4u q, float (&f)[8]) {
    f[0] = __uint_as_float(q.x << 16); f[1] = __uint_as_float(q.x & 0xffff0000u); f[2] = __uint_as_float(q.y << 16); f[3] = __uint_as_float(q.y & 0xffff0000u);
    f[4] = __uint_as_float(q.z << 16); f[5] = __uint_as_float(q.z & 0xffff0000u); f[6] = __uint_as_float(q.w << 16); f[7] = __uint_as_float(q.w & 0xffff0000u);
}
__device__ __forceinline__ void pool_item(Frame& F, int item) {
    const bf16* U = (const bf16*)(F.ws + WS_NG + SL_POOL * SLAB_BYTES) + F.lane * 8; bf16* CAT = (bf16*)(F.ws + WS_CAT) + F.lane * 8;
    const int grp = F.lane >> 4, w = 2 << grp, m0 = item * 32, tt0 = m0 & (SEQ - 1);
    v4u ring[16];
#pragma unroll
    for (int j = 1; j < 16; ++j) { ring[(16 - j) & 15] = (v4u){0u, 0u, 0u, 0u}; if (tt0 - j >= 0) ring[(16 - j) & 15] = *(const GAS v4u*)(U + (size_t)(m0 - j) * 512); }
    float sum[8];
#pragma unroll
    for (int i = 0; i < 8; ++i) sum[i] = 0.f;
#pragma unroll
    for (int j = 1; j < 16; ++j) { float f[8]; unpack8(ring[(16 - j) & 15], f); const float on = (j < w) ? 1.f : 0.f;
#pragma unroll
        for (int i = 0; i < 8; ++i) sum[i] += on * f[i]; }
#pragma unroll
    for (int r0 = 0; r0 < 32; r0 += 8) {
        v4u cur[8];
#pragma unroll
        for (int j = 0; j < 8; ++j) cur[j] = *(const GAS v4u*)(U + (size_t)(m0 + r0 + j) * 512);
#pragma unroll
        for (int j = 0; j < 8; ++j) { const int r = r0 + j, tt = tt0 + r;
            float c[8]; unpack8(cur[j], c);
#pragma unroll
            for (int i = 0; i < 8; ++i) sum[i] += c[i];
            const int cnt = (tt + 1 < w) ? tt + 1 : w; const float inv = 1.f / (float)cnt;
            v4u o; o.x = pk2(sum[0] * inv - c[0], sum[1] * inv - c[1]); o.y = pk2(sum[2] * inv - c[2], sum[3] * inv - c[3]); o.z = pk2(sum[4] * inv - c[4], sum[5] * inv - c[5]); o.w = pk2(sum[6] * inv - c[6], sum[7] * inv - c[7]);
            *(GAS v4u*)(CAT + (size_t)(m0 + r) * KCAT) = o;
            const v4u a2 = (r - 1 >= 0 || true) ? ((r - 1) >= r0 ? cur[(j - 1) & 7] : ring[(r - 1) & 15]) : ring[0];
            const v4u a4 = ((r - 3) >= r0) ? cur[(j - 3) & 7] : ring[(r - 3) & 15];
            const v4u a8 = ((r - 7) >= r0) ? cur[(j - 7) & 7] : ring[(r - 7) & 15];
            const v4u a16 = ring[(r - 15) & 15];
            v4u old; old.x = grp == 0 ? a2.x : (grp == 1 ? a4.x : (grp == 2 ? a8.x : a16.x)); old.y = grp == 0 ? a2.y : (grp == 1 ? a4.y : (grp == 2 ? a8.y : a16.y));
            old.z = grp == 0 ? a2.z : (grp == 1 ? a4.z : (grp == 2 ? a8.z : a16.z)); old.w = grp == 0 ? a2.w : (grp == 1 ? a4.w : (grp == 2 ? a8.w : a16.w));
            float f[8]; unpack8(old, f);
#pragma unroll
            for (int i = 0; i < 8; ++i) sum[i] -= f[i];
        }
#pragma unroll
        for (int j = 0; j < 8; ++j) ring[(r0 + j) & 15] = cur[j];
    }
}

__device__ __forceinline__ void fox_norm_item(Frame& F, int it) {
    const int bhblk = it >> 3, wv = it & 7, bh = bhblk >> 5, blk = bhblk & 31, b = bh >> 3, h = bh & 7;
    const size_t m = (size_t)b * SEQ + blk * 256 + wv * 32 + (F.lane >> 1); const int col = h * 64 + (F.lane & 1) * 32;
    const bf16* QS = (const bf16*)(F.ws + WS_NG + SL_FQ * SLAB_BYTES) + m * 512 + col; const bf16* KS = (const bf16*)(F.ws + WS_NG + SL_FK * SLAB_BYTES) + m * 512 + col;
    float sq = 0.f, sk = 0.f, dq = 0.f;
#pragma unroll
    for (int i = 0; i < 4; ++i) { float f[8], g[8]; const v4u a = *(const GAS v4u*)(QS + 8 * i), c = *(const GAS v4u*)(KS + 8 * i);
        f[0] = __uint_as_float(a.x << 16); f[1] = __uint_as_float(a.x & 0xffff0000u); f[2] = __uint_as_float(a.y << 16); f[3] = __uint_as_float(a.y & 0xffff0000u); f[4] = __uint_as_float(a.z << 16); f[5] = __uint_as_float(a.z & 0xffff0000u); f[6] = __uint_as_float(a.w << 16); f[7] = __uint_as_float(a.w & 0xffff0000u);
        g[0] = __uint_as_float(c.x << 16); g[1] = __uint_as_float(c.x & 0xffff0000u); g[2] = __uint_as_float(c.y << 16); g[3] = __uint_as_float(c.y & 0xffff0000u); g[4] = __uint_as_float(c.z << 16); g[5] = __uint_as_float(c.z & 0xffff0000u); g[6] = __uint_as_float(c.w << 16); g[7] = __uint_as_float(c.w & 0xffff0000u);
#pragma unroll
        for (int j = 0; j < 8; ++j) { sq += f[j] * f[j]; sk += g[j] * g[j]; dq += f[j] * g[j]; } }
    sq += __shfl_xor(sq, 1); sk += __shfl_xor(sk, 1); dq += __shfl_xor(dq, 1);
    dq = -wave_max(-dq);
    sq = wave_max(sq) * 1.0001f; sk = wave_max(sk) * 1.0001f;
    if (F.lane == 0) { ((float*)(F.ws + WS_SM + SM_FQN))[it] = sq; ((float*)(F.ws + WS_SM + SM_FKN))[it] = sk; ((float*)(F.ws + WS_SM + SM_FXM))[it] = dq; }
}

typedef float f32x16 __attribute__((ext_vector_type(16)));
typedef unsigned u32x2 __attribute__((ext_vector_type(2)));
__device__ __forceinline__ float silu_f(float x) { return x * __builtin_amdgcn_rcpf(1.f + __builtin_amdgcn_exp2f(-1.4426950408889634f * x)); }
__device__ __forceinline__ void conv8(const bf16* slab, size_t m, int tt, int col, const float (&cw)[4][8], float (&o)[8]) {
    v4u q[4];
#pragma unroll
    for (int j = 0; j < 4; ++j) { const size_t mr = (tt - 3 + j >= 0) ? m - 3 + j : m; q[j] = *(const GAS v4u*)(slab + mr * 512 + col); }
#pragma unroll
    for (int i = 0; i < 8; ++i) o[i] = 0.f;
#pragma unroll
    for (int j = 0; j < 4; ++j) { float f[8]; unpack8(q[j], f); const float vld = (tt - 3 + j >= 0) ? 1.f : 0.f;
#pragma unroll
        for (int i = 0; i < 8; ++i) o[i] += (cw[j][i] * vld) * f[i]; }
#pragma unroll
    for (int i = 0; i < 8; ++i) o[i] = silu_f(o[i]);
}
constexpr int KT_P = 72, QS_P = 136;
__device__ __forceinline__ bf16x8 pack_acc8(const f32x16& x, int s) {
    v4u w; w.x = pk2(x[8 * s + 0], x[8 * s + 1]); w.y = pk2(x[8 * s + 2], x[8 * s + 3]); w.z = pk2(x[8 * s + 4], x[8 * s + 5]); w.w = pk2(x[8 * s + 6], x[8 * s + 7]);
    return __builtin_bit_cast(bf16x8, w);
}
__device__ __forceinline__ void conv8r(const v4u (&q)[4], int tt, const LAS float* cw, int col, float (&o)[8]) {
#pragma unroll
    for (int i = 0; i < 8; ++i) o[i] = 0.f;
#pragma unroll
    for (int j = 0; j < 4; ++j) { float f[8]; unpack8(q[j], f); const float vld = (tt - 3 + j >= 0) ? 1.f : 0.f;
        const f32x4 w0 = *(const LAS f32x4*)(cw + j * 512 + col) * vld, w1 = *(const LAS f32x4*)(cw + j * 512 + col + 4) * vld;
#pragma unroll
        for (int i = 0; i < 4; ++i) { o[i] += w0[i] * f[i]; o[4 + i] += w1[i] * f[4 + i]; } }
#pragma unroll
    for (int i = 0; i < 8; ++i) o[i] = silu_f(o[i]);
}
struct RawL { v4u k[2][4]; v4u v[2]; float fp, ip; };
__device__ __forceinline__ void mlstm_L_load(Frame& F, int u, RawL& R) {
    const int bh = u >> 7, c = u & (NCH - 1), b = bh >> 2, h = bh & 3;
    const bf16* KS = (const bf16*)(F.ws + WS_NG + SL_MK * SLAB_BYTES); const bf16* VS = (const bf16*)(F.ws + WS_NG + SL_MV * SLAB_BYTES);
    const int s = F.lane, tt = c * CHUNK + s; const size_t m = (size_t)b * SEQ + tt;
#pragma unroll
    for (int half = 0; half < 2; ++half) { const int col = h * ML_DH + (F.wave + 8 * half) * 8;
#pragma unroll
        for (int j = 0; j < 4; ++j) { const size_t mr = (tt - 3 + j >= 0) ? m - 3 + j : m; R.k[half][j] = *(const GAS v4u*)(KS + mr * 512 + col); }
        R.v[half] = *(const GAS v4u*)(VS + m * 512 + col); }
    const float* gate16 = (const float*)(F.ws + WS_SM + SM_GATE16) + m * 16;
    R.fp = gate16[4 + h]; R.ip = gate16[h];
}
__device__ __forceinline__ void mlstm_L_phase(Frame& F, int l) {
    LAS bf16* Kt = (LAS bf16*)(F.lds); LAS bf16* Vt = Kt + 128 * KT_P; LAS float* wk = (LAS float*)(F.lds + 2 * 128 * KT_P * 2); LAS float* cwk = (LAS float*)(F.lds + 40960);
    for (int i = F.tid; i < 4 * 512; i += NWAVES * 64) cwk[i] = INP(F, IN_CONVW)[(size_t)l * 4 * 1024 + (i >> 9) * 1024 + 512 + (i & 511)];
    const int NU = BATCH * ML_H * NCH;
    float b_f[ML_H], b_i[ML_H];
#pragma unroll
    for (int i = 0; i < ML_H; ++i) { b_f[i] = INP(F, IN_MLBF)[l * ML_H + i]; b_i[i] = INP(F, IN_MLBI)[l * ML_H + i]; }
    int u = F.vcu; if (u >= NU) { __syncthreads(); return; }
    RawL cur; mlstm_L_load(F, u, cur);
    __syncthreads();
    for (; u < NU; u += F.G) {
        const int bh = u >> 7, h = bh & 3;
        if (F.tid < CHUNK) {
            const float lf = logsigmoid_f(cur.fp + b_f[h]), li = cur.ip + b_i[h];
            const float bc = wave_scan_add(lf, F.lane), a = li - bc, amax = wave_max(a);
            wk[F.tid] = __expf(a - amax);
            const int c = u & (NCH - 1);
            ((float*)(F.ws + WS_SM + SM_MLB))[(size_t)bh * SEQ + c * CHUNK + F.tid] = bc; ((float*)(F.ws + WS_SM + SM_MLA))[(size_t)bh * SEQ + c * CHUNK + F.tid] = a;
            if (F.tid == 63) { float* bg = (float*)(F.ws + WS_SM + SM_MLBG) + 2 * u; bg[0] = bc; bg[1] = bc + amax; }
        }
        __syncthreads();
        {   const int s = F.lane, tt = (u & (NCH - 1)) * CHUNK + s;
#pragma unroll
            for (int half = 0; half < 2; ++half) { const int cg = F.wave + 8 * half, col = h * ML_DH + cg * 8;
                float kk[8]; conv8r(cur.k[half], tt, cwk, col, kk);
                float vv[8]; unpack8(cur.v[half], vv); const float ws = wk[s];
#pragma unroll
                for (int i = 0; i < 8; ++i) { Kt[(cg * 8 + i) * KT_P + s] = (bf16)f2bf(kk[i] * 0.08838834764831845f); Vt[(cg * 8 + i) * KT_P + s] = (bf16)f2bf(vv[i] * ws); } }
        }
        __syncthreads();
        if (u + F.G < NU) mlstm_L_load(F, u + F.G, cur);
        {   const int r = F.lane & 31, hi = F.lane >> 5, kb = F.wave >> 1;
            f32x16 acc[2]; acc[0] = f32x16{}; acc[1] = f32x16{};
#pragma unroll
            for (int sp = 0; sp < 4; ++sp) { const bf16x8 a = *(const LAS bf16x8*)(Kt + (kb * 32 + r) * KT_P + 16 * sp + 8 * hi);
#pragma unroll
                for (int j = 0; j < 2; ++j) { const int vb = 2 * (F.wave & 1) + j; const bf16x8 bb = *(const LAS bf16x8*)(Vt + (vb * 32 + r) * KT_P + 16 * sp + 8 * hi);
                    acc[j] = __builtin_amdgcn_mfma_f32_32x32x16_bf16(a, bb, acc[j], 0, 0, 0); } }
            GAS bf16x8* img = (GAS bf16x8*)(F.ws + WS_MLC + (size_t)u * 32768);
#pragma unroll
            for (int j = 0; j < 2; ++j) { const int vb = 2 * (F.wave & 1) + j;
#pragma unroll
                for (int s = 0; s < 2; ++s) img[((vb * 4 + kb) * 2 + s) * 64 + F.lane] = pack_acc8(acc[j], s); }
        }
        if (F.tid < ML_DH) { float a = 0.f;
#pragma unroll 8
            for (int s = 0; s < CHUNK; ++s) a += wk[s] * __uint_as_float((unsigned)Kt[F.tid * KT_P + s] << 16);
            ((float*)(F.ws + WS_SM + SM_MLN))[(size_t)u * ML_DH + F.tid] = a; }
        __syncthreads();
    }
}
__device__ __forceinline__ void mlstm_S(Frame& F) {
    LAS float* dec = (LAS float*)(F.lds); LAS float* cor = dec + NCH;
    for (int unit = F.vcu; unit < 16 * 16; unit += F.G) {
        const int bh = unit >> 4, part = unit & 15;
        if (F.tid == 0) { const float* bg = (const float*)(F.ws + WS_SM + SM_MLBG) + 2 * bh * NCH; float* mlm = (float*)(F.ws + WS_SM + SM_MLM) + bh * 132; float mm = 0.f;
            for (int c = 0; c < NCH; ++c) { const float B = bg[2 * c], G = bg[2 * c + 1], mn = fmaxf(B + mm, G); dec[c] = __expf(B + mm - mn); cor[c] = __expf(G - mn); mlm[c] = mm; mm = mn; }
            mlm[NCH] = mm; }
        __syncthreads();
        {   const int e2 = part * 512 + F.tid; GAS unsigned* p = (GAS unsigned*)(F.ws + WS_MLC + (size_t)bh * NCH * 32768) + e2;
            float r0 = 0.f, r1 = 0.f;
            for (int c0 = 0; c0 < NCH; c0 += 16) { unsigned q[16];
#pragma unroll
                for (int i = 0; i < 16; ++i) q[i] = p[(size_t)(c0 + i) * 8192];
#pragma unroll
                for (int i = 0; i < 16; ++i) { const float d = dec[c0 + i], k = cor[c0 + i]; p[(size_t)(c0 + i) * 8192] = pk2(r0, r1);
                    r0 = d * r0 + k * __uint_as_float(q[i] << 16); r1 = d * r1 + k * __uint_as_float(q[i] & 0xffff0000u); } } }
        if (part == 0 && F.tid < ML_DH) { float* p = (float*)(F.ws + WS_SM + SM_MLN) + (size_t)bh * NCH * ML_DH + F.tid;
            float r = 0.f;
            for (int c0 = 0; c0 < NCH; c0 += 16) { float q[16];
#pragma unroll
                for (int i = 0; i < 16; ++i) q[i] = p[(size_t)(c0 + i) * ML_DH];
#pragma unroll
                for (int i = 0; i < 16; ++i) { p[(size_t)(c0 + i) * ML_DH] = r; r = dec[c0 + i] * r + cor[c0 + i] * q[i]; } } }
        __syncthreads();
    }
}
#define O_BAR() do { asm volatile("s_waitcnt lgkmcnt(0)" ::: "memory"); __builtin_amdgcn_s_barrier(); asm volatile("" ::: "memory"); } while (0)
constexpr int O_RAWQ = 73728, O_RAWK = O_RAWQ + 68 * 256, O_RAWV = O_RAWK + 68 * 256, O_END = O_RAWV + 64 * 256;
static_assert(O_END + 3 * 2 * 1024 <= RING_BYTES, "mLSTM O-phase LDS map");
__device__ __forceinline__ void mlstm_O_dma(Frame& F, int u) {
    const int bh = u >> 7, c = u & (NCH - 1), b = bh >> 2, h = bh & 3;
    const size_t seq0 = (size_t)b * SEQ; const int t0 = c * CHUNK;
    for (int i = F.wave; i < 50; i += NWAVES) {
        const int ten = i < 17 ? 0 : (i < 34 ? 1 : 2), ii = i - 17 * ten, row = 4 * ii + (F.lane >> 4);
        int t = (ten == 2) ? t0 + row : t0 - 3 + row; t = t < 0 ? 0 : (t > t0 + CHUNK - 1 ? t0 + CHUNK - 1 : t);
        const bf16* src = (const bf16*)(F.ws + WS_NG + (size_t)(ten == 0 ? SL_MQ : (ten == 1 ? SL_MK : SL_MV)) * SLAB_BYTES) + (seq0 + t) * 512 + h * ML_DH + (((F.lane & 15) ^ (row & 15)) * 8);
        const int dst = (ten == 0 ? O_RAWQ : (ten == 1 ? O_RAWK : O_RAWV)) + ii * 1024;
        __builtin_amdgcn_global_load_lds((const GAS unsigned*)src, (LAS unsigned*)(F.lds + dst), 16, 0, 0);
    }
}
__device__ __forceinline__ void conv8l(const LAS bf16* raw, int s, int tt, const LAS float* cw, int cg, int col, float (&o)[8]) {
#pragma unroll
    for (int i = 0; i < 8; ++i) o[i] = 0.f;
#pragma unroll
    for (int j = 0; j < 4; ++j) { float f[8]; unpack8(*(const LAS v4u*)(raw + (s + j) * 128 + ((cg ^ ((s + j) & 15)) * 8)), f); const float vld = (tt - 3 + j >= 0) ? 1.f : 0.f;
        const f32x4 w0 = *(const LAS f32x4*)(cw + j * 512 + col) * vld, w1 = *(const LAS f32x4*)(cw + j * 512 + col + 4) * vld;
#pragma unroll
        for (int i = 0; i < 4; ++i) { o[i] += w0[i] * f[i]; o[4 + i] += w1[i] * f[4 + i]; } }
#pragma unroll
    for (int i = 0; i < 8; ++i) o[i] = silu_f(o[i]);
}
__device__ __forceinline__ void mlstm_O_phase(Frame& F, int l) {
    LAS bf16* Qs = (LAS bf16*)(F.lds); LAS bf16* Ks = Qs + 64 * QS_P; LAS bf16* Vt = Ks + 64 * QS_P;
    LAS float* fa = (LAS float*)(F.lds + (2 * 64 * QS_P + 128 * KT_P) * 2); LAS float* fmx = fa + 64; LAS float* fb = fa + 128; LAS float* nvec = fa + 192; LAS float* ssq = fa + 320;
    LAS float* cwq = (LAS float*)(F.lds + 57344); LAS float* cwk = cwq + 4 * 512;
    LAS float* psm = (LAS float*)(F.lds + 55552); LAS float* nqp = psm + 96; LAS bf16x8* pimg = (LAS bf16x8*)(F.lds + O_END);
    const LAS bf16* rawq = (const LAS bf16*)(F.lds + O_RAWQ); const LAS bf16* rawk = (const LAS bf16*)(F.lds + O_RAWK); const LAS bf16* rawv = (const LAS bf16*)(F.lds + O_RAWV);
    for (int i = F.tid; i < 4 * 512; i += NWAVES * 64) { cwq[i] = INP(F, IN_CONVW)[(size_t)l * 4 * 1024 + (i >> 9) * 1024 + (i & 511)]; cwk[i] = INP(F, IN_CONVW)[(size_t)l * 4 * 1024 + (i >> 9) * 1024 + 512 + (i & 511)]; }
    const int NU = BATCH * ML_H * NCH;
    int u = F.vcu; if (u >= NU) { __syncthreads(); return; }
    mlstm_O_dma(F, u);
    const bf16* OS = (const bf16*)(F.ws + WS_NG + SL_MO * SLAB_BYTES);
    const int r = F.lane & 31, hi = F.lane >> 5, tb = F.wave & 1, vb = F.wave >> 1;
    for (; u < NU; u += F.G) {
    const int bh = u >> 7, c = u & (NCH - 1), b = bh >> 2, h = bh & 3;
    asm volatile("s_waitcnt vmcnt(0)" ::: "memory"); O_BAR();
    const float m_c = ((const float*)(F.ws + WS_SM + SM_MLM))[bh * 132 + c];
    bf16x8 cf[4][2];
    {   const GAS bf16x8* img = (const GAS bf16x8*)(F.ws + WS_MLC + (size_t)u * 32768);
#pragma unroll
        for (int kb = 0; kb < 4; ++kb)
#pragma unroll
            for (int s = 0; s < 2; ++s) cf[kb][s] = img[((vb * 4 + kb) * 2 + s) * 64 + F.lane]; }
    u32x2 oww[4];
    {   const size_t m = (size_t)b * SEQ + c * CHUNK + tb * 32 + r;
#pragma unroll
        for (int q = 0; q < 4; ++q) oww[q] = *(const GAS u32x2*)(OS + m * 512 + h * ML_DH + vb * 32 + 8 * q + 4 * hi); }
    float g0 = 0.f, g1 = 0.f, g2 = 0.f;
    {   const float* mlb = (const float*)(F.ws + WS_SM + SM_MLB) + (size_t)bh * SEQ; const float* mla = (const float*)(F.ws + WS_SM + SM_MLA) + (size_t)bh * SEQ; const float* mlmx = (const float*)(F.ws + WS_SM + SM_MLMX) + (size_t)bh * SEQ;
        if (F.tid < CHUNK) { g0 = mla[c * CHUNK + F.tid]; g2 = mlb[c * CHUNK + F.tid]; g1 = fmaxf(m_c, wave_scan_max(g0, F.lane)); }
        else if (F.tid < CHUNK + ML_DH) g0 = ((const float*)(F.ws + WS_SM + SM_MLN))[(size_t)u * ML_DH + F.tid - CHUNK]; }
    {   const int s = F.lane, tt = c * CHUNK + s;
#pragma unroll
        for (int half = 0; half < 2; ++half) { const int cg = F.wave + 8 * half, col = h * ML_DH + cg * 8;
            float qq[8], kk[8], vv[8]; conv8l(rawq, s, tt, cwq, cg, col, qq); conv8l(rawk, s, tt, cwk, cg, col, kk); unpack8(*(const LAS v4u*)(rawv + s * 128 + ((cg ^ (s & 15)) * 8)), vv);
            v4u wq, wkk; wq.x = pk2(qq[0], qq[1]); wq.y = pk2(qq[2], qq[3]); wq.z = pk2(qq[4], qq[5]); wq.w = pk2(qq[6], qq[7]);
            const float sc = 0.08838834764831845f;
            wkk.x = pk2(kk[0] * sc, kk[1] * sc); wkk.y = pk2(kk[2] * sc, kk[3] * sc); wkk.z = pk2(kk[4] * sc, kk[5] * sc); wkk.w = pk2(kk[6] * sc, kk[7] * sc);
            *(LAS v4u*)(Qs + s * QS_P + cg * 8) = wq; *(LAS v4u*)(Ks + s * QS_P + cg * 8) = wkk;
#pragma unroll
            for (int i = 0; i < 8; ++i) Vt[(cg * 8 + i) * KT_P + s] = (bf16)f2bf(vv[i]); }
    }
    if (F.tid < CHUNK) { fa[F.tid] = g0; fmx[F.tid] = g1; fb[F.tid] = g2; }
    else if (F.tid < CHUNK + ML_DH) nvec[F.tid - CHUNK] = g0;
    O_BAR();
    if (u + F.G < NU) mlstm_O_dma(F, u + F.G);
    const int t = tb * 32 + r;
    const float Mx_t = fmx[t], m_t = fb[t] + Mx_t, w_int = __expf(m_c - Mx_t);
    if (F.wave < 3) {
        const int tbs = F.wave ? 1 : 0, sbs = F.wave == 2 ? 1 : 0, ts = tbs * 32 + r; const float Mxs = fmx[ts];
        f32x16 x = f32x16{};
#pragma unroll
        for (int ks = 0; ks < 8; ++ks) { const bf16x8 a = *(const LAS bf16x8*)(Ks + (sbs * 32 + r) * QS_P + 16 * ks + 8 * hi); const bf16x8 q = *(const LAS bf16x8*)(Qs + ts * QS_P + 16 * ks + 8 * hi);
            x = __builtin_amdgcn_mfma_f32_32x32x16_bf16(a, q, x, 0, 0, 0); }
        float ps = 0.f;
#pragma unroll
        for (int rr = 0; rr < 16; ++rr) { const int s = sbs * 32 + (rr & 3) + 8 * (rr >> 2) + 4 * hi; const float pv = (s <= ts) ? __expf(fa[s] - Mxs) * x[rr] : 0.f; x[rr] = pv; ps += pv; }
        ps += __shfl_xor(ps, 32);
        pimg[(F.wave * 2 + 0) * 64 + F.lane] = pack_acc8(x, 0); pimg[(F.wave * 2 + 1) * 64 + F.lane] = pack_acc8(x, 1);
        if (hi == 0) psm[F.wave * 32 + r] = ps;
    }
    {   float nq = 0.f;
#pragma unroll
        for (int i = 0; i < 2; ++i) { float f[8]; unpack8(*(const LAS v4u*)(Qs + t * QS_P + 32 * vb + 16 * hi + 8 * i), f);
#pragma unroll
            for (int j = 0; j < 8; ++j) nq += f[j] * nvec[32 * vb + 16 * hi + 8 * i + j]; }
        nq += __shfl_xor(nq, 32);
        if (hi == 0) nqp[vb * 64 + t] = nq; }
    f32x16 acc = f32x16{};
#pragma unroll
    for (int kb = 0; kb < 4; ++kb)
#pragma unroll
        for (int s = 0; s < 2; ++s) { const u32x2 lo = *(const LAS u32x2*)(Qs + t * QS_P + kb * 32 + 16 * s + 4 * hi), hi2 = *(const LAS u32x2*)(Qs + t * QS_P + kb * 32 + 16 * s + 8 + 4 * hi);
            v4u w; w.x = lo.x; w.y = lo.y; w.z = hi2.x; w.w = hi2.y;
            acc = __builtin_amdgcn_mfma_f32_32x32x16_bf16(cf[kb][s], __builtin_bit_cast(bf16x8, w), acc, 0, 0, 0); }
#pragma unroll
    for (int rr = 0; rr < 16; ++rr) acc[rr] *= w_int;
    O_BAR();
    float psum = 0.f;
#pragma unroll
    for (int sb = 0; sb < 2; ++sb) {
        if (sb <= tb) { const int blk = tb == 0 ? 0 : 1 + sb; psum += psm[blk * 32 + r];
#pragma unroll
            for (int s = 0; s < 2; ++s) { const u32x2 lo = *(const LAS u32x2*)(Vt + (vb * 32 + r) * KT_P + sb * 32 + 16 * s + 4 * hi), hi2 = *(const LAS u32x2*)(Vt + (vb * 32 + r) * KT_P + sb * 32 + 16 * s + 8 + 4 * hi);
                v4u w; w.x = lo.x; w.y = lo.y; w.z = hi2.x; w.w = hi2.y;
                acc = __builtin_amdgcn_mfma_f32_32x32x16_bf16(__builtin_bit_cast(bf16x8, w), pimg[(blk * 2 + s) * 64 + F.lane], acc, 0, 0, 0); }
        }
    }
    const float nq = (nqp[t] + nqp[64 + t]) + (nqp[128 + t] + nqp[192 + t]);
    const float den = w_int * nq + psum, inv = 1.f / fmaxf(fabsf(den), __expf(-m_t));
    float sq = 0.f;
#pragma unroll
    for (int rr = 0; rr < 16; ++rr) { acc[rr] *= inv; sq += acc[rr] * acc[rr]; }
    sq += __shfl_xor(sq, 32);
    if (hi == 0) ssq[vb * 64 + t] = sq;
    O_BAR();
    const float rstd = 1.f / sqrtf((ssq[t] + ssq[64 + t] + ssq[128 + t] + ssq[192 + t]) * (1.f / ML_DH) + NORM_EPS);
    {   const size_t m = (size_t)b * SEQ + c * CHUNK + t; bf16* CAT = (bf16*)(F.ws + WS_CAT);
#pragma unroll
        for (int q = 0; q < 4; ++q) { const int v0 = vb * 32 + 8 * q + 4 * hi, col = h * ML_DH + v0;
            const u32x2 ow = oww[q]; const f32x4 gn = *(const GAS f32x4*)(INP(F, IN_MLNG) + (size_t)l * 512 + col);
            const float o0 = sigmoid_f(__uint_as_float(ow.x << 16)), o1 = sigmoid_f(__uint_as_float(ow.x & 0xffff0000u)), o2 = sigmoid_f(__uint_as_float(ow.y << 16)), o3 = sigmoid_f(__uint_as_float(ow.y & 0xffff0000u));
            u32x2 w; w.x = pk2(acc[4 * q] * rstd * gn.x * o0, acc[4 * q + 1] * rstd * gn.y * o1); w.y = pk2(acc[4 * q + 2] * rstd * gn.z * o2, acc[4 * q + 3] * rstd * gn.w * o3);
            *(GAS u32x2*)(CAT + m * KCAT + 512 + col) = w; }
    }
    }
    asm volatile("s_waitcnt vmcnt(0)" ::: "memory"); O_BAR();
}
#undef O_BAR

#ifndef SUBP
#define SUBP 0
#endif
#ifndef MK_MULTI
#define MK_MULTI 0
#endif
constexpr int NPH = 1 + (8 + 1) + (1 + 8 + 4) + 1;
#ifndef PH_MASK
#define PH_MASK 0xffffffffu
#endif
#ifndef PROBE_MASK
#define PROBE_MASK 0u
#endif
#define PH_BEGIN(id) if (ph >= lo && ph < hi) { if constexpr (((PH_MASK) >> (id)) & 1u) { for (int rep_ = 0; rep_ < 1 + (int)(((PROBE_MASK) >> (id)) & 1u); ++rep_) { Frame F = FK; { size_t z_ = 0; int zi_ = 0; asm volatile("" : "+v"(F.tid), "+s"(z_), "+s"(zi_)); \
        F.lane = F.tid & 63; F.ws = FK.ws + z_; F.out = (float*)((char*)FK.out + z_); F.zi = zi_; } const int gw = F.vcu * NWAVES + F.wave, NGWV = F.G * NWAVES; (void)gw; (void)NGWV;
#define PH_END __syncthreads(); } } if (ph + 1 < hi) { XcdBarrier b2_ = bar; size_t zb_ = 0; asm volatile("" : "+s"(zb_)); b2_.bar = bar.bar + zb_; xcd_barrier(b2_); } } ++ph;
#define HB ((bf16*)(F.ws + WS_HB))
#define CAT ((bf16*)(F.ws + WS_CAT))
#define SLAB ((bf16*)(F.ws + WS_NG))
#define GATE ((bf16*)(F.ws + WS_GATE))
#define WL ((bf16*)(F.ws + WS_W + (size_t)l * W_LAYER))
#define XBP ((bf16*)F.out)

template <int l> __device__ __forceinline__ void layer_phases(Frame& FK, int& ph, const int lo, const int hi, const XcdBarrier& bar, unsigned char* lds) {
        if constexpr (l > 0) { PH_BEGIN(1) phase_norm_mix<true>(F, XBP, l); PH_END }
        PH_BEGIN(2)
            pg8::Gemm g{HB, WL + W_NG / 2, M, NGW, D}; pg8::StaticOrder S; S.init(M, NGW, F.G, F.blk);
            pg8::EpiSlab E{SLAB, (size_t)M * 512, SL_FQ, attn_body::C2};
            pg8::gemm_phase<pg8::EpiSlab, pg8::StaticOrder, true, true>(F.lds + RING_OFF, g, S, E);
        PH_END
        PH_BEGIN(3)
            for (int s = F.blk; s < BATCH * FX_H; s += F.G) prep_fox(F, l, s);
            for (int rp = 0; rp < (SUBP == 1 ? 2 : 1); ++rp) for (int it = gw; it < M / 32; it += NGWV) pool_item(F, it);
            for (int rp = 0; rp < (SUBP == 2 ? 2 : 1); ++rp) for (int it = gw; it < BATCH * FX_H * 32 * 8; it += NGWV) fox_norm_item(F, it);
            for (int rp = 0; rp < (SUBP == 3 ? 2 : 1); ++rp) mlstm_L_phase(F, l);
        PH_END
        PH_BEGIN(4)
            mlstm_S(F);
            for (int ui = gw; ui < BATCH * FX_H * 32; ui += NGWV) { const int bh = ui >> 5, qb = ui & 31;
                const int t0 = attn_body::attn_t0(qb, (const float*)(F.ws + WS_SM + SM_FNB) + (size_t)bh * SEQ, (const float*)(F.ws + WS_SM + SM_FQN) + bh * 256, (const float*)(F.ws + WS_SM + SM_FKN) + bh * 256, (const float*)(F.ws + WS_SM + SM_FXM) + bh * 256, F.lane);
                if (F.lane == 0) ((int*)(F.ws + WS_SM + SM_FT0))[ui] = t0; }
        PH_END
        PH_BEGIN(18)
            for (int rp = 0; rp < (SUBP == 4 ? 2 : 1); ++rp) mlstm_O_phase(F, l);
            const attn_body::AttnTensors AT{(const attn_body::bf16*)(SLAB + (size_t)SL_FQ * M * 512), (const attn_body::bf16*)(SLAB + (size_t)SL_FK * M * 512), (const attn_body::bf16*)(SLAB + (size_t)SL_FV * M * 512),
                                            (attn_body::bf16*)CAT, (const float*)(F.ws + WS_SM + SM_FNB), (const float*)(F.ws + WS_SM + SM_FQN), (const float*)(F.ws + WS_SM + SM_FKN), (const int*)(F.ws + WS_SM + SM_FT0)};
            attn_body::attn_phase_dyn<8>((char*)lds + RING_OFF, AT, (unsigned*)(F.ctl + 2048 + 64 * l), F.MISC + 0);
            quant_rows_fp8(F, HB, F.ws + WS_NG + (size_t)SL_POOL * SLAB_BYTES);
        PH_END
        PH_BEGIN(6)
            pg8::Gemm g{(const bf16*)(F.ws + WS_NG + (size_t)SL_POOL * SLAB_BYTES), WL + W_GT / 2, M, NGT, D / 2}; pg8::StaticOrder S; S.init(M, NGT, F.G, F.blk);
            pg8::EpiSig E{(unsigned char*)GATE, 1.f / (FP8_ASCALE * FP8_WSCALE)};
            pg8::gemm_phase<pg8::EpiSig, pg8::StaticOrder, true, true, true>(F.lds + RING_OFF, g, S, E);
        PH_END
        PH_BEGIN(7)
            pg8::Gemm g{CAT, WL + W_CAT / 2, M, D, KCAT}; pg8::StaticOrder S; S.init(M, D, F.G, F.blk);
            pg8::EpiMerge E{(const unsigned char*)GATE, HB};
            pg8::gemm_phase<pg8::EpiMerge, pg8::StaticOrder, true, true>(F.lds + RING_OFF, g, S, E);
        PH_END
        PH_BEGIN(8)
            pg8::Gemm g{HB, WL + W_OUT / 2, M, D, D}; pg8::StaticOrder S; S.init(M, D, F.G, F.blk);
            if constexpr (l == 0) { pg8::EpiResB<true> E{INP(F, IN_X), XBP, (float*)(F.ws + WS_SM + SM_GATE16)};     pg8::gemm_phase<pg8::EpiResB<true>, pg8::StaticOrder, true, true>(F.lds + RING_OFF, g, S, E); }
            else { pg8::EpiResB<false> E{XBP, XBP, nullptr}; pg8::gemm_phase<pg8::EpiResB<false>, pg8::StaticOrder, true, true>(F.lds + RING_OFF, g, S, E); }
        PH_END
        if constexpr (l == 0) {
            PH_BEGIN(10)
                pg8::Gemm g{XBP, (const bf16*)(F.ws + WS_WGU), M, 2 * DFF, D}; pg8::StaticOrder S; S.init(M, 2 * DFF, F.G, F.blk);
                pg8::EpiSwiGLUR E{(bf16*)(F.ws + WS_ACT0), DFF, (const float*)(F.ws + WS_SM + SM_GATE16), 1.f / D, NORM_EPS};
                pg8::gemm_phase<pg8::EpiSwiGLUR, pg8::StaticOrder, true, true, false, XLD, XROT>(F.lds + RING_OFF, g, S, E);
            PH_END
            PH_BEGIN(11)
                pg8::Gemm g{(const bf16*)(F.ws + WS_ACT0), (const bf16*)(F.ws + WS_WDN), M, D, DFF}; pg8::StaticOrder S; S.init(M, D, F.G, F.blk);
                pg8::EpiResB<false> E{XBP, XBP, nullptr};
                pg8::gemm_phase<pg8::EpiResB<false>, pg8::StaticOrder, true, true>(F.lds + RING_OFF, g, S, E);
            PH_END
        } else {
            PH_BEGIN(12)
                phase_route1(F, XBP);
                __syncthreads();
                LAS float* scr = (LAS float*)(F.lds + F.wave * 16384);
                for (int it = gw; it < CI_MOE; it += NGWV) conv_item_moe(F, it, scr);
            PH_END
            PH_BEGIN(13) phase_route2(F, XBP); PH_END
#define MOE_UP(k_, S_) do { pg8::Gemm g{(const bf16*)(F.ws + WS_XS + (size_t)(k_) * MOE_KROWS * D), (const bf16*)(F.ws + WS_MOEGU), MOE_KROWS, 2 * DFE, D / 2}; \
                    pg8::EpiSwiGLU8 E{F.ws + WS_ACT1 + (size_t)(k_) * MOE_KROWS * DFE, DFE, 1.f / (FP8_ASCALE * FP8_WSCALE), FP8_ASCALE}; \
                    pg8::gemm_phase<pg8::EpiSwiGLU8, decltype(S_), true, true, true>(F.lds + RING_OFF, g, S_, E); } while (0)
#define MOE_DOWN(k_, off_, lo_, hi_) do { pg8::Gemm g{(const bf16*)(F.ws + WS_ACT1 + (size_t)(k_) * MOE_KROWS * DFE), (const bf16*)(F.ws + WS_MOEDN), MOE_KROWS, D, DFE / 2}; pg8::MoeOrder S; S.init(nM[k_], D / 256, F.G, F.blk, tile_e + (k_) * MOE_KTILES, off_, lo_, hi_); \
                    pg8::EpiMoeDown E{(bf16*)(F.ws + ((k_) == 0 ? WS_Y0 : WS_Y1)), (const int*)(sm + MO_ROWTOK) + (k_) * MOE_KROWS, (const float*)(sm + MO_ROWG) + (k_) * MOE_KROWS, 1.f / (FP8_ASCALE * FP8_WSCALE)}; \
                    pg8::gemm_phase<pg8::EpiMoeDown, pg8::MoeOrder, true, true, true>(F.lds + RING_OFF, g, S, E); } while (0)
#define MOE_TABLES unsigned char* sm = F.ws + WS_SM + SM_MOE; LAS int* tile_e = (LAS int*)(F.lds + LDSCTL_OFF + 1024); \
                    for (int i_ = F.tid; i_ < 2 * MOE_KTILES; i_ += NWAVES * 64) tile_e[i_] = __hip_atomic_load((const int*)(sm + MO_TILEE) + i_, RLX_AGENT); __syncthreads(); \
                    const int nM[2] = {__builtin_amdgcn_readfirstlane(__hip_atomic_load((const int*)(sm + MO_NT), RLX_AGENT)), __builtin_amdgcn_readfirstlane(__hip_atomic_load((const int*)(sm + MO_NT) + 1, RLX_AGENT))}; \
                    const int Nd0 = nM[0] * (D / 256), r1 = (nM[1] * (D / 256)) % F.G, dfr_ = (F.G - r1) % F.G, dfr = dfr_ <= Nd0 ? dfr_ : 0;
            PH_BEGIN(14)
                MOE_TABLES
                pg8::MoeOrder S; S.init(nM[0], 2 * DFE / 256, F.G, F.blk, tile_e);
                MOE_UP(0, S);
            PH_END
            PH_BEGIN(15)
                MOE_TABLES
                MOE_DOWN(0, 0, 0, Nd0 - dfr);
                { const int Nd = Nd0 - dfr; pg8::MoeOrderHL R; R.init(nM[1], 2 * DFE / 256, F.G, F.blk, (F.G % 8 == 0) ? Nd % F.G : 0, 3.5f, tile_e + MOE_KTILES);
                  MOE_UP(1, R); }
            PH_END
            PH_BEGIN(19)
                MOE_TABLES
                MOE_DOWN(1, 0, 0, 0x7fffffff);
                if (dfr > 0) MOE_DOWN(0, Nd0 - dfr - r1, Nd0 - dfr, Nd0);
            PH_END
#undef MOE_UP
#undef MOE_DOWN
#undef MOE_TABLES
        }
    }
struct Args { const float* in[24]; float* out; unsigned char* ws; int ph_lo, ph_hi; };
__global__ void __launch_bounds__(NWAVES * 64, 2) fwd(Args args) {
    extern __shared__ __attribute__((aligned(16))) unsigned char lds[];
    Frame FK;
    FK.lds = (LAS unsigned char*)lds;
    FK.MISC = (volatile LAS unsigned*)(FK.lds + MISC_OFF);
    FK.tid = threadIdx.x; FK.lane = FK.tid & 63; FK.wave = __builtin_amdgcn_readfirstlane(FK.tid >> 6);
    FK.G = gridDim.x; FK.blk = blockIdx.x; { const int bx = blockIdx.x; FK.vcu = (FK.G % 8 == 0) ? (bx % 8) * (FK.G / 8) + bx / 8 : bx; }
    FK.ws = args.ws; FK.ctl = (gu32*)(args.ws + WS_CTL); FK.out = args.out;
    FK.in = args.in; FK.zi = 0;
    for (int u = FK.tid; u < (LDS_BYTES - LDSCTL_OFF) / 4; u += NWAVES * 64) ((LAS unsigned*)(FK.lds + LDSCTL_OFF))[u] = 0u;
    __syncthreads();
    const int lo = args.ph_lo, hi = args.ph_hi;
    XcdBarrier bar; bar.bar = (unsigned*)(FK.ctl + CW_BAR); bar.x = 0; bar.st = nullptr;
    if (hi - lo > 1) bar = xcd_barrier_post((unsigned*)(FK.ctl + CW_BAR), FK.MISC + 8);
    int ph = 0;
    PH_BEGIN(0)
        LAS float* scr = (LAS float*)(F.lds + F.wave * 16384);
        for (int it = gw; it < CI_MAIN; it += NGWV) conv_item_main(F, it, scr);
        pool_fold(F);
        __syncthreads();
        phase_norm_mix<false>(F, INP(F, IN_X), 0);
    PH_END

    layer_phases<0>(FK, ph, lo, hi, bar, lds);
    layer_phases<1>(FK, ph, lo, hi, bar, lds);
    PH_BEGIN(16) phase_norm_final(F, XBP, F.out); PH_END
#undef PH_BEGIN
#undef HB
#undef CAT
#undef SLAB
#undef GATE
#undef WL
#undef XBP
#undef PH_END
}

extern "C" void kernel_launch(void* const* d_in, const int* in_sizes, int n_in, void* d_out, int out_size, void* d_ws, size_t ws_size, hipStream_t stream) {
    static int grid = 0;
    if (grid == 0) {
        if (n_in != 24 || in_sizes[0] != M * D || out_size != M * D || ws_size < WS_END) { fprintf(stderr, "kernel_launch: built for 24 inputs, x/out of %d floats, >= %zu bytes of workspace; got n_in %d, in0 %d, out %d, ws %zu; nothing launched\n", M * D, (size_t)WS_END, n_in, n_in > 0 ? in_sizes[0] : -1, out_size, ws_size); grid = -1; return; }
        int dev = 0, cus = 0, per_cu = 0;
        if (hipGetDevice(&dev) != hipSuccess || hipDeviceGetAttribute(&cus, hipDeviceAttributeMultiprocessorCount, dev) != hipSuccess) { fprintf(stderr, "kernel_launch: hipGetDevice / hipDeviceGetAttribute failed\n"); grid = -1; return; }
        if (hipFuncSetAttribute((const void*)fwd, hipFuncAttributeMaxDynamicSharedMemorySize, LDS_BYTES) != hipSuccess) { fprintf(stderr, "kernel_launch: hipFuncSetAttribute failed\n"); grid = -1; return; }
        if (hipOccupancyMaxActiveBlocksPerMultiprocessor(&per_cu, (const void*)fwd, NWAVES * 64, LDS_BYTES) != hipSuccess || per_cu < 1)
            fprintf(stderr, "kernel_launch: note: the occupancy query reports %d workgroups per CU\n", per_cu);
        (void)hipGetLastError();
        grid = cus;
    }
    if (grid < 0) return;
    if (hipMemsetAsync((char*)d_ws + WS_CTL, 0, CTL_ZERO_BYTES, stream) != hipSuccess) { fprintf(stderr, "kernel_launch: hipMemsetAsync failed\n"); return; }
    Args a{};
    for (int i = 0; i < 24; ++i) a.in[i] = (const float*)d_in[i];
    a.out = (float*)d_out; a.ws = (unsigned char*)d_ws;
#if MK_MULTI
    for (int p = 0; p < NPH; ++p) { a.ph_lo = p; a.ph_hi = p + 1; hipLaunchKernelGGL(fwd, dim3(grid), dim3(NWAVES * 64), LDS_BYTES, stream, a); }
#else
    a.ph_lo = 0; a.ph_hi = NPH; hipLaunchKernelGGL(fwd, dim3(grid), dim3(NWAVES * 64), LDS_BYTES, stream, a);
#endif
    const hipError_t le = hipPeekAtLastError();
    if (le != hipSuccess) fprintf(stderr, "kernel_launch: launch failed: %s\n", hipGetErrorName(le));
}
```

```cpp
#include <hip/hip_runtime.h>
#include <cstdio>
#include <cstdint>
namespace pg8 {
#define PG8_LAS __attribute__((address_space(3)))
typedef unsigned short bf16_t;
typedef short bf16x8 __attribute__((ext_vector_type(8)));
typedef float f32x4 __attribute__((ext_vector_type(4)));
typedef unsigned u32x4 __attribute__((ext_vector_type(4)));
constexpr int BM = 256, BK = 64, HALF = 128, HTB = HALF * BK * 2  , STAGE_BYTES = 8 * HTB, NXCD = 8, WGM = 8, WGS = 4  ;

__host__ __device__ __forceinline__ int lds_byte(int r, int c) { const int st = (r >> 4) * 2 + (c >> 5), rr = r & 15, cc = c & 31, ob = rr * 64 + cc * 2; return st * 1024 + (ob ^ (((ob >> 9) & 1) << 5)); }
__host__ __device__ __forceinline__ void stage_rc(int b, int& R, int& C) { const int st = b / 1024, sb = b % 1024, swz = sb ^ (((sb >> 9) & 1) << 5); R = (st >> 1) * 16 + swz / 64; C = (st & 1) * 32 + (swz % 64) / 2; }
__host__ __device__ __forceinline__ int perm32(int rho) { const int n = rho >> 4, i = rho & 15; return 8 * (i >> 2) + 4 * n + (i & 3); }

struct Unit { int pm, pn, pb; };
struct Gemm { const bf16_t* A; const bf16_t* Bt; int M, N, K; const int* rowidx = nullptr; int zrow = 0; };

struct StaticOrder {
    int nM, nN, nwg, G, c;
    __host__ __device__ void init(int M, int N, int G_, int c_) { nM = M / BM; nN = N / BM; nwg = nM * nN; G = G_; c = c_; }
    __host__ __device__ bool next(int i, Unit& u) const {
        const long L = (long)i * G + c; if (L >= nwg) return false;
        int wgid = (int)L; { const int q = nwg / NXCD, r = nwg % NXCD, xcd = wgid % NXCD, off = wgid / NXCD; wgid = (xcd < r ? xcd * (q + 1) : r * (q + 1) + (xcd - r) * q) + off; }
        const int nig = WGS * nN, gid = wgid / nig, fm = gid * WGS, gsz = (nM - fm) < WGS ? (nM - fm) : WGS;
        u.pm = fm + ((wgid % nig) % gsz); u.pn = (wgid % nig) / gsz; u.pb = u.pn; return true;
    }
    __device__ __forceinline__ void a_ready(const Unit&) const {}
    __device__ __forceinline__ void done(const Unit&) const {}
};

__device__ __forceinline__ unsigned cvt_pk_bf16(float lo, float hi) { unsigned r; asm volatile("v_cvt_pk_bf16_f32 %0, %1, %2" : "=v"(r) : "v"(lo), "v"(hi)); return r; }
__device__ __forceinline__ float sigm(float x) { return __builtin_amdgcn_rcpf(1.f + __builtin_amdgcn_exp2f(-1.4426950408889634f * x)); }
typedef int v4i_t __attribute__((ext_vector_type(4)));
typedef int v8i_t __attribute__((ext_vector_type(8)));
__device__ __forceinline__ v8i_t cat8(bf16x8 a, bf16x8 b) { return __builtin_shufflevector(__builtin_bit_cast(v4i_t, a), __builtin_bit_cast(v4i_t, b), 0, 1, 2, 3, 4, 5, 6, 7); }
__device__ __forceinline__ float clamp8(float x) { return __builtin_amdgcn_fmed3f(x, -448.f, 448.f); }
__device__ __forceinline__ unsigned pack_fp8x4(float a, float b, float c, float d) { int w = 0; w = __builtin_amdgcn_cvt_pk_fp8_f32(clamp8(a), clamp8(b), w, false); w = __builtin_amdgcn_cvt_pk_fp8_f32(clamp8(c), clamp8(d), w, true); return (unsigned)w; }
__device__ __forceinline__ float bf_lo(unsigned w) { return __uint_as_float(w << 16); }
__device__ __forceinline__ float bf_hi(unsigned w) { return __uint_as_float(w & 0xffff0000u); }

struct EpiSlab {
    static constexpr bool PERM = true, AFTER_DRAIN = false, HOOK = false;
    static constexpr int NST = 16;
    bf16_t* O; size_t slab_stride; int qslab; float qscale;
    __device__ __forceinline__ void operator()(const f32x4 (&acc)[2][2][4][2], const Unit& u, int wr, int wc, int fr, int fq) const {
        const int slab = u.pn >> 1; bf16_t* base = O + (size_t)slab * slab_stride; const float sc = (slab == qslab) ? qscale : 1.f;
        const int row0 = u.pm * BM + wr * 64 + fr, col0 = (u.pn & 1) * 256 + wc * 32 + 8 * fq;
#pragma unroll
        for (int ai = 0; ai < 2; ++ai)
#pragma unroll
            for (int m = 0; m < 4; ++m) { bf16_t* rowp = base + (size_t)(row0 + ai * HALF + m * 16) * 512 + col0;
#pragma unroll
                for (int bj = 0; bj < 2; ++bj) { const f32x4 v0 = acc[ai][bj][m][0] * sc, v1 = acc[ai][bj][m][1] * sc;
                    u32x4 w; w.x = cvt_pk_bf16(v0[0], v0[1]); w.y = cvt_pk_bf16(v0[2], v0[3]); w.z = cvt_pk_bf16(v1[0], v1[1]); w.w = cvt_pk_bf16(v1[2], v1[3]);
                    *(u32x4*)(rowp + bj * HALF) = w; } }
    }
};
__device__ __forceinline__ size_t gate_img(int br, int pm, int pn, int piece, int wave, int lane) { return ((((size_t)(br * 512 + pm * 4 + pn) * 16 + piece) * 8 + wave) * 64 + lane) * 8; }
typedef unsigned u32x2g __attribute__((ext_vector_type(2)));
__device__ __forceinline__ float gate_val(float x, float c) { return __builtin_fmaxf(__builtin_fmaf(__builtin_amdgcn_rcpf(1.f + __builtin_amdgcn_exp2f(x * c)), 256.f, 0.5f), 1.f); }
__device__ __forceinline__ f32x4 ub4(unsigned w) { return (f32x4){(float)(w & 0xffu), (float)((w >> 8) & 0xffu), (float)((w >> 16) & 0xffu), (float)(w >> 24)}; }
struct EpiSig {
    static constexpr bool PERM = true, AFTER_DRAIN = false, HOOK = false;
    static constexpr int NST = 16;
    unsigned char* O; float in_scale;
    __device__ __forceinline__ void operator()(const f32x4 (&acc)[2][2][4][2], const Unit& u, int wr, int wc, int fr, int fq) const {
        const int br = u.pn >> 2, pn = u.pn & 3, wave = wr * 4 + wc, lane = fq * 16 + fr;
#pragma unroll
        for (int ai = 0; ai < 2; ++ai)
#pragma unroll
            for (int m = 0; m < 4; ++m)
#pragma unroll
                for (int bj = 0; bj < 2; ++bj) { const f32x4 v0 = acc[ai][bj][m][0], v1 = acc[ai][bj][m][1];
                    const float c = -1.4426950408889634f * in_scale; u32x2g w; w.x = 0u; w.y = 0u;
#pragma unroll
                    for (int j = 0; j < 4; ++j) { w.x = __builtin_amdgcn_cvt_pk_u8_f32(gate_val(v0[j], c), j, w.x); w.y = __builtin_amdgcn_cvt_pk_u8_f32(gate_val(v1[j], c), j, w.y); }
                    *(u32x2g*)(O + gate_img(br, u.pm, pn, ai * 8 + m * 2 + bj, wave, lane)) = w; }
    }
};
struct EpiMerge {
    static constexpr bool PERM = true, AFTER_DRAIN = false, HOOK = true;
    static constexpr int NST = 16;
    const unsigned char* G; bf16_t* O;
    __device__ __forceinline__ void hook(f32x4 (&acc)[2][2][4][2], const Unit& u, int t, int wr, int wc, int fr, int fq) const {
        const int i = (t >> 3) - 1; int lane = fq * 16 + fr; const int wave = wr * 4 + wc;
        asm volatile("" : "+v"(lane));
#pragma unroll
        for (int ai = 0; ai < 2; ++ai) {
            u32x2g ga[4][2], gb[4][2];
#pragma unroll
            for (int m = 0; m < 4; ++m)
#pragma unroll
                for (int bj = 0; bj < 2; ++bj) { ga[m][bj] = *(const u32x2g*)(G + gate_img(i, u.pm, u.pn, ai * 8 + m * 2 + bj, wave, lane)); gb[m][bj] = *(const u32x2g*)(G + gate_img(i + 1, u.pm, u.pn, ai * 8 + m * 2 + bj, wave, lane)); }
            __builtin_amdgcn_sched_barrier(0);
#pragma unroll
            for (int m = 0; m < 4; ++m)
#pragma unroll
                for (int bj = 0; bj < 2; ++bj) { const f32x4 a0 = ub4(ga[m][bj].x), a1 = ub4(ga[m][bj].y), b0 = ub4(gb[m][bj].x), b1 = ub4(gb[m][bj].y);
                    f32x4 r0, r1;
#pragma unroll
                    for (int j = 0; j < 4; ++j) { r0[j] = a0[j] * __builtin_amdgcn_rcpf(b0[j]); r1[j] = a1[j] * __builtin_amdgcn_rcpf(b1[j]); }
                    acc[ai][bj][m][0] *= r0; acc[ai][bj][m][1] *= r1; }
            __builtin_amdgcn_sched_barrier(0);
        }
    }
    __device__ __forceinline__ void operator()(const f32x4 (&acc)[2][2][4][2], const Unit& u, int wr, int wc, int fr, int fq) const {
        const int row0 = u.pm * BM + wr * 64 + fr, col0 = u.pn * BM + wc * 32 + 8 * fq, lane = fq * 16 + fr, wave = wr * 4 + wc;
        u32x2g g[2][4][2];
#pragma unroll
        for (int ai = 0; ai < 2; ++ai)
#pragma unroll
            for (int m = 0; m < 4; ++m)
#pragma unroll
                for (int bj = 0; bj < 2; ++bj) g[ai][m][bj] = *(const u32x2g*)(G + gate_img(2, u.pm, u.pn, ai * 8 + m * 2 + bj, wave, lane));
        __builtin_amdgcn_sched_barrier(0);
#pragma unroll
        for (int ai = 0; ai < 2; ++ai)
#pragma unroll
            for (int m = 0; m < 4; ++m) { const size_t off = (size_t)(row0 + ai * HALF + m * 16) * 1024 + col0;
#pragma unroll
                for (int bj = 0; bj < 2; ++bj) { const f32x4 g0 = ub4(g[ai][m][bj].x) * (1.f / 256.f), g1 = ub4(g[ai][m][bj].y) * (1.f / 256.f); const f32x4 v0 = acc[ai][bj][m][0] * g0, v1 = acc[ai][bj][m][1] * g1;
                    u32x4 w; w.x = cvt_pk_bf16(v0[0], v0[1]); w.y = cvt_pk_bf16(v0[2], v0[3]); w.z = cvt_pk_bf16(v1[0], v1[1]); w.w = cvt_pk_bf16(v1[2], v1[3]);
                    *(u32x4*)(O + off + bj * HALF) = w; } }
    }
};
struct EpiRes {
    static constexpr bool PERM = false, AFTER_DRAIN = false, HOOK = false;
    static constexpr int NST = 0;
    const float* base; float* out; int ldc; float in_scale = 1.f;
    __device__ __forceinline__ void operator()(const f32x4 (&acc)[2][2][4][2], const Unit& u, int wr, int wc, int fr, int fq) const {
        const int row0 = u.pm * BM + wr * 64 + fr, col0 = u.pn * BM + wc * 32 + 4 * fq;
#pragma unroll
        for (int ai = 0; ai < 2; ++ai) {
            f32x4 bs[4][2][2];
#pragma unroll
            for (int m = 0; m < 4; ++m)
#pragma unroll
                for (int bj = 0; bj < 2; ++bj)
#pragma unroll
                    for (int n = 0; n < 2; ++n) bs[m][bj][n] = *(const f32x4*)(base + (size_t)(row0 + ai * HALF + m * 16) * ldc + col0 + bj * HALF + n * 16);
            __builtin_amdgcn_sched_barrier(0);
#pragma unroll
            for (int m = 0; m < 4; ++m)
#pragma unroll
                for (int bj = 0; bj < 2; ++bj)
#pragma unroll
                    for (int n = 0; n < 2; ++n) *(f32x4*)(out + (size_t)(row0 + ai * HALF + m * 16) * ldc + col0 + bj * HALF + n * 16) = bs[m][bj][n] + acc[ai][bj][m][n] * in_scale;
            __builtin_amdgcn_sched_barrier(0);
        }
    }
};
template <bool BASE_F32> struct EpiResB {
    static constexpr bool PERM = true, AFTER_DRAIN = false, HOOK = false;
    static constexpr int NST = 16;
    static constexpr int XLD = 2048, XROT = 16;
    const void* base; bf16_t* out; float* ssq_part;
    __device__ __forceinline__ void operator()(const f32x4 (&acc)[2][2][4][2], const Unit& u, int wr, int wc, int fr, int fq) const {
        const int row0 = u.pm * BM + wr * 64 + fr, col0 = u.pn * BM + wc * 32 + 8 * fq;
#pragma unroll
        for (int ai = 0; ai < 2; ++ai) {
            f32x4 b0[4][2], b1[4][2];
            if constexpr (BASE_F32) {
#pragma unroll
                for (int m = 0; m < 4; ++m)
#pragma unroll
                    for (int bj = 0; bj < 2; ++bj) { const float* p = (const float*)base + (size_t)(row0 + ai * HALF + m * 16) * 1024 + col0 + bj * HALF; b0[m][bj] = *(const f32x4*)p; b1[m][bj] = *(const f32x4*)(p + 4); }
            } else {
                u32x4 q[4][2];
#pragma unroll
                for (int m = 0; m < 4; ++m)
#pragma unroll
                    for (int bj = 0; bj < 2; ++bj) q[m][bj] = *(const u32x4*)((const bf16_t*)base + (size_t)(row0 + ai * HALF + m * 16) * XLD + ((row0 + m * 16) & (XROT - 1)) * 64 + col0 + bj * HALF);
                __builtin_amdgcn_sched_barrier(0);
#pragma unroll
                for (int m = 0; m < 4; ++m)
#pragma unroll
                    for (int bj = 0; bj < 2; ++bj) { b0[m][bj] = (f32x4){bf_lo(q[m][bj].x), bf_hi(q[m][bj].x), bf_lo(q[m][bj].y), bf_hi(q[m][bj].y)}; b1[m][bj] = (f32x4){bf_lo(q[m][bj].z), bf_hi(q[m][bj].z), bf_lo(q[m][bj].w), bf_hi(q[m][bj].w)}; }
            }
            __builtin_amdgcn_sched_barrier(0);
#pragma unroll
            for (int m = 0; m < 4; ++m) { float ss = 0.f;
#pragma unroll
                for (int bj = 0; bj < 2; ++bj) { const f32x4 v0 = b0[m][bj] + acc[ai][bj][m][0], v1 = b1[m][bj] + acc[ai][bj][m][1];
                    ss += ((v0[0] * v0[0] + v0[1] * v0[1]) + (v0[2] * v0[2] + v0[3] * v0[3])) + ((v1[0] * v1[0] + v1[1] * v1[1]) + (v1[2] * v1[2] + v1[3] * v1[3]));
                    u32x4 w; w.x = cvt_pk_bf16(v0[0], v0[1]); w.y = cvt_pk_bf16(v0[2], v0[3]); w.z = cvt_pk_bf16(v1[0], v1[1]); w.w = cvt_pk_bf16(v1[2], v1[3]);
                    *(u32x4*)(out + (size_t)(row0 + ai * HALF + m * 16) * XLD + ((row0 + m * 16) & (XROT - 1)) * 64 + col0 + bj * HALF) = w; }
                if (ssq_part) { ss += __shfl_xor(ss, 16); ss += __shfl_xor(ss, 32); if (fq == 0) ssq_part[(size_t)(row0 + ai * HALF + m * 16) * 16 + u.pn * 4 + wc] = ss; } }
            __builtin_amdgcn_sched_barrier(0);
        }
    }
};
struct EpiSwiGLU {
    static constexpr bool PERM = true, AFTER_DRAIN = false, HOOK = false;
    static constexpr int NST = 0;
    bf16_t* O; int ldc;
    __device__ __forceinline__ void operator()(const f32x4 (&acc)[2][2][4][2], const Unit& u, int wr, int wc, int fr, int fq) const {
        const int row0 = u.pm * BM + wr * 64 + fr, col0 = u.pn * HALF + wc * 32 + 8 * fq;
#pragma unroll
        for (int ai = 0; ai < 2; ++ai)
#pragma unroll
            for (int m = 0; m < 4; ++m) { f32x4 v0, v1;
#pragma unroll
                for (int j = 0; j < 4; ++j) { const float g0 = acc[ai][0][m][0][j], g1 = acc[ai][0][m][1][j]; v0[j] = g0 * sigm(g0) * acc[ai][1][m][0][j]; v1[j] = g1 * sigm(g1) * acc[ai][1][m][1][j]; }
                u32x4 w; w.x = cvt_pk_bf16(v0[0], v0[1]); w.y = cvt_pk_bf16(v0[2], v0[3]); w.z = cvt_pk_bf16(v1[0], v1[1]); w.w = cvt_pk_bf16(v1[2], v1[3]);
                *(u32x4*)(O + (size_t)(row0 + ai * HALF + m * 16) * ldc + col0) = w; }
    }
};
struct EpiSwiGLUR {
    static constexpr bool PERM = true, AFTER_DRAIN = false, HOOK = false;
    static constexpr int NST = 8;
    bf16_t* O; int ldc; const PG8_LAS int* pml; const PG8_LAS float* rtab;
    __device__ __forceinline__ void operator()(const f32x4 (&acc)[2][2][4][2], const Unit& u, int wr, int wc, int fr, int fq) const {
        const int row0 = u.pm * BM + wr * 64 + fr, col0 = u.pn * HALF + wc * 32 + 8 * fq;
        int slot = 0; { int n; asm volatile("ds_read_b32 %0, %1\n\ts_waitcnt lgkmcnt(0)" : "=v"(n) : "v"((unsigned)(uintptr_t)pml) : "memory"); n = __builtin_amdgcn_readfirstlane(n);
            for (int k = 0; k < n; ++k) { int pk; asm volatile("ds_read_b32 %0, %1\n\ts_waitcnt lgkmcnt(0)" : "=v"(pk) : "v"((unsigned)(uintptr_t)(pml + 1 + k)) : "memory"); if (__builtin_amdgcn_readfirstlane(pk) == u.pm) slot = k; } }
        const unsigned rta = (unsigned)(uintptr_t)(rtab + slot * BM + wr * 64 + fr); float rsv[2][4];
#pragma unroll
        for (int ai = 0; ai < 2; ++ai)
#pragma unroll
            for (int m = 0; m < 4; ++m) asm volatile("ds_read_b32 %0, %1 offset:%c2" : "=v"(rsv[ai][m]) : "v"(rta), "i"((ai * HALF + m * 16) * 4) : "memory");
        asm volatile("s_waitcnt lgkmcnt(0)" : "+v"(rsv[0][0]), "+v"(rsv[0][1]), "+v"(rsv[0][2]), "+v"(rsv[0][3]), "+v"(rsv[1][0]), "+v"(rsv[1][1]), "+v"(rsv[1][2]), "+v"(rsv[1][3]));
#pragma unroll
        for (int ai = 0; ai < 2; ++ai)
#pragma unroll
            for (int m = 0; m < 4; ++m) { const float rs = rsv[ai][m]; f32x4 v0, v1;
#pragma unroll
                for (int j = 0; j < 4; ++j) { const float g0 = acc[ai][0][m][0][j] * rs, g1 = acc[ai][0][m][1][j] * rs; v0[j] = g0 * sigm(g0) * (acc[ai][1][m][0][j] * rs); v1[j] = g1 * sigm(g1) * (acc[ai][1][m][1][j] * rs); }
                u32x4 w; w.x = cvt_pk_bf16(v0[0], v0[1]); w.y = cvt_pk_bf16(v0[2], v0[3]); w.z = cvt_pk_bf16(v1[0], v1[1]); w.w = cvt_pk_bf16(v1[2], v1[3]);
                *(u32x4*)(O + (size_t)(row0 + ai * HALF + m * 16) * ldc + col0) = w; }
    }
};
struct EpiSwiGLU8 {
    static constexpr bool PERM = true, AFTER_DRAIN = false, HOOK = false;
    static constexpr int NST = 8;
    unsigned char* O; int ldc; float in_scale, out_scale;
    __device__ __forceinline__ void operator()(const f32x4 (&acc)[2][2][4][2], const Unit& u, int wr, int wc, int fr, int fq) const {
        const int row0 = u.pm * BM + wr * 64 + fr, col0 = u.pn * HALF + wc * 32 + 8 * fq; const float c1 = in_scale * in_scale * out_scale, c2 = -1.4426950408889634f * in_scale;
#pragma unroll
        for (int ai = 0; ai < 2; ++ai)
#pragma unroll
            for (int m = 0; m < 4; ++m) { f32x4 v0, v1;
#pragma unroll
                for (int j = 0; j < 4; ++j) { const float g0 = acc[ai][0][m][0][j], g1 = acc[ai][0][m][1][j];
                    v0[j] = (g0 * acc[ai][1][m][0][j]) * __builtin_amdgcn_rcpf(1.f + __builtin_amdgcn_exp2f(g0 * c2)) * c1; v1[j] = (g1 * acc[ai][1][m][1][j]) * __builtin_amdgcn_rcpf(1.f + __builtin_amdgcn_exp2f(g1 * c2)) * c1; }
                typedef unsigned u32x2_t __attribute__((ext_vector_type(2)));
                u32x2_t w; w.x = pack_fp8x4(v0[0], v0[1], v0[2], v0[3]); w.y = pack_fp8x4(v1[0], v1[1], v1[2], v1[3]);
                *(u32x2_t*)(O + (size_t)(row0 + ai * HALF + m * 16) * ldc + col0) = w; }
    }
};
struct EpiMoeDown {
    static constexpr bool PERM = true, AFTER_DRAIN = false, HOOK = false;
    static constexpr int NST = 0;
    bf16_t* Y; const int* row_tok; const float* row_g; float in_scale;
    __device__ __forceinline__ void operator()(const f32x4 (&acc)[2][2][4][2], const Unit& u, int wr, int wc, int fr, int fq) const {
        const int row0 = u.pm * BM + wr * 64 + fr, col0 = u.pn * BM + wc * 32 + 8 * fq;
#pragma unroll
        for (int ai = 0; ai < 2; ++ai)
#pragma unroll
            for (int m = 0; m < 4; ++m) { const int r = row0 + ai * HALF + m * 16; const int tok = row_tok[r]; const float g = row_g[r] * in_scale;
                if (tok >= 0) { bf16_t* p = Y + (size_t)tok * 1024 + col0;
#pragma unroll
                    for (int bj = 0; bj < 2; ++bj) { const f32x4 v0 = acc[ai][bj][m][0] * g, v1 = acc[ai][bj][m][1] * g;
                        u32x4 w; w.x = cvt_pk_bf16(v0[0], v0[1]); w.y = cvt_pk_bf16(v0[2], v0[3]); w.z = cvt_pk_bf16(v1[0], v1[1]); w.w = cvt_pk_bf16(v1[2], v1[3]);
                        *(u32x4*)(p + bj * HALF) = w; } } }
    }
};
struct MoeRange {
    int nM, nN, lo, hi; const PG8_LAS int* tile_e;
    __device__ void init(int nM_, int nN_, int lo_, int hi_, const PG8_LAS int* te) { nM = nM_; nN = nN_; lo = lo_; hi = hi_; tile_e = te; }
    __device__ bool next(int i, Unit& u) const {
        const int wgid = lo + i; if (wgid >= hi) return false;
        const int nig = WGM * nN, gid = wgid / nig, fm = gid * WGM, gsz = (nM - fm) < WGM ? (nM - fm) : WGM;
        u.pm = fm + ((wgid % nig) % gsz); u.pn = (wgid % nig) / gsz;
        const int e = __builtin_amdgcn_readfirstlane(tile_e[u.pm]); u.pb = e * nN + u.pn; return true;
    }
    __device__ __forceinline__ void a_ready(const Unit&) const {}
    __device__ __forceinline__ void done(const Unit&) const {}
};
struct MoeOrderHL {
    int nM, nN, nwg, G, c, heavy, R0; const PG8_LAS int* tile_e;
    __device__ void init(int nM_, int nN_, int G_, int c_, int heavy_, float rho, const PG8_LAS int* te) { nM = nM_; nN = nN_; nwg = nM * nN; G = G_; c = c_; heavy = heavy_; tile_e = te;
        const int cpx = G / NXCD, hx = heavy / NXCD; const float r0 = ((float)(nwg / NXCD) - rho * (float)(cpx - hx)) / (float)cpx + 0.5f; R0 = r0 > 0.f ? (int)r0 : 0; if (heavy == 0) R0 = 1 << 20; }
    __device__ bool next(int i, Unit& u) const {
        const int q = nwg / NXCD, r = nwg % NXCD; int wgid;
        if (heavy == 0 || G % NXCD != 0) { const long L = (long)i * G + c; if (L >= nwg) return false;
            const int xcd = (int)L % NXCD, off_ = (int)L / NXCD; wgid = (xcd < r ? xcd * (q + 1) : r * (q + 1) + (xcd - r) * q) + off_; }
        else { const int cpx = G / NXCD, x = c % NXCD, j = c / NXCD; int hx = heavy > x ? (heavy - x + NXCD - 1) / NXCD : 0; if (hx >= cpx) hx = 0;
            const int qx = q + (x < r ? 1 : 0), start = x < r ? x * (q + 1) : r * (q + 1) + (x - r) * q;
            int p;
            if (i < R0) p = i * cpx + j; else { if (j < hx) return false; p = R0 * cpx + (i - R0) * (cpx - hx) + (j - hx); }
            if (p >= qx) return false;
            wgid = start + p; }
        const int nig = WGM * nN, gid = wgid / nig, fm = gid * WGM, gsz = (nM - fm) < WGM ? (nM - fm) : WGM;
        u.pm = fm + ((wgid % nig) % gsz); u.pn = (wgid % nig) / gsz;
        const int e = __builtin_amdgcn_readfirstlane(tile_e[u.pm]); u.pb = e * nN + u.pn; return true;
    }
    __device__ __forceinline__ void a_ready(const Unit&) const {}
    __device__ __forceinline__ void done(const Unit&) const {}
};
struct MoeOrder {
    int nM, nN, nwg, G, c, off, lo, hi; const PG8_LAS int* tile_e;
    __device__ void init(int nM_, int nN_, int G_, int c_, const PG8_LAS int* te, int off_ = 0, int lo_ = 0, int hi_ = 0x7fffffff) { nM = nM_; nN = nN_; nwg = nM * nN; G = G_; c = c_; tile_e = te; off = off_; lo = lo_; hi = hi_ < nwg ? hi_ : nwg; }
    __device__ bool next(int i, Unit& u) const {
        const long L = (long)i * G + c + off; if (L < lo || L >= hi) return false;
        int wgid = (int)L; { const int q = nwg / NXCD, r = nwg % NXCD, xcd = wgid % NXCD, off_ = wgid / NXCD; wgid = (xcd < r ? xcd * (q + 1) : r * (q + 1) + (xcd - r) * q) + off_; }
        const int nig = WGM * nN, gid = wgid / nig, fm = gid * WGM, gsz = (nM - fm) < WGM ? (nM - fm) : WGM;
        u.pm = fm + ((wgid % nig) % gsz); u.pn = (wgid % nig) / gsz;
        const int e = __builtin_amdgcn_readfirstlane(tile_e[u.pm]); u.pb = e * nN + u.pn; return true;
    }
    __device__ __forceinline__ void a_ready(const Unit&) const {}
    __device__ __forceinline__ void done(const Unit&) const {}
};
template <class Epi, class Sched, bool ALIGN_EPI = false, bool SP2 = false, bool FP8 = false, int LDA = 0, int ROTA = 0, bool GATHER = false>
__device__ __forceinline__ void gemm_phase(PG8_LAS unsigned char* lds, const Gemm g, const Sched& S, const Epi& E) {
    int tid_ = threadIdx.x; asm volatile("" : "+v"(tid_));
    const int tid = tid_, wid = __builtin_amdgcn_readfirstlane(tid >> 6), lane = tid & 63, wr = wid >> 2, wc = wid & 3, fr = lane & 15, fq = lane >> 4;
    const int K = g.K, nt = K / BK;
    unsigned voffA[2], voffB[2];
#pragma unroll
    for (int i = 0; i < 2; ++i) { int R, C; stage_rc(tid * 16 + i * 8192, R, C); const int Rb = Epi::PERM ? ((R & ~31) + perm32(R & 31)) : R;
        voffA[i] = (unsigned)(R * (LDA ? LDA : K) + C) * 2u + (ROTA ? (unsigned)(R & (ROTA - 1)) * 128u : 0u); voffB[i] = (unsigned)(Rb * K + C) * 2u; }
    unsigned vc[2][2] = {{0u, 0u}, {0u, 0u}};
    PG8_LAS int* idxl = (PG8_LAS int*)(lds + STAGE_BYTES + 4096);
    const size_t kstep = (size_t)(BK * 2);
    const size_t hstep = (size_t)HALF * K * 2;
    const size_t tstep = 2 * hstep;
    const size_t hstepA = (size_t)HALF * (LDA ? LDA : K) * 2, tstepA = 2 * hstepA;
    const unsigned ldsw = (unsigned)wid * 1024u;
    const int aoff = lds_byte(wr * 64 + fr, fq * 8), boff = lds_byte(wc * 32 + fr, fq * 8);
#define PG8_SA(b, h) (((b) * 2 + (h)) * HTB)
#define PG8_SB(b, h) ((4 + (b) * 2 + (h)) * HTB)
#define PG8_STAGE(bufoff, gbase, voff) do { _Pragma("unroll") for (int _i = 0; _i < 2; ++_i) \
        __builtin_amdgcn_global_load_lds((const unsigned*)((const char*)(gbase) + (voff)[_i]), (PG8_LAS unsigned*)(lds + (bufoff) + ldsw + _i * 8192), 16, 0, 0); } while (0)
#define PG8_STAGE_AX(bufoff, gbase, hh, NEXT) do { if constexpr (GATHER) { _Pragma("unroll") for (int _i = 0; _i < 2; ++_i) \
        __builtin_amdgcn_global_load_lds((const unsigned*)((const char*)(gbase) + vc[hh][_i]), (PG8_LAS unsigned*)(lds + (bufoff) + ldsw + _i * 8192), 16, 0, 0); } \
    else PG8_STAGE(bufoff, (gbase) + ((hh) ? hstepA : 0), voffA); } while (0)
#define PG8_LDA(dst, b, h) do { _Pragma("unroll") for (int m = 0; m < 4; ++m) _Pragma("unroll") for (int k = 0; k < 2; ++k) dst[m][k] = *(const PG8_LAS bf16x8*)(lds + PG8_SA(b, h) + aoff + m * 2048 + k * 1024); } while (0)
#define PG8_LDB(dst, b, h) do { _Pragma("unroll") for (int n = 0; n < 2; ++n) _Pragma("unroll") for (int k = 0; k < 2; ++k) dst[n][k] = *(const PG8_LAS bf16x8*)(lds + PG8_SB(b, h) + boff + n * 2048 + k * 1024); } while (0)
#define PG8_MMA(ai, bj, At, Bt) do { __builtin_amdgcn_s_setprio(1); \
        if constexpr (FP8) { _Pragma("unroll") for (int m = 0; m < 4; ++m) _Pragma("unroll") for (int n = 0; n < 2; ++n) \
            asm volatile("v_mfma_f32_16x16x128_f8f6f4 %0, %1, %2, %0" : "+v"(acc[ai][bj][m][n]) : "v"(cat8(Bt[n][0], Bt[n][1])), "v"(cat8(At[m][0], At[m][1]))); } \
        else { _Pragma("unroll") for (int m = 0; m < 4; ++m) _Pragma("unroll") for (int n = 0; n < 2; ++n) _Pragma("unroll") for (int k = 0; k < 2; ++k) \
            acc[ai][bj][m][n] = __builtin_amdgcn_mfma_f32_16x16x32_bf16(Bt[n][k], At[m][k], acc[ai][bj][m][n], 0, 0, 0); } \
        __builtin_amdgcn_s_setprio(0); } while (0)
#define PG8_WAIT_V(n) asm volatile("s_waitcnt vmcnt(" #n ")" ::: "memory")
#define PG8_WAIT_VF do { if (fresh0) asm volatile("s_waitcnt vmcnt(%0)" :: "n"(10 + Epi::NST) : "memory"); else asm volatile("s_waitcnt vmcnt(8)" ::: "memory"); } while (0)
#define PG8_WAIT_L(n) asm volatile("s_waitcnt lgkmcnt(" #n ")" ::: "memory")
#define PG8_BAR __builtin_amdgcn_s_barrier()
#define PG8_SCHED __builtin_amdgcn_sched_barrier(0)
    Unit cur, nxt; int ui = 0;
    if (!S.next(0, cur)) return;
    f32x4 acc[2][2][4][2];
#pragma unroll
    for (int a = 0; a < 2; ++a)
#pragma unroll
        for (int b = 0; b < 2; ++b)
#pragma unroll
            for (int m = 0; m < 4; ++m)
#pragma unroll
                for (int n = 0; n < 2; ++n) acc[a][b][m][n] = (f32x4){0.f, 0.f, 0.f, 0.f};
    bf16x8 At[4][2], B0[2][2], B1[2][2];
    const char* cA = (const char*)g.A + (GATHER ? (size_t)0 : (size_t)cur.pm * tstepA); const char* cB = (const char*)g.Bt + (size_t)cur.pb * tstep;
    if constexpr (GATHER) {
#pragma unroll
        for (int hh = 0; hh < 2; ++hh)
#pragma unroll
            for (int i = 0; i < 2; ++i) { int R, C; stage_rc(tid * 16 + i * 8192, R, C); const int t_ = g.rowidx[cur.pm * BM + hh * HALF + R]; vc[hh][i] = (unsigned)(t_ < 0 ? g.zrow : t_) * (unsigned)(K * 2) + (unsigned)(C * 2); } }
    S.a_ready(cur);
    if constexpr (SP2) {
        PG8_STAGE(PG8_SB(0, 0), cB, voffB); PG8_STAGE(PG8_SB(0, 1), cB + hstep, voffB); PG8_STAGE_AX(PG8_SA(0, 0), cA, 0, false); PG8_STAGE_AX(PG8_SA(0, 1), cA, 1, false);
        if (wr == 1) PG8_BAR;
        PG8_WAIT_V(2); PG8_BAR;
        PG8_STAGE(PG8_SB(1, 0), cB + kstep, voffB); PG8_STAGE_AX(PG8_SA(1, 0), cA + kstep, 0, false); PG8_STAGE(PG8_SB(1, 1), cB + hstep + kstep, voffB);
        PG8_WAIT_V(6); PG8_BAR;
    } else {
        PG8_STAGE(PG8_SB(0, 0), cB, voffB); PG8_STAGE(PG8_SA(0, 0), cA, voffA); PG8_STAGE(PG8_SB(0, 1), cB + hstep, voffB); PG8_STAGE(PG8_SA(0, 1), cA + hstepA, voffA);
        if (wr == 1) PG8_BAR;
        PG8_WAIT_V(4); PG8_BAR;
        PG8_STAGE(PG8_SB(1, 0), cB + kstep, voffB); PG8_STAGE(PG8_SA(1, 0), cA + kstep, voffA); PG8_STAGE(PG8_SB(1, 1), cB + hstep + kstep, voffB);
        PG8_WAIT_V(6); PG8_BAR;
    }
    constexpr bool EARLY = ALIGN_EPI && SP2 && FP8;
    bool fresh = false;
    for (;;) {
        const bool has_next = S.next(ui + 1, nxt);
        const char* nA = (has_next && !GATHER) ? (const char*)g.A + (size_t)nxt.pm * tstepA : cA; const char* nB = has_next ? (const char*)g.Bt + (size_t)nxt.pb * tstep : cB;
        if constexpr (GATHER) { if (has_next && wid < 4) __builtin_amdgcn_global_load_lds((const unsigned*)(g.rowidx + nxt.pm * BM + tid), (PG8_LAS unsigned*)(idxl + ((ui + 1) & 1) * 256 + wid * 64), 4, 0, 0); }
        for (int t = 0; t < nt; t += 2) {
            if constexpr (Epi::HOOK) { if (t == 8 || t == 16) E.hook(acc, cur, t, wr, wc, fr, fq); }
            const bool last = (t == nt - 2);
            const char* a1 = cA + (size_t)(t + 1) * kstep;
            const char* a2 = last ? nA : cA + (size_t)(t + 2) * kstep; const char* b2 = last ? nB : cB + (size_t)(t + 2) * kstep;
            const char* a3 = a2 + kstep; const char* b3 = b2 + kstep;
            if (last && has_next) S.a_ready(nxt);
            if constexpr (SP2) {
            const bool fresh0 = EARLY && fresh && t == 0;
            PG8_LDB(B0, 0, 0); PG8_LDB(B1, 0, 1); PG8_SCHED; PG8_LDA(At, 0, 0); PG8_STAGE_AX(PG8_SA(1, 1), a1, 1, false);
            PG8_WAIT_VF; PG8_WAIT_L(0); PG8_BAR; PG8_MMA(0, 0, At, B0); PG8_MMA(0, 1, At, B1); PG8_BAR; PG8_SCHED;
            if constexpr (GATHER) { if (last && has_next) {
#pragma unroll
                for (int hh = 0; hh < 2; ++hh)
#pragma unroll
                    for (int i = 0; i < 2; ++i) { int R, C; stage_rc(tid * 16 + i * 8192, R, C); const int t_ = idxl[((ui + 1) & 1) * 256 + hh * HALF + R]; vc[hh][i] = (unsigned)(t_ < 0 ? g.zrow : t_) * (unsigned)(K * 2) + (unsigned)(C * 2); } } }
            PG8_LDA(At, 0, 1); PG8_STAGE(PG8_SB(0, 0), b2, voffB); PG8_STAGE(PG8_SB(0, 1), b2 + hstep, voffB); PG8_STAGE_AX(PG8_SA(0, 0), a2, 0, last);
            PG8_WAIT_VF; PG8_WAIT_L(0); PG8_BAR; PG8_MMA(1, 0, At, B0); PG8_MMA(1, 1, At, B1); PG8_BAR; PG8_SCHED;
            PG8_LDB(B0, 1, 0); PG8_LDB(B1, 1, 1); PG8_SCHED; PG8_LDA(At, 1, 0); PG8_STAGE_AX(PG8_SA(0, 1), a2, 1, last);
            PG8_WAIT_VF; PG8_WAIT_L(0); PG8_BAR; PG8_MMA(0, 0, At, B0); PG8_MMA(0, 1, At, B1); PG8_BAR; PG8_SCHED;
            PG8_LDA(At, 1, 1); PG8_STAGE(PG8_SB(1, 0), b3, voffB); PG8_STAGE(PG8_SB(1, 1), b3 + hstep, voffB); PG8_STAGE_AX(PG8_SA(1, 0), a3, 0, last);
            PG8_WAIT_V(8); PG8_WAIT_L(0); PG8_BAR; PG8_MMA(1, 0, At, B0); PG8_MMA(1, 1, At, B1); PG8_BAR; PG8_SCHED;
            } else {
            PG8_LDB(B0, 0, 0); PG8_SCHED; PG8_LDA(At, 0, 0); PG8_STAGE(PG8_SA(1, 1), a1 + hstepA, voffA);
            PG8_WAIT_L(8); PG8_BAR; PG8_WAIT_L(0); PG8_MMA(0, 0, At, B0); PG8_BAR; PG8_SCHED;
            PG8_LDB(B1, 0, 1); PG8_STAGE(PG8_SB(0, 0), b2, voffB);
            PG8_BAR; PG8_WAIT_L(0); PG8_MMA(0, 1, At, B1); PG8_BAR;
            PG8_LDA(At, 0, 1); PG8_STAGE(PG8_SA(0, 0), a2, voffA);
            PG8_BAR; PG8_WAIT_L(0); PG8_MMA(1, 0, At, B0); PG8_BAR; PG8_SCHED;
            PG8_STAGE(PG8_SB(0, 1), b2 + hstep, voffB);
            PG8_WAIT_V(6); PG8_BAR; PG8_MMA(1, 1, At, B1); PG8_BAR;
            PG8_LDB(B0, 1, 0); PG8_SCHED; PG8_LDA(At, 1, 0); PG8_STAGE(PG8_SA(0, 1), a2 + hstepA, voffA);
            PG8_WAIT_L(8); PG8_BAR; PG8_WAIT_L(0); PG8_MMA(0, 0, At, B0); PG8_BAR; PG8_SCHED;
            PG8_LDB(B1, 1, 1); PG8_STAGE(PG8_SB(1, 0), b3, voffB);
            PG8_BAR; PG8_WAIT_L(0); PG8_MMA(0, 1, At, B1); PG8_BAR;
            PG8_LDA(At, 1, 1); PG8_STAGE(PG8_SA(1, 0), a3, voffA);
            PG8_BAR; PG8_WAIT_L(0); PG8_MMA(1, 0, At, B0); PG8_BAR; PG8_SCHED;
            PG8_STAGE(PG8_SB(1, 1), b3 + hstep, voffB);
            PG8_WAIT_V(6); PG8_BAR; PG8_MMA(1, 1, At, B1); PG8_BAR;
            }
        }
        if constexpr (ALIGN_EPI) { if (wr == 0) PG8_BAR; }
        if constexpr (EARLY) { PG8_STAGE_AX(PG8_SA(1, 1), nA + kstep, 1, true); fresh = true; }
        if constexpr (FP8) {
            asm volatile("s_nop 15\n\ts_nop 15" : "+v"(acc[0][0][0][0]), "+v"(acc[0][0][0][1]), "+v"(acc[0][0][1][0]), "+v"(acc[0][0][1][1]), "+v"(acc[0][0][2][0]), "+v"(acc[0][0][2][1]), "+v"(acc[0][0][3][0]), "+v"(acc[0][0][3][1]));
            asm volatile("" : "+v"(acc[0][1][0][0]), "+v"(acc[0][1][0][1]), "+v"(acc[0][1][1][0]), "+v"(acc[0][1][1][1]), "+v"(acc[0][1][2][0]), "+v"(acc[0][1][2][1]), "+v"(acc[0][1][3][0]), "+v"(acc[0][1][3][1]));
            asm volatile("" : "+v"(acc[1][0][0][0]), "+v"(acc[1][0][0][1]), "+v"(acc[1][0][1][0]), "+v"(acc[1][0][1][1]), "+v"(acc[1][0][2][0]), "+v"(acc[1][0][2][1]), "+v"(acc[1][0][3][0]), "+v"(acc[1][0][3][1]));
            asm volatile("" : "+v"(acc[1][1][0][0]), "+v"(acc[1][1][0][1]), "+v"(acc[1][1][1][0]), "+v"(acc[1][1][1][1]), "+v"(acc[1][1][2][0]), "+v"(acc[1][1][2][1]), "+v"(acc[1][1][3][0]), "+v"(acc[1][1][3][1])); }
        if constexpr (!Epi::AFTER_DRAIN) { E(acc, cur, wr, wc, fr, fq); S.done(cur); }
        if (!has_next) break;
#pragma unroll
        for (int a = 0; a < 2; ++a)
#pragma unroll
            for (int b = 0; b < 2; ++b)
#pragma unroll
                for (int m = 0; m < 4; ++m)
#pragma unroll
                    for (int n = 0; n < 2; ++n) acc[a][b][m][n] = (f32x4){0.f, 0.f, 0.f, 0.f};
        cur = nxt; cA = nA; cB = nB; ++ui;
        if constexpr (ALIGN_EPI) { if (wr == 1) PG8_BAR; }
    }
    PG8_WAIT_V(0);
    if constexpr (!ALIGN_EPI) { if (wr == 0) PG8_BAR; }
    PG8_BAR;
    if constexpr (Epi::AFTER_DRAIN) { E.fused(acc, cur, wr, wc, fr, fq, lds, wid, lane); S.done(cur); }
#undef PG8_SA
#undef PG8_SB
#undef PG8_STAGE
#undef PG8_STAGE_AX
#undef PG8_LDA
#undef PG8_LDB
#undef PG8_MMA
#undef PG8_WAIT_V
#undef PG8_WAIT_VF
#undef PG8_WAIT_L
#undef PG8_BAR
#undef PG8_SCHED
}
}
#include <hip/hip_bf16.h>
#include <cmath>
namespace attn_body {
using bf16=__hip_bfloat16;
using bf16x8=__attribute__((ext_vector_type(8)))short;
using s16x4=__attribute__((ext_vector_type(4)))short;
using f32x16=__attribute__((ext_vector_type(16)))float;
using u32x4=__attribute__((ext_vector_type(4)))unsigned;
constexpr int BATCH=4,NHEAD=8,SEQ=8192,D=64,DM=NHEAD*D,DMO=1536,OCOL=1024;
constexpr int NW=8,QBLK=32,QB=QBLK*NW,KVBLK=64,NQB=SEQ/QB;
constexpr int ATTN_PITCH=DM, ATTN_UNIT_ROWS=QB;
__device__ __forceinline__ int crow(int r,int hi){return (r&3)+8*(r>>2)+4*hi;}
#define SBAR() __builtin_amdgcn_sched_barrier(0)
__device__ __forceinline__ void cmask(f32x16&p0,f32x16&p1,int jb,int qrel,int hi){
  const float NEG=-INFINITY; int kb=64*jb+4*hi;
  #pragma unroll
  for(int r=0;r<16;++r){int kv=kb+(r&3)+8*(r>>2); if(kv>qrel)p0[r]=NEG; if(kv+32>qrel)p1[r]=NEG;}
}

constexpr int NSLOT=3, SLOTB=8192;
constexpr int LDS_K=0, LDS_V=NSLOT*SLOTB, LDS_WS=2*NSLOT*SLOTB, LDS_OST=LDS_WS+NW*64*4, LDS_NB=LDS_OST+NW*4096, LDS_BYTES=LDS_NB+SEQ*4;
constexpr float C2=0.125f*1.4426950408889634f;
__device__ __forceinline__ void glds16(const void*gsrc,unsigned lds_dst){unsigned keep;
  asm volatile("s_mov_b32 %0, m0\n\ts_mov_b32 m0, %2\n\ts_nop 0\n\tglobal_load_lds_dwordx4 %1, off\n\ts_mov_b32 m0, %0":"=&s"(keep):"v"(gsrc),"s"(lds_dst):"memory");}
__device__ __forceinline__ float max3f(float a,float b,float c){float r;asm("v_max3_f32 %0, %1, %2, %3":"=v"(r):"v"(a),"v"(b),"v"(c));return r;}
__device__ __forceinline__ float max2f(float a,float b){float r;asm("v_max_f32_e32 %0, %1, %2":"=v"(r):"v"(a),"v"(b));return r;}
__device__ __forceinline__ float fadd_s(float a,float b){float r;asm("v_add_f32_e32 %0, %1, %2":"=v"(r):"v"(a),"v"(b));return r;}
__device__ __forceinline__ float fsub_s(float a,float b){float r;asm("v_sub_f32_e32 %0, %1, %2":"=v"(r):"v"(a),"v"(b));return r;}
typedef float f32x2_t __attribute__((ext_vector_type(2))); typedef __bf16 bf16x2_t __attribute__((ext_vector_type(2)));
__device__ __forceinline__ unsigned cvtpk_s(float lo,float hi){f32x2_t v={lo,hi};bf16x2_t b=__builtin_convertvector(v,bf16x2_t);return __builtin_bit_cast(unsigned,b);}
#define WAIT_BAR(N) asm volatile("s_waitcnt vmcnt(" #N ") lgkmcnt(0)\n\ts_barrier":::"memory")

__device__ __forceinline__ void qkt(f32x16&p0,f32x16&p1,const char*Kslot,const bf16x8*qr,int r32,int hi){
  const char*kb=Kslot+hi*1024+r32*16;
  #pragma unroll
  for(int d0=0;d0<4;++d0){
    const bf16x8 b0=*reinterpret_cast<const bf16x8*>(kb+d0*2048);
    const bf16x8 b1=*reinterpret_cast<const bf16x8*>(kb+d0*2048+512);
    p0=__builtin_amdgcn_mfma_f32_32x32x16_bf16(b0,qr[d0],p0,0,0,0);p1=__builtin_amdgcn_mfma_f32_32x32x16_bf16(b1,qr[d0],p1,0,0,0);}
}
typedef __attribute__((address_space(3))) const char* lds_cptr;
typedef short v4i16_t __attribute__((ext_vector_type(4)));
__device__ __forceinline__ void kload8(bf16x8*kf,lds_cptr kp){
  kf[0]=*(const __attribute__((address_space(3))) bf16x8*)(kp);      kf[1]=*(const __attribute__((address_space(3))) bf16x8*)(kp+512);
  kf[2]=*(const __attribute__((address_space(3))) bf16x8*)(kp+2048); kf[3]=*(const __attribute__((address_space(3))) bf16x8*)(kp+2560);
  kf[4]=*(const __attribute__((address_space(3))) bf16x8*)(kp+4096); kf[5]=*(const __attribute__((address_space(3))) bf16x8*)(kp+4608);
  kf[6]=*(const __attribute__((address_space(3))) bf16x8*)(kp+6144); kf[7]=*(const __attribute__((address_space(3))) bf16x8*)(kp+6656);
}
__device__ __forceinline__ void kload2(bf16x8*kf,lds_cptr kp,int j){ kf[2*j]=*(const __attribute__((address_space(3))) bf16x8*)(kp+j*2048); kf[2*j+1]=*(const __attribute__((address_space(3))) bf16x8*)(kp+j*2048+512); }
__device__ __forceinline__ s16x4 vtr(lds_cptr p){ return __builtin_bit_cast(s16x4,__builtin_amdgcn_ds_read_tr16_b64_v4i16((__attribute__((address_space(3))) v4i16_t*)p)); }
__device__ __forceinline__ float rowmax(const f32x16&p0,const f32x16&p1){
  float a=max3f(p0[0],p0[1],p1[0]),b=max3f(p0[2],p0[3],p1[1]);a=max3f(a,p1[2],p1[3]);
  #pragma unroll
  for(int r=4;r<16;r+=4){a=max3f(a,p0[r],p0[r+1]);b=max3f(b,p0[r+2],p0[r+3]);a=max3f(a,p1[r],p1[r+1]);b=max3f(b,p1[r+2],p1[r+3]);}
  const float m=max2f(a,b);
  auto rr=__builtin_amdgcn_permlane32_swap(__float_as_uint(m),__float_as_uint(m),false,false);
  return max2f(__uint_as_float(rr[0]),__uint_as_float(rr[1]));
}
__device__ __forceinline__ void pv(f32x16*o,int vb,bf16x8 pa0,bf16x8 pa1,bf16x8 pa2,bf16x8 pa3){
  #pragma unroll
  for(int d0=0;d0<2;++d0){s16x4 lo[4],hi[4];
    #pragma unroll
    for(int ks=0;ks<4;++ks){
      asm volatile("ds_read_b64_tr_b16 %0,%1 offset:%c2":"=&v"(lo[ks]):"v"(vb),"i"(d0*4096+ks*1024):"memory");
      asm volatile("ds_read_b64_tr_b16 %0,%1 offset:%c2":"=&v"(hi[ks]):"v"(vb),"i"(d0*4096+ks*1024+512):"memory");}
    asm volatile("s_waitcnt lgkmcnt(0)":::"memory");SBAR();
    #define PK(k) (bf16x8){lo[k][0],lo[k][1],lo[k][2],lo[k][3],hi[k][0],hi[k][1],hi[k][2],hi[k][3]}
    o[d0]=__builtin_amdgcn_mfma_f32_32x32x16_bf16(pa0,PK(0),o[d0],0,0,0);
    o[d0]=__builtin_amdgcn_mfma_f32_32x32x16_bf16(pa1,PK(1),o[d0],0,0,0);
    o[d0]=__builtin_amdgcn_mfma_f32_32x32x16_bf16(pa2,PK(2),o[d0],0,0,0);
    o[d0]=__builtin_amdgcn_mfma_f32_32x32x16_bf16(pa3,PK(3),o[d0],0,0,0);
    #undef PK
  }
}

#ifndef ATTN_STORE16
#define ATTN_STORE16(p,v) (*(u32x4*)(p)=(v))
#endif
typedef float f32x4v __attribute__((ext_vector_type(4)));
__device__ __forceinline__ float segoff8(const float*__restrict__ st,int j){const int s=j>>10; float o=0.f; _Pragma("unroll") for(int i=0;i<7;++i)o+=(i<s)?st[i]:0.f; return o;}
__device__ __forceinline__ int attn_t0(int qb,const float*__restrict__ nbg,const float*__restrict__ segt,const float*__restrict__ qnw,const float*__restrict__ knw,const float*__restrict__ xmw,int lane){
  const int q0=qb*QB; float qn=0.f,kn=0.f,xm=3.0e38f; if(lane<8){qn=qnw[qb*8+lane];xm=xmw[qb*8+lane];}
  _Pragma("unroll") for(int i=0;i<4;++i){const int idx=lane*4+i; if(idx<(qb+1)*8)kn=__builtin_fmaxf(kn,knw[idx]);}
  _Pragma("unroll") for(int o_=1;o_<64;o_<<=1){qn=__builtin_fmaxf(qn,__shfl_xor(qn,o_));kn=__builtin_fmaxf(kn,__shfl_xor(kn,o_));xm=__builtin_fminf(xm,__shfl_xor(xm,o_));}
  const float thr=56.f+sqrtf(qn*kn)-xm; const int NT0=(q0+QB)/KVBLK;
  bool c_=(lane>=1)&&(2*lane<=NT0-4); float d_=0.f; if(c_)d_=(nbg[128*lane-1]+segoff8(segt,128*lane-1))-(nbg[q0]+segoff8(segt,q0)); c_=c_&&(d_<=-thr);
  return __builtin_amdgcn_readfirstlane(2*(int)__popcll(__ballot(c_)));
}
template<int THRL> __device__ __forceinline__ void attn_unit(int b,int h,int qb,const bf16*Q,const bf16*__restrict__ K,const bf16*__restrict__ V,bf16*O,const float*__restrict__ nbg,const float*__restrict__ segt,const int t0,char*shm){
  int tid_=threadIdx.x; asm volatile("":"+v"(tid_));
  const int tid=tid_,lane=tid&63,r32=lane&31,hi=lane>>5; const int wid=__builtin_amdgcn_readfirstlane(tid>>6);
  const long rowbase=(long)b*SEQ; const int q0=qb*QB;
  const bf16*Qw=Q+(rowbase+q0+wid*QBLK)*DM+h*D;
  const bf16*Kh=K+(rowbase+(long)t0*KVBLK)*DM+h*D,*Vh=V+(rowbase+(long)t0*KVBLK)*DM+h*D;
  const unsigned lds0=(unsigned)(uintptr_t)shm;
  float*wsf=(float*)(shm+LDS_WS)+wid*64;
  const bf16*ksrc=Kh+(long)lane*DM+wid*8;
  const bf16*vsrc=Vh+(long)(16*(wid&3)+(lane>>2))*DM+(wid>>2)*32+(lane&3)*8;
  const unsigned kdst=lds0+LDS_K+wid*1024, vdst=lds0+LDS_V+wid*1024;
  #define DMA_K(t,slot) glds16(ksrc+(long)(t)*KVBLK*DM,(unsigned)__builtin_amdgcn_readfirstlane(kdst+(slot)))
  #define DMA_V(t,slot) glds16(vsrc+(long)(t)*KVBLK*DM,(unsigned)__builtin_amdgcn_readfirstlane(vdst+(slot)))
  const int vb0=(int)(lds0+LDS_V)+((lane>>4)&1)*32+(lane&3)*8+(4*hi+((lane&15)>>2))*64;
  const char*Kbase=shm+LDS_K; bf16x8 kf[8];
  const lds_cptr shm3=(lds_cptr)shm; const lds_cptr kp0=shm3+LDS_K+hi*1024+r32*16; const lds_cptr vp0=shm3+LDS_V+((lane>>4)&1)*32+(lane&3)*8+(4*hi+((lane&15)>>2))*64;
  const int NT=(q0+QB)/KVBLK-t0;
  typedef __attribute__((address_space(3))) float* lds_fptr;
  const lds_fptr nbl3=(lds_fptr)(shm3+LDS_NB);
  const lds_fptr nbl3o=nbl3+t0*KVBLK;
  DMA_K(0,0);DMA_V(0,0);DMA_K(1,SLOTB);
  { const float ref=nbg[q0+QB-1]+segoff8(segt,q0+QB-1); for(int j=t0*KVBLK+tid;j<q0+QB;j+=NW*64) nbl3[j]=nbg[j]+segoff8(segt,j)-ref; }
  bf16x8 qr[4];
  #pragma unroll
  for(int d0=0;d0<4;++d0)qr[d0]=*reinterpret_cast<const bf16x8*>(&Qw[(long)r32*DM+d0*16+hi*8]);
  float mhat=0.f,l_reg=0.f;f32x16 o[2];o[0]=f32x16{};o[1]=f32x16{};
  const int qrel=wid*QBLK+r32;
  #define CMASK(P0,P1,t) do{int jb_=(t)-(NT-4); if(jb_>=0)cmask(P0,P1,jb_,qrel,hi);}while(0)
  bool resc=false;
  #define START(P0,P1) do{ const float rm=rowmax(P0,P1); resc=false; \
    if(__any(rm>(float)THRL)){ const float dl=__builtin_fmaxf(rm,0.f); mhat=fadd_s(mhat,dl); \
      _Pragma("unroll") for(int r=0;r<16;++r){P0[r]=fsub_s(P0[r],dl);P1[r]=fsub_s(P1[r],dl);} } \
    _Pragma("unroll") for(int r=0;r<16;++r)P0[r]=__builtin_amdgcn_exp2f(P0[r]); }while(0)
  #define BIAS(P0,P1,t) do{ const lds_fptr nbp_=nbl3o+64*(t)+4*hi; \
    _Pragma("unroll") for(int q_=0;q_<4;++q_){ const f32x4v b0_=*(const __attribute__((address_space(3))) f32x4v*)(nbp_+8*q_), b1_=*(const __attribute__((address_space(3))) f32x4v*)(nbp_+32+8*q_); \
      _Pragma("unroll") for(int i_=0;i_<4;++i_){ P0[4*q_+i_]=b0_[i_]-mhat; P1[4*q_+i_]=b1_[i_]-mhat; } } }while(0)
  #define RESC() do{ if(resc){ asm volatile("s_waitcnt lgkmcnt(0)":::"memory"); \
      _Pragma("unroll") for(int d_=0;d_<2;++d_) _Pragma("unroll") for(int r=0;r<16;++r)o[d_][r]*=wsf[crow(r,hi)]; } }while(0)
  f32x16 pA0,pA1,pB0,pB1;
  int sl_prev=0,sl_cur=0,sl_next=SLOTB;
  #define ROT() do{sl_prev=sl_cur;sl_cur=sl_next;sl_next=(sl_next==(NSLOT-1)*SLOTB)?0:sl_next+SLOTB;}while(0)
  DMA_K(2,2*SLOTB);
  WAIT_BAR(3);
  mhat=nbl3[q0+qrel];
  BIAS(pA0,pA1,0);qkt(pA0,pA1,Kbase,qr,r32,hi);asm volatile("s_nop 15\n\ts_nop 7":"+v"(pA0),"+v"(pA1));CMASK(pA0,pA1,0);
  START(pA0,pA1);
  _Pragma("unroll") for(int r=0;r<16;++r)pA1[r]=__builtin_amdgcn_exp2f(pA1[r]);
  WAIT_BAR(0);
  DMA_K(3,0);DMA_V(1,SLOTB);
  ROT();
  kload8(kf,kp0+sl_cur);
  WAIT_BAR(2);
  s16x4 vlo[8],vhi[8]; u32x4 pw0,pw1,pw2,pw3;
  #define PKW(P,B) cvtpk_s(P[B],P[B+1])
  #define PAF(k) __builtin_bit_cast(bf16x8,pw##k)
  #define VFR(i) (bf16x8){vlo[i][0],vlo[i][1],vlo[i][2],vlo[i][3],vhi[i][0],vhi[i][1],vhi[i][2],vhi[i][3]}
  #define PIN(x) asm volatile("":"+v"(x))
  #define MX3(a,b,c) __builtin_fmaxf(__builtin_fmaxf((a),(b)),(c))
  #define GAPA(MF,A0,A1,A2,A3,W0,W1,PW) do{ MF; sacc+=A0; sacc+=A1; sacc+=A2; sacc+=A3; PIN(sacc); W0; W1; PIN(PW); SBAR(); }while(0)
  #define EX(v) __builtin_amdgcn_exp2f(v)
  #define GAPB(MF,X,B) do{ MF; X[B]=EX(X[B]); X[B+1]=EX(X[B+1]); X[B+2]=EX(X[B+2]); X[B+3]=EX(X[B+3]); PIN(X); SBAR(); }while(0)
  #define VRD(i) do{ vlo[i]=vtr(vp_+(((i)>>2)*4096+((i)&3)*1024)); vhi[i]=vtr(vp_+(((i)>>2)*4096+((i)&3)*1024+512)); }while(0)
  #define KRD(G,j) do{ if(G){ kload2(kf,kp0+sl_next,j); SBAR(); } }while(0)
  #define STEP(C0,C1,P0,P1,t,GK,GV,GL) do{ SBAR(); \
    const lds_cptr vp_=vp0+sl_prev; \
    BIAS(C0,C1,t); SBAR(); \
    VRD(0); SBAR(); float sacc=(P0[0]+P0[1]); \
    GAPA(C0=__builtin_amdgcn_mfma_f32_32x32x16_bf16(kf[0],qr[0],C0,0,0,0), P0[2],P0[3],P0[4],P0[5],     pw0[0]=PKW(P0,0), pw0[1]=PKW(P0,2), pw0); \
    VRD(4); SBAR(); GAPA(C1=__builtin_amdgcn_mfma_f32_32x32x16_bf16(kf[1],qr[0],C1,0,0,0), P0[6],P0[7],P0[8],P0[9],     pw0[2]=PKW(P0,4), pw0[3]=PKW(P0,6), pw0); \
    VRD(1); SBAR(); GAPA(C0=__builtin_amdgcn_mfma_f32_32x32x16_bf16(kf[2],qr[1],C0,0,0,0),   P0[10],P0[11],P0[12],P0[13], pw1[0]=PKW(P0,8), pw1[1]=PKW(P0,10), pw1); \
    VRD(5); SBAR(); GAPA(C1=__builtin_amdgcn_mfma_f32_32x32x16_bf16(kf[3],qr[1],C1,0,0,0),   P0[14],P0[15],P1[0],P1[1],   pw1[2]=PKW(P0,12),pw1[3]=PKW(P0,14), pw1); \
    VRD(2); SBAR(); GAPA(C0=__builtin_amdgcn_mfma_f32_32x32x16_bf16(kf[4],qr[2],C0,0,0,0),   P1[2],P1[3],P1[4],P1[5],     pw2[0]=PKW(P1,0), pw2[1]=PKW(P1,2), pw2); \
    VRD(6); SBAR(); GAPA(C1=__builtin_amdgcn_mfma_f32_32x32x16_bf16(kf[5],qr[2],C1,0,0,0),   P1[6],P1[7],P1[8],P1[9],     pw2[2]=PKW(P1,4), pw2[3]=PKW(P1,6), pw2); \
    VRD(3); SBAR(); GAPA(C0=__builtin_amdgcn_mfma_f32_32x32x16_bf16(kf[6],qr[3],C0,0,0,0),   P1[10],P1[11],P1[12],P1[13], pw3[0]=PKW(P1,8), pw3[1]=PKW(P1,10), pw3); \
    VRD(7); SBAR(); GAPA(C1=__builtin_amdgcn_mfma_f32_32x32x16_bf16(kf[7],qr[3],C1,0,0,0),   P1[14],P1[15],0.f,0.f,       pw3[2]=PKW(P1,12),pw3[3]=PKW(P1,14), pw3); \
    l_reg+=sacc; \
    if(GK){DMA_K((t)+3,sl_cur);} if(GV){DMA_V((t)+1,sl_next);} \
    CMASK(C0,C1,t); \
    { float a=MX3(C0[0],C0[1],C1[0]),b=MX3(C0[2],C0[3],C1[1]); a=MX3(a,C1[2],C1[3]); \
      _Pragma("unroll") for(int r=4;r<16;r+=4){a=MX3(a,C0[r],C0[r+1]);b=MX3(b,C0[r+2],C0[r+3]);a=MX3(a,C1[r],C1[r+1]);b=MX3(b,C1[r+2],C1[r+3]);} \
      float rm=__builtin_fmaxf(a,b); { auto rr=__builtin_amdgcn_permlane32_swap(__float_as_uint(rm),__float_as_uint(rm),false,false); rm=__builtin_fmaxf(__uint_as_float(rr[0]),__uint_as_float(rr[1])); } \
      resc=false; \
      if(__builtin_expect(__any(rm>(float)THRL),0)){ const float dl=__builtin_fmaxf(rm,0.f); mhat+=dl; \
        _Pragma("unroll") for(int r=0;r<16;++r){C0[r]-=dl;C1[r]-=dl;} \
        const float f=__builtin_amdgcn_exp2f(-dl); l_reg*=f; if(hi==0)wsf[r32]=f; resc=true; } } \
    SBAR(); \
    GAPB(o[0]=__builtin_amdgcn_mfma_f32_32x32x16_bf16(PAF(0),VFR(0),o[0],0,0,0), C0,0); \
    GAPB(o[1]=__builtin_amdgcn_mfma_f32_32x32x16_bf16(PAF(0),VFR(4),o[1],0,0,0), C0,4); \
    KRD(GL,0); GAPB(o[0]=__builtin_amdgcn_mfma_f32_32x32x16_bf16(PAF(1),VFR(1),o[0],0,0,0), C0,8); \
    KRD(GL,1); GAPB(o[1]=__builtin_amdgcn_mfma_f32_32x32x16_bf16(PAF(1),VFR(5),o[1],0,0,0), C0,12); \
    KRD(GL,2); GAPB(o[0]=__builtin_amdgcn_mfma_f32_32x32x16_bf16(PAF(2),VFR(2),o[0],0,0,0), C1,0); \
    KRD(GL,3); GAPB(o[1]=__builtin_amdgcn_mfma_f32_32x32x16_bf16(PAF(2),VFR(6),o[1],0,0,0), C1,4); \
    GAPB(o[0]=__builtin_amdgcn_mfma_f32_32x32x16_bf16(PAF(3),VFR(3),o[0],0,0,0), C1,8); \
    GAPB(o[1]=__builtin_amdgcn_mfma_f32_32x32x16_bf16(PAF(3),VFR(7),o[1],0,0,0), C1,12); \
    }while(0)
  int t=1;
  #undef CMASK
  #define CMASK(P0,P1,t) do{}while(0)
  for(;t+5<NT;t+=2){
    STEP(pB0,pB1,pA0,pA1,t,true,true,true);     WAIT_BAR(2); RESC(); ROT();
    STEP(pA0,pA1,pB0,pB1,t+1,true,true,true);   WAIT_BAR(2); RESC(); ROT();
  }
  #undef CMASK
  #define CMASK(P0,P1,t) do{int jb_=(t)-(NT-4); if(jb_>=0)cmask(P0,P1,jb_,qrel,hi);}while(0)
  #define ENDW(tt) do{ if((tt)+3<NT){WAIT_BAR(2);} else if((tt)+2<NT){WAIT_BAR(1);} else {WAIT_BAR(0);} }while(0)
  for(;t+1<NT;t+=2){
    STEP(pB0,pB1,pA0,pA1,t,(t+3<NT),(t+1<NT),(t+1<NT));       ENDW(t);   RESC(); ROT();
    STEP(pA0,pA1,pB0,pB1,t+1,(t+4<NT),(t+2<NT),(t+2<NT));     ENDW(t+1); RESC(); ROT();
  }
  STEP(pB0,pB1,pA0,pA1,NT-1,false,false,false); RESC();
  { float sacc=pB0[0]+pB0[1]; _Pragma("unroll") for(int r=2;r<16;++r)sacc+=pB0[r]; _Pragma("unroll") for(int r=0;r<16;++r)sacc+=pB1[r]; l_reg+=sacc;
    pw0=(u32x4){PKW(pB0,0),PKW(pB0,2),PKW(pB0,4),PKW(pB0,6)};pw1=(u32x4){PKW(pB0,8),PKW(pB0,10),PKW(pB0,12),PKW(pB0,14)};pw2=(u32x4){PKW(pB1,0),PKW(pB1,2),PKW(pB1,4),PKW(pB1,6)};pw3=(u32x4){PKW(pB1,8),PKW(pB1,10),PKW(pB1,12),PKW(pB1,14)};
    SBAR(); pv(o,vb0+sl_cur,PAF(0),PAF(1),PAF(2),PAF(3)); }
  #undef PKW
  #undef PAF
  #undef VFR
  #undef PIN
  #undef MX3
  #undef GAPA
  #undef GAPB
  #undef EX
  #undef VRD
  #undef KRD
  #undef STEP
  #undef ENDW
  {auto rr=__builtin_amdgcn_permlane32_swap(__float_as_uint(l_reg),__float_as_uint(l_reg),false,false);l_reg=__uint_as_float(rr[0])+__uint_as_float(rr[1]);}
  if(hi==0)wsf[32+r32]=l_reg;asm volatile("s_waitcnt lgkmcnt(0)":::"memory");
  float rli[16];
  #pragma unroll
  for(int r=0;r<16;++r)rli[r]=__builtin_amdgcn_rcpf(wsf[32+crow(r,hi)]);
  bf16*Ow=O+(rowbase+q0+wid*QBLK)*DMO+OCOL+h*D;
  { bf16*stg=(bf16*)(shm+LDS_OST)+wid*2048;
    #pragma unroll
    for(int r=0;r<16;++r){const int orow=crow(r,hi);
      #pragma unroll
      for(int d0=0;d0<2;++d0)stg[orow*64+d0*32+r32]=__float2bfloat16(o[d0][r]*rli[r]);}
    asm volatile("s_waitcnt lgkmcnt(0)":::"memory");
    #pragma unroll
    for(int i=0;i<4;++i){const int row=i*8+(lane>>3),ch=lane&7; const u32x4 v=*(const u32x4*)(stg+row*64+ch*8); ATTN_STORE16(Ow+(long)row*DMO+ch*8,v);} }
  asm volatile("s_waitcnt lgkmcnt(0)\n\ts_barrier":::"memory");
  #undef DMA_K
  #undef DMA_V
  #undef CMASK
  #undef START
  #undef BIAS
  #undef RESC
  #undef ROT
}
constexpr int ATTN_LDS_BYTES=LDS_BYTES;
struct AttnTensors { const bf16* Q; const bf16* K; const bf16* V; bf16* O; const float* nb; const float* qn; const float* kn; const int* t0tab; const float* seg; };
struct AttnUnit { int bh; int qb; };
struct StaticOrder {
  int vcu,G;
  __device__ __forceinline__ explicit StaticOrder(int grid,int block):vcu((grid%8==0)?(block%8)*(grid/8)+block/8:block),G(grid){}
  __device__ __forceinline__ bool next(int i,AttnUnit&u)const{ const int w=vcu+(i>>2)*G; if(w>=BATCH*NHEAD*8)return false; const int s=w&7,j=i&3; u.bh=((w>>3)+9*j)&31; u.qb=(j==0)?s:(j==1)?15-s:(j==2)?16+s:31-s; return true; }
  __device__ __forceinline__ void a_ready(const AttnUnit&)const{}
  __device__ __forceinline__ void done(const AttnUnit&)const{}
};
template<int THRL=8> __device__ __forceinline__ void attn_phase_dyn(char*lds,const AttnTensors&T,unsigned*ctr,volatile __attribute__((address_space(3))) unsigned*slot){
  const int tid=threadIdx.x,lane=tid&63;
  int ord=0;
  { float myv=3.0e38f; if(lane<32){myv=0.f; _Pragma("unroll") for(int i=0;i<8;++i)myv+=T.seg[lane*8+i];} int rank=0;
    _Pragma("unroll") for(int j=0;j<32;++j){const float vj=__shfl(myv,j); rank+=(vj<myv||(vj==myv&&j<lane))?1:0;}
    _Pragma("unroll") for(int j=0;j<32;++j){const int rj=__shfl(rank,j); if(rj==lane)ord=j;} }
  if(tid==0){ const unsigned id=__hip_atomic_fetch_add(ctr,1u,__ATOMIC_RELAXED,__HIP_MEMORY_SCOPE_AGENT); *slot=id; }
  asm volatile("s_waitcnt vmcnt(0) lgkmcnt(0)\n\ts_barrier":::"memory");
  for(;;){
    const unsigned uid=*slot;
    if(uid>=(unsigned)(BATCH*NHEAD*NQB))break;
    unsigned nxt=0u; if(tid==0)nxt=__hip_atomic_fetch_add(ctr,1u,__ATOMIC_RELAXED,__HIP_MEMORY_SCOPE_AGENT);
    const int bh=__builtin_amdgcn_readfirstlane(__shfl(ord,(int)(uid>>5))), qb=NQB-1-(int)(uid&31u);
    const int t0=__builtin_amdgcn_readfirstlane(T.t0tab[bh*NQB+qb]);
    attn_unit<THRL>(bh/NHEAD,bh%NHEAD,qb,T.Q,T.K,T.V,T.O,T.nb+(long)bh*SEQ,T.seg+bh*8,t0,lds);
    if(tid==0)*slot=nxt;
    asm volatile("s_waitcnt vmcnt(0) lgkmcnt(0)\n\ts_barrier":::"memory");
  }
}
#undef SBAR
#undef WAIT_BAR
}
#define GAS __attribute__((address_space(1)))
#define LAS __attribute__((address_space(3)))
typedef unsigned short bf16;
typedef unsigned v4u __attribute__((ext_vector_type(4)));
typedef float f32x4 __attribute__((ext_vector_type(4)));
typedef short bf16x8 __attribute__((ext_vector_type(8)));
typedef GAS unsigned gu32;
typedef GAS unsigned long long gu64;
#define RLX_AGENT __ATOMIC_RELAXED, __HIP_MEMORY_SCOPE_AGENT
#define LDS_WAIT() asm volatile("s_waitcnt lgkmcnt(0)" ::: "memory")
#define VM_WAIT() asm volatile("s_waitcnt vmcnt(0)" ::: "memory")
__device__ __forceinline__ unsigned long long rt() { return __builtin_amdgcn_s_memrealtime(); }
typedef float f32x2_pk __attribute__((ext_vector_type(2))); typedef __bf16 bf16x2_pk __attribute__((ext_vector_type(2)));
__device__ __forceinline__ unsigned pk2(float lo, float hi) { f32x2_pk v = {lo, hi}; bf16x2_pk r = __builtin_convertvector(v, bf16x2_pk); return __builtin_bit_cast(unsigned, r); }
__device__ __forceinline__ unsigned f2bf(float f) { return pk2(f, 0.f) & 0xffffu; }

#define XB_TMO      128
#define XB_XCNT(j)  (256  + 64 * (j))
#define XB_XSUB(j)  (1280 + 64 * (j))
#define XB_XGEN(j)  (2304 + 64 * (j))
#define XB_TOP      3328
#define XB_TOPGEN   3392
#define XCD_BAR_WORDS 3456
#define XB_SPIN_CAP (1u << 18)

__device__ __forceinline__ unsigned xb_ld(unsigned* p)              { return __hip_atomic_load(p, __ATOMIC_RELAXED, __HIP_MEMORY_SCOPE_AGENT); }
__device__ __forceinline__ unsigned xb_add(unsigned* p, unsigned v) { return __hip_atomic_fetch_add(p, v, __ATOMIC_RELAXED, __HIP_MEMORY_SCOPE_AGENT); }
__device__ __forceinline__ unsigned xb_xcc_id() { return (unsigned)__builtin_amdgcn_s_getreg((3 << 11) | 20) & 0xFu; }
#define XB_SPIN(cond, bar) do { unsigned _sp = 0; while (cond) { __builtin_amdgcn_s_sleep(1); \
    if ((++_sp & 255u) == 0u) { if (xb_ld(&(bar)[XB_TMO])) break; if (_sp > XB_SPIN_CAP) { atomicAdd(&(bar)[XB_TMO], 1u); break; } } } } while (0)

struct XcdBarrier {
    unsigned* bar; unsigned x;
    volatile LAS unsigned* st;
};

__device__ __forceinline__ XcdBarrier xcd_barrier_post(unsigned* bar, volatile LAS unsigned* st) {
    XcdBarrier b; b.bar = bar; b.x = xb_xcc_id(); b.st = st;
    if (threadIdx.x == 0) (void)xb_add(&bar[XB_XCNT(b.x)], 1u);
    return b;
}
__device__ __forceinline__ void xcd_barrier_complete(unsigned* bar, unsigned x, unsigned& nloc, unsigned& nx) {
    const unsigned G = gridDim.x * gridDim.y * gridDim.z;
    unsigned sum, cnt, mine, sp = 0u;
    for (;;) {
        sum = 0u; cnt = 0u; mine = 0u;
#pragma unroll
        for (unsigned j = 0; j < 16; ++j) { const unsigned c = xb_ld(&bar[XB_XCNT(j)]); sum += c; cnt += (c > 0u) ? 1u : 0u; mine = (j == x) ? c : mine; }
        if (sum == G) break;
        __builtin_amdgcn_s_sleep(1);
        if ((++sp & 255u) == 0u) { if (xb_ld(&bar[XB_TMO])) break; if (sp > XB_SPIN_CAP) { atomicAdd(&bar[XB_TMO], 1u); break; } }
    }
    nloc = mine > 0u ? mine : 1u; nx = cnt > 0u ? cnt : 1u;
}

__device__ __forceinline__ void xcd_barrier(const XcdBarrier& b) {
    asm volatile("s_waitcnt vmcnt(0)" ::: "memory");
    __syncthreads();
    if (threadIdx.x == 0) {
        unsigned* bar = b.bar;
        __builtin_amdgcn_s_waitcnt(0);
        unsigned nloc = b.st[0], nx = b.st[1];
        if (nloc == 0u) { xcd_barrier_complete(bar, b.x, nloc, nx); b.st[0] = nloc; b.st[1] = nx; }
        const unsigned old = xb_add(&bar[XB_XSUB(b.x)], 1u);
        const unsigned gen = old / nloc;
        if (old + 1u == (gen + 1u) * nloc) {
            __builtin_amdgcn_fence(__ATOMIC_RELEASE, "agent");
            asm volatile("s_waitcnt vmcnt(0)" ::: "memory");
            const unsigned og = xb_add(&bar[XB_TOP], 1u);
            const unsigned tg = og / nx;
            if (og + 1u != (tg + 1u) * nx) XB_SPIN(xb_ld(&bar[XB_TOP]) < (tg + 1u) * nx, bar);
            __builtin_amdgcn_fence(__ATOMIC_ACQUIRE, "agent");
            xb_add(&bar[XB_XGEN(b.x)], 1u);
            asm volatile("s_waitcnt vmcnt(0)" ::: "memory");
        } else {
            XB_SPIN(xb_ld(&bar[XB_XGEN(b.x)]) == gen, bar);
            __builtin_amdgcn_fence(__ATOMIC_ACQUIRE, "agent");
            asm volatile("s_waitcnt vmcnt(0)" ::: "memory");
        }
    }
    __syncthreads();
}

constexpr int NWAVES = 8;
constexpr int BATCH = 4, SEQ = 8192, D = 1024, M = BATCH * SEQ;
constexpr int IN_W = 7184, NGW = 4096, NGT = 3072, NSLAB = 8;
constexpr int SL_POOL = 0, SL_MQ = 1, SL_MK = 2, SL_MV = 3, SL_MO = 4, SL_FQ = 5, SL_FK = 6, SL_FV = 7;
constexpr int ML_H = 4, ML_DH = 128, CHUNK = 64, NCH = SEQ / CHUNK;
constexpr int FX_H = 8;
constexpr int DFF = 2816, NEXP = 8, DFE = 3584;
constexpr float NORM_EPS = 1e-6f;
constexpr int XLD = 2 * D;
constexpr int XROT = 16;
constexpr int KCAT = 1536;
constexpr int MOE_KROWS = 34816;
constexpr int MOE_KTILES = MOE_KROWS / 256;
constexpr int TOKBLK = 128, NTOKBLK = M / TOKBLK;

constexpr size_t MiB = 1u << 20;
constexpr size_t WS_CTL = 0, CTL_ZERO_BYTES = 1 * MiB;
constexpr size_t WS_W = 1 * MiB;
constexpr size_t W_LAYER = 19 * MiB, W_NG = 0, W_GT = 8 * MiB, W_CAT = 14 * MiB, W_OUT = 17 * MiB;
constexpr size_t WS_WGU = WS_W + 2 * W_LAYER, WS_WDN = WS_WGU + 11 * MiB;
constexpr size_t WS_NG = 56 * MiB, SLAB_BYTES = (size_t)M * 512 * 2;
constexpr size_t WS_GATE = WS_NG + SLAB_BYTES;
constexpr size_t WS_ACT0 = WS_NG;
constexpr size_t WS_HB = 312 * MiB;
constexpr size_t WS_CAT = 376 * MiB;
constexpr size_t WS_MLC = 472 * MiB;
constexpr size_t WS_MOEGU = 1 * MiB;
constexpr size_t WS_MOEDN = 57 * MiB;
constexpr size_t WS_XS = 85 * MiB;
constexpr size_t WS_Y0 = 153 * MiB, WS_Y1 = 217 * MiB;
constexpr size_t WS_ACT1 = 305 * MiB;
constexpr size_t WS_SM = 544 * MiB;
constexpr size_t SM_GATE16 = 0;
constexpr size_t SM_MLB = 2 * MiB, SM_MLA = SM_MLB + 512 * 1024, SM_MLMX = SM_MLA + 512 * 1024;
constexpr size_t SM_FNB = SM_MLMX + 512 * 1024;
constexpr size_t SM_MLN = SM_FNB + 1 * MiB;
constexpr size_t SM_MLM = SM_MLN + 1 * MiB;
constexpr size_t SM_MLDEC = SM_MLM + 16 * 132 * 4;
constexpr size_t SM_FQN = SM_MLDEC + 16 * 128 * 4, SM_FKN = SM_FQN + 32768, SM_FT0 = SM_FKN + 32768, SM_MLBG = SM_FT0 + 4096, SM_FXM = SM_MLBG + 16384;
constexpr size_t SM_FSEG = SM_FXM + 32768;
static_assert(SM_FSEG + 1024 <= 6 * MiB, "small arrays (layer stage)");
constexpr size_t SM_MOE = 6 * MiB;
constexpr size_t MO_RSTD = 0, MO_TOKE = MO_RSTD + (size_t)M * 4, MO_TOKG = MO_TOKE + (size_t)M * 8, MO_HIST = MO_TOKG + (size_t)M * 8,
                 MO_ROWTOK = MO_HIST + (size_t)NTOKBLK * 16 * 4, MO_ROWG = MO_ROWTOK + (size_t)2 * MOE_KROWS * 4, MO_TILEE = MO_ROWG + (size_t)2 * MOE_KROWS * 4, MO_NT = MO_TILEE + 2 * MOE_KTILES * 4, MO_END = MO_NT + 64;
static_assert(SM_MOE + MO_END <= 8 * MiB, "small arrays");
constexpr size_t WS_END = 552 * MiB;
static_assert(WS_WDN + (size_t)DFF * D * 2 <= WS_NG && WS_NG + NSLAB * SLAB_BYTES <= WS_HB && WS_HB + (size_t)M * D * 2 <= WS_CAT && WS_CAT + (size_t)M * KCAT * 2 <= WS_MLC && WS_MLC + 64 * MiB <= WS_SM, "d_ws map");
static_assert(WS_MOEGU + (size_t)NEXP * 2 * DFE * D <= WS_MOEDN && WS_MOEDN + (size_t)NEXP * D * DFE <= WS_XS && WS_XS + (size_t)2 * MOE_KROWS * D <= WS_Y0 && WS_Y0 + (size_t)M * D * 2 <= WS_Y1 && WS_Y1 + (size_t)M * D * 2 <= WS_ACT1 && WS_ACT1 + (size_t)2 * MOE_KROWS * DFE <= WS_SM, "d_ws map (MoE)");
constexpr int CW_TMO = 0, CW_CODE = 1, CW_BAR = 4096;

constexpr int RING_OFF = 0, RING_BYTES = 131072;
constexpr int LDSCTL_OFF = RING_BYTES, MISC_OFF = LDSCTL_OFF + 320;
constexpr int LDS_BYTES = 147456;
static_assert(MISC_OFF + 128 <= LDS_BYTES, "LDS map");

struct Frame {
    LAS unsigned char* lds;
    volatile LAS unsigned* MISC;
    gu32* ctl;
    int tid, lane, wave;
    int vcu, G, blk;
    unsigned char* ws;
    const float* const* in; float* out; int zi;
};
#define INP(F, i) ((F).in[(i) + (F).zi])
enum { IN_X = 0, IN_MIXG, IN_WIN, IN_POOLW, IN_POOLS, IN_CONVW, IN_MLBI, IN_MLBF, IN_MLNG, IN_FXBF, IN_WBRP, IN_WBRM, IN_WBRF, IN_WOUT, IN_FFNG, IN_FFG, IN_FFU, IN_FFD, IN_RW, IN_RB, IN_MOEG, IN_MOEU, IN_MOED, IN_FING };

__device__ __forceinline__ float wave_sum(float v) {
#pragma unroll
    for (int o = 1; o < 64; o <<= 1) v += __shfl_xor(v, o);
    return v;
}
__device__ __forceinline__ float wave_max(float v) {
#pragma unroll
    for (int o = 1; o < 64; o <<= 1) v = fmaxf(v, __shfl_xor(v, o));
    return v;
}
__device__ __forceinline__ float sigmoid_f(float x) { return __builtin_amdgcn_rcpf(1.f + __builtin_amdgcn_exp2f(-1.4426950408889634f * x)); }
__device__ __forceinline__ float logsigmoid_f(float x) {
    const float e = __builtin_amdgcn_exp2f(-1.4426950408889634f * fabsf(x));
    const float ser = e * (1.f + e * (-0.5f + e * (0.33333334f + e * (-0.25f + e * (0.2f + e * -0.16666667f)))));
    const float lg = 0.6931471805599453f * __builtin_amdgcn_logf(1.f + e);
    return fminf(x, 0.f) - (e < 0.0625f ? ser : lg);
}

__device__ __forceinline__ void tr_item(const float* W, int ldw, int srccol0, const float* gain, bf16* WT, int ldt, int drow0, int dcol0, int k0, LAS float* scr, int lane) {
    (void)scr;
    const int ng = lane & 7, kg = lane >> 3;
    f32x4 v[8];
#pragma unroll
    for (int i = 0; i < 8; ++i) v[i] = *(const GAS f32x4*)(W + (size_t)(k0 + 8 * kg + i) * ldw + srccol0 + 4 * ng);
    if (gain) { const f32x4 g0 = *(const GAS f32x4*)(gain + k0 + 8 * kg), g1 = *(const GAS f32x4*)(gain + k0 + 8 * kg + 4);
#pragma unroll
        for (int i = 0; i < 4; ++i) { v[i] = v[i] * g0[i]; v[4 + i] = v[4 + i] * g1[i]; } }
#pragma unroll
    for (int j = 0; j < 4; ++j) { v4u o; o.x = pk2(v[0][j], v[1][j]); o.y = pk2(v[2][j], v[3][j]); o.z = pk2(v[4][j], v[5][j]); o.w = pk2(v[6][j], v[7][j]);
        *(GAS v4u*)(WT + (size_t)(drow0 + 4 * ng + j) * ldt + dcol0 + k0 + 8 * kg) = o; }
}
__device__ __forceinline__ void tr_item_fp8(const float* W, int ldw, int srccol0, const float* gain, float scale, unsigned char* WT8, int ldt, int drow0, int k0, int lane) {
    const int ng = lane & 7, kg = lane >> 3;
    f32x4 v[8];
#pragma unroll
    for (int i = 0; i < 8; ++i) v[i] = *(const GAS f32x4*)(W + (size_t)(k0 + 8 * kg + i) * ldw + srccol0 + 4 * ng);
    f32x4 g0 = (f32x4){scale, scale, scale, scale}, g1 = g0;
    if (gain) { g0 = *(const GAS f32x4*)(gain + k0 + 8 * kg) * scale; g1 = *(const GAS f32x4*)(gain + k0 + 8 * kg + 4) * scale; }
#pragma unroll
    for (int i = 0; i < 4; ++i) { v[i] = v[i] * g0[i]; v[4 + i] = v[4 + i] * g1[i]; }
    typedef unsigned u32x2_t __attribute__((ext_vector_type(2)));
#pragma unroll
    for (int j = 0; j < 4; ++j) { u32x2_t o; o.x = pg8::pack_fp8x4(v[0][j], v[1][j], v[2][j], v[3][j]); o.y = pg8::pack_fp8x4(v[4][j], v[5][j], v[6][j], v[7][j]);
        *(GAS u32x2_t*)(WT8 + (size_t)(drow0 + 4 * ng + j) * ldt + k0 + 8 * kg) = o; }
}
constexpr float FP8_ASCALE = 16.f, FP8_WSCALE = 256.f;
constexpr int CI_NG = 2048, CI_GT = 1536, CI_BR = 256, CI_OUT = 512, CI_LAYER = CI_NG + CI_GT + 2 * CI_BR + CI_OUT, CI_GU = 2816, CI_DN = 1408, CI_MAIN = 2 * CI_LAYER + CI_GU + CI_DN;
__device__ __forceinline__ void conv_item_main(Frame& F, int it, LAS float* scr) {
    if (it < 2 * CI_LAYER) {
        const int l = it / CI_LAYER; int r = it % CI_LAYER; bf16* wl = (bf16*)(F.ws + WS_W + (size_t)l * W_LAYER);
        const float* g = INP(F, IN_MIXG) + l * D; const float* win = INP(F, IN_WIN) + (size_t)l * D * IN_W;
        if (r < CI_NG) { const int nb = r >> 4, kb = r & 15; tr_item(win, IN_W, nb * 32 + (nb * 32 >= 2560 ? 8 : 0), g, wl + W_NG / 2, D, nb * 32, 0, kb * 64, scr, F.lane); return; } r -= CI_NG;
        if (r < CI_GT) { const int nb = r >> 4, kb = r & 15; tr_item_fp8(win, IN_W, 4112 + nb * 32, g, FP8_WSCALE, (unsigned char*)wl + W_GT, D, nb * 32, kb * 64, F.lane); return; } r -= CI_GT;
        if (r < CI_BR) { const int nb = r >> 3, kb = r & 7; tr_item(INP(F, IN_WBRM) + (size_t)l * 512 * D, D, nb * 32, nullptr, wl + W_CAT / 2, KCAT, nb * 32, 512, kb * 64, scr, F.lane); return; } r -= CI_BR;
        if (r < CI_BR) { const int nb = r >> 3, kb = r & 7; tr_item(INP(F, IN_WBRF) + (size_t)l * 512 * D, D, nb * 32, nullptr, wl + W_CAT / 2, KCAT, nb * 32, 1024, kb * 64, scr, F.lane); return; } r -= CI_BR;
        { const int nb = r >> 4, kb = r & 15; tr_item(INP(F, IN_WOUT) + (size_t)l * D * D, D, nb * 32, nullptr, wl + W_OUT / 2, D, nb * 32, 0, kb * 64, scr, F.lane); }
        return;
    }
    it -= 2 * CI_LAYER;
    if (it < CI_GU) { const int nb = it >> 4, kb = it & 15, p = nb >> 3, w = nb & 7;
        tr_item(w < 4 ? INP(F, IN_FFG) : INP(F, IN_FFU), DFF, 128 * p + (w & 3) * 32, INP(F, IN_FFNG), (bf16*)(F.ws + WS_WGU), D, nb * 32, 0, kb * 64, scr, F.lane); return; }
    it -= CI_GU;
    { const int kb = it >> 5, nb = it & 31; tr_item(INP(F, IN_FFD), D, nb * 32, nullptr, (bf16*)(F.ws + WS_WDN), DFF, nb * 32, 0, kb * 64, scr, F.lane); }
}
constexpr int CI_MGU = 3584, CI_MDN = 1792, CI_MEXP = CI_MGU + CI_MDN, CI_MOE = NEXP * CI_MEXP;
__device__ __forceinline__ void conv_item_moe(Frame& F, int it, LAS float* scr) {
    (void)scr;
    const int e = it / CI_MEXP; int r = it % CI_MEXP;
    if (r < CI_MGU) { const int nb = r % 224, kb = r / 224, p = nb >> 3, w = nb & 7;
        tr_item_fp8((w < 4 ? INP(F, IN_MOEG) : INP(F, IN_MOEU)) + (size_t)e * D * DFE, DFE, 128 * p + (w & 3) * 32, INP(F, IN_FFNG) + D, FP8_WSCALE, F.ws + WS_MOEGU + (size_t)e * 2 * DFE * D, D, nb * 32, kb * 64, F.lane); return; }
    r -= CI_MGU;
    { const int kb = r >> 5, nb = r & 31; tr_item_fp8(INP(F, IN_MOED) + (size_t)e * DFE * D, D, nb * 32, nullptr, FP8_WSCALE, F.ws + WS_MOEDN + (size_t)e * D * DFE, DFE, nb * 32, kb * 64, F.lane); }
}
__device__ __forceinline__ void pool_fold(Frame& F) {
    const int gt = F.blk * (NWAVES * 64) + F.tid, NT = F.G * NWAVES * 64;
    for (int o = gt; o < 2 * 4 * 16 * D; o += NT) {
        const int n = o & (D - 1), cb = __builtin_amdgcn_readfirstlane(o >> 10), l = cb >> 6, g = (cb >> 4) & 3, c0 = (cb & 15) * 8;
        const float* wg = INP(F, IN_POOLW) + (size_t)l * 4 * 128 * 128 + (size_t)(g * 128 + c0) * 128; const float* sc = INP(F, IN_POOLS) + l * 512 + g * 128; const float* wb = INP(F, IN_WBRP) + (size_t)l * 512 * D + (size_t)(g * 128) * D + n;
        float a[8];
#pragma unroll
        for (int i = 0; i < 8; ++i) a[i] = 0.f;
#pragma unroll 8
        for (int dd = 0; dd < 128; ++dd) { const float t = sc[dd] * wb[(size_t)dd * D];
#pragma unroll
            for (int i = 0; i < 8; ++i) a[i] += wg[i * 128 + dd] * t; }
        v4u w; w.x = pk2(a[0], a[1]); w.y = pk2(a[2], a[3]); w.z = pk2(a[4], a[5]); w.w = pk2(a[6], a[7]);
        *(GAS v4u*)((bf16*)(F.ws + WS_W + (size_t)l * W_LAYER + W_CAT) + (size_t)n * KCAT + g * 128 + c0) = w;
    }
}

template <bool XB, int LD = D, int ROT = 0> __device__ __forceinline__ void load_xrow(const void* x, size_t m, int lane, f32x4 (&v)[4]) {
    if constexpr (XB) { typedef unsigned u32x2_t __attribute__((ext_vector_type(2))); const GAS u32x2_t* xr = (const GAS u32x2_t*)((const bf16*)x + m * LD + (ROT ? (m & (ROT - 1)) * 64 : 0)) + lane;
#pragma unroll
        for (int j = 0; j < 4; ++j) { const u32x2_t q = xr[64 * j]; v[j] = (f32x4){__uint_as_float(q.x << 16), __uint_as_float(q.x & 0xffff0000u), __uint_as_float(q.y << 16), __uint_as_float(q.y & 0xffff0000u)}; } }
    else { const GAS f32x4* xr = (const GAS f32x4*)((const float*)x + m * D) + lane;
#pragma unroll
        for (int j = 0; j < 4; ++j) v[j] = xr[64 * j]; }
}
template <bool XB> __device__ __forceinline__ void phase_norm_mix(Frame& F, const void* x, int l) {
    LAS float* w16 = (LAS float*)(F.lds);
    const float* g = INP(F, IN_MIXG) + l * D; const float* win = INP(F, IN_WIN) + (size_t)l * D * IN_W;
    for (int idx = F.tid; idx < 16 * D; idx += NWAVES * 64) { const int k = idx >> 4, j = idx & 15, col = j < 8 ? 2560 + j : 4104 + (j - 8); w16[j * D + k] = g[k] * win[(size_t)k * IN_W + col]; }
    __syncthreads();
    bf16* HB = (bf16*)(F.ws + WS_HB); float* gate16 = (float*)(F.ws + WS_SM + SM_GATE16);
    const int gw = F.vcu * NWAVES + F.wave, NGWV = F.G * NWAVES;
    f32x4 nv[4]; if (gw < M) load_xrow<XB, XB ? XLD : D, XB ? XROT : 0>(x, (size_t)gw, F.lane, nv);
    for (int m = gw; m < M; m += NGWV) {
        f32x4 v[4]; float ss = 0.f;
#pragma unroll
        for (int j = 0; j < 4; ++j) v[j] = nv[j];
        if (m + NGWV < M) load_xrow<XB, XB ? XLD : D, XB ? XROT : 0>(x, (size_t)(m + NGWV), F.lane, nv);
#pragma unroll
        for (int j = 0; j < 4; ++j) ss += (v[j].x * v[j].x + v[j].y * v[j].y) + (v[j].z * v[j].z + v[j].w * v[j].w);
        const float rstd = 1.f / sqrtf(wave_sum(ss) * (1.f / D) + NORM_EPS);
        GAS unsigned long long* o8 = (GAS unsigned long long*)(HB + (size_t)m * D) + F.lane;
#pragma unroll
        for (int j = 0; j < 4; ++j) o8[64 * j] = (unsigned long long)pk2(v[j].x * rstd, v[j].y * rstd) | ((unsigned long long)pk2(v[j].z * rstd, v[j].w * rstd) << 32);
        float pp[16];
#pragma unroll
        for (int jj = 0; jj < 16; ++jj) { float p = 0.f;
#pragma unroll
            for (int j = 0; j < 4; ++j) { const f32x4 wv = *(const LAS f32x4*)(w16 + jj * D + 256 * j + 4 * F.lane); p += (v[j].x * wv.x + v[j].y * wv.y) + (v[j].z * wv.z + v[j].w * wv.w); }
            pp[jj] = p; if ((jj & 3) == 3) asm volatile("" ::: "memory"); }
#define TB_STAGE(ST, N) { const bool up = (F.lane >> (ST)) & 1; _Pragma("unroll") for (int i = 0; i < (N); ++i) { const float mine = up ? pp[2 * i + 1] : pp[2 * i], give = up ? pp[2 * i] : pp[2 * i + 1]; pp[i] = mine + __shfl_xor(give, 1 << (ST)); } }
        TB_STAGE(0, 8) TB_STAGE(1, 4) TB_STAGE(2, 2) TB_STAGE(3, 1)
        float keep = pp[0]; keep += __shfl_xor(keep, 16); keep += __shfl_xor(keep, 32); keep *= rstd;
        if (F.lane < 16) gate16[(size_t)m * 16 + F.lane] = keep;
    }
    __syncthreads();
}
__device__ __forceinline__ void phase_norm_ffn(Frame& F, const bf16* x) {
    bf16* HB = (bf16*)(F.ws + WS_HB);
    const int gw = F.vcu * NWAVES + F.wave, NGWV = F.G * NWAVES;
    f32x4 nv[4]; if (gw < M) load_xrow<true, XLD, XROT>(x, (size_t)gw, F.lane, nv);
    for (int m = gw; m < M; m += NGWV) {
        f32x4 v[4]; float ss = 0.f;
#pragma unroll
        for (int j = 0; j < 4; ++j) v[j] = nv[j];
        if (m + NGWV < M) load_xrow<true, XLD, XROT>(x, (size_t)(m + NGWV), F.lane, nv);
#pragma unroll
        for (int j = 0; j < 4; ++j) ss += (v[j].x * v[j].x + v[j].y * v[j].y) + (v[j].z * v[j].z + v[j].w * v[j].w);
        const float rstd = 1.f / sqrtf(wave_sum(ss) * (1.f / D) + NORM_EPS);
        GAS unsigned long long* o8 = (GAS unsigned long long*)(HB + (size_t)m * D) + F.lane;
#pragma unroll
        for (int j = 0; j < 4; ++j) o8[64 * j] = (unsigned long long)pk2(v[j].x * rstd, v[j].y * rstd) | ((unsigned long long)pk2(v[j].z * rstd, v[j].w * rstd) << 32);
    }
}
__device__ __forceinline__ void quant_rows_fp8(Frame& F, const bf16* src, unsigned char* dst) {
    const int gw = F.vcu * NWAVES + F.wave, NGWV = F.G * NWAVES;
    for (int m = gw; m < M; m += NGWV) {
        const v4u a = *((const GAS v4u*)(src + (size_t)m * D) + F.lane), b = *((const GAS v4u*)(src + (size_t)m * D) + 64 + F.lane);
        typedef unsigned u32x2_t __attribute__((ext_vector_type(2)));
        u32x2_t o0, o1; const float s = FP8_ASCALE;
        o0.x = pg8::pack_fp8x4(__uint_as_float(a.x << 16) * s, __uint_as_float(a.x & 0xffff0000u) * s, __uint_as_float(a.y << 16) * s, __uint_as_float(a.y & 0xffff0000u) * s);
        o0.y = pg8::pack_fp8x4(__uint_as_float(a.z << 16) * s, __uint_as_float(a.z & 0xffff0000u) * s, __uint_as_float(a.w << 16) * s, __uint_as_float(a.w & 0xffff0000u) * s);
        o1.x = pg8::pack_fp8x4(__uint_as_float(b.x << 16) * s, __uint_as_float(b.x & 0xffff0000u) * s, __uint_as_float(b.y << 16) * s, __uint_as_float(b.y & 0xffff0000u) * s);
        o1.y = pg8::pack_fp8x4(__uint_as_float(b.z << 16) * s, __uint_as_float(b.z & 0xffff0000u) * s, __uint_as_float(b.w << 16) * s, __uint_as_float(b.w & 0xffff0000u) * s);
        *((GAS u32x2_t*)(dst + (size_t)m * D) + F.lane) = o0; *((GAS u32x2_t*)(dst + (size_t)m * D) + 64 + F.lane) = o1;
    }
}
__device__ __forceinline__ void phase_norm_final(Frame& F, const bf16* xb, float* out) {
    const GAS f32x4* gp = (const GAS f32x4*)INP(F, IN_FING) + F.lane; f32x4 gv[4];
#pragma unroll
    for (int j = 0; j < 4; ++j) gv[j] = gp[64 * j];
    const bf16* Y0 = (const bf16*)(F.ws + WS_Y0); const bf16* Y1 = (const bf16*)(F.ws + WS_Y1);
    const int gw = F.vcu * NWAVES + F.wave, NGWV = F.G * NWAVES;
    f32x4 nv[4], na[4], nb_[4]; if (gw < M) { load_xrow<true, XLD, XROT>(xb, (size_t)gw, F.lane, nv); load_xrow<true>(Y0, (size_t)gw, F.lane, na); load_xrow<true>(Y1, (size_t)gw, F.lane, nb_); }
    for (int m = gw; m < M; m += NGWV) {
        f32x4 v[4]; float ss = 0.f;
#pragma unroll
        for (int j = 0; j < 4; ++j) v[j] = nv[j] + (na[j] + nb_[j]);
        if (m + NGWV < M) { load_xrow<true, XLD, XROT>(xb, (size_t)(m + NGWV), F.lane, nv); load_xrow<true>(Y0, (size_t)(m + NGWV), F.lane, na); load_xrow<true>(Y1, (size_t)(m + NGWV), F.lane, nb_); }
#pragma unroll
        for (int j = 0; j < 4; ++j) ss += (v[j].x * v[j].x + v[j].y * v[j].y) + (v[j].z * v[j].z + v[j].w * v[j].w);
        const float rstd = 1.f / sqrtf(wave_sum(ss) * (1.f / D) + NORM_EPS);
        GAS f32x4* o = (GAS f32x4*)(out + (size_t)m * D) + F.lane;
#pragma unroll
        for (int j = 0; j < 4; ++j) o[64 * j] = v[j] * rstd * gv[j];
    }
}

__device__ __forceinline__ void phase_route1(Frame& F, const bf16* x) {
    LAS float* w8 = (LAS float*)(F.lds);
    LAS int* hist = (LAS int*)(F.lds + 32768);
    const float* g = INP(F, IN_FFNG) + D; const float* rw = INP(F, IN_RW);
    for (int idx = F.tid; idx < 8 * D; idx += NWAVES * 64) { const int k = idx >> 3, e = idx & 7; w8[e * D + k] = g[k] * rw[(size_t)k * 8 + e]; }
    unsigned char* sm = F.ws + WS_SM + SM_MOE;
    float* rstd_g = (float*)(sm + MO_RSTD); int* tok_e = (int*)(sm + MO_TOKE); float* tok_g = (float*)(sm + MO_TOKG); int* hist_g = (int*)(sm + MO_HIST);
    if (F.blk == 0 && F.tid < 256) ((GAS unsigned*)(F.ws + WS_XS + (size_t)M * D))[F.tid] = 0u;
    for (int blk = F.blk; blk < NTOKBLK; blk += F.G) {
        if (F.tid < 16) hist[F.tid] = 0;
        __syncthreads();
        f32x4 nv[4]; load_xrow<true, XLD, XROT>(x, (size_t)(blk * TOKBLK + F.wave * (TOKBLK / NWAVES)), F.lane, nv);
        for (int i = 0; i < TOKBLK / NWAVES; ++i) {
            const int m = blk * TOKBLK + F.wave * (TOKBLK / NWAVES) + i;
            f32x4 v[4]; float ss = 0.f;
#pragma unroll
            for (int j = 0; j < 4; ++j) v[j] = nv[j];
            if (i + 1 < TOKBLK / NWAVES) load_xrow<true, XLD, XROT>(x, (size_t)(m + 1), F.lane, nv);
#pragma unroll
            for (int j = 0; j < 4; ++j) ss += (v[j].x * v[j].x + v[j].y * v[j].y) + (v[j].z * v[j].z + v[j].w * v[j].w);
            const float rstd = 1.f / sqrtf(wave_sum(ss) * (1.f / D) + NORM_EPS);
            { GAS unsigned* q8 = (GAS unsigned*)(F.ws + WS_XS + (size_t)m * D) + F.lane; const float r8 = rstd * FP8_ASCALE;
#pragma unroll
              for (int j = 0; j < 4; ++j) q8[64 * j] = pg8::pack_fp8x4(v[j].x * r8, v[j].y * r8, v[j].z * r8, v[j].w * r8); }
            float pp[8];
#pragma unroll
            for (int e = 0; e < 8; ++e) { float p = 0.f;
#pragma unroll
                for (int j = 0; j < 4; ++j) { const f32x4 wv = *(const LAS f32x4*)(w8 + e * D + 256 * j + 4 * F.lane); p += (v[j].x * wv.x + v[j].y * wv.y) + (v[j].z * wv.z + v[j].w * wv.w); }
                pp[e] = p; }
            TB_STAGE(0, 4) TB_STAGE(1, 2) TB_STAGE(2, 1)
            float tot = pp[0]; tot += __shfl_xor(tot, 8); tot += __shfl_xor(tot, 16); tot += __shfl_xor(tot, 32);
            float lg[8];
#pragma unroll
            for (int e = 0; e < 8; ++e) lg[e] = __shfl(tot, e) * rstd + INP(F, IN_RB)[e];
            if (F.lane == 0) {
                int e0 = 0; float v0 = lg[0];
#pragma unroll
                for (int e = 1; e < 8; ++e) if (lg[e] > v0) { v0 = lg[e]; e0 = e; }
                int e1 = -1; float v1 = -INFINITY;
#pragma unroll
                for (int e = 0; e < 8; ++e) if (e != e0 && lg[e] > v1) { v1 = lg[e]; e1 = e; }
                const float t = __expf(v1 - v0), g0 = 1.f / (1.f + t), g1 = t * g0;
                rstd_g[m] = rstd; tok_e[2 * m] = e0; tok_e[2 * m + 1] = e1; tok_g[2 * m] = g0; tok_g[2 * m + 1] = g1;
                atomicAdd((int*)&hist[e0], 1); atomicAdd((int*)&hist[8 + e1], 1);
            }
        }
        __syncthreads();
        if (F.tid < 16) hist_g[blk * 16 + F.tid] = hist[F.tid];
        __syncthreads();
    }
}
__device__ __forceinline__ void phase_route2(Frame& F, const bf16* x) {
    LAS int* H = (LAS int*)(F.lds);
    LAS int* tot = (LAS int*)(F.lds + 16384); LAS int* pre = tot + 16; LAS int* start = tot + 32; LAS int* dest = tot + 64; LAS int* te = tot + 320;
    unsigned char* sm = F.ws + WS_SM + SM_MOE;
    const float* rstd_g = (const float*)(sm + MO_RSTD); const int* tok_e = (const int*)(sm + MO_TOKE); const float* tok_g = (const float*)(sm + MO_TOKG); const int* hist_g = (const int*)(sm + MO_HIST);
    int* row_tok = (int*)(sm + MO_ROWTOK); float* row_g = (float*)(sm + MO_ROWG); int* tile_e = (int*)(sm + MO_TILEE); int* ntl = (int*)(sm + MO_NT);
    unsigned char* XS = F.ws + WS_XS;
    for (int blk = F.blk; blk < NTOKBLK; blk += F.G) {
        for (int i = F.tid; i < NTOKBLK * 16; i += NWAVES * 64) H[i] = hist_g[i];
        __syncthreads();
        {
            LAS int* ptot = tot + 1024; LAS int* ppre = ptot + 512;
            const int g = F.tid & 15, part = F.tid >> 4; int t = 0, pq = 0;
            static_assert(NTOKBLK == 256 && NWAVES * 64 == 512, "route2 partial sums");
#pragma unroll
            for (int i = 0; i < 8; ++i) { const int b = part * 8 + i, h = H[b * 16 + g]; t += h; pq += (b < blk) ? h : 0; }
            ptot[part * 16 + g] = t; ppre[part * 16 + g] = pq;
            __syncthreads();
            if (F.tid < 16) { int tt = 0, pp2 = 0;
#pragma unroll 8
                for (int q = 0; q < 32; ++q) { tt += ptot[q * 16 + F.tid]; pp2 += ppre[q * 16 + F.tid]; }
                tot[F.tid] = tt; pre[F.tid] = pp2; } }
        __syncthreads();
        if (F.tid == 0) { for (int k = 0; k < 2; ++k) { int run = 0; for (int e = 0; e < 8; ++e) { start[k * 8 + e] = run; run += ((tot[k * 8 + e] + 255) >> 8) << 8; } if (blk == 0) ntl[k] = run >> 8; } }
        __syncthreads();
        if (F.tid < 2 * TOKBLK) te[F.tid] = tok_e[2 * blk * TOKBLK + F.tid];
        __syncthreads();
        {
#pragma unroll
            for (int q = 0; q < 2; ++q) { const int pr = 2 * F.wave + q, k = pr >> 3, e = pr & 7; const int base = k * MOE_KROWS + start[pr] + pre[pr];
                const bool m0 = te[2 * F.lane + k] == e, m1 = te[2 * (64 + F.lane) + k] == e;
                const unsigned long long b0 = __ballot(m0), b1 = __ballot(m1), lt = (1ull << F.lane) - 1ull;
                if (m0) dest[2 * F.lane + k] = base + (int)__popcll(b0 & lt);
                if (m1) dest[2 * (64 + F.lane) + k] = base + (int)__popcll(b0) + (int)__popcll(b1 & lt); }
            if (blk == 0 && F.tid < 16) { const int k = F.tid >> 3, e = F.tid & 7; const int s0 = start[F.tid], t0 = tot[F.tid], pe = ((t0 + 255) >> 8) << 8;
                for (int tI = s0 >> 8; tI < (s0 + pe) >> 8; ++tI) tile_e[k * MOE_KTILES + tI] = e;
                for (int r = s0 + t0; r < s0 + pe; ++r) { row_tok[k * MOE_KROWS + r] = -1; row_g[k * MOE_KROWS + r] = 0.f; } } }
        __syncthreads();
        if (F.tid < 2 * TOKBLK) { const int m = blk * TOKBLK + (F.tid >> 1), d = dest[F.tid]; row_tok[d] = m; row_g[d] = tok_g[2 * m + (F.tid & 1)]; }
        __syncthreads();
    }
}

__device__ __forceinline__ float wave_scan_add(float v, int lane) {
#pragma unroll
    for (int d = 1; d < 64; d <<= 1) { const float t = __shfl_up(v, d); if (lane >= d) v += t; }
    return v;
}
__device__ __forceinline__ float wave_scan_max(float v, int lane) {
#pragma unroll
    for (int d = 1; d < 64; d <<= 1) { const float t = __shfl_up(v, d); if (lane >= d) v = fmaxf(v, t); }
    return v;
}
__device__ __forceinline__ void prep_mlstm(Frame& F, int l, int bh) {
    LAS float* Bc = (LAS float*)(F.lds); LAS float* Gc = Bc + NCH; LAS float* mc = Gc + NCH;
    const int b = bh >> 2, h = bh & 3;
    const float* gate16 = (const float*)(F.ws + WS_SM + SM_GATE16);
    float* mlb = (float*)(F.ws + WS_SM + SM_MLB) + (size_t)bh * SEQ; float* mla = (float*)(F.ws + WS_SM + SM_MLA) + (size_t)bh * SEQ; float* mlmx = (float*)(F.ws + WS_SM + SM_MLMX) + (size_t)bh * SEQ;
    float* mlm = (float*)(F.ws + WS_SM + SM_MLM) + bh * 132; float* mldec = (float*)(F.ws + WS_SM + SM_MLDEC) + bh * NCH;
    const float bi = INP(F, IN_MLBI)[l * ML_H + h], bf = INP(F, IN_MLBF)[l * ML_H + h];
    float areg[NCH / NWAVES];
#pragma unroll
    for (int ci = 0; ci < NCH / NWAVES; ++ci) {
        const int c = F.wave + NWAVES * ci, t = c * CHUNK + F.lane; const size_t m = (size_t)b * SEQ + t;
        const float lf = logsigmoid_f(gate16[m * 16 + 4 + h] + bf), li = gate16[m * 16 + h] + bi;
        const float bc = wave_scan_add(lf, F.lane), a = li - bc;
        const float amax = wave_max(a), btot = __shfl(bc, 63);
        mlb[t] = bc; mla[t] = a; areg[ci] = a;
        if (F.lane == 0) { Bc[c] = btot; Gc[c] = btot + amax; }
    }
    __syncthreads();
    if (F.tid == 0) { float mm = 0.f; for (int c = 0; c < NCH; ++c) { mc[c] = mm; const float mn = fmaxf(Bc[c] + mm, Gc[c]); mldec[c] = __expf(Bc[c] + mm - mn); mlm[c] = mm; mm = mn; } mc[NCH] = mm; mlm[NCH] = mm; }
    __syncthreads();
#pragma unroll
    for (int ci = 0; ci < NCH / NWAVES; ++ci) {
        const int c = F.wave + NWAVES * ci, t = c * CHUNK + F.lane;
        mlmx[t] = fmaxf(mc[c], wave_scan_max(areg[ci], F.lane));
    }
    __syncthreads();
}
__device__ __forceinline__ void prep_fox(Frame& F, int l, int item) {
    LAS float* wtot = (LAS float*)(F.lds);
    const int bh = item >> 3, seg = item & 7, b = bh >> 3, h = bh & 7;
    const float* gate16 = (const float*)(F.ws + WS_SM + SM_GATE16);
    float* nb = (float*)(F.ws + WS_SM + SM_FNB) + (size_t)bh * SEQ + seg * 1024; float* segt = (float*)(F.ws + WS_SM + SM_FSEG) + item;
    const float bf = INP(F, IN_FXBF)[l * FX_H + h];
    const size_t m0 = (size_t)b * SEQ + seg * 1024 + 2 * F.tid;
    const float s0 = logsigmoid_f(gate16[m0 * 16 + 8 + h] + bf), s1 = s0 + logsigmoid_f(gate16[(m0 + 1) * 16 + 8 + h] + bf);
    const float incl = wave_scan_add(s1, F.lane);
    if (F.lane == 63) wtot[F.wave] = incl;
    __syncthreads();
    float off = incl - s1;
    for (int w = 0; w < F.wave; ++w) off += wtot[w];
    nb[2 * F.tid] = -1.4426950408889634f * (off + s0); nb[2 * F.tid + 1] = -1.4426950408889634f * (off + s1);
    if (F.tid == NWAVES * 64 - 1) segt[0] = -1.4426950408889634f * (off + s1);
    __syncthreads();
}

__device__ __forceinline__ void unpack8(const v4u q, float (&f)[8]) {
    f[0] = __uint_as_float(q.x << 16); f[1] = __uint_as_float(q.x & 0xffff0000u); f[2] = __uint_as_float(q.y << 16); f[3] = __uint_as_float(q.y & 0xffff0000u);
    f[4] = __uint_as_float(q.z << 16); f[5] = __uint_as_float(q.z & 0xffff0000u); f[6] = __uint_as_float(q.w << 16); f[7] = __uint_as_float(q.w & 0xffff0000u);
}
constexpr int POOL_ROWS = 16;
__device__ __forceinline__ void pool_item(Frame& F, int item) {
    const bf16* U = (const bf16*)(F.ws + WS_NG + SL_POOL * SLAB_BYTES) + F.lane * 8; bf16* CAT = (bf16*)(F.ws + WS_CAT) + F.lane * 8;
    const int grp = F.lane >> 4, w = 2 << grp, m0 = item * POOL_ROWS, tt0 = m0 & (SEQ - 1);
    v4u ring[16];
#pragma unroll
    for (int j = 1; j < 16; ++j) { ring[(16 - j) & 15] = (v4u){0u, 0u, 0u, 0u}; if (tt0 - j >= 0) ring[(16 - j) & 15] = *(const GAS v4u*)(U + (size_t)(m0 - j) * 512); }
    float sum[8];
#pragma unroll
    for (int i = 0; i < 8; ++i) sum[i] = 0.f;
#pragma unroll
    for (int j = 1; j < 16; ++j) { float f[8]; unpack8(ring[(16 - j) & 15], f); const float on = (j < w) ? 1.f : 0.f;
#pragma unroll
        for (int i = 0; i < 8; ++i) sum[i] += on * f[i]; }
#pragma unroll
    for (int r0 = 0; r0 < POOL_ROWS; r0 += 8) {
        v4u cur[8];
#pragma unroll
        for (int j = 0; j < 8; ++j) cur[j] = *(const GAS v4u*)(U + (size_t)(m0 + r0 + j) * 512);
#pragma unroll
        for (int j = 0; j < 8; ++j) { const int r = r0 + j, tt = tt0 + r;
            float c[8]; unpack8(cur[j], c);
#pragma unroll
            for (int i = 0; i < 8; ++i) sum[i] += c[i];
            const int cnt = (tt + 1 < w) ? tt + 1 : w; const float inv = 1.f / (float)cnt;
            v4u o; o.x = pk2(sum[0] * inv - c[0], sum[1] * inv - c[1]); o.y = pk2(sum[2] * inv - c[2], sum[3] * inv - c[3]); o.z = pk2(sum[4] * inv - c[4], sum[5] * inv - c[5]); o.w = pk2(sum[6] * inv - c[6], sum[7] * inv - c[7]);
            *(GAS v4u*)(CAT + (size_t)(m0 + r) * KCAT) = o;
            const v4u a2 = (r - 1 >= 0 || true) ? ((r - 1) >= r0 ? cur[(j - 1) & 7] : ring[(r - 1) & 15]) : ring[0];
            const v4u a4 = ((r - 3) >= r0) ? cur[(j - 3) & 7] : ring[(r - 3) & 15];
            const v4u a8 = ((r - 7) >= r0) ? cur[(j - 7) & 7] : ring[(r - 7) & 15];
            const v4u a16 = ring[(r - 15) & 15];
            v4u old; old.x = grp == 0 ? a2.x : (grp == 1 ? a4.x : (grp == 2 ? a8.x : a16.x)); old.y = grp == 0 ? a2.y : (grp == 1 ? a4.y : (grp == 2 ? a8.y : a16.y));
            old.z = grp == 0 ? a2.z : (grp == 1 ? a4.z : (grp == 2 ? a8.z : a16.z)); old.w = grp == 0 ? a2.w : (grp == 1 ? a4.w : (grp == 2 ? a8.w : a16.w));
            float f[8]; unpack8(old, f);
#pragma unroll
            for (int i = 0; i < 8; ++i) sum[i] -= f[i];
        }
#pragma unroll
        for (int j = 0; j < 8; ++j) ring[(r0 + j) & 15] = cur[j];
    }
}

__device__ __forceinline__ void fox_norm_item(Frame& F, int it) {
    const int bhblk = it >> 3, wv = it & 7, bh = bhblk >> 5, blk = bhblk & 31, b = bh >> 3, h = bh & 7;
    const size_t m = (size_t)b * SEQ + blk * 256 + wv * 32 + (F.lane >> 1); const int col = h * 64 + (F.lane & 1) * 32;
    const bf16* QS = (const bf16*)(F.ws + WS_NG + SL_FQ * SLAB_BYTES) + m * 512 + col; const bf16* KS = (const bf16*)(F.ws + WS_NG + SL_FK * SLAB_BYTES) + m * 512 + col;
    float sq = 0.f, sk = 0.f, dq = 0.f;
#pragma unroll
    for (int i = 0; i < 4; ++i) { float f[8], g[8]; const v4u a = *(const GAS v4u*)(QS + 8 * i), c = *(const GAS v4u*)(KS + 8 * i);
        f[0] = __uint_as_float(a.x << 16); f[1] = __uint_as_float(a.x & 0xffff0000u); f[2] = __uint_as_float(a.y << 16); f[3] = __uint_as_float(a.y & 0xffff0000u); f[4] = __uint_as_float(a.z << 16); f[5] = __uint_as_float(a.z & 0xffff0000u); f[6] = __uint_as_float(a.w << 16); f[7] = __uint_as_float(a.w & 0xffff0000u);
        g[0] = __uint_as_float(c.x << 16); g[1] = __uint_as_float(c.x & 0xffff0000u); g[2] = __uint_as_float(c.y << 16); g[3] = __uint_as_float(c.y & 0xffff0000u); g[4] = __uint_as_float(c.z << 16); g[5] = __uint_as_float(c.z & 0xffff0000u); g[6] = __uint_as_float(c.w << 16); g[7] = __uint_as_float(c.w & 0xffff0000u);
#pragma unroll
        for (int j = 0; j < 8; ++j) { sq += f[j] * f[j]; sk += g[j] * g[j]; dq += f[j] * g[j]; } }
    sq += __shfl_xor(sq, 1); sk += __shfl_xor(sk, 1); dq += __shfl_xor(dq, 1);
    dq = -wave_max(-dq);
    sq = wave_max(sq) * 1.0001f; sk = wave_max(sk) * 1.0001f;
    if (F.lane == 0) { ((float*)(F.ws + WS_SM + SM_FQN))[it] = sq; ((float*)(F.ws + WS_SM + SM_FKN))[it] = sk; ((float*)(F.ws + WS_SM + SM_FXM))[it] = dq; }
}

typedef float f32x16 __attribute__((ext_vector_type(16)));
typedef unsigned u32x2 __attribute__((ext_vector_type(2)));
__device__ __forceinline__ float silu_f(float x) { return x * __builtin_amdgcn_rcpf(1.f + __builtin_amdgcn_exp2f(-1.4426950408889634f * x)); }
__device__ __forceinline__ void conv8(const bf16* slab, size_t m, int tt, int col, const float (&cw)[4][8], float (&o)[8]) {
    v4u q[4];
#pragma unroll
    for (int j = 0; j < 4; ++j) { const size_t mr = (tt - 3 + j >= 0) ? m - 3 + j : m; q[j] = *(const GAS v4u*)(slab + mr * 512 + col); }
#pragma unroll
    for (int i = 0; i < 8; ++i) o[i] = 0.f;
#pragma unroll
    for (int j = 0; j < 4; ++j) { float f[8]; unpack8(q[j], f); const float vld = (tt - 3 + j >= 0) ? 1.f : 0.f;
#pragma unroll
        for (int i = 0; i < 8; ++i) o[i] += (cw[j][i] * vld) * f[i]; }
#pragma unroll
    for (int i = 0; i < 8; ++i) o[i] = silu_f(o[i]);
}
constexpr int KT_P = 72, QS_P = 136;
__device__ __forceinline__ bf16x8 pack_acc8(const f32x16& x, int s) {
    v4u w; w.x = pk2(x[8 * s + 0], x[8 * s + 1]); w.y = pk2(x[8 * s + 2], x[8 * s + 3]); w.z = pk2(x[8 * s + 4], x[8 * s + 5]); w.w = pk2(x[8 * s + 6], x[8 * s + 7]);
    return __builtin_bit_cast(bf16x8, w);
}
__device__ __forceinline__ void conv8r(const v4u (&q)[4], int tt, const LAS float* cw, int col, float (&o)[8]) {
#pragma unroll
    for (int i = 0; i < 8; ++i) o[i] = 0.f;
#pragma unroll
    for (int j = 0; j < 4; ++j) { float f[8]; unpack8(q[j], f); const float vld = (tt - 3 + j >= 0) ? 1.f : 0.f;
        const f32x4 w0 = *(const LAS f32x4*)(cw + j * 512 + col) * vld, w1 = *(const LAS f32x4*)(cw + j * 512 + col + 4) * vld;
#pragma unroll
        for (int i = 0; i < 4; ++i) { o[i] += w0[i] * f[i]; o[4 + i] += w1[i] * f[4 + i]; } }
#pragma unroll
    for (int i = 0; i < 8; ++i) o[i] = silu_f(o[i]);
}
struct RawL { v4u k[2][4]; v4u v[2]; float fp, ip; };
__device__ __forceinline__ void mlstm_L_load(Frame& F, int u, RawL& R) {
    const int bh = u >> 7, c = u & (NCH - 1), b = bh >> 2, h = bh & 3;
    const bf16* KS = (const bf16*)(F.ws + WS_NG + SL_MK * SLAB_BYTES); const bf16* VS = (const bf16*)(F.ws + WS_NG + SL_MV * SLAB_BYTES);
    const int s = F.lane, tt = c * CHUNK + s; const size_t m = (size_t)b * SEQ + tt;
#pragma unroll
    for (int half = 0; half < 2; ++half) { const int col = h * ML_DH + (F.wave + 8 * half) * 8;
#pragma unroll
        for (int j = 0; j < 4; ++j) { const size_t mr = (tt - 3 + j >= 0) ? m - 3 + j : m; R.k[half][j] = *(const GAS v4u*)(KS + mr * 512 + col); }
        R.v[half] = *(const GAS v4u*)(VS + m * 512 + col); }
    const float* gate16 = (const float*)(F.ws + WS_SM + SM_GATE16) + m * 16;
    R.fp = gate16[4 + h]; R.ip = gate16[h];
}
__device__ __forceinline__ void mlstm_L_phase(Frame& F, int l) {
    LAS bf16* Kt = (LAS bf16*)(F.lds); LAS bf16* Vt = Kt + 128 * KT_P; LAS float* wk = (LAS float*)(F.lds + 2 * 128 * KT_P * 2); LAS float* cwk = (LAS float*)(F.lds + 40960);
    for (int i = F.tid; i < 4 * 512; i += NWAVES * 64) cwk[i] = INP(F, IN_CONVW)[(size_t)l * 4 * 1024 + (i >> 9) * 1024 + 512 + (i & 511)];
    const int NU = BATCH * ML_H * NCH;
    float b_f[ML_H], b_i[ML_H];
#pragma unroll
    for (int i = 0; i < ML_H; ++i) { b_f[i] = INP(F, IN_MLBF)[l * ML_H + i]; b_i[i] = INP(F, IN_MLBI)[l * ML_H + i]; }
    int u = F.vcu; if (u >= NU) { __syncthreads(); return; }
    RawL cur; mlstm_L_load(F, u, cur);
    __syncthreads();
    for (; u < NU; u += F.G) {
        const int bh = u >> 7, h = bh & 3;
        if (F.tid < CHUNK) {
            const float lf = logsigmoid_f(cur.fp + b_f[h]), li = cur.ip + b_i[h];
            const float bc = wave_scan_add(lf, F.lane), a = li - bc, amax = wave_max(a);
            wk[F.tid] = __expf(a - amax);
            const int c = u & (NCH - 1);
            ((float*)(F.ws + WS_SM + SM_MLB))[(size_t)bh * SEQ + c * CHUNK + F.tid] = bc; ((float*)(F.ws + WS_SM + SM_MLA))[(size_t)bh * SEQ + c * CHUNK + F.tid] = a;
            if (F.tid == 63) { float* bg = (float*)(F.ws + WS_SM + SM_MLBG) + 2 * u; bg[0] = bc; bg[1] = bc + amax; }
        }
        __syncthreads();
        {   const int s = F.lane, tt = (u & (NCH - 1)) * CHUNK + s;
#pragma unroll
            for (int half = 0; half < 2; ++half) { const int cg = F.wave + 8 * half, col = h * ML_DH + cg * 8;
                float kk[8]; conv8r(cur.k[half], tt, cwk, col, kk);
                float vv[8]; unpack8(cur.v[half], vv); const float ws = wk[s];
#pragma unroll
                for (int i = 0; i < 8; ++i) { Kt[(cg * 8 + i) * KT_P + s] = (bf16)f2bf(kk[i] * 0.08838834764831845f); Vt[(cg * 8 + i) * KT_P + s] = (bf16)f2bf(vv[i] * ws); } }
        }
        __syncthreads();
        if (u + F.G < NU) mlstm_L_load(F, u + F.G, cur);
        {   const int r = F.lane & 31, hi = F.lane >> 5, kb = F.wave >> 1;
            f32x16 acc[2]; acc[0] = f32x16{}; acc[1] = f32x16{};
#pragma unroll
            for (int sp = 0; sp < 4; ++sp) { const bf16x8 a = *(const LAS bf16x8*)(Kt + (kb * 32 + r) * KT_P + 16 * sp + 8 * hi);
#pragma unroll
                for (int j = 0; j < 2; ++j) { const int vb = 2 * (F.wave & 1) + j; const bf16x8 bb = *(const LAS bf16x8*)(Vt + (vb * 32 + r) * KT_P + 16 * sp + 8 * hi);
                    acc[j] = __builtin_amdgcn_mfma_f32_32x32x16_bf16(a, bb, acc[j], 0, 0, 0); } }
            GAS bf16x8* img = (GAS bf16x8*)(F.ws + WS_MLC + (size_t)u * 32768);
#pragma unroll
            for (int j = 0; j < 2; ++j) { const int vb = 2 * (F.wave & 1) + j;
#pragma unroll
                for (int s = 0; s < 2; ++s) img[((vb * 4 + kb) * 2 + s) * 64 + F.lane] = pack_acc8(acc[j], s); }
        }
        if (F.tid < ML_DH) { float a = 0.f;
#pragma unroll 8
            for (int s = 0; s < CHUNK; ++s) a += wk[s] * __uint_as_float((unsigned)Kt[F.tid * KT_P + s] << 16);
            ((float*)(F.ws + WS_SM + SM_MLN))[(size_t)u * ML_DH + F.tid] = a; }
        __syncthreads();
    }
}
__device__ __forceinline__ void mlstm_S(Frame& F) {
    LAS float* dec = (LAS float*)(F.lds); LAS float* cor = dec + NCH;
    for (int unit = F.vcu; unit < 16 * 16; unit += F.G) {
        const int bh = unit >> 4, part = unit & 15;
        const int e2 = part * 512 + F.tid; GAS unsigned* p = (GAS unsigned*)(F.ws + WS_MLC + (size_t)bh * NCH * 32768) + e2;
        unsigned q[32];
#pragma unroll
        for (int i = 0; i < 32; ++i) q[i] = p[(size_t)i * 8192];
        {
            const float* bg = (const float*)(F.ws + WS_SM + SM_MLBG) + 2 * bh * NCH; float* mlm = (float*)(F.ws + WS_SM + SM_MLM) + bh * 132;
            LAS float* bgl = cor + NCH; LAS float* mml = bgl + 2 * NCH;
            if (F.tid < 2 * NCH) bgl[F.tid] = bg[F.tid];
            __syncthreads();
            if (F.tid == 0) { float mm = 0.f;
                for (int c = 0; c < NCH; ++c) { const float B = bgl[2 * c], G = bgl[2 * c + 1], mn = fmaxf(B + mm, G); dec[c] = __expf(B + mm - mn); cor[c] = __expf(G - mn); mml[c] = mm; mm = mn; }
                mml[NCH] = mm; }
            __syncthreads();
            if (F.tid <= NCH) mlm[F.tid] = mml[F.tid]; }
        {   float r0 = 0.f, r1 = 0.f;
            for (int c0 = 0; c0 < NCH; c0 += 32) {
#pragma unroll
                for (int i = 0; i < 32; ++i) { const float d = dec[c0 + i], k = cor[c0 + i]; p[(size_t)(c0 + i) * 8192] = pk2(r0, r1);
                    r0 = d * r0 + k * __uint_as_float(q[i] << 16); r1 = d * r1 + k * __uint_as_float(q[i] & 0xffff0000u); }
                if (c0 + 32 < NCH) {
#pragma unroll
                    for (int i = 0; i < 32; ++i) q[i] = p[(size_t)(c0 + 32 + i) * 8192]; } } }
        if (part == 0 && F.tid < ML_DH) { float* p = (float*)(F.ws + WS_SM + SM_MLN) + (size_t)bh * NCH * ML_DH + F.tid;
            float r = 0.f;
            for (int c0 = 0; c0 < NCH; c0 += 32) { float q[32];
#pragma unroll
                for (int i = 0; i < 32; ++i) q[i] = p[(size_t)(c0 + i) * ML_DH];
#pragma unroll
                for (int i = 0; i < 32; ++i) { p[(size_t)(c0 + i) * ML_DH] = r; r = dec[c0 + i] * r + cor[c0 + i] * q[i]; } } }
        __syncthreads();
    }
}
#define O_BAR() do { asm volatile("s_waitcnt lgkmcnt(0)" ::: "memory"); __builtin_amdgcn_s_barrier(); asm volatile("" ::: "memory"); } while (0)
constexpr int O_RAWQ = 73728, O_RAWK = O_RAWQ + 68 * 256, O_RAWV = O_RAWK + 68 * 256, O_END = O_RAWV + 64 * 256;
static_assert(O_END + 3 * 2 * 1024 <= RING_BYTES, "mLSTM O-phase LDS map");
__device__ __forceinline__ void mlstm_O_dma(Frame& F, int u) {
    const int bh = u >> 7, c = u & (NCH - 1), b = bh >> 2, h = bh & 3;
    const size_t seq0 = (size_t)b * SEQ; const int t0 = c * CHUNK;
    for (int i = F.wave; i < 50; i += NWAVES) {
        const int ten = i < 17 ? 0 : (i < 34 ? 1 : 2), ii = i - 17 * ten, row = 4 * ii + (F.lane >> 4);
        int t = (ten == 2) ? t0 + row : t0 - 3 + row; t = t < 0 ? 0 : (t > t0 + CHUNK - 1 ? t0 + CHUNK - 1 : t);
        const bf16* src = (const bf16*)(F.ws + WS_NG + (size_t)(ten == 0 ? SL_MQ : (ten == 1 ? SL_MK : SL_MV)) * SLAB_BYTES) + (seq0 + t) * 512 + h * ML_DH + (((F.lane & 15) ^ (row & 15)) * 8);
        const int dst = (ten == 0 ? O_RAWQ : (ten == 1 ? O_RAWK : O_RAWV)) + ii * 1024;
        __builtin_amdgcn_global_load_lds((const GAS unsigned*)src, (LAS unsigned*)(F.lds + dst), 16, 0, 0);
    }
}
__device__ __forceinline__ void conv8l(const LAS bf16* raw, int s, int tt, const LAS float* cw, int cg, int col, float (&o)[8]) {
#pragma unroll
    for (int i = 0; i < 8; ++i) o[i] = 0.f;
#pragma unroll
    for (int j = 0; j < 4; ++j) { float f[8]; unpack8(*(const LAS v4u*)(raw + (s + j) * 128 + ((cg ^ ((s + j) & 15)) * 8)), f); const float vld = (tt - 3 + j >= 0) ? 1.f : 0.f;
        const f32x4 w0 = *(const LAS f32x4*)(cw + j * 512 + col) * vld, w1 = *(const LAS f32x4*)(cw + j * 512 + col + 4) * vld;
#pragma unroll
        for (int i = 0; i < 4; ++i) { o[i] += w0[i] * f[i]; o[4 + i] += w1[i] * f[4 + i]; } }
#pragma unroll
    for (int i = 0; i < 8; ++i) o[i] = silu_f(o[i]);
}
__device__ __forceinline__ void mlstm_O_phase(Frame& F, int l) {
    LAS bf16* Qs = (LAS bf16*)(F.lds); LAS bf16* Ks = Qs + 64 * QS_P; LAS bf16* Vt = Ks + 64 * QS_P;
    LAS float* fa = (LAS float*)(F.lds + (2 * 64 * QS_P + 128 * KT_P) * 2); LAS float* fmx = fa + 64; LAS float* fb = fa + 128; LAS float* nvec = fa + 192; LAS float* ssq = fa + 320;
    LAS float* cwq = (LAS float*)(F.lds + 57344); LAS float* cwk = cwq + 4 * 512;
    LAS float* psm = (LAS float*)(F.lds + 55552); LAS float* nqp = psm + 96; LAS bf16x8* pimg = (LAS bf16x8*)(F.lds + O_END);
    const LAS bf16* rawq = (const LAS bf16*)(F.lds + O_RAWQ); const LAS bf16* rawk = (const LAS bf16*)(F.lds + O_RAWK); const LAS bf16* rawv = (const LAS bf16*)(F.lds + O_RAWV);
    for (int i = F.tid; i < 4 * 512; i += NWAVES * 64) { cwq[i] = INP(F, IN_CONVW)[(size_t)l * 4 * 1024 + (i >> 9) * 1024 + (i & 511)]; cwk[i] = INP(F, IN_CONVW)[(size_t)l * 4 * 1024 + (i >> 9) * 1024 + 512 + (i & 511)]; }
    const int NU = BATCH * ML_H * NCH;
    int u = F.vcu; if (u >= NU) { __syncthreads(); return; }
    mlstm_O_dma(F, u);
    const bf16* OS = (const bf16*)(F.ws + WS_NG + SL_MO * SLAB_BYTES);
    const int r = F.lane & 31, hi = F.lane >> 5, tb = F.wave & 1, vb = F.wave >> 1;
    for (; u < NU; u += F.G) {
    const int bh = u >> 7, c = u & (NCH - 1), b = bh >> 2, h = bh & 3;
    asm volatile("s_waitcnt vmcnt(0)" ::: "memory"); O_BAR();
    const float m_c = ((const float*)(F.ws + WS_SM + SM_MLM))[bh * 132 + c];
    bf16x8 cf[4][2];
    {   const GAS bf16x8* img = (const GAS bf16x8*)(F.ws + WS_MLC + (size_t)u * 32768);
#pragma unroll
        for (int kb = 0; kb < 4; ++kb)
#pragma unroll
            for (int s = 0; s < 2; ++s) cf[kb][s] = img[((vb * 4 + kb) * 2 + s) * 64 + F.lane]; }
    u32x2 oww[4];
    {   const size_t m = (size_t)b * SEQ + c * CHUNK + tb * 32 + r;
#pragma unroll
        for (int q = 0; q < 4; ++q) oww[q] = *(const GAS u32x2*)(OS + m * 512 + h * ML_DH + vb * 32 + 8 * q + 4 * hi); }
    float g0 = 0.f, g1 = 0.f, g2 = 0.f;
    {   const float* mlb = (const float*)(F.ws + WS_SM + SM_MLB) + (size_t)bh * SEQ; const float* mla = (const float*)(F.ws + WS_SM + SM_MLA) + (size_t)bh * SEQ; const float* mlmx = (const float*)(F.ws + WS_SM + SM_MLMX) + (size_t)bh * SEQ;
        if (F.tid < CHUNK) { g0 = mla[c * CHUNK + F.tid]; g2 = mlb[c * CHUNK + F.tid]; g1 = fmaxf(m_c, wave_scan_max(g0, F.lane)); }
        else if (F.tid < CHUNK + ML_DH) g0 = ((const float*)(F.ws + WS_SM + SM_MLN))[(size_t)u * ML_DH + F.tid - CHUNK]; }
    {   const int s = F.lane, tt = c * CHUNK + s;
#pragma unroll
        for (int half = 0; half < 2; ++half) { const int cg = F.wave + 8 * half, col = h * ML_DH + cg * 8;
            float qq[8], kk[8], vv[8]; conv8l(rawq, s, tt, cwq, cg, col, qq); conv8l(rawk, s, tt, cwk, cg, col, kk); unpack8(*(const LAS v4u*)(rawv + s * 128 + ((cg ^ (s & 15)) * 8)), vv);
            v4u wq, wkk; wq.x = pk2(qq[0], qq[1]); wq.y = pk2(qq[2], qq[3]); wq.z = pk2(qq[4], qq[5]); wq.w = pk2(qq[6], qq[7]);
            const float sc = 0.08838834764831845f;
            wkk.x = pk2(kk[0] * sc, kk[1] * sc); wkk.y = pk2(kk[2] * sc, kk[3] * sc); wkk.z = pk2(kk[4] * sc, kk[5] * sc); wkk.w = pk2(kk[6] * sc, kk[7] * sc);
            *(LAS v4u*)(Qs + s * QS_P + cg * 8) = wq; *(LAS v4u*)(Ks + s * QS_P + cg * 8) = wkk;
#pragma unroll
            for (int i = 0; i < 8; ++i) Vt[(cg * 8 + i) * KT_P + s] = (bf16)f2bf(vv[i]); }
    }
    if (F.tid < CHUNK) { fa[F.tid] = g0; fmx[F.tid] = g1; fb[F.tid] = g2; }
    else if (F.tid < CHUNK + ML_DH) nvec[F.tid - CHUNK] = g0;
    O_BAR();
    if (u + F.G < NU) mlstm_O_dma(F, u + F.G);
    const int t = tb * 32 + r;
    const float Mx_t = fmx[t], m_t = fb[t] + Mx_t, w_int = __expf(m_c - Mx_t);
    if (F.wave < 3) {
        const int tbs = F.wave ? 1 : 0, sbs = F.wave == 2 ? 1 : 0, ts = tbs * 32 + r; const float Mxs = fmx[ts];
        f32x16 x = f32x16{};
#pragma unroll
        for (int ks = 0; ks < 8; ++ks) { const bf16x8 a = *(const LAS bf16x8*)(Ks + (sbs * 32 + r) * QS_P + 16 * ks + 8 * hi); const bf16x8 q = *(const LAS bf16x8*)(Qs + ts * QS_P + 16 * ks + 8 * hi);
            x = __builtin_amdgcn_mfma_f32_32x32x16_bf16(a, q, x, 0, 0, 0); }
        float ps = 0.f;
#pragma unroll
        for (int rr = 0; rr < 16; ++rr) { const int s = sbs * 32 + (rr & 3) + 8 * (rr >> 2) + 4 * hi; const float pv = (s <= ts) ? __expf(fa[s] - Mxs) * x[rr] : 0.f; x[rr] = pv; ps += pv; }
        ps += __shfl_xor(ps, 32);
        pimg[(F.wave * 2 + 0) * 64 + F.lane] = pack_acc8(x, 0); pimg[(F.wave * 2 + 1) * 64 + F.lane] = pack_acc8(x, 1);
        if (hi == 0) psm[F.wave * 32 + r] = ps;
    }
    {   float nq = 0.f;
#pragma unroll
        for (int i = 0; i < 2; ++i) { float f[8]; unpack8(*(const LAS v4u*)(Qs + t * QS_P + 32 * vb + 16 * hi + 8 * i), f);
#pragma unroll
            for (int j = 0; j < 8; ++j) nq += f[j] * nvec[32 * vb + 16 * hi + 8 * i + j]; }
        nq += __shfl_xor(nq, 32);
        if (hi == 0) nqp[vb * 64 + t] = nq; }
    f32x16 acc = f32x16{};
#pragma unroll
    for (int kb = 0; kb < 4; ++kb)
#pragma unroll
        for (int s = 0; s < 2; ++s) { const u32x2 lo = *(const LAS u32x2*)(Qs + t * QS_P + kb * 32 + 16 * s + 4 * hi), hi2 = *(const LAS u32x2*)(Qs + t * QS_P + kb * 32 + 16 * s + 8 + 4 * hi);
            v4u w; w.x = lo.x; w.y = lo.y; w.z = hi2.x; w.w = hi2.y;
            acc = __builtin_amdgcn_mfma_f32_32x32x16_bf16(cf[kb][s], __builtin_bit_cast(bf16x8, w), acc, 0, 0, 0); }
#pragma unroll
    for (int rr = 0; rr < 16; ++rr) acc[rr] *= w_int;
    O_BAR();
    float psum = 0.f;
#pragma unroll
    for (int sb = 0; sb < 2; ++sb) {
        if (sb <= tb) { const int blk = tb == 0 ? 0 : 1 + sb; psum += psm[blk * 32 + r];
#pragma unroll
            for (int s = 0; s < 2; ++s) { const u32x2 lo = *(const LAS u32x2*)(Vt + (vb * 32 + r) * KT_P + sb * 32 + 16 * s + 4 * hi), hi2 = *(const LAS u32x2*)(Vt + (vb * 32 + r) * KT_P + sb * 32 + 16 * s + 8 + 4 * hi);
                v4u w; w.x = lo.x; w.y = lo.y; w.z = hi2.x; w.w = hi2.y;
                acc = __builtin_amdgcn_mfma_f32_32x32x16_bf16(__builtin_bit_cast(bf16x8, w), pimg[(blk * 2 + s) * 64 + F.lane], acc, 0, 0, 0); }
        }
    }
    const float nq = (nqp[t] + nqp[64 + t]) + (nqp[128 + t] + nqp[192 + t]);
    const float den = w_int * nq + psum, inv = 1.f / fmaxf(fabsf(den), __expf(-m_t));
    float sq = 0.f;
#pragma unroll
    for (int rr = 0; rr < 16; ++rr) { acc[rr] *= inv; sq += acc[rr] * acc[rr]; }
    sq += __shfl_xor(sq, 32);
    if (hi == 0) ssq[vb * 64 + t] = sq;
    O_BAR();
    const float rstd = 1.f / sqrtf((ssq[t] + ssq[64 + t] + ssq[128 + t] + ssq[192 + t]) * (1.f / ML_DH) + NORM_EPS);
    {   const size_t m = (size_t)b * SEQ + c * CHUNK + t; bf16* CAT = (bf16*)(F.ws + WS_CAT);
#pragma unroll
        for (int q = 0; q < 4; ++q) { const int v0 = vb * 32 + 8 * q + 4 * hi, col = h * ML_DH + v0;
            const u32x2 ow = oww[q]; const f32x4 gn = *(const GAS f32x4*)(INP(F, IN_MLNG) + (size_t)l * 512 + col);
            const float o0 = sigmoid_f(__uint_as_float(ow.x << 16)), o1 = sigmoid_f(__uint_as_float(ow.x & 0xffff0000u)), o2 = sigmoid_f(__uint_as_float(ow.y << 16)), o3 = sigmoid_f(__uint_as_float(ow.y & 0xffff0000u));
            u32x2 w; w.x = pk2(acc[4 * q] * rstd * gn.x * o0, acc[4 * q + 1] * rstd * gn.y * o1); w.y = pk2(acc[4 * q + 2] * rstd * gn.z * o2, acc[4 * q + 3] * rstd * gn.w * o3);
            *(GAS u32x2*)(CAT + m * KCAT + 512 + col) = w; }
    }
    }
    asm volatile("s_waitcnt vmcnt(0)" ::: "memory"); O_BAR();
}
#undef O_BAR

#ifndef SUBP
#define SUBP 0
#endif
#ifndef MK_MULTI
#define MK_MULTI 0
#endif
constexpr int NPH = 1 + (8 + 1) + (1 + 8 + 4) + 1;
#ifndef PH_MASK
#define PH_MASK 0xffffffffu
#endif
#ifndef PROBE_MASK
#define PROBE_MASK 0u
#endif
#define PH_BEGIN(id) if (ph >= lo && ph < hi) { if constexpr (((PH_MASK) >> (id)) & 1u) { for (int rep_ = 0; rep_ < 1 + (int)(((PROBE_MASK) >> (id)) & 1u); ++rep_) { Frame F = FK; { size_t z_ = 0; int zi_ = 0; asm volatile("" : "+v"(F.tid), "+s"(z_), "+s"(zi_)); \
        F.lane = F.tid & 63; F.ws = FK.ws + z_; F.out = (float*)((char*)FK.out + z_); F.zi = zi_; } const int gw = F.vcu * NWAVES + F.wave, NGWV = F.G * NWAVES; (void)gw; (void)NGWV;
#define PH_END __syncthreads(); } } if (ph + 1 < hi) { XcdBarrier b2_ = bar; size_t zb_ = 0; asm volatile("" : "+s"(zb_)); b2_.bar = bar.bar + zb_; xcd_barrier(b2_); } } ++ph;
#define HB ((bf16*)(F.ws + WS_HB))
#define CAT ((bf16*)(F.ws + WS_CAT))
#define SLAB ((bf16*)(F.ws + WS_NG))
#define GATE ((bf16*)(F.ws + WS_GATE))
#define WL ((bf16*)(F.ws + WS_W + (size_t)l * W_LAYER))
#define XBP ((bf16*)F.out)

template <int l> __device__ __forceinline__ void layer_phases(Frame& FK, int& ph, const int lo, const int hi, const XcdBarrier& bar, unsigned char* lds) {
        if constexpr (l > 0) { PH_BEGIN(1) phase_norm_mix<true>(F, XBP, l); PH_END }
        PH_BEGIN(2)
            pg8::Gemm g{HB, WL + W_NG / 2, M, NGW, D}; pg8::StaticOrder S; S.init(M, NGW, F.G, F.blk);
            pg8::EpiSlab E{SLAB, (size_t)M * 512, SL_FQ, attn_body::C2};
            pg8::gemm_phase<pg8::EpiSlab, pg8::StaticOrder, true, true>(F.lds + RING_OFF, g, S, E);
        PH_END
        PH_BEGIN(3)
            for (int s = F.blk; s < BATCH * FX_H * 8; s += F.G) prep_fox(F, l, s);
            for (int rp = 0; rp < (SUBP == 1 ? 2 : 1); ++rp) for (int it = gw; it < M / POOL_ROWS; it += NGWV) pool_item(F, it);
            for (int rp = 0; rp < (SUBP == 2 ? 2 : 1); ++rp) for (int it = gw; it < BATCH * FX_H * 32 * 8; it += NGWV) fox_norm_item(F, it);
            for (int rp = 0; rp < (SUBP == 3 ? 2 : 1); ++rp) mlstm_L_phase(F, l);
        PH_END
        PH_BEGIN(4)
            mlstm_S(F);
            for (int ui = gw; ui < BATCH * FX_H * 32; ui += NGWV) { const int bh = ui >> 5, qb = ui & 31;
                const int t0 = attn_body::attn_t0(qb, (const float*)(F.ws + WS_SM + SM_FNB) + (size_t)bh * SEQ, (const float*)(F.ws + WS_SM + SM_FSEG) + bh * 8, (const float*)(F.ws + WS_SM + SM_FQN) + bh * 256, (const float*)(F.ws + WS_SM + SM_FKN) + bh * 256, (const float*)(F.ws + WS_SM + SM_FXM) + bh * 256, F.lane);
                if (F.lane == 0) ((int*)(F.ws + WS_SM + SM_FT0))[ui] = t0; }
        PH_END
        PH_BEGIN(18)
            for (int rp = 0; rp < (SUBP == 4 ? 2 : 1); ++rp) mlstm_O_phase(F, l);
            const attn_body::AttnTensors AT{(const attn_body::bf16*)(SLAB + (size_t)SL_FQ * M * 512), (const attn_body::bf16*)(SLAB + (size_t)SL_FK * M * 512), (const attn_body::bf16*)(SLAB + (size_t)SL_FV * M * 512),
                                            (attn_body::bf16*)CAT, (const float*)(F.ws + WS_SM + SM_FNB), (const float*)(F.ws + WS_SM + SM_FQN), (const float*)(F.ws + WS_SM + SM_FKN), (const int*)(F.ws + WS_SM + SM_FT0), (const float*)(F.ws + WS_SM + SM_FSEG)};
            attn_body::attn_phase_dyn<8>((char*)lds + RING_OFF, AT, (unsigned*)(F.ctl + 2048 + 64 * l), F.MISC + 0);
            quant_rows_fp8(F, HB, F.ws + WS_NG + (size_t)SL_POOL * SLAB_BYTES);
        PH_END
        PH_BEGIN(6)
            pg8::Gemm g{(const bf16*)(F.ws + WS_NG + (size_t)SL_POOL * SLAB_BYTES), WL + W_GT / 2, M, NGT, D / 2}; pg8::StaticOrder S; S.init(M, NGT, F.G, F.blk);
            pg8::EpiSig E{(unsigned char*)GATE, 1.f / (FP8_ASCALE * FP8_WSCALE)};
            pg8::gemm_phase<pg8::EpiSig, pg8::StaticOrder, true, true, true>(F.lds + RING_OFF, g, S, E);
        PH_END
        PH_BEGIN(7)
            pg8::Gemm g{CAT, WL + W_CAT / 2, M, D, KCAT}; pg8::StaticOrder S; S.init(M, D, F.G, F.blk);
            pg8::EpiMerge E{(const unsigned char*)GATE, HB};
            pg8::gemm_phase<pg8::EpiMerge, pg8::StaticOrder, true, true>(F.lds + RING_OFF, g, S, E);
        PH_END
        PH_BEGIN(8)
            pg8::Gemm g{HB, WL + W_OUT / 2, M, D, D}; pg8::StaticOrder S; S.init(M, D, F.G, F.blk);
            if constexpr (l == 0) { pg8::EpiResB<true> E{INP(F, IN_X), XBP, (float*)(F.ws + WS_SM + SM_GATE16)};     pg8::gemm_phase<pg8::EpiResB<true>, pg8::StaticOrder, true, true>(F.lds + RING_OFF, g, S, E); }
            else { pg8::EpiResB<false> E{XBP, XBP, nullptr}; pg8::gemm_phase<pg8::EpiResB<false>, pg8::StaticOrder, true, true>(F.lds + RING_OFF, g, S, E); }
        PH_END
        if constexpr (l == 0) {
            PH_BEGIN(10)
                pg8::Gemm g{XBP, (const bf16*)(F.ws + WS_WGU), M, 2 * DFF, D}; pg8::StaticOrder S; S.init(M, 2 * DFF, F.G, F.blk);
                LAS int* pml = (LAS int*)(F.lds + LDSCTL_OFF + 512); LAS float* rtab = (LAS float*)(F.lds + LDSCTL_OFF + 1024);
                if (F.tid == 0) { int n = 0; pg8::Unit u_; for (int i = 0; S.next(i, u_); ++i) { bool seen = false; for (int k = 0; k < n; ++k) seen = seen || (pml[1 + k] == u_.pm); if (!seen && n < 14) { pml[1 + n] = u_.pm; ++n; } } pml[0] = n; }
                __syncthreads();
                { const float* part = (const float*)(F.ws + WS_SM + SM_GATE16); const int n = pml[0];
                  for (int k = F.tid >> 8; k < n; k += 2) { const int r = F.tid & 255; const GAS f32x4* pr = (const GAS f32x4*)(part + (size_t)(pml[1 + k] * 256 + r) * 16);
                      const f32x4 a = pr[0], b = pr[1], c = pr[2], d = pr[3]; const float s = (((a.x + a.y) + (a.z + a.w)) + ((b.x + b.y) + (b.z + b.w))) + (((c.x + c.y) + (c.z + c.w)) + ((d.x + d.y) + (d.z + d.w)));
                      rtab[k * 256 + r] = __builtin_amdgcn_rsqf(s * (1.f / D) + NORM_EPS); } }
                __syncthreads();
                pg8::EpiSwiGLUR E{(bf16*)(F.ws + WS_ACT0), DFF, (const PG8_LAS int*)pml, (const PG8_LAS float*)rtab};
                pg8::gemm_phase<pg8::EpiSwiGLUR, pg8::StaticOrder, true, true, false, XLD, XROT>(F.lds + RING_OFF, g, S, E);
            PH_END
            PH_BEGIN(11)
                pg8::Gemm g{(const bf16*)(F.ws + WS_ACT0), (const bf16*)(F.ws + WS_WDN), M, D, DFF}; pg8::StaticOrder S; S.init(M, D, F.G, F.blk);
                pg8::EpiResB<false> E{XBP, XBP, nullptr};
                pg8::gemm_phase<pg8::EpiResB<false>, pg8::StaticOrder, true, true>(F.lds + RING_OFF, g, S, E);
            PH_END
        } else {
            PH_BEGIN(12)
                phase_route1(F, XBP);
                __syncthreads();
                LAS float* scr = (LAS float*)(F.lds + F.wave * 16384);
                for (int it = gw; it < CI_MOE; it += NGWV) conv_item_moe(F, it, scr);
            PH_END
            PH_BEGIN(13) phase_route2(F, XBP); PH_END
#define MOE_UP(k_, S_) do { pg8::Gemm g{(const bf16*)(F.ws + WS_XS), (const bf16*)(F.ws + WS_MOEGU), MOE_KROWS, 2 * DFE, D / 2, (const int*)(sm + MO_ROWTOK) + (k_) * MOE_KROWS, M}; \
                    pg8::EpiSwiGLU8 E{F.ws + WS_ACT1 + (size_t)(k_) * MOE_KROWS * DFE, DFE, 1.f / (FP8_ASCALE * FP8_WSCALE), FP8_ASCALE}; \
                    pg8::gemm_phase<pg8::EpiSwiGLU8, decltype(S_), true, true, true, 0, 0, true>(F.lds + RING_OFF, g, S_, E); } while (0)
#define MOE_DOWN(k_, off_, lo_, hi_) do { pg8::Gemm g{(const bf16*)(F.ws + WS_ACT1 + (size_t)(k_) * MOE_KROWS * DFE), (const bf16*)(F.ws + WS_MOEDN), MOE_KROWS, D, DFE / 2}; pg8::MoeOrder S; S.init(nM[k_], D / 256, F.G, F.blk, tile_e + (k_) * MOE_KTILES, off_, lo_, hi_); \
                    pg8::EpiMoeDown E{(bf16*)(F.ws + ((k_) == 0 ? WS_Y0 : WS_Y1)), (const int*)(sm + MO_ROWTOK) + (k_) * MOE_KROWS, (const float*)(sm + MO_ROWG) + (k_) * MOE_KROWS, 1.f / (FP8_ASCALE * FP8_WSCALE)}; \
                    pg8::gemm_phase<pg8::EpiMoeDown, pg8::MoeOrder, true, true, true>(F.lds + RING_OFF, g, S, E); } while (0)
#define MOE_TABLES unsigned char* sm = F.ws + WS_SM + SM_MOE; LAS int* tile_e = (LAS int*)(F.lds + LDSCTL_OFF + 1024); \
                    for (int i_ = F.tid; i_ < 2 * MOE_KTILES; i_ += NWAVES * 64) tile_e[i_] = __hip_atomic_load((const int*)(sm + MO_TILEE) + i_, RLX_AGENT); __syncthreads(); \
                    const int nM[2] = {__builtin_amdgcn_readfirstlane(__hip_atomic_load((const int*)(sm + MO_NT), RLX_AGENT)), __builtin_amdgcn_readfirstlane(__hip_atomic_load((const int*)(sm + MO_NT) + 1, RLX_AGENT))}; \
                    const int Nd0 = nM[0] * (D / 256), r1 = (nM[1] * (D / 256)) % F.G, dfr_ = (F.G - r1) % F.G, dfr = dfr_ <= Nd0 ? dfr_ : 0;
            PH_BEGIN(14)
                MOE_TABLES
                pg8::MoeOrder S; S.init(nM[0], 2 * DFE / 256, F.G, F.blk, tile_e);
                MOE_UP(0, S);
            PH_END
            PH_BEGIN(15)
                MOE_TABLES
                MOE_DOWN(0, 0, 0, Nd0 - dfr);
                { const int Nd = Nd0 - dfr; pg8::MoeOrderHL R; R.init(nM[1], 2 * DFE / 256, F.G, F.blk, (F.G % 8 == 0) ? Nd % F.G : 0, 3.5f, tile_e + MOE_KTILES);
                  MOE_UP(1, R); }
            PH_END
            PH_BEGIN(19)
                MOE_TABLES
                MOE_DOWN(1, 0, 0, 0x7fffffff);
                if (dfr > 0) MOE_DOWN(0, Nd0 - dfr - r1, Nd0 - dfr, Nd0);
            PH_END
#undef MOE_UP
#undef MOE_DOWN
#undef MOE_TABLES
        }
    }
struct Args { const float* in[24]; float* out; unsigned char* ws; int ph_lo, ph_hi; };
__global__ void __launch_bounds__(NWAVES * 64, 2) fwd(Args args) {
    extern __shared__ __attribute__((aligned(16))) unsigned char lds[];
    Frame FK;
    FK.lds = (LAS unsigned char*)lds;
    FK.MISC = (volatile LAS unsigned*)(FK.lds + MISC_OFF);
    FK.tid = threadIdx.x; FK.lane = FK.tid & 63; FK.wave = __builtin_amdgcn_readfirstlane(FK.tid >> 6);
    FK.G = gridDim.x; FK.blk = blockIdx.x; { const int bx = blockIdx.x; FK.vcu = (FK.G % 8 == 0) ? (bx % 8) * (FK.G / 8) + bx / 8 : bx; }
    FK.ws = args.ws; FK.ctl = (gu32*)(args.ws + WS_CTL); FK.out = args.out;
    FK.in = args.in; FK.zi = 0;
    for (int u = FK.tid; u < (LDS_BYTES - LDSCTL_OFF) / 4; u += NWAVES * 64) ((LAS unsigned*)(FK.lds + LDSCTL_OFF))[u] = 0u;
    __syncthreads();
    const int lo = args.ph_lo, hi = args.ph_hi;
    XcdBarrier bar; bar.bar = (unsigned*)(FK.ctl + CW_BAR); bar.x = 0; bar.st = nullptr;
    if (hi - lo > 1) bar = xcd_barrier_post((unsigned*)(FK.ctl + CW_BAR), FK.MISC + 8);
    int ph = 0;
    PH_BEGIN(0)
        LAS float* scr = (LAS float*)(F.lds + F.wave * 16384);
        for (int it = gw; it < CI_MAIN; it += NGWV) conv_item_main(F, it, scr);
        pool_fold(F);
        __syncthreads();
        phase_norm_mix<false>(F, INP(F, IN_X), 0);
    PH_END

    layer_phases<0>(FK, ph, lo, hi, bar, lds);
    layer_phases<1>(FK, ph, lo, hi, bar, lds);
    PH_BEGIN(16) phase_norm_final(F, XBP, F.out); PH_END
#undef PH_BEGIN
#undef HB
#undef CAT
#undef SLAB
#undef GATE
#undef WL
#undef XBP
#undef PH_END
}

extern "C" void kernel_launch(void* const* d_in, const int* in_sizes, int n_in, void* d_out, int out_size, void* d_ws, size_t ws_size, hipStream_t stream) {
    static int grid = 0;
    if (grid == 0) {
        if (n_in != 24 || in_sizes[0] != M * D || out_size != M * D || ws_size < WS_END) { fprintf(stderr, "kernel_launch: built for 24 inputs, x/out of %d floats, >= %zu bytes of workspace; got n_in %d, in0 %d, out %d, ws %zu; nothing launched\n", M * D, (size_t)WS_END, n_in, n_in > 0 ? in_sizes[0] : -1, out_size, ws_size); grid = -1; return; }
        int dev = 0, cus = 0, per_cu = 0;
        if (hipGetDevice(&dev) != hipSuccess || hipDeviceGetAttribute(&cus, hipDeviceAttributeMultiprocessorCount, dev) != hipSuccess) { fprintf(stderr, "kernel_launch: hipGetDevice / hipDeviceGetAttribute failed\n"); grid = -1; return; }
        if (hipFuncSetAttribute((const void*)fwd, hipFuncAttributeMaxDynamicSharedMemorySize, LDS_BYTES) != hipSuccess) { fprintf(stderr, "kernel_launch: hipFuncSetAttribute failed\n"); grid = -1; return; }
        if (hipOccupancyMaxActiveBlocksPerMultiprocessor(&per_cu, (const void*)fwd, NWAVES * 64, LDS_BYTES) != hipSuccess || per_cu < 1)
            fprintf(stderr, "kernel_launch: note: the occupancy query reports %d workgroups per CU\n", per_cu);
        (void)hipGetLastError();
        grid = cus;
    }
    if (grid < 0) return;
    if (hipMemsetAsync((char*)d_ws + WS_CTL, 0, CTL_ZERO_BYTES, stream) != hipSuccess) { fprintf(stderr, "kernel_launch: hipMemsetAsync failed\n"); return; }
    Args a{};
    for (int i = 0; i < 24; ++i) a.in[i] = (const float*)d_in[i];
    a.out = (float*)d_out; a.ws = (unsigned char*)d_ws;
#if MK_MULTI
    for (int p = 0; p < NPH; ++p) { a.ph_lo = p; a.ph_hi = p + 1; hipLaunchKernelGGL(fwd, dim3(grid), dim3(NWAVES * 64), LDS_BYTES, stream, a); }
#else
    a.ph_lo = 0; a.ph_hi = NPH; hipLaunchKernelGGL(fwd, dim3(grid), dim3(NWAVES * 64), LDS_BYTES, stream, a);
#endif
    const hipError_t le = hipPeekAtLastError();
    if (le != hipSuccess) fprintf(stderr, "kernel_launch: launch failed: %s\n", hipGetErrorName(le));
}
```
